# Optimizing an MI355X kernel written in HIP

```python
import math
import jax
import jax.numpy as jnp
from jax import lax
import numpy as np

D_MODEL = 1024
BATCH = 4
SEQ = 4096
DEPTH = 2

CTX_LEN = 256
GRID_W = 64
NORM_EPS = 1e-6
ROPE_THETA = 10000.0

GDN_HEADS = 8
GDN_DK = 64
GDN_DV = 64
GDN_CHUNK = 64
CONV_K = 5

SWA_Q_HEADS = 8
SWA_KV_HEADS = 2
SWA_HEAD_DIM = 64
SWA_WINDOW = 128
SWA_BLOCK = 128

MLA_HEADS = 8
MLA_Q_RANK = 384
MLA_KV_RANK = 256
MLA_NOPE = 64
MLA_ROPE = 32
MLA_V = 64

DIFF_HEADS = 4
DIFF_HEAD_DIM = 64

Q_BLOCK = 128

D_FF = 2816
N_EXPERTS = 8
TOP_K = 2
D_FF_EXPERT = 3584

N_EVEN = (DEPTH + 1) // 2
N_ODD = DEPTH // 2

GDN_QKV = GDN_HEADS * (2 * GDN_DK + GDN_DV)
GDN_Z = GDN_HEADS * GDN_DV
SWA_Q = SWA_Q_HEADS * SWA_HEAD_DIM
SWA_KV = SWA_KV_HEADS * SWA_HEAD_DIM
EVEN_COLS = (GDN_QKV, GDN_Z, 2 * GDN_HEADS, 2 * GDN_HEADS, SWA_Q, SWA_KV, SWA_KV)
EVEN_IN = sum(EVEN_COLS)
EVEN_MIX = GDN_Z + SWA_Q

DIFF_QK = DIFF_HEADS * 2 * DIFF_HEAD_DIM
DIFF_VW = DIFF_HEADS * 2 * DIFF_HEAD_DIM
ODD_COLS = (MLA_Q_RANK, MLA_KV_RANK, MLA_ROPE, DIFF_QK, DIFF_QK, DIFF_VW)
ODD_IN = sum(ODD_COLS)
ODD_MIX = MLA_HEADS * MLA_V + DIFF_VW

kernel_name = 'hybrid_diffusion_trunk'


def split_cols(a, sizes):
    return jnp.split(a, np.cumsum(sizes)[:-1].tolist(), axis=-1)


def rmsnorm(x, w):
    xf = x.astype(jnp.float32)
    y = xf * lax.rsqrt(jnp.mean(xf * xf, axis=-1, keepdims=True) + NORM_EPS)
    return (y * w.astype(jnp.float32)).astype(x.dtype)


def l2norm(x):
    xf = x.astype(jnp.float32)
    return xf * lax.rsqrt(jnp.sum(xf * xf, axis=-1, keepdims=True) + NORM_EPS)


def modulate(h, shift, scale):
    return h * (1 + scale) + shift


def axial_rope_tables(rows, rot_dim):
    row = jnp.repeat(jnp.arange(rows, dtype=jnp.float32), GRID_W)
    col = jnp.tile(jnp.arange(GRID_W, dtype=jnp.float32), rows)
    half = rot_dim // 2
    inv_freq = ROPE_THETA ** (-jnp.arange(0, half, 2, dtype=jnp.float32) / half)
    ang_r = row[:, None] * inv_freq[None, :]
    ang_c = col[:, None] * inv_freq[None, :]
    ang = jnp.concatenate([ang_r, ang_r, ang_c, ang_c], axis=-1)
    return jnp.cos(ang), jnp.sin(ang)


def rotate_half(x):
    x1, x2 = jnp.split(x, 2, axis=-1)
    return jnp.concatenate([-x2, x1], axis=-1)


def apply_axial_rope(x, cos, sin):
    half = x.shape[-1] // 2
    rot = jnp.concatenate([rotate_half(x[..., :half]), rotate_half(x[..., half:])], axis=-1)
    return x * cos[None, :, None, :].astype(x.dtype) + rot * sin[None, :, None, :].astype(x.dtype)


def centred_dwconv(x, w):
    pad = CONV_K // 2
    return lax.conv_general_dilated(x, w[:, None, :].astype(x.dtype), window_strides=(1,),
                                    padding=[(pad, pad)], dimension_numbers=('NWC', 'WIO', 'NWC'),
                                    feature_group_count=x.shape[-1])


def gated_delta_chunked(q, k, v, g, beta, state0):
    B, T, H, Dk = q.shape
    Dv = v.shape[-1]
    C = GDN_CHUNK
    N = T // C

    def to_chunks(a):
        a = a.reshape(B, N, C, H, *a.shape[3:])
        return jnp.moveaxis(a, (1, 3), (0, 2))

    qc, kc, vc = to_chunks(q), to_chunks(k), to_chunks(v)
    gc = jnp.cumsum(to_chunks(g), axis=-1)
    bc = to_chunks(beta)
    idx = jnp.arange(C)
    lower_incl = idx[:, None] >= idx[None, :]
    strict = idx[:, None] > idx[None, :]
    decay = jnp.exp(jnp.where(lower_incl, gc[..., :, None] - gc[..., None, :], -jnp.inf))
    kb = kc * bc[..., None]
    vb = vc * bc[..., None]
    L = jnp.where(strict, jnp.einsum('nbhid,nbhjd->nbhij', kb, kc) * decay, 0.0)
    eye = jnp.eye(C, dtype=jnp.float32)
    t_inv = lax.linalg.triangular_solve(eye + L, jnp.broadcast_to(eye, L.shape), left_side=True, lower=True)
    u = t_inv @ vb
    w = t_inv @ (kb * jnp.exp(gc)[..., None])
    attn_intra = jnp.where(lower_incl, jnp.einsum('nbhid,nbhjd->nbhij', qc, kc) * decay, 0.0)
    g_last = gc[..., -1]
    k_tail = kc * jnp.exp(g_last[..., None] - gc)[..., None]
    q_head = qc * jnp.exp(gc)[..., None]

    def step(S, inp):
        q_h, k_t, u_i, w_i, a_i, gl = inp
        v_new = u_i - w_i @ S
        o = q_h @ S + a_i @ v_new
        S = S * jnp.exp(gl)[..., None, None] + jnp.swapaxes(k_t, -1, -2) @ v_new
        return S, o

    s_final, o = lax.scan(step, state0, (q_head, k_tail, u, w, attn_intra, g_last))
    o = jnp.moveaxis(o, (0, 2), (1, 3)).reshape(B, T, H, Dv)
    return o, s_final


def window_gqa_latent(q, k, v, k_ctx, v_ctx, sink):
    B, T, Hq, D = q.shape
    Hk = k.shape[2]
    G = Hq // Hk
    W = SWA_BLOCK
    nb = T // W
    Tc = k_ctx.shape[1]
    scale = D ** -0.5
    qb = q.reshape(B, nb, W, Hk, G, D)

    def band(a):
        ap = jnp.pad(a, ((0, 0), (W, W), (0, 0), (0, 0))).reshape(B, nb + 2, W, Hk, D)
        return jnp.concatenate([ap[:, :-2], ap[:, 1:-1], ap[:, 2:]], axis=2)

    k_win, v_win = band(k), band(v)
    i_abs = jnp.arange(nb)[:, None] * W + jnp.arange(W)[None, :]
    j_abs = jnp.arange(nb)[:, None] * W - W + jnp.arange(3 * W)[None, :]
    valid = ((jnp.abs(i_abs[:, :, None] - j_abs[:, None, :]) <= SWA_WINDOW)
             & (j_abs >= 0)[:, None, :] & (j_abs < T)[:, None, :])
    s_win = jnp.einsum('bnqhgd,bnkhd->bnhgqk', qb, k_win).astype(jnp.float32) * scale
    s_win = jnp.where(valid[None, :, None, None], s_win, -jnp.inf)
    s_ctx = jnp.einsum('bnqhgd,bchd->bnhgqc', qb, k_ctx).astype(jnp.float32) * scale
    s_sink = jnp.broadcast_to(sink.astype(jnp.float32).reshape(1, 1, Hk, G, 1, 1), s_ctx.shape[:-1] + (1,))
    p = jax.nn.softmax(jnp.concatenate([s_sink, s_ctx, s_win], axis=-1), axis=-1).astype(v.dtype)
    o = (jnp.einsum('bnhgqc,bchd->bnqhgd', p[..., 1:1 + Tc], v_ctx)
         + jnp.einsum('bnhgqk,bnkhd->bnqhgd', p[..., 1 + Tc:], v_win))
    return o.reshape(B, T, Hq * D)


def gqa_sink_dense(q, k, v, sink):
    B, Tq, Hq, D = q.shape
    Hk = k.shape[2]
    G = Hq // Hk
    qg = q.reshape(B, Tq, Hk, G, D)
    s = jnp.einsum('bqhgd,bkhd->bhgqk', qg, k).astype(jnp.float32) * D ** -0.5
    s_sink = jnp.broadcast_to(sink.astype(jnp.float32).reshape(1, Hk, G, 1, 1), s.shape[:-1] + (1,))
    p = jax.nn.softmax(jnp.concatenate([s_sink, s], axis=-1), axis=-1)[..., 1:].astype(v.dtype)
    o = jnp.einsum('bhgqk,bkhd->bqhgd', p, v)
    return o.reshape(B, Tq, Hq * D)


def sweep_query_blocks(fn, *qs):
    B, T = qs[0].shape[:2]
    nb = T // Q_BLOCK
    blocks = tuple(jnp.moveaxis(a.reshape(B, nb, Q_BLOCK, *a.shape[2:]), 1, 0) for a in qs)
    out = lax.map(lambda xs: fn(*xs), blocks)
    return jnp.moveaxis(out, 0, 1).reshape(B, T, *out.shape[3:])


def mla_attend(q_nope, q_rope, k_nope, k_rope, v):
    scale = (MLA_NOPE + MLA_ROPE) ** -0.5
    s = (jnp.einsum('bqhd,bshd->bhqs', q_nope, k_nope)
         + jnp.einsum('bqhr,bsr->bhqs', q_rope, k_rope)).astype(jnp.float32) * scale
    p = jax.nn.softmax(s, axis=-1).astype(v.dtype)
    return jnp.einsum('bhqs,bshd->bqhd', p, v)


def diff_attend(q1, q2, k1, k2, v, lam):
    scale = DIFF_HEAD_DIM ** -0.5
    s1 = jnp.einsum('bqhd,bshd->bhqs', q1, k1).astype(jnp.float32) * scale
    s2 = jnp.einsum('bqhd,bshd->bhqs', q2, k2).astype(jnp.float32) * scale
    a = jax.nn.softmax(s1, axis=-1) - lam * jax.nn.softmax(s2, axis=-1)
    return jnp.einsum('bhqs,bshe->bqhe', a.astype(v.dtype), v)


def even_mixer(h_c, h_l, w_in, conv_w, a_log, dt_bias, gdn_norm, sink, w_out, cos, sin, need_ctx):
    B, Tc, _ = h_c.shape
    T = h_l.shape[1]
    n_all = Tc + T
    proj = jnp.concatenate([h_c, h_l], axis=1) @ w_in
    qkv, z, ga, gb, sq, sk, sv = split_cols(proj, EVEN_COLS)

    g = -jnp.exp(a_log.astype(jnp.float32)) * jax.nn.softplus(
        ga.astype(jnp.float32).reshape(B, n_all, 2, GDN_HEADS) + dt_bias.astype(jnp.float32))
    beta = jax.nn.sigmoid(gb.astype(jnp.float32).reshape(B, n_all, 2, GDN_HEADS))

    def qkv_heads(u):
        n = u.shape[1]
        u = jax.nn.silu(centred_dwconv(u, conv_w))
        q, k, v = split_cols(u, (GDN_HEADS * GDN_DK, GDN_HEADS * GDN_DK, GDN_HEADS * GDN_DV))
        q = l2norm(q.reshape(B, n, GDN_HEADS, GDN_DK)) * GDN_DK ** -0.5
        k = l2norm(k.reshape(B, n, GDN_HEADS, GDN_DK))
        v = v.reshape(B, n, GDN_HEADS, GDN_DV).astype(jnp.float32)
        return q, k, v

    qc, kc, vc = qkv_heads(qkv[:, :Tc])
    ql, kl, vl = qkv_heads(qkv[:, Tc:])
    g_c, g_l = g[:, :Tc], g[:, Tc:]
    b_c, b_l = beta[:, :Tc], beta[:, Tc:]
    s0 = jnp.zeros((B, GDN_HEADS, GDN_DK, GDN_DV), jnp.float32)
    rev = lambda t: jnp.flip(t, axis=1)
    oc_f, s_f = gated_delta_chunked(qc, kc, vc, g_c[:, :, 0], b_c[:, :, 0], s0)
    oc_b, s_b = gated_delta_chunked(rev(qc), rev(kc), rev(vc), rev(g_c[:, :, 1]), rev(b_c[:, :, 1]), s0)
    ol_f, _ = gated_delta_chunked(ql, kl, vl, g_l[:, :, 0], b_l[:, :, 0], s_f)
    ol_b, _ = gated_delta_chunked(rev(ql), rev(kl), rev(vl), rev(g_l[:, :, 1]), rev(b_l[:, :, 1]), s_b)

    def gdn_out(o, zz):
        n = o.shape[1]
        o = rmsnorm(o, gdn_norm).astype(zz.dtype).reshape(B, n, GDN_Z)
        return o * jax.nn.silu(zz)

    lat_gdn = gdn_out(ol_f + rev(ol_b), z[:, Tc:])

    sq_c = sq[:, :Tc].reshape(B, Tc, SWA_Q_HEADS, SWA_HEAD_DIM)
    sk_c = sk[:, :Tc].reshape(B, Tc, SWA_KV_HEADS, SWA_HEAD_DIM)
    sv_c = sv[:, :Tc].reshape(B, Tc, SWA_KV_HEADS, SWA_HEAD_DIM)
    sq_l = apply_axial_rope(sq[:, Tc:].reshape(B, T, SWA_Q_HEADS, SWA_HEAD_DIM), cos, sin)
    sk_l = apply_axial_rope(sk[:, Tc:].reshape(B, T, SWA_KV_HEADS, SWA_HEAD_DIM), cos, sin)
    sv_l = sv[:, Tc:].reshape(B, T, SWA_KV_HEADS, SWA_HEAD_DIM)
    lat_swa = window_gqa_latent(sq_l, sk_l, sv_l, sk_c, sv_c, sink)

    y_l = jnp.concatenate([lat_gdn, lat_swa], axis=-1) @ w_out
    y_c = None
    if need_ctx:
        ctx_gdn = gdn_out(oc_f + rev(oc_b), z[:, :Tc])
        ctx_swa = gqa_sink_dense(sq_c, sk_c, sv_c, sink)
        y_c = jnp.concatenate([ctx_gdn, ctx_swa], axis=-1) @ w_out
    return y_c, y_l


def odd_mixer(h_c, h_l, w_in, q_norm, kv_norm, w_uq, w_ukv, lam_p, lam_init, subln, w_out,
              cos_d, sin_d, cos_r, sin_r, need_ctx):
    B, Tc, _ = h_c.shape
    T = h_l.shape[1]
    n_all = Tc + T
    proj = jnp.concatenate([h_c, h_l], axis=1) @ w_in
    cq, ckv, kr, dq, dk, dv = split_cols(proj, ODD_COLS)

    q_m = (rmsnorm(cq, q_norm) @ w_uq).reshape(B, n_all, MLA_HEADS, MLA_NOPE + MLA_ROPE)
    kv_m = (rmsnorm(ckv, kv_norm) @ w_ukv).reshape(B, n_all, MLA_HEADS, MLA_NOPE + MLA_V)
    qn, qr = q_m[..., :MLA_NOPE], q_m[..., MLA_NOPE:]
    kn, vm = kv_m[..., :MLA_NOPE], kv_m[..., MLA_NOPE:]
    qr_l = apply_axial_rope(qr[:, Tc:], cos_r, sin_r)
    kr_l = apply_axial_rope(kr[:, Tc:, None, :], cos_r, sin_r)[:, :, 0]
    kr_all = jnp.concatenate([kr[:, :Tc], kr_l], axis=1)
    mla_l = sweep_query_blocks(lambda a, b: mla_attend(a, b, kn, kr_all, vm), qn[:, Tc:], qr_l)
    mla_l = mla_l.reshape(B, T, MLA_HEADS * MLA_V)

    dq = dq.reshape(B, n_all, 2 * DIFF_HEADS, DIFF_HEAD_DIM)
    dk = dk.reshape(B, n_all, 2 * DIFF_HEADS, DIFF_HEAD_DIM)
    dv = dv.reshape(B, n_all, DIFF_HEADS, 2 * DIFF_HEAD_DIM)
    dq_l = apply_axial_rope(dq[:, Tc:], cos_d, sin_d).reshape(B, T, DIFF_HEADS, 2, DIFF_HEAD_DIM)
    dk_l = apply_axial_rope(dk[:, Tc:], cos_d, sin_d)
    dk_all = jnp.concatenate([dk[:, :Tc], dk_l], axis=1).reshape(B, n_all, DIFF_HEADS, 2, DIFF_HEAD_DIM)
    k1, k2 = dk_all[..., 0, :], dk_all[..., 1, :]
    lp = lam_p.astype(jnp.float32)
    lam = jnp.exp(jnp.sum(lp[0] * lp[1])) - jnp.exp(jnp.sum(lp[2] * lp[3])) + lam_init

    def diff_post(o):
        n = o.shape[1]
        return (rmsnorm(o, subln) * (1.0 - lam_init)).reshape(B, n, DIFF_VW)

    diff_l = sweep_query_blocks(lambda a, b: diff_attend(a, b, k1, k2, dv, lam),
                                dq_l[..., 0, :], dq_l[..., 1, :])
    y_l = jnp.concatenate([mla_l, diff_post(diff_l)], axis=-1) @ w_out
    y_c = None
    if need_ctx:
        mla_c = mla_attend(qn[:, :Tc], qr[:, :Tc], kn[:, :Tc], kr[:, :Tc], vm[:, :Tc])
        dq_c = dq[:, :Tc].reshape(B, Tc, DIFF_HEADS, 2, DIFF_HEAD_DIM)
        diff_c = diff_attend(dq_c[..., 0, :], dq_c[..., 1, :], k1[:, :Tc], k2[:, :Tc], dv[:, :Tc], lam)
        y_c = jnp.concatenate([mla_c.reshape(B, Tc, MLA_HEADS * MLA_V), diff_post(diff_c)], axis=-1) @ w_out
    return y_c, y_l


def swiglu(h, w_gate, w_up, w_down):
    return (jax.nn.silu(h @ w_gate) * (h @ w_up)) @ w_down


def moe_swiglu(h, w_router, w_gate, w_up, w_down):
    logits = (h @ w_router).astype(jnp.float32)
    top_val, top_idx = lax.top_k(logits, TOP_K)
    top_w = jax.nn.softmax(top_val, axis=-1)
    gates = jnp.sum(jax.nn.one_hot(top_idx, N_EXPERTS, dtype=jnp.float32) * top_w[..., None], axis=-2)
    gates = gates.astype(h.dtype)
    out = jnp.zeros_like(h)
    for e in range(N_EXPERTS):
        out = out + gates[:, e:e + 1] * swiglu(h, w_gate[e], w_up[e], w_down[e])
    return out


def setup_inputs(seed: int = 0) -> dict:
    key = jax.random.key(seed)
    keys = list(jax.random.split(key, 40))
    D = D_MODEL

    def nrm(shape, scale):
        return jax.random.normal(keys.pop(), shape, jnp.float32) * scale

    def gain(shape):
        return 1.0 + nrm(shape, 0.02)

    inp = {}
    inp['x'] = nrm((BATCH, SEQ, D), 1.0)
    inp['c'] = nrm((BATCH, D), 1.0)
    inp['ctx'] = nrm((BATCH, CTX_LEN, D), 1.0)
    inp['c_ctx'] = nrm((D,), 1.0)
    inp['e_mod_w'] = nrm((N_EVEN, D, 6 * D), D ** -0.5)
    inp['e_mod_b'] = nrm((N_EVEN, 6 * D), 0.02)
    inp['e_norms'] = gain((N_EVEN, 4, D))
    inp['e_w_in'] = nrm((N_EVEN, D, EVEN_IN), D ** -0.5)
    inp['e_conv_w'] = nrm((N_EVEN, CONV_K, GDN_QKV), CONV_K ** -0.5)
    inp['e_a_log'] = jnp.log(jax.random.uniform(keys.pop(), (N_EVEN, 2, GDN_HEADS), jnp.float32, 1.0, 16.0))
    inp['e_dt_bias'] = 1.0 + nrm((N_EVEN, 2, GDN_HEADS), 0.1)
    inp['e_gdn_norm'] = gain((N_EVEN, GDN_DV))
    inp['e_sink'] = nrm((N_EVEN, SWA_Q_HEADS), 0.5)
    inp['e_w_out'] = nrm((N_EVEN, EVEN_MIX, D), EVEN_MIX ** -0.5)
    inp['e_ffn_gate'] = nrm((N_EVEN, D, D_FF), D ** -0.5)
    inp['e_ffn_up'] = nrm((N_EVEN, D, D_FF), D ** -0.5)
    inp['e_ffn_down'] = nrm((N_EVEN, D_FF, D), D_FF ** -0.5)
    inp['o_mod_w'] = nrm((N_ODD, D, 6 * D), D ** -0.5)
    inp['o_mod_b'] = nrm((N_ODD, 6 * D), 0.02)
    inp['o_norms'] = gain((N_ODD, 4, D))
    inp['o_w_in'] = nrm((N_ODD, D, ODD_IN), D ** -0.5)
    inp['o_q_norm'] = gain((N_ODD, MLA_Q_RANK))
    inp['o_kv_norm'] = gain((N_ODD, MLA_KV_RANK))
    inp['o_w_uq'] = nrm((N_ODD, MLA_Q_RANK, MLA_HEADS * (MLA_NOPE + MLA_ROPE)), MLA_Q_RANK ** -0.5)
    inp['o_w_ukv'] = nrm((N_ODD, MLA_KV_RANK, MLA_HEADS * (MLA_NOPE + MLA_V)), MLA_KV_RANK ** -0.5)
    inp['o_lambda'] = nrm((N_ODD, 4, DIFF_HEAD_DIM), 0.1)
    inp['o_subln'] = gain((N_ODD, 2 * DIFF_HEAD_DIM))
    inp['o_w_out'] = nrm((N_ODD, ODD_MIX, D), ODD_MIX ** -0.5)
    inp['o_router'] = nrm((N_ODD, D, N_EXPERTS), D ** -0.5)
    inp['o_exp_gate'] = nrm((N_ODD, N_EXPERTS, D, D_FF_EXPERT), D ** -0.5)
    inp['o_exp_up'] = nrm((N_ODD, N_EXPERTS, D, D_FF_EXPERT), D ** -0.5)
    inp['o_exp_down'] = nrm((N_ODD, N_EXPERTS, D_FF_EXPERT, D), D_FF_EXPERT ** -0.5)
    return inp


def reference(x, c, ctx, c_ctx,
              e_mod_w, e_mod_b, e_norms, e_w_in, e_conv_w, e_a_log, e_dt_bias, e_gdn_norm, e_sink, e_w_out,
              e_ffn_gate, e_ffn_up, e_ffn_down,
              o_mod_w, o_mod_b, o_norms, o_w_in, o_q_norm, o_kv_norm, o_w_uq, o_w_ukv, o_lambda, o_subln,
              o_w_out, o_router, o_exp_gate, o_exp_up, o_exp_down):
    B, T, D = x.shape
    Tc = ctx.shape[1]
    rows = T // GRID_W
    cos_s, sin_s = axial_rope_tables(rows, SWA_HEAD_DIM)
    cos_d, sin_d = axial_rope_tables(rows, DIFF_HEAD_DIM)
    cos_r, sin_r = axial_rope_tables(rows, MLA_ROPE)
    silu_c = jax.nn.silu(c)
    silu_cc = jax.nn.silu(c_ctx)
    h_ctx = ctx
    for i in range(DEPTH):
        last = i == DEPTH - 1
        j = i // 2
        even = i % 2 == 0
        mod_w, mod_b, norms = (e_mod_w[j], e_mod_b[j], e_norms[j]) if even else (o_mod_w[j], o_mod_b[j], o_norms[j])
        m_l = jnp.split((silu_c @ mod_w + mod_b)[:, None, :], 6, axis=-1)
        m_c = jnp.split((silu_cc @ mod_w + mod_b)[None, None, :], 6, axis=-1)

        a_c = modulate(rmsnorm(h_ctx, norms[0]), m_c[0], m_c[1])
        a_l = modulate(rmsnorm(x, norms[0]), m_l[0], m_l[1])
        if even:
            y_c, y_l = even_mixer(a_c, a_l, e_w_in[j], e_conv_w[j], e_a_log[j], e_dt_bias[j], e_gdn_norm[j],
                                  e_sink[j], e_w_out[j], cos_s, sin_s, not last)
        else:
            lam_init = 0.8 - 0.6 * math.exp(-0.3 * i)
            y_c, y_l = odd_mixer(a_c, a_l, o_w_in[j], o_q_norm[j], o_kv_norm[j], o_w_uq[j], o_w_ukv[j],
                                 o_lambda[j], lam_init, o_subln[j], o_w_out[j], cos_d, sin_d, cos_r, sin_r,
                                 not last)
        x = x + m_l[2] * rmsnorm(y_l, norms[1])
        if not last:
            h_ctx = h_ctx + m_c[2] * rmsnorm(y_c, norms[1])

        f_in = modulate(rmsnorm(x, norms[2]), m_l[3], m_l[4])
        if not last:
            f_in = jnp.concatenate([modulate(rmsnorm(h_ctx, norms[2]), m_c[3], m_c[4]), f_in], axis=1)
        if even:
            f_out = swiglu(f_in, e_ffn_gate[j], e_ffn_up[j], e_ffn_down[j])
        else:
            f_out = moe_swiglu(f_in.reshape(-1, D), o_router[j], o_exp_gate[j], o_exp_up[j],
                               o_exp_down[j]).reshape(f_in.shape)
        x = x + m_l[5] * rmsnorm(f_out[:, -T:], norms[3])
        if not last:
            h_ctx = h_ctx + m_c[5] * rmsnorm(f_out[:, :Tc], norms[3])
    return x
```

```cpp
#include <hip/hip_runtime.h>
#include <cstdio>
#include <cstdint>
#include <cmath>

#ifndef MK_N_LAUNCHES
#define MK_N_LAUNCHES 1
#endif
#define SOLVE_C_FMA 1
#define SOLVE_C_LOAD 1
#ifndef G1_LOCK
#define G1_LOCK 0
#endif
#ifndef MK_LAST_PHASE
#define MK_LAST_PHASE 99
#endif

constexpr int NB = 4, T = 4096, TC = 256, SROW = T + TC  , NR = NB * SROW  , D = 1024;
constexpr int EIN = 2848, EINP = 3072, OIN = 2208, OINP = 2304, DFF = 2816, DFX = 3584, NEXP = 8;
constexpr float EPS = 1e-6f;
constexpr int E_Q = 0, E_K = 512, E_V = 1024, E_Z = 1536, E_GA = 2048, E_GB = 2064, E_SQ = 2080, E_SK = 2592, E_SV = 2720;
constexpr int O_CQ = 0, O_CKV = 384, O_KR = 640, O_DQ = 672, O_DK = 1184, O_DV = 1696;

constexpr size_t MiB = 1u << 20;
constexpr size_t WS_CTL = 0, CTL_ZERO_BYTES = 1 * MiB;
constexpr size_t WS_MODV = 1 * MiB;
constexpr size_t WS_GB = 2 * MiB;
constexpr size_t WS_META = 5 * MiB;
constexpr size_t WS_HCTX = 8 * MiB;
constexpr size_t WS_WEIN = 12 * MiB, WS_WEOUT = 18 * MiB, WS_WEGU = 20 * MiB, WS_WEDN = 31 * MiB, WS_WOIN = 37 * MiB, WS_WUQ = 42 * MiB, WS_WUKV = 43 * MiB, WS_WOOUT = 44 * MiB;
constexpr size_t WS_BIG = 46 * MiB;
constexpr size_t WS_PROJ = 46 * MiB, WS_QKVN = 148 * MiB;
constexpr size_t WS_PROJ2 = 46 * MiB, WS_QM = 123 * MiB, WS_VMLA = 149 * MiB, WS_KMLA = 167 * MiB, WS_ODIFF = 316 * MiB;
constexpr size_t WS_WXGU = 46 * MiB, WS_WXDN = 158 * MiB;
constexpr size_t WS_CQN = 214 * MiB;
constexpr size_t WS_ABUF = 214 * MiB, WS_MIX = 248 * MiB, WS_YBUF = 282 * MiB;
constexpr size_t WS_OG = 436 * MiB;
constexpr size_t WS_GDNI = 282 * MiB;
constexpr size_t WS_HID = 46 * MiB;
constexpr size_t WS_ASORT = 214 * MiB;
constexpr size_t WS_FIN2 = 282 * MiB;
constexpr size_t WS_Y2 = 316 * MiB;
constexpr size_t WS_HIDX = 316 * MiB;
constexpr size_t WS_END = 470 * MiB;
static_assert(WS_QKVN + (size_t)NR * 1536 * 2 <= 214 * MiB && WS_PROJ + (size_t)NR * EINP * 2 <= WS_QKVN, "layer-0 big region");
static_assert(WS_PROJ2 + (size_t)NR * OINP * 2 <= WS_QM && WS_QM + (size_t)NR * 768 * 2 <= WS_VMLA && WS_VMLA + (size_t)NR * 512 * 2 <= WS_KMLA && WS_KMLA + (size_t)NR * 768 * 2 <= 214 * MiB, "layer-1 big region");
static_assert(WS_WXGU + (size_t)NEXP * 7168 * 1024 * 2 <= WS_WXDN && WS_WXDN + (size_t)NEXP * 1024 * 3584 * 2 <= 214 * MiB, "expert weights");
static_assert(WS_HIDX + (size_t)17408 * 3584 * 2 <= WS_END && WS_ASORT + (size_t)34816 * 1024 * 2 <= WS_FIN2 && WS_HID + (size_t)NR * DFF * 2 <= 214 * MiB, "moe map");
constexpr size_t META_TOPI = 0, META_TOPW = 128 * 1024, META_RANK = 256 * 1024, META_RSTD = 384 * 1024;
constexpr int CW_TMO = 0, CW_CODE = 1;
constexpr int CW_MOECNT = 64;
constexpr int CW_SWAQ = 2048;
constexpr int CW_CHK = 1024;
constexpr int CW_BAR = 4096;
constexpr int RING_OFF = 0, RING_BYTES = 141312;
constexpr int MISC_OFF = RING_BYTES;
constexpr int LDS_BYTES = 147456;
constexpr int NWAVES = 8;
namespace pg8 {
#define PG8_LAS __attribute__((address_space(3)))
typedef unsigned short bf16_t;
typedef short bf16x8 __attribute__((ext_vector_type(8)));
typedef float f32x4 __attribute__((ext_vector_type(4)));
typedef unsigned u32x4 __attribute__((ext_vector_type(4)));
constexpr int BM = 256, BK = 64, HALF = 128, HTB = HALF * BK * 2  , STAGE_BYTES = 8 * HTB, NXCD = 8, WGM = 8;

__host__ __device__ __forceinline__ int lds_byte(int r, int c) { const int st = (r >> 4) * 2 + (c >> 5), rr = r & 15, cc = c & 31, ob = rr * 64 + cc * 2; return st * 1024 + (ob ^ (((ob >> 9) & 1) << 5)); }
__host__ __device__ __forceinline__ void stage_rc(int b, int& R, int& C) { const int st = b / 1024, sb = b % 1024, swz = sb ^ (((sb >> 9) & 1) << 5); R = (st >> 1) * 16 + swz / 64; C = (st & 1) * 32 + (swz % 64) / 2; }
__host__ __device__ __forceinline__ int perm32(int rho) { const int n = rho >> 4, i = rho & 15; return 8 * (i >> 2) + 4 * n + (i & 3); }

struct Unit { int pm, pn; };
struct Gemm { const bf16_t* A; const bf16_t* Bt; int M, N, K, lda, ldb; };

struct StaticOrder {
    int nM, nN, nwg, G, c;
    __host__ __device__ void init(int M, int N, int G_, int c_) { nM = M / BM; nN = N / BM; nwg = nM * nN; G = G_; c = c_; }
    __host__ __device__ bool next(int i, Unit& u) const {
        const long L = (long)i * G + c; if (L >= nwg) return false;
        int wgid = (int)L; { const int q = nwg / NXCD, r = nwg % NXCD, xcd = wgid % NXCD, off = wgid / NXCD; wgid = (xcd < r ? xcd * (q + 1) : r * (q + 1) + (xcd - r) * q) + off; }
        const int nig = WGM * nN, gid = wgid / nig, fm = gid * WGM, gsz = (nM - fm) < WGM ? (nM - fm) : WGM;
        u.pm = fm + ((wgid % nig) % gsz); u.pn = (wgid % nig) / gsz; return true;
    }
    __device__ __forceinline__ void a_ready(const Unit&) const {}
    __device__ __forceinline__ void done(const Unit&) const {}
};

__device__ __forceinline__ unsigned cvt_pk_bf16(float lo, float hi) { unsigned r; asm volatile("v_cvt_pk_bf16_f32 %0, %1, %2" : "=v"(r) : "v"(lo), "v"(hi)); return r; }
typedef float f32x2 __attribute__((ext_vector_type(2)));
template <class Epi, class Sched, bool ALIGN_EPI = false, bool SP2 = false>
__device__ __forceinline__ void gemm_phase(PG8_LAS unsigned char* lds, const Gemm g, const Sched& S, const Epi& E) {
    const int tid = threadIdx.x, wid = __builtin_amdgcn_readfirstlane(tid >> 6), lane = tid & 63, wr = wid >> 2, wc = wid & 3, fr = lane & 15, fq = lane >> 4;
    const int K = g.K, nt = K / BK;
    unsigned voffA[2], voffB[2];
#pragma unroll
    for (int i = 0; i < 2; ++i) { int R, C; stage_rc(tid * 16 + i * 8192, R, C); const int Rb = Epi::PERM ? ((R & ~31) + perm32(R & 31)) : R;
        voffA[i] = (unsigned)(R * g.lda + C) * 2u; voffB[i] = (unsigned)(Rb * g.ldb + C) * 2u; }
    const size_t kstep = (size_t)(BK * 2);
    const size_t hstepA = (size_t)HALF * g.lda * 2, hstepB = (size_t)HALF * g.ldb * 2;
    const size_t tstepA = 2 * hstepA, tstepB = 2 * hstepB;
    const unsigned ldsw = (unsigned)wid * 1024u;
    const int aoff = lds_byte(wr * 64 + fr, fq * 8), boff = lds_byte(wc * 32 + fr, fq * 8);
#define PG8_SA(b, h) (((b) * 2 + (h)) * HTB)
#define PG8_SB(b, h) ((4 + (b) * 2 + (h)) * HTB)
#define PG8_STAGE(bufoff, gbase, voff) do { _Pragma("unroll") for (int _i = 0; _i < 2; ++_i) \
        __builtin_amdgcn_global_load_lds((const unsigned*)((const char*)(gbase) + (voff)[_i]), (PG8_LAS unsigned*)(lds + (bufoff) + ldsw + _i * 8192), 16, 0, 0); } while (0)
#define PG8_LDA(dst, b, h) do { _Pragma("unroll") for (int m = 0; m < 4; ++m) _Pragma("unroll") for (int k = 0; k < 2; ++k) dst[m][k] = *(const PG8_LAS bf16x8*)(lds + PG8_SA(b, h) + aoff + m * 2048 + k * 1024); } while (0)
#define PG8_LDB(dst, b, h) do { _Pragma("unroll") for (int n = 0; n < 2; ++n) _Pragma("unroll") for (int k = 0; k < 2; ++k) dst[n][k] = *(const PG8_LAS bf16x8*)(lds + PG8_SB(b, h) + boff + n * 2048 + k * 1024); } while (0)
#define PG8_MMA(ai, bj, At, Bt) do { __builtin_amdgcn_s_setprio(1); _Pragma("unroll") for (int m = 0; m < 4; ++m) _Pragma("unroll") for (int n = 0; n < 2; ++n) _Pragma("unroll") for (int k = 0; k < 2; ++k) \
        acc[ai][bj][m][n] = __builtin_amdgcn_mfma_f32_16x16x32_bf16(Bt[n][k], At[m][k], acc[ai][bj][m][n], 0, 0, 0); __builtin_amdgcn_s_setprio(0); } while (0)
#define PG8_WAIT_V(n) asm volatile("s_waitcnt vmcnt(" #n ")" ::: "memory")
#define PG8_WAIT_L(n) asm volatile("s_waitcnt lgkmcnt(" #n ")" ::: "memory")
#define PG8_BAR __builtin_amdgcn_s_barrier()
#define PG8_SCHED __builtin_amdgcn_sched_barrier(0)
    Unit cur, nxt; int ui = 0;
    if (!S.next(0, cur)) return;
    f32x4 acc[2][2][4][2];
#pragma unroll
    for (int a = 0; a < 2; ++a)
#pragma unroll
        for (int b = 0; b < 2; ++b)
#pragma unroll
            for (int m = 0; m < 4; ++m)
#pragma unroll
                for (int n = 0; n < 2; ++n) acc[a][b][m][n] = (f32x4){0.f, 0.f, 0.f, 0.f};
    bf16x8 At[4][2], B0[2][2], B1[2][2];
    const char* cA = (const char*)g.A + (size_t)cur.pm * tstepA; const char* cB = (const char*)g.Bt + (size_t)cur.pn * tstepB;
    S.a_ready(cur);
    if constexpr (SP2) {
        PG8_STAGE(PG8_SB(0, 0), cB, voffB); PG8_STAGE(PG8_SB(0, 1), cB + hstepB, voffB); PG8_STAGE(PG8_SA(0, 0), cA, voffA); PG8_STAGE(PG8_SA(0, 1), cA + hstepA, voffA);
        if (wr == 1) PG8_BAR;
        PG8_WAIT_V(2); PG8_BAR;
        PG8_STAGE(PG8_SB(1, 0), cB + kstep, voffB); PG8_STAGE(PG8_SA(1, 0), cA + kstep, voffA); PG8_STAGE(PG8_SB(1, 1), cB + hstepB + kstep, voffB);
        PG8_WAIT_V(6); PG8_BAR;
    } else {
        PG8_STAGE(PG8_SB(0, 0), cB, voffB); PG8_STAGE(PG8_SA(0, 0), cA, voffA); PG8_STAGE(PG8_SB(0, 1), cB + hstepB, voffB); PG8_STAGE(PG8_SA(0, 1), cA + hstepA, voffA);
        if (wr == 1) PG8_BAR;
        PG8_WAIT_V(4); PG8_BAR;
        PG8_STAGE(PG8_SB(1, 0), cB + kstep, voffB); PG8_STAGE(PG8_SA(1, 0), cA + kstep, voffA); PG8_STAGE(PG8_SB(1, 1), cB + hstepB + kstep, voffB);
        PG8_WAIT_V(6); PG8_BAR;
    }
    for (;;) {
        const bool has_next = S.next(ui + 1, nxt);
        const char* nA = has_next ? (const char*)g.A + (size_t)nxt.pm * tstepA : cA; const char* nB = has_next ? (const char*)g.Bt + (size_t)nxt.pn * tstepB : cB;
        _Pragma("unroll 1") for (int t = 0; t < nt; t += 2) {
            const bool last = (t == nt - 2);
            const char* a1 = cA + (size_t)(t + 1) * kstep;
            const char* a2 = last ? nA : cA + (size_t)(t + 2) * kstep; const char* b2 = last ? nB : cB + (size_t)(t + 2) * kstep;
            const char* a3 = a2 + kstep; const char* b3 = b2 + kstep;
            if (last && has_next) S.a_ready(nxt);
            if constexpr (SP2) {
            PG8_LDB(B0, 0, 0); PG8_LDB(B1, 0, 1); PG8_SCHED; PG8_LDA(At, 0, 0); PG8_STAGE(PG8_SA(1, 1), a1 + hstepA, voffA);
            PG8_WAIT_V(8); PG8_WAIT_L(0); PG8_BAR; PG8_MMA(0, 0, At, B0); PG8_MMA(0, 1, At, B1); PG8_BAR; PG8_SCHED;
            PG8_LDA(At, 0, 1); PG8_STAGE(PG8_SB(0, 0), b2, voffB); PG8_STAGE(PG8_SB(0, 1), b2 + hstepB, voffB); PG8_STAGE(PG8_SA(0, 0), a2, voffA);
            PG8_WAIT_V(8); PG8_WAIT_L(0); PG8_BAR; PG8_MMA(1, 0, At, B0); PG8_MMA(1, 1, At, B1); PG8_BAR; PG8_SCHED;
            PG8_LDB(B0, 1, 0); PG8_LDB(B1, 1, 1); PG8_SCHED; PG8_LDA(At, 1, 0); PG8_STAGE(PG8_SA(0, 1), a2 + hstepA, voffA);
            PG8_WAIT_V(8); PG8_WAIT_L(0); PG8_BAR; PG8_MMA(0, 0, At, B0); PG8_MMA(0, 1, At, B1); PG8_BAR; PG8_SCHED;
            PG8_LDA(At, 1, 1); PG8_STAGE(PG8_SB(1, 0), b3, voffB); PG8_STAGE(PG8_SB(1, 1), b3 + hstepB, voffB); PG8_STAGE(PG8_SA(1, 0), a3, voffA);
            PG8_WAIT_V(8); PG8_WAIT_L(0); PG8_BAR; PG8_MMA(1, 0, At, B0); PG8_MMA(1, 1, At, B1); PG8_BAR; PG8_SCHED;
            } else {
            PG8_LDB(B0, 0, 0); PG8_SCHED; PG8_LDA(At, 0, 0); PG8_STAGE(PG8_SA(1, 1), a1 + hstepA, voffA);
            PG8_WAIT_L(8); PG8_BAR; PG8_WAIT_L(0); PG8_MMA(0, 0, At, B0); PG8_BAR; PG8_SCHED;
            PG8_LDB(B1, 0, 1); PG8_STAGE(PG8_SB(0, 0), b2, voffB);
            PG8_BAR; PG8_WAIT_L(0); PG8_MMA(0, 1, At, B1); PG8_BAR;
            PG8_LDA(At, 0, 1); PG8_STAGE(PG8_SA(0, 0), a2, voffA);
            PG8_BAR; PG8_WAIT_L(0); PG8_MMA(1, 0, At, B0); PG8_BAR; PG8_SCHED;
            PG8_STAGE(PG8_SB(0, 1), b2 + hstepB, voffB);
            PG8_WAIT_V(6); PG8_BAR; PG8_MMA(1, 1, At, B1); PG8_BAR;
            PG8_LDB(B0, 1, 0); PG8_SCHED; PG8_LDA(At, 1, 0); PG8_STAGE(PG8_SA(0, 1), a2 + hstepA, voffA);
            PG8_WAIT_L(8); PG8_BAR; PG8_WAIT_L(0); PG8_MMA(0, 0, At, B0); PG8_BAR; PG8_SCHED;
            PG8_LDB(B1, 1, 1); PG8_STAGE(PG8_SB(1, 0), b3, voffB);
            PG8_BAR; PG8_WAIT_L(0); PG8_MMA(0, 1, At, B1); PG8_BAR;
            PG8_LDA(At, 1, 1); PG8_STAGE(PG8_SA(1, 0), a3, voffA);
            PG8_BAR; PG8_WAIT_L(0); PG8_MMA(1, 0, At, B0); PG8_BAR; PG8_SCHED;
            PG8_STAGE(PG8_SB(1, 1), b3 + hstepB, voffB);
            PG8_WAIT_V(6); PG8_BAR; PG8_MMA(1, 1, At, B1); PG8_BAR;
            }
        }
        if constexpr (ALIGN_EPI) { if (wr == 0) PG8_BAR; }
        if constexpr (!Epi::AFTER_DRAIN) { E(acc, cur, wr, wc, fr, fq); S.done(cur); }
        if (!has_next) break;
#pragma unroll
        for (int a = 0; a < 2; ++a)
#pragma unroll
            for (int b = 0; b < 2; ++b)
#pragma unroll
                for (int m = 0; m < 4; ++m)
#pragma unroll
                    for (int n = 0; n < 2; ++n) acc[a][b][m][n] = (f32x4){0.f, 0.f, 0.f, 0.f};
        cur = nxt; cA = nA; cB = nB; ++ui;
        if constexpr (ALIGN_EPI) { if (wr == 1) PG8_BAR; }
    }
    PG8_WAIT_V(0);
    if constexpr (!ALIGN_EPI) { if (wr == 0) PG8_BAR; }
    PG8_BAR;
    if constexpr (Epi::AFTER_DRAIN) { E.fused(acc, cur, wr, wc, fr, fq, lds, wid, lane); S.done(cur); }
#undef PG8_SA
#undef PG8_SB
#undef PG8_STAGE
#undef PG8_LDA
#undef PG8_LDB
#undef PG8_MMA
#undef PG8_WAIT_V
#undef PG8_WAIT_L
#undef PG8_BAR
#undef PG8_SCHED
}
}
namespace pg8 {
struct EpiStore { static constexpr bool PERM = true, AFTER_DRAIN = false;
    bf16_t* O; int ldc; int nN;
    __device__ __forceinline__ void operator()(const f32x4 (&acc)[2][2][4][2], const Unit& u, int wr, int wc, int fr, int fq) const {
        const int row0 = u.pm * BM + wr * 64 + fr, col0 = (u.pn % nN) * BM + wc * 32 + 8 * fq;
#pragma unroll
        for (int ai = 0; ai < 2; ++ai)
#pragma unroll
            for (int m = 0; m < 4; ++m) { const int row = row0 + ai * HALF + m * 16;
                bf16_t* rowp = O + (size_t)row * ldc + col0;
#pragma unroll
                for (int bj = 0; bj < 2; ++bj) { const f32x4 v0 = acc[ai][bj][m][0], v1 = acc[ai][bj][m][1];
                    u32x4 w; w.x = cvt_pk_bf16(v0[0], v0[1]); w.y = cvt_pk_bf16(v0[2], v0[3]); w.z = cvt_pk_bf16(v1[0], v1[1]); w.w = cvt_pk_bf16(v1[2], v1[3]);
                    *(u32x4*)(rowp + bj * HALF) = w; } }
    }
};
struct EpiSwiGLU { static constexpr bool PERM = true, AFTER_DRAIN = false;
    bf16_t* O; int ldc; int nN;
    __device__ __forceinline__ void operator()(const f32x4 (&acc)[2][2][4][2], const Unit& u, int wr, int wc, int fr, int fq) const {
        const int row0 = u.pm * BM + wr * 64 + fr, col0 = (u.pn % nN) * HALF + wc * 32 + 8 * fq;
#pragma unroll
        for (int ai = 0; ai < 2; ++ai)
#pragma unroll
            for (int m = 0; m < 4; ++m) { bf16_t* rowp = O + (size_t)(row0 + ai * HALF + m * 16) * ldc + col0;
                float h[8];
#pragma unroll
                for (int n = 0; n < 2; ++n)
#pragma unroll
                    for (int j = 0; j < 4; ++j) { const float g = acc[ai][0][m][n][j], up = acc[ai][1][m][n][j]; h[n * 4 + j] = g * __builtin_amdgcn_rcpf(1.f + __expf(-g)) * up; }
                u32x4 w; w.x = cvt_pk_bf16(h[0], h[1]); w.y = cvt_pk_bf16(h[2], h[3]); w.z = cvt_pk_bf16(h[4], h[5]); w.w = cvt_pk_bf16(h[6], h[7]);
                *(u32x4*)rowp = w; }
    }
};
struct EpiKV { static constexpr bool PERM = true, AFTER_DRAIN = false;
    bf16_t* KM; bf16_t* VM;
    __device__ __forceinline__ void operator()(const f32x4 (&acc)[2][2][4][2], const Unit& u, int wr, int wc, int fr, int fq) const {
        const int row0 = u.pm * BM + wr * 64 + fr, within = wc * 32 + 8 * fq;
#pragma unroll
        for (int ai = 0; ai < 2; ++ai)
#pragma unroll
            for (int m = 0; m < 4; ++m) { const int row = row0 + ai * HALF + m * 16;
#pragma unroll
                for (int bj = 0; bj < 2; ++bj) { const int h = 2 * u.pn + bj; const f32x4 v0 = acc[ai][bj][m][0], v1 = acc[ai][bj][m][1];
                    u32x4 w; w.x = cvt_pk_bf16(v0[0], v0[1]); w.y = cvt_pk_bf16(v0[2], v0[3]); w.z = cvt_pk_bf16(v1[0], v1[1]); w.w = cvt_pk_bf16(v1[2], v1[3]);
                    bf16_t* p = (within < 64) ? KM + (size_t)row * 768 + h * 96 + within : VM + (size_t)row * 512 + h * 64 + (within - 64);
                    *(u32x4*)p = w; } }
    }
};
struct LatOrder { StaticOrder so;
    __device__ void init(int N, int G, int c) { so.nM = 64; so.nN = N / BM; so.nwg = 64 * so.nN; so.G = G; so.c = c; }
    __device__ bool next(int i, Unit& u) const { if (!so.next(i, u)) return false; u.pm = (u.pm >> 4) * 17 + 1 + (u.pm & 15); return true; }
    __device__ __forceinline__ void a_ready(const Unit&) const {}
    __device__ __forceinline__ void done(const Unit&) const {}
};
struct MoeOrder { StaticOrder so; const int* texp; int t0, nNe;
    __device__ void init(int ntiles, int nNe_, int G, int c, const int* texp_, int t0_) { so.nM = ntiles; so.nN = nNe_; so.nwg = ntiles * nNe_; so.G = G; so.c = c; texp = texp_; t0 = t0_; nNe = nNe_; }
    __device__ bool next(int i, Unit& u) const { if (!so.next(i, u)) return false; const int e = __builtin_amdgcn_readfirstlane(texp[t0 + u.pm]); u.pn = e * nNe + u.pn; return true; }
    __device__ __forceinline__ void a_ready(const Unit&) const {}
    __device__ __forceinline__ void done(const Unit&) const {}
};
}
#define PG8_SP2 true
#define PG8_ALIGN true
#define GAS __attribute__((address_space(1)))
#define LAS __attribute__((address_space(3)))
typedef unsigned short bf16;
typedef unsigned v4u __attribute__((ext_vector_type(4)));
typedef unsigned v2u __attribute__((ext_vector_type(2)));
typedef float f32x4 __attribute__((ext_vector_type(4)));
typedef short bf16x8 __attribute__((ext_vector_type(8)));
typedef GAS unsigned gu32;
#define RLX_AGENT __ATOMIC_RELAXED, __HIP_MEMORY_SCOPE_AGENT
#define LDS_WAIT() asm volatile("s_waitcnt lgkmcnt(0)" ::: "memory")
#define VM_WAIT() asm volatile("s_waitcnt vmcnt(0)" ::: "memory")
__device__ __forceinline__ unsigned f2bf(float f) { unsigned u = __builtin_bit_cast(unsigned, f); return (u + 0x7fffu + ((u >> 16) & 1u)) >> 16; }
__device__ __forceinline__ unsigned pk2(float lo, float hi) { return f2bf(lo) | (f2bf(hi) << 16); }
__device__ __forceinline__ float bf2f(unsigned short b) { return __builtin_bit_cast(float, ((unsigned)b) << 16); }
__device__ __forceinline__ float bflo(unsigned w) { return __builtin_bit_cast(float, w << 16); }
__device__ __forceinline__ float bfhi(unsigned w) { return __builtin_bit_cast(float, w & 0xffff0000u); }
__device__ __forceinline__ float wave_sum(float v) {
#pragma unroll
    for (int o = 1; o < 64; o <<= 1) v += __shfl_xor(v, o);
    return v;
}
__device__ __forceinline__ float siluf(float x) { return x / (1.f + __expf(-x)); }
#define XB_TMO      128
#define XB_XCNT(j)  (256  + 64 * (j))
#define XB_XSUB(j)  (1280 + 64 * (j))
#define XB_XGEN(j)  (2304 + 64 * (j))
#define XB_TOP      3328
#define XB_TOPGEN   3392
#define XCD_BAR_WORDS 3456
#define XB_SPIN_CAP (1u << 18)

__device__ __forceinline__ unsigned xb_ld(unsigned* p)              { return __hip_atomic_load(p, __ATOMIC_RELAXED, __HIP_MEMORY_SCOPE_AGENT); }
__device__ __forceinline__ unsigned xb_add(unsigned* p, unsigned v) { return __hip_atomic_fetch_add(p, v, __ATOMIC_RELAXED, __HIP_MEMORY_SCOPE_AGENT); }
__device__ __forceinline__ unsigned xb_xcc_id() { return (unsigned)__builtin_amdgcn_s_getreg((3 << 11) | 20) & 0xFu; }
#define XB_SPIN(cond, bar) do { unsigned _sp = 0; while (cond) { __builtin_amdgcn_s_sleep(1); \
    if ((++_sp & 255u) == 0u) { if (xb_ld(&(bar)[XB_TMO])) break; if (_sp > XB_SPIN_CAP) { atomicAdd(&(bar)[XB_TMO], 1u); break; } } } } while (0)

struct XcdBarrier {
    unsigned* bar; unsigned x;
    volatile LAS unsigned* st;
};

__device__ __forceinline__ XcdBarrier xcd_barrier_post(unsigned* bar, volatile LAS unsigned* st) {
    XcdBarrier b; b.bar = bar; b.x = xb_xcc_id(); b.st = st;
    if (threadIdx.x == 0) (void)xb_add(&bar[XB_XCNT(b.x)], 1u);
    return b;
}
__device__ __forceinline__ void xcd_barrier_complete(unsigned* bar, unsigned x, unsigned& nloc, unsigned& nx) {
    const unsigned G = gridDim.x * gridDim.y * gridDim.z;
    unsigned sum, cnt, mine, sp = 0u;
    for (;;) {
        sum = 0u; cnt = 0u; mine = 0u;
#pragma unroll
        for (unsigned j = 0; j < 16; ++j) { const unsigned c = xb_ld(&bar[XB_XCNT(j)]); sum += c; cnt += (c > 0u) ? 1u : 0u; mine = (j == x) ? c : mine; }
        if (sum == G) break;
        __builtin_amdgcn_s_sleep(1);
        if ((++sp & 255u) == 0u) { if (xb_ld(&bar[XB_TMO])) break; if (sp > XB_SPIN_CAP) { atomicAdd(&bar[XB_TMO], 1u); break; } }
    }
    nloc = mine > 0u ? mine : 1u; nx = cnt > 0u ? cnt : 1u;
}

__device__ __forceinline__ void xcd_barrier(const XcdBarrier& b) {
    asm volatile("s_waitcnt vmcnt(0)" ::: "memory");
    __syncthreads();
    if (threadIdx.x == 0) {
        unsigned* bar = b.bar;
        __builtin_amdgcn_s_waitcnt(0);
        unsigned nloc = b.st[0], nx = b.st[1];
        if (nloc == 0u) { xcd_barrier_complete(bar, b.x, nloc, nx); b.st[0] = nloc; b.st[1] = nx; }
        const unsigned old = xb_add(&bar[XB_XSUB(b.x)], 1u);
        const unsigned gen = old / nloc;
        if (old + 1u == (gen + 1u) * nloc) {
            __builtin_amdgcn_fence(__ATOMIC_RELEASE, "agent");
            asm volatile("s_waitcnt vmcnt(0)" ::: "memory");
            const unsigned og = xb_add(&bar[XB_TOP], 1u);
            const unsigned tg = og / nx;
            if (og + 1u == (tg + 1u) * nx) xb_add(&bar[XB_TOPGEN], 1u);
            else XB_SPIN(xb_ld(&bar[XB_TOPGEN]) == tg, bar);
            __builtin_amdgcn_fence(__ATOMIC_ACQUIRE, "agent");
            xb_add(&bar[XB_XGEN(b.x)], 1u);
            asm volatile("s_waitcnt vmcnt(0)" ::: "memory");
        } else {
            XB_SPIN(xb_ld(&bar[XB_XGEN(b.x)]) == gen, bar);
            __builtin_amdgcn_fence(__ATOMIC_ACQUIRE, "agent");
            asm volatile("s_waitcnt vmcnt(0)" ::: "memory");
        }
    }
    __syncthreads();
}
namespace att {
using bf16x8 = __attribute__((ext_vector_type(8))) short;
using s16x4  = __attribute__((ext_vector_type(4))) short;
using f32x16 = __attribute__((ext_vector_type(16))) float;
using u32x4  = __attribute__((ext_vector_type(4))) unsigned;
constexpr int NW = 8, QBLK = 32, KVBLK = 64;
constexpr size_t SHM_V = KVBLK * 128 * 2, SHM_K = KVBLK * 128 * 2, SHM_ATTN = 2 * SHM_V + 2 * SHM_K + NW * 64 * 4;
constexpr float THR = 8.f;
#define KSWZ(row, colB) ((row) * 256 + ((colB) ^ (((row) & 7) << 4)))
#define SBAR() __builtin_amdgcn_sched_barrier(0)
__device__ __forceinline__ int crow(int r, int hi) { return (r & 3) + 8 * (r >> 2) + 4 * hi; }
__device__ __forceinline__ unsigned cvtpk(float lo, float hi) { unsigned r; asm volatile("v_cvt_pk_bf16_f32 %0, %1, %2" : "=v"(r) : "v"(lo), "v"(hi)); return r; }
__device__ __forceinline__ void partialSM(f32x16& p0, f32x16& p1, float& m_reg, float& mn, float& alpha, float C, float thr_s) {
  float pmax = p0[0];
#pragma unroll
  for (int r = 1; r < 16; ++r) pmax = fmaxf(pmax, p0[r]);
#pragma unroll
  for (int r = 0; r < 16; ++r) pmax = fmaxf(pmax, p1[r]);
  { auto rr = __builtin_amdgcn_permlane32_swap(__float_as_uint(pmax), __float_as_uint(pmax), false, false);
    pmax = fmaxf(__uint_as_float(rr[0]), __uint_as_float(rr[1])); }
  if (__builtin_expect(__all(pmax - m_reg <= thr_s), 1)) { mn = m_reg; alpha = 1.f; }
  else { mn = fmaxf(m_reg, pmax); alpha = __builtin_amdgcn_exp2f((m_reg - mn) * C); m_reg = mn; }
  const float mnC = -mn * C;
#pragma unroll
  for (int r = 0; r < 16; ++r) p0[r] = fmaf(p0[r], C, mnC);
#pragma unroll
  for (int r = 0; r < 16; ++r) p1[r] = fmaf(p1[r], C, mnC);
#pragma unroll
  for (int r = 0; r < 16; ++r) p0[r] = __builtin_amdgcn_exp2f(p0[r]);
}
__device__ __forceinline__ void finishSM(f32x16& p0, f32x16& p1, float alpha, float& l_reg, bf16x8& pa0, bf16x8& pa1, bf16x8& pa2, bf16x8& pa3) {
#pragma unroll
  for (int r = 0; r < 16; ++r) p1[r] = __builtin_amdgcn_exp2f(p1[r]);
  float ps = 0;
#pragma unroll
  for (int r = 0; r < 16; ++r) ps += p0[r];
#pragma unroll
  for (int r = 0; r < 16; ++r) ps += p1[r];
  { auto rr = __builtin_amdgcn_permlane32_swap(__float_as_uint(ps), __float_as_uint(ps), false, false);
    ps = __uint_as_float(rr[0]) + __uint_as_float(rr[1]); }
  l_reg = l_reg * alpha + ps;
#define PK4(P, BASE, OUT) do { unsigned a0 = cvtpk(P[BASE + 0], P[BASE + 1]), a1 = cvtpk(P[BASE + 2], P[BASE + 3]);   \
    unsigned b0 = cvtpk(P[BASE + 4], P[BASE + 5]), b1 = cvtpk(P[BASE + 6], P[BASE + 7]);                              \
    auto r0 = __builtin_amdgcn_permlane32_swap(a0, b0, false, false); auto r1 = __builtin_amdgcn_permlane32_swap(a1, b1, false, false); \
    u32x4 w = {r0[0], r1[0], r0[1], r1[1]}; OUT = *reinterpret_cast<bf16x8*>(&w); } while (0)
  PK4(p0, 0, pa0); PK4(p0, 8, pa1); PK4(p1, 0, pa2); PK4(p1, 8, pa3);
#undef PK4
}
template <int DQK> __device__ __forceinline__ void qkt(f32x16& p0, f32x16& p1, const char* Ks, const bf16x8* qr, int r32, int hi) {
  p0 = f32x16{}; p1 = f32x16{};
#pragma unroll
  for (int d0 = 0; d0 < DQK / 16; ++d0) { const int cb = (d0 * 16 + hi * 8) * 2;
    const bf16x8 b0 = *reinterpret_cast<const bf16x8*>(Ks + KSWZ(r32, cb));
    const bf16x8 b1 = *reinterpret_cast<const bf16x8*>(Ks + KSWZ(32 + r32, cb));
    p0 = __builtin_amdgcn_mfma_f32_32x32x16_bf16(b0, qr[d0], p0, 0, 0, 0);
    p1 = __builtin_amdgcn_mfma_f32_32x32x16_bf16(b1, qr[d0], p1, 0, 0, 0); }
}
__device__ __forceinline__ int v_st(int k, int c) { const int kk = (k & ~0xC) | ((k & 4) << 1) | ((k & 8) >> 1); return ((kk >> 3) * 4 + (c >> 5)) * 512 + ((kk & 7) * 32 + (c & 31)) * 2; }
__device__ __forceinline__ int v_rd_base(int lane) { return ((lane & 3) << 3) | (((lane >> 2) & 3) << 6) | (((lane >> 4) & 1) << 5) | (((lane >> 5) & 1) << 8); }
constexpr int v_rd_off(int d0, int ks, int half) { return d0 * 512 + ks * 4096 + half * 2048; }
template <int OFF> __device__ __forceinline__ s16x4 tr_read(int vb) {
  s16x4 r; asm volatile("ds_read_b64_tr_b16 %0, %1 offset:%2" : "=&v"(r) : "v"(vb), "i"(OFF) : "memory"); return r;
}
template <int D0> __device__ __forceinline__ void pv_one(f32x16& od, int vb, bf16x8 pa0, bf16x8 pa1, bf16x8 pa2, bf16x8 pa3) {
  const s16x4 l0 = tr_read<v_rd_off(D0, 0, 0)>(vb), h0 = tr_read<v_rd_off(D0, 0, 1)>(vb), l1 = tr_read<v_rd_off(D0, 1, 0)>(vb), h1 = tr_read<v_rd_off(D0, 1, 1)>(vb);
  const s16x4 l2 = tr_read<v_rd_off(D0, 2, 0)>(vb), h2 = tr_read<v_rd_off(D0, 2, 1)>(vb), l3 = tr_read<v_rd_off(D0, 3, 0)>(vb), h3 = tr_read<v_rd_off(D0, 3, 1)>(vb);
  asm volatile("s_waitcnt lgkmcnt(0)" ::: "memory"); SBAR();
#define PK(L, H) (bf16x8){L[0], L[1], L[2], L[3], H[0], H[1], H[2], H[3]}
  od = __builtin_amdgcn_mfma_f32_32x32x16_bf16(pa0, PK(l0, h0), od, 0, 0, 0);
  od = __builtin_amdgcn_mfma_f32_32x32x16_bf16(pa1, PK(l1, h1), od, 0, 0, 0);
  od = __builtin_amdgcn_mfma_f32_32x32x16_bf16(pa2, PK(l2, h2), od, 0, 0, 0);
  od = __builtin_amdgcn_mfma_f32_32x32x16_bf16(pa3, PK(l3, h3), od, 0, 0, 0);
#undef PK
}
template <int DV> __device__ __forceinline__ void pv_all(f32x16* o, int vb, bf16x8 pa0, bf16x8 pa1, bf16x8 pa2, bf16x8 pa3) {
  pv_one<0>(o[0], vb, pa0, pa1, pa2, pa3); pv_one<1>(o[1], vb, pa0, pa1, pa2, pa3);
  if constexpr (DV > 64) { pv_one<2>(o[2], vb, pa0, pa1, pa2, pa3); pv_one<3>(o[3], vb, pa0, pa1, pa2, pa3); }
}
template <int DQK, int DV, int MODE, bool QROPE = false, int OUTMODE = 0>
__device__ __forceinline__ void attn_unit(const unsigned short* __restrict__ Qb, int ldq, const unsigned short* __restrict__ Kb, int ldk, const unsigned short* __restrict__ Vb, int ldv,
                                          unsigned short* __restrict__ Ob, int ldo, int NT, int lat0, int q0lat, float C, float thr_s, float sinkl2, char* lds, float lam = 0.f, const float* nw = nullptr, float nscale = 1.f) {
  int tid_ = threadIdx.x; asm volatile("" : "+v"(tid_));
  const int tid = tid_, wid = tid >> 6, lane = tid & 63, r32 = lane & 31, hi = lane >> 5;
  char* V_lds = lds; char* K_lds = lds + 2 * SHM_V;
  float* ws = (float*)(lds + 2 * SHM_V + 2 * SHM_K) + wid * 64; float* li_l = ws; float* al_l = ws + 32;
  float m_reg = -1e30f, l_reg = 0; f32x16 o[DV / 32]; bf16x8 qr[DQK / 16];
#pragma unroll
  for (int d = 0; d < DV / 32; ++d) o[d] = f32x16{};
  const unsigned short* Qw = Qb + (long)(wid * QBLK + r32) * ldq + hi * 8;
#pragma unroll
  for (int d0 = 0; d0 < DQK / 16; ++d0) qr[d0] = *reinterpret_cast<const bf16x8*>(Qw + d0 * 16);
  if constexpr (QROPE) {
    static_assert(DQK == 96, "QROPE is the MLA case");
    int t = q0lat + wid * QBLK + r32; asm volatile("" : "+v"(t));
#pragma unroll
    for (int part = 0; part < 2; ++part) { const float pos = (float)(part ? (t & 63) : (t >> 6)); u32x4 w = __builtin_bit_cast(u32x4, qr[4 + part]); u32x4 o;
#pragma unroll
      for (int q = 0; q < 4; ++q) { const unsigned pw = (unsigned)__shfl_xor((int)w[q], 32); float x0 = bflo(w[q]), x1 = bfhi(w[q]); const float p0 = bflo(pw), p1 = bfhi(pw);
        float s0, c0, s1, c1; sincosf(pos * __powf(10000.f, -(float)(2 * q) * 0.125f), &s0, &c0); sincosf(pos * __powf(10000.f, -(float)(2 * q + 1) * 0.125f), &s1, &c1);
        x0 = hi ? (x0 * c0 + p0 * s0) : (x0 * c0 - p0 * s0); x1 = hi ? (x1 * c1 + p1 * s1) : (x1 * c1 - p1 * s1); o[q] = cvtpk(x0, x1); }
      qr[4 + part] = __builtin_bit_cast(bf16x8, o); } }
  const int sr = tid >> 4, sc = (tid & 15) * 8, vst0 = v_st(sr, sc), vst1 = v_st(32 + sr, sc);
  const bool kact = sc < DQK, vact = sc < DV;
  const int vb0 = (int)(uintptr_t)V_lds + v_rd_base(lane);
  struct { bf16x8 vs0, vs1, ks0, ks1; } sr_[2];
#define TROW(j) ((MODE == 1 && (j) >= 4) ? (256 + lat0 + ((j) - 4) * 64) : (j) * 64)
#define SLOAD(i, j) do { const long k0_ = TROW(j); \
    if (vact) { sr_[i].vs0 = *reinterpret_cast<const bf16x8*>(&Vb[(k0_ + sr) * ldv + sc]); sr_[i].vs1 = *reinterpret_cast<const bf16x8*>(&Vb[(k0_ + 32 + sr) * ldv + sc]); } \
    if (kact) { sr_[i].ks0 = *reinterpret_cast<const bf16x8*>(&Kb[(k0_ + sr) * ldk + sc]); sr_[i].ks1 = *reinterpret_cast<const bf16x8*>(&Kb[(k0_ + 32 + sr) * ldk + sc]); } } while (0)
#define SWRITE(b, i) do { if (vact) { *(bf16x8*)(V_lds + (b) * SHM_V + vst0) = sr_[i].vs0; *(bf16x8*)(V_lds + (b) * SHM_V + vst1) = sr_[i].vs1; } \
    if (kact) { const int kc = sc * 2; *(bf16x8*)(K_lds + (b) * SHM_K + KSWZ(sr, kc)) = sr_[i].ks0; *(bf16x8*)(K_lds + (b) * SHM_K + KSWZ(32 + sr, kc)) = sr_[i].ks1; } } while (0)
#define RESC(a) do { if (__any((a) < 1.f)) { if (hi == 0) al_l[r32] = (a); asm volatile("s_waitcnt lgkmcnt(0)" ::: "memory"); \
    _Pragma("unroll") for (int d = 0; d < DV / 32; ++d) _Pragma("unroll") for (int r = 0; r < 16; ++r) o[d][r] *= al_l[crow(r, hi)]; } } while (0)
#define MASK(P0, P1, j) do { if (MODE == 1 && (j) >= 4) { const int kb_ = lat0 + ((j) - 4) * 64 + 4 * hi - (q0lat + wid * QBLK + r32); \
    _Pragma("unroll") for (int r = 0; r < 16; ++r) { const int dk_ = kb_ + (r & 3) + 8 * (r >> 2); if (dk_ > 128 || dk_ < -128) P0[r] = -1e30f; if (dk_ + 32 > 128 || dk_ + 32 < -128) P1[r] = -1e30f; } } } while (0)
  f32x16 pA0, pA1, pB0, pB1; float mnA, mnB, alA, alB; bf16x8 pa0, pa1, pa2, pa3;
  SLOAD(0, 0); asm volatile("s_waitcnt vmcnt(0)" ::: "memory"); SWRITE(0, 0); __syncthreads();
  qkt<DQK>(pA0, pA1, K_lds, qr, r32, hi); MASK(pA0, pA1, 0); partialSM(pA0, pA1, m_reg, mnA, alA, C, thr_s);
  SLOAD(1, 1); if (2 < NT) SLOAD(0, 2);
  asm volatile("s_waitcnt vmcnt(4)" ::: "memory"); SWRITE(1, 1); __syncthreads();
  for (int j = 1; j + 1 < NT; j += 2) {
    SBAR(); qkt<DQK>(pB0, pB1, K_lds + SHM_K, qr, r32, hi); MASK(pB0, pB1, j);
    finishSM(pA0, pA1, alA, l_reg, pa0, pa1, pa2, pa3); SBAR();
    SLOAD(1, j + 2); SBAR();
    pv_all<DV>(o, vb0, pa0, pa1, pa2, pa3); partialSM(pB0, pB1, m_reg, mnB, alB, C, thr_s);
    __syncthreads(); asm volatile("s_waitcnt vmcnt(4)" ::: "memory"); SWRITE(0, 0);
    RESC(alB); __syncthreads();
    SBAR(); qkt<DQK>(pA0, pA1, K_lds, qr, r32, hi); MASK(pA0, pA1, j + 1);
    finishSM(pB0, pB1, alB, l_reg, pa0, pa1, pa2, pa3); SBAR();
    if (j + 3 < NT) SLOAD(0, j + 3); SBAR();
    pv_all<DV>(o, vb0 + (int)SHM_V, pa0, pa1, pa2, pa3); partialSM(pA0, pA1, m_reg, mnA, alA, C, thr_s);
    __syncthreads(); asm volatile("s_waitcnt vmcnt(4)" ::: "memory"); SWRITE(1, 1);
    RESC(alA); __syncthreads();
  }
  SBAR(); qkt<DQK>(pB0, pB1, K_lds + SHM_K, qr, r32, hi); MASK(pB0, pB1, NT - 1);
  finishSM(pA0, pA1, alA, l_reg, pa0, pa1, pa2, pa3); SBAR();
  pv_all<DV>(o, vb0, pa0, pa1, pa2, pa3); partialSM(pB0, pB1, m_reg, mnB, alB, C, thr_s);
  __syncthreads(); RESC(alB);
  finishSM(pB0, pB1, alB, l_reg, pa0, pa1, pa2, pa3); SBAR();
  pv_all<DV>(o, vb0 + (int)SHM_V, pa0, pa1, pa2, pa3);
  if (sinkl2 > -1e29f) l_reg += __builtin_amdgcn_exp2f(sinkl2 - m_reg * C);
  if (hi == 0) li_l[r32] = l_reg; asm volatile("s_waitcnt lgkmcnt(0)" ::: "memory");
  float rli[16];
#pragma unroll
  for (int r = 0; r < 16; ++r) rli[r] = __builtin_amdgcn_rcpf(li_l[crow(r, hi)]);
  if constexpr (OUTMODE == 0) {
  unsigned short* Ow = Ob + (long)(wid * QBLK) * ldo;
#pragma unroll
  for (int r = 0; r < 16; ++r) { const int orow = crow(r, hi);
#pragma unroll
    for (int d0 = 0; d0 < DV / 32; ++d0) Ow[(long)orow * ldo + d0 * 32 + r32] = (unsigned short)f2bf(o[d0][r] * rli[r]); }
  } else {   int zo_ = 0; asm volatile("" : "+v"(zo_)); const int lane = (int)__builtin_amdgcn_mbcnt_hi(~0u, __builtin_amdgcn_mbcnt_lo(~0u, (unsigned)zo_)), r32 = lane & 31, hi = lane >> 5;
    unsigned short* stg = (unsigned short*)(lds + SHM_ATTN) + wid * 4096;
    if constexpr (OUTMODE == 1) {
#pragma unroll
      for (int d0 = 0; d0 < DV / 32; ++d0)
#pragma unroll
        for (int r = 0; r < 16; ++r) stg[(d0 * 16 + r) * 64 + lane] = (unsigned short)f2bf(o[d0][r] * rli[r]);
    } else {
      unsigned short* Ow = Ob + (long)(wid * QBLK) * ldo;
#pragma unroll
      for (int r = 0; r < 16; ++r) { float v[DV / 32]; float ss = 0.f;
#pragma unroll
        for (int d0 = 0; d0 < DV / 32; ++d0) { v[d0] = bf2f(stg[(d0 * 16 + r) * 64 + lane]) - lam * (o[d0][r] * rli[r]); ss += v[d0] * v[d0]; }
        ss += __shfl_xor(ss, 1); ss += __shfl_xor(ss, 2); ss += __shfl_xor(ss, 4); ss += __shfl_xor(ss, 8); ss += __shfl_xor(ss, 16);
        const float rs = nscale / sqrtf(ss * (1.f / (float)DV) + 1e-6f); const int orow = crow(r, hi);
#pragma unroll
        for (int d0 = 0; d0 < DV / 32; ++d0) Ow[(long)orow * ldo + d0 * 32 + r32] = (unsigned short)f2bf(v[d0] * rs * nw[d0 * 32 + r32]);
        __builtin_amdgcn_sched_barrier(0); }
    }
  }
  __syncthreads();
#undef TROW
#undef SLOAD
#undef SWRITE
#undef RESC
#undef MASK
}
#undef KSWZ
#undef SBAR
}
struct Args { const float* in[32]; float* out; unsigned char* ws; int ph_lo, ph_hi; };
struct Frame {
    LAS unsigned char* lds; char* ldsg;
    volatile LAS unsigned* MISC;
    gu32* ctl;
    int tid, lane, wave, vcu, G, gw, NGW;
    const float* const* in; float* out; unsigned char* ws;
};
enum { I_X = 0, I_C, I_CTX, I_CCTX, I_EMODW, I_EMODB, I_ENORMS, I_EWIN, I_ECONV, I_EALOG, I_EDTB, I_EGDNN, I_ESINK, I_EWOUT, I_EFG, I_EFU, I_EFD,
       I_OMODW, I_OMODB, I_ONORMS, I_OWIN, I_OQN, I_OKVN, I_OWUQ, I_OWUKV, I_OLAM, I_OSUBLN, I_OWOUT, I_OROUTER, I_OXG, I_OXU, I_OXD };

__device__ __forceinline__ void transpose_item(const float* W, int N, bf16* WT, int ldk, int k0, int n0, int drow0, const float* kscale, LAS float* scr, int lane) {
#pragma unroll 8
    for (int i = 0; i < 32; ++i) { const int kk = 2 * i + (lane >> 5); float v = W[(size_t)(k0 + kk) * N + n0 + (lane & 31)]; if (kscale) v *= kscale[k0 + kk]; scr[kk * 33 + (lane & 31)] = v; }
    LDS_WAIT(); asm volatile("" ::: "memory");
    const int c = lane & 7;
#pragma unroll
    for (int j = 0; j < 4; ++j) { const int n = (lane >> 3) + 8 * j; const LAS float* s = scr + (8 * c) * 33 + n;
        v4u o; o.x = pk2(s[0 * 33], s[1 * 33]); o.y = pk2(s[2 * 33], s[3 * 33]); o.z = pk2(s[4 * 33], s[5 * 33]); o.w = pk2(s[6 * 33], s[7 * 33]);
        *(GAS v4u*)(WT + (size_t)(drow0 + n) * ldk + k0 + 8 * c) = o; }
    LDS_WAIT(); asm volatile("" ::: "memory");
}
template <int MAP> __device__ __forceinline__ void transpose_job(Frame& F, const float* W, int K, int N, bf16* WT, const float* kscale, int first, int stride, LAS unsigned char* scrb) {
    LAS float* scr = (LAS float*)scrb;
    const int nblk = N / 32, items = (K / 64) * nblk;
    for (int it = first; it < items; it += stride) { const int kb = it / nblk, nb = it % nblk, n0 = 32 * nb;
        const int drow0 = (MAP == 0) ? n0 : ((n0 >> 7) * 256 + (n0 & 127) + (MAP == 2 ? 128 : 0));
        transpose_item(W, N, WT, K, 64 * kb, n0, drow0, kscale, scr, F.lane); }
}
__device__ __forceinline__ void zero_rows(Frame& F, bf16* WT, int row0, int nrows, int K) {
    const size_t n16 = (size_t)nrows * K / 8; GAS v4u* p = (GAS v4u*)(WT + (size_t)row0 * K);
    for (size_t i = (size_t)F.gw * 64 + F.lane; i < n16; i += (size_t)F.NGW * 64) p[i] = (v4u){0u, 0u, 0u, 0u};
}
__device__ __forceinline__ void modv_items(Frame& F) {
    LAS float* sc = (LAS float*)(F.lds + RING_OFF);
    LAS float* part = (LAS float*)(F.lds + RING_OFF + 20480);
    float* MODV = (float*)(F.ws + WS_MODV);
    const int nitems = 2 * 96;
    if ((int)blockIdx.x >= nitems) return;
    for (int i = F.tid; i < 5 * 1024; i += 512) { const int r = i >> 10, k = i & 1023; const float v = (r < 4) ? F.in[I_C][r * 1024 + k] : F.in[I_CCTX][k]; sc[i] = siluf(v); }
    __syncthreads();
    for (int it = blockIdx.x; it < nitems; it += F.G) {
        const int l = it / 96, n0 = (it % 96) * 64, col = F.tid & 63, ks = F.tid >> 6;
        const float* W = F.in[l ? I_OMODW : I_EMODW] + (size_t)(ks * 128) * 6144 + n0 + col;
        float a0 = 0, a1 = 0, a2 = 0, a3 = 0, a4 = 0;
#pragma unroll 8
        for (int k = 0; k < 128; ++k) { const float w = W[(size_t)k * 6144]; const int kk = ks * 128 + k;
            a0 += sc[kk] * w; a1 += sc[1024 + kk] * w; a2 += sc[2048 + kk] * w; a3 += sc[3072 + kk] * w; a4 += sc[4096 + kk] * w; }
        part[(ks * 5 + 0) * 64 + col] = a0; part[(ks * 5 + 1) * 64 + col] = a1; part[(ks * 5 + 2) * 64 + col] = a2; part[(ks * 5 + 3) * 64 + col] = a3; part[(ks * 5 + 4) * 64 + col] = a4;
        __syncthreads();
        if (F.tid < 320) { const int r = F.tid >> 6, c2 = F.tid & 63; float s = F.in[l ? I_OMODB : I_EMODB][n0 + c2];
#pragma unroll
            for (int q = 0; q < 8; ++q) s += part[(q * 5 + r) * 64 + c2];
            MODV[(size_t)(l * 5 + r) * 6144 + n0 + c2] = s; }
        __syncthreads();
    }
}
__device__ __forceinline__ const float* modvec(Frame& F, int l, int mr, int k) { return (const float*)(F.ws + WS_MODV) + (size_t)((l * 5 + mr) * 6 + k) * 1024; }

struct Row4 { f32x4 v[4]; };
__device__ __forceinline__ Row4 ld_row_f32(const float* p, int lane) { Row4 r; const GAS f32x4* q = (const GAS f32x4*)p + lane;
#pragma unroll
    for (int j = 0; j < 4; ++j) r.v[j] = q[64 * j]; return r; }
__device__ __forceinline__ Row4 ld_row_bf16(const bf16* p, int lane) { Row4 r; const GAS v2u* q = (const GAS v2u*)p + lane;
#pragma unroll
    for (int j = 0; j < 4; ++j) { const v2u w = q[64 * j]; r.v[j] = (f32x4){bflo(w.x), bfhi(w.x), bflo(w.y), bfhi(w.y)}; } return r; }
__device__ __forceinline__ void st_row_f32(float* p, int lane, const Row4& r) { GAS f32x4* q = (GAS f32x4*)p + lane;
#pragma unroll
    for (int j = 0; j < 4; ++j) q[64 * j] = r.v[j]; }
__device__ __forceinline__ void st_row_bf16(bf16* p, int lane, const Row4& r) { GAS v2u* q = (GAS v2u*)p + lane;
#pragma unroll
    for (int j = 0; j < 4; ++j) q[64 * j] = (v2u){pk2(r.v[j].x, r.v[j].y), pk2(r.v[j].z, r.v[j].w)}; }
__device__ __forceinline__ float row_rstd(const Row4& r) { float s = 0.f;
#pragma unroll
    for (int j = 0; j < 4; ++j) s += (r.v[j].x * r.v[j].x + r.v[j].y * r.v[j].y) + (r.v[j].z * r.v[j].z + r.v[j].w * r.v[j].w);
    return 1.f / sqrtf(wave_sum(s) * (1.f / 1024.f) + EPS); }
__device__ __forceinline__ float* xres_ptr(Frame& F, int r, int& mr) { const int b = r / SROW, s = r - b * SROW;
    if (s < TC) { mr = 4; return (float*)(F.ws + WS_HCTX) + (size_t)(b * TC + s) * D; }
    mr = b; return F.out + (size_t)(b * T + s - TC) * D; }
__device__ __forceinline__ Row4 norm_mod(const Row4& x, const float* w, const float* shift, const float* scale, int lane) {
    const float rs = row_rstd(x); const Row4 W = ld_row_f32(w, lane), SH = ld_row_f32(shift, lane), SC = ld_row_f32(scale, lane); Row4 a;
#pragma unroll
    for (int j = 0; j < 4; ++j) a.v[j] = (x.v[j] * rs * W.v[j]) * (SC.v[j] + 1.f) + SH.v[j];
    return a; }
__device__ __forceinline__ void add_gated_norm(Row4& x, const Row4& y, const float* w, const float* gate, int lane) {
    const float rs = row_rstd(y); const Row4 W = ld_row_f32(w, lane), G = ld_row_f32(gate, lane);
#pragma unroll
    for (int j = 0; j < 4; ++j) x.v[j] = x.v[j] + G.v[j] * (y.v[j] * rs * W.v[j]); }
__device__ __forceinline__ void p0_prologue(Frame& F) {
    modv_items(F);
    __syncthreads();
    transpose_job<0>(F, F.in[I_EWIN], 1024, EIN, (bf16*)(F.ws + WS_WEIN), nullptr, F.gw, F.NGW, F.lds + RING_OFF + F.wave * 16384);
    zero_rows(F, (bf16*)(F.ws + WS_WEIN), EIN, EINP - EIN, 1024);
}
__device__ __forceinline__ void p0_deferred(Frame& F, int w4, LAS unsigned char* scr) {
    const float* const* in = F.in; unsigned char* ws = F.ws; const int gw = F.vcu * 4 + w4, N = F.G * 4;
    transpose_job<0>(F, in[I_EWOUT], 1024, 1024, (bf16*)(ws + WS_WEOUT), nullptr, gw, N, scr);
    transpose_job<1>(F, in[I_EFG], 1024, DFF, (bf16*)(ws + WS_WEGU), nullptr, (gw + 512) % N, N, scr);
    transpose_job<2>(F, in[I_EFU], 1024, DFF, (bf16*)(ws + WS_WEGU), nullptr, (gw + 896) % N, N, scr);
    transpose_job<0>(F, in[I_EFD], DFF, 1024, (bf16*)(ws + WS_WEDN), nullptr, (gw + 256) % N, N, scr);
    transpose_job<0>(F, in[I_OWIN], 1024, OIN, (bf16*)(ws + WS_WOIN), nullptr, (gw + 640) % N, N, scr);
    transpose_job<0>(F, in[I_OWUQ], 384, 768, (bf16*)(ws + WS_WUQ), in[I_OQN], (gw + 720) % N, N, scr);
    transpose_job<0>(F, in[I_OWUKV], 256, 1024, (bf16*)(ws + WS_WUKV), in[I_OKVN], (gw + 864) % N, N, scr);
    transpose_job<0>(F, in[I_OWOUT], 1024, 1024, (bf16*)(ws + WS_WOOUT), nullptr, (gw + 992) % N, N, scr);
    { const size_t n16 = (size_t)(OINP - OIN) * 1024 / 8; GAS v4u* p = (GAS v4u*)((bf16*)(ws + WS_WOIN) + (size_t)OIN * 1024);
      for (size_t i = (size_t)gw * 64 + F.lane; i < n16; i += (size_t)N * 64) p[i] = (v4u){0u, 0u, 0u, 0u}; }
}
__device__ __forceinline__ void px_expert_weights(Frame& F) {
    for (int e = 0; e < NEXP; ++e) {
        transpose_job<1>(F, F.in[I_OXG] + (size_t)e * 1024 * DFX, 1024, DFX, (bf16*)(F.ws + WS_WXGU) + (size_t)e * 7168 * 1024, nullptr, (F.gw + e * 448) % F.NGW, F.NGW, F.lds + RING_OFF + F.wave * 16384);
        transpose_job<2>(F, F.in[I_OXU] + (size_t)e * 1024 * DFX, 1024, DFX, (bf16*)(F.ws + WS_WXGU) + (size_t)e * 7168 * 1024, nullptr, (F.gw + e * 448 + 224) % F.NGW, F.NGW, F.lds + RING_OFF + F.wave * 16384);
        transpose_job<0>(F, F.in[I_OXD] + (size_t)e * DFX * 1024, DFX, 1024, (bf16*)(F.ws + WS_WXDN) + (size_t)e * 1024 * DFX, nullptr, (F.gw + e * 448 + 112) % F.NGW, F.NGW, F.lds + RING_OFF + F.wave * 16384);
    }
}
__device__ __forceinline__ void p1_first_rows(Frame& F) {
    bf16* A = (bf16*)(F.ws + WS_ABUF); const float* w0 = F.in[I_ENORMS];
#define SRC_OF(r) (((r) % SROW < TC) ? F.in[I_CTX] + (size_t)(((r) / SROW) * TC + (r) % SROW) * D : F.in[I_X] + (size_t)(((r) / SROW) * T + (r) % SROW - TC) * D)
    Row4 xn; if (F.gw < NR) xn = ld_row_f32(SRC_OF(F.gw), F.lane);
    for (int r = F.gw; r < NR; r += F.NGW) { int mr; float* xr = xres_ptr(F, r, mr);
        const Row4 x = xn; if (r + F.NGW < NR) xn = ld_row_f32(SRC_OF(r + F.NGW), F.lane);
        st_row_f32(xr, F.lane, x);
        const Row4 a = norm_mod(x, w0, modvec(F, 0, mr, 0), modvec(F, 0, mr, 1), F.lane);
        st_row_bf16(A + (size_t)r * D, F.lane, a); }
#undef SRC_OF
}
template <bool ROUTER> __device__ __forceinline__ void rows_mid(Frame& F, const bf16* Y, const float* wy, int lg, int kg, const float* w2, int l2, int ks2, bf16* Aout, bool lat_only) {
    const int count = lat_only ? NB * T : NR;
#define ROW_OF(i) (lat_only ? ((i) / T) * SROW + TC + (i) % T : (i))
    Row4 xn, yn; int mrn = 0; float* xrn = nullptr;
    if (F.gw < count) { const int r = ROW_OF(F.gw); xrn = xres_ptr(F, r, mrn); xn = ld_row_f32(xrn, F.lane); yn = ld_row_bf16(Y + (size_t)r * D, F.lane); }
    for (int i = F.gw; i < count; i += F.NGW) { const int r = ROW_OF(i); const int b = r / SROW, s = r - b * SROW; const int mr = mrn; float* xr = xrn;
        Row4 x = xn; const Row4 y = yn;
        if (i + F.NGW < count) { const int r2 = ROW_OF(i + F.NGW); xrn = xres_ptr(F, r2, mrn); xn = ld_row_f32(xrn, F.lane); yn = ld_row_bf16(Y + (size_t)r2 * D, F.lane); }
        add_gated_norm(x, y, wy, modvec(F, lg, mr, kg), F.lane); st_row_f32(xr, F.lane, x);
        const Row4 a = norm_mod(x, w2, modvec(F, l2, mr, ks2), modvec(F, l2, mr, ks2 + 1), F.lane);
        st_row_bf16(Aout + (size_t)r * D, F.lane, a);
        if constexpr (ROUTER) {
            const float* Rw = F.in[I_OROUTER]; float lg8[8];
#pragma unroll
            for (int e = 0; e < 8; ++e) lg8[e] = 0.f;
#pragma unroll
            for (int j = 0; j < 4; ++j)
#pragma unroll
                for (int q = 0; q < 4; ++q) { const int k = 4 * F.lane + 256 * j + q; const f32x4 r0 = *(const GAS f32x4*)(Rw + (size_t)k * 8), r1 = *(const GAS f32x4*)(Rw + (size_t)k * 8 + 4); const float av = a.v[j][q];
                    lg8[0] += av * r0.x; lg8[1] += av * r0.y; lg8[2] += av * r0.z; lg8[3] += av * r0.w; lg8[4] += av * r1.x; lg8[5] += av * r1.y; lg8[6] += av * r1.z; lg8[7] += av * r1.w; }
#pragma unroll
            for (int e = 0; e < 8; ++e) lg8[e] = wave_sum(lg8[e]);
            int i0 = 0; float v0 = lg8[0];
#pragma unroll
            for (int e = 1; e < 8; ++e) if (lg8[e] > v0) { v0 = lg8[e]; i0 = e; }
            int i1 = -1; float v1 = -3.0e38f;
#pragma unroll
            for (int e = 0; e < 8; ++e) if (e != i0 && lg8[e] > v1) { v1 = lg8[e]; i1 = e; }
            const float e1 = __expf(v1 - v0), w0 = 1.f / (1.f + e1), w1 = e1 * w0;
            if (F.lane == 0) { const int tk = b * T + s - TC;
                int* TOPI = (int*)(F.ws + WS_META + META_TOPI); float* TOPW = (float*)(F.ws + WS_META + META_TOPW); int* RANK = (int*)(F.ws + WS_META + META_RANK);
                TOPI[tk * 2] = i0; TOPI[tk * 2 + 1] = i1; TOPW[tk * 2] = w0; TOPW[tk * 2 + 1] = w1;
                RANK[tk * 2] = (int)__hip_atomic_fetch_add((unsigned*)(F.ctl + CW_MOECNT + 64 * i0), 1u, RLX_AGENT);
                RANK[tk * 2 + 1] = (int)__hip_atomic_fetch_add((unsigned*)(F.ctl + CW_MOECNT + 64 * i1), 1u, RLX_AGENT); }
        }
    }
}
#undef ROW_OF
__device__ __forceinline__ void g0_prep(Frame& F) {
    const bf16* P = (const bf16*)(F.ws + WS_PROJ); bf16* PW = (bf16*)(F.ws + WS_PROJ); bf16* QK = (bf16*)(F.ws + WS_QKVN); float* GB = (float*)(F.ws + WS_GB);
    const float* cw = F.in[I_ECONV]; const int lane = F.lane;
    for (int r = F.gw; r < NR; r += F.NGW) { const int b = r / SROW, s = r - b * SROW; const bool isc = s < TC; const int p = isc ? s : s - TC, len = isc ? TC : T;
#pragma unroll
        for (int part = 0; part < 3; ++part) { const int ch = part * 512 + 8 * lane; float acc[8];
#pragma unroll
            for (int e = 0; e < 8; ++e) acc[e] = 0.f;
#pragma unroll
            for (int j = 0; j < 5; ++j) { const int pp = p + j - 2; if (pp >= 0 && pp < len) {
                    const v4u xv = *(const GAS v4u*)(P + (size_t)(r + j - 2) * EINP + ch); const f32x4 w0 = *(const GAS f32x4*)(cw + j * 1536 + ch), w1 = *(const GAS f32x4*)(cw + j * 1536 + ch + 4);
                    acc[0] += bflo(xv.x) * w0.x; acc[1] += bfhi(xv.x) * w0.y; acc[2] += bflo(xv.y) * w0.z; acc[3] += bfhi(xv.y) * w0.w;
                    acc[4] += bflo(xv.z) * w1.x; acc[5] += bfhi(xv.z) * w1.y; acc[6] += bflo(xv.w) * w1.z; acc[7] += bfhi(xv.w) * w1.w; } }
            float ss = 0.f;
#pragma unroll
            for (int e = 0; e < 8; ++e) { acc[e] = siluf(acc[e]); ss += acc[e] * acc[e]; }
            if (part < 2) { ss += __shfl_xor(ss, 1); ss += __shfl_xor(ss, 2); ss += __shfl_xor(ss, 4); const float sc = (part == 0 ? 0.125f : 1.f) / sqrtf(ss + EPS);
#pragma unroll
                for (int e = 0; e < 8; ++e) acc[e] *= sc; }
            *(GAS v4u*)(QK + (size_t)r * 1536 + ch) = (v4u){pk2(acc[0], acc[1]), pk2(acc[2], acc[3]), pk2(acc[4], acc[5]), pk2(acc[6], acc[7])}; }
        if (lane < 16) { const float ga = bf2f(P[(size_t)r * EINP + E_GA + lane]), gb = bf2f(P[(size_t)r * EINP + E_GB + lane]);
            const float xx = ga + F.in[I_EDTB][lane], sp = fmaxf(xx, 0.f) + log1pf(__expf(-fabsf(xx)));
            GB[(size_t)r * 32 + lane] = -__expf(F.in[I_EALOG][lane]) * sp; GB[(size_t)r * 32 + 16 + lane] = 1.f / (1.f + __expf(-gb)); }
        if (!isc) {
            const int pi = lane & 31, seg = pi >> 4, i = pi & 15, d0 = seg * 32 + i; const float pos = (float)(seg ? (p & 63) : (p >> 6));
            const float ang = pos * __powf(10000.f, -(float)i * (1.f / 16.f)); float sn, cs; sincosf(ang, &sn, &cs);
#pragma unroll
            for (int q = 0; q < 5; ++q) { const int hh = (lane >> 5) + 2 * q; bf16* base = PW + (size_t)r * EINP + (hh < 8 ? E_SQ + hh * 64 : E_SK + (hh - 8) * 64) + d0;
                const float x0 = bf2f(base[0]), x1 = bf2f(base[16]); base[0] = (bf16)f2bf(x0 * cs - x1 * sn); base[16] = (bf16)f2bf(x1 * cs + x0 * sn); }
        }
    }
}
constexpr int GP = 65, GLP = 68;
template <int I> struct SolveRow {
    static __device__ __forceinline__ void run(float (&x)[64], const LAS float* Ls) {
        SolveRow<I - 1>::run(x, Ls);
        float a = x[I];
#pragma unroll
        for (int j = 0; j < I; ++j) a -= Ls[I * GLP + j] * x[j];
        x[I] = a;
    }
};
template <> struct SolveRow<0> { static __device__ __forceinline__ void run(float (&)[64], const LAS float*) {} };

__device__ __forceinline__ void gdn_chain(Frame& F, int chain) {
    const int b = chain >> 4, h = (chain >> 1) & 7, dir = chain & 1;
    LAS float* Ss = (LAS float*)(F.lds + RING_OFF);
    LAS float* Qs = Ss + 64 * GP, *Ks = Qs + 64 * GP, *Vs = Ks + 64 * GP  , *ATs = Vs + 64 * GP, *Ws = ATs + 64 * GP, *VNs = Ws + 64 * GP;
    LAS float* Ls = VNs + 64 * GP;
    LAS float* gcs = Ls + 64 * GLP, *bts = gcs + 64;
    const bf16* QK = (const bf16*)(F.ws + WS_QKVN); const float* GB = (const float*)(F.ws + WS_GB); bf16* OG = (bf16*)(F.ws + WS_OG);
    const int tid = F.tid, lane = F.lane, w = F.wave;
    for (int i = tid; i < 64 * GP; i += 512) Ss[i] = 0.f;
    for (int ci = 0; ci < 68; ++ci) {
        const bool isc = ci < 4; const int n0 = (isc ? ci : ci - 4) * 64; const int rbase = b * SROW + (isc ? 0 : TC), len = isc ? TC : T;
        __syncthreads();
        for (int e = tid; e < 64 * 24; e += 512) { const int i = e / 24, c8 = e % 24, part = c8 >> 3, cc = (c8 & 7) * 8; const int n = n0 + i, row = rbase + (dir ? len - 1 - n : n);
            const v4u xv = *(const GAS v4u*)(QK + (size_t)row * 1536 + part * 512 + h * 64 + cc); LAS float* dst = (part == 0 ? Qs : part == 1 ? Ks : Vs) + i * GP + cc;
            dst[0] = bflo(xv.x); dst[1] = bfhi(xv.x); dst[2] = bflo(xv.y); dst[3] = bfhi(xv.y); dst[4] = bflo(xv.z); dst[5] = bfhi(xv.z); dst[6] = bflo(xv.w); dst[7] = bfhi(xv.w); }
        if (tid < 64) { const int n = n0 + tid, row = rbase + (dir ? len - 1 - n : n); float g = GB[(size_t)row * 32 + dir * 8 + h]; bts[tid] = GB[(size_t)row * 32 + 16 + dir * 8 + h];
#pragma unroll
            for (int o = 1; o < 64; o <<= 1) { const float t = __shfl_up(g, o); if (lane >= o) g += t; }
            gcs[tid] = g; }
        __syncthreads();
#pragma unroll 1
        for (int k = 0; k < 8; ++k) { const int i = w + 8 * k, j = lane; float kk = 0.f, qk = 0.f;
#pragma unroll 16
            for (int d = 0; d < 64; ++d) { const float kj = Ks[j * GP + d]; kk += Ks[i * GP + d] * kj; qk += Qs[i * GP + d] * kj; }
            const float dec = (j <= i) ? __expf(gcs[i] - gcs[j]) : 0.f;
            Ls[i * GLP + j] = (j < i) ? bts[i] * kk * dec : 0.f; ATs[i * GP + j] = qk * dec; }
        __syncthreads();
        if (tid < 128) { float x[64]; const int c = tid & 63; const bool isw = tid >= 64; int zz = 0; asm volatile("" : "+v"(zz));
            const LAS float* src = (isw ? Ks : Vs) + c; const LAS float* btz = bts + zz; const LAS float* gcz = gcs + zz;
#pragma unroll
            for (int i = 0; i < 64; ++i) { const float e = isw ? __expf(gcz[i]) : 1.f; x[i] = src[i * GP] * btz[i] * e; }
            SolveRow<63>::run(x, Ls + zz);
            LAS float* dst = isw ? Ws : Vs;
#pragma unroll
            for (int i = 0; i < 64; ++i) dst[i * GP + c] = x[i]; }
        __syncthreads();
#pragma unroll 1
        for (int k = 0; k < 8; ++k) { const int i = w + 8 * k, d = lane; float a = Vs[i * GP + d];
#pragma unroll 16
            for (int q = 0; q < 64; ++q) a -= Ws[i * GP + q] * Ss[q * GP + d];
            VNs[i * GP + d] = a; }
        __syncthreads();
#pragma unroll 1
        for (int k = 0; k < 8; ++k) { const int i = w + 8 * k, d = lane; float a = 0.f, c2 = 0.f;
#pragma unroll 16
            for (int q = 0; q < 64; ++q) { a += Qs[i * GP + q] * Ss[q * GP + d]; c2 += ATs[i * GP + q] * VNs[q * GP + d]; }
            const int n = n0 + i, row = rbase + (dir ? len - 1 - n : n);
            OG[(size_t)row * 1024 + dir * 512 + h * 64 + d] = (bf16)f2bf(a * __expf(gcs[i]) + c2); }
        __syncthreads();
        const float gl = gcs[63];
#pragma unroll 1
        for (int k = 0; k < 8; ++k) { const int a = w + 8 * k, d = lane; float acc = Ss[a * GP + d] * __expf(gl);
#pragma unroll 16
            for (int i = 0; i < 64; ++i) acc += Ks[i * GP + a] * __expf(gl - gcs[i]) * VNs[i * GP + d];
            Ss[a * GP + d] = acc; }
    }
    __syncthreads();
}
__device__ __forceinline__ void g4_gdn_out(Frame& F) {
    const bf16* OG = (const bf16*)(F.ws + WS_OG); const bf16* P = (const bf16*)(F.ws + WS_PROJ); bf16* MIX = (bf16*)(F.ws + WS_MIX); const float* gn = F.in[I_EGDNN]; const int lane = F.lane;
    const f32x4 g0 = *(const GAS f32x4*)(gn + (lane & 7) * 8), g1 = *(const GAS f32x4*)(gn + (lane & 7) * 8 + 4);
    for (int r = F.gw; r < NR; r += F.NGW) {
        const v4u a = *(const GAS v4u*)(OG + (size_t)r * 1024 + 8 * lane), c = *(const GAS v4u*)(OG + (size_t)r * 1024 + 512 + 8 * lane), z = *(const GAS v4u*)(P + (size_t)r * EINP + E_Z + 8 * lane);
        float o[8] = {bflo(a.x) + bflo(c.x), bfhi(a.x) + bfhi(c.x), bflo(a.y) + bflo(c.y), bfhi(a.y) + bfhi(c.y), bflo(a.z) + bflo(c.z), bfhi(a.z) + bfhi(c.z), bflo(a.w) + bflo(c.w), bfhi(a.w) + bfhi(c.w)};
        float ss = 0.f;
#pragma unroll
        for (int e = 0; e < 8; ++e) ss += o[e] * o[e];
        ss += __shfl_xor(ss, 1); ss += __shfl_xor(ss, 2); ss += __shfl_xor(ss, 4);
        const float rs = 1.f / sqrtf(ss * (1.f / 64.f) + EPS);
        const float zz[8] = {bflo(z.x), bfhi(z.x), bflo(z.y), bfhi(z.y), bflo(z.z), bfhi(z.z), bflo(z.w), bfhi(z.w)};
        const float gg[8] = {g0.x, g0.y, g0.z, g0.w, g1.x, g1.y, g1.z, g1.w};
#pragma unroll
        for (int e = 0; e < 8; ++e) o[e] = o[e] * rs * gg[e] * siluf(zz[e]);
        *(GAS v4u*)(MIX + (size_t)r * 1024 + 8 * lane) = (v4u){pk2(o[0], o[1]), pk2(o[2], o[3]), pk2(o[4], o[5]), pk2(o[6], o[7])}; }
}
__device__ __forceinline__ void swa_unit(Frame& F, int u) {
    const bf16* P = (const bf16*)(F.ws + WS_PROJ); bf16* MIX = (bf16*)(F.ws + WS_MIX);
    constexpr float SC = 0.125f, C = SC * 1.4426950408889634f, THRS = att::THR / SC;
    if (u < 512) { const int b = u >> 7, qb = (u >> 3) & 15, hq = u & 7, kvh = hq >> 2; const size_t rq = (size_t)b * SROW + TC + qb * 256, r0 = (size_t)b * SROW;
        const int lat0 = qb * 256 - 128 < 0 ? 0 : qb * 256 - 128, lend = qb * 256 + 384 > T ? T : qb * 256 + 384, NT = 4 + (lend - lat0) / 64;
        att::attn_unit<64, 64, 1>(P + rq * EINP + E_SQ + hq * 64, EINP, P + r0 * EINP + E_SK + kvh * 64, EINP, P + r0 * EINP + E_SV + kvh * 64, EINP,
                                  MIX + rq * 1024 + 512 + hq * 64, 1024, NT, lat0, qb * 256, C, THRS, F.in[I_ESINK][hq] * 1.4426950408889634f, F.ldsg + RING_OFF);
    } else { const int v = u - 512, b = v >> 3, hq = v & 7, kvh = hq >> 2; const size_t r0 = (size_t)b * SROW;
        att::attn_unit<64, 64, 2>(P + r0 * EINP + E_SQ + hq * 64, EINP, P + r0 * EINP + E_SK + kvh * 64, EINP, P + r0 * EINP + E_SV + kvh * 64, EINP,
                                  MIX + r0 * 1024 + 512 + hq * 64, 1024, 4, 0, 0, C, THRS, F.in[I_ESINK][hq] * 1.4426950408889634f, F.ldsg + RING_OFF); }
}
namespace gdn {
using bf16x8 = __attribute__((ext_vector_type(8))) short;
using f32x16 = __attribute__((ext_vector_type(16))) float;
using u32x4  = __attribute__((ext_vector_type(4))) unsigned;
__device__ __forceinline__ int crow(int r, int hi) { return (r & 3) + 8 * (r >> 2) + 4 * hi; }
typedef float f32x2_t __attribute__((ext_vector_type(2))); typedef __bf16 bf16x2_t __attribute__((ext_vector_type(2)));
__device__ __forceinline__ unsigned cvtpk(float lo, float hi) { f32x2_t v = {lo, hi}; bf16x2_t b = __builtin_convertvector(v, bf16x2_t); return __builtin_bit_cast(unsigned, b); }
__device__ __forceinline__ int swap23(int p) { return (p & ~0xC) | ((p & 4) << 1) | ((p & 8) >> 1); }
typedef float f32x4g __attribute__((ext_vector_type(4)));
template <int I> struct LRow {
    static constexpr int NQ = (I + 3) / 4, O = I * 128;
    static __device__ __forceinline__ void load(f32x4g (&b)[8], unsigned la) {
        if constexpr (NQ == 1) asm volatile("ds_read_b128 %0, %1 offset:%2\n\ts_waitcnt lgkmcnt(0)" : "=&v"(b[0]) : "v"(la), "i"(O));
        else if constexpr (NQ == 2) asm volatile("ds_read_b128 %0, %2 offset:%3\n\tds_read_b128 %1, %2 offset:%4\n\ts_waitcnt lgkmcnt(0)" : "=&v"(b[0]), "=&v"(b[1]) : "v"(la), "i"(O), "i"(O + 16));
        else if constexpr (NQ == 3) asm volatile("ds_read_b128 %0, %3 offset:%4\n\tds_read_b128 %1, %3 offset:%5\n\tds_read_b128 %2, %3 offset:%6\n\ts_waitcnt lgkmcnt(0)" : "=&v"(b[0]), "=&v"(b[1]), "=&v"(b[2]) : "v"(la), "i"(O), "i"(O + 16), "i"(O + 32));
        else if constexpr (NQ == 4) asm volatile("ds_read_b128 %0, %4 offset:%5\n\tds_read_b128 %1, %4 offset:%6\n\tds_read_b128 %2, %4 offset:%7\n\tds_read_b128 %3, %4 offset:%8\n\ts_waitcnt lgkmcnt(0)" : "=&v"(b[0]), "=&v"(b[1]), "=&v"(b[2]), "=&v"(b[3]) : "v"(la), "i"(O), "i"(O + 16), "i"(O + 32), "i"(O + 48));
        else if constexpr (NQ == 5) asm volatile("ds_read_b128 %0, %5 offset:%6\n\tds_read_b128 %1, %5 offset:%7\n\tds_read_b128 %2, %5 offset:%8\n\tds_read_b128 %3, %5 offset:%9\n\tds_read_b128 %4, %5 offset:%10\n\ts_waitcnt lgkmcnt(0)" : "=&v"(b[0]), "=&v"(b[1]), "=&v"(b[2]), "=&v"(b[3]), "=&v"(b[4]) : "v"(la), "i"(O), "i"(O + 16), "i"(O + 32), "i"(O + 48), "i"(O + 64));
        else if constexpr (NQ == 6) asm volatile("ds_read_b128 %0, %6 offset:%7\n\tds_read_b128 %1, %6 offset:%8\n\tds_read_b128 %2, %6 offset:%9\n\tds_read_b128 %3, %6 offset:%10\n\tds_read_b128 %4, %6 offset:%11\n\tds_read_b128 %5, %6 offset:%12\n\ts_waitcnt lgkmcnt(0)" : "=&v"(b[0]), "=&v"(b[1]), "=&v"(b[2]), "=&v"(b[3]), "=&v"(b[4]), "=&v"(b[5]) : "v"(la), "i"(O), "i"(O + 16), "i"(O + 32), "i"(O + 48), "i"(O + 64), "i"(O + 80));
        else if constexpr (NQ == 7) asm volatile("ds_read_b128 %0, %7 offset:%8\n\tds_read_b128 %1, %7 offset:%9\n\tds_read_b128 %2, %7 offset:%10\n\tds_read_b128 %3, %7 offset:%11\n\tds_read_b128 %4, %7 offset:%12\n\tds_read_b128 %5, %7 offset:%13\n\tds_read_b128 %6, %7 offset:%14\n\ts_waitcnt lgkmcnt(0)" : "=&v"(b[0]), "=&v"(b[1]), "=&v"(b[2]), "=&v"(b[3]), "=&v"(b[4]), "=&v"(b[5]), "=&v"(b[6]) : "v"(la), "i"(O), "i"(O + 16), "i"(O + 32), "i"(O + 48), "i"(O + 64), "i"(O + 80), "i"(O + 96));
        else asm volatile("ds_read_b128 %0, %8 offset:%9\n\tds_read_b128 %1, %8 offset:%10\n\tds_read_b128 %2, %8 offset:%11\n\tds_read_b128 %3, %8 offset:%12\n\tds_read_b128 %4, %8 offset:%13\n\tds_read_b128 %5, %8 offset:%14\n\tds_read_b128 %6, %8 offset:%15\n\tds_read_b128 %7, %8 offset:%16\n\ts_waitcnt lgkmcnt(0)" : "=&v"(b[0]), "=&v"(b[1]), "=&v"(b[2]), "=&v"(b[3]), "=&v"(b[4]), "=&v"(b[5]), "=&v"(b[6]), "=&v"(b[7]) : "v"(la), "i"(O), "i"(O + 16), "i"(O + 32), "i"(O + 48), "i"(O + 64), "i"(O + 80), "i"(O + 96), "i"(O + 112));
    }
};
template <int I> struct Solve32 {
    static __device__ __forceinline__ void run(float (&x)[32], unsigned la) {
#ifdef SOLVE_C_LOAD
        f32x4g b[8]; { const LAS f32x4g* Lp = (const LAS f32x4g*)(uintptr_t)(la + I * 128);
#pragma unroll
          for (int q = 0; q < (I + 3) / 4; ++q) b[q] = Lp[q]; }
#else
        f32x4g b[8]; LRow<I>::load(b, la);
#endif
        float a = x[I];
#pragma unroll
#ifdef SOLVE_C_FMA
        for (int j = 0; j < I; ++j) a = __builtin_fmaf(-b[j >> 2][j & 3], x[j], a);
#else
        for (int j = 0; j < I; ++j) asm volatile("v_fma_f32 %0, -%1, %2, %0" : "+v"(a) : "v"(b[j >> 2][j & 3]), "v"(x[j]));
#endif
        x[I] = a;
        if constexpr (I < 31) Solve32<I + 1>::run(x, la);
    }
};
__device__ __forceinline__ void solve32(float (&x)[32], unsigned la) { Solve32<1>::run(x, la); }
__device__ __forceinline__ void col_frags32(const float (&x)[32], bf16x8 (&F)[4][2], int s0) {
#pragma unroll
    for (int s = 0; s < 2; ++s) {
        const unsigned p0[4] = {cvtpk(x[16 * s + 0], x[16 * s + 1]), cvtpk(x[16 * s + 2], x[16 * s + 3]), cvtpk(x[16 * s + 8], x[16 * s + 9]), cvtpk(x[16 * s + 10], x[16 * s + 11])};
        const unsigned p1[4] = {cvtpk(x[16 * s + 4], x[16 * s + 5]), cvtpk(x[16 * s + 6], x[16 * s + 7]), cvtpk(x[16 * s + 12], x[16 * s + 13]), cvtpk(x[16 * s + 14], x[16 * s + 15])};
        u32x4 f0, f1;
#pragma unroll
        for (int q = 0; q < 4; ++q) { auto r = __builtin_amdgcn_permlane32_swap(p0[q], p1[q], false, false); f0[q] = r[0]; f1[q] = r[1]; }
        F[s0 + s][0] = __builtin_bit_cast(bf16x8, f0); F[s0 + s][1] = __builtin_bit_cast(bf16x8, f1); }
}
__device__ __forceinline__ void solve_blocked(float (&x1)[32], float (&x2)[32], unsigned la, const bf16x8 (&L21A)[2], bf16x8 (&F)[4][2]) {
    solve32(x1, la);
    col_frags32(x1, F, 0);
    f32x16 t0 = f32x16{}, t1 = f32x16{};
    t0 = __builtin_amdgcn_mfma_f32_32x32x16_bf16(L21A[0], F[0][0], t0, 0, 0, 0); t0 = __builtin_amdgcn_mfma_f32_32x32x16_bf16(L21A[1], F[1][0], t0, 0, 0, 0);
    t1 = __builtin_amdgcn_mfma_f32_32x32x16_bf16(L21A[0], F[0][1], t1, 0, 0, 0); t1 = __builtin_amdgcn_mfma_f32_32x32x16_bf16(L21A[1], F[1][1], t1, 0, 0, 0);
#pragma unroll
    for (int r = 0; r < 16; ++r) { const float e0 = t0[r], e1 = t1[r]; auto sw = __builtin_amdgcn_permlane32_swap(__float_as_uint(e0), __float_as_uint(e1), false, false);
        x2[(r & 3) + 8 * (r >> 2)] -= __uint_as_float(sw[0]); x2[(r & 3) + 8 * (r >> 2) + 4] -= __uint_as_float(sw[1]); }
    __builtin_amdgcn_sched_barrier(0);
    solve32(x2, la + 4096u);
    col_frags32(x2, F, 2);
}
__device__ __forceinline__ bf16x8 acc_frag(const f32x16& t, int sp) {
    u32x4 w;
    if (sp == 0) { w[0] = cvtpk(t[0], t[1]); w[1] = cvtpk(t[2], t[3]); w[2] = cvtpk(t[4], t[5]); w[3] = cvtpk(t[6], t[7]); }
    else { w[0] = cvtpk(t[8], t[9]); w[1] = cvtpk(t[10], t[11]); w[2] = cvtpk(t[12], t[13]); w[3] = cvtpk(t[14], t[15]); }
    return __builtin_bit_cast(bf16x8, w);
}
__device__ __forceinline__ void store_accfrag(__amdgpu_buffer_rsrc_t ro, int soff, int lane, const f32x16& t) {
    __builtin_amdgcn_raw_buffer_store_b128((u32x4){cvtpk(t[0], t[1]), cvtpk(t[2], t[3]), cvtpk(t[4], t[5]), cvtpk(t[6], t[7])}, ro, lane * 32, soff, 0);
    __builtin_amdgcn_raw_buffer_store_b128((u32x4){cvtpk(t[8], t[9]), cvtpk(t[10], t[11]), cvtpk(t[12], t[13]), cvtpk(t[14], t[15])}, ro, lane * 32 + 16, soff, 0);
}
struct ItemGeom { int b, h, dir, rbase, len, n0; };
__device__ __forceinline__ ItemGeom item_geom(int chain, int ci) { ItemGeom g; g.b = chain >> 4; g.h = (chain >> 1) & 7; g.dir = chain & 1; const bool isc = ci < 4;
    g.n0 = (isc ? ci : ci - 4) * 64; g.rbase = g.b * SROW + (isc ? 0 : TC); g.len = isc ? TC : T; return g; }
__device__ __forceinline__ int item_row(const ItemGeom& g, int i) { const int n = g.n0 + i; return g.rbase + (g.dir ? g.len - 1 - n : n); }

#define G1_LANES() int zs_ = 0; asm volatile("" : "+v"(zs_)); const int lane = (int)__builtin_amdgcn_mbcnt_hi(~0u, __builtin_amdgcn_mbcnt_lo(~0u, (unsigned)zs_)), r32 = lane & 31, hi = lane >> 5; (void)r32; (void)hi
__device__ __forceinline__ void pair_lock(volatile LAS unsigned* w) {
    for (;;) { unsigned got = 0u; if (__builtin_amdgcn_mbcnt_hi(~0u, __builtin_amdgcn_mbcnt_lo(~0u, 0u)) == 0u) got = (__hip_atomic_exchange((LAS unsigned*)w, 1u, __ATOMIC_RELAXED, __HIP_MEMORY_SCOPE_WORKGROUP) == 0u) ? 1u : 0u;
        got = (unsigned)__builtin_amdgcn_readfirstlane((int)got); if (got) break; __builtin_amdgcn_s_sleep(2); }
    asm volatile("s_waitcnt lgkmcnt(0)" ::: "memory"); }
__device__ __forceinline__ void pair_unlock(volatile LAS unsigned* w) { asm volatile("s_waitcnt vmcnt(0) lgkmcnt(0)" ::: "memory"); if (__builtin_amdgcn_mbcnt_hi(~0u, __builtin_amdgcn_mbcnt_lo(~0u, 0u)) == 0u) __hip_atomic_store((LAS unsigned*)w, 0u, __ATOMIC_RELAXED, __HIP_MEMORY_SCOPE_WORKGROUP); asm volatile("s_waitcnt lgkmcnt(0)" ::: "memory"); }
#ifndef G1_LOCK
#define G1_LOCK 0
#endif
#define LOCK_IF(m) do { if (G1_LOCK & (m)) pair_lock(lockw); } while (0)
#define UNLOCK_IF(m) do { if (G1_LOCK & (m)) pair_unlock(lockw); } while (0)
constexpr int G1_L = 0, G1_ARR = 8192, G1_TK = 9216, G1_TV = 17408, G1_TQ = 17408  , G1_WAVE_LDS = 26624;
__device__ __forceinline__ void g1_item(Frame& F, int item, LAS unsigned char* wl, volatile LAS unsigned* lockw) {
    int zz = 0; asm volatile("" : "+v"(zz)); __builtin_assume((unsigned)zz < 2u);
    const int chain = item / 68, ci = item - chain * 68; const ItemGeom G = item_geom(chain, ci); const int h = G.h;
    LAS float* Ls = (LAS float*)(wl + G1_L); LAS float* gcA = (LAS float*)(wl + G1_ARR), *btA = gcA + 64, *egA = gcA + 128, *etA = gcA + 192;
    const LAS bf16* TK = (const LAS bf16*)(wl + G1_TK); const LAS bf16* TV = (const LAS bf16*)(wl + G1_TV); const LAS bf16* TQ = (const LAS bf16*)(wl + G1_TQ);
    const bf16* QK = (const bf16*)(F.ws + WS_QKVN); const float* GB = (const float*)(F.ws + WS_GB);
    bf16* out = (bf16*)(F.ws + WS_GDNI) + (size_t)item * 16384;
    LOCK_IF(1);
    u32x4 tq[8];
    { G1_LANES(); u32x4 t[2][8];
#pragma unroll
      for (int j = 0; j < 8; ++j) { const int i = (lane >> 3) + 8 * j; const bf16* rp = QK + (size_t)item_row(G, i) * 1536 + h * 64 + (lane & 7) * 8;
          t[0][j] = *(const GAS u32x4*)(rp + 512); t[1][j] = *(const GAS u32x4*)(rp + 1024); tq[j] = *(const GAS u32x4*)rp; }
#pragma unroll
      for (int j = 0; j < 8; ++j) { const int o = ((lane >> 3) + 8 * j) * 128 + (lane & 7) * 16;
          *(LAS u32x4*)(wl + G1_TK + o) = t[0][j]; *(LAS u32x4*)(wl + G1_TV + o) = t[1][j]; } }
    float gl;
    { G1_LANES(); const int row = item_row(G, lane); float g = GB[(size_t)row * 32 + G.dir * 8 + h]; const float bt = GB[(size_t)row * 32 + 16 + G.dir * 8 + h];
#pragma unroll
      for (int o = 1; o < 64; o <<= 1) { const float t = __builtin_bit_cast(float, __builtin_amdgcn_ds_bpermute((lane - o) << 2, __builtin_bit_cast(int, g))); if (lane >= o) g += t; }
      gl = __builtin_bit_cast(float, __builtin_amdgcn_readlane(__builtin_bit_cast(int, g), 63)); gcA[lane] = g; btA[lane] = bt; egA[lane] = __expf(g); etA[lane] = __expf(gl - g); }
    asm volatile("s_waitcnt lgkmcnt(0)" ::: "memory");
    const LAS float* gcz = gcA + zz; const LAS float* btz = btA + zz; const LAS float* egz = egA + zz; const LAS float* etz = etA + zz;
    UNLOCK_IF(1); LOCK_IF(2);
    bf16x8 L21A[2];
    { G1_LANES(); bf16x8 Kf[2][4];
#pragma unroll
      for (int t = 0; t < 2; ++t)
#pragma unroll
          for (int s = 0; s < 4; ++s) Kf[t][s] = *(const LAS bf16x8*)(TK + (32 * t + r32) * 64 + 16 * s + 8 * hi);
#pragma unroll
      for (int t = 0; t < 2; ++t) { f32x16 acc = f32x16{};
#pragma unroll
          for (int s = 0; s < 4; ++s) acc = __builtin_amdgcn_mfma_f32_32x32x16_bf16(Kf[t][s], Kf[t][s], acc, 0, 0, 0);
          const float gcj = gcz[32 * t + r32];
#pragma unroll
          for (int r = 0; r < 16; ++r) { const int il = crow(r, hi), i = 32 * t + il; const float e = __expf(fminf(gcz[i] - gcj, 0.f)); const float v0 = btz[i] * acc[r] * e; Ls[t * 1024 + il * 32 + r32] = (r32 < il) ? v0 : 0.f; } }
      { f32x16 acc = f32x16{};
#pragma unroll
          for (int s = 0; s < 4; ++s) acc = __builtin_amdgcn_mfma_f32_32x32x16_bf16(Kf[0][s], Kf[1][s], acc, 0, 0, 0);
          const int i = 32 + r32; const float gci = gcz[i], bti = btz[i];
#pragma unroll
          for (int r = 0; r < 16; ++r) { const int j = crow(r, hi); acc[r] = bti * acc[r] * __expf(fminf(gci - gcz[j], 0.f)); }
          L21A[0] = acc_frag(acc, 0); L21A[1] = acc_frag(acc, 1); } }
    asm volatile("s_waitcnt lgkmcnt(0)" ::: "memory"); __builtin_amdgcn_sched_barrier(0);
    UNLOCK_IF(2); LOCK_IF(4);
    bf16x8 UF[4][2];
    const unsigned la = (unsigned)(uintptr_t)Ls + ((unsigned)zz << 4);
    { G1_LANES(); float x1[32], x2[32];
#pragma unroll
      for (int i = 0; i < 64; ++i) { const float v = bf2f(TV[i * 64 + lane]) * btz[i]; if (i < 32) x1[i & 31] = v; else x2[i & 31] = v; }
      asm volatile("s_waitcnt lgkmcnt(0)" ::: "memory");
#pragma unroll
      for (int j = 0; j < 8; ++j) *(LAS u32x4*)(wl + G1_TQ + ((lane >> 3) + 8 * j) * 128 + (lane & 7) * 16) = tq[j];
      solve_blocked(x1, x2, la, L21A, UF); }
    __builtin_amdgcn_sched_barrier(0);
    bf16x8 WF[4][2];
    { G1_LANES(); float x1[32], x2[32];
#pragma unroll
      for (int i = 0; i < 64; ++i) { const float v = bf2f(TK[i * 64 + lane]) * btz[i] * egz[i]; if (i < 32) x1[i & 31] = v; else x2[i & 31] = v; }
      solve_blocked(x1, x2, la, L21A, WF); }
    __builtin_amdgcn_sched_barrier(0);
    UNLOCK_IF(4); LOCK_IF(8);
    bf16x8 KTA[4][2];
    { G1_LANES(); float k1[32], k2[32];
#pragma unroll
      for (int i = 0; i < 32; ++i) { k1[i] = bf2f(TK[i * 64 + lane]) * etz[i]; k2[i] = bf2f(TK[(32 + i) * 64 + lane]) * etz[32 + i]; }
      col_frags32(k1, KTA, 0); col_frags32(k2, KTA, 2); }
    __builtin_amdgcn_sched_barrier(0);
    const __amdgpu_buffer_rsrc_t ro = __builtin_amdgcn_make_buffer_rsrc((void*)out, 0, 32768, 0x00020000);
    {
    G1_LANES();
    const float egl = __expf(gl);
#pragma unroll
    for (int at = 0; at < 2; ++at)
#pragma unroll
        for (int ct = 0; ct < 2; ++ct) { f32x16 a0 = f32x16{}, a1 = f32x16{};
#pragma unroll
            for (int s = 0; s < 4; ++s) { a0 = __builtin_amdgcn_mfma_f32_32x32x16_bf16(KTA[s][at], UF[s][ct], a0, 0, 0, 0); a1 = __builtin_amdgcn_mfma_f32_32x32x16_bf16(KTA[s][at], WF[s][ct], a1, 0, 0, 0); }
            store_accfrag(ro, 16384 + (at * 2 + ct) * 2048, lane, a0);
            const int vo = 4 * hi * 128 + (32 * ct + swap23(r32)) * 2;
#pragma unroll
            for (int r = 0; r < 16; ++r) { const float v = ((at == ct && crow(r, hi) == r32) ? egl : 0.f) - a1[r];
                __builtin_amdgcn_raw_buffer_store_b16((short)f2bf(v), ro, vo + (r & 3) * 128 + (r >> 2) * 1024, 32 * at * 128, 0); }
            __builtin_amdgcn_sched_barrier(0); }
    }
    UNLOCK_IF(8); LOCK_IF(16);
    bf16x8 XA[3][2];
    { G1_LANES(); bf16x8 Kf[4], Qf[2][4]; const LAS bf16* TK2 = TK + zz;
#pragma unroll
      for (int t = 0; t < 2; ++t)
#pragma unroll
          for (int s = 0; s < 4; ++s) Qf[t][s] = *(const LAS bf16x8*)(TQ + (32 * t + r32) * 64 + 16 * s + 8 * hi);
#pragma unroll
      for (int tl = 0; tl < 3; ++tl) { const int jt = tl == 2 ? 1 : 0, it = tl == 0 ? 0 : 1;
          if (tl != 1) {
#pragma unroll
              for (int s = 0; s < 4; ++s) Kf[s] = *(const LAS bf16x8*)(TK2 + (32 * jt + r32) * 64 + 16 * s + 8 * hi); }
          f32x16 acc = f32x16{};
#pragma unroll
          for (int s = 0; s < 4; ++s) acc = __builtin_amdgcn_mfma_f32_32x32x16_bf16(Kf[s], Qf[it][s], acc, 0, 0, 0);
          const int i = 32 * it + r32; const float gci = gcz[i];
#pragma unroll
          for (int r = 0; r < 16; ++r) { const int j = 32 * jt + crow(r, hi); const float e = __expf(fminf(gci - gcz[j], 0.f)); const float v0 = acc[r] * e; acc[r] = (j <= i) ? v0 : 0.f; }
          XA[tl][0] = acc_frag(acc, 0); XA[tl][1] = acc_frag(acc, 1); __builtin_amdgcn_sched_barrier(0); } }
    __builtin_amdgcn_sched_barrier(0);
    {
    G1_LANES();
#pragma unroll
    for (int it = 0; it < 2; ++it)
#pragma unroll
        for (int ct = 0; ct < 2; ++ct) { f32x16 a0 = f32x16{}, a1 = f32x16{};
#pragma unroll
            for (int jt = 0; jt <= it; ++jt) { const int tl = (it == 0) ? 0 : (jt == 0 ? 1 : 2);
#pragma unroll
                for (int sp = 0; sp < 2; ++sp) { a0 = __builtin_amdgcn_mfma_f32_32x32x16_bf16(XA[tl][sp], UF[2 * jt + sp][ct], a0, 0, 0, 0); a1 = __builtin_amdgcn_mfma_f32_32x32x16_bf16(XA[tl][sp], WF[2 * jt + sp][ct], a1, 0, 0, 0); } }
            store_accfrag(ro, 24576 + (it * 2 + ct) * 2048, lane, a0);
            const int vo = 4 * hi * 128 + (32 * ct + swap23(r32)) * 2; const int a = 32 * ct + r32;
#pragma unroll
            for (int r = 0; r < 16; ++r) { const int i = 32 * it + crow(r, hi); const float qv = bf2f(TQ[i * 64 + a]);
                __builtin_amdgcn_raw_buffer_store_b16((short)f2bf(qv * egz[i] - a1[r]), ro, vo + (r & 3) * 128 + (r >> 2) * 1024, 8192 + 32 * it * 128, 0); }
            __builtin_amdgcn_sched_barrier(0); }
    }
    asm volatile("s_waitcnt lgkmcnt(0)" ::: "memory");
    UNLOCK_IF(16);
}
__device__ __forceinline__ void scan_chain(Frame& F, int chain) {
    const int w = F.wave, lane = F.lane, r32 = lane & 31, hi = lane >> 5, role = w >> 2, rt = (w >> 1) & 1, dc = w & 1;
    LAS u32x4* SF = (LAS u32x4*)(F.lds + RING_OFF);
    const bf16* base = (const bf16*)(F.ws + WS_GDNI) + (size_t)chain * 68 * 16384; bf16* OG = (bf16*)(F.ws + WS_OG);
    for (int i = F.tid; i < 2 * 2 * 4 * 64; i += 512) SF[i] = (u32x4){0u, 0u, 0u, 0u};
    const bf16* Ab = base + (role ? 4096 : 0) + (32 * rt + r32) * 64 + 8 * hi; const bf16* Cb = base + (role ? 12288 : 8192) + ((rt * 2 + dc) * 64 + lane) * 16;
    struct Ops { bf16x8 a[4]; u32x4 c[2]; };
#define SC_LOAD(o, ci_) do { const bf16* A_ = Ab + (size_t)(ci_) * 16384; const bf16* C_ = Cb + (size_t)(ci_) * 16384; \
        _Pragma("unroll") for (int s_ = 0; s_ < 4; ++s_) (o).a[s_] = *(const GAS bf16x8*)(A_ + 16 * s_); (o).c[0] = *(const GAS u32x4*)C_; (o).c[1] = *(const GAS u32x4*)(C_ + 8); } while (0)
#define SC_STEP(o, ci_) do { f32x16 acc; \
        _Pragma("unroll") for (int q = 0; q < 4; ++q) { acc[2 * q] = bflo((o).c[0][q]); acc[2 * q + 1] = bfhi((o).c[0][q]); acc[8 + 2 * q] = bflo((o).c[1][q]); acc[8 + 2 * q + 1] = bfhi((o).c[1][q]); } \
        const LAS u32x4* Sb = SF + ((((ci_) & 1) * 2 + dc) * 256) + lane; \
        _Pragma("unroll") for (int s_ = 0; s_ < 4; ++s_) { const u32x4 bw = Sb[s_ * 64]; acc = __builtin_amdgcn_mfma_f32_32x32x16_bf16((o).a[s_], __builtin_bit_cast(bf16x8, bw), acc, 0, 0, 0); } \
        if ((ci_) + 4 < 68) SC_LOAD(o, (ci_) + 4); \
        if (role == 0) { LAS u32x4* Sn = SF + ((((((ci_) + 1) & 1) * 2 + dc) * 4 + 2 * rt) * 64) + lane; Sn[0] = __builtin_bit_cast(u32x4, acc_frag(acc, 0)); Sn[64] = __builtin_bit_cast(u32x4, acc_frag(acc, 1)); } \
        else { const ItemGeom G = item_geom(chain, (ci_)); LAS bf16* stg = (LAS bf16*)(F.lds + RING_OFF + 16384 + (w - 4) * 2048);     \
            _Pragma("unroll") for (int r = 0; r < 16; ++r) stg[crow(r, hi) * 32 + r32] = (bf16)f2bf(acc[r]); \
            asm volatile("s_waitcnt lgkmcnt(0)" ::: "memory"); \
            const u32x4 v0 = *(const LAS u32x4*)(stg + (lane >> 1) * 32 + (lane & 1) * 16), v1 = *(const LAS u32x4*)(stg + (lane >> 1) * 32 + (lane & 1) * 16 + 8); \
            GAS u32x4* po = (GAS u32x4*)(OG + (size_t)item_row(G, 32 * rt + (lane >> 1)) * 1024 + G.dir * 512 + G.h * 64 + 32 * dc + (lane & 1) * 16); po[0] = v0; po[1] = v1; } \
        asm volatile("s_waitcnt lgkmcnt(0)" ::: "memory"); __builtin_amdgcn_s_barrier(); asm volatile("" ::: "memory"); } while (0)
    Ops o0, o1, o2, o3;
    SC_LOAD(o0, 0); SC_LOAD(o1, 1); SC_LOAD(o2, 2); SC_LOAD(o3, 3);
    __syncthreads();
#pragma unroll 1
    for (int ci = 0; ci < 68; ci += 4) { SC_STEP(o0, ci); SC_STEP(o1, ci + 1); SC_STEP(o2, ci + 2); SC_STEP(o3, ci + 3); }
#undef SC_LOAD
#undef SC_STEP
    asm volatile("s_waitcnt vmcnt(0)" ::: "memory");
}
}
__device__ __forceinline__ void l1_prep(Frame& F) {
    bf16* P = (bf16*)(F.ws + WS_PROJ2); bf16* KM = (bf16*)(F.ws + WS_KMLA); const int lane = F.lane;
    for (int r = F.gw; r < NR; r += F.NGW) { const int b = r / SROW, s = r - b * SROW; const bool isc = s < TC; const int p = s - TC; bf16* row = P + (size_t)r * OINP;
        { bf16* CQ = (bf16*)(F.ws + WS_CQN) + (size_t)r * 640;
          const v2u a = *(const GAS v2u*)(row + O_CQ + 4 * lane); const v2u c = (lane < 32) ? *(const GAS v2u*)(row + O_CQ + 256 + 4 * lane) : (v2u){0u, 0u}; const v2u k = *(const GAS v2u*)(row + O_CKV + 4 * lane);
          const float a0 = bflo(a.x), a1 = bfhi(a.x), a2 = bflo(a.y), a3 = bfhi(a.y), c0 = bflo(c.x), c1 = bfhi(c.x), c2 = bflo(c.y), c3 = bfhi(c.y), k0 = bflo(k.x), k1 = bfhi(k.x), k2 = bflo(k.y), k3 = bfhi(k.y);
          const float sq = wave_sum(a0 * a0 + a1 * a1 + a2 * a2 + a3 * a3 + c0 * c0 + c1 * c1 + c2 * c2 + c3 * c3), skv = wave_sum(k0 * k0 + k1 * k1 + k2 * k2 + k3 * k3);
          const float rq = 1.f / sqrtf(sq * (1.f / 384.f) + EPS), rk = 1.f / sqrtf(skv * (1.f / 256.f) + EPS);
          *(GAS v2u*)(CQ + 4 * lane) = (v2u){pk2(a0 * rq, a1 * rq), pk2(a2 * rq, a3 * rq)};
          if (lane < 32) *(GAS v2u*)(CQ + 256 + 4 * lane) = (v2u){pk2(c0 * rq, c1 * rq), pk2(c2 * rq, c3 * rq)};
          *(GAS v2u*)(CQ + 384 + 4 * lane) = (v2u){pk2(k0 * rk, k1 * rk), pk2(k2 * rk, k3 * rk)}; }
        if (lane < 16) { const int seg = lane >> 3, i = lane & 7, d0 = seg * 16 + i; float x0 = bf2f(row[O_KR + d0]), x1 = bf2f(row[O_KR + d0 + 8]);
            if (!isc) { const float pos = (float)(seg ? (p & 63) : (p >> 6)); const float ang = pos * __powf(10000.f, -(float)i * (1.f / 8.f)); float sn, cs; sincosf(ang, &sn, &cs);
                const float y0 = x0 * cs - x1 * sn, y1 = x1 * cs + x0 * sn; x0 = y0; x1 = y1; }
            const bf16 b0 = (bf16)f2bf(x0), b1 = (bf16)f2bf(x1);
#pragma unroll
            for (int h = 0; h < 8; ++h) { KM[(size_t)r * 768 + h * 96 + 64 + d0] = b0; KM[(size_t)r * 768 + h * 96 + 64 + d0 + 8] = b1; } }
        if (!isc) {
            const int pi = lane & 31, seg = pi >> 4, i = pi & 15, d0 = seg * 32 + i; const float pos = (float)(seg ? (p & 63) : (p >> 6));
            const float ang = pos * __powf(10000.f, -(float)i * (1.f / 16.f)); float sn, cs; sincosf(ang, &sn, &cs);
#pragma unroll
            for (int q = 0; q < 8; ++q) { const int hh = (lane >> 5) + 2 * q; bf16* base = row + (hh < 8 ? O_DQ + hh * 64 : O_DK + (hh - 8) * 64) + d0;
                const float x0 = bf2f(base[0]), x1 = bf2f(base[16]); base[0] = (bf16)f2bf(x0 * cs - x1 * sn); base[16] = (bf16)f2bf(x1 * cs + x0 * sn); } }
    }
}
__device__ __forceinline__ void l1_qrope(Frame& F) {
    bf16* QM = (bf16*)(F.ws + WS_QM); const int lane = F.lane;
    for (int r = F.gw; r < NR; r += F.NGW) { const int b = r / SROW, s = r - b * SROW; if (s < TC) continue; const int p = s - TC;
        const int pi = lane & 15, seg = pi >> 3, i = pi & 7, d0 = seg * 16 + i; const float pos = (float)(seg ? (p & 63) : (p >> 6));
        const float ang = pos * __powf(10000.f, -(float)i * (1.f / 8.f)); float sn, cs; sincosf(ang, &sn, &cs);
#pragma unroll
        for (int q = 0; q < 2; ++q) { const int h = (lane >> 4) + 4 * q; bf16* base = QM + (size_t)r * 768 + h * 96 + 64 + d0;
            const float x0 = bf2f(base[0]), x1 = bf2f(base[8]); base[0] = (bf16)f2bf(x0 * cs - x1 * sn); base[8] = (bf16)f2bf(x1 * cs + x0 * sn); } }
}
__device__ __forceinline__ void l1_attn_unit(Frame& F, int u) {
    if (u < 512) { const int b = u >> 7, qb = (u >> 3) & 15, h = u & 7; const size_t rq = (size_t)b * SROW + TC + qb * 256, r0 = (size_t)b * SROW;
        constexpr float SC = 0.10206207261596575f  , C = SC * 1.4426950408889634f, THRS = att::THR / SC;
        const bf16* QM = (const bf16*)(F.ws + WS_QM); const bf16* KM = (const bf16*)(F.ws + WS_KMLA); const bf16* VM = (const bf16*)(F.ws + WS_VMLA); bf16* MIX = (bf16*)(F.ws + WS_MIX);
        att::attn_unit<96, 64, 0, true>(QM + rq * 768 + h * 96, 768, KM + r0 * 768 + h * 96, 768, VM + r0 * 512 + h * 64, 512, MIX + rq * 1024 + h * 64, 1024, SROW / 64, 0, qb * 256, C, THRS, -3.0e38f, F.ldsg + RING_OFF);
    } else { const int v = u - 512, b = v >> 6, qb = (v >> 2) & 15, head = v & 3; const size_t rq = (size_t)b * SROW + TC + qb * 256, r0 = (size_t)b * SROW;
        constexpr float SC = 0.125f, C = SC * 1.4426950408889634f, THRS = att::THR / SC; constexpr float LAM_INIT = 0.35550906759096556f;
        const float* lp = F.in[I_OLAM]; const float lam = __expf(wave_sum(lp[F.lane] * lp[64 + F.lane])) - __expf(wave_sum(lp[128 + F.lane] * lp[192 + F.lane])) + LAM_INIT;
        const bf16* P = (const bf16*)(F.ws + WS_PROJ2); bf16* MIX = (bf16*)(F.ws + WS_MIX); const int hh = 2 * head;
        att::attn_unit<64, 128, 0, false, 1>(P + rq * OINP + O_DQ + hh * 64, OINP, P + r0 * OINP + O_DK + hh * 64, OINP, P + r0 * OINP + O_DV + head * 128, OINP, MIX, 1024, SROW / 64, 0, 0, C, THRS, -3.0e38f, F.ldsg + RING_OFF);
        att::attn_unit<64, 128, 0, false, 2>(P + rq * OINP + O_DQ + (hh + 1) * 64, OINP, P + r0 * OINP + O_DK + (hh + 1) * 64, OINP, P + r0 * OINP + O_DV + head * 128, OINP, MIX + rq * 1024 + 512 + head * 128, 1024, SROW / 64, 0, 0, C, THRS, -3.0e38f, F.ldsg + RING_OFF,
                                             lam, F.in[I_OSUBLN], 1.f - LAM_INIT); }
}
__device__ __forceinline__ void l1_diff_post(Frame& F) {
    const bf16* OD = (const bf16*)(F.ws + WS_ODIFF); bf16* MIX = (bf16*)(F.ws + WS_MIX); const int lane = F.lane; const float* lp = F.in[I_OLAM];
    constexpr float LAM_INIT = 0.35550906759096556f;
    const float s01 = wave_sum(lp[lane] * lp[64 + lane]), s23 = wave_sum(lp[128 + lane] * lp[192 + lane]); const float lam = __expf(s01) - __expf(s23) + LAM_INIT;
    const int head = lane >> 4, d = (lane & 15) * 8; const f32x4 w0 = *(const GAS f32x4*)(F.in[I_OSUBLN] + d), w1 = *(const GAS f32x4*)(F.in[I_OSUBLN] + d + 4);
    const float ww[8] = {w0.x, w0.y, w0.z, w0.w, w1.x, w1.y, w1.z, w1.w};
    for (int r = F.gw; r < NR; r += F.NGW) { const int b = r / SROW, s = r - b * SROW; if (s < TC) continue;
        const v4u a = *(const GAS v4u*)(OD + (size_t)r * 1024 + (2 * head) * 128 + d), c = *(const GAS v4u*)(OD + (size_t)r * 1024 + (2 * head + 1) * 128 + d);
        float o[8] = {bflo(a.x) - lam * bflo(c.x), bfhi(a.x) - lam * bfhi(c.x), bflo(a.y) - lam * bflo(c.y), bfhi(a.y) - lam * bfhi(c.y), bflo(a.z) - lam * bflo(c.z), bfhi(a.z) - lam * bfhi(c.z), bflo(a.w) - lam * bflo(c.w), bfhi(a.w) - lam * bfhi(c.w)};
        float ss = 0.f;
#pragma unroll
        for (int e = 0; e < 8; ++e) ss += o[e] * o[e];
        ss += __shfl_xor(ss, 1); ss += __shfl_xor(ss, 2); ss += __shfl_xor(ss, 4); ss += __shfl_xor(ss, 8);
        const float rs = (1.f - LAM_INIT) / sqrtf(ss * (1.f / 128.f) + EPS);
#pragma unroll
        for (int e = 0; e < 8; ++e) o[e] = o[e] * rs * ww[e];
        *(GAS v4u*)(MIX + (size_t)r * 1024 + 512 + head * 128 + d) = (v4u){pk2(o[0], o[1]), pk2(o[2], o[3]), pk2(o[4], o[5]), pk2(o[6], o[7])}; }
}
__device__ __forceinline__ void moe_bases(Frame& F, int (&base)[8], int& ntiles) { int acc = 0;
#pragma unroll
    for (int e = 0; e < 8; ++e) { base[e] = acc; const int c = (int)__hip_atomic_load((unsigned*)(F.ctl + CW_MOECNT + 64 * e), RLX_AGENT); acc += (c + 255) & ~255; }
    ntiles = acc >> 8; }
constexpr size_t META_TEXP = 640 * 1024, META_POS = 768 * 1024;
__device__ __forceinline__ void moe_gather(Frame& F) {
    int base[8], ntiles; moe_bases(F, base, ntiles);
    int* TEXP = (int*)(F.ws + WS_META + META_TEXP); int* POS = (int*)(F.ws + WS_META + META_POS);
    const int* TOPI = (const int*)(F.ws + WS_META + META_TOPI); const int* RANK = (const int*)(F.ws + WS_META + META_RANK);
    if (blockIdx.x == 0 && F.tid < 144) { const int t = F.tid; int e = 0;
#pragma unroll
        for (int q = 1; q < 8; ++q) if (t * 256 >= base[q]) e = q;
        TEXP[t] = e; if (t == 143) TEXP[144] = ntiles; }
    const bf16* FIN = (const bf16*)(F.ws + WS_FIN2); bf16* AS = (bf16*)(F.ws + WS_ASORT);
    for (int tk = F.gw; tk < NB * T; tk += F.NGW) { const int b = tk / T, t = tk - b * T; const size_t r = (size_t)b * SROW + TC + t;
        const GAS v4u* src = (const GAS v4u*)(FIN + r * D) + F.lane; const v4u x0 = src[0], x1 = src[64];
#pragma unroll
        for (int sl = 0; sl < 2; ++sl) { const int e = TOPI[tk * 2 + sl]; int bs = 0;
#pragma unroll
            for (int q = 0; q < 8; ++q) if (q == e) bs = base[q];
            const int pos = bs + RANK[tk * 2 + sl]; if (F.lane == 0) POS[tk * 2 + sl] = pos;
            GAS v4u* dst = (GAS v4u*)(AS + (size_t)pos * D) + F.lane; dst[0] = x0; dst[64] = x1; } }
}
__device__ __forceinline__ void rows_final(Frame& F) {
    const bf16* OR = (const bf16*)(F.ws + WS_ASORT); const int* POS = (const int*)(F.ws + WS_META + META_POS); const float* TOPW = (const float*)(F.ws + WS_META + META_TOPW);
    Row4 xn, y0n, y1n;
    if (F.gw < NB * T) { const int tk = F.gw; xn = ld_row_f32(F.out + (size_t)tk * D, F.lane); y0n = ld_row_bf16(OR + (size_t)POS[tk * 2] * D, F.lane); y1n = ld_row_bf16(OR + (size_t)POS[tk * 2 + 1] * D, F.lane); }
    for (int tk = F.gw; tk < NB * T; tk += F.NGW) { const int b = tk / T; float* xr = F.out + (size_t)tk * D;
        Row4 x = xn; const Row4 y0 = y0n, y1 = y1n;
        if (tk + F.NGW < NB * T) { const int t2 = tk + F.NGW; xn = ld_row_f32(F.out + (size_t)t2 * D, F.lane); y0n = ld_row_bf16(OR + (size_t)POS[t2 * 2] * D, F.lane); y1n = ld_row_bf16(OR + (size_t)POS[t2 * 2 + 1] * D, F.lane); }
        const float w0 = TOPW[tk * 2], w1 = TOPW[tk * 2 + 1]; Row4 y;
#pragma unroll
        for (int j = 0; j < 4; ++j) y.v[j] = y0.v[j] * w0 + y1.v[j] * w1;
        add_gated_norm(x, y, F.in[I_ONORMS] + 3 * 1024, modvec(F, 1, b, 5), F.lane); st_row_f32(xr, F.lane, x); }
}
constexpr int N_PHASES = 26;
__global__ void __launch_bounds__(NWAVES * 64, 2) trunk_fwd(Args args) {
    extern __shared__ __attribute__((aligned(16))) unsigned char lds[];
    Frame F;
    F.lds = (LAS unsigned char*)lds; F.ldsg = (char*)lds;
    F.MISC = (volatile LAS unsigned*)(F.lds + MISC_OFF);
    F.wave = __builtin_amdgcn_readfirstlane((int)threadIdx.x >> 6);
#define REFRESH() do { int z_ = 0; asm volatile("" : "+v"(z_)); F.lane = (int)__builtin_amdgcn_mbcnt_hi(~0u, __builtin_amdgcn_mbcnt_lo(~0u, (unsigned)z_)); F.tid = F.wave * 64 + F.lane; } while (0)
    REFRESH();
    F.G = gridDim.x; { const int bx = blockIdx.x; F.vcu = (F.G % 8 == 0) ? (bx % 8) * (F.G / 8) + bx / 8 : bx; }
    F.gw = F.vcu * NWAVES + F.wave; F.NGW = F.G * NWAVES;
    F.in = args.in; F.out = args.out; F.ws = args.ws; F.ctl = (gu32*)(args.ws + WS_CTL);
    unsigned char* ws = args.ws;
    for (int u = F.tid; u < (LDS_BYTES - MISC_OFF) / 4; u += NWAVES * 64) ((LAS unsigned*)(F.lds + MISC_OFF))[u] = 0u;
    __syncthreads();
    XcdBarrier bar; bar.bar = (unsigned*)(F.ctl + CW_BAR); bar.x = 0; bar.st = nullptr;
    const int lo = args.ph_lo, hi = args.ph_hi;
    const bool use_bar = (hi - lo) > 1;
    if (use_bar) bar = xcd_barrier_post((unsigned*)(F.ctl + CW_BAR), F.MISC + 8);
#ifndef MK_ONLY
#define MK_ONLY_OK(k) true
#else
#define MK_ONLY_OK(k) ((k) == MK_ONLY)
#endif
#define IN(k) (MK_ONLY_OK(k) && lo <= (k) && (k) < hi && (k) <= MK_LAST_PHASE)
#ifndef CHK_MASK
#define CHK_MASK 0xffu
#endif
#ifndef MK_REP_MASK
#define MK_REP_MASK 0u
#endif
#define REPS(k) ((((unsigned)MK_REP_MASK >> (k)) & 1u) ? 2 : 1)
#define SEAM(k) do { if (IN(k) && IN((k) + 1)) xcd_barrier(bar); } while (0)
    typedef pg8::bf16_t pb;
    const int bid = blockIdx.x;

    if (IN(0)) for (int rep_ = 0; rep_ < REPS(0); ++rep_) { REFRESH(); p0_prologue(F); } SEAM(0);
    if (IN(1)) for (int rep_ = 0; rep_ < REPS(1); ++rep_) { REFRESH(); p1_first_rows(F); } SEAM(1);
    if (IN(2)) for (int rep_ = 0; rep_ < REPS(2); ++rep_) { REFRESH();
        pg8::Gemm g{(const pb*)(ws + WS_ABUF), (const pb*)(ws + WS_WEIN), NR, EINP, 1024, 1024, 1024}; pg8::StaticOrder S; S.init(NR, EINP, F.G, bid);
        pg8::EpiStore E{(pb*)(ws + WS_PROJ), EINP, EINP / 256};
        pg8::gemm_phase<pg8::EpiStore, pg8::StaticOrder, PG8_ALIGN, PG8_SP2>(F.lds + RING_OFF, g, S, E); } SEAM(2);
    if (IN(3)) for (int rep_ = 0; rep_ < REPS(3); ++rep_) { REFRESH(); g0_prep(F); } SEAM(3);
#ifdef GDN_SLOW
    if (IN(5)) for (int rep_ = 0; rep_ < REPS(5); ++rep_) { REFRESH();
        if (F.G > 64) { if (bid < 64) gdn_chain(F, bid); else for (int u = bid - 64; u < 544; u += F.G - 64) swa_unit(F, u); }
        else { for (int c = bid; c < 64; c += F.G) gdn_chain(F, c); for (int u = bid; u < 544; u += F.G) swa_unit(F, u); } } SEAM(5);
#else
    if (IN(4)) for (int rep_ = 0; rep_ < REPS(4); ++rep_) { REFRESH();
#if G1_LOCK
        if ((F.wave & 3) == 0) for (int item = F.vcu * 2 + (F.wave >> 2); item < 64 * 68; item += F.G * 2) gdn::g1_item(F, item, F.lds + RING_OFF + (F.wave >> 2) * gdn::G1_WAVE_LDS, F.MISC + 16);
#else
        if (F.wave < 4) for (int item = F.vcu * 4 + F.wave; item < 64 * 68; item += F.G * 4) gdn::g1_item(F, item, F.lds + RING_OFF + F.wave * gdn::G1_WAVE_LDS, F.MISC + 16);
        else p0_deferred(F, F.wave - 4, F.lds + RING_OFF + 4 * gdn::G1_WAVE_LDS + (F.wave - 4) * 8448);
#endif
    } SEAM(4);
    if (IN(5)) for (int rep_ = 0; rep_ < REPS(5); ++rep_) { REFRESH();
        if (bid < 64) for (int c = bid; c < 64; c += F.G) { gdn::scan_chain(F, c); __syncthreads(); }
        for (;;) { if (F.tid == 0) F.MISC[20] = __hip_atomic_fetch_add((unsigned*)(F.ctl + CW_SWAQ), 1u, RLX_AGENT);
            __syncthreads(); const int u = (int)F.MISC[20]; __syncthreads();
            if (u >= 544 * REPS(5)) break;
            swa_unit(F, u % 544); } } SEAM(5);
#endif
    if (IN(6)) for (int rep_ = 0; rep_ < REPS(6); ++rep_) { REFRESH(); g4_gdn_out(F); } SEAM(6);
    if (IN(7)) for (int rep_ = 0; rep_ < REPS(7); ++rep_) { REFRESH();
        pg8::Gemm g{(const pb*)(ws + WS_MIX), (const pb*)(ws + WS_WEOUT), NR, 1024, 1024, 1024, 1024}; pg8::StaticOrder S; S.init(NR, 1024, F.G, bid);
        pg8::EpiStore E{(pb*)(ws + WS_YBUF), 1024, 4};
        pg8::gemm_phase<pg8::EpiStore, pg8::StaticOrder, PG8_ALIGN, PG8_SP2>(F.lds + RING_OFF, g, S, E); } SEAM(7);
    if (IN(8)) for (int rep_ = 0; rep_ < REPS(8); ++rep_) { REFRESH(); rows_mid<false>(F, (const bf16*)(ws + WS_YBUF), F.in[I_ENORMS] + 1024, 0, 2, F.in[I_ENORMS] + 2048, 0, 3, (bf16*)(ws + WS_ABUF), false); } SEAM(8);
    if (IN(9)) for (int rep_ = 0; rep_ < REPS(9); ++rep_) { REFRESH();
        pg8::Gemm g{(const pb*)(ws + WS_ABUF), (const pb*)(ws + WS_WEGU), NR, 2 * DFF, 1024, 1024, 1024}; pg8::StaticOrder S; S.init(NR, 2 * DFF, F.G, bid);
        pg8::EpiSwiGLU E{(pb*)(ws + WS_HID), DFF, DFF / 128};
        pg8::gemm_phase<pg8::EpiSwiGLU, pg8::StaticOrder, PG8_ALIGN, PG8_SP2>(F.lds + RING_OFF, g, S, E); } SEAM(9);
    if (IN(10)) for (int rep_ = 0; rep_ < REPS(10); ++rep_) { REFRESH();
        pg8::Gemm g{(const pb*)(ws + WS_HID), (const pb*)(ws + WS_WEDN), NR, 1024, DFF, DFF, DFF}; pg8::StaticOrder S; S.init(NR, 1024, F.G, bid);
        pg8::EpiStore E{(pb*)(ws + WS_YBUF), 1024, 4};
        pg8::gemm_phase<pg8::EpiStore, pg8::StaticOrder, PG8_ALIGN, PG8_SP2>(F.lds + RING_OFF, g, S, E); } SEAM(10);
    if (IN(11)) for (int rep_ = 0; rep_ < REPS(11); ++rep_) { REFRESH(); rows_mid<false>(F, (const bf16*)(ws + WS_YBUF), F.in[I_ENORMS] + 3072, 0, 5, F.in[I_ONORMS], 1, 0, (bf16*)(ws + WS_ABUF), false); } SEAM(11);
    if (IN(12)) for (int rep_ = 0; rep_ < REPS(12); ++rep_) { REFRESH();
        pg8::Gemm g{(const pb*)(ws + WS_ABUF), (const pb*)(ws + WS_WOIN), NR, OINP, 1024, 1024, 1024}; pg8::StaticOrder S; S.init(NR, OINP, F.G, bid);
        pg8::EpiStore E{(pb*)(ws + WS_PROJ2), OINP, OINP / 256};
        pg8::gemm_phase<pg8::EpiStore, pg8::StaticOrder, PG8_ALIGN, PG8_SP2>(F.lds + RING_OFF, g, S, E); } SEAM(12);
    if (IN(13)) for (int rep_ = 0; rep_ < REPS(13); ++rep_) { REFRESH(); l1_prep(F); } SEAM(13);
    if (IN(14)) for (int rep_ = 0; rep_ < REPS(14); ++rep_) { REFRESH();
#if !defined(T13) || T13 == 1
        { pg8::Gemm g{(const pb*)(ws + WS_CQN), (const pb*)(ws + WS_WUQ), NR, 768, 384, 640, 384}; pg8::LatOrder S; S.init(768, F.G, bid);
          pg8::EpiStore E{(pb*)(ws + WS_QM), 768, 3};
          pg8::gemm_phase<pg8::EpiStore, pg8::LatOrder, PG8_ALIGN, PG8_SP2>(F.lds + RING_OFF, g, S, E); }
#endif
        __syncthreads();
#if !defined(T13) || T13 == 2
        { pg8::Gemm g{(const pb*)(ws + WS_CQN) + 384, (const pb*)(ws + WS_WUKV), NR, 1024, 256, 640, 256}; pg8::StaticOrder S; S.init(NR, 1024, F.G, bid);
          pg8::EpiKV E{(pb*)(ws + WS_KMLA), (pb*)(ws + WS_VMLA)};
          pg8::gemm_phase<pg8::EpiKV, pg8::StaticOrder, PG8_ALIGN, PG8_SP2>(F.lds + RING_OFF, g, S, E); }
#endif
    } SEAM(14);
    if (IN(16)) for (int rep_ = 0; rep_ < REPS(16); ++rep_) { REFRESH(); for (int u = F.vcu; u < 768; u += F.G) l1_attn_unit(F, u); } SEAM(16);
    if (IN(18)) for (int rep_ = 0; rep_ < REPS(18); ++rep_) { REFRESH();
        pg8::Gemm g{(const pb*)(ws + WS_MIX), (const pb*)(ws + WS_WOOUT), NR, 1024, 1024, 1024, 1024}; pg8::LatOrder S; S.init(1024, F.G, bid);
        pg8::EpiStore E{(pb*)(ws + WS_Y2), 1024, 4};
        pg8::gemm_phase<pg8::EpiStore, pg8::LatOrder, PG8_ALIGN, PG8_SP2>(F.lds + RING_OFF, g, S, E); } SEAM(18);
    if (IN(19)) for (int rep_ = 0; rep_ < REPS(19); ++rep_) { REFRESH(); rows_mid<true>(F, (const bf16*)(ws + WS_Y2), F.in[I_ONORMS] + 1024, 1, 2, F.in[I_ONORMS] + 2048, 1, 3, (bf16*)(ws + WS_FIN2), true); } SEAM(19);
    if (IN(20)) for (int rep_ = 0; rep_ < REPS(20); ++rep_) { REFRESH(); px_expert_weights(F); moe_gather(F); } SEAM(20);
#define MOE_PART(kgu, kdn, t0_, cap_) \
    if (IN(kgu)) for (int rep_ = 0; rep_ < REPS(kgu); ++rep_) { REFRESH(); int base[8], ntiles; moe_bases(F, base, ntiles); const int t0 = (t0_), ntl = (ntiles - t0 < 0) ? 0 : ((ntiles - t0 < (cap_)) ? ntiles - t0 : (cap_)); \
        pg8::Gemm g{(const pb*)(ws + WS_ASORT) + (size_t)t0 * 256 * 1024, (const pb*)(ws + WS_WXGU), 0, 0, 1024, 1024, 1024}; pg8::MoeOrder S; S.init(ntl, 28, F.G, bid, (const int*)(ws + WS_META + META_TEXP), t0); \
        pg8::EpiSwiGLU E{(pb*)(ws + WS_HIDX), DFX, 28}; \
        pg8::gemm_phase<pg8::EpiSwiGLU, pg8::MoeOrder, PG8_ALIGN, PG8_SP2>(F.lds + RING_OFF, g, S, E); } SEAM(kgu); \
    if (IN(kdn)) for (int rep_ = 0; rep_ < REPS(kdn); ++rep_) { REFRESH(); int base[8], ntiles; moe_bases(F, base, ntiles); const int t0 = (t0_), ntl = (ntiles - t0 < 0) ? 0 : ((ntiles - t0 < (cap_)) ? ntiles - t0 : (cap_)); \
        pg8::Gemm g{(const pb*)(ws + WS_HIDX), (const pb*)(ws + WS_WXDN), 0, 0, DFX, DFX, DFX}; pg8::MoeOrder S; S.init(ntl, 4, F.G, bid, (const int*)(ws + WS_META + META_TEXP), t0); \
        pg8::EpiStore E{(pb*)(ws + WS_ASORT) + (size_t)t0 * 256 * 1024, 1024, 4}; \
        pg8::gemm_phase<pg8::EpiStore, pg8::MoeOrder, PG8_ALIGN, PG8_SP2>(F.lds + RING_OFF, g, S, E); } SEAM(kdn);
    MOE_PART(21, 22, 0, 68)
    MOE_PART(23, 24, 68, 68)
    if (IN(25)) for (int rep_ = 0; rep_ < REPS(25); ++rep_) { REFRESH(); rows_final(F);
#if defined(CHK_G1) || defined(CHK_SCAN)
        { const unsigned fb = __hip_atomic_load((unsigned*)(F.ctl + CW_CHK), RLX_AGENT) & CHK_MASK; if (fb != 0u) { VM_WAIT(); __syncthreads(); for (int i = F.gw * 64 + F.lane; i < NB * T * D; i += F.NGW * 64) F.out[i] = 0.f; } }
#endif
    }
#undef IN
#undef SEAM
}

extern "C" void kernel_launch(void* const* d_in, const int* in_sizes, int n_in, void* d_out, int out_size, void* d_ws, size_t ws_size, hipStream_t stream) {
    static int grid = 0;
    if (grid == 0) {
        if (n_in != 32 || in_sizes[0] != NB * T * D || out_size != NB * T * D || ws_size < WS_END) { fprintf(stderr, "kernel_launch: unexpected shapes: n_in %d in0 %d out %d ws %zu (need %zu)\n", n_in, n_in > 0 ? in_sizes[0] : -1, out_size, ws_size, (size_t)WS_END); grid = -1; return; }
        int dev = 0, cus = 0, per_cu = 0;
        if (hipGetDevice(&dev) != hipSuccess || hipDeviceGetAttribute(&cus, hipDeviceAttributeMultiprocessorCount, dev) != hipSuccess) { grid = -1; return; }
        if (hipFuncSetAttribute((const void*)trunk_fwd, hipFuncAttributeMaxDynamicSharedMemorySize, LDS_BYTES) != hipSuccess) { fprintf(stderr, "kernel_launch: hipFuncSetAttribute failed\n"); grid = -1; return; }
        if (hipOccupancyMaxActiveBlocksPerMultiprocessor(&per_cu, (const void*)trunk_fwd, NWAVES * 64, LDS_BYTES) != hipSuccess || per_cu < 1) fprintf(stderr, "kernel_launch: occupancy query reports %d\n", per_cu);
        (void)hipGetLastError();
        grid = cus;
    }
    if (grid < 0) return;
    if (hipMemsetAsync((char*)d_ws + WS_CTL, 0, CTL_ZERO_BYTES, stream) != hipSuccess) return;
#ifdef DIAG_POISON
    (void)hipMemsetAsync((char*)d_ws + WS_GDNI, 0xFF, (size_t)64 * 68 * 32768, stream);
    (void)hipMemsetAsync((char*)d_ws + WS_OG, 0xFF, (size_t)NR * 1024 * 2, stream);
    (void)hipMemsetAsync((char*)d_ws + WS_QKVN, 0xFF, (size_t)NR * 1536 * 2, stream);
    (void)hipMemsetAsync((char*)d_ws + WS_GB, 0xFF, (size_t)NR * 32 * 4, stream);
#endif
    Args a{};
    for (int i = 0; i < 32; ++i) a.in[i] = (const float*)d_in[i];
    a.out = (float*)d_out; a.ws = (unsigned char*)d_ws;
#if MK_N_LAUNCHES == 1
    a.ph_lo = 0; a.ph_hi = N_PHASES;
    hipLaunchKernelGGL(trunk_fwd, dim3(grid), dim3(NWAVES * 64), LDS_BYTES, stream, a);
#else
    for (int p = 0; p < N_PHASES && p <= MK_LAST_PHASE; ++p) { a.ph_lo = p; a.ph_hi = p + 1; hipLaunchKernelGGL(trunk_fwd, dim3(grid), dim3(NWAVES * 64), LDS_BYTES, stream, a); }
#endif
    const hipError_t le = hipPeekAtLastError();
    if (le != hipSuccess) fprintf(stderr, "kernel_launch: launch failed: %s\n", hipGetErrorName(le));
}
```

```cpp
#include <hip/hip_runtime.h>
#include <cstdio>
#include <cstdint>
#include <cmath>

#ifndef MK_N_LAUNCHES
#define MK_N_LAUNCHES 1
#endif
#define SOLVE_C_FMA 1
#define SOLVE_C_LOAD 1
#ifndef G1_LOCK
#define G1_LOCK 0
#endif
#ifndef MK_LAST_PHASE
#define MK_LAST_PHASE 99
#endif

constexpr int NB = 4, T = 4096, TC = 256, SROW = T + TC  , NR = NB * SROW  , D = 1024;
constexpr int EIN = 2848, EINP = 3072, OIN = 2208, OINP = 2304, DFF = 2816, DFX = 3584, NEXP = 8;
constexpr float EPS = 1e-6f;
constexpr int E_Q = 0, E_K = 512, E_V = 1024, E_Z = 1536, E_GA = 2048, E_GB = 2064, E_SQ = 2080, E_SK = 2592, E_SV = 2720;
constexpr int O_CQ = 0, O_CKV = 384, O_KR = 640, O_DQ = 672, O_DK = 1184, O_DV = 1696;

constexpr size_t MiB = 1u << 20;
constexpr size_t WS_CTL = 0, CTL_ZERO_BYTES = 1 * MiB;
constexpr size_t WS_MODV = 1 * MiB;
constexpr size_t WS_GB = 2 * MiB;
constexpr size_t WS_META = 5 * MiB;
constexpr size_t WS_HCTX = 8 * MiB;
constexpr size_t WS_WEIN = 12 * MiB, WS_WEOUT = 18 * MiB, WS_WEGU = 20 * MiB, WS_WEDN = 31 * MiB, WS_WOIN = 37 * MiB, WS_WUQ = 42 * MiB, WS_WUKV = 43 * MiB, WS_WOOUT = 44 * MiB;
constexpr size_t WS_BIG = 46 * MiB;
constexpr size_t WS_PROJ = 46 * MiB, WS_QKVN = 148 * MiB;
constexpr size_t WS_PROJ2 = 46 * MiB, WS_QM = 123 * MiB, WS_VMLA = 149 * MiB, WS_KMLA = 167 * MiB, WS_ODIFF = 316 * MiB;
constexpr size_t WS_WXGU = 46 * MiB, WS_WXDN = 158 * MiB;
constexpr size_t WS_CQN = 214 * MiB;
constexpr size_t WS_ABUF = 214 * MiB, WS_MIX = 248 * MiB, WS_YBUF = 282 * MiB;
constexpr size_t WS_OG = 214 * MiB;
constexpr size_t WS_PART = 350 * MiB;
constexpr size_t WS_GDNI = 282 * MiB;
constexpr size_t WS_HID = 46 * MiB;
constexpr size_t WS_ASORT = 214 * MiB;
constexpr size_t WS_FIN2 = 282 * MiB;
constexpr size_t WS_Y2 = 316 * MiB;
constexpr size_t WS_HIDX = 316 * MiB;
constexpr size_t WS_END = 436 * MiB;
static_assert(WS_QKVN + (size_t)NR * 1536 * 2 <= 214 * MiB && WS_PROJ + (size_t)NR * EINP * 2 <= WS_QKVN, "layer-0 big region");
static_assert(WS_PROJ2 + (size_t)NR * OINP * 2 <= WS_QM && WS_QM + (size_t)NR * 768 * 2 <= WS_VMLA && WS_VMLA + (size_t)NR * 512 * 2 <= WS_KMLA && WS_KMLA + (size_t)NR * 768 * 2 <= 214 * MiB, "layer-1 big region");
static_assert(WS_WXGU + (size_t)NEXP * 7168 * 1024 * 2 <= WS_WXDN && WS_WXDN + (size_t)NEXP * 1024 * 3584 * 2 <= 214 * MiB, "expert weights");
static_assert(WS_HIDX + (size_t)17408 * 3584 * 2 <= WS_END && WS_ASORT + (size_t)34816 * 1024 * 2 <= WS_FIN2 && WS_HID + (size_t)NR * DFF * 2 <= 214 * MiB, "moe map");
constexpr size_t META_TOPI = 0, META_TOPW = 128 * 1024, META_RANK = 256 * 1024, META_RSTD = 384 * 1024;
constexpr int CW_TMO = 0, CW_CODE = 1;
constexpr int CW_MOECNT = 64;
constexpr int CW_SWAQ = 2048;
constexpr int CW_CHK = 1024;
constexpr int CW_BAR = 4096;
constexpr int RING_OFF = 0, RING_BYTES = 141312;
constexpr int MISC_OFF = RING_BYTES;
constexpr int LDS_BYTES = 147456;
constexpr int NWAVES = 8;
namespace pg8 {
#define PG8_LAS __attribute__((address_space(3)))
typedef unsigned short bf16_t;
typedef short bf16x8 __attribute__((ext_vector_type(8)));
typedef float f32x4 __attribute__((ext_vector_type(4)));
typedef unsigned u32x4 __attribute__((ext_vector_type(4)));
constexpr int BM = 256, BK = 64, HALF = 128, HTB = HALF * BK * 2  , STAGE_BYTES = 8 * HTB, NXCD = 8, WGM = 8;

__host__ __device__ __forceinline__ int lds_byte(int r, int c) { const int st = (r >> 4) * 2 + (c >> 5), rr = r & 15, cc = c & 31, ob = rr * 64 + cc * 2; return st * 1024 + (ob ^ (((ob >> 9) & 1) << 5)); }
__host__ __device__ __forceinline__ void stage_rc(int b, int& R, int& C) { const int st = b / 1024, sb = b % 1024, swz = sb ^ (((sb >> 9) & 1) << 5); R = (st >> 1) * 16 + swz / 64; C = (st & 1) * 32 + (swz % 64) / 2; }
__host__ __device__ __forceinline__ int perm32(int rho) { const int n = rho >> 4, i = rho & 15; return 8 * (i >> 2) + 4 * n + (i & 3); }

struct Unit { int pm, pn, kof; };
struct Gemm { const bf16_t* A; const bf16_t* Bt; int M, N, K, lda, ldb; };

struct StaticOrder {
    int nM, nN, nwg, G, c;
    __host__ __device__ void init(int M, int N, int G_, int c_) { nM = M / BM; nN = N / BM; nwg = nM * nN; G = G_; c = c_; }
    __host__ __device__ bool next(int i, Unit& u) const {
        const long L = (long)i * G + c; if (L >= nwg) return false;
        int wgid = (int)L; { const int q = nwg / NXCD, r = nwg % NXCD, xcd = wgid % NXCD, off = wgid / NXCD; wgid = (xcd < r ? xcd * (q + 1) : r * (q + 1) + (xcd - r) * q) + off; }
        const int nig = WGM * nN, gid = wgid / nig, fm = gid * WGM, gsz = (nM - fm) < WGM ? (nM - fm) : WGM;
        u.pm = fm + ((wgid % nig) % gsz); u.pn = (wgid % nig) / gsz; u.kof = 0; return true;
    }
    __device__ __forceinline__ void a_ready(const Unit&) const {}
    __device__ __forceinline__ void done(const Unit&) const {}
};

__device__ __forceinline__ unsigned cvt_pk_bf16(float lo, float hi) { unsigned r; asm volatile("v_cvt_pk_bf16_f32 %0, %1, %2" : "=v"(r) : "v"(lo), "v"(hi)); return r; }
typedef float f32x2 __attribute__((ext_vector_type(2)));
template <class Epi, class Sched, bool ALIGN_EPI = false, bool SP2 = false>
__device__ __forceinline__ void gemm_phase(PG8_LAS unsigned char* lds, const Gemm g, const Sched& S, const Epi& E) {
    const int tid = threadIdx.x, wid = __builtin_amdgcn_readfirstlane(tid >> 6), lane = tid & 63, wr = wid >> 2, wc = wid & 3, fr = lane & 15, fq = lane >> 4;
    const int K = g.K, nt = K / BK;
    unsigned voffA[2], voffB[2];
#pragma unroll
    for (int i = 0; i < 2; ++i) { int R, C; stage_rc(tid * 16 + i * 8192, R, C); const int Rb = Epi::PERM ? ((R & ~31) + perm32(R & 31)) : R;
        voffA[i] = (unsigned)(R * g.lda + C) * 2u; voffB[i] = (unsigned)(Rb * g.ldb + C) * 2u; }
    const size_t kstep = (size_t)(BK * 2);
    const size_t hstepA = (size_t)HALF * g.lda * 2, hstepB = (size_t)HALF * g.ldb * 2;
    const size_t tstepA = 2 * hstepA, tstepB = 2 * hstepB;
    const unsigned ldsw = (unsigned)wid * 1024u;
    const int aoff = lds_byte(wr * 64 + fr, fq * 8), boff = lds_byte(wc * 32 + fr, fq * 8);
#define PG8_SA(b, h) (((b) * 2 + (h)) * HTB)
#define PG8_SB(b, h) ((4 + (b) * 2 + (h)) * HTB)
#define PG8_STAGE(bufoff, gbase, voff) do { _Pragma("unroll") for (int _i = 0; _i < 2; ++_i) \
        __builtin_amdgcn_global_load_lds((const unsigned*)((const char*)(gbase) + (voff)[_i]), (PG8_LAS unsigned*)(lds + (bufoff) + ldsw + _i * 8192), 16, 0, 0); } while (0)
#define PG8_LDA(dst, b, h) do { _Pragma("unroll") for (int m = 0; m < 4; ++m) _Pragma("unroll") for (int k = 0; k < 2; ++k) dst[m][k] = *(const PG8_LAS bf16x8*)(lds + PG8_SA(b, h) + aoff + m * 2048 + k * 1024); } while (0)
#define PG8_LDB(dst, b, h) do { _Pragma("unroll") for (int n = 0; n < 2; ++n) _Pragma("unroll") for (int k = 0; k < 2; ++k) dst[n][k] = *(const PG8_LAS bf16x8*)(lds + PG8_SB(b, h) + boff + n * 2048 + k * 1024); } while (0)
#define PG8_MMA(ai, bj, At, Bt) do { __builtin_amdgcn_s_setprio(1); _Pragma("unroll") for (int m = 0; m < 4; ++m) _Pragma("unroll") for (int n = 0; n < 2; ++n) _Pragma("unroll") for (int k = 0; k < 2; ++k) \
        acc[ai][bj][m][n] = __builtin_amdgcn_mfma_f32_16x16x32_bf16(Bt[n][k], At[m][k], acc[ai][bj][m][n], 0, 0, 0); __builtin_amdgcn_s_setprio(0); } while (0)
#define PG8_WAIT_V(n) asm volatile("s_waitcnt vmcnt(" #n ")" ::: "memory")
#define PG8_WAIT_L(n) asm volatile("s_waitcnt lgkmcnt(" #n ")" ::: "memory")
#define PG8_BAR __builtin_amdgcn_s_barrier()
#define PG8_SCHED __builtin_amdgcn_sched_barrier(0)
    Unit cur, nxt; int ui = 0;
    if (!S.next(0, cur)) return;
    f32x4 acc[2][2][4][2];
#pragma unroll
    for (int a = 0; a < 2; ++a)
#pragma unroll
        for (int b = 0; b < 2; ++b)
#pragma unroll
            for (int m = 0; m < 4; ++m)
#pragma unroll
                for (int n = 0; n < 2; ++n) acc[a][b][m][n] = (f32x4){0.f, 0.f, 0.f, 0.f};
    bf16x8 At[4][2], B0[2][2], B1[2][2];
    const char* cA = (const char*)g.A + (size_t)cur.pm * tstepA + (size_t)cur.kof * 2; const char* cB = (const char*)g.Bt + (size_t)cur.pn * tstepB + (size_t)cur.kof * 2;
    S.a_ready(cur);
    if constexpr (SP2) {
        PG8_STAGE(PG8_SB(0, 0), cB, voffB); PG8_STAGE(PG8_SB(0, 1), cB + hstepB, voffB); PG8_STAGE(PG8_SA(0, 0), cA, voffA); PG8_STAGE(PG8_SA(0, 1), cA + hstepA, voffA);
        if (wr == 1) PG8_BAR;
        PG8_WAIT_V(2); PG8_BAR;
        PG8_STAGE(PG8_SB(1, 0), cB + kstep, voffB); PG8_STAGE(PG8_SA(1, 0), cA + kstep, voffA); PG8_STAGE(PG8_SB(1, 1), cB + hstepB + kstep, voffB);
        PG8_WAIT_V(6); PG8_BAR;
    } else {
        PG8_STAGE(PG8_SB(0, 0), cB, voffB); PG8_STAGE(PG8_SA(0, 0), cA, voffA); PG8_STAGE(PG8_SB(0, 1), cB + hstepB, voffB); PG8_STAGE(PG8_SA(0, 1), cA + hstepA, voffA);
        if (wr == 1) PG8_BAR;
        PG8_WAIT_V(4); PG8_BAR;
        PG8_STAGE(PG8_SB(1, 0), cB + kstep, voffB); PG8_STAGE(PG8_SA(1, 0), cA + kstep, voffA); PG8_STAGE(PG8_SB(1, 1), cB + hstepB + kstep, voffB);
        PG8_WAIT_V(6); PG8_BAR;
    }
    for (;;) {
        const bool has_next = S.next(ui + 1, nxt);
        const char* nA = has_next ? (const char*)g.A + (size_t)nxt.pm * tstepA + (size_t)nxt.kof * 2 : cA; const char* nB = has_next ? (const char*)g.Bt + (size_t)nxt.pn * tstepB + (size_t)nxt.kof * 2 : cB;
        _Pragma("unroll 1") for (int t = 0; t < nt; t += 2) {
            const bool last = (t == nt - 2);
            const char* a1 = cA + (size_t)(t + 1) * kstep;
            const char* a2 = last ? nA : cA + (size_t)(t + 2) * kstep; const char* b2 = last ? nB : cB + (size_t)(t + 2) * kstep;
            const char* a3 = a2 + kstep; const char* b3 = b2 + kstep;
            if (last && has_next) S.a_ready(nxt);
            if constexpr (SP2) {
            PG8_LDB(B0, 0, 0); PG8_LDB(B1, 0, 1); PG8_SCHED; PG8_LDA(At, 0, 0); PG8_STAGE(PG8_SA(1, 1), a1 + hstepA, voffA);
            PG8_WAIT_V(8); PG8_WAIT_L(0); PG8_BAR; PG8_MMA(0, 0, At, B0); PG8_MMA(0, 1, At, B1); PG8_BAR; PG8_SCHED;
            PG8_LDA(At, 0, 1); PG8_STAGE(PG8_SB(0, 0), b2, voffB); PG8_STAGE(PG8_SB(0, 1), b2 + hstepB, voffB); PG8_STAGE(PG8_SA(0, 0), a2, voffA);
            PG8_WAIT_V(8); PG8_WAIT_L(0); PG8_BAR; PG8_MMA(1, 0, At, B0); PG8_MMA(1, 1, At, B1); PG8_BAR; PG8_SCHED;
            PG8_LDB(B0, 1, 0); PG8_LDB(B1, 1, 1); PG8_SCHED; PG8_LDA(At, 1, 0); PG8_STAGE(PG8_SA(0, 1), a2 + hstepA, voffA);
            PG8_WAIT_V(8); PG8_WAIT_L(0); PG8_BAR; PG8_MMA(0, 0, At, B0); PG8_MMA(0, 1, At, B1); PG8_BAR; PG8_SCHED;
            PG8_LDA(At, 1, 1); PG8_STAGE(PG8_SB(1, 0), b3, voffB); PG8_STAGE(PG8_SB(1, 1), b3 + hstepB, voffB); PG8_STAGE(PG8_SA(1, 0), a3, voffA);
            PG8_WAIT_V(8); PG8_WAIT_L(0); PG8_BAR; PG8_MMA(1, 0, At, B0); PG8_MMA(1, 1, At, B1); PG8_BAR; PG8_SCHED;
            } else {
            PG8_LDB(B0, 0, 0); PG8_SCHED; PG8_LDA(At, 0, 0); PG8_STAGE(PG8_SA(1, 1), a1 + hstepA, voffA);
            PG8_WAIT_L(8); PG8_BAR; PG8_WAIT_L(0); PG8_MMA(0, 0, At, B0); PG8_BAR; PG8_SCHED;
            PG8_LDB(B1, 0, 1); PG8_STAGE(PG8_SB(0, 0), b2, voffB);
            PG8_BAR; PG8_WAIT_L(0); PG8_MMA(0, 1, At, B1); PG8_BAR;
            PG8_LDA(At, 0, 1); PG8_STAGE(PG8_SA(0, 0), a2, voffA);
            PG8_BAR; PG8_WAIT_L(0); PG8_MMA(1, 0, At, B0); PG8_BAR; PG8_SCHED;
            PG8_STAGE(PG8_SB(0, 1), b2 + hstepB, voffB);
            PG8_WAIT_V(6); PG8_BAR; PG8_MMA(1, 1, At, B1); PG8_BAR;
            PG8_LDB(B0, 1, 0); PG8_SCHED; PG8_LDA(At, 1, 0); PG8_STAGE(PG8_SA(0, 1), a2 + hstepA, voffA);
            PG8_WAIT_L(8); PG8_BAR; PG8_WAIT_L(0); PG8_MMA(0, 0, At, B0); PG8_BAR; PG8_SCHED;
            PG8_LDB(B1, 1, 1); PG8_STAGE(PG8_SB(1, 0), b3, voffB);
            PG8_BAR; PG8_WAIT_L(0); PG8_MMA(0, 1, At, B1); PG8_BAR;
            PG8_LDA(At, 1, 1); PG8_STAGE(PG8_SA(1, 0), a3, voffA);
            PG8_BAR; PG8_WAIT_L(0); PG8_MMA(1, 0, At, B0); PG8_BAR; PG8_SCHED;
            PG8_STAGE(PG8_SB(1, 1), b3 + hstepB, voffB);
            PG8_WAIT_V(6); PG8_BAR; PG8_MMA(1, 1, At, B1); PG8_BAR;
            }
        }
        if constexpr (ALIGN_EPI) { if (wr == 0) PG8_BAR; }
        if constexpr (!Epi::AFTER_DRAIN) { E(acc, cur, wr, wc, fr, fq); S.done(cur); }
        if (!has_next) break;
#pragma unroll
        for (int a = 0; a < 2; ++a)
#pragma unroll
            for (int b = 0; b < 2; ++b)
#pragma unroll
                for (int m = 0; m < 4; ++m)
#pragma unroll
                    for (int n = 0; n < 2; ++n) acc[a][b][m][n] = (f32x4){0.f, 0.f, 0.f, 0.f};
        cur = nxt; cA = nA; cB = nB; ++ui;
        if constexpr (ALIGN_EPI) { if (wr == 1) PG8_BAR; }
    }
    PG8_WAIT_V(0);
    if constexpr (!ALIGN_EPI) { if (wr == 0) PG8_BAR; }
    PG8_BAR;
    if constexpr (Epi::AFTER_DRAIN) { E.fused(acc, cur, wr, wc, fr, fq, lds, wid, lane); S.done(cur); }
#undef PG8_SA
#undef PG8_SB
#undef PG8_STAGE
#undef PG8_LDA
#undef PG8_LDB
#undef PG8_MMA
#undef PG8_WAIT_V
#undef PG8_WAIT_L
#undef PG8_BAR
#undef PG8_SCHED
}
}
namespace pg8 {
struct EpiStore { static constexpr bool PERM = true, AFTER_DRAIN = false;
    bf16_t* O; int ldc; int nN;
    __device__ __forceinline__ void operator()(const f32x4 (&acc)[2][2][4][2], const Unit& u, int wr, int wc, int fr, int fq) const {
        const int row0 = u.pm * BM + wr * 64 + fr, col0 = (u.pn % nN) * BM + wc * 32 + 8 * fq;
#pragma unroll
        for (int ai = 0; ai < 2; ++ai)
#pragma unroll
            for (int m = 0; m < 4; ++m) { const int row = row0 + ai * HALF + m * 16;
                bf16_t* rowp = O + (size_t)row * ldc + col0;
#pragma unroll
                for (int bj = 0; bj < 2; ++bj) { const f32x4 v0 = acc[ai][bj][m][0], v1 = acc[ai][bj][m][1];
                    u32x4 w; w.x = cvt_pk_bf16(v0[0], v0[1]); w.y = cvt_pk_bf16(v0[2], v0[3]); w.z = cvt_pk_bf16(v1[0], v1[1]); w.w = cvt_pk_bf16(v1[2], v1[3]);
                    *(u32x4*)(rowp + bj * HALF) = w; } }
    }
};
struct EpiSwiGLU { static constexpr bool PERM = true, AFTER_DRAIN = false;
    bf16_t* O; int ldc; int nN;
    __device__ __forceinline__ void operator()(const f32x4 (&acc)[2][2][4][2], const Unit& u, int wr, int wc, int fr, int fq) const {
        const int row0 = u.pm * BM + wr * 64 + fr, col0 = (u.pn % nN) * HALF + wc * 32 + 8 * fq;
#pragma unroll
        for (int ai = 0; ai < 2; ++ai)
#pragma unroll
            for (int m = 0; m < 4; ++m) { bf16_t* rowp = O + (size_t)(row0 + ai * HALF + m * 16) * ldc + col0;
                float h[8];
#pragma unroll
                for (int n = 0; n < 2; ++n)
#pragma unroll
                    for (int j = 0; j < 4; ++j) { const float g = acc[ai][0][m][n][j], up = acc[ai][1][m][n][j]; h[n * 4 + j] = g * __builtin_amdgcn_rcpf(1.f + __expf(-g)) * up; }
                u32x4 w; w.x = cvt_pk_bf16(h[0], h[1]); w.y = cvt_pk_bf16(h[2], h[3]); w.z = cvt_pk_bf16(h[4], h[5]); w.w = cvt_pk_bf16(h[6], h[7]);
                *(u32x4*)rowp = w; }
    }
};
struct EpiKV { static constexpr bool PERM = true, AFTER_DRAIN = false;
    bf16_t* KM; bf16_t* VM;
    __device__ __forceinline__ void operator()(const f32x4 (&acc)[2][2][4][2], const Unit& u, int wr, int wc, int fr, int fq) const {
        const int row0 = u.pm * BM + wr * 64 + fr, within = wc * 32 + 8 * fq;
#pragma unroll
        for (int ai = 0; ai < 2; ++ai)
#pragma unroll
            for (int m = 0; m < 4; ++m) { const int row = row0 + ai * HALF + m * 16;
#pragma unroll
                for (int bj = 0; bj < 2; ++bj) { const int h = 2 * u.pn + bj; const f32x4 v0 = acc[ai][bj][m][0], v1 = acc[ai][bj][m][1];
                    u32x4 w; w.x = cvt_pk_bf16(v0[0], v0[1]); w.y = cvt_pk_bf16(v0[2], v0[3]); w.z = cvt_pk_bf16(v1[0], v1[1]); w.w = cvt_pk_bf16(v1[2], v1[3]);
                    bf16_t* p = (within < 64) ? KM + (size_t)row * 768 + h * 96 + within : VM + (size_t)row * 512 + h * 64 + (within - 64);
                    *(u32x4*)p = w; } }
    }
};
struct CtxSplitOrder { int nsl, ksl, G, c;
    __device__ void init(int nsl_, int ksl_, int G_, int c_) { nsl = nsl_; ksl = ksl_; G = G_; c = c_; }
    __device__ bool next(int i, Unit& u) const { const int L = i * G + c; if (L >= 16 * nsl) return false; const int sl = L >> 4, rem = L & 15; u.pm = (rem >> 2) * 17; u.pn = rem & 3; u.kof = sl * ksl; return true; }
    __device__ __forceinline__ void a_ready(const Unit&) const {}
    __device__ __forceinline__ void done(const Unit&) const {}
};
struct EpiPartF32 { static constexpr bool PERM = false, AFTER_DRAIN = false;
    float* P; int ksl;
    __device__ __forceinline__ void operator()(const f32x4 (&acc)[2][2][4][2], const Unit& u, int wr, int wc, int fr, int fq) const {
        float* base = P + ((size_t)(u.kof / ksl) * 1024 + (size_t)(u.pm / 17) * 256) * 1024; const int row0 = wr * 64 + fr, col0 = u.pn * BM + wc * 32 + 4 * fq;
#pragma unroll
        for (int ai = 0; ai < 2; ++ai)
#pragma unroll
            for (int m = 0; m < 4; ++m) { float* rowp = base + (size_t)(row0 + ai * HALF + m * 16) * 1024 + col0;
#pragma unroll
                for (int bj = 0; bj < 2; ++bj)
#pragma unroll
                    for (int n = 0; n < 2; ++n) *(f32x4*)(rowp + bj * HALF + n * 16) = acc[ai][bj][m][n]; }
    }
};
struct LatOrder { StaticOrder so;
    __device__ void init(int N, int G, int c) { so.nM = 64; so.nN = N / BM; so.nwg = 64 * so.nN; so.G = G; so.c = c; }
    __device__ bool next(int i, Unit& u) const { if (!so.next(i, u)) return false; u.pm = (u.pm >> 4) * 17 + 1 + (u.pm & 15); return true; }
    __device__ __forceinline__ void a_ready(const Unit&) const {}
    __device__ __forceinline__ void done(const Unit&) const {}
};
struct MoeOrder { StaticOrder so; const int* texp; int t0, nNe;
    __device__ void init(int ntiles, int nNe_, int G, int c, const int* texp_, int t0_) { so.nM = ntiles; so.nN = nNe_; so.nwg = ntiles * nNe_; so.G = G; so.c = c; texp = texp_; t0 = t0_; nNe = nNe_; }
    __device__ bool next(int i, Unit& u) const { if (!so.next(i, u)) return false; const int e = __builtin_amdgcn_readfirstlane(texp[t0 + u.pm]); u.pn = e * nNe + u.pn; return true; }
    __device__ __forceinline__ void a_ready(const Unit&) const {}
    __device__ __forceinline__ void done(const Unit&) const {}
};
}
#define PG8_SP2 true
#define PG8_ALIGN true
#define GAS __attribute__((address_space(1)))
#define LAS __attribute__((address_space(3)))
typedef unsigned short bf16;
typedef unsigned v4u __attribute__((ext_vector_type(4)));
typedef unsigned v2u __attribute__((ext_vector_type(2)));
typedef float f32x4 __attribute__((ext_vector_type(4)));
typedef short bf16x8 __attribute__((ext_vector_type(8)));
typedef GAS unsigned gu32;
#define RLX_AGENT __ATOMIC_RELAXED, __HIP_MEMORY_SCOPE_AGENT
#define LDS_WAIT() asm volatile("s_waitcnt lgkmcnt(0)" ::: "memory")
#define VM_WAIT() asm volatile("s_waitcnt vmcnt(0)" ::: "memory")
__device__ __forceinline__ unsigned f2bf(float f) { unsigned u = __builtin_bit_cast(unsigned, f); return (u + 0x7fffu + ((u >> 16) & 1u)) >> 16; }
__device__ __forceinline__ unsigned pk2(float lo, float hi) { return f2bf(lo) | (f2bf(hi) << 16); }
__device__ __forceinline__ float bf2f(unsigned short b) { return __builtin_bit_cast(float, ((unsigned)b) << 16); }
__device__ __forceinline__ float bflo(unsigned w) { return __builtin_bit_cast(float, w << 16); }
__device__ __forceinline__ float bfhi(unsigned w) { return __builtin_bit_cast(float, w & 0xffff0000u); }
__device__ __forceinline__ float wave_sum(float v) {
#pragma unroll
    for (int o = 1; o < 64; o <<= 1) v += __shfl_xor(v, o);
    return v;
}
__device__ __forceinline__ float siluf(float x) { return x / (1.f + __expf(-x)); }
#define XB_TMO      128
#define XB_XCNT(j)  (256  + 64 * (j))
#define XB_XSUB(j)  (1280 + 64 * (j))
#define XB_XGEN(j)  (2304 + 64 * (j))
#define XB_TOP      3328
#define XB_TOPGEN   3392
#define XCD_BAR_WORDS 3456
#define XB_SPIN_CAP (1u << 18)

__device__ __forceinline__ unsigned xb_ld(unsigned* p)              { return __hip_atomic_load(p, __ATOMIC_RELAXED, __HIP_MEMORY_SCOPE_AGENT); }
__device__ __forceinline__ unsigned xb_add(unsigned* p, unsigned v) { return __hip_atomic_fetch_add(p, v, __ATOMIC_RELAXED, __HIP_MEMORY_SCOPE_AGENT); }
__device__ __forceinline__ unsigned xb_xcc_id() { return (unsigned)__builtin_amdgcn_s_getreg((3 << 11) | 20) & 0xFu; }
#define XB_SPIN(cond, bar) do { unsigned _sp = 0; while (cond) { __builtin_amdgcn_s_sleep(1); \
    if ((++_sp & 255u) == 0u) { if (xb_ld(&(bar)[XB_TMO])) break; if (_sp > XB_SPIN_CAP) { atomicAdd(&(bar)[XB_TMO], 1u); break; } } } } while (0)

struct XcdBarrier {
    unsigned* bar; unsigned x;
    volatile LAS unsigned* st;
};

__device__ __forceinline__ XcdBarrier xcd_barrier_post(unsigned* bar, volatile LAS unsigned* st) {
    XcdBarrier b; b.bar = bar; b.x = xb_xcc_id(); b.st = st;
    if (threadIdx.x == 0) (void)xb_add(&bar[XB_XCNT(b.x)], 1u);
    return b;
}
__device__ __forceinline__ void xcd_barrier_complete(unsigned* bar, unsigned x, unsigned& nloc, unsigned& nx) {
    const unsigned G = gridDim.x * gridDim.y * gridDim.z;
    unsigned sum, cnt, mine, sp = 0u;
    for (;;) {
        sum = 0u; cnt = 0u; mine = 0u;
#pragma unroll
        for (unsigned j = 0; j < 16; ++j) { const unsigned c = xb_ld(&bar[XB_XCNT(j)]); sum += c; cnt += (c > 0u) ? 1u : 0u; mine = (j == x) ? c : mine; }
        if (sum == G) break;
        __builtin_amdgcn_s_sleep(1);
        if ((++sp & 255u) == 0u) { if (xb_ld(&bar[XB_TMO])) break; if (sp > XB_SPIN_CAP) { atomicAdd(&bar[XB_TMO], 1u); break; } }
    }
    nloc = mine > 0u ? mine : 1u; nx = cnt > 0u ? cnt : 1u;
}

__device__ __forceinline__ void xcd_barrier(const XcdBarrier& b) {
    asm volatile("s_waitcnt vmcnt(0)" ::: "memory");
    __syncthreads();
    if (threadIdx.x == 0) {
        unsigned* bar = b.bar;
        __builtin_amdgcn_s_waitcnt(0);
        unsigned nloc = b.st[0], nx = b.st[1];
        if (nloc == 0u) { xcd_barrier_complete(bar, b.x, nloc, nx); b.st[0] = nloc; b.st[1] = nx; }
        const unsigned old = xb_add(&bar[XB_XSUB(b.x)], 1u);
        const unsigned gen = old / nloc;
        if (old + 1u == (gen + 1u) * nloc) {
            __builtin_amdgcn_fence(__ATOMIC_RELEASE, "agent");
            asm volatile("s_waitcnt vmcnt(0)" ::: "memory");
            const unsigned og = xb_add(&bar[XB_TOP], 1u);
            const unsigned tg = og / nx;
            if (og + 1u == (tg + 1u) * nx) xb_add(&bar[XB_TOPGEN], 1u);
            else XB_SPIN(xb_ld(&bar[XB_TOPGEN]) == tg, bar);
            __builtin_amdgcn_fence(__ATOMIC_ACQUIRE, "agent");
            xb_add(&bar[XB_XGEN(b.x)], 1u);
            asm volatile("s_waitcnt vmcnt(0)" ::: "memory");
        } else {
            XB_SPIN(xb_ld(&bar[XB_XGEN(b.x)]) == gen, bar);
            __builtin_amdgcn_fence(__ATOMIC_ACQUIRE, "agent");
            asm volatile("s_waitcnt vmcnt(0)" ::: "memory");
        }
    }
    __syncthreads();
}
namespace att {
using bf16x8 = __attribute__((ext_vector_type(8))) short;
using s16x4  = __attribute__((ext_vector_type(4))) short;
using f32x16 = __attribute__((ext_vector_type(16))) float;
using u32x4  = __attribute__((ext_vector_type(4))) unsigned;
constexpr int NW = 8, QBLK = 32, KVBLK = 64;
constexpr size_t SHM_V = KVBLK * 128 * 2, SHM_K = KVBLK * 128 * 2, SHM_ATTN = 2 * SHM_V + 2 * SHM_K + NW * 64 * 4;
constexpr float THR = 8.f;
#define KSWZ(row, colB) ((row) * 256 + ((colB) ^ (((row) & 7) << 4)))
#define SBAR() __builtin_amdgcn_sched_barrier(0)
__device__ __forceinline__ int crow(int r, int hi) { return (r & 3) + 8 * (r >> 2) + 4 * hi; }
__device__ __forceinline__ unsigned cvtpk(float lo, float hi) { unsigned r; asm volatile("v_cvt_pk_bf16_f32 %0, %1, %2" : "=v"(r) : "v"(lo), "v"(hi)); return r; }
__device__ __forceinline__ void partialSM(f32x16& p0, f32x16& p1, float& m_reg, float& mn, float& alpha, float C, float thr_s) {
  float pmax = p0[0];
#pragma unroll
  for (int r = 1; r < 16; ++r) pmax = fmaxf(pmax, p0[r]);
#pragma unroll
  for (int r = 0; r < 16; ++r) pmax = fmaxf(pmax, p1[r]);
  { auto rr = __builtin_amdgcn_permlane32_swap(__float_as_uint(pmax), __float_as_uint(pmax), false, false);
    pmax = fmaxf(__uint_as_float(rr[0]), __uint_as_float(rr[1])); }
  if (__builtin_expect(__all(pmax - m_reg <= thr_s), 1)) { mn = m_reg; alpha = 1.f; }
  else { mn = fmaxf(m_reg, pmax); alpha = __builtin_amdgcn_exp2f((m_reg - mn) * C); m_reg = mn; }
  const float mnC = -mn * C;
#pragma unroll
  for (int r = 0; r < 16; ++r) p0[r] = fmaf(p0[r], C, mnC);
#pragma unroll
  for (int r = 0; r < 16; ++r) p1[r] = fmaf(p1[r], C, mnC);
#pragma unroll
  for (int r = 0; r < 16; ++r) p0[r] = __builtin_amdgcn_exp2f(p0[r]);
}
__device__ __forceinline__ void finishSM(f32x16& p0, f32x16& p1, float alpha, float& l_reg, bf16x8& pa0, bf16x8& pa1, bf16x8& pa2, bf16x8& pa3) {
#pragma unroll
  for (int r = 0; r < 16; ++r) p1[r] = __builtin_amdgcn_exp2f(p1[r]);
  float ps = 0;
#pragma unroll
  for (int r = 0; r < 16; ++r) ps += p0[r];
#pragma unroll
  for (int r = 0; r < 16; ++r) ps += p1[r];
  { auto rr = __builtin_amdgcn_permlane32_swap(__float_as_uint(ps), __float_as_uint(ps), false, false);
    ps = __uint_as_float(rr[0]) + __uint_as_float(rr[1]); }
  l_reg = l_reg * alpha + ps;
#define PK4(P, BASE, OUT) do { unsigned a0 = cvtpk(P[BASE + 0], P[BASE + 1]), a1 = cvtpk(P[BASE + 2], P[BASE + 3]);   \
    unsigned b0 = cvtpk(P[BASE + 4], P[BASE + 5]), b1 = cvtpk(P[BASE + 6], P[BASE + 7]);                              \
    auto r0 = __builtin_amdgcn_permlane32_swap(a0, b0, false, false); auto r1 = __builtin_amdgcn_permlane32_swap(a1, b1, false, false); \
    u32x4 w = {r0[0], r1[0], r0[1], r1[1]}; OUT = *reinterpret_cast<bf16x8*>(&w); } while (0)
  PK4(p0, 0, pa0); PK4(p0, 8, pa1); PK4(p1, 0, pa2); PK4(p1, 8, pa3);
#undef PK4
}
template <int DQK> __device__ __forceinline__ void qkt(f32x16& p0, f32x16& p1, const char* Ks, const bf16x8* qr, int r32, int hi) {
  p0 = f32x16{}; p1 = f32x16{};
#pragma unroll
  for (int d0 = 0; d0 < DQK / 16; ++d0) { const int cb = (d0 * 16 + hi * 8) * 2;
    const bf16x8 b0 = *reinterpret_cast<const bf16x8*>(Ks + KSWZ(r32, cb));
    const bf16x8 b1 = *reinterpret_cast<const bf16x8*>(Ks + KSWZ(32 + r32, cb));
    p0 = __builtin_amdgcn_mfma_f32_32x32x16_bf16(b0, qr[d0], p0, 0, 0, 0);
    p1 = __builtin_amdgcn_mfma_f32_32x32x16_bf16(b1, qr[d0], p1, 0, 0, 0); }
}
__device__ __forceinline__ int v_st(int k, int c) { const int kk = (k & ~0xC) | ((k & 4) << 1) | ((k & 8) >> 1); return ((kk >> 3) * 4 + (c >> 5)) * 512 + ((kk & 7) * 32 + (c & 31)) * 2; }
__device__ __forceinline__ int v_rd_base(int lane) { return ((lane & 3) << 3) | (((lane >> 2) & 3) << 6) | (((lane >> 4) & 1) << 5) | (((lane >> 5) & 1) << 8); }
constexpr int v_rd_off(int d0, int ks, int half) { return d0 * 512 + ks * 4096 + half * 2048; }
template <int OFF> __device__ __forceinline__ s16x4 tr_read(int vb) {
  s16x4 r; asm volatile("ds_read_b64_tr_b16 %0, %1 offset:%2" : "=&v"(r) : "v"(vb), "i"(OFF) : "memory"); return r;
}
template <int D0> __device__ __forceinline__ void pv_one(f32x16& od, int vb, bf16x8 pa0, bf16x8 pa1, bf16x8 pa2, bf16x8 pa3) {
  const s16x4 l0 = tr_read<v_rd_off(D0, 0, 0)>(vb), h0 = tr_read<v_rd_off(D0, 0, 1)>(vb), l1 = tr_read<v_rd_off(D0, 1, 0)>(vb), h1 = tr_read<v_rd_off(D0, 1, 1)>(vb);
  const s16x4 l2 = tr_read<v_rd_off(D0, 2, 0)>(vb), h2 = tr_read<v_rd_off(D0, 2, 1)>(vb), l3 = tr_read<v_rd_off(D0, 3, 0)>(vb), h3 = tr_read<v_rd_off(D0, 3, 1)>(vb);
  asm volatile("s_waitcnt lgkmcnt(0)" ::: "memory"); SBAR();
#define PK(L, H) (bf16x8){L[0], L[1], L[2], L[3], H[0], H[1], H[2], H[3]}
  od = __builtin_amdgcn_mfma_f32_32x32x16_bf16(pa0, PK(l0, h0), od, 0, 0, 0);
  od = __builtin_amdgcn_mfma_f32_32x32x16_bf16(pa1, PK(l1, h1), od, 0, 0, 0);
  od = __builtin_amdgcn_mfma_f32_32x32x16_bf16(pa2, PK(l2, h2), od, 0, 0, 0);
  od = __builtin_amdgcn_mfma_f32_32x32x16_bf16(pa3, PK(l3, h3), od, 0, 0, 0);
#undef PK
}
template <int DV> __device__ __forceinline__ void pv_all(f32x16* o, int vb, bf16x8 pa0, bf16x8 pa1, bf16x8 pa2, bf16x8 pa3) {
  pv_one<0>(o[0], vb, pa0, pa1, pa2, pa3); pv_one<1>(o[1], vb, pa0, pa1, pa2, pa3);
  if constexpr (DV > 64) { pv_one<2>(o[2], vb, pa0, pa1, pa2, pa3); pv_one<3>(o[3], vb, pa0, pa1, pa2, pa3); }
}
template <int DQK, int DV, int MODE, bool QROPE = false, int OUTMODE = 0>
__device__ __forceinline__ void attn_unit(const unsigned short* __restrict__ Qb, int ldq, const unsigned short* __restrict__ Kb, int ldk, const unsigned short* __restrict__ Vb, int ldv,
                                          unsigned short* __restrict__ Ob, int ldo, int NT, int lat0, int q0lat, float C, float thr_s, float sinkl2, char* lds, float lam = 0.f, const float* nw = nullptr, float nscale = 1.f) {
  int tid_ = threadIdx.x; asm volatile("" : "+v"(tid_));
  const int tid = tid_, wid = tid >> 6, lane = tid & 63, r32 = lane & 31, hi = lane >> 5;
  char* V_lds = lds; char* K_lds = lds + 2 * SHM_V;
  float* ws = (float*)(lds + 2 * SHM_V + 2 * SHM_K) + wid * 64; float* li_l = ws; float* al_l = ws + 32;
  float m_reg = -1e30f, l_reg = 0; f32x16 o[DV / 32]; bf16x8 qr[DQK / 16];
#pragma unroll
  for (int d = 0; d < DV / 32; ++d) o[d] = f32x16{};
  const unsigned short* Qw = Qb + (long)(wid * QBLK + r32) * ldq + hi * 8;
#pragma unroll
  for (int d0 = 0; d0 < DQK / 16; ++d0) qr[d0] = *reinterpret_cast<const bf16x8*>(Qw + d0 * 16);
  if constexpr (QROPE) {
    static_assert(DQK == 96, "QROPE is the MLA case");
    int t = q0lat + wid * QBLK + r32; asm volatile("" : "+v"(t));
#pragma unroll
    for (int part = 0; part < 2; ++part) { const float pos = (float)(part ? (t & 63) : (t >> 6)); u32x4 w = __builtin_bit_cast(u32x4, qr[4 + part]); u32x4 o;
#pragma unroll
      for (int q = 0; q < 4; ++q) { const unsigned pw = (unsigned)__shfl_xor((int)w[q], 32); float x0 = bflo(w[q]), x1 = bfhi(w[q]); const float p0 = bflo(pw), p1 = bfhi(pw);
        float s0, c0, s1, c1; sincosf(pos * __powf(10000.f, -(float)(2 * q) * 0.125f), &s0, &c0); sincosf(pos * __powf(10000.f, -(float)(2 * q + 1) * 0.125f), &s1, &c1);
        x0 = hi ? (x0 * c0 + p0 * s0) : (x0 * c0 - p0 * s0); x1 = hi ? (x1 * c1 + p1 * s1) : (x1 * c1 - p1 * s1); o[q] = cvtpk(x0, x1); }
      qr[4 + part] = __builtin_bit_cast(bf16x8, o); } }
  const int sr = tid >> 4, sc = (tid & 15) * 8, vst0 = v_st(sr, sc), vst1 = v_st(32 + sr, sc);
  const bool kact = sc < DQK, vact = sc < DV;
  const int vb0 = (int)(uintptr_t)V_lds + v_rd_base(lane);
  struct { bf16x8 vs0, vs1, ks0, ks1; } sr_[2];
#define TROW(j) ((MODE == 1 && (j) >= 4) ? (256 + lat0 + ((j) - 4) * 64) : (j) * 64)
#define SLOAD(i, j) do { const long k0_ = TROW(j); \
    if (vact) { sr_[i].vs0 = *reinterpret_cast<const bf16x8*>(&Vb[(k0_ + sr) * ldv + sc]); sr_[i].vs1 = *reinterpret_cast<const bf16x8*>(&Vb[(k0_ + 32 + sr) * ldv + sc]); } \
    if (kact) { sr_[i].ks0 = *reinterpret_cast<const bf16x8*>(&Kb[(k0_ + sr) * ldk + sc]); sr_[i].ks1 = *reinterpret_cast<const bf16x8*>(&Kb[(k0_ + 32 + sr) * ldk + sc]); } } while (0)
#define SWRITE(b, i) do { if (vact) { *(bf16x8*)(V_lds + (b) * SHM_V + vst0) = sr_[i].vs0; *(bf16x8*)(V_lds + (b) * SHM_V + vst1) = sr_[i].vs1; } \
    if (kact) { const int kc = sc * 2; *(bf16x8*)(K_lds + (b) * SHM_K + KSWZ(sr, kc)) = sr_[i].ks0; *(bf16x8*)(K_lds + (b) * SHM_K + KSWZ(32 + sr, kc)) = sr_[i].ks1; } } while (0)
#define RESC(a) do { if (__any((a) < 1.f)) { if (hi == 0) al_l[r32] = (a); asm volatile("s_waitcnt lgkmcnt(0)" ::: "memory"); \
    _Pragma("unroll") for (int d = 0; d < DV / 32; ++d) _Pragma("unroll") for (int r = 0; r < 16; ++r) o[d][r] *= al_l[crow(r, hi)]; } } while (0)
#define MASK(P0, P1, j) do { if (MODE == 1 && (j) >= 4) { const int kb_ = lat0 + ((j) - 4) * 64 + 4 * hi - (q0lat + wid * QBLK + r32); \
    _Pragma("unroll") for (int r = 0; r < 16; ++r) { const int dk_ = kb_ + (r & 3) + 8 * (r >> 2); if (dk_ > 128 || dk_ < -128) P0[r] = -1e30f; if (dk_ + 32 > 128 || dk_ + 32 < -128) P1[r] = -1e30f; } } } while (0)
  f32x16 pA0, pA1, pB0, pB1; float mnA, mnB, alA, alB; bf16x8 pa0, pa1, pa2, pa3;
  SLOAD(0, 0); asm volatile("s_waitcnt vmcnt(0)" ::: "memory"); SWRITE(0, 0); __syncthreads();
  qkt<DQK>(pA0, pA1, K_lds, qr, r32, hi); MASK(pA0, pA1, 0); partialSM(pA0, pA1, m_reg, mnA, alA, C, thr_s);
  SLOAD(1, 1); if (2 < NT) SLOAD(0, 2);
  asm volatile("s_waitcnt vmcnt(4)" ::: "memory"); SWRITE(1, 1); __syncthreads();
  for (int j = 1; j + 1 < NT; j += 2) {
    SBAR(); qkt<DQK>(pB0, pB1, K_lds + SHM_K, qr, r32, hi); MASK(pB0, pB1, j);
    finishSM(pA0, pA1, alA, l_reg, pa0, pa1, pa2, pa3); SBAR();
    SLOAD(1, j + 2); SBAR();
    pv_all<DV>(o, vb0, pa0, pa1, pa2, pa3); partialSM(pB0, pB1, m_reg, mnB, alB, C, thr_s);
    __syncthreads(); asm volatile("s_waitcnt vmcnt(4)" ::: "memory"); SWRITE(0, 0);
    RESC(alB); __syncthreads();
    SBAR(); qkt<DQK>(pA0, pA1, K_lds, qr, r32, hi); MASK(pA0, pA1, j + 1);
    finishSM(pB0, pB1, alB, l_reg, pa0, pa1, pa2, pa3); SBAR();
    if (j + 3 < NT) SLOAD(0, j + 3); SBAR();
    pv_all<DV>(o, vb0 + (int)SHM_V, pa0, pa1, pa2, pa3); partialSM(pA0, pA1, m_reg, mnA, alA, C, thr_s);
    __syncthreads(); asm volatile("s_waitcnt vmcnt(4)" ::: "memory"); SWRITE(1, 1);
    RESC(alA); __syncthreads();
  }
  SBAR(); qkt<DQK>(pB0, pB1, K_lds + SHM_K, qr, r32, hi); MASK(pB0, pB1, NT - 1);
  finishSM(pA0, pA1, alA, l_reg, pa0, pa1, pa2, pa3); SBAR();
  pv_all<DV>(o, vb0, pa0, pa1, pa2, pa3); partialSM(pB0, pB1, m_reg, mnB, alB, C, thr_s);
  __syncthreads(); RESC(alB);
  finishSM(pB0, pB1, alB, l_reg, pa0, pa1, pa2, pa3); SBAR();
  pv_all<DV>(o, vb0 + (int)SHM_V, pa0, pa1, pa2, pa3);
  if (sinkl2 > -1e29f) l_reg += __builtin_amdgcn_exp2f(sinkl2 - m_reg * C);
  if (hi == 0) li_l[r32] = l_reg; asm volatile("s_waitcnt lgkmcnt(0)" ::: "memory");
  float rli[16];
#pragma unroll
  for (int r = 0; r < 16; ++r) rli[r] = __builtin_amdgcn_rcpf(li_l[crow(r, hi)]);
  if constexpr (OUTMODE == 0) {
  unsigned short* Ow = Ob + (long)(wid * QBLK) * ldo;
#pragma unroll
  for (int r = 0; r < 16; ++r) { const int orow = crow(r, hi);
#pragma unroll
    for (int d0 = 0; d0 < DV / 32; ++d0) Ow[(long)orow * ldo + d0 * 32 + r32] = (unsigned short)f2bf(o[d0][r] * rli[r]); }
  } else {   int zo_ = 0; asm volatile("" : "+v"(zo_)); const int lane = (int)__builtin_amdgcn_mbcnt_hi(~0u, __builtin_amdgcn_mbcnt_lo(~0u, (unsigned)zo_)), r32 = lane & 31, hi = lane >> 5;
    unsigned short* stg = (unsigned short*)(lds + SHM_ATTN) + wid * 4096;
    if constexpr (OUTMODE == 1) {
#pragma unroll
      for (int d0 = 0; d0 < DV / 32; ++d0)
#pragma unroll
        for (int r = 0; r < 16; ++r) stg[(d0 * 16 + r) * 64 + lane] = (unsigned short)f2bf(o[d0][r] * rli[r]);
    } else {
      unsigned short* Ow = Ob + (long)(wid * QBLK) * ldo;
#pragma unroll
      for (int r = 0; r < 16; ++r) { float v[DV / 32]; float ss = 0.f;
#pragma unroll
        for (int d0 = 0; d0 < DV / 32; ++d0) { v[d0] = bf2f(stg[(d0 * 16 + r) * 64 + lane]) - lam * (o[d0][r] * rli[r]); ss += v[d0] * v[d0]; }
        ss += __shfl_xor(ss, 1); ss += __shfl_xor(ss, 2); ss += __shfl_xor(ss, 4); ss += __shfl_xor(ss, 8); ss += __shfl_xor(ss, 16);
        const float rs = nscale / sqrtf(ss * (1.f / (float)DV) + 1e-6f); const int orow = crow(r, hi);
#pragma unroll
        for (int d0 = 0; d0 < DV / 32; ++d0) Ow[(long)orow * ldo + d0 * 32 + r32] = (unsigned short)f2bf(v[d0] * rs * nw[d0 * 32 + r32]);
        __builtin_amdgcn_sched_barrier(0); }
    }
  }
  __syncthreads();
#undef TROW
#undef SLOAD
#undef SWRITE
#undef RESC
#undef MASK
}
#undef KSWZ
#undef SBAR
}
struct Args { const float* in[32]; float* out; unsigned char* ws; int ph_lo, ph_hi; };
struct Frame {
    LAS unsigned char* lds; char* ldsg;
    volatile LAS unsigned* MISC;
    gu32* ctl;
    int tid, lane, wave, vcu, G, gw, NGW;
    const float* const* in; float* out; unsigned char* ws;
};
enum { I_X = 0, I_C, I_CTX, I_CCTX, I_EMODW, I_EMODB, I_ENORMS, I_EWIN, I_ECONV, I_EALOG, I_EDTB, I_EGDNN, I_ESINK, I_EWOUT, I_EFG, I_EFU, I_EFD,
       I_OMODW, I_OMODB, I_ONORMS, I_OWIN, I_OQN, I_OKVN, I_OWUQ, I_OWUKV, I_OLAM, I_OSUBLN, I_OWOUT, I_OROUTER, I_OXG, I_OXU, I_OXD };

__device__ __forceinline__ void transpose_item(const float* W, int N, bf16* WT, int ldk, int k0, int n0, int drow0, const float* kscale, LAS float* scr, int lane) {
#pragma unroll 8
    for (int i = 0; i < 32; ++i) { const int kk = 2 * i + (lane >> 5); float v = W[(size_t)(k0 + kk) * N + n0 + (lane & 31)]; if (kscale) v *= kscale[k0 + kk]; scr[kk * 33 + (lane & 31)] = v; }
    LDS_WAIT(); asm volatile("" ::: "memory");
    const int c = lane & 7;
#pragma unroll
    for (int j = 0; j < 4; ++j) { const int n = (lane >> 3) + 8 * j; const LAS float* s = scr + (8 * c) * 33 + n;
        v4u o; o.x = pk2(s[0 * 33], s[1 * 33]); o.y = pk2(s[2 * 33], s[3 * 33]); o.z = pk2(s[4 * 33], s[5 * 33]); o.w = pk2(s[6 * 33], s[7 * 33]);
        *(GAS v4u*)(WT + (size_t)(drow0 + n) * ldk + k0 + 8 * c) = o; }
    LDS_WAIT(); asm volatile("" ::: "memory");
}
template <int MAP> __device__ __forceinline__ void transpose_job(Frame& F, const float* W, int K, int N, bf16* WT, const float* kscale, int first, int stride, LAS unsigned char* scrb) {
    LAS float* scr = (LAS float*)scrb;
    const int nblk = N / 32, items = (K / 64) * nblk;
    for (int it = first; it < items; it += stride) { const int kb = it / nblk, nb = it % nblk, n0 = 32 * nb;
        const int drow0 = (MAP == 0) ? n0 : ((n0 >> 7) * 256 + (n0 & 127) + (MAP == 2 ? 128 : 0));
        transpose_item(W, N, WT, K, 64 * kb, n0, drow0, kscale, scr, F.lane); }
}
__device__ __forceinline__ void zero_rows(Frame& F, bf16* WT, int row0, int nrows, int K) {
    const size_t n16 = (size_t)nrows * K / 8; GAS v4u* p = (GAS v4u*)(WT + (size_t)row0 * K);
    for (size_t i = (size_t)F.gw * 64 + F.lane; i < n16; i += (size_t)F.NGW * 64) p[i] = (v4u){0u, 0u, 0u, 0u};
}
__device__ __forceinline__ void modv_items(Frame& F) {
    LAS float* sc = (LAS float*)(F.lds + RING_OFF);
    LAS float* part = (LAS float*)(F.lds + RING_OFF + 20480);
    float* MODV = (float*)(F.ws + WS_MODV);
    const int nitems = 2 * 96;
    if ((int)blockIdx.x >= nitems) return;
    for (int i = F.tid; i < 5 * 1024; i += 512) { const int r = i >> 10, k = i & 1023; const float v = (r < 4) ? F.in[I_C][r * 1024 + k] : F.in[I_CCTX][k]; sc[i] = siluf(v); }
    __syncthreads();
    for (int it = blockIdx.x; it < nitems; it += F.G) {
        const int l = it / 96, n0 = (it % 96) * 64, col = F.tid & 63, ks = F.tid >> 6;
        const float* W = F.in[l ? I_OMODW : I_EMODW] + (size_t)(ks * 128) * 6144 + n0 + col;
        float a0 = 0, a1 = 0, a2 = 0, a3 = 0, a4 = 0;
#pragma unroll 8
        for (int k = 0; k < 128; ++k) { const float w = W[(size_t)k * 6144]; const int kk = ks * 128 + k;
            a0 += sc[kk] * w; a1 += sc[1024 + kk] * w; a2 += sc[2048 + kk] * w; a3 += sc[3072 + kk] * w; a4 += sc[4096 + kk] * w; }
        part[(ks * 5 + 0) * 64 + col] = a0; part[(ks * 5 + 1) * 64 + col] = a1; part[(ks * 5 + 2) * 64 + col] = a2; part[(ks * 5 + 3) * 64 + col] = a3; part[(ks * 5 + 4) * 64 + col] = a4;
        __syncthreads();
        if (F.tid < 320) { const int r = F.tid >> 6, c2 = F.tid & 63; float s = F.in[l ? I_OMODB : I_EMODB][n0 + c2];
#pragma unroll
            for (int q = 0; q < 8; ++q) s += part[(q * 5 + r) * 64 + c2];
            MODV[(size_t)(l * 5 + r) * 6144 + n0 + c2] = s; }
        __syncthreads();
    }
}
__device__ __forceinline__ const float* modvec(Frame& F, int l, int mr, int k) { return (const float*)(F.ws + WS_MODV) + (size_t)((l * 5 + mr) * 6 + k) * 1024; }

struct Row4 { f32x4 v[4]; };
__device__ __forceinline__ Row4 ld_row_f32(const float* p, int lane) { Row4 r; const GAS f32x4* q = (const GAS f32x4*)p + lane;
#pragma unroll
    for (int j = 0; j < 4; ++j) r.v[j] = q[64 * j]; return r; }
__device__ __forceinline__ Row4 ld_row_bf16(const bf16* p, int lane) { Row4 r; const GAS v2u* q = (const GAS v2u*)p + lane;
#pragma unroll
    for (int j = 0; j < 4; ++j) { const v2u w = q[64 * j]; r.v[j] = (f32x4){bflo(w.x), bfhi(w.x), bflo(w.y), bfhi(w.y)}; } return r; }
__device__ __forceinline__ void st_row_f32(float* p, int lane, const Row4& r) { GAS f32x4* q = (GAS f32x4*)p + lane;
#pragma unroll
    for (int j = 0; j < 4; ++j) q[64 * j] = r.v[j]; }
__device__ __forceinline__ void st_row_bf16(bf16* p, int lane, const Row4& r) { GAS v2u* q = (GAS v2u*)p + lane;
#pragma unroll
    for (int j = 0; j < 4; ++j) q[64 * j] = (v2u){pk2(r.v[j].x, r.v[j].y), pk2(r.v[j].z, r.v[j].w)}; }
__device__ __forceinline__ float row_rstd(const Row4& r) { float s = 0.f;
#pragma unroll
    for (int j = 0; j < 4; ++j) s += (r.v[j].x * r.v[j].x + r.v[j].y * r.v[j].y) + (r.v[j].z * r.v[j].z + r.v[j].w * r.v[j].w);
    return 1.f / sqrtf(wave_sum(s) * (1.f / 1024.f) + EPS); }
__device__ __forceinline__ float* xres_ptr(Frame& F, int r, int& mr) { const int b = r / SROW, s = r - b * SROW;
    if (s < TC) { mr = 4; return (float*)(F.ws + WS_HCTX) + (size_t)(b * TC + s) * D; }
    mr = b; return F.out + (size_t)(b * T + s - TC) * D; }
__device__ __forceinline__ Row4 norm_mod(const Row4& x, const float* w, const float* shift, const float* scale, int lane) {
    const float rs = row_rstd(x); const Row4 W = ld_row_f32(w, lane), SH = ld_row_f32(shift, lane), SC = ld_row_f32(scale, lane); Row4 a;
#pragma unroll
    for (int j = 0; j < 4; ++j) a.v[j] = (x.v[j] * rs * W.v[j]) * (SC.v[j] + 1.f) + SH.v[j];
    return a; }
__device__ __forceinline__ void add_gated_norm(Row4& x, const Row4& y, const float* w, const float* gate, int lane) {
    const float rs = row_rstd(y); const Row4 W = ld_row_f32(w, lane), G = ld_row_f32(gate, lane);
#pragma unroll
    for (int j = 0; j < 4; ++j) x.v[j] = x.v[j] + G.v[j] * (y.v[j] * rs * W.v[j]); }
__device__ __forceinline__ void p0_prologue(Frame& F) {
    modv_items(F);
    __syncthreads();
    transpose_job<0>(F, F.in[I_EWIN], 1024, EIN, (bf16*)(F.ws + WS_WEIN), nullptr, F.gw, F.NGW, F.lds + RING_OFF + F.wave * 16384);
    zero_rows(F, (bf16*)(F.ws + WS_WEIN), EIN, EINP - EIN, 1024);
}
__device__ __forceinline__ void p0_deferred(Frame& F, int w4, LAS unsigned char* scr) {
    const float* const* in = F.in; unsigned char* ws = F.ws; const int gw = F.vcu * 4 + w4, N = F.G * 4;
    transpose_job<0>(F, in[I_EWOUT], 1024, 1024, (bf16*)(ws + WS_WEOUT), nullptr, gw, N, scr);
    transpose_job<1>(F, in[I_EFG], 1024, DFF, (bf16*)(ws + WS_WEGU), nullptr, (gw + 512) % N, N, scr);
    transpose_job<2>(F, in[I_EFU], 1024, DFF, (bf16*)(ws + WS_WEGU), nullptr, (gw + 896) % N, N, scr);
    transpose_job<0>(F, in[I_EFD], DFF, 1024, (bf16*)(ws + WS_WEDN), nullptr, (gw + 256) % N, N, scr);
    transpose_job<0>(F, in[I_OWIN], 1024, OIN, (bf16*)(ws + WS_WOIN), nullptr, (gw + 640) % N, N, scr);
    transpose_job<0>(F, in[I_OWUQ], 384, 768, (bf16*)(ws + WS_WUQ), in[I_OQN], (gw + 720) % N, N, scr);
    transpose_job<0>(F, in[I_OWUKV], 256, 1024, (bf16*)(ws + WS_WUKV), in[I_OKVN], (gw + 864) % N, N, scr);
    transpose_job<0>(F, in[I_OWOUT], 1024, 1024, (bf16*)(ws + WS_WOOUT), nullptr, (gw + 992) % N, N, scr);
    { const size_t n16 = (size_t)(OINP - OIN) * 1024 / 8; GAS v4u* p = (GAS v4u*)((bf16*)(ws + WS_WOIN) + (size_t)OIN * 1024);
      for (size_t i = (size_t)gw * 64 + F.lane; i < n16; i += (size_t)N * 64) p[i] = (v4u){0u, 0u, 0u, 0u}; }
}
__device__ __forceinline__ void px_expert_weights(Frame& F) {
    for (int e = 0; e < NEXP; ++e) {
        transpose_job<1>(F, F.in[I_OXG] + (size_t)e * 1024 * DFX, 1024, DFX, (bf16*)(F.ws + WS_WXGU) + (size_t)e * 7168 * 1024, nullptr, (F.gw + e * 448) % F.NGW, F.NGW, F.lds + RING_OFF + F.wave * 16384);
        transpose_job<2>(F, F.in[I_OXU] + (size_t)e * 1024 * DFX, 1024, DFX, (bf16*)(F.ws + WS_WXGU) + (size_t)e * 7168 * 1024, nullptr, (F.gw + e * 448 + 224) % F.NGW, F.NGW, F.lds + RING_OFF + F.wave * 16384);
        transpose_job<0>(F, F.in[I_OXD] + (size_t)e * DFX * 1024, DFX, 1024, (bf16*)(F.ws + WS_WXDN) + (size_t)e * 1024 * DFX, nullptr, (F.gw + e * 448 + 112) % F.NGW, F.NGW, F.lds + RING_OFF + F.wave * 16384);
    }
}
__device__ __forceinline__ void p1_first_rows(Frame& F) {
    bf16* A = (bf16*)(F.ws + WS_ABUF); const float* w0 = F.in[I_ENORMS];
    for (int r = F.gw; r < NR; r += F.NGW) { const int b = r / SROW, s = r - b * SROW; int mr; float* xr = xres_ptr(F, r, mr);
        const float* src = (s < TC) ? F.in[I_CTX] + (size_t)(b * TC + s) * D : F.in[I_X] + (size_t)(b * T + s - TC) * D;
        const Row4 x = ld_row_f32(src, F.lane); st_row_f32(xr, F.lane, x);
        const Row4 a = norm_mod(x, w0, modvec(F, 0, mr, 0), modvec(F, 0, mr, 1), F.lane);
        st_row_bf16(A + (size_t)r * D, F.lane, a); }
}
template <bool ROUTER> __device__ __forceinline__ void rows_mid(Frame& F, const bf16* Y, const float* wy, int lg, int kg, const float* w2, int l2, int ks2, bf16* Aout, bool lat_only, int nsl = 0) {
    for (int r = F.gw; r < NR; r += F.NGW) { const int b = r / SROW, s = r - b * SROW; if (lat_only && s < TC) continue; int mr; float* xr = xres_ptr(F, r, mr);
        Row4 x = ld_row_f32(xr, F.lane); Row4 y;
        if (nsl > 0 && s < TC) {
            const float* pp = (const float*)(F.ws + WS_PART) + (size_t)(b * TC + s) * 1024; y = ld_row_f32(pp, F.lane);
            for (int q = 1; q < nsl; ++q) { const Row4 t = ld_row_f32(pp + (size_t)q * 1024 * 1024, F.lane);
#pragma unroll
                for (int j = 0; j < 4; ++j) y.v[j] = y.v[j] + t.v[j]; } }
        else y = ld_row_bf16(Y + (size_t)r * D, F.lane);
        add_gated_norm(x, y, wy, modvec(F, lg, mr, kg), F.lane); st_row_f32(xr, F.lane, x);
        const Row4 a = norm_mod(x, w2, modvec(F, l2, mr, ks2), modvec(F, l2, mr, ks2 + 1), F.lane);
        st_row_bf16(Aout + (size_t)r * D, F.lane, a);
        if constexpr (ROUTER) {
            const float* Rw = F.in[I_OROUTER]; float lg8[8];
#pragma unroll
            for (int e = 0; e < 8; ++e) lg8[e] = 0.f;
#pragma unroll
            for (int j = 0; j < 4; ++j)
#pragma unroll
                for (int q = 0; q < 4; ++q) { const int k = 4 * F.lane + 256 * j + q; const f32x4 r0 = *(const GAS f32x4*)(Rw + (size_t)k * 8), r1 = *(const GAS f32x4*)(Rw + (size_t)k * 8 + 4); const float av = a.v[j][q];
                    lg8[0] += av * r0.x; lg8[1] += av * r0.y; lg8[2] += av * r0.z; lg8[3] += av * r0.w; lg8[4] += av * r1.x; lg8[5] += av * r1.y; lg8[6] += av * r1.z; lg8[7] += av * r1.w; }
#pragma unroll
            for (int e = 0; e < 8; ++e) lg8[e] = wave_sum(lg8[e]);
            int i0 = 0; float v0 = lg8[0];
#pragma unroll
            for (int e = 1; e < 8; ++e) if (lg8[e] > v0) { v0 = lg8[e]; i0 = e; }
            int i1 = -1; float v1 = -3.0e38f;
#pragma unroll
            for (int e = 0; e < 8; ++e) if (e != i0 && lg8[e] > v1) { v1 = lg8[e]; i1 = e; }
            const float e1 = __expf(v1 - v0), w0 = 1.f / (1.f + e1), w1 = e1 * w0;
            if (F.lane == 0) { const int tk = b * T + s - TC;
                int* TOPI = (int*)(F.ws + WS_META + META_TOPI); float* TOPW = (float*)(F.ws + WS_META + META_TOPW); int* RANK = (int*)(F.ws + WS_META + META_RANK);
                TOPI[tk * 2] = i0; TOPI[tk * 2 + 1] = i1; TOPW[tk * 2] = w0; TOPW[tk * 2 + 1] = w1;
                RANK[tk * 2] = (int)__hip_atomic_fetch_add((unsigned*)(F.ctl + CW_MOECNT + 64 * i0), 1u, RLX_AGENT);
                RANK[tk * 2 + 1] = (int)__hip_atomic_fetch_add((unsigned*)(F.ctl + CW_MOECNT + 64 * i1), 1u, RLX_AGENT); }
        }
    }
}
__device__ __forceinline__ void g0_prep(Frame& F) {
    const bf16* P = (const bf16*)(F.ws + WS_PROJ); bf16* PW = (bf16*)(F.ws + WS_PROJ); bf16* QK = (bf16*)(F.ws + WS_QKVN); float* GB = (float*)(F.ws + WS_GB);
    const float* cw = F.in[I_ECONV]; const int lane = F.lane;
    for (int r = F.gw; r < NR; r += F.NGW) { const int b = r / SROW, s = r - b * SROW; const bool isc = s < TC; const int p = isc ? s : s - TC, len = isc ? TC : T;
#pragma unroll
        for (int part = 0; part < 3; ++part) { const int ch = part * 512 + 8 * lane; float acc[8];
#pragma unroll
            for (int e = 0; e < 8; ++e) acc[e] = 0.f;
#pragma unroll
            for (int j = 0; j < 5; ++j) { const int pp = p + j - 2; if (pp >= 0 && pp < len) {
                    const v4u xv = *(const GAS v4u*)(P + (size_t)(r + j - 2) * EINP + ch); const f32x4 w0 = *(const GAS f32x4*)(cw + j * 1536 + ch), w1 = *(const GAS f32x4*)(cw + j * 1536 + ch + 4);
                    acc[0] += bflo(xv.x) * w0.x; acc[1] += bfhi(xv.x) * w0.y; acc[2] += bflo(xv.y) * w0.z; acc[3] += bfhi(xv.y) * w0.w;
                    acc[4] += bflo(xv.z) * w1.x; acc[5] += bfhi(xv.z) * w1.y; acc[6] += bflo(xv.w) * w1.z; acc[7] += bfhi(xv.w) * w1.w; } }
            float ss = 0.f;
#pragma unroll
            for (int e = 0; e < 8; ++e) { acc[e] = siluf(acc[e]); ss += acc[e] * acc[e]; }
            if (part < 2) { ss += __shfl_xor(ss, 1); ss += __shfl_xor(ss, 2); ss += __shfl_xor(ss, 4); const float sc = (part == 0 ? 0.125f : 1.f) / sqrtf(ss + EPS);
#pragma unroll
                for (int e = 0; e < 8; ++e) acc[e] *= sc; }
            *(GAS v4u*)(QK + (size_t)r * 1536 + ch) = (v4u){pk2(acc[0], acc[1]), pk2(acc[2], acc[3]), pk2(acc[4], acc[5]), pk2(acc[6], acc[7])}; }
        if (lane < 16) { const float ga = bf2f(P[(size_t)r * EINP + E_GA + lane]), gb = bf2f(P[(size_t)r * EINP + E_GB + lane]);
            const float xx = ga + F.in[I_EDTB][lane], sp = fmaxf(xx, 0.f) + log1pf(__expf(-fabsf(xx)));
            GB[(size_t)r * 32 + lane] = -__expf(F.in[I_EALOG][lane]) * sp; GB[(size_t)r * 32 + 16 + lane] = 1.f / (1.f + __expf(-gb)); }
        if (!isc) {
            const int pi = lane & 31, seg = pi >> 4, i = pi & 15, d0 = seg * 32 + i; const float pos = (float)(seg ? (p & 63) : (p >> 6));
            const float ang = pos * __powf(10000.f, -(float)i * (1.f / 16.f)); float sn, cs; sincosf(ang, &sn, &cs);
#pragma unroll
            for (int q = 0; q < 5; ++q) { const int hh = (lane >> 5) + 2 * q; bf16* base = PW + (size_t)r * EINP + (hh < 8 ? E_SQ + hh * 64 : E_SK + (hh - 8) * 64) + d0;
                const float x0 = bf2f(base[0]), x1 = bf2f(base[16]); base[0] = (bf16)f2bf(x0 * cs - x1 * sn); base[16] = (bf16)f2bf(x1 * cs + x0 * sn); }
        }
    }
}
constexpr int GP = 65, GLP = 68;
template <int I> struct SolveRow {
    static __device__ __forceinline__ void run(float (&x)[64], const LAS float* Ls) {
        SolveRow<I - 1>::run(x, Ls);
        float a = x[I];
#pragma unroll
        for (int j = 0; j < I; ++j) a -= Ls[I * GLP + j] * x[j];
        x[I] = a;
    }
};
template <> struct SolveRow<0> { static __device__ __forceinline__ void run(float (&)[64], const LAS float*) {} };

__device__ __forceinline__ void gdn_chain(Frame& F, int chain) {
    const int b = chain >> 4, h = (chain >> 1) & 7, dir = chain & 1;
    LAS float* Ss = (LAS float*)(F.lds + RING_OFF);
    LAS float* Qs = Ss + 64 * GP, *Ks = Qs + 64 * GP, *Vs = Ks + 64 * GP  , *ATs = Vs + 64 * GP, *Ws = ATs + 64 * GP, *VNs = Ws + 64 * GP;
    LAS float* Ls = VNs + 64 * GP;
    LAS float* gcs = Ls + 64 * GLP, *bts = gcs + 64;
    const bf16* QK = (const bf16*)(F.ws + WS_QKVN); const float* GB = (const float*)(F.ws + WS_GB); bf16* OG = (bf16*)(F.ws + WS_OG);
    const int tid = F.tid, lane = F.lane, w = F.wave;
    for (int i = tid; i < 64 * GP; i += 512) Ss[i] = 0.f;
    for (int ci = 0; ci < 68; ++ci) {
        const bool isc = ci < 4; const int n0 = (isc ? ci : ci - 4) * 64; const int rbase = b * SROW + (isc ? 0 : TC), len = isc ? TC : T;
        __syncthreads();
        for (int e = tid; e < 64 * 24; e += 512) { const int i = e / 24, c8 = e % 24, part = c8 >> 3, cc = (c8 & 7) * 8; const int n = n0 + i, row = rbase + (dir ? len - 1 - n : n);
            const v4u xv = *(const GAS v4u*)(QK + (size_t)row * 1536 + part * 512 + h * 64 + cc); LAS float* dst = (part == 0 ? Qs : part == 1 ? Ks : Vs) + i * GP + cc;
            dst[0] = bflo(xv.x); dst[1] = bfhi(xv.x); dst[2] = bflo(xv.y); dst[3] = bfhi(xv.y); dst[4] = bflo(xv.z); dst[5] = bfhi(xv.z); dst[6] = bflo(xv.w); dst[7] = bfhi(xv.w); }
        if (tid < 64) { const int n = n0 + tid, row = rbase + (dir ? len - 1 - n : n); float g = GB[(size_t)row * 32 + dir * 8 + h]; bts[tid] = GB[(size_t)row * 32 + 16 + dir * 8 + h];
#pragma unroll
            for (int o = 1; o < 64; o <<= 1) { const float t = __shfl_up(g, o); if (lane >= o) g += t; }
            gcs[tid] = g; }
        __syncthreads();
#pragma unroll 1
        for (int k = 0; k < 8; ++k) { const int i = w + 8 * k, j = lane; float kk = 0.f, qk = 0.f;
#pragma unroll 16
            for (int d = 0; d < 64; ++d) { const float kj = Ks[j * GP + d]; kk += Ks[i * GP + d] * kj; qk += Qs[i * GP + d] * kj; }
            const float dec = (j <= i) ? __expf(gcs[i] - gcs[j]) : 0.f;
            Ls[i * GLP + j] = (j < i) ? bts[i] * kk * dec : 0.f; ATs[i * GP + j] = qk * dec; }
        __syncthreads();
        if (tid < 128) { float x[64]; const int c = tid & 63; const bool isw = tid >= 64; int zz = 0; asm volatile("" : "+v"(zz));
            const LAS float* src = (isw ? Ks : Vs) + c; const LAS float* btz = bts + zz; const LAS float* gcz = gcs + zz;
#pragma unroll
            for (int i = 0; i < 64; ++i) { const float e = isw ? __expf(gcz[i]) : 1.f; x[i] = src[i * GP] * btz[i] * e; }
            SolveRow<63>::run(x, Ls + zz);
            LAS float* dst = isw ? Ws : Vs;
#pragma unroll
            for (int i = 0; i < 64; ++i) dst[i * GP + c] = x[i]; }
        __syncthreads();
#pragma unroll 1
        for (int k = 0; k < 8; ++k) { const int i = w + 8 * k, d = lane; float a = Vs[i * GP + d];
#pragma unroll 16
            for (int q = 0; q < 64; ++q) a -= Ws[i * GP + q] * Ss[q * GP + d];
            VNs[i * GP + d] = a; }
        __syncthreads();
#pragma unroll 1
        for (int k = 0; k < 8; ++k) { const int i = w + 8 * k, d = lane; float a = 0.f, c2 = 0.f;
#pragma unroll 16
            for (int q = 0; q < 64; ++q) { a += Qs[i * GP + q] * Ss[q * GP + d]; c2 += ATs[i * GP + q] * VNs[q * GP + d]; }
            const int n = n0 + i, row = rbase + (dir ? len - 1 - n : n);
            OG[(size_t)row * 1024 + dir * 512 + h * 64 + d] = (bf16)f2bf(a * __expf(gcs[i]) + c2); }
        __syncthreads();
        const float gl = gcs[63];
#pragma unroll 1
        for (int k = 0; k < 8; ++k) { const int a = w + 8 * k, d = lane; float acc = Ss[a * GP + d] * __expf(gl);
#pragma unroll 16
            for (int i = 0; i < 64; ++i) acc += Ks[i * GP + a] * __expf(gl - gcs[i]) * VNs[i * GP + d];
            Ss[a * GP + d] = acc; }
    }
    __syncthreads();
}
__device__ __forceinline__ void g4_gdn_out(Frame& F) {
    const bf16* OG = (const bf16*)(F.ws + WS_OG); const bf16* P = (const bf16*)(F.ws + WS_PROJ); bf16* MIX = (bf16*)(F.ws + WS_MIX); const float* gn = F.in[I_EGDNN]; const int lane = F.lane;
    const f32x4 g0 = *(const GAS f32x4*)(gn + (lane & 7) * 8), g1 = *(const GAS f32x4*)(gn + (lane & 7) * 8 + 4);
    for (int r = F.gw; r < NR; r += F.NGW) {
        const v4u a = *(const GAS v4u*)(OG + (size_t)r * 1024 + 8 * lane), c = *(const GAS v4u*)(OG + (size_t)r * 1024 + 512 + 8 * lane), z = *(const GAS v4u*)(P + (size_t)r * EINP + E_Z + 8 * lane);
        float o[8] = {bflo(a.x) + bflo(c.x), bfhi(a.x) + bfhi(c.x), bflo(a.y) + bflo(c.y), bfhi(a.y) + bfhi(c.y), bflo(a.z) + bflo(c.z), bfhi(a.z) + bfhi(c.z), bflo(a.w) + bflo(c.w), bfhi(a.w) + bfhi(c.w)};
        float ss = 0.f;
#pragma unroll
        for (int e = 0; e < 8; ++e) ss += o[e] * o[e];
        ss += __shfl_xor(ss, 1); ss += __shfl_xor(ss, 2); ss += __shfl_xor(ss, 4);
        const float rs = 1.f / sqrtf(ss * (1.f / 64.f) + EPS);
        const float zz[8] = {bflo(z.x), bfhi(z.x), bflo(z.y), bfhi(z.y), bflo(z.z), bfhi(z.z), bflo(z.w), bfhi(z.w)};
        const float gg[8] = {g0.x, g0.y, g0.z, g0.w, g1.x, g1.y, g1.z, g1.w};
#pragma unroll
        for (int e = 0; e < 8; ++e) o[e] = o[e] * rs * gg[e] * siluf(zz[e]);
        *(GAS v4u*)(MIX + (size_t)r * 1024 + 8 * lane) = (v4u){pk2(o[0], o[1]), pk2(o[2], o[3]), pk2(o[4], o[5]), pk2(o[6], o[7])}; }
}
__device__ __forceinline__ void swa_unit(Frame& F, int u) {
    const bf16* P = (const bf16*)(F.ws + WS_PROJ); bf16* MIX = (bf16*)(F.ws + WS_MIX);
    constexpr float SC = 0.125f, C = SC * 1.4426950408889634f, THRS = att::THR / SC;
    if (u < 512) { const int b = u >> 7, qb = (u >> 3) & 15, hq = u & 7, kvh = hq >> 2; const size_t rq = (size_t)b * SROW + TC + qb * 256, r0 = (size_t)b * SROW;
        const int lat0 = qb * 256 - 128 < 0 ? 0 : qb * 256 - 128, lend = qb * 256 + 384 > T ? T : qb * 256 + 384, NT = 4 + (lend - lat0) / 64;
        att::attn_unit<64, 64, 1>(P + rq * EINP + E_SQ + hq * 64, EINP, P + r0 * EINP + E_SK + kvh * 64, EINP, P + r0 * EINP + E_SV + kvh * 64, EINP,
                                  MIX + rq * 1024 + 512 + hq * 64, 1024, NT, lat0, qb * 256, C, THRS, F.in[I_ESINK][hq] * 1.4426950408889634f, F.ldsg + RING_OFF);
    } else { const int v = u - 512, b = v >> 3, hq = v & 7, kvh = hq >> 2; const size_t r0 = (size_t)b * SROW;
        att::attn_unit<64, 64, 2>(P + r0 * EINP + E_SQ + hq * 64, EINP, P + r0 * EINP + E_SK + kvh * 64, EINP, P + r0 * EINP + E_SV + kvh * 64, EINP,
                                  MIX + r0 * 1024 + 512 + hq * 64, 1024, 4, 0, 0, C, THRS, F.in[I_ESINK][hq] * 1.4426950408889634f, F.ldsg + RING_OFF); }
}
namespace gdn {
using bf16x8 = __attribute__((ext_vector_type(8))) short;
using f32x16 = __attribute__((ext_vector_type(16))) float;
using u32x4  = __attribute__((ext_vector_type(4))) unsigned;
__device__ __forceinline__ int crow(int r, int hi) { return (r & 3) + 8 * (r >> 2) + 4 * hi; }
typedef float f32x2_t __attribute__((ext_vector_type(2))); typedef __bf16 bf16x2_t __attribute__((ext_vector_type(2)));
__device__ __forceinline__ unsigned cvtpk(float lo, float hi) { f32x2_t v = {lo, hi}; bf16x2_t b = __builtin_convertvector(v, bf16x2_t); return __builtin_bit_cast(unsigned, b); }
__device__ __forceinline__ int swap23(int p) { return (p & ~0xC) | ((p & 4) << 1) | ((p & 8) >> 1); }
typedef float f32x4g __attribute__((ext_vector_type(4)));
template <int I> struct LRow {
    static constexpr int NQ = (I + 3) / 4, O = I * 128;
    static __device__ __forceinline__ void load(f32x4g (&b)[8], unsigned la) {
        if constexpr (NQ == 1) asm volatile("ds_read_b128 %0, %1 offset:%2\n\ts_waitcnt lgkmcnt(0)" : "=&v"(b[0]) : "v"(la), "i"(O));
        else if constexpr (NQ == 2) asm volatile("ds_read_b128 %0, %2 offset:%3\n\tds_read_b128 %1, %2 offset:%4\n\ts_waitcnt lgkmcnt(0)" : "=&v"(b[0]), "=&v"(b[1]) : "v"(la), "i"(O), "i"(O + 16));
        else if constexpr (NQ == 3) asm volatile("ds_read_b128 %0, %3 offset:%4\n\tds_read_b128 %1, %3 offset:%5\n\tds_read_b128 %2, %3 offset:%6\n\ts_waitcnt lgkmcnt(0)" : "=&v"(b[0]), "=&v"(b[1]), "=&v"(b[2]) : "v"(la), "i"(O), "i"(O + 16), "i"(O + 32));
        else if constexpr (NQ == 4) asm volatile("ds_read_b128 %0, %4 offset:%5\n\tds_read_b128 %1, %4 offset:%6\n\tds_read_b128 %2, %4 offset:%7\n\tds_read_b128 %3, %4 offset:%8\n\ts_waitcnt lgkmcnt(0)" : "=&v"(b[0]), "=&v"(b[1]), "=&v"(b[2]), "=&v"(b[3]) : "v"(la), "i"(O), "i"(O + 16), "i"(O + 32), "i"(O + 48));
        else if constexpr (NQ == 5) asm volatile("ds_read_b128 %0, %5 offset:%6\n\tds_read_b128 %1, %5 offset:%7\n\tds_read_b128 %2, %5 offset:%8\n\tds_read_b128 %3, %5 offset:%9\n\tds_read_b128 %4, %5 offset:%10\n\ts_waitcnt lgkmcnt(0)" : "=&v"(b[0]), "=&v"(b[1]), "=&v"(b[2]), "=&v"(b[3]), "=&v"(b[4]) : "v"(la), "i"(O), "i"(O + 16), "i"(O + 32), "i"(O + 48), "i"(O + 64));
        else if constexpr (NQ == 6) asm volatile("ds_read_b128 %0, %6 offset:%7\n\tds_read_b128 %1, %6 offset:%8\n\tds_read_b128 %2, %6 offset:%9\n\tds_read_b128 %3, %6 offset:%10\n\tds_read_b128 %4, %6 offset:%11\n\tds_read_b128 %5, %6 offset:%12\n\ts_waitcnt lgkmcnt(0)" : "=&v"(b[0]), "=&v"(b[1]), "=&v"(b[2]), "=&v"(b[3]), "=&v"(b[4]), "=&v"(b[5]) : "v"(la), "i"(O), "i"(O + 16), "i"(O + 32), "i"(O + 48), "i"(O + 64), "i"(O + 80));
        else if constexpr (NQ == 7) asm volatile("ds_read_b128 %0, %7 offset:%8\n\tds_read_b128 %1, %7 offset:%9\n\tds_read_b128 %2, %7 offset:%10\n\tds_read_b128 %3, %7 offset:%11\n\tds_read_b128 %4, %7 offset:%12\n\tds_read_b128 %5, %7 offset:%13\n\tds_read_b128 %6, %7 offset:%14\n\ts_waitcnt lgkmcnt(0)" : "=&v"(b[0]), "=&v"(b[1]), "=&v"(b[2]), "=&v"(b[3]), "=&v"(b[4]), "=&v"(b[5]), "=&v"(b[6]) : "v"(la), "i"(O), "i"(O + 16), "i"(O + 32), "i"(O + 48), "i"(O + 64), "i"(O + 80), "i"(O + 96));
        else asm volatile("ds_read_b128 %0, %8 offset:%9\n\tds_read_b128 %1, %8 offset:%10\n\tds_read_b128 %2, %8 offset:%11\n\tds_read_b128 %3, %8 offset:%12\n\tds_read_b128 %4, %8 offset:%13\n\tds_read_b128 %5, %8 offset:%14\n\tds_read_b128 %6, %8 offset:%15\n\tds_read_b128 %7, %8 offset:%16\n\ts_waitcnt lgkmcnt(0)" : "=&v"(b[0]), "=&v"(b[1]), "=&v"(b[2]), "=&v"(b[3]), "=&v"(b[4]), "=&v"(b[5]), "=&v"(b[6]), "=&v"(b[7]) : "v"(la), "i"(O), "i"(O + 16), "i"(O + 32), "i"(O + 48), "i"(O + 64), "i"(O + 80), "i"(O + 96), "i"(O + 112));
    }
};
template <int I> struct Solve32 {
    static __device__ __forceinline__ void run(float (&x)[32], unsigned la) {
#ifdef SOLVE_C_LOAD
        f32x4g b[8]; { const LAS f32x4g* Lp = (const LAS f32x4g*)(uintptr_t)(la + I * 128);
#pragma unroll
          for (int q = 0; q < (I + 3) / 4; ++q) b[q] = Lp[q]; }
#else
        f32x4g b[8]; LRow<I>::load(b, la);
#endif
        float a = x[I];
#pragma unroll
#ifdef SOLVE_C_FMA
        for (int j = 0; j < I; ++j) a = __builtin_fmaf(-b[j >> 2][j & 3], x[j], a);
#else
        for (int j = 0; j < I; ++j) asm volatile("v_fma_f32 %0, -%1, %2, %0" : "+v"(a) : "v"(b[j >> 2][j & 3]), "v"(x[j]));
#endif
        x[I] = a;
        if constexpr (I < 31) Solve32<I + 1>::run(x, la);
    }
};
__device__ __forceinline__ void solve32(float (&x)[32], unsigned la) { Solve32<1>::run(x, la); }
__device__ __forceinline__ void col_frags32(const float (&x)[32], bf16x8 (&F)[4][2], int s0) {
#pragma unroll
    for (int s = 0; s < 2; ++s) {
        const unsigned p0[4] = {cvtpk(x[16 * s + 0], x[16 * s + 1]), cvtpk(x[16 * s + 2], x[16 * s + 3]), cvtpk(x[16 * s + 8], x[16 * s + 9]), cvtpk(x[16 * s + 10], x[16 * s + 11])};
        const unsigned p1[4] = {cvtpk(x[16 * s + 4], x[16 * s + 5]), cvtpk(x[16 * s + 6], x[16 * s + 7]), cvtpk(x[16 * s + 12], x[16 * s + 13]), cvtpk(x[16 * s + 14], x[16 * s + 15])};
        u32x4 f0, f1;
#pragma unroll
        for (int q = 0; q < 4; ++q) { auto r = __builtin_amdgcn_permlane32_swap(p0[q], p1[q], false, false); f0[q] = r[0]; f1[q] = r[1]; }
        F[s0 + s][0] = __builtin_bit_cast(bf16x8, f0); F[s0 + s][1] = __builtin_bit_cast(bf16x8, f1); }
}
__device__ __forceinline__ void solve_blocked(float (&x1)[32], float (&x2)[32], unsigned la, const bf16x8 (&L21A)[2], bf16x8 (&F)[4][2]) {
    solve32(x1, la);
    col_frags32(x1, F, 0);
    f32x16 t0 = f32x16{}, t1 = f32x16{};
    t0 = __builtin_amdgcn_mfma_f32_32x32x16_bf16(L21A[0], F[0][0], t0, 0, 0, 0); t0 = __builtin_amdgcn_mfma_f32_32x32x16_bf16(L21A[1], F[1][0], t0, 0, 0, 0);
    t1 = __builtin_amdgcn_mfma_f32_32x32x16_bf16(L21A[0], F[0][1], t1, 0, 0, 0); t1 = __builtin_amdgcn_mfma_f32_32x32x16_bf16(L21A[1], F[1][1], t1, 0, 0, 0);
#pragma unroll
    for (int r = 0; r < 16; ++r) { const float e0 = t0[r], e1 = t1[r]; auto sw = __builtin_amdgcn_permlane32_swap(__float_as_uint(e0), __float_as_uint(e1), false, false);
        x2[(r & 3) + 8 * (r >> 2)] -= __uint_as_float(sw[0]); x2[(r & 3) + 8 * (r >> 2) + 4] -= __uint_as_float(sw[1]); }
    __builtin_amdgcn_sched_barrier(0);
    solve32(x2, la + 4096u);
    col_frags32(x2, F, 2);
}
__device__ __forceinline__ bf16x8 acc_frag(const f32x16& t, int sp) {
    u32x4 w;
    if (sp == 0) { w[0] = cvtpk(t[0], t[1]); w[1] = cvtpk(t[2], t[3]); w[2] = cvtpk(t[4], t[5]); w[3] = cvtpk(t[6], t[7]); }
    else { w[0] = cvtpk(t[8], t[9]); w[1] = cvtpk(t[10], t[11]); w[2] = cvtpk(t[12], t[13]); w[3] = cvtpk(t[14], t[15]); }
    return __builtin_bit_cast(bf16x8, w);
}
__device__ __forceinline__ void store_accfrag(__amdgpu_buffer_rsrc_t ro, int soff, int lane, const f32x16& t) {
    __builtin_amdgcn_raw_buffer_store_b128((u32x4){cvtpk(t[0], t[1]), cvtpk(t[2], t[3]), cvtpk(t[4], t[5]), cvtpk(t[6], t[7])}, ro, lane * 32, soff, 0);
    __builtin_amdgcn_raw_buffer_store_b128((u32x4){cvtpk(t[8], t[9]), cvtpk(t[10], t[11]), cvtpk(t[12], t[13]), cvtpk(t[14], t[15])}, ro, lane * 32 + 16, soff, 0);
}
struct ItemGeom { int b, h, dir, rbase, len, n0; };
__device__ __forceinline__ ItemGeom item_geom(int chain, int ci) { ItemGeom g; g.b = chain >> 4; g.h = (chain >> 1) & 7; g.dir = chain & 1; const bool isc = ci < 4;
    g.n0 = (isc ? ci : ci - 4) * 64; g.rbase = g.b * SROW + (isc ? 0 : TC); g.len = isc ? TC : T; return g; }
__device__ __forceinline__ int item_row(const ItemGeom& g, int i) { const int n = g.n0 + i; return g.rbase + (g.dir ? g.len - 1 - n : n); }

#define G1_LANES() int zs_ = 0; asm volatile("" : "+v"(zs_)); const int lane = (int)__builtin_amdgcn_mbcnt_hi(~0u, __builtin_amdgcn_mbcnt_lo(~0u, (unsigned)zs_)), r32 = lane & 31, hi = lane >> 5; (void)r32; (void)hi
__device__ __forceinline__ void pair_lock(volatile LAS unsigned* w) {
    for (;;) { unsigned got = 0u; if (__builtin_amdgcn_mbcnt_hi(~0u, __builtin_amdgcn_mbcnt_lo(~0u, 0u)) == 0u) got = (__hip_atomic_exchange((LAS unsigned*)w, 1u, __ATOMIC_RELAXED, __HIP_MEMORY_SCOPE_WORKGROUP) == 0u) ? 1u : 0u;
        got = (unsigned)__builtin_amdgcn_readfirstlane((int)got); if (got) break; __builtin_amdgcn_s_sleep(2); }
    asm volatile("s_waitcnt lgkmcnt(0)" ::: "memory"); }
__device__ __forceinline__ void pair_unlock(volatile LAS unsigned* w) { asm volatile("s_waitcnt vmcnt(0) lgkmcnt(0)" ::: "memory"); if (__builtin_amdgcn_mbcnt_hi(~0u, __builtin_amdgcn_mbcnt_lo(~0u, 0u)) == 0u) __hip_atomic_store((LAS unsigned*)w, 0u, __ATOMIC_RELAXED, __HIP_MEMORY_SCOPE_WORKGROUP); asm volatile("s_waitcnt lgkmcnt(0)" ::: "memory"); }
#ifndef G1_LOCK
#define G1_LOCK 0
#endif
#define LOCK_IF(m) do { if (G1_LOCK & (m)) pair_lock(lockw); } while (0)
#define UNLOCK_IF(m) do { if (G1_LOCK & (m)) pair_unlock(lockw); } while (0)
constexpr int G1_L = 0, G1_ARR = 8192, G1_TK = 9216, G1_TV = 17408, G1_TQ = 17408  , G1_WAVE_LDS = 26624;
__device__ __forceinline__ void g1_item(Frame& F, int item, LAS unsigned char* wl, volatile LAS unsigned* lockw) {
    int zz = 0; asm volatile("" : "+v"(zz)); __builtin_assume((unsigned)zz < 2u);
    const int chain = item / 68, ci = item - chain * 68; const ItemGeom G = item_geom(chain, ci); const int h = G.h;
    LAS float* Ls = (LAS float*)(wl + G1_L); LAS float* gcA = (LAS float*)(wl + G1_ARR), *btA = gcA + 64, *egA = gcA + 128, *etA = gcA + 192;
    const LAS bf16* TK = (const LAS bf16*)(wl + G1_TK); const LAS bf16* TV = (const LAS bf16*)(wl + G1_TV); const LAS bf16* TQ = (const LAS bf16*)(wl + G1_TQ);
    const bf16* QK = (const bf16*)(F.ws + WS_QKVN); const float* GB = (const float*)(F.ws + WS_GB);
    bf16* out = (bf16*)(F.ws + WS_GDNI) + (size_t)item * 16384;
    LOCK_IF(1);
    u32x4 tq[8];
    { G1_LANES(); u32x4 t[2][8];
#pragma unroll
      for (int j = 0; j < 8; ++j) { const int i = (lane >> 3) + 8 * j; const bf16* rp = QK + (size_t)item_row(G, i) * 1536 + h * 64 + (lane & 7) * 8;
          t[0][j] = *(const GAS u32x4*)(rp + 512); t[1][j] = *(const GAS u32x4*)(rp + 1024); tq[j] = *(const GAS u32x4*)rp; }
#pragma unroll
      for (int j = 0; j < 8; ++j) { const int o = ((lane >> 3) + 8 * j) * 128 + (lane & 7) * 16;
          *(LAS u32x4*)(wl + G1_TK + o) = t[0][j]; *(LAS u32x4*)(wl + G1_TV + o) = t[1][j]; } }
    float gl;
    { G1_LANES(); const int row = item_row(G, lane); float g = GB[(size_t)row * 32 + G.dir * 8 + h]; const float bt = GB[(size_t)row * 32 + 16 + G.dir * 8 + h];
#pragma unroll
      for (int o = 1; o < 64; o <<= 1) { const float t = __builtin_bit_cast(float, __builtin_amdgcn_ds_bpermute((lane - o) << 2, __builtin_bit_cast(int, g))); if (lane >= o) g += t; }
      gl = __builtin_bit_cast(float, __builtin_amdgcn_readlane(__builtin_bit_cast(int, g), 63)); gcA[lane] = g; btA[lane] = bt; egA[lane] = __expf(g); etA[lane] = __expf(gl - g); }
    asm volatile("s_waitcnt lgkmcnt(0)" ::: "memory");
    const LAS float* gcz = gcA + zz; const LAS float* btz = btA + zz; const LAS float* egz = egA + zz; const LAS float* etz = etA + zz;
    UNLOCK_IF(1); LOCK_IF(2);
    bf16x8 L21A[2];
    { G1_LANES(); bf16x8 Kf[2][4];
#pragma unroll
      for (int t = 0; t < 2; ++t)
#pragma unroll
          for (int s = 0; s < 4; ++s) Kf[t][s] = *(const LAS bf16x8*)(TK + (32 * t + r32) * 64 + 16 * s + 8 * hi);
#pragma unroll
      for (int t = 0; t < 2; ++t) { f32x16 acc = f32x16{};
#pragma unroll
          for (int s = 0; s < 4; ++s) acc = __builtin_amdgcn_mfma_f32_32x32x16_bf16(Kf[t][s], Kf[t][s], acc, 0, 0, 0);
          const float gcj = gcz[32 * t + r32];
#pragma unroll
          for (int r = 0; r < 16; ++r) { const int il = crow(r, hi), i = 32 * t + il; const float e = __expf(fminf(gcz[i] - gcj, 0.f)); const float v0 = btz[i] * acc[r] * e; Ls[t * 1024 + il * 32 + r32] = (r32 < il) ? v0 : 0.f; } }
      { f32x16 acc = f32x16{};
#pragma unroll
          for (int s = 0; s < 4; ++s) acc = __builtin_amdgcn_mfma_f32_32x32x16_bf16(Kf[0][s], Kf[1][s], acc, 0, 0, 0);
          const int i = 32 + r32; const float gci = gcz[i], bti = btz[i];
#pragma unroll
          for (int r = 0; r < 16; ++r) { const int j = crow(r, hi); acc[r] = bti * acc[r] * __expf(fminf(gci - gcz[j], 0.f)); }
          L21A[0] = acc_frag(acc, 0); L21A[1] = acc_frag(acc, 1); } }
    asm volatile("s_waitcnt lgkmcnt(0)" ::: "memory"); __builtin_amdgcn_sched_barrier(0);
    UNLOCK_IF(2); LOCK_IF(4);
    bf16x8 UF[4][2];
    const unsigned la = (unsigned)(uintptr_t)Ls + ((unsigned)zz << 4);
    { G1_LANES(); float x1[32], x2[32];
#pragma unroll
      for (int i = 0; i < 64; ++i) { const float v = bf2f(TV[i * 64 + lane]) * btz[i]; if (i < 32) x1[i & 31] = v; else x2[i & 31] = v; }
      asm volatile("s_waitcnt lgkmcnt(0)" ::: "memory");
#pragma unroll
      for (int j = 0; j < 8; ++j) *(LAS u32x4*)(wl + G1_TQ + ((lane >> 3) + 8 * j) * 128 + (lane & 7) * 16) = tq[j];
      solve_blocked(x1, x2, la, L21A, UF); }
    __builtin_amdgcn_sched_barrier(0);
    bf16x8 WF[4][2];
    { G1_LANES(); float x1[32], x2[32];
#pragma unroll
      for (int i = 0; i < 64; ++i) { const float v = bf2f(TK[i * 64 + lane]) * btz[i] * egz[i]; if (i < 32) x1[i & 31] = v; else x2[i & 31] = v; }
      solve_blocked(x1, x2, la, L21A, WF); }
    __builtin_amdgcn_sched_barrier(0);
    UNLOCK_IF(4); LOCK_IF(8);
    bf16x8 KTA[4][2];
    { G1_LANES(); float k1[32], k2[32];
#pragma unroll
      for (int i = 0; i < 32; ++i) { k1[i] = bf2f(TK[i * 64 + lane]) * etz[i]; k2[i] = bf2f(TK[(32 + i) * 64 + lane]) * etz[32 + i]; }
      col_frags32(k1, KTA, 0); col_frags32(k2, KTA, 2); }
    __builtin_amdgcn_sched_barrier(0);
    const __amdgpu_buffer_rsrc_t ro = __builtin_amdgcn_make_buffer_rsrc((void*)out, 0, 32768, 0x00020000);
    {
    G1_LANES();
    const float egl = __expf(gl);
#pragma unroll
    for (int at = 0; at < 2; ++at)
#pragma unroll
        for (int ct = 0; ct < 2; ++ct) { f32x16 a0 = f32x16{}, a1 = f32x16{};
#pragma unroll
            for (int s = 0; s < 4; ++s) { a0 = __builtin_amdgcn_mfma_f32_32x32x16_bf16(KTA[s][at], UF[s][ct], a0, 0, 0, 0); a1 = __builtin_amdgcn_mfma_f32_32x32x16_bf16(KTA[s][at], WF[s][ct], a1, 0, 0, 0); }
            store_accfrag(ro, 16384 + (at * 2 + ct) * 2048, lane, a0);
            const int vo = 4 * hi * 128 + (32 * ct + swap23(r32)) * 2;
#pragma unroll
            for (int r = 0; r < 16; ++r) { const float v = ((at == ct && crow(r, hi) == r32) ? egl : 0.f) - a1[r];
                __builtin_amdgcn_raw_buffer_store_b16((short)f2bf(v), ro, vo + (r & 3) * 128 + (r >> 2) * 1024, 32 * at * 128, 0); }
            __builtin_amdgcn_sched_barrier(0); }
    }
    UNLOCK_IF(8); LOCK_IF(16);
    bf16x8 XA[3][2];
    { G1_LANES(); bf16x8 Kf[4], Qf[2][4]; const LAS bf16* TK2 = TK + zz;
#pragma unroll
      for (int t = 0; t < 2; ++t)
#pragma unroll
          for (int s = 0; s < 4; ++s) Qf[t][s] = *(const LAS bf16x8*)(TQ + (32 * t + r32) * 64 + 16 * s + 8 * hi);
#pragma unroll
      for (int tl = 0; tl < 3; ++tl) { const int jt = tl == 2 ? 1 : 0, it = tl == 0 ? 0 : 1;
          if (tl != 1) {
#pragma unroll
              for (int s = 0; s < 4; ++s) Kf[s] = *(const LAS bf16x8*)(TK2 + (32 * jt + r32) * 64 + 16 * s + 8 * hi); }
          f32x16 acc = f32x16{};
#pragma unroll
          for (int s = 0; s < 4; ++s) acc = __builtin_amdgcn_mfma_f32_32x32x16_bf16(Kf[s], Qf[it][s], acc, 0, 0, 0);
          const int i = 32 * it + r32; const float gci = gcz[i];
#pragma unroll
          for (int r = 0; r < 16; ++r) { const int j = 32 * jt + crow(r, hi); const float e = __expf(fminf(gci - gcz[j], 0.f)); const float v0 = acc[r] * e; acc[r] = (j <= i) ? v0 : 0.f; }
          XA[tl][0] = acc_frag(acc, 0); XA[tl][1] = acc_frag(acc, 1); __builtin_amdgcn_sched_barrier(0); } }
    __builtin_amdgcn_sched_barrier(0);
    {
    G1_LANES();
#pragma unroll
    for (int it = 0; it < 2; ++it)
#pragma unroll
        for (int ct = 0; ct < 2; ++ct) { f32x16 a0 = f32x16{}, a1 = f32x16{};
#pragma unroll
            for (int jt = 0; jt <= it; ++jt) { const int tl = (it == 0) ? 0 : (jt == 0 ? 1 : 2);
#pragma unroll
                for (int sp = 0; sp < 2; ++sp) { a0 = __builtin_amdgcn_mfma_f32_32x32x16_bf16(XA[tl][sp], UF[2 * jt + sp][ct], a0, 0, 0, 0); a1 = __builtin_amdgcn_mfma_f32_32x32x16_bf16(XA[tl][sp], WF[2 * jt + sp][ct], a1, 0, 0, 0); } }
            store_accfrag(ro, 24576 + (it * 2 + ct) * 2048, lane, a0);
            const int vo = 4 * hi * 128 + (32 * ct + swap23(r32)) * 2; const int a = 32 * ct + r32;
#pragma unroll
            for (int r = 0; r < 16; ++r) { const int i = 32 * it + crow(r, hi); const float qv = bf2f(TQ[i * 64 + a]);
                __builtin_amdgcn_raw_buffer_store_b16((short)f2bf(qv * egz[i] - a1[r]), ro, vo + (r & 3) * 128 + (r >> 2) * 1024, 8192 + 32 * it * 128, 0); }
            __builtin_amdgcn_sched_barrier(0); }
    }
    asm volatile("s_waitcnt lgkmcnt(0)" ::: "memory");
    UNLOCK_IF(16);
}
__device__ __forceinline__ void scan_chain(Frame& F, int chain) {
    const int w = F.wave, lane = F.lane, r32 = lane & 31, hi = lane >> 5, role = w >> 2, rt = (w >> 1) & 1, dc = w & 1;
    LAS u32x4* SF = (LAS u32x4*)(F.lds + RING_OFF);
    const bf16* base = (const bf16*)(F.ws + WS_GDNI) + (size_t)chain * 68 * 16384; bf16* OG = (bf16*)(F.ws + WS_OG);
    for (int i = F.tid; i < 2 * 2 * 4 * 64; i += 512) SF[i] = (u32x4){0u, 0u, 0u, 0u};
    const bf16* Ab = base + (role ? 4096 : 0) + (32 * rt + r32) * 64 + 8 * hi; const bf16* Cb = base + (role ? 12288 : 8192) + ((rt * 2 + dc) * 64 + lane) * 16;
    struct Ops { bf16x8 a[4]; u32x4 c[2]; };
#define SC_LOAD(o, ci_) do { const bf16* A_ = Ab + (size_t)(ci_) * 16384; const bf16* C_ = Cb + (size_t)(ci_) * 16384; \
        _Pragma("unroll") for (int s_ = 0; s_ < 4; ++s_) (o).a[s_] = *(const GAS bf16x8*)(A_ + 16 * s_); (o).c[0] = *(const GAS u32x4*)C_; (o).c[1] = *(const GAS u32x4*)(C_ + 8); } while (0)
#define SC_STEP(o, ci_) do { f32x16 acc; \
        _Pragma("unroll") for (int q = 0; q < 4; ++q) { acc[2 * q] = bflo((o).c[0][q]); acc[2 * q + 1] = bfhi((o).c[0][q]); acc[8 + 2 * q] = bflo((o).c[1][q]); acc[8 + 2 * q + 1] = bfhi((o).c[1][q]); } \
        const LAS u32x4* Sb = SF + ((((ci_) & 1) * 2 + dc) * 256) + lane; \
        _Pragma("unroll") for (int s_ = 0; s_ < 4; ++s_) { const u32x4 bw = Sb[s_ * 64]; acc = __builtin_amdgcn_mfma_f32_32x32x16_bf16((o).a[s_], __builtin_bit_cast(bf16x8, bw), acc, 0, 0, 0); } \
        if ((ci_) + 4 < 68) SC_LOAD(o, (ci_) + 4); \
        if (role == 0) { LAS u32x4* Sn = SF + ((((((ci_) + 1) & 1) * 2 + dc) * 4 + 2 * rt) * 64) + lane; Sn[0] = __builtin_bit_cast(u32x4, acc_frag(acc, 0)); Sn[64] = __builtin_bit_cast(u32x4, acc_frag(acc, 1)); } \
        else { const ItemGeom G = item_geom(chain, (ci_)); LAS bf16* stg = (LAS bf16*)(F.lds + RING_OFF + 16384 + (w - 4) * 2048);     \
            _Pragma("unroll") for (int r = 0; r < 16; ++r) stg[crow(r, hi) * 32 + r32] = (bf16)f2bf(acc[r]); \
            asm volatile("s_waitcnt lgkmcnt(0)" ::: "memory"); \
            const u32x4 v0 = *(const LAS u32x4*)(stg + (lane >> 1) * 32 + (lane & 1) * 16), v1 = *(const LAS u32x4*)(stg + (lane >> 1) * 32 + (lane & 1) * 16 + 8); \
            GAS u32x4* po = (GAS u32x4*)(OG + (size_t)item_row(G, 32 * rt + (lane >> 1)) * 1024 + G.dir * 512 + G.h * 64 + 32 * dc + (lane & 1) * 16); po[0] = v0; po[1] = v1; } \
        asm volatile("s_waitcnt lgkmcnt(0)" ::: "memory"); __builtin_amdgcn_s_barrier(); asm volatile("" ::: "memory"); } while (0)
    Ops o0, o1, o2, o3;
    SC_LOAD(o0, 0); SC_LOAD(o1, 1); SC_LOAD(o2, 2); SC_LOAD(o3, 3);
    __syncthreads();
#pragma unroll 1
    for (int ci = 0; ci < 68; ci += 4) { SC_STEP(o0, ci); SC_STEP(o1, ci + 1); SC_STEP(o2, ci + 2); SC_STEP(o3, ci + 3); }
#undef SC_LOAD
#undef SC_STEP
    asm volatile("s_waitcnt vmcnt(0)" ::: "memory");
}
}
__device__ __forceinline__ void l1_prep(Frame& F) {
    bf16* P = (bf16*)(F.ws + WS_PROJ2); bf16* KM = (bf16*)(F.ws + WS_KMLA); const int lane = F.lane;
    for (int r = F.gw; r < NR; r += F.NGW) { const int b = r / SROW, s = r - b * SROW; const bool isc = s < TC; const int p = s - TC; bf16* row = P + (size_t)r * OINP;
        { bf16* CQ = (bf16*)(F.ws + WS_CQN) + (size_t)r * 640;
          const v2u a = *(const GAS v2u*)(row + O_CQ + 4 * lane); const v2u c = (lane < 32) ? *(const GAS v2u*)(row + O_CQ + 256 + 4 * lane) : (v2u){0u, 0u}; const v2u k = *(const GAS v2u*)(row + O_CKV + 4 * lane);
          const float a0 = bflo(a.x), a1 = bfhi(a.x), a2 = bflo(a.y), a3 = bfhi(a.y), c0 = bflo(c.x), c1 = bfhi(c.x), c2 = bflo(c.y), c3 = bfhi(c.y), k0 = bflo(k.x), k1 = bfhi(k.x), k2 = bflo(k.y), k3 = bfhi(k.y);
          const float sq = wave_sum(a0 * a0 + a1 * a1 + a2 * a2 + a3 * a3 + c0 * c0 + c1 * c1 + c2 * c2 + c3 * c3), skv = wave_sum(k0 * k0 + k1 * k1 + k2 * k2 + k3 * k3);
          const float rq = 1.f / sqrtf(sq * (1.f / 384.f) + EPS), rk = 1.f / sqrtf(skv * (1.f / 256.f) + EPS);
          *(GAS v2u*)(CQ + 4 * lane) = (v2u){pk2(a0 * rq, a1 * rq), pk2(a2 * rq, a3 * rq)};
          if (lane < 32) *(GAS v2u*)(CQ + 256 + 4 * lane) = (v2u){pk2(c0 * rq, c1 * rq), pk2(c2 * rq, c3 * rq)};
          *(GAS v2u*)(CQ + 384 + 4 * lane) = (v2u){pk2(k0 * rk, k1 * rk), pk2(k2 * rk, k3 * rk)}; }
        if (lane < 16) { const int seg = lane >> 3, i = lane & 7, d0 = seg * 16 + i; float x0 = bf2f(row[O_KR + d0]), x1 = bf2f(row[O_KR + d0 + 8]);
            if (!isc) { const float pos = (float)(seg ? (p & 63) : (p >> 6)); const float ang = pos * __powf(10000.f, -(float)i * (1.f / 8.f)); float sn, cs; sincosf(ang, &sn, &cs);
                const float y0 = x0 * cs - x1 * sn, y1 = x1 * cs + x0 * sn; x0 = y0; x1 = y1; }
            const bf16 b0 = (bf16)f2bf(x0), b1 = (bf16)f2bf(x1);
#pragma unroll
            for (int h = 0; h < 8; ++h) { KM[(size_t)r * 768 + h * 96 + 64 + d0] = b0; KM[(size_t)r * 768 + h * 96 + 64 + d0 + 8] = b1; } }
        if (!isc) {
            const int pi = lane & 31, seg = pi >> 4, i = pi & 15, d0 = seg * 32 + i; const float pos = (float)(seg ? (p & 63) : (p >> 6));
            const float ang = pos * __powf(10000.f, -(float)i * (1.f / 16.f)); float sn, cs; sincosf(ang, &sn, &cs);
#pragma unroll
            for (int q = 0; q < 8; ++q) { const int hh = (lane >> 5) + 2 * q; bf16* base = row + (hh < 8 ? O_DQ + hh * 64 : O_DK + (hh - 8) * 64) + d0;
                const float x0 = bf2f(base[0]), x1 = bf2f(base[16]); base[0] = (bf16)f2bf(x0 * cs - x1 * sn); base[16] = (bf16)f2bf(x1 * cs + x0 * sn); } }
    }
}
__device__ __forceinline__ void l1_qrope(Frame& F) {
    bf16* QM = (bf16*)(F.ws + WS_QM); const int lane = F.lane;
    for (int r = F.gw; r < NR; r += F.NGW) { const int b = r / SROW, s = r - b * SROW; if (s < TC) continue; const int p = s - TC;
        const int pi = lane & 15, seg = pi >> 3, i = pi & 7, d0 = seg * 16 + i; const float pos = (float)(seg ? (p & 63) : (p >> 6));
        const float ang = pos * __powf(10000.f, -(float)i * (1.f / 8.f)); float sn, cs; sincosf(ang, &sn, &cs);
#pragma unroll
        for (int q = 0; q < 2; ++q) { const int h = (lane >> 4) + 4 * q; bf16* base = QM + (size_t)r * 768 + h * 96 + 64 + d0;
            const float x0 = bf2f(base[0]), x1 = bf2f(base[8]); base[0] = (bf16)f2bf(x0 * cs - x1 * sn); base[8] = (bf16)f2bf(x1 * cs + x0 * sn); } }
}
__device__ __forceinline__ void l1_attn_unit(Frame& F, int u) {
    if (u < 512) { const int b = u >> 7, qb = (u >> 3) & 15, h = u & 7; const size_t rq = (size_t)b * SROW + TC + qb * 256, r0 = (size_t)b * SROW;
        constexpr float SC = 0.10206207261596575f  , C = SC * 1.4426950408889634f, THRS = att::THR / SC;
        const bf16* QM = (const bf16*)(F.ws + WS_QM); const bf16* KM = (const bf16*)(F.ws + WS_KMLA); const bf16* VM = (const bf16*)(F.ws + WS_VMLA); bf16* MIX = (bf16*)(F.ws + WS_MIX);
        att::attn_unit<96, 64, 0, true>(QM + rq * 768 + h * 96, 768, KM + r0 * 768 + h * 96, 768, VM + r0 * 512 + h * 64, 512, MIX + rq * 1024 + h * 64, 1024, SROW / 64, 0, qb * 256, C, THRS, -3.0e38f, F.ldsg + RING_OFF);
    } else { const int v = u - 512, b = v >> 6, qb = (v >> 2) & 15, head = v & 3; const size_t rq = (size_t)b * SROW + TC + qb * 256, r0 = (size_t)b * SROW;
        constexpr float SC = 0.125f, C = SC * 1.4426950408889634f, THRS = att::THR / SC; constexpr float LAM_INIT = 0.35550906759096556f;
        const float* lp = F.in[I_OLAM]; const float lam = __expf(wave_sum(lp[F.lane] * lp[64 + F.lane])) - __expf(wave_sum(lp[128 + F.lane] * lp[192 + F.lane])) + LAM_INIT;
        const bf16* P = (const bf16*)(F.ws + WS_PROJ2); bf16* MIX = (bf16*)(F.ws + WS_MIX); const int hh = 2 * head;
        att::attn_unit<64, 128, 0, false, 1>(P + rq * OINP + O_DQ + hh * 64, OINP, P + r0 * OINP + O_DK + hh * 64, OINP, P + r0 * OINP + O_DV + head * 128, OINP, MIX, 1024, SROW / 64, 0, 0, C, THRS, -3.0e38f, F.ldsg + RING_OFF);
        att::attn_unit<64, 128, 0, false, 2>(P + rq * OINP + O_DQ + (hh + 1) * 64, OINP, P + r0 * OINP + O_DK + (hh + 1) * 64, OINP, P + r0 * OINP + O_DV + head * 128, OINP, MIX + rq * 1024 + 512 + head * 128, 1024, SROW / 64, 0, 0, C, THRS, -3.0e38f, F.ldsg + RING_OFF,
                                             lam, F.in[I_OSUBLN], 1.f - LAM_INIT); }
}
__device__ __forceinline__ void l1_diff_post(Frame& F) {
    const bf16* OD = (const bf16*)(F.ws + WS_ODIFF); bf16* MIX = (bf16*)(F.ws + WS_MIX); const int lane = F.lane; const float* lp = F.in[I_OLAM];
    constexpr float LAM_INIT = 0.35550906759096556f;
    const float s01 = wave_sum(lp[lane] * lp[64 + lane]), s23 = wave_sum(lp[128 + lane] * lp[192 + lane]); const float lam = __expf(s01) - __expf(s23) + LAM_INIT;
    const int head = lane >> 4, d = (lane & 15) * 8; const f32x4 w0 = *(const GAS f32x4*)(F.in[I_OSUBLN] + d), w1 = *(const GAS f32x4*)(F.in[I_OSUBLN] + d + 4);
    const float ww[8] = {w0.x, w0.y, w0.z, w0.w, w1.x, w1.y, w1.z, w1.w};
    for (int r = F.gw; r < NR; r += F.NGW) { const int b = r / SROW, s = r - b * SROW; if (s < TC) continue;
        const v4u a = *(const GAS v4u*)(OD + (size_t)r * 1024 + (2 * head) * 128 + d), c = *(const GAS v4u*)(OD + (size_t)r * 1024 + (2 * head + 1) * 128 + d);
        float o[8] = {bflo(a.x) - lam * bflo(c.x), bfhi(a.x) - lam * bfhi(c.x), bflo(a.y) - lam * bflo(c.y), bfhi(a.y) - lam * bfhi(c.y), bflo(a.z) - lam * bflo(c.z), bfhi(a.z) - lam * bfhi(c.z), bflo(a.w) - lam * bflo(c.w), bfhi(a.w) - lam * bfhi(c.w)};
        float ss = 0.f;
#pragma unroll
        for (int e = 0; e < 8; ++e) ss += o[e] * o[e];
        ss += __shfl_xor(ss, 1); ss += __shfl_xor(ss, 2); ss += __shfl_xor(ss, 4); ss += __shfl_xor(ss, 8);
        const float rs = (1.f - LAM_INIT) / sqrtf(ss * (1.f / 128.f) + EPS);
#pragma unroll
        for (int e = 0; e < 8; ++e) o[e] = o[e] * rs * ww[e];
        *(GAS v4u*)(MIX + (size_t)r * 1024 + 512 + head * 128 + d) = (v4u){pk2(o[0], o[1]), pk2(o[2], o[3]), pk2(o[4], o[5]), pk2(o[6], o[7])}; }
}
__device__ __forceinline__ void moe_bases(Frame& F, int (&base)[8], int& ntiles) { int acc = 0;
#pragma unroll
    for (int e = 0; e < 8; ++e) { base[e] = acc; const int c = (int)__hip_atomic_load((unsigned*)(F.ctl + CW_MOECNT + 64 * e), RLX_AGENT); acc += (c + 255) & ~255; }
    ntiles = acc >> 8; }
constexpr size_t META_TEXP = 640 * 1024, META_POS = 768 * 1024;
__device__ __forceinline__ void moe_gather(Frame& F) {
    int base[8], ntiles; moe_bases(F, base, ntiles);
    int* TEXP = (int*)(F.ws + WS_META + META_TEXP); int* POS = (int*)(F.ws + WS_META + META_POS);
    const int* TOPI = (const int*)(F.ws + WS_META + META_TOPI); const int* RANK = (const int*)(F.ws + WS_META + META_RANK);
    if (blockIdx.x == 0 && F.tid < 144) { const int t = F.tid; int e = 0;
#pragma unroll
        for (int q = 1; q < 8; ++q) if (t * 256 >= base[q]) e = q;
        TEXP[t] = e; if (t == 143) TEXP[144] = ntiles; }
    const bf16* FIN = (const bf16*)(F.ws + WS_FIN2); bf16* AS = (bf16*)(F.ws + WS_ASORT);
    for (int tk = F.gw; tk < NB * T; tk += F.NGW) { const int b = tk / T, t = tk - b * T; const size_t r = (size_t)b * SROW + TC + t;
        const GAS v4u* src = (const GAS v4u*)(FIN + r * D) + F.lane; const v4u x0 = src[0], x1 = src[64];
#pragma unroll
        for (int sl = 0; sl < 2; ++sl) { const int e = TOPI[tk * 2 + sl]; int bs = 0;
#pragma unroll
            for (int q = 0; q < 8; ++q) if (q == e) bs = base[q];
            const int pos = bs + RANK[tk * 2 + sl]; if (F.lane == 0) POS[tk * 2 + sl] = pos;
            GAS v4u* dst = (GAS v4u*)(AS + (size_t)pos * D) + F.lane; dst[0] = x0; dst[64] = x1; } }
}
__device__ __forceinline__ void rows_final(Frame& F) {
    const bf16* OR = (const bf16*)(F.ws + WS_ASORT); const int* POS = (const int*)(F.ws + WS_META + META_POS); const float* TOPW = (const float*)(F.ws + WS_META + META_TOPW);
    for (int tk = F.gw; tk < NB * T; tk += F.NGW) { const int b = tk / T; float* xr = F.out + (size_t)tk * D;
        Row4 x = ld_row_f32(xr, F.lane); const Row4 y0 = ld_row_bf16(OR + (size_t)POS[tk * 2] * D, F.lane), y1 = ld_row_bf16(OR + (size_t)POS[tk * 2 + 1] * D, F.lane);
        const float w0 = TOPW[tk * 2], w1 = TOPW[tk * 2 + 1]; Row4 y;
#pragma unroll
        for (int j = 0; j < 4; ++j) y.v[j] = y0.v[j] * w0 + y1.v[j] * w1;
        add_gated_norm(x, y, F.in[I_ONORMS] + 3 * 1024, modvec(F, 1, b, 5), F.lane); st_row_f32(xr, F.lane, x); }
}
constexpr int N_PHASES = 26;
__global__ void __launch_bounds__(NWAVES * 64, 2) trunk_fwd(Args args) {
    extern __shared__ __attribute__((aligned(16))) unsigned char lds[];
    Frame F;
    F.lds = (LAS unsigned char*)lds; F.ldsg = (char*)lds;
    F.MISC = (volatile LAS unsigned*)(F.lds + MISC_OFF);
    F.wave = __builtin_amdgcn_readfirstlane((int)threadIdx.x >> 6);
#define REFRESH() do { int z_ = 0; asm volatile("" : "+v"(z_)); F.lane = (int)__builtin_amdgcn_mbcnt_hi(~0u, __builtin_amdgcn_mbcnt_lo(~0u, (unsigned)z_)); F.tid = F.wave * 64 + F.lane; } while (0)
    REFRESH();
    F.G = gridDim.x; { const int bx = blockIdx.x; F.vcu = (F.G % 8 == 0) ? (bx % 8) * (F.G / 8) + bx / 8 : bx; }
    F.gw = F.vcu * NWAVES + F.wave; F.NGW = F.G * NWAVES;
    F.in = args.in; F.out = args.out; F.ws = args.ws; F.ctl = (gu32*)(args.ws + WS_CTL);
    unsigned char* ws = args.ws;
    for (int u = F.tid; u < (LDS_BYTES - MISC_OFF) / 4; u += NWAVES * 64) ((LAS unsigned*)(F.lds + MISC_OFF))[u] = 0u;
    __syncthreads();
    XcdBarrier bar; bar.bar = (unsigned*)(F.ctl + CW_BAR); bar.x = 0; bar.st = nullptr;
    const int lo = args.ph_lo, hi = args.ph_hi;
    const bool use_bar = (hi - lo) > 1;
    if (use_bar) bar = xcd_barrier_post((unsigned*)(F.ctl + CW_BAR), F.MISC + 8);
#ifndef MK_ONLY
#define MK_ONLY_OK(k) true
#else
#define MK_ONLY_OK(k) ((k) == MK_ONLY)
#endif
#define IN(k) (MK_ONLY_OK(k) && lo <= (k) && (k) < hi && (k) <= MK_LAST_PHASE)
#ifndef CHK_MASK
#define CHK_MASK 0xffu
#endif
#ifndef MK_REP_MASK
#define MK_REP_MASK 0u
#endif
#define REPS(k) ((((unsigned)MK_REP_MASK >> (k)) & 1u) ? 2 : 1)
#define SEAM(k) do { if (IN(k) && IN((k) + 1)) xcd_barrier(bar); } while (0)
    typedef pg8::bf16_t pb;
    const int bid = blockIdx.x;

    if (IN(0)) for (int rep_ = 0; rep_ < REPS(0); ++rep_) { REFRESH(); p0_prologue(F); } SEAM(0);
    if (IN(1)) for (int rep_ = 0; rep_ < REPS(1); ++rep_) { REFRESH(); p1_first_rows(F); } SEAM(1);
    if (IN(2)) for (int rep_ = 0; rep_ < REPS(2); ++rep_) { REFRESH();
        pg8::Gemm g{(const pb*)(ws + WS_ABUF), (const pb*)(ws + WS_WEIN), NR, EINP, 1024, 1024, 1024}; pg8::StaticOrder S; S.init(NR, EINP, F.G, bid);
        pg8::EpiStore E{(pb*)(ws + WS_PROJ), EINP, EINP / 256};
        pg8::gemm_phase<pg8::EpiStore, pg8::StaticOrder, PG8_ALIGN, PG8_SP2>(F.lds + RING_OFF, g, S, E); } SEAM(2);
    if (IN(3)) for (int rep_ = 0; rep_ < REPS(3); ++rep_) { REFRESH(); g0_prep(F); } SEAM(3);
#ifdef GDN_SLOW
    if (IN(5)) for (int rep_ = 0; rep_ < REPS(5); ++rep_) { REFRESH();
        if (F.G > 64) { if (bid < 64) gdn_chain(F, bid); else for (int u = bid - 64; u < 544; u += F.G - 64) swa_unit(F, u); }
        else { for (int c = bid; c < 64; c += F.G) gdn_chain(F, c); for (int u = bid; u < 544; u += F.G) swa_unit(F, u); } } SEAM(5);
#else
    if (IN(4)) for (int rep_ = 0; rep_ < REPS(4); ++rep_) { REFRESH();
#if G1_LOCK
        if ((F.wave & 3) == 0) for (int item = F.vcu * 2 + (F.wave >> 2); item < 64 * 68; item += F.G * 2) gdn::g1_item(F, item, F.lds + RING_OFF + (F.wave >> 2) * gdn::G1_WAVE_LDS, F.MISC + 16);
#else
        if (F.wave < 4) for (int item = F.vcu * 4 + F.wave; item < 64 * 68; item += F.G * 4) gdn::g1_item(F, item, F.lds + RING_OFF + F.wave * gdn::G1_WAVE_LDS, F.MISC + 16);
        else p0_deferred(F, F.wave - 4, F.lds + RING_OFF + 4 * gdn::G1_WAVE_LDS + (F.wave - 4) * 8448);
#endif
    } SEAM(4);
    if (IN(5)) for (int rep_ = 0; rep_ < REPS(5); ++rep_) { REFRESH();
        if (bid < 64) for (int c = bid; c < 64; c += F.G) { gdn::scan_chain(F, c); __syncthreads(); }
        for (;;) { if (F.tid == 0) F.MISC[20] = __hip_atomic_fetch_add((unsigned*)(F.ctl + CW_SWAQ), 1u, RLX_AGENT);
            __syncthreads(); const int u = (int)F.MISC[20]; __syncthreads();
            if (u >= 544 * REPS(5)) break;
            swa_unit(F, u % 544); } } SEAM(5);
#endif
    if (IN(6)) for (int rep_ = 0; rep_ < REPS(6); ++rep_) { REFRESH(); g4_gdn_out(F); } SEAM(6);
    if (IN(7)) for (int rep_ = 0; rep_ < REPS(7); ++rep_) { REFRESH();
        { pg8::Gemm g{(const pb*)(ws + WS_MIX), (const pb*)(ws + WS_WEOUT), NR, 1024, 1024, 1024, 1024}; pg8::LatOrder S; S.init(1024, F.G, bid);
          pg8::EpiStore E{(pb*)(ws + WS_YBUF), 1024, 4};
          pg8::gemm_phase<pg8::EpiStore, pg8::LatOrder, PG8_ALIGN, PG8_SP2>(F.lds + RING_OFF, g, S, E); }
        __syncthreads();
        { pg8::Gemm g{(const pb*)(ws + WS_MIX), (const pb*)(ws + WS_WEOUT), NR, 1024, 256, 1024, 1024}; pg8::CtxSplitOrder S; S.init(4, 256, F.G, bid);
          pg8::EpiPartF32 E{(float*)(ws + WS_PART), 256};
          pg8::gemm_phase<pg8::EpiPartF32, pg8::CtxSplitOrder, PG8_ALIGN, PG8_SP2>(F.lds + RING_OFF, g, S, E); } } SEAM(7);
    if (IN(8)) for (int rep_ = 0; rep_ < REPS(8); ++rep_) { REFRESH(); rows_mid<false>(F, (const bf16*)(ws + WS_YBUF), F.in[I_ENORMS] + 1024, 0, 2, F.in[I_ENORMS] + 2048, 0, 3, (bf16*)(ws + WS_ABUF), false, 4); } SEAM(8);
    if (IN(9)) for (int rep_ = 0; rep_ < REPS(9); ++rep_) { REFRESH();
        pg8::Gemm g{(const pb*)(ws + WS_ABUF), (const pb*)(ws + WS_WEGU), NR, 2 * DFF, 1024, 1024, 1024}; pg8::StaticOrder S; S.init(NR, 2 * DFF, F.G, bid);
        pg8::EpiSwiGLU E{(pb*)(ws + WS_HID), DFF, DFF / 128};
        pg8::gemm_phase<pg8::EpiSwiGLU, pg8::StaticOrder, PG8_ALIGN, PG8_SP2>(F.lds + RING_OFF, g, S, E); } SEAM(9);
    if (IN(10)) for (int rep_ = 0; rep_ < REPS(10); ++rep_) { REFRESH();
        { pg8::Gemm g{(const pb*)(ws + WS_HID), (const pb*)(ws + WS_WEDN), NR, 1024, DFF, DFF, DFF}; pg8::LatOrder S; S.init(1024, F.G, bid);
          pg8::EpiStore E{(pb*)(ws + WS_YBUF), 1024, 4};
          pg8::gemm_phase<pg8::EpiStore, pg8::LatOrder, PG8_ALIGN, PG8_SP2>(F.lds + RING_OFF, g, S, E); }
        __syncthreads();
        { pg8::Gemm g{(const pb*)(ws + WS_HID), (const pb*)(ws + WS_WEDN), NR, 1024, 256, DFF, DFF}; pg8::CtxSplitOrder S; S.init(11, 256, F.G, bid);
          pg8::EpiPartF32 E{(float*)(ws + WS_PART), 256};
          pg8::gemm_phase<pg8::EpiPartF32, pg8::CtxSplitOrder, PG8_ALIGN, PG8_SP2>(F.lds + RING_OFF, g, S, E); } } SEAM(10);
    if (IN(11)) for (int rep_ = 0; rep_ < REPS(11); ++rep_) { REFRESH(); rows_mid<false>(F, (const bf16*)(ws + WS_YBUF), F.in[I_ENORMS] + 3072, 0, 5, F.in[I_ONORMS], 1, 0, (bf16*)(ws + WS_ABUF), false, 11); } SEAM(11);
    if (IN(12)) for (int rep_ = 0; rep_ < REPS(12); ++rep_) { REFRESH();
        pg8::Gemm g{(const pb*)(ws + WS_ABUF), (const pb*)(ws + WS_WOIN), NR, OINP, 1024, 1024, 1024}; pg8::StaticOrder S; S.init(NR, OINP, F.G, bid);
        pg8::EpiStore E{(pb*)(ws + WS_PROJ2), OINP, OINP / 256};
        pg8::gemm_phase<pg8::EpiStore, pg8::StaticOrder, PG8_ALIGN, PG8_SP2>(F.lds + RING_OFF, g, S, E); } SEAM(12);
    if (IN(13)) for (int rep_ = 0; rep_ < REPS(13); ++rep_) { REFRESH(); l1_prep(F); } SEAM(13);
    if (IN(14)) for (int rep_ = 0; rep_ < REPS(14); ++rep_) { REFRESH();
#if !defined(T13) || T13 == 1
        { pg8::Gemm g{(const pb*)(ws + WS_CQN), (const pb*)(ws + WS_WUQ), NR, 768, 384, 640, 384}; pg8::LatOrder S; S.init(768, F.G, bid);
          pg8::EpiStore E{(pb*)(ws + WS_QM), 768, 3};
          pg8::gemm_phase<pg8::EpiStore, pg8::LatOrder, PG8_ALIGN, PG8_SP2>(F.lds + RING_OFF, g, S, E); }
#endif
        __syncthreads();
#if !defined(T13) || T13 == 2
        { pg8::Gemm g{(const pb*)(ws + WS_CQN) + 384, (const pb*)(ws + WS_WUKV), NR, 1024, 256, 640, 256}; pg8::StaticOrder S; S.init(NR, 1024, F.G, bid);
          pg8::EpiKV E{(pb*)(ws + WS_KMLA), (pb*)(ws + WS_VMLA)};
          pg8::gemm_phase<pg8::EpiKV, pg8::StaticOrder, PG8_ALIGN, PG8_SP2>(F.lds + RING_OFF, g, S, E); }
#endif
    } SEAM(14);
    if (IN(16)) for (int rep_ = 0; rep_ < REPS(16); ++rep_) { REFRESH(); for (int u = F.vcu; u < 768; u += F.G) l1_attn_unit(F, u); } SEAM(16);
    if (IN(18)) for (int rep_ = 0; rep_ < REPS(18); ++rep_) { REFRESH();
        pg8::Gemm g{(const pb*)(ws + WS_MIX), (const pb*)(ws + WS_WOOUT), NR, 1024, 1024, 1024, 1024}; pg8::LatOrder S; S.init(1024, F.G, bid);
        pg8::EpiStore E{(pb*)(ws + WS_Y2), 1024, 4};
        pg8::gemm_phase<pg8::EpiStore, pg8::LatOrder, PG8_ALIGN, PG8_SP2>(F.lds + RING_OFF, g, S, E); } SEAM(18);
    if (IN(19)) for (int rep_ = 0; rep_ < REPS(19); ++rep_) { REFRESH(); rows_mid<true>(F, (const bf16*)(ws + WS_Y2), F.in[I_ONORMS] + 1024, 1, 2, F.in[I_ONORMS] + 2048, 1, 3, (bf16*)(ws + WS_FIN2), true); } SEAM(19);
    if (IN(20)) for (int rep_ = 0; rep_ < REPS(20); ++rep_) { REFRESH(); px_expert_weights(F); moe_gather(F); } SEAM(20);
#define MOE_PART(kgu, kdn, t0_, cap_) \
    if (IN(kgu)) for (int rep_ = 0; rep_ < REPS(kgu); ++rep_) { REFRESH(); int base[8], ntiles; moe_bases(F, base, ntiles); const int t0 = (t0_), ntl = (ntiles - t0 < 0) ? 0 : ((ntiles - t0 < (cap_)) ? ntiles - t0 : (cap_)); \
        pg8::Gemm g{(const pb*)(ws + WS_ASORT) + (size_t)t0 * 256 * 1024, (const pb*)(ws + WS_WXGU), 0, 0, 1024, 1024, 1024}; pg8::MoeOrder S; S.init(ntl, 28, F.G, bid, (const int*)(ws + WS_META + META_TEXP), t0); \
        pg8::EpiSwiGLU E{(pb*)(ws + WS_HIDX), DFX, 28}; \
        pg8::gemm_phase<pg8::EpiSwiGLU, pg8::MoeOrder, PG8_ALIGN, PG8_SP2>(F.lds + RING_OFF, g, S, E); } SEAM(kgu); \
    if (IN(kdn)) for (int rep_ = 0; rep_ < REPS(kdn); ++rep_) { REFRESH(); int base[8], ntiles; moe_bases(F, base, ntiles); const int t0 = (t0_), ntl = (ntiles - t0 < 0) ? 0 : ((ntiles - t0 < (cap_)) ? ntiles - t0 : (cap_)); \
        pg8::Gemm g{(const pb*)(ws + WS_HIDX), (const pb*)(ws + WS_WXDN), 0, 0, DFX, DFX, DFX}; pg8::MoeOrder S; S.init(ntl, 4, F.G, bid, (const int*)(ws + WS_META + META_TEXP), t0); \
        pg8::EpiStore E{(pb*)(ws + WS_ASORT) + (size_t)t0 * 256 * 1024, 1024, 4}; \
        pg8::gemm_phase<pg8::EpiStore, pg8::MoeOrder, PG8_ALIGN, PG8_SP2>(F.lds + RING_OFF, g, S, E); } SEAM(kdn);
    MOE_PART(21, 22, 0, 68)
    MOE_PART(23, 24, 68, 68)
    if (IN(25)) for (int rep_ = 0; rep_ < REPS(25); ++rep_) { REFRESH(); rows_final(F);
#if defined(CHK_G1) || defined(CHK_SCAN)
        { const unsigned fb = __hip_atomic_load((unsigned*)(F.ctl + CW_CHK), RLX_AGENT) & CHK_MASK; if (fb != 0u) { VM_WAIT(); __syncthreads(); for (int i = F.gw * 64 + F.lane; i < NB * T * D; i += F.NGW * 64) F.out[i] = 0.f; } }
#endif
    }
#undef IN
#undef SEAM
}

extern "C" void kernel_launch(void* const* d_in, const int* in_sizes, int n_in, void* d_out, int out_size, void* d_ws, size_t ws_size, hipStream_t stream) {
    static int grid = 0;
    if (grid == 0) {
        if (n_in != 32 || in_sizes[0] != NB * T * D || out_size != NB * T * D || ws_size < WS_END) { fprintf(stderr, "kernel_launch: unexpected shapes: n_in %d in0 %d out %d ws %zu (need %zu)\n", n_in, n_in > 0 ? in_sizes[0] : -1, out_size, ws_size, (size_t)WS_END); grid = -1; return; }
        int dev = 0, cus = 0, per_cu = 0;
        if (hipGetDevice(&dev) != hipSuccess || hipDeviceGetAttribute(&cus, hipDeviceAttributeMultiprocessorCount, dev) != hipSuccess) { grid = -1; return; }
        if (hipFuncSetAttribute((const void*)trunk_fwd, hipFuncAttributeMaxDynamicSharedMemorySize, LDS_BYTES) != hipSuccess) { fprintf(stderr, "kernel_launch: hipFuncSetAttribute failed\n"); grid = -1; return; }
        if (hipOccupancyMaxActiveBlocksPerMultiprocessor(&per_cu, (const void*)trunk_fwd, NWAVES * 64, LDS_BYTES) != hipSuccess || per_cu < 1) fprintf(stderr, "kernel_launch: occupancy query reports %d\n", per_cu);
        (void)hipGetLastError();
        grid = cus;
    }
    if (grid < 0) return;
    if (hipMemsetAsync((char*)d_ws + WS_CTL, 0, CTL_ZERO_BYTES, stream) != hipSuccess) return;
#ifdef DIAG_POISON
    (void)hipMemsetAsync((char*)d_ws + WS_GDNI, 0xFF, (size_t)64 * 68 * 32768, stream);
    (void)hipMemsetAsync((char*)d_ws + WS_OG, 0xFF, (size_t)NR * 1024 * 2, stream);
    (void)hipMemsetAsync((char*)d_ws + WS_QKVN, 0xFF, (size_t)NR * 1536 * 2, stream);
    (void)hipMemsetAsync((char*)d_ws + WS_GB, 0xFF, (size_t)NR * 32 * 4, stream);
#endif
    Args a{};
    for (int i = 0; i < 32; ++i) a.in[i] = (const float*)d_in[i];
    a.out = (float*)d_out; a.ws = (unsigned char*)d_ws;
#if MK_N_LAUNCHES == 1
    a.ph_lo = 0; a.ph_hi = N_PHASES;
    hipLaunchKernelGGL(trunk_fwd, dim3(grid), dim3(NWAVES * 64), LDS_BYTES, stream, a);
#else
    for (int p = 0; p < N_PHASES && p <= MK_LAST_PHASE; ++p) { a.ph_lo = p; a.ph_hi = p + 1; hipLaunchKernelGGL(trunk_fwd, dim3(grid), dim3(NWAVES * 64), LDS_BYTES, stream, a); }
#endif
    const hipError_t le = hipPeekAtLastError();
    if (le != hipSuccess) fprintf(stderr, "kernel_launch: launch failed: %s\n", hipGetErrorName(le));
}
```

```cpp
#include <hip/hip_runtime.h>
#include <cstdio>
#include <cstdint>
#include <cmath>

#ifndef MK_N_LAUNCHES
#define MK_N_LAUNCHES 1
#endif
#define SOLVE_C_FMA 1
#define SOLVE_C_LOAD 1
#ifndef G1_LOCK
#define G1_LOCK 0
#ifndef SCAN_PF
#define SCAN_PF 8
#endif
#ifndef SCAN_UNROLL
#define SCAN_UNROLL 1
#endif
#ifndef MOE_KSL
#define MOE_KSL 512
#endif
#endif
#ifndef MK_LAST_PHASE
#define MK_LAST_PHASE 99
#endif

constexpr int NB = 4, T = 4096, TC = 256, SROW = T + TC  , NR = NB * SROW  , D = 1024;
constexpr int EIN = 2848, EINP = 3072, OIN = 2208, OINP = 2304, DFF = 2816, DFX = 3584, NEXP = 8;
constexpr float EPS = 1e-6f;
constexpr int E_Q = 0, E_K = 512, E_V = 1024, E_Z = 1536, E_GA = 2048, E_GB = 2064, E_SQ = 2080, E_SK = 2592, E_SV = 2720;
constexpr int O_CQ = 0, O_CKV = 384, O_KR = 640, O_DQ = 672, O_DK = 1184, O_DV = 1696;

constexpr size_t MiB = 1u << 20;
constexpr size_t WS_CTL = 0, CTL_ZERO_BYTES = 1 * MiB;
constexpr size_t WS_MODV = 1 * MiB;
constexpr size_t WS_GB = 2 * MiB;
constexpr size_t WS_META = 5 * MiB;
constexpr size_t WS_HCTX = 8 * MiB;
constexpr size_t WS_WEIN = 12 * MiB, WS_WEOUT = 18 * MiB, WS_WEGU = 20 * MiB, WS_WEDN = 31 * MiB, WS_WOIN = 37 * MiB, WS_WUQ = 42 * MiB, WS_WUKV = 43 * MiB, WS_WOOUT = 44 * MiB;
constexpr size_t WS_BIG = 46 * MiB;
constexpr size_t WS_PROJ = 46 * MiB, WS_QKVN = 148 * MiB;
constexpr size_t WS_PROJ2 = 46 * MiB, WS_QM = 123 * MiB, WS_VMLA = 149 * MiB, WS_KMLA = 167 * MiB, WS_ODIFF = 316 * MiB;
constexpr size_t WS_WXGU = 46 * MiB, WS_WXDN = 158 * MiB;
constexpr size_t WS_CQN = 214 * MiB;
constexpr size_t WS_ABUF = 214 * MiB, WS_MIX = 248 * MiB, WS_YBUF = 282 * MiB;
constexpr size_t WS_OG = 214 * MiB;
constexpr size_t WS_PART = 350 * MiB;
constexpr size_t WS_GDNI = 282 * MiB;
constexpr size_t WS_HID = 46 * MiB;
constexpr size_t WS_ASORT = 214 * MiB;
constexpr size_t WS_FIN2 = 282 * MiB;
constexpr size_t WS_Y2 = 316 * MiB;
constexpr size_t WS_HIDX = 316 * MiB;
constexpr size_t WS_XB = 436 * MiB;
constexpr size_t WS_END = 470 * MiB;
static_assert(WS_QKVN + (size_t)NR * 1536 * 2 <= 214 * MiB && WS_PROJ + (size_t)NR * EINP * 2 <= WS_QKVN, "layer-0 big region");
static_assert(WS_PROJ2 + (size_t)NR * OINP * 2 <= WS_QM && WS_QM + (size_t)NR * 768 * 2 <= WS_VMLA && WS_VMLA + (size_t)NR * 512 * 2 <= WS_KMLA && WS_KMLA + (size_t)NR * 768 * 2 <= 214 * MiB, "layer-1 big region");
static_assert(WS_WXGU + (size_t)NEXP * 7168 * 1024 * 2 <= WS_WXDN && WS_WXDN + (size_t)NEXP * 1024 * 3584 * 2 <= 214 * MiB, "expert weights");
static_assert(WS_HIDX + (size_t)17408 * 3584 * 2 <= WS_END && WS_ASORT + (size_t)34816 * 1024 * 2 <= WS_FIN2 && WS_HID + (size_t)NR * DFF * 2 <= 214 * MiB, "moe map");
constexpr size_t META_TOPI = 0, META_TOPW = 128 * 1024, META_RANK = 256 * 1024, META_RSTD = 384 * 1024, META_BLKB = 960 * 1024;
constexpr int CW_TMO = 0, CW_CODE = 1;
constexpr int CW_MOECNT = 64;
constexpr int CW_SWAQ = 2048;
constexpr int CW_CHK = 1024;
constexpr int CW_BAR = 4096;
constexpr int RING_OFF = 0, RING_BYTES = 141312;
constexpr int MISC_OFF = RING_BYTES;
constexpr int LDS_BYTES = 147456;
constexpr int NWAVES = 8;
namespace pg8 {
#define PG8_LAS __attribute__((address_space(3)))
typedef unsigned short bf16_t;
typedef short bf16x8 __attribute__((ext_vector_type(8)));
typedef float f32x4 __attribute__((ext_vector_type(4)));
typedef unsigned u32x4 __attribute__((ext_vector_type(4)));
constexpr int BM = 256, BK = 64, HALF = 128, HTB = HALF * BK * 2  , STAGE_BYTES = 8 * HTB, NXCD = 8, WGM = 8;

__host__ __device__ __forceinline__ int lds_byte(int r, int c) { const int st = (r >> 4) * 2 + (c >> 5), rr = r & 15, cc = c & 31, ob = rr * 64 + cc * 2; return st * 1024 + (ob ^ (((ob >> 9) & 1) << 5)); }
__host__ __device__ __forceinline__ void stage_rc(int b, int& R, int& C) { const int st = b / 1024, sb = b % 1024, swz = sb ^ (((sb >> 9) & 1) << 5); R = (st >> 1) * 16 + swz / 64; C = (st & 1) * 32 + (swz % 64) / 2; }
__host__ __device__ __forceinline__ int perm32(int rho) { const int n = rho >> 4, i = rho & 15; return 8 * (i >> 2) + 4 * n + (i & 3); }

struct Unit { int pm, pn, kof; };
struct Gemm { const bf16_t* A; const bf16_t* Bt; int M, N, K, lda, ldb; };

struct StaticOrder {
    int nM, nN, nwg, G, c;
    __host__ __device__ void init(int M, int N, int G_, int c_) { nM = M / BM; nN = N / BM; nwg = nM * nN; G = G_; c = c_; }
    __host__ __device__ bool next(int i, Unit& u) const {
        const long L = (long)i * G + c; if (L >= nwg) return false;
        int wgid = (int)L; { const int q = nwg / NXCD, r = nwg % NXCD, xcd = wgid % NXCD, off = wgid / NXCD; wgid = (xcd < r ? xcd * (q + 1) : r * (q + 1) + (xcd - r) * q) + off; }
        const int nig = WGM * nN, gid = wgid / nig, fm = gid * WGM, gsz = (nM - fm) < WGM ? (nM - fm) : WGM;
        u.pm = fm + ((wgid % nig) % gsz); u.pn = (wgid % nig) / gsz; u.kof = 0; return true;
    }
    __device__ __forceinline__ void a_ready(const Unit&) const {}
    __device__ __forceinline__ void done(const Unit&) const {}
};

__device__ __forceinline__ unsigned cvt_pk_bf16(float lo, float hi) { unsigned r; asm volatile("v_cvt_pk_bf16_f32 %0, %1, %2" : "=v"(r) : "v"(lo), "v"(hi)); return r; }
typedef float f32x2 __attribute__((ext_vector_type(2)));
template <class Epi, class Sched, bool ALIGN_EPI = false, bool SP2 = false>
__device__ __forceinline__ void gemm_phase(PG8_LAS unsigned char* lds, const Gemm g, const Sched& S, const Epi& E) {
    const int tid = threadIdx.x, wid = __builtin_amdgcn_readfirstlane(tid >> 6), lane = tid & 63, wr = wid >> 2, wc = wid & 3, fr = lane & 15, fq = lane >> 4;
    const int K = g.K, nt = K / BK;
    unsigned voffA[2], voffB[2];
#pragma unroll
    for (int i = 0; i < 2; ++i) { int R, C; stage_rc(tid * 16 + i * 8192, R, C); const int Rb = Epi::PERM ? ((R & ~31) + perm32(R & 31)) : R;
        voffA[i] = (unsigned)(R * g.lda + C) * 2u; voffB[i] = (unsigned)(Rb * g.ldb + C) * 2u; }
    const size_t kstep = (size_t)(BK * 2);
    const size_t hstepA = (size_t)HALF * g.lda * 2, hstepB = (size_t)HALF * g.ldb * 2;
    const size_t tstepA = 2 * hstepA, tstepB = 2 * hstepB;
    const unsigned ldsw = (unsigned)wid * 1024u;
    const int aoff = lds_byte(wr * 64 + fr, fq * 8), boff = lds_byte(wc * 32 + fr, fq * 8);
#define PG8_SA(b, h) (((b) * 2 + (h)) * HTB)
#define PG8_SB(b, h) ((4 + (b) * 2 + (h)) * HTB)
#define PG8_STAGE(bufoff, gbase, voff) do { _Pragma("unroll") for (int _i = 0; _i < 2; ++_i) \
        __builtin_amdgcn_global_load_lds((const unsigned*)((const char*)(gbase) + (voff)[_i]), (PG8_LAS unsigned*)(lds + (bufoff) + ldsw + _i * 8192), 16, 0, 0); } while (0)
#define PG8_LDA(dst, b, h) do { _Pragma("unroll") for (int m = 0; m < 4; ++m) _Pragma("unroll") for (int k = 0; k < 2; ++k) dst[m][k] = *(const PG8_LAS bf16x8*)(lds + PG8_SA(b, h) + aoff + m * 2048 + k * 1024); } while (0)
#define PG8_LDB(dst, b, h) do { _Pragma("unroll") for (int n = 0; n < 2; ++n) _Pragma("unroll") for (int k = 0; k < 2; ++k) dst[n][k] = *(const PG8_LAS bf16x8*)(lds + PG8_SB(b, h) + boff + n * 2048 + k * 1024); } while (0)
#define PG8_MMA(ai, bj, At, Bt) do { __builtin_amdgcn_s_setprio(1); _Pragma("unroll") for (int m = 0; m < 4; ++m) _Pragma("unroll") for (int n = 0; n < 2; ++n) _Pragma("unroll") for (int k = 0; k < 2; ++k) \
        acc[ai][bj][m][n] = __builtin_amdgcn_mfma_f32_16x16x32_bf16(Bt[n][k], At[m][k], acc[ai][bj][m][n], 0, 0, 0); __builtin_amdgcn_s_setprio(0); } while (0)
#define PG8_WAIT_V(n) asm volatile("s_waitcnt vmcnt(" #n ")" ::: "memory")
#define PG8_WAIT_L(n) asm volatile("s_waitcnt lgkmcnt(" #n ")" ::: "memory")
#define PG8_BAR __builtin_amdgcn_s_barrier()
#define PG8_SCHED __builtin_amdgcn_sched_barrier(0)
    Unit cur, nxt; int ui = 0;
    if (!S.next(0, cur)) return;
    f32x4 acc[2][2][4][2];
#pragma unroll
    for (int a = 0; a < 2; ++a)
#pragma unroll
        for (int b = 0; b < 2; ++b)
#pragma unroll
            for (int m = 0; m < 4; ++m)
#pragma unroll
                for (int n = 0; n < 2; ++n) acc[a][b][m][n] = (f32x4){0.f, 0.f, 0.f, 0.f};
    bf16x8 At[4][2], B0[2][2], B1[2][2];
    const char* cA = (const char*)g.A + (size_t)cur.pm * tstepA + (size_t)cur.kof * 2; const char* cB = (const char*)g.Bt + (size_t)cur.pn * tstepB + (size_t)cur.kof * 2;
    S.a_ready(cur);
    if constexpr (SP2) {
        PG8_STAGE(PG8_SB(0, 0), cB, voffB); PG8_STAGE(PG8_SB(0, 1), cB + hstepB, voffB); PG8_STAGE(PG8_SA(0, 0), cA, voffA); PG8_STAGE(PG8_SA(0, 1), cA + hstepA, voffA);
        if (wr == 1) PG8_BAR;
        PG8_WAIT_V(2); PG8_BAR;
        PG8_STAGE(PG8_SB(1, 0), cB + kstep, voffB); PG8_STAGE(PG8_SA(1, 0), cA + kstep, voffA); PG8_STAGE(PG8_SB(1, 1), cB + hstepB + kstep, voffB);
        PG8_WAIT_V(6); PG8_BAR;
    } else {
        PG8_STAGE(PG8_SB(0, 0), cB, voffB); PG8_STAGE(PG8_SA(0, 0), cA, voffA); PG8_STAGE(PG8_SB(0, 1), cB + hstepB, voffB); PG8_STAGE(PG8_SA(0, 1), cA + hstepA, voffA);
        if (wr == 1) PG8_BAR;
        PG8_WAIT_V(4); PG8_BAR;
        PG8_STAGE(PG8_SB(1, 0), cB + kstep, voffB); PG8_STAGE(PG8_SA(1, 0), cA + kstep, voffA); PG8_STAGE(PG8_SB(1, 1), cB + hstepB + kstep, voffB);
        PG8_WAIT_V(6); PG8_BAR;
    }
    for (;;) {
        const bool has_next = S.next(ui + 1, nxt);
        const char* nA = has_next ? (const char*)g.A + (size_t)nxt.pm * tstepA + (size_t)nxt.kof * 2 : cA; const char* nB = has_next ? (const char*)g.Bt + (size_t)nxt.pn * tstepB + (size_t)nxt.kof * 2 : cB;
        _Pragma("unroll 1") for (int t = 0; t < nt; t += 2) {
            const bool last = (t == nt - 2);
            const char* a1 = cA + (size_t)(t + 1) * kstep;
            const char* a2 = last ? nA : cA + (size_t)(t + 2) * kstep; const char* b2 = last ? nB : cB + (size_t)(t + 2) * kstep;
            const char* a3 = a2 + kstep; const char* b3 = b2 + kstep;
            if (last && has_next) S.a_ready(nxt);
            if constexpr (SP2) {
            PG8_LDB(B0, 0, 0); PG8_LDB(B1, 0, 1); PG8_SCHED; PG8_LDA(At, 0, 0); PG8_STAGE(PG8_SA(1, 1), a1 + hstepA, voffA);
            PG8_WAIT_V(8); PG8_WAIT_L(0); PG8_BAR; PG8_MMA(0, 0, At, B0); PG8_MMA(0, 1, At, B1); PG8_BAR; PG8_SCHED;
            PG8_LDA(At, 0, 1); PG8_STAGE(PG8_SB(0, 0), b2, voffB); PG8_STAGE(PG8_SB(0, 1), b2 + hstepB, voffB); PG8_STAGE(PG8_SA(0, 0), a2, voffA);
            PG8_WAIT_V(8); PG8_WAIT_L(0); PG8_BAR; PG8_MMA(1, 0, At, B0); PG8_MMA(1, 1, At, B1); PG8_BAR; PG8_SCHED;
            PG8_LDB(B0, 1, 0); PG8_LDB(B1, 1, 1); PG8_SCHED; PG8_LDA(At, 1, 0); PG8_STAGE(PG8_SA(0, 1), a2 + hstepA, voffA);
            PG8_WAIT_V(8); PG8_WAIT_L(0); PG8_BAR; PG8_MMA(0, 0, At, B0); PG8_MMA(0, 1, At, B1); PG8_BAR; PG8_SCHED;
            PG8_LDA(At, 1, 1); PG8_STAGE(PG8_SB(1, 0), b3, voffB); PG8_STAGE(PG8_SB(1, 1), b3 + hstepB, voffB); PG8_STAGE(PG8_SA(1, 0), a3, voffA);
            PG8_WAIT_V(8); PG8_WAIT_L(0); PG8_BAR; PG8_MMA(1, 0, At, B0); PG8_MMA(1, 1, At, B1); PG8_BAR; PG8_SCHED;
            } else {
            PG8_LDB(B0, 0, 0); PG8_SCHED; PG8_LDA(At, 0, 0); PG8_STAGE(PG8_SA(1, 1), a1 + hstepA, voffA);
            PG8_WAIT_L(8); PG8_BAR; PG8_WAIT_L(0); PG8_MMA(0, 0, At, B0); PG8_BAR; PG8_SCHED;
            PG8_LDB(B1, 0, 1); PG8_STAGE(PG8_SB(0, 0), b2, voffB);
            PG8_BAR; PG8_WAIT_L(0); PG8_MMA(0, 1, At, B1); PG8_BAR;
            PG8_LDA(At, 0, 1); PG8_STAGE(PG8_SA(0, 0), a2, voffA);
            PG8_BAR; PG8_WAIT_L(0); PG8_MMA(1, 0, At, B0); PG8_BAR; PG8_SCHED;
            PG8_STAGE(PG8_SB(0, 1), b2 + hstepB, voffB);
            PG8_WAIT_V(6); PG8_BAR; PG8_MMA(1, 1, At, B1); PG8_BAR;
            PG8_LDB(B0, 1, 0); PG8_SCHED; PG8_LDA(At, 1, 0); PG8_STAGE(PG8_SA(0, 1), a2 + hstepA, voffA);
            PG8_WAIT_L(8); PG8_BAR; PG8_WAIT_L(0); PG8_MMA(0, 0, At, B0); PG8_BAR; PG8_SCHED;
            PG8_LDB(B1, 1, 1); PG8_STAGE(PG8_SB(1, 0), b3, voffB);
            PG8_BAR; PG8_WAIT_L(0); PG8_MMA(0, 1, At, B1); PG8_BAR;
            PG8_LDA(At, 1, 1); PG8_STAGE(PG8_SA(1, 0), a3, voffA);
            PG8_BAR; PG8_WAIT_L(0); PG8_MMA(1, 0, At, B0); PG8_BAR; PG8_SCHED;
            PG8_STAGE(PG8_SB(1, 1), b3 + hstepB, voffB);
            PG8_WAIT_V(6); PG8_BAR; PG8_MMA(1, 1, At, B1); PG8_BAR;
            }
        }
        if constexpr (ALIGN_EPI) { if (wr == 0) PG8_BAR; }
        if constexpr (!Epi::AFTER_DRAIN) { E(acc, cur, wr, wc, fr, fq); S.done(cur); }
        if (!has_next) break;
#pragma unroll
        for (int a = 0; a < 2; ++a)
#pragma unroll
            for (int b = 0; b < 2; ++b)
#pragma unroll
                for (int m = 0; m < 4; ++m)
#pragma unroll
                    for (int n = 0; n < 2; ++n) acc[a][b][m][n] = (f32x4){0.f, 0.f, 0.f, 0.f};
        cur = nxt; cA = nA; cB = nB; ++ui;
        if constexpr (ALIGN_EPI) { if (wr == 1) PG8_BAR; }
    }
    PG8_WAIT_V(0);
    if constexpr (!ALIGN_EPI) { if (wr == 0) PG8_BAR; }
    PG8_BAR;
    if constexpr (Epi::AFTER_DRAIN) { E.fused(acc, cur, wr, wc, fr, fq, lds, wid, lane); S.done(cur); }
#undef PG8_SA
#undef PG8_SB
#undef PG8_STAGE
#undef PG8_LDA
#undef PG8_LDB
#undef PG8_MMA
#undef PG8_WAIT_V
#undef PG8_WAIT_L
#undef PG8_BAR
#undef PG8_SCHED
}
}
namespace pg8 {
struct EpiStore { static constexpr bool PERM = true, AFTER_DRAIN = false;
    bf16_t* O; int ldc; int nN;
    __device__ __forceinline__ void operator()(const f32x4 (&acc)[2][2][4][2], const Unit& u, int wr, int wc, int fr, int fq) const {
        const int row0 = u.pm * BM + wr * 64 + fr, col0 = (u.pn % nN) * BM + wc * 32 + 8 * fq;
#pragma unroll
        for (int ai = 0; ai < 2; ++ai)
#pragma unroll
            for (int m = 0; m < 4; ++m) { const int row = row0 + ai * HALF + m * 16;
                bf16_t* rowp = O + (size_t)row * ldc + col0;
#pragma unroll
                for (int bj = 0; bj < 2; ++bj) { const f32x4 v0 = acc[ai][bj][m][0], v1 = acc[ai][bj][m][1];
                    u32x4 w; w.x = cvt_pk_bf16(v0[0], v0[1]); w.y = cvt_pk_bf16(v0[2], v0[3]); w.z = cvt_pk_bf16(v1[0], v1[1]); w.w = cvt_pk_bf16(v1[2], v1[3]);
                    *(u32x4*)(rowp + bj * HALF) = w; } }
    }
};
struct EpiSwiGLU { static constexpr bool PERM = true, AFTER_DRAIN = false;
    bf16_t* O; int ldc; int nN;
    __device__ __forceinline__ void operator()(const f32x4 (&acc)[2][2][4][2], const Unit& u, int wr, int wc, int fr, int fq) const {
        const int row0 = u.pm * BM + wr * 64 + fr, col0 = (u.pn % nN) * HALF + wc * 32 + 8 * fq;
#pragma unroll
        for (int ai = 0; ai < 2; ++ai)
#pragma unroll
            for (int m = 0; m < 4; ++m) { bf16_t* rowp = O + (size_t)(row0 + ai * HALF + m * 16) * ldc + col0;
                float h[8];
#pragma unroll
                for (int n = 0; n < 2; ++n)
#pragma unroll
                    for (int j = 0; j < 4; ++j) { const float g = acc[ai][0][m][n][j], up = acc[ai][1][m][n][j]; h[n * 4 + j] = g * __builtin_amdgcn_rcpf(1.f + __expf(-g)) * up; }
                u32x4 w; w.x = cvt_pk_bf16(h[0], h[1]); w.y = cvt_pk_bf16(h[2], h[3]); w.z = cvt_pk_bf16(h[4], h[5]); w.w = cvt_pk_bf16(h[6], h[7]);
                *(u32x4*)rowp = w; }
    }
};
struct EpiKV { static constexpr bool PERM = true, AFTER_DRAIN = false;
    bf16_t* KM; bf16_t* VM;
    __device__ __forceinline__ void operator()(const f32x4 (&acc)[2][2][4][2], const Unit& u, int wr, int wc, int fr, int fq) const {
        const int row0 = u.pm * BM + wr * 64 + fr, within = wc * 32 + 8 * fq;
#pragma unroll
        for (int ai = 0; ai < 2; ++ai)
#pragma unroll
            for (int m = 0; m < 4; ++m) { const int row = row0 + ai * HALF + m * 16;
#pragma unroll
                for (int bj = 0; bj < 2; ++bj) { const int h = 2 * u.pn + bj; const f32x4 v0 = acc[ai][bj][m][0], v1 = acc[ai][bj][m][1];
                    u32x4 w; w.x = cvt_pk_bf16(v0[0], v0[1]); w.y = cvt_pk_bf16(v0[2], v0[3]); w.z = cvt_pk_bf16(v1[0], v1[1]); w.w = cvt_pk_bf16(v1[2], v1[3]);
                    bf16_t* p = (within < 64) ? KM + (size_t)row * 768 + h * 96 + within : VM + (size_t)row * 512 + h * 64 + (within - 64);
                    *(u32x4*)p = w; } }
    }
};
struct CtxSplitOrder { int nsl, ksl, G, c;
    __device__ void init(int nsl_, int ksl_, int G_, int c_) { nsl = nsl_; ksl = ksl_; G = G_; c = c_; }
    __device__ bool next(int i, Unit& u) const { const int L = i * G + c; if (L >= 16 * nsl) return false; const int sl = L >> 4, rem = L & 15; u.pm = (rem >> 2) * 17; u.pn = rem & 3; u.kof = sl * ksl; return true; }
    __device__ __forceinline__ void a_ready(const Unit&) const {}
    __device__ __forceinline__ void done(const Unit&) const {}
};
struct EpiPartF32 { static constexpr bool PERM = false, AFTER_DRAIN = false;
    float* P; int ksl;
    __device__ __forceinline__ void operator()(const f32x4 (&acc)[2][2][4][2], const Unit& u, int wr, int wc, int fr, int fq) const {
        float* base = P + ((size_t)(u.kof / ksl) * 1024 + (size_t)(u.pm / 17) * 256) * 1024; const int row0 = wr * 64 + fr, col0 = u.pn * BM + wc * 32 + 4 * fq;
#pragma unroll
        for (int ai = 0; ai < 2; ++ai)
#pragma unroll
            for (int m = 0; m < 4; ++m) { float* rowp = base + (size_t)(row0 + ai * HALF + m * 16) * 1024 + col0;
#pragma unroll
                for (int bj = 0; bj < 2; ++bj)
#pragma unroll
                    for (int n = 0; n < 2; ++n) *(f32x4*)(rowp + bj * HALF + n * 16) = acc[ai][bj][m][n]; }
    }
};
struct LatOrder { StaticOrder so;
    __device__ void init(int N, int G, int c) { so.nM = 64; so.nN = N / BM; so.nwg = 64 * so.nN; so.G = G; so.c = c; }
    __device__ bool next(int i, Unit& u) const { if (!so.next(i, u)) return false; u.pm = (u.pm >> 4) * 17 + 1 + (u.pm & 15); return true; }
    __device__ __forceinline__ void a_ready(const Unit&) const {}
    __device__ __forceinline__ void done(const Unit&) const {}
};
struct MoeOrder { StaticOrder so; const int* texp; int t0, nNe;
    __device__ void init(int ntiles, int nNe_, int G, int c, const int* texp_, int t0_) { so.nM = ntiles; so.nN = nNe_; so.nwg = ntiles * nNe_; so.G = G; so.c = c; texp = texp_; t0 = t0_; nNe = nNe_; }
    __device__ bool next(int i, Unit& u) const { if (!so.next(i, u)) return false; const int e = __builtin_amdgcn_readfirstlane(texp[t0 + u.pm]); u.pn = e * nNe + u.pn; return true; }
    __device__ __forceinline__ void a_ready(const Unit&) const {}
    __device__ __forceinline__ void done(const Unit&) const {}
};
struct MoeSplitOrder { int ex4, nsl, ksl, G, c, t0; const int* texp;
    __device__ void init(int ex, int nsl_, int ksl_, int G_, int c_, const int* texp_, int t0_) { ex4 = ex * 4; nsl = nsl_; ksl = ksl_; G = G_; c = c_; texp = texp_; t0 = t0_; }
    __device__ bool next(int i, Unit& u) const { const int L = i * G + c; if (L >= ex4 * nsl) return false; const int sl = L / ex4, rem = L - sl * ex4; u.pm = 64 + (rem >> 2);
        const int e = __builtin_amdgcn_readfirstlane(texp[t0 + u.pm]); u.pn = e * 4 + (rem & 3); u.kof = sl * ksl; return true; }
    __device__ __forceinline__ void a_ready(const Unit&) const {}
    __device__ __forceinline__ void done(const Unit&) const {}
};
struct EpiMoePart { static constexpr bool PERM = false, AFTER_DRAIN = false;
    float* P; int ksl;
    __device__ __forceinline__ void operator()(const f32x4 (&acc)[2][2][4][2], const Unit& u, int wr, int wc, int fr, int fq) const {
        float* base = P + ((size_t)(u.kof / ksl) * 4 + (size_t)(u.pm - 64)) * 256 * 1024; const int row0 = wr * 64 + fr, col0 = (u.pn & 3) * BM + wc * 32 + 4 * fq;
#pragma unroll
        for (int ai = 0; ai < 2; ++ai)
#pragma unroll
            for (int m = 0; m < 4; ++m) { float* rowp = base + (size_t)(row0 + ai * HALF + m * 16) * 1024 + col0;
#pragma unroll
                for (int bj = 0; bj < 2; ++bj)
#pragma unroll
                    for (int n = 0; n < 2; ++n) *(f32x4*)(rowp + bj * HALF + n * 16) = acc[ai][bj][m][n]; }
    }
};
}
#define PG8_SP2 true
#define PG8_ALIGN true
#define GAS __attribute__((address_space(1)))
#define LAS __attribute__((address_space(3)))
typedef unsigned short bf16;
typedef unsigned v4u __attribute__((ext_vector_type(4)));
typedef unsigned v2u __attribute__((ext_vector_type(2)));
typedef float f32x4 __attribute__((ext_vector_type(4)));
typedef short bf16x8 __attribute__((ext_vector_type(8)));
typedef GAS unsigned gu32;
#define RLX_AGENT __ATOMIC_RELAXED, __HIP_MEMORY_SCOPE_AGENT
#define LDS_WAIT() asm volatile("s_waitcnt lgkmcnt(0)" ::: "memory")
#define VM_WAIT() asm volatile("s_waitcnt vmcnt(0)" ::: "memory")
__device__ __forceinline__ unsigned f2bf(float f) { unsigned u = __builtin_bit_cast(unsigned, f); return (u + 0x7fffu + ((u >> 16) & 1u)) >> 16; }
__device__ __forceinline__ unsigned pk2(float lo, float hi) { return f2bf(lo) | (f2bf(hi) << 16); }
__device__ __forceinline__ float bf2f(unsigned short b) { return __builtin_bit_cast(float, ((unsigned)b) << 16); }
__device__ __forceinline__ float bflo(unsigned w) { return __builtin_bit_cast(float, w << 16); }
__device__ __forceinline__ float bfhi(unsigned w) { return __builtin_bit_cast(float, w & 0xffff0000u); }
__device__ __forceinline__ float wave_sum(float v) {
#pragma unroll
    for (int o = 1; o < 64; o <<= 1) v += __shfl_xor(v, o);
    return v;
}
__device__ __forceinline__ float siluf(float x) { return x / (1.f + __expf(-x)); }
#define XB_TMO      128
#define XB_XCNT(j)  (256  + 64 * (j))
#define XB_XSUB(j)  (1280 + 64 * (j))
#define XB_XGEN(j)  (2304 + 64 * (j))
#define XB_TOP      3328
#define XB_TOPGEN   3392
#define XCD_BAR_WORDS 3456
#define XB_SPIN_CAP (1u << 18)

__device__ __forceinline__ unsigned xb_ld(unsigned* p)              { return __hip_atomic_load(p, __ATOMIC_RELAXED, __HIP_MEMORY_SCOPE_AGENT); }
__device__ __forceinline__ unsigned xb_add(unsigned* p, unsigned v) { return __hip_atomic_fetch_add(p, v, __ATOMIC_RELAXED, __HIP_MEMORY_SCOPE_AGENT); }
__device__ __forceinline__ unsigned xb_xcc_id() { return (unsigned)__builtin_amdgcn_s_getreg((3 << 11) | 20) & 0xFu; }
#define XB_SPIN(cond, bar) do { unsigned _sp = 0; while (cond) { __builtin_amdgcn_s_sleep(1); \
    if ((++_sp & 255u) == 0u) { if (xb_ld(&(bar)[XB_TMO])) break; if (_sp > XB_SPIN_CAP) { atomicAdd(&(bar)[XB_TMO], 1u); break; } } } } while (0)

struct XcdBarrier {
    unsigned* bar; unsigned x;
    volatile LAS unsigned* st;
};

__device__ __forceinline__ XcdBarrier xcd_barrier_post(unsigned* bar, volatile LAS unsigned* st) {
    XcdBarrier b; b.bar = bar; b.x = xb_xcc_id(); b.st = st;
    if (threadIdx.x == 0) (void)xb_add(&bar[XB_XCNT(b.x)], 1u);
    return b;
}
__device__ __forceinline__ void xcd_barrier_complete(unsigned* bar, unsigned x, unsigned& nloc, unsigned& nx) {
    const unsigned G = gridDim.x * gridDim.y * gridDim.z;
    unsigned sum, cnt, mine, sp = 0u;
    for (;;) {
        sum = 0u; cnt = 0u; mine = 0u;
#pragma unroll
        for (unsigned j = 0; j < 16; ++j) { const unsigned c = xb_ld(&bar[XB_XCNT(j)]); sum += c; cnt += (c > 0u) ? 1u : 0u; mine = (j == x) ? c : mine; }
        if (sum == G) break;
        __builtin_amdgcn_s_sleep(1);
        if ((++sp & 255u) == 0u) { if (xb_ld(&bar[XB_TMO])) break; if (sp > XB_SPIN_CAP) { atomicAdd(&bar[XB_TMO], 1u); break; } }
    }
    nloc = mine > 0u ? mine : 1u; nx = cnt > 0u ? cnt : 1u;
}

__device__ __forceinline__ void xcd_barrier(const XcdBarrier& b) {
    asm volatile("s_waitcnt vmcnt(0)" ::: "memory");
    __syncthreads();
    if (threadIdx.x == 0) {
        unsigned* bar = b.bar;
        __builtin_amdgcn_s_waitcnt(0);
        unsigned nloc = b.st[0], nx = b.st[1];
        if (nloc == 0u) { xcd_barrier_complete(bar, b.x, nloc, nx); b.st[0] = nloc; b.st[1] = nx; }
        const unsigned old = xb_add(&bar[XB_XSUB(b.x)], 1u);
        const unsigned gen = old / nloc;
        if (old + 1u == (gen + 1u) * nloc) {
            __builtin_amdgcn_fence(__ATOMIC_RELEASE, "agent");
            asm volatile("s_waitcnt vmcnt(0)" ::: "memory");
            const unsigned og = xb_add(&bar[XB_TOP], 1u);
            const unsigned tg = og / nx;
            if (og + 1u == (tg + 1u) * nx) xb_add(&bar[XB_TOPGEN], 1u);
            else XB_SPIN(xb_ld(&bar[XB_TOPGEN]) == tg, bar);
            __builtin_amdgcn_fence(__ATOMIC_ACQUIRE, "agent");
            xb_add(&bar[XB_XGEN(b.x)], 1u);
            asm volatile("s_waitcnt vmcnt(0)" ::: "memory");
        } else {
            XB_SPIN(xb_ld(&bar[XB_XGEN(b.x)]) == gen, bar);
            __builtin_amdgcn_fence(__ATOMIC_ACQUIRE, "agent");
            asm volatile("s_waitcnt vmcnt(0)" ::: "memory");
        }
    }
    __syncthreads();
}
namespace att {
using bf16x8 = __attribute__((ext_vector_type(8))) short;
using s16x4  = __attribute__((ext_vector_type(4))) short;
using f32x16 = __attribute__((ext_vector_type(16))) float;
using u32x4  = __attribute__((ext_vector_type(4))) unsigned;
constexpr int NW = 8, QBLK = 32, KVBLK = 64;
constexpr size_t SHM_V = KVBLK * 128 * 2, SHM_K = KVBLK * 128 * 2, SHM_ATTN = 2 * SHM_V + 2 * SHM_K + NW * 64 * 4;
constexpr float THR = 8.f;
#define KSWZ(row, colB) ((row) * 256 + ((colB) ^ (((row) & 7) << 4)))
#define SBAR() __builtin_amdgcn_sched_barrier(0)
__device__ __forceinline__ int crow(int r, int hi) { return (r & 3) + 8 * (r >> 2) + 4 * hi; }
__device__ __forceinline__ unsigned cvtpk(float lo, float hi) { unsigned r; asm volatile("v_cvt_pk_bf16_f32 %0, %1, %2" : "=v"(r) : "v"(lo), "v"(hi)); return r; }
__device__ __forceinline__ void partialSM(f32x16& p0, f32x16& p1, float& m_reg, float& mn, float& alpha, float C, float thr_s) {
  float pmax = p0[0];
#pragma unroll
  for (int r = 1; r < 16; ++r) pmax = fmaxf(pmax, p0[r]);
#pragma unroll
  for (int r = 0; r < 16; ++r) pmax = fmaxf(pmax, p1[r]);
  { auto rr = __builtin_amdgcn_permlane32_swap(__float_as_uint(pmax), __float_as_uint(pmax), false, false);
    pmax = fmaxf(__uint_as_float(rr[0]), __uint_as_float(rr[1])); }
  if (__builtin_expect(__all(pmax - m_reg <= thr_s), 1)) { mn = m_reg; alpha = 1.f; }
  else { mn = fmaxf(m_reg, pmax); alpha = __builtin_amdgcn_exp2f((m_reg - mn) * C); m_reg = mn; }
  const float mnC = -mn * C;
#pragma unroll
  for (int r = 0; r < 16; ++r) p0[r] = fmaf(p0[r], C, mnC);
#pragma unroll
  for (int r = 0; r < 16; ++r) p1[r] = fmaf(p1[r], C, mnC);
#pragma unroll
  for (int r = 0; r < 16; ++r) p0[r] = __builtin_amdgcn_exp2f(p0[r]);
}
__device__ __forceinline__ void finishSM(f32x16& p0, f32x16& p1, float alpha, float& l_reg, bf16x8& pa0, bf16x8& pa1, bf16x8& pa2, bf16x8& pa3) {
#pragma unroll
  for (int r = 0; r < 16; ++r) p1[r] = __builtin_amdgcn_exp2f(p1[r]);
  float ps = 0;
#pragma unroll
  for (int r = 0; r < 16; ++r) ps += p0[r];
#pragma unroll
  for (int r = 0; r < 16; ++r) ps += p1[r];
  { auto rr = __builtin_amdgcn_permlane32_swap(__float_as_uint(ps), __float_as_uint(ps), false, false);
    ps = __uint_as_float(rr[0]) + __uint_as_float(rr[1]); }
  l_reg = l_reg * alpha + ps;
#define PK4(P, BASE, OUT) do { unsigned a0 = cvtpk(P[BASE + 0], P[BASE + 1]), a1 = cvtpk(P[BASE + 2], P[BASE + 3]);   \
    unsigned b0 = cvtpk(P[BASE + 4], P[BASE + 5]), b1 = cvtpk(P[BASE + 6], P[BASE + 7]);                              \
    auto r0 = __builtin_amdgcn_permlane32_swap(a0, b0, false, false); auto r1 = __builtin_amdgcn_permlane32_swap(a1, b1, false, false); \
    u32x4 w = {r0[0], r1[0], r0[1], r1[1]}; OUT = *reinterpret_cast<bf16x8*>(&w); } while (0)
  PK4(p0, 0, pa0); PK4(p0, 8, pa1); PK4(p1, 0, pa2); PK4(p1, 8, pa3);
#undef PK4
}
template <int DQK> __device__ __forceinline__ void qkt(f32x16& p0, f32x16& p1, const char* Ks, const bf16x8* qr, int r32, int hi) {
  p0 = f32x16{}; p1 = f32x16{};
#pragma unroll
  for (int d0 = 0; d0 < DQK / 16; ++d0) { const int cb = (d0 * 16 + hi * 8) * 2;
    const bf16x8 b0 = *reinterpret_cast<const bf16x8*>(Ks + KSWZ(r32, cb));
    const bf16x8 b1 = *reinterpret_cast<const bf16x8*>(Ks + KSWZ(32 + r32, cb));
    p0 = __builtin_amdgcn_mfma_f32_32x32x16_bf16(b0, qr[d0], p0, 0, 0, 0);
    p1 = __builtin_amdgcn_mfma_f32_32x32x16_bf16(b1, qr[d0], p1, 0, 0, 0); }
}
__device__ __forceinline__ int v_st(int k, int c) { const int kk = (k & ~0xC) | ((k & 4) << 1) | ((k & 8) >> 1); return ((kk >> 3) * 4 + (c >> 5)) * 512 + ((kk & 7) * 32 + (c & 31)) * 2; }
__device__ __forceinline__ int v_rd_base(int lane) { return ((lane & 3) << 3) | (((lane >> 2) & 3) << 6) | (((lane >> 4) & 1) << 5) | (((lane >> 5) & 1) << 8); }
constexpr int v_rd_off(int d0, int ks, int half) { return d0 * 512 + ks * 4096 + half * 2048; }
template <int OFF> __device__ __forceinline__ s16x4 tr_read(int vb) {
  s16x4 r; asm volatile("ds_read_b64_tr_b16 %0, %1 offset:%2" : "=&v"(r) : "v"(vb), "i"(OFF) : "memory"); return r;
}
template <int D0> __device__ __forceinline__ void pv_one(f32x16& od, int vb, bf16x8 pa0, bf16x8 pa1, bf16x8 pa2, bf16x8 pa3) {
  const s16x4 l0 = tr_read<v_rd_off(D0, 0, 0)>(vb), h0 = tr_read<v_rd_off(D0, 0, 1)>(vb), l1 = tr_read<v_rd_off(D0, 1, 0)>(vb), h1 = tr_read<v_rd_off(D0, 1, 1)>(vb);
  const s16x4 l2 = tr_read<v_rd_off(D0, 2, 0)>(vb), h2 = tr_read<v_rd_off(D0, 2, 1)>(vb), l3 = tr_read<v_rd_off(D0, 3, 0)>(vb), h3 = tr_read<v_rd_off(D0, 3, 1)>(vb);
  asm volatile("s_waitcnt lgkmcnt(0)" ::: "memory"); SBAR();
#define PK(L, H) (bf16x8){L[0], L[1], L[2], L[3], H[0], H[1], H[2], H[3]}
  od = __builtin_amdgcn_mfma_f32_32x32x16_bf16(pa0, PK(l0, h0), od, 0, 0, 0);
  od = __builtin_amdgcn_mfma_f32_32x32x16_bf16(pa1, PK(l1, h1), od, 0, 0, 0);
  od = __builtin_amdgcn_mfma_f32_32x32x16_bf16(pa2, PK(l2, h2), od, 0, 0, 0);
  od = __builtin_amdgcn_mfma_f32_32x32x16_bf16(pa3, PK(l3, h3), od, 0, 0, 0);
#undef PK
}
template <int DV> __device__ __forceinline__ void pv_all(f32x16* o, int vb, bf16x8 pa0, bf16x8 pa1, bf16x8 pa2, bf16x8 pa3) {
  pv_one<0>(o[0], vb, pa0, pa1, pa2, pa3); pv_one<1>(o[1], vb, pa0, pa1, pa2, pa3);
  if constexpr (DV > 64) { pv_one<2>(o[2], vb, pa0, pa1, pa2, pa3); pv_one<3>(o[3], vb, pa0, pa1, pa2, pa3); }
}
template <int DQK, int DV, int MODE, bool QROPE = false, int OUTMODE = 0>
__device__ __forceinline__ void attn_unit(const unsigned short* __restrict__ Qb, int ldq, const unsigned short* __restrict__ Kb, int ldk, const unsigned short* __restrict__ Vb, int ldv,
                                          unsigned short* __restrict__ Ob, int ldo, int NT, int lat0, int q0lat, float C, float thr_s, float sinkl2, char* lds, float lam = 0.f, const float* nw = nullptr, float nscale = 1.f) {
  int tid_ = threadIdx.x; asm volatile("" : "+v"(tid_));
  const int tid = tid_, wid = tid >> 6, lane = tid & 63, r32 = lane & 31, hi = lane >> 5;
  char* V_lds = lds; char* K_lds = lds + 2 * SHM_V;
  float* ws = (float*)(lds + 2 * SHM_V + 2 * SHM_K) + wid * 64; float* li_l = ws; float* al_l = ws + 32;
  float m_reg = -1e30f, l_reg = 0; f32x16 o[DV / 32]; bf16x8 qr[DQK / 16];
#pragma unroll
  for (int d = 0; d < DV / 32; ++d) o[d] = f32x16{};
  const unsigned short* Qw = Qb + (long)(wid * QBLK + r32) * ldq + hi * 8;
#pragma unroll
  for (int d0 = 0; d0 < DQK / 16; ++d0) qr[d0] = *reinterpret_cast<const bf16x8*>(Qw + d0 * 16);
  if constexpr (QROPE) {
    static_assert(DQK == 96, "QROPE is the MLA case");
    int t = q0lat + wid * QBLK + r32; asm volatile("" : "+v"(t));
#pragma unroll
    for (int part = 0; part < 2; ++part) { const float pos = (float)(part ? (t & 63) : (t >> 6)); u32x4 w = __builtin_bit_cast(u32x4, qr[4 + part]); u32x4 o;
#pragma unroll
      for (int q = 0; q < 4; ++q) { const unsigned pw = (unsigned)__shfl_xor((int)w[q], 32); float x0 = bflo(w[q]), x1 = bfhi(w[q]); const float p0 = bflo(pw), p1 = bfhi(pw);
        float s0, c0, s1, c1; sincosf(pos * __powf(10000.f, -(float)(2 * q) * 0.125f), &s0, &c0); sincosf(pos * __powf(10000.f, -(float)(2 * q + 1) * 0.125f), &s1, &c1);
        x0 = hi ? (x0 * c0 + p0 * s0) : (x0 * c0 - p0 * s0); x1 = hi ? (x1 * c1 + p1 * s1) : (x1 * c1 - p1 * s1); o[q] = cvtpk(x0, x1); }
      qr[4 + part] = __builtin_bit_cast(bf16x8, o); } }
  const int sr = tid >> 4, sc = (tid & 15) * 8, vst0 = v_st(sr, sc), vst1 = v_st(32 + sr, sc);
  const bool kact = sc < DQK, vact = sc < DV;
  const int vb0 = (int)(uintptr_t)V_lds + v_rd_base(lane);
  struct { bf16x8 vs0, vs1, ks0, ks1; } sr_[2];
#define TROW(j) ((MODE == 1 && (j) >= 4) ? (256 + lat0 + ((j) - 4) * 64) : (j) * 64)
#define SLOAD(i, j) do { const long k0_ = TROW(j); \
    if (vact) { sr_[i].vs0 = *reinterpret_cast<const bf16x8*>(&Vb[(k0_ + sr) * ldv + sc]); sr_[i].vs1 = *reinterpret_cast<const bf16x8*>(&Vb[(k0_ + 32 + sr) * ldv + sc]); } \
    if (kact) { sr_[i].ks0 = *reinterpret_cast<const bf16x8*>(&Kb[(k0_ + sr) * ldk + sc]); sr_[i].ks1 = *reinterpret_cast<const bf16x8*>(&Kb[(k0_ + 32 + sr) * ldk + sc]); } } while (0)
#define SWRITE(b, i) do { if (vact) { *(bf16x8*)(V_lds + (b) * SHM_V + vst0) = sr_[i].vs0; *(bf16x8*)(V_lds + (b) * SHM_V + vst1) = sr_[i].vs1; } \
    if (kact) { const int kc = sc * 2; *(bf16x8*)(K_lds + (b) * SHM_K + KSWZ(sr, kc)) = sr_[i].ks0; *(bf16x8*)(K_lds + (b) * SHM_K + KSWZ(32 + sr, kc)) = sr_[i].ks1; } } while (0)
#define RESC(a) do { if (__any((a) < 1.f)) { if (hi == 0) al_l[r32] = (a); asm volatile("s_waitcnt lgkmcnt(0)" ::: "memory"); \
    _Pragma("unroll") for (int d = 0; d < DV / 32; ++d) _Pragma("unroll") for (int r = 0; r < 16; ++r) o[d][r] *= al_l[crow(r, hi)]; } } while (0)
#define MASK(P0, P1, j) do { if (MODE == 1 && (j) >= 4) { const int kb_ = lat0 + ((j) - 4) * 64 + 4 * hi - (q0lat + wid * QBLK + r32); \
    _Pragma("unroll") for (int r = 0; r < 16; ++r) { const int dk_ = kb_ + (r & 3) + 8 * (r >> 2); if (dk_ > 128 || dk_ < -128) P0[r] = -1e30f; if (dk_ + 32 > 128 || dk_ + 32 < -128) P1[r] = -1e30f; } } } while (0)
  f32x16 pA0, pA1, pB0, pB1; float mnA, mnB, alA, alB; bf16x8 pa0, pa1, pa2, pa3;
  SLOAD(0, 0); asm volatile("s_waitcnt vmcnt(0)" ::: "memory"); SWRITE(0, 0); __syncthreads();
  qkt<DQK>(pA0, pA1, K_lds, qr, r32, hi); MASK(pA0, pA1, 0); partialSM(pA0, pA1, m_reg, mnA, alA, C, thr_s);
  SLOAD(1, 1); if (2 < NT) SLOAD(0, 2);
  asm volatile("s_waitcnt vmcnt(4)" ::: "memory"); SWRITE(1, 1); __syncthreads();
  for (int j = 1; j + 1 < NT; j += 2) {
    SBAR(); qkt<DQK>(pB0, pB1, K_lds + SHM_K, qr, r32, hi); MASK(pB0, pB1, j);
    finishSM(pA0, pA1, alA, l_reg, pa0, pa1, pa2, pa3); SBAR();
    SLOAD(1, j + 2); SBAR();
    pv_all<DV>(o, vb0, pa0, pa1, pa2, pa3); partialSM(pB0, pB1, m_reg, mnB, alB, C, thr_s);
    __syncthreads(); asm volatile("s_waitcnt vmcnt(4)" ::: "memory"); SWRITE(0, 0);
    RESC(alB); __syncthreads();
    SBAR(); qkt<DQK>(pA0, pA1, K_lds, qr, r32, hi); MASK(pA0, pA1, j + 1);
    finishSM(pB0, pB1, alB, l_reg, pa0, pa1, pa2, pa3); SBAR();
    if (j + 3 < NT) SLOAD(0, j + 3); SBAR();
    pv_all<DV>(o, vb0 + (int)SHM_V, pa0, pa1, pa2, pa3); partialSM(pA0, pA1, m_reg, mnA, alA, C, thr_s);
    __syncthreads(); asm volatile("s_waitcnt vmcnt(4)" ::: "memory"); SWRITE(1, 1);
    RESC(alA); __syncthreads();
  }
  SBAR(); qkt<DQK>(pB0, pB1, K_lds + SHM_K, qr, r32, hi); MASK(pB0, pB1, NT - 1);
  finishSM(pA0, pA1, alA, l_reg, pa0, pa1, pa2, pa3); SBAR();
  pv_all<DV>(o, vb0, pa0, pa1, pa2, pa3); partialSM(pB0, pB1, m_reg, mnB, alB, C, thr_s);
  __syncthreads(); RESC(alB);
  finishSM(pB0, pB1, alB, l_reg, pa0, pa1, pa2, pa3); SBAR();
  pv_all<DV>(o, vb0 + (int)SHM_V, pa0, pa1, pa2, pa3);
  if (sinkl2 > -1e29f) l_reg += __builtin_amdgcn_exp2f(sinkl2 - m_reg * C);
  if (hi == 0) li_l[r32] = l_reg; asm volatile("s_waitcnt lgkmcnt(0)" ::: "memory");
  float rli[16];
#pragma unroll
  for (int r = 0; r < 16; ++r) rli[r] = __builtin_amdgcn_rcpf(li_l[crow(r, hi)]);
  if constexpr (OUTMODE == 0) {
  unsigned short* Ow = Ob + (long)(wid * QBLK) * ldo;
#pragma unroll
  for (int r = 0; r < 16; ++r) { const int orow = crow(r, hi);
#pragma unroll
    for (int d0 = 0; d0 < DV / 32; ++d0) Ow[(long)orow * ldo + d0 * 32 + r32] = (unsigned short)f2bf(o[d0][r] * rli[r]); }
  } else {   int zo_ = 0; asm volatile("" : "+v"(zo_)); const int lane = (int)__builtin_amdgcn_mbcnt_hi(~0u, __builtin_amdgcn_mbcnt_lo(~0u, (unsigned)zo_)), r32 = lane & 31, hi = lane >> 5;
    unsigned short* stg = (unsigned short*)(lds + SHM_ATTN) + wid * 4096;
    if constexpr (OUTMODE == 1) {
#pragma unroll
      for (int d0 = 0; d0 < DV / 32; ++d0)
#pragma unroll
        for (int r = 0; r < 16; ++r) stg[(d0 * 16 + r) * 64 + lane] = (unsigned short)f2bf(o[d0][r] * rli[r]);
    } else {
      unsigned short* Ow = Ob + (long)(wid * QBLK) * ldo;
#pragma unroll
      for (int r = 0; r < 16; ++r) { float v[DV / 32]; float ss = 0.f;
#pragma unroll
        for (int d0 = 0; d0 < DV / 32; ++d0) { v[d0] = bf2f(stg[(d0 * 16 + r) * 64 + lane]) - lam * (o[d0][r] * rli[r]); ss += v[d0] * v[d0]; }
        ss += __shfl_xor(ss, 1); ss += __shfl_xor(ss, 2); ss += __shfl_xor(ss, 4); ss += __shfl_xor(ss, 8); ss += __shfl_xor(ss, 16);
        const float rs = nscale / sqrtf(ss * (1.f / (float)DV) + 1e-6f); const int orow = crow(r, hi);
#pragma unroll
        for (int d0 = 0; d0 < DV / 32; ++d0) Ow[(long)orow * ldo + d0 * 32 + r32] = (unsigned short)f2bf(v[d0] * rs * nw[d0 * 32 + r32]);
        __builtin_amdgcn_sched_barrier(0); }
    }
  }
  __syncthreads();
#undef TROW
#undef SLOAD
#undef SWRITE
#undef RESC
#undef MASK
}
#undef KSWZ
#undef SBAR
}
struct Args { const float* in[32]; float* out; unsigned char* ws; int ph_lo, ph_hi; };
struct Frame {
    LAS unsigned char* lds; char* ldsg;
    volatile LAS unsigned* MISC;
    gu32* ctl;
    int tid, lane, wave, vcu, G, gw, NGW;
    const float* const* in; float* out; unsigned char* ws;
};
enum { I_X = 0, I_C, I_CTX, I_CCTX, I_EMODW, I_EMODB, I_ENORMS, I_EWIN, I_ECONV, I_EALOG, I_EDTB, I_EGDNN, I_ESINK, I_EWOUT, I_EFG, I_EFU, I_EFD,
       I_OMODW, I_OMODB, I_ONORMS, I_OWIN, I_OQN, I_OKVN, I_OWUQ, I_OWUKV, I_OLAM, I_OSUBLN, I_OWOUT, I_OROUTER, I_OXG, I_OXU, I_OXD };

__device__ __forceinline__ void transpose_item(const float* W, int N, bf16* WT, int ldk, int k0, int n0, int drow0, const float* kscale, LAS float* scr, int lane) {
#pragma unroll 8
    for (int i = 0; i < 32; ++i) { const int kk = 2 * i + (lane >> 5); float v = W[(size_t)(k0 + kk) * N + n0 + (lane & 31)]; if (kscale) v *= kscale[k0 + kk]; scr[kk * 33 + (lane & 31)] = v; }
    LDS_WAIT(); asm volatile("" ::: "memory");
    const int c = lane & 7;
#pragma unroll
    for (int j = 0; j < 4; ++j) { const int n = (lane >> 3) + 8 * j; const LAS float* s = scr + (8 * c) * 33 + n;
        v4u o; o.x = pk2(s[0 * 33], s[1 * 33]); o.y = pk2(s[2 * 33], s[3 * 33]); o.z = pk2(s[4 * 33], s[5 * 33]); o.w = pk2(s[6 * 33], s[7 * 33]);
        *(GAS v4u*)(WT + (size_t)(drow0 + n) * ldk + k0 + 8 * c) = o; }
    LDS_WAIT(); asm volatile("" ::: "memory");
}
template <int MAP> __device__ __forceinline__ void transpose_job(Frame& F, const float* W, int K, int N, bf16* WT, const float* kscale, int first, int stride, LAS unsigned char* scrb) {
    LAS float* scr = (LAS float*)scrb;
    const int nblk = N / 32, items = (K / 64) * nblk;
    for (int it = first; it < items; it += stride) { const int kb = it / nblk, nb = it % nblk, n0 = 32 * nb;
        const int drow0 = (MAP == 0) ? n0 : ((n0 >> 7) * 256 + (n0 & 127) + (MAP == 2 ? 128 : 0));
        transpose_item(W, N, WT, K, 64 * kb, n0, drow0, kscale, scr, F.lane); }
}
__device__ __forceinline__ void zero_rows(Frame& F, bf16* WT, int row0, int nrows, int K) {
    const size_t n16 = (size_t)nrows * K / 8; GAS v4u* p = (GAS v4u*)(WT + (size_t)row0 * K);
    for (size_t i = (size_t)F.gw * 64 + F.lane; i < n16; i += (size_t)F.NGW * 64) p[i] = (v4u){0u, 0u, 0u, 0u};
}
__device__ __forceinline__ void modv_items(Frame& F) {
    LAS float* sc = (LAS float*)(F.lds + RING_OFF);
    LAS float* part = (LAS float*)(F.lds + RING_OFF + 20480);
    float* MODV = (float*)(F.ws + WS_MODV);
    const int nitems = 2 * 96;
    if ((int)blockIdx.x >= nitems) return;
    for (int i = F.tid; i < 5 * 1024; i += 512) { const int r = i >> 10, k = i & 1023; const float v = (r < 4) ? F.in[I_C][r * 1024 + k] : F.in[I_CCTX][k]; sc[i] = siluf(v); }
    __syncthreads();
    for (int it = blockIdx.x; it < nitems; it += F.G) {
        const int l = it / 96, n0 = (it % 96) * 64, col = F.tid & 63, ks = F.tid >> 6;
        const float* W = F.in[l ? I_OMODW : I_EMODW] + (size_t)(ks * 128) * 6144 + n0 + col;
        float a0 = 0, a1 = 0, a2 = 0, a3 = 0, a4 = 0;
#pragma unroll 8
        for (int k = 0; k < 128; ++k) { const float w = W[(size_t)k * 6144]; const int kk = ks * 128 + k;
            a0 += sc[kk] * w; a1 += sc[1024 + kk] * w; a2 += sc[2048 + kk] * w; a3 += sc[3072 + kk] * w; a4 += sc[4096 + kk] * w; }
        part[(ks * 5 + 0) * 64 + col] = a0; part[(ks * 5 + 1) * 64 + col] = a1; part[(ks * 5 + 2) * 64 + col] = a2; part[(ks * 5 + 3) * 64 + col] = a3; part[(ks * 5 + 4) * 64 + col] = a4;
        __syncthreads();
        if (F.tid < 320) { const int r = F.tid >> 6, c2 = F.tid & 63; float s = F.in[l ? I_OMODB : I_EMODB][n0 + c2];
#pragma unroll
            for (int q = 0; q < 8; ++q) s += part[(q * 5 + r) * 64 + c2];
            MODV[(size_t)(l * 5 + r) * 6144 + n0 + c2] = s; }
        __syncthreads();
    }
}
__device__ __forceinline__ const float* modvec(Frame& F, int l, int mr, int k) { return (const float*)(F.ws + WS_MODV) + (size_t)((l * 5 + mr) * 6 + k) * 1024; }

struct Row4 { f32x4 v[4]; };
__device__ __forceinline__ Row4 ld_row_f32(const float* p, int lane) { Row4 r; const GAS f32x4* q = (const GAS f32x4*)p + lane;
#pragma unroll
    for (int j = 0; j < 4; ++j) r.v[j] = q[64 * j]; return r; }
__device__ __forceinline__ Row4 ld_row_bf16(const bf16* p, int lane) { Row4 r; const GAS v2u* q = (const GAS v2u*)p + lane;
#pragma unroll
    for (int j = 0; j < 4; ++j) { const v2u w = q[64 * j]; r.v[j] = (f32x4){bflo(w.x), bfhi(w.x), bflo(w.y), bfhi(w.y)}; } return r; }
__device__ __forceinline__ void st_row_f32(float* p, int lane, const Row4& r) { GAS f32x4* q = (GAS f32x4*)p + lane;
#pragma unroll
    for (int j = 0; j < 4; ++j) q[64 * j] = r.v[j]; }
__device__ __forceinline__ void st_row_bf16(bf16* p, int lane, const Row4& r) { GAS v2u* q = (GAS v2u*)p + lane;
#pragma unroll
    for (int j = 0; j < 4; ++j) q[64 * j] = (v2u){pk2(r.v[j].x, r.v[j].y), pk2(r.v[j].z, r.v[j].w)}; }
__device__ __forceinline__ float row_rstd(const Row4& r) { float s = 0.f;
#pragma unroll
    for (int j = 0; j < 4; ++j) s += (r.v[j].x * r.v[j].x + r.v[j].y * r.v[j].y) + (r.v[j].z * r.v[j].z + r.v[j].w * r.v[j].w);
    return 1.f / sqrtf(wave_sum(s) * (1.f / 1024.f) + EPS); }
__device__ __forceinline__ float* xres_ptr(Frame& F, int r, int& mr) { const int b = r / SROW, s = r - b * SROW;
    if (s < TC) { mr = 4; return (float*)(F.ws + WS_HCTX) + (size_t)(b * TC + s) * D; }
    mr = b; return F.out + (size_t)(b * T + s - TC) * D; }
__device__ __forceinline__ Row4 norm_mod(const Row4& x, const float* w, const float* shift, const float* scale, int lane) {
    const float rs = row_rstd(x); const Row4 W = ld_row_f32(w, lane), SH = ld_row_f32(shift, lane), SC = ld_row_f32(scale, lane); Row4 a;
#pragma unroll
    for (int j = 0; j < 4; ++j) a.v[j] = (x.v[j] * rs * W.v[j]) * (SC.v[j] + 1.f) + SH.v[j];
    return a; }
__device__ __forceinline__ Row4 norm_mod_r(const Row4& x, const Row4& W, const Row4& SH, const Row4& SC) {
    const float rs = row_rstd(x); Row4 a;
#pragma unroll
    for (int j = 0; j < 4; ++j) a.v[j] = (x.v[j] * rs * W.v[j]) * (SC.v[j] + 1.f) + SH.v[j];
    return a; }
__device__ __forceinline__ void add_gated_norm_r(Row4& x, const Row4& y, const Row4& W, const Row4& G) {
    const float rs = row_rstd(y);
#pragma unroll
    for (int j = 0; j < 4; ++j) x.v[j] = x.v[j] + G.v[j] * (y.v[j] * rs * W.v[j]); }
__device__ __forceinline__ int tok_vcu(const Frame& F, int b, int t) { const int wpb = F.NGW >> 2; return (b * wpb + t % wpb) >> 3; }
__device__ __forceinline__ void add_gated_norm(Row4& x, const Row4& y, const float* w, const float* gate, int lane) {
    const float rs = row_rstd(y); const Row4 W = ld_row_f32(w, lane), G = ld_row_f32(gate, lane);
#pragma unroll
    for (int j = 0; j < 4; ++j) x.v[j] = x.v[j] + G.v[j] * (y.v[j] * rs * W.v[j]); }
__device__ __forceinline__ void p0_prologue(Frame& F) {
    modv_items(F);
    __syncthreads();
    transpose_job<0>(F, F.in[I_EWIN], 1024, EIN, (bf16*)(F.ws + WS_WEIN), nullptr, F.gw, F.NGW, F.lds + RING_OFF + F.wave * 16384);
    zero_rows(F, (bf16*)(F.ws + WS_WEIN), EIN, EINP - EIN, 1024);
}
__device__ __forceinline__ void p0_deferred(Frame& F, int w4, LAS unsigned char* scr) {
    const float* const* in = F.in; unsigned char* ws = F.ws; const int gw = F.vcu * 4 + w4, N = F.G * 4;
    transpose_job<0>(F, in[I_EWOUT], 1024, 1024, (bf16*)(ws + WS_WEOUT), nullptr, gw, N, scr);
    transpose_job<1>(F, in[I_EFG], 1024, DFF, (bf16*)(ws + WS_WEGU), nullptr, (gw + 512) % N, N, scr);
    transpose_job<2>(F, in[I_EFU], 1024, DFF, (bf16*)(ws + WS_WEGU), nullptr, (gw + 896) % N, N, scr);
    transpose_job<0>(F, in[I_EFD], DFF, 1024, (bf16*)(ws + WS_WEDN), nullptr, (gw + 256) % N, N, scr);
    transpose_job<0>(F, in[I_OWIN], 1024, OIN, (bf16*)(ws + WS_WOIN), nullptr, (gw + 640) % N, N, scr);
    transpose_job<0>(F, in[I_OWUQ], 384, 768, (bf16*)(ws + WS_WUQ), in[I_OQN], (gw + 720) % N, N, scr);
    transpose_job<0>(F, in[I_OWUKV], 256, 1024, (bf16*)(ws + WS_WUKV), in[I_OKVN], (gw + 864) % N, N, scr);
    transpose_job<0>(F, in[I_OWOUT], 1024, 1024, (bf16*)(ws + WS_WOOUT), nullptr, (gw + 992) % N, N, scr);
    { const size_t n16 = (size_t)(OINP - OIN) * 1024 / 8; GAS v4u* p = (GAS v4u*)((bf16*)(ws + WS_WOIN) + (size_t)OIN * 1024);
      for (size_t i = (size_t)gw * 64 + F.lane; i < n16; i += (size_t)N * 64) p[i] = (v4u){0u, 0u, 0u, 0u}; }
}
__device__ __forceinline__ void px_expert_weights(Frame& F) {
    for (int e = 0; e < NEXP; ++e) {
        transpose_job<1>(F, F.in[I_OXG] + (size_t)e * 1024 * DFX, 1024, DFX, (bf16*)(F.ws + WS_WXGU) + (size_t)e * 7168 * 1024, nullptr, (F.gw + e * 448) % F.NGW, F.NGW, F.lds + RING_OFF + F.wave * 8448);
        transpose_job<2>(F, F.in[I_OXU] + (size_t)e * 1024 * DFX, 1024, DFX, (bf16*)(F.ws + WS_WXGU) + (size_t)e * 7168 * 1024, nullptr, (F.gw + e * 448 + 224) % F.NGW, F.NGW, F.lds + RING_OFF + F.wave * 8448);
        transpose_job<0>(F, F.in[I_OXD] + (size_t)e * DFX * 1024, DFX, 1024, (bf16*)(F.ws + WS_WXDN) + (size_t)e * 1024 * DFX, nullptr, (F.gw + e * 448 + 112) % F.NGW, F.NGW, F.lds + RING_OFF + F.wave * 8448);
    }
}
__device__ __forceinline__ void p1_first_rows(Frame& F) {
    bf16* A = (bf16*)(F.ws + WS_ABUF); const float* w0 = F.in[I_ENORMS]; const int wpb = F.NGW >> 2, b = F.gw / wpb, wl = F.gw - b * wpb;
    { const Row4 W = ld_row_f32(w0, F.lane), SH = ld_row_f32(modvec(F, 0, b, 0), F.lane), SC = ld_row_f32(modvec(F, 0, b, 1), F.lane);
      for (int t = wl; t < T; t += wpb) { const size_t tk = (size_t)b * T + t; const Row4 x = ld_row_f32(F.in[I_X] + tk * D, F.lane); st_row_bf16((bf16*)(F.ws + WS_XB) + tk * D, F.lane, x);
          const Row4 a = norm_mod_r(x, W, SH, SC); st_row_bf16(A + ((size_t)b * SROW + TC + t) * D, F.lane, a); } }
    for (int c = F.gw; c < NB * TC; c += F.NGW) { const int cb = c / TC, s = c - cb * TC;
        const Row4 x = ld_row_f32(F.in[I_CTX] + (size_t)c * D, F.lane); st_row_f32((float*)(F.ws + WS_HCTX) + (size_t)c * D, F.lane, x);
        const Row4 a = norm_mod(x, w0, modvec(F, 0, 4, 0), modvec(F, 0, 4, 1), F.lane); st_row_bf16(A + ((size_t)cb * SROW + s) * D, F.lane, a); }
}
constexpr int ROUTER_TAB_OFF = 69632;
__device__ __forceinline__ void router_table(Frame& F) {
    LAS f32x4* tab = (LAS f32x4*)(F.lds + RING_OFF + ROUTER_TAB_OFF); const float* Rw = F.in[I_OROUTER];
    for (int i = F.tid; i < 2048; i += 512) { const int ln = i & 63, h = (i >> 6) & 1, q = (i >> 7) & 3, j = i >> 9; tab[i] = *(const GAS f32x4*)(Rw + (size_t)(4 * ln + 256 * j + q) * 8 + 4 * h); }
    __syncthreads();
}
template <bool ROUTER> __device__ __forceinline__ void rows_mid(Frame& F, const bf16* Y, const float* wy, int lg, int kg, const float* w2, int l2, int ks2, bf16* Aout, bool lat_only, int nsl = 0) {
    const int wpb = F.NGW >> 2, b = F.gw / wpb, wl = F.gw - b * wpb;
    { const Row4 Wy = ld_row_f32(wy, F.lane), Gt = ld_row_f32(modvec(F, lg, b, kg), F.lane), W2 = ld_row_f32(w2, F.lane), SH = ld_row_f32(modvec(F, l2, b, ks2), F.lane), SC = ld_row_f32(modvec(F, l2, b, ks2 + 1), F.lane);
      for (int t = wl; t < T; t += wpb) { const size_t tk = (size_t)b * T + t, r = (size_t)b * SROW + TC + t; bf16* xr = (bf16*)(F.ws + WS_XB) + tk * D;
        Row4 x = ld_row_bf16(xr, F.lane); const Row4 y = ld_row_bf16(Y + r * D, F.lane);
        add_gated_norm_r(x, y, Wy, Gt); st_row_bf16(xr, F.lane, x);
        const Row4 a = norm_mod_r(x, W2, SH, SC);
        st_row_bf16(Aout + r * D, F.lane, a);
        if constexpr (ROUTER) {
            LAS const f32x4* Rt = (LAS const f32x4*)(F.lds + RING_OFF + ROUTER_TAB_OFF) + F.lane; float lg8[8];
#pragma unroll
            for (int e = 0; e < 8; ++e) lg8[e] = 0.f;
#pragma unroll
            for (int j = 0; j < 4; ++j)
#pragma unroll
                for (int q = 0; q < 4; ++q) { const f32x4 r0 = Rt[((j * 4 + q) * 2 + 0) * 64], r1 = Rt[((j * 4 + q) * 2 + 1) * 64]; const float av = a.v[j][q];
                    lg8[0] += av * r0.x; lg8[1] += av * r0.y; lg8[2] += av * r0.z; lg8[3] += av * r0.w; lg8[4] += av * r1.x; lg8[5] += av * r1.y; lg8[6] += av * r1.z; lg8[7] += av * r1.w; }
#pragma unroll
            for (int e = 0; e < 8; ++e) lg8[e] = wave_sum(lg8[e]);
            int i0 = 0; float v0 = lg8[0];
#pragma unroll
            for (int e = 1; e < 8; ++e) if (lg8[e] > v0) { v0 = lg8[e]; i0 = e; }
            int i1 = -1; float v1 = -3.0e38f;
#pragma unroll
            for (int e = 0; e < 8; ++e) if (e != i0 && lg8[e] > v1) { v1 = lg8[e]; i1 = e; }
            const float e1 = __expf(v1 - v0), w0 = 1.f / (1.f + e1), w1 = e1 * w0;
            if (F.lane == 0) {
                int* TOPI = (int*)(F.ws + WS_META + META_TOPI); float* TOPW = (float*)(F.ws + WS_META + META_TOPW); int* RANK = (int*)(F.ws + WS_META + META_RANK);
                TOPI[tk * 2] = i0; TOPI[tk * 2 + 1] = i1; TOPW[tk * 2] = w0; TOPW[tk * 2 + 1] = w1;
                RANK[tk * 2] = (int)__hip_atomic_fetch_add((LAS unsigned*)(F.MISC + 24 + i0), 1u, __ATOMIC_RELAXED, __HIP_MEMORY_SCOPE_WORKGROUP);
                RANK[tk * 2 + 1] = (int)__hip_atomic_fetch_add((LAS unsigned*)(F.MISC + 24 + i1), 1u, __ATOMIC_RELAXED, __HIP_MEMORY_SCOPE_WORKGROUP); }
        } } }
    if (!lat_only) for (int c = F.gw; c < NB * TC; c += F.NGW) { const int cb = c / TC, s = c - cb * TC; const size_t r = (size_t)cb * SROW + s; float* xr = (float*)(F.ws + WS_HCTX) + (size_t)c * D;
        Row4 x = ld_row_f32(xr, F.lane); Row4 y;
        if (nsl > 0) {
            const float* pp = (const float*)(F.ws + WS_PART) + (size_t)c * 1024; y = ld_row_f32(pp, F.lane);
            for (int q = 1; q < nsl; ++q) { const Row4 t = ld_row_f32(pp + (size_t)q * 1024 * 1024, F.lane);
#pragma unroll
                for (int j = 0; j < 4; ++j) y.v[j] = y.v[j] + t.v[j]; } }
        else y = ld_row_bf16(Y + r * D, F.lane);
        add_gated_norm(x, y, wy, modvec(F, lg, 4, kg), F.lane); st_row_f32(xr, F.lane, x);
        const Row4 a = norm_mod(x, w2, modvec(F, l2, 4, ks2), modvec(F, l2, 4, ks2 + 1), F.lane);
        st_row_bf16(Aout + r * D, F.lane, a); }
}
__device__ __forceinline__ void router_tail(Frame& F) {
    {
        __syncthreads();
        if (F.tid < 8) { ((int*)(F.ws + WS_META + META_BLKB))[F.vcu * 8 + F.tid] = (int)__hip_atomic_fetch_add((unsigned*)(F.ctl + CW_MOECNT + 64 * F.tid), F.MISC[24 + F.tid], RLX_AGENT); F.MISC[24 + F.tid] = 0u; }
    }
}
__device__ __forceinline__ void g0_prep(Frame& F) {
    const bf16* P = (const bf16*)(F.ws + WS_PROJ); bf16* PW = (bf16*)(F.ws + WS_PROJ); bf16* QK = (bf16*)(F.ws + WS_QKVN); float* GB = (float*)(F.ws + WS_GB);
    const float* cw = F.in[I_ECONV]; const int lane = F.lane;
#pragma unroll 1
    for (int part = 0; part < 3; ++part) { const int ch = part * 512 + 8 * lane; float w[5][8];
#pragma unroll
        for (int j = 0; j < 5; ++j) { const f32x4 w0 = *(const GAS f32x4*)(cw + j * 1536 + ch), w1 = *(const GAS f32x4*)(cw + j * 1536 + ch + 4); w[j][0] = w0.x; w[j][1] = w0.y; w[j][2] = w0.z; w[j][3] = w0.w; w[j][4] = w1.x; w[j][5] = w1.y; w[j][6] = w1.z; w[j][7] = w1.w; }
        v4u tn[5];
#define G0_TAPS(dst, r_) do { const int b_ = (r_) / SROW, s_ = (r_) - b_ * SROW; const bool c_ = s_ < TC; const int p_ = c_ ? s_ : s_ - TC, len_ = c_ ? TC : T; \
            _Pragma("unroll") for (int j = 0; j < 5; ++j) { const int pp = p_ + j - 2; dst[j] = (pp >= 0 && pp < len_) ? *(const GAS v4u*)(P + (size_t)((r_) + j - 2) * EINP + ch) : (v4u){0u, 0u, 0u, 0u}; } } while (0)
        if (F.gw < NR) G0_TAPS(tn, F.gw);
        for (int r = F.gw; r < NR; r += F.NGW) { v4u tc[5];
#pragma unroll
            for (int j = 0; j < 5; ++j) tc[j] = tn[j];
            if (r + F.NGW < NR) G0_TAPS(tn, r + F.NGW);
            float acc[8];
#pragma unroll
            for (int e = 0; e < 8; ++e) acc[e] = 0.f;
#pragma unroll
            for (int j = 0; j < 5; ++j) { const v4u xv = tc[j];
                acc[0] += bflo(xv.x) * w[j][0]; acc[1] += bfhi(xv.x) * w[j][1]; acc[2] += bflo(xv.y) * w[j][2]; acc[3] += bfhi(xv.y) * w[j][3];
                acc[4] += bflo(xv.z) * w[j][4]; acc[5] += bfhi(xv.z) * w[j][5]; acc[6] += bflo(xv.w) * w[j][6]; acc[7] += bfhi(xv.w) * w[j][7]; }
            float ss = 0.f;
#pragma unroll
            for (int e = 0; e < 8; ++e) { acc[e] = siluf(acc[e]); ss += acc[e] * acc[e]; }
            if (part < 2) { ss += __shfl_xor(ss, 1); ss += __shfl_xor(ss, 2); ss += __shfl_xor(ss, 4); const float sc = (part == 0 ? 0.125f : 1.f) / sqrtf(ss + EPS);
#pragma unroll
                for (int e = 0; e < 8; ++e) acc[e] *= sc; }
            *(GAS v4u*)(QK + (size_t)r * 1536 + ch) = (v4u){pk2(acc[0], acc[1]), pk2(acc[2], acc[3]), pk2(acc[4], acc[5]), pk2(acc[6], acc[7])}; }
#undef G0_TAPS
    }
    for (int r = F.gw; r < NR; r += F.NGW) { const int b = r / SROW, s = r - b * SROW; const bool isc = s < TC; const int p = isc ? s : s - TC;
        if (lane < 16) { const float ga = bf2f(P[(size_t)r * EINP + E_GA + lane]), gb = bf2f(P[(size_t)r * EINP + E_GB + lane]);
            const float xx = ga + F.in[I_EDTB][lane], sp = fmaxf(xx, 0.f) + log1pf(__expf(-fabsf(xx)));
            GB[(size_t)r * 32 + lane] = -__expf(F.in[I_EALOG][lane]) * sp; GB[(size_t)r * 32 + 16 + lane] = 1.f / (1.f + __expf(-gb)); }
        if (!isc) {
            const int pi = lane & 31, seg = pi >> 4, i = pi & 15, d0 = seg * 32 + i; const float pos = (float)(seg ? (p & 63) : (p >> 6));
            const float ang = pos * __powf(10000.f, -(float)i * (1.f / 16.f)); float sn, cs; sincosf(ang, &sn, &cs);
#pragma unroll
            for (int q = 0; q < 5; ++q) { const int hh = (lane >> 5) + 2 * q; bf16* base = PW + (size_t)r * EINP + (hh < 8 ? E_SQ + hh * 64 : E_SK + (hh - 8) * 64) + d0;
                const float x0 = bf2f(base[0]), x1 = bf2f(base[16]); base[0] = (bf16)f2bf(x0 * cs - x1 * sn); base[16] = (bf16)f2bf(x1 * cs + x0 * sn); }
        }
    }
}
constexpr int GP = 65, GLP = 68;
template <int I> struct SolveRow {
    static __device__ __forceinline__ void run(float (&x)[64], const LAS float* Ls) {
        SolveRow<I - 1>::run(x, Ls);
        float a = x[I];
#pragma unroll
        for (int j = 0; j < I; ++j) a -= Ls[I * GLP + j] * x[j];
        x[I] = a;
    }
};
template <> struct SolveRow<0> { static __device__ __forceinline__ void run(float (&)[64], const LAS float*) {} };

__device__ __forceinline__ void gdn_chain(Frame& F, int chain) {
    const int b = chain >> 4, h = (chain >> 1) & 7, dir = chain & 1;
    LAS float* Ss = (LAS float*)(F.lds + RING_OFF);
    LAS float* Qs = Ss + 64 * GP, *Ks = Qs + 64 * GP, *Vs = Ks + 64 * GP  , *ATs = Vs + 64 * GP, *Ws = ATs + 64 * GP, *VNs = Ws + 64 * GP;
    LAS float* Ls = VNs + 64 * GP;
    LAS float* gcs = Ls + 64 * GLP, *bts = gcs + 64;
    const bf16* QK = (const bf16*)(F.ws + WS_QKVN); const float* GB = (const float*)(F.ws + WS_GB); bf16* OG = (bf16*)(F.ws + WS_OG);
    const int tid = F.tid, lane = F.lane, w = F.wave;
    for (int i = tid; i < 64 * GP; i += 512) Ss[i] = 0.f;
    for (int ci = 0; ci < 68; ++ci) {
        const bool isc = ci < 4; const int n0 = (isc ? ci : ci - 4) * 64; const int rbase = b * SROW + (isc ? 0 : TC), len = isc ? TC : T;
        __syncthreads();
        for (int e = tid; e < 64 * 24; e += 512) { const int i = e / 24, c8 = e % 24, part = c8 >> 3, cc = (c8 & 7) * 8; const int n = n0 + i, row = rbase + (dir ? len - 1 - n : n);
            const v4u xv = *(const GAS v4u*)(QK + (size_t)row * 1536 + part * 512 + h * 64 + cc); LAS float* dst = (part == 0 ? Qs : part == 1 ? Ks : Vs) + i * GP + cc;
            dst[0] = bflo(xv.x); dst[1] = bfhi(xv.x); dst[2] = bflo(xv.y); dst[3] = bfhi(xv.y); dst[4] = bflo(xv.z); dst[5] = bfhi(xv.z); dst[6] = bflo(xv.w); dst[7] = bfhi(xv.w); }
        if (tid < 64) { const int n = n0 + tid, row = rbase + (dir ? len - 1 - n : n); float g = GB[(size_t)row * 32 + dir * 8 + h]; bts[tid] = GB[(size_t)row * 32 + 16 + dir * 8 + h];
#pragma unroll
            for (int o = 1; o < 64; o <<= 1) { const float t = __shfl_up(g, o); if (lane >= o) g += t; }
            gcs[tid] = g; }
        __syncthreads();
#pragma unroll 1
        for (int k = 0; k < 8; ++k) { const int i = w + 8 * k, j = lane; float kk = 0.f, qk = 0.f;
#pragma unroll 16
            for (int d = 0; d < 64; ++d) { const float kj = Ks[j * GP + d]; kk += Ks[i * GP + d] * kj; qk += Qs[i * GP + d] * kj; }
            const float dec = (j <= i) ? __expf(gcs[i] - gcs[j]) : 0.f;
            Ls[i * GLP + j] = (j < i) ? bts[i] * kk * dec : 0.f; ATs[i * GP + j] = qk * dec; }
        __syncthreads();
        if (tid < 128) { float x[64]; const int c = tid & 63; const bool isw = tid >= 64; int zz = 0; asm volatile("" : "+v"(zz));
            const LAS float* src = (isw ? Ks : Vs) + c; const LAS float* btz = bts + zz; const LAS float* gcz = gcs + zz;
#pragma unroll
            for (int i = 0; i < 64; ++i) { const float e = isw ? __expf(gcz[i]) : 1.f; x[i] = src[i * GP] * btz[i] * e; }
            SolveRow<63>::run(x, Ls + zz);
            LAS float* dst = isw ? Ws : Vs;
#pragma unroll
            for (int i = 0; i < 64; ++i) dst[i * GP + c] = x[i]; }
        __syncthreads();
#pragma unroll 1
        for (int k = 0; k < 8; ++k) { const int i = w + 8 * k, d = lane; float a = Vs[i * GP + d];
#pragma unroll 16
            for (int q = 0; q < 64; ++q) a -= Ws[i * GP + q] * Ss[q * GP + d];
            VNs[i * GP + d] = a; }
        __syncthreads();
#pragma unroll 1
        for (int k = 0; k < 8; ++k) { const int i = w + 8 * k, d = lane; float a = 0.f, c2 = 0.f;
#pragma unroll 16
            for (int q = 0; q < 64; ++q) { a += Qs[i * GP + q] * Ss[q * GP + d]; c2 += ATs[i * GP + q] * VNs[q * GP + d]; }
            const int n = n0 + i, row = rbase + (dir ? len - 1 - n : n);
            OG[(size_t)row * 1024 + dir * 512 + h * 64 + d] = (bf16)f2bf(a * __expf(gcs[i]) + c2); }
        __syncthreads();
        const float gl = gcs[63];
#pragma unroll 1
        for (int k = 0; k < 8; ++k) { const int a = w + 8 * k, d = lane; float acc = Ss[a * GP + d] * __expf(gl);
#pragma unroll 16
            for (int i = 0; i < 64; ++i) acc += Ks[i * GP + a] * __expf(gl - gcs[i]) * VNs[i * GP + d];
            Ss[a * GP + d] = acc; }
    }
    __syncthreads();
}
__device__ __forceinline__ void g4_gdn_out(Frame& F) {
    const bf16* OG = (const bf16*)(F.ws + WS_OG); const bf16* P = (const bf16*)(F.ws + WS_PROJ); bf16* MIX = (bf16*)(F.ws + WS_MIX); const float* gn = F.in[I_EGDNN]; const int lane = F.lane;
    const f32x4 g0 = *(const GAS f32x4*)(gn + (lane & 7) * 8), g1 = *(const GAS f32x4*)(gn + (lane & 7) * 8 + 4);
    for (int r = F.gw; r < NR; r += F.NGW) {
        const v4u a = *(const GAS v4u*)(OG + (size_t)r * 1024 + 8 * lane), c = *(const GAS v4u*)(OG + (size_t)r * 1024 + 512 + 8 * lane), z = *(const GAS v4u*)(P + (size_t)r * EINP + E_Z + 8 * lane);
        float o[8] = {bflo(a.x) + bflo(c.x), bfhi(a.x) + bfhi(c.x), bflo(a.y) + bflo(c.y), bfhi(a.y) + bfhi(c.y), bflo(a.z) + bflo(c.z), bfhi(a.z) + bfhi(c.z), bflo(a.w) + bflo(c.w), bfhi(a.w) + bfhi(c.w)};
        float ss = 0.f;
#pragma unroll
        for (int e = 0; e < 8; ++e) ss += o[e] * o[e];
        ss += __shfl_xor(ss, 1); ss += __shfl_xor(ss, 2); ss += __shfl_xor(ss, 4);
        const float rs = 1.f / sqrtf(ss * (1.f / 64.f) + EPS);
        const float zz[8] = {bflo(z.x), bfhi(z.x), bflo(z.y), bfhi(z.y), bflo(z.z), bfhi(z.z), bflo(z.w), bfhi(z.w)};
        const float gg[8] = {g0.x, g0.y, g0.z, g0.w, g1.x, g1.y, g1.z, g1.w};
#pragma unroll
        for (int e = 0; e < 8; ++e) o[e] = o[e] * rs * gg[e] * siluf(zz[e]);
        *(GAS v4u*)(MIX + (size_t)r * 1024 + 8 * lane) = (v4u){pk2(o[0], o[1]), pk2(o[2], o[3]), pk2(o[4], o[5]), pk2(o[6], o[7])}; }
}
__device__ __forceinline__ void swa_unit(Frame& F, int u) {
    const bf16* P = (const bf16*)(F.ws + WS_PROJ); bf16* MIX = (bf16*)(F.ws + WS_MIX);
    constexpr float SC = 0.125f, C = SC * 1.4426950408889634f, THRS = att::THR / SC;
    if (u < 512) { const int b = u >> 7, qb = (u >> 3) & 15, hq = u & 7, kvh = hq >> 2; const size_t rq = (size_t)b * SROW + TC + qb * 256, r0 = (size_t)b * SROW;
        const int lat0 = qb * 256 - 128 < 0 ? 0 : qb * 256 - 128, lend = qb * 256 + 384 > T ? T : qb * 256 + 384, NT = 4 + (lend - lat0) / 64;
        att::attn_unit<64, 64, 1>(P + rq * EINP + E_SQ + hq * 64, EINP, P + r0 * EINP + E_SK + kvh * 64, EINP, P + r0 * EINP + E_SV + kvh * 64, EINP,
                                  MIX + rq * 1024 + 512 + hq * 64, 1024, NT, lat0, qb * 256, C, THRS, F.in[I_ESINK][hq] * 1.4426950408889634f, F.ldsg + RING_OFF);
    } else { const int v = u - 512, b = v >> 3, hq = v & 7, kvh = hq >> 2; const size_t r0 = (size_t)b * SROW;
        att::attn_unit<64, 64, 2>(P + r0 * EINP + E_SQ + hq * 64, EINP, P + r0 * EINP + E_SK + kvh * 64, EINP, P + r0 * EINP + E_SV + kvh * 64, EINP,
                                  MIX + r0 * 1024 + 512 + hq * 64, 1024, 4, 0, 0, C, THRS, F.in[I_ESINK][hq] * 1.4426950408889634f, F.ldsg + RING_OFF); }
}
namespace gdn {
using bf16x8 = __attribute__((ext_vector_type(8))) short;
using f32x16 = __attribute__((ext_vector_type(16))) float;
using u32x4  = __attribute__((ext_vector_type(4))) unsigned;
__device__ __forceinline__ int crow(int r, int hi) { return (r & 3) + 8 * (r >> 2) + 4 * hi; }
typedef float f32x2_t __attribute__((ext_vector_type(2))); typedef __bf16 bf16x2_t __attribute__((ext_vector_type(2)));
__device__ __forceinline__ unsigned cvtpk(float lo, float hi) { f32x2_t v = {lo, hi}; bf16x2_t b = __builtin_convertvector(v, bf16x2_t); return __builtin_bit_cast(unsigned, b); }
__device__ __forceinline__ int swap23(int p) { return (p & ~0xC) | ((p & 4) << 1) | ((p & 8) >> 1); }
typedef float f32x4g __attribute__((ext_vector_type(4)));
template <int I> struct LRow {
    static constexpr int NQ = (I + 3) / 4, O = I * 128;
    static __device__ __forceinline__ void load(f32x4g (&b)[8], unsigned la) {
        if constexpr (NQ == 1) asm volatile("ds_read_b128 %0, %1 offset:%2\n\ts_waitcnt lgkmcnt(0)" : "=&v"(b[0]) : "v"(la), "i"(O));
        else if constexpr (NQ == 2) asm volatile("ds_read_b128 %0, %2 offset:%3\n\tds_read_b128 %1, %2 offset:%4\n\ts_waitcnt lgkmcnt(0)" : "=&v"(b[0]), "=&v"(b[1]) : "v"(la), "i"(O), "i"(O + 16));
        else if constexpr (NQ == 3) asm volatile("ds_read_b128 %0, %3 offset:%4\n\tds_read_b128 %1, %3 offset:%5\n\tds_read_b128 %2, %3 offset:%6\n\ts_waitcnt lgkmcnt(0)" : "=&v"(b[0]), "=&v"(b[1]), "=&v"(b[2]) : "v"(la), "i"(O), "i"(O + 16), "i"(O + 32));
        else if constexpr (NQ == 4) asm volatile("ds_read_b128 %0, %4 offset:%5\n\tds_read_b128 %1, %4 offset:%6\n\tds_read_b128 %2, %4 offset:%7\n\tds_read_b128 %3, %4 offset:%8\n\ts_waitcnt lgkmcnt(0)" : "=&v"(b[0]), "=&v"(b[1]), "=&v"(b[2]), "=&v"(b[3]) : "v"(la), "i"(O), "i"(O + 16), "i"(O + 32), "i"(O + 48));
        else if constexpr (NQ == 5) asm volatile("ds_read_b128 %0, %5 offset:%6\n\tds_read_b128 %1, %5 offset:%7\n\tds_read_b128 %2, %5 offset:%8\n\tds_read_b128 %3, %5 offset:%9\n\tds_read_b128 %4, %5 offset:%10\n\ts_waitcnt lgkmcnt(0)" : "=&v"(b[0]), "=&v"(b[1]), "=&v"(b[2]), "=&v"(b[3]), "=&v"(b[4]) : "v"(la), "i"(O), "i"(O + 16), "i"(O + 32), "i"(O + 48), "i"(O + 64));
        else if constexpr (NQ == 6) asm volatile("ds_read_b128 %0, %6 offset:%7\n\tds_read_b128 %1, %6 offset:%8\n\tds_read_b128 %2, %6 offset:%9\n\tds_read_b128 %3, %6 offset:%10\n\tds_read_b128 %4, %6 offset:%11\n\tds_read_b128 %5, %6 offset:%12\n\ts_waitcnt lgkmcnt(0)" : "=&v"(b[0]), "=&v"(b[1]), "=&v"(b[2]), "=&v"(b[3]), "=&v"(b[4]), "=&v"(b[5]) : "v"(la), "i"(O), "i"(O + 16), "i"(O + 32), "i"(O + 48), "i"(O + 64), "i"(O + 80));
        else if constexpr (NQ == 7) asm volatile("ds_read_b128 %0, %7 offset:%8\n\tds_read_b128 %1, %7 offset:%9\n\tds_read_b128 %2, %7 offset:%10\n\tds_read_b128 %3, %7 offset:%11\n\tds_read_b128 %4, %7 offset:%12\n\tds_read_b128 %5, %7 offset:%13\n\tds_read_b128 %6, %7 offset:%14\n\ts_waitcnt lgkmcnt(0)" : "=&v"(b[0]), "=&v"(b[1]), "=&v"(b[2]), "=&v"(b[3]), "=&v"(b[4]), "=&v"(b[5]), "=&v"(b[6]) : "v"(la), "i"(O), "i"(O + 16), "i"(O + 32), "i"(O + 48), "i"(O + 64), "i"(O + 80), "i"(O + 96));
        else asm volatile("ds_read_b128 %0, %8 offset:%9\n\tds_read_b128 %1, %8 offset:%10\n\tds_read_b128 %2, %8 offset:%11\n\tds_read_b128 %3, %8 offset:%12\n\tds_read_b128 %4, %8 offset:%13\n\tds_read_b128 %5, %8 offset:%14\n\tds_read_b128 %6, %8 offset:%15\n\tds_read_b128 %7, %8 offset:%16\n\ts_waitcnt lgkmcnt(0)" : "=&v"(b[0]), "=&v"(b[1]), "=&v"(b[2]), "=&v"(b[3]), "=&v"(b[4]), "=&v"(b[5]), "=&v"(b[6]), "=&v"(b[7]) : "v"(la), "i"(O), "i"(O + 16), "i"(O + 32), "i"(O + 48), "i"(O + 64), "i"(O + 80), "i"(O + 96), "i"(O + 112));
    }
};
template <int I> struct Solve32 {
    static __device__ __forceinline__ void run(float (&x)[32], unsigned la) {
#ifdef SOLVE_C_LOAD
        f32x4g b[8]; { const LAS f32x4g* Lp = (const LAS f32x4g*)(uintptr_t)(la + I * 128);
#pragma unroll
          for (int q = 0; q < (I + 3) / 4; ++q) b[q] = Lp[q]; }
#else
        f32x4g b[8]; LRow<I>::load(b, la);
#endif
        float a = x[I];
#pragma unroll
#ifdef SOLVE_C_FMA
        for (int j = 0; j < I; ++j) a = __builtin_fmaf(-b[j >> 2][j & 3], x[j], a);
#else
        for (int j = 0; j < I; ++j) asm volatile("v_fma_f32 %0, -%1, %2, %0" : "+v"(a) : "v"(b[j >> 2][j & 3]), "v"(x[j]));
#endif
        x[I] = a;
        if constexpr (I < 31) Solve32<I + 1>::run(x, la);
    }
};
__device__ __forceinline__ void solve32(float (&x)[32], unsigned la) { Solve32<1>::run(x, la); }
__device__ __forceinline__ void col_frags32(const float (&x)[32], bf16x8 (&F)[4][2], int s0) {
#pragma unroll
    for (int s = 0; s < 2; ++s) {
        const unsigned p0[4] = {cvtpk(x[16 * s + 0], x[16 * s + 1]), cvtpk(x[16 * s + 2], x[16 * s + 3]), cvtpk(x[16 * s + 8], x[16 * s + 9]), cvtpk(x[16 * s + 10], x[16 * s + 11])};
        const unsigned p1[4] = {cvtpk(x[16 * s + 4], x[16 * s + 5]), cvtpk(x[16 * s + 6], x[16 * s + 7]), cvtpk(x[16 * s + 12], x[16 * s + 13]), cvtpk(x[16 * s + 14], x[16 * s + 15])};
        u32x4 f0, f1;
#pragma unroll
        for (int q = 0; q < 4; ++q) { auto r = __builtin_amdgcn_permlane32_swap(p0[q], p1[q], false, false); f0[q] = r[0]; f1[q] = r[1]; }
        F[s0 + s][0] = __builtin_bit_cast(bf16x8, f0); F[s0 + s][1] = __builtin_bit_cast(bf16x8, f1); }
}
__device__ __forceinline__ void solve_blocked(float (&x1)[32], float (&x2)[32], unsigned la, const bf16x8 (&L21A)[2], bf16x8 (&F)[4][2]) {
    solve32(x1, la);
    col_frags32(x1, F, 0);
    f32x16 t0 = f32x16{}, t1 = f32x16{};
    t0 = __builtin_amdgcn_mfma_f32_32x32x16_bf16(L21A[0], F[0][0], t0, 0, 0, 0); t0 = __builtin_amdgcn_mfma_f32_32x32x16_bf16(L21A[1], F[1][0], t0, 0, 0, 0);
    t1 = __builtin_amdgcn_mfma_f32_32x32x16_bf16(L21A[0], F[0][1], t1, 0, 0, 0); t1 = __builtin_amdgcn_mfma_f32_32x32x16_bf16(L21A[1], F[1][1], t1, 0, 0, 0);
#pragma unroll
    for (int r = 0; r < 16; ++r) { const float e0 = t0[r], e1 = t1[r]; auto sw = __builtin_amdgcn_permlane32_swap(__float_as_uint(e0), __float_as_uint(e1), false, false);
        x2[(r & 3) + 8 * (r >> 2)] -= __uint_as_float(sw[0]); x2[(r & 3) + 8 * (r >> 2) + 4] -= __uint_as_float(sw[1]); }
    __builtin_amdgcn_sched_barrier(0);
    solve32(x2, la + 4096u);
    col_frags32(x2, F, 2);
}
__device__ __forceinline__ bf16x8 acc_frag(const f32x16& t, int sp) {
    u32x4 w;
    if (sp == 0) { w[0] = cvtpk(t[0], t[1]); w[1] = cvtpk(t[2], t[3]); w[2] = cvtpk(t[4], t[5]); w[3] = cvtpk(t[6], t[7]); }
    else { w[0] = cvtpk(t[8], t[9]); w[1] = cvtpk(t[10], t[11]); w[2] = cvtpk(t[12], t[13]); w[3] = cvtpk(t[14], t[15]); }
    return __builtin_bit_cast(bf16x8, w);
}
__device__ __forceinline__ void store_accfrag(__amdgpu_buffer_rsrc_t ro, int soff, int lane, const f32x16& t) {
    __builtin_amdgcn_raw_buffer_store_b128((u32x4){cvtpk(t[0], t[1]), cvtpk(t[2], t[3]), cvtpk(t[4], t[5]), cvtpk(t[6], t[7])}, ro, lane * 32, soff, 0);
    __builtin_amdgcn_raw_buffer_store_b128((u32x4){cvtpk(t[8], t[9]), cvtpk(t[10], t[11]), cvtpk(t[12], t[13]), cvtpk(t[14], t[15])}, ro, lane * 32 + 16, soff, 0);
}
struct ItemGeom { int b, h, dir, rbase, len, n0; };
__device__ __forceinline__ ItemGeom item_geom(int chain, int ci) { ItemGeom g; g.b = chain >> 4; g.h = (chain >> 1) & 7; g.dir = chain & 1; const bool isc = ci < 4;
    g.n0 = (isc ? ci : ci - 4) * 64; g.rbase = g.b * SROW + (isc ? 0 : TC); g.len = isc ? TC : T; return g; }
__device__ __forceinline__ int item_row(const ItemGeom& g, int i) { const int n = g.n0 + i; return g.rbase + (g.dir ? g.len - 1 - n : n); }

#define G1_LANES() int zs_ = 0; asm volatile("" : "+v"(zs_)); const int lane = (int)__builtin_amdgcn_mbcnt_hi(~0u, __builtin_amdgcn_mbcnt_lo(~0u, (unsigned)zs_)), r32 = lane & 31, hi = lane >> 5; (void)r32; (void)hi
__device__ __forceinline__ void pair_lock(volatile LAS unsigned* w) {
    for (;;) { unsigned got = 0u; if (__builtin_amdgcn_mbcnt_hi(~0u, __builtin_amdgcn_mbcnt_lo(~0u, 0u)) == 0u) got = (__hip_atomic_exchange((LAS unsigned*)w, 1u, __ATOMIC_RELAXED, __HIP_MEMORY_SCOPE_WORKGROUP) == 0u) ? 1u : 0u;
        got = (unsigned)__builtin_amdgcn_readfirstlane((int)got); if (got) break; __builtin_amdgcn_s_sleep(2); }
    asm volatile("s_waitcnt lgkmcnt(0)" ::: "memory"); }
__device__ __forceinline__ void pair_unlock(volatile LAS unsigned* w) { asm volatile("s_waitcnt vmcnt(0) lgkmcnt(0)" ::: "memory"); if (__builtin_amdgcn_mbcnt_hi(~0u, __builtin_amdgcn_mbcnt_lo(~0u, 0u)) == 0u) __hip_atomic_store((LAS unsigned*)w, 0u, __ATOMIC_RELAXED, __HIP_MEMORY_SCOPE_WORKGROUP); asm volatile("s_waitcnt lgkmcnt(0)" ::: "memory"); }
#ifndef G1_LOCK
#define G1_LOCK 0
#endif
#define LOCK_IF(m) do { if (G1_LOCK & (m)) pair_lock(lockw); } while (0)
#define UNLOCK_IF(m) do { if (G1_LOCK & (m)) pair_unlock(lockw); } while (0)
constexpr int G1_L = 0, G1_ARR = 8192, G1_TK = 9216, G1_TV = 17408, G1_TQ = 17408  , G1_WAVE_LDS = 26624;
__device__ __forceinline__ void g1_item(Frame& F, int item, LAS unsigned char* wl, volatile LAS unsigned* lockw) {
    int zz = 0; asm volatile("" : "+v"(zz)); __builtin_assume((unsigned)zz < 2u);
    const int chain = item / 68, ci = item - chain * 68; const ItemGeom G = item_geom(chain, ci); const int h = G.h;
    LAS float* Ls = (LAS float*)(wl + G1_L); LAS float* gcA = (LAS float*)(wl + G1_ARR), *btA = gcA + 64, *egA = gcA + 128, *etA = gcA + 192;
    const LAS bf16* TK = (const LAS bf16*)(wl + G1_TK); const LAS bf16* TV = (const LAS bf16*)(wl + G1_TV); const LAS bf16* TQ = (const LAS bf16*)(wl + G1_TQ);
    const bf16* QK = (const bf16*)(F.ws + WS_QKVN); const float* GB = (const float*)(F.ws + WS_GB);
    bf16* out = (bf16*)(F.ws + WS_GDNI) + (size_t)item * 16384;
    LOCK_IF(1);
    u32x4 tq[8];
    { G1_LANES(); u32x4 t[2][8];
#pragma unroll
      for (int j = 0; j < 8; ++j) { const int i = (lane >> 3) + 8 * j; const bf16* rp = QK + (size_t)item_row(G, i) * 1536 + h * 64 + (lane & 7) * 8;
          t[0][j] = *(const GAS u32x4*)(rp + 512); t[1][j] = *(const GAS u32x4*)(rp + 1024); tq[j] = *(const GAS u32x4*)rp; }
#pragma unroll
      for (int j = 0; j < 8; ++j) { const int o = ((lane >> 3) + 8 * j) * 128 + (lane & 7) * 16;
          *(LAS u32x4*)(wl + G1_TK + o) = t[0][j]; *(LAS u32x4*)(wl + G1_TV + o) = t[1][j]; } }
    float gl;
    { G1_LANES(); const int row = item_row(G, lane); float g = GB[(size_t)row * 32 + G.dir * 8 + h]; const float bt = GB[(size_t)row * 32 + 16 + G.dir * 8 + h];
#pragma unroll
      for (int o = 1; o < 64; o <<= 1) { const float t = __builtin_bit_cast(float, __builtin_amdgcn_ds_bpermute((lane - o) << 2, __builtin_bit_cast(int, g))); if (lane >= o) g += t; }
      gl = __builtin_bit_cast(float, __builtin_amdgcn_readlane(__builtin_bit_cast(int, g), 63)); gcA[lane] = g; btA[lane] = bt; egA[lane] = __expf(g); etA[lane] = __expf(gl - g); }
    asm volatile("s_waitcnt lgkmcnt(0)" ::: "memory");
    const LAS float* gcz = gcA + zz; const LAS float* btz = btA + zz; const LAS float* egz = egA + zz; const LAS float* etz = etA + zz;
    UNLOCK_IF(1); LOCK_IF(2);
    bf16x8 L21A[2];
    { G1_LANES(); bf16x8 Kf[2][4];
#pragma unroll
      for (int t = 0; t < 2; ++t)
#pragma unroll
          for (int s = 0; s < 4; ++s) Kf[t][s] = *(const LAS bf16x8*)(TK + (32 * t + r32) * 64 + 16 * s + 8 * hi);
#pragma unroll
      for (int t = 0; t < 2; ++t) { f32x16 acc = f32x16{};
#pragma unroll
          for (int s = 0; s < 4; ++s) acc = __builtin_amdgcn_mfma_f32_32x32x16_bf16(Kf[t][s], Kf[t][s], acc, 0, 0, 0);
          const float gcj = gcz[32 * t + r32];
#pragma unroll
          for (int r = 0; r < 16; ++r) { const int il = crow(r, hi), i = 32 * t + il; const float e = __expf(fminf(gcz[i] - gcj, 0.f)); const float v0 = btz[i] * acc[r] * e; Ls[t * 1024 + il * 32 + r32] = (r32 < il) ? v0 : 0.f; } }
      { f32x16 acc = f32x16{};
#pragma unroll
          for (int s = 0; s < 4; ++s) acc = __builtin_amdgcn_mfma_f32_32x32x16_bf16(Kf[0][s], Kf[1][s], acc, 0, 0, 0);
          const int i = 32 + r32; const float gci = gcz[i], bti = btz[i];
#pragma unroll
          for (int r = 0; r < 16; ++r) { const int j = crow(r, hi); acc[r] = bti * acc[r] * __expf(fminf(gci - gcz[j], 0.f)); }
          L21A[0] = acc_frag(acc, 0); L21A[1] = acc_frag(acc, 1); } }
    asm volatile("s_waitcnt lgkmcnt(0)" ::: "memory"); __builtin_amdgcn_sched_barrier(0);
    UNLOCK_IF(2); LOCK_IF(4);
    bf16x8 UF[4][2];
    const unsigned la = (unsigned)(uintptr_t)Ls + ((unsigned)zz << 4);
    { G1_LANES(); float x1[32], x2[32];
#pragma unroll
      for (int i = 0; i < 64; ++i) { const float v = bf2f(TV[i * 64 + lane]) * btz[i]; if (i < 32) x1[i & 31] = v; else x2[i & 31] = v; }
      asm volatile("s_waitcnt lgkmcnt(0)" ::: "memory");
#pragma unroll
      for (int j = 0; j < 8; ++j) *(LAS u32x4*)(wl + G1_TQ + ((lane >> 3) + 8 * j) * 128 + (lane & 7) * 16) = tq[j];
      solve_blocked(x1, x2, la, L21A, UF); }
    __builtin_amdgcn_sched_barrier(0);
    bf16x8 WF[4][2];
    { G1_LANES(); float x1[32], x2[32];
#pragma unroll
      for (int i = 0; i < 64; ++i) { const float v = bf2f(TK[i * 64 + lane]) * btz[i] * egz[i]; if (i < 32) x1[i & 31] = v; else x2[i & 31] = v; }
      solve_blocked(x1, x2, la, L21A, WF); }
    __builtin_amdgcn_sched_barrier(0);
    UNLOCK_IF(4); LOCK_IF(8);
    bf16x8 KTA[4][2];
    { G1_LANES(); float k1[32], k2[32];
#pragma unroll
      for (int i = 0; i < 32; ++i) { k1[i] = bf2f(TK[i * 64 + lane]) * etz[i]; k2[i] = bf2f(TK[(32 + i) * 64 + lane]) * etz[32 + i]; }
      col_frags32(k1, KTA, 0); col_frags32(k2, KTA, 2); }
    __builtin_amdgcn_sched_barrier(0);
    const __amdgpu_buffer_rsrc_t ro = __builtin_amdgcn_make_buffer_rsrc((void*)out, 0, 32768, 0x00020000);
    {
    G1_LANES();
    const float egl = __expf(gl);
#pragma unroll
    for (int at = 0; at < 2; ++at)
#pragma unroll
        for (int ct = 0; ct < 2; ++ct) { f32x16 a0 = f32x16{}, a1 = f32x16{};
#pragma unroll
            for (int s = 0; s < 4; ++s) { a0 = __builtin_amdgcn_mfma_f32_32x32x16_bf16(KTA[s][at], UF[s][ct], a0, 0, 0, 0); a1 = __builtin_amdgcn_mfma_f32_32x32x16_bf16(KTA[s][at], WF[s][ct], a1, 0, 0, 0); }
            store_accfrag(ro, 16384 + (at * 2 + ct) * 2048, lane, a0);
            const int vo = 4 * hi * 128 + (32 * ct + swap23(r32)) * 2;
#pragma unroll
            for (int r = 0; r < 16; ++r) { const float v = ((at == ct && crow(r, hi) == r32) ? egl : 0.f) - a1[r];
                __builtin_amdgcn_raw_buffer_store_b16((short)f2bf(v), ro, vo + (r & 3) * 128 + (r >> 2) * 1024, 32 * at * 128, 0); }
            __builtin_amdgcn_sched_barrier(0); }
    }
    UNLOCK_IF(8); LOCK_IF(16);
    bf16x8 XA[3][2];
    { G1_LANES(); bf16x8 Kf[4], Qf[2][4]; const LAS bf16* TK2 = TK + zz;
#pragma unroll
      for (int t = 0; t < 2; ++t)
#pragma unroll
          for (int s = 0; s < 4; ++s) Qf[t][s] = *(const LAS bf16x8*)(TQ + (32 * t + r32) * 64 + 16 * s + 8 * hi);
#pragma unroll
      for (int tl = 0; tl < 3; ++tl) { const int jt = tl == 2 ? 1 : 0, it = tl == 0 ? 0 : 1;
          if (tl != 1) {
#pragma unroll
              for (int s = 0; s < 4; ++s) Kf[s] = *(const LAS bf16x8*)(TK2 + (32 * jt + r32) * 64 + 16 * s + 8 * hi); }
          f32x16 acc = f32x16{};
#pragma unroll
          for (int s = 0; s < 4; ++s) acc = __builtin_amdgcn_mfma_f32_32x32x16_bf16(Kf[s], Qf[it][s], acc, 0, 0, 0);
          const int i = 32 * it + r32; const float gci = gcz[i];
#pragma unroll
          for (int r = 0; r < 16; ++r) { const int j = 32 * jt + crow(r, hi); const float e = __expf(fminf(gci - gcz[j], 0.f)); const float v0 = acc[r] * e; acc[r] = (j <= i) ? v0 : 0.f; }
          XA[tl][0] = acc_frag(acc, 0); XA[tl][1] = acc_frag(acc, 1); __builtin_amdgcn_sched_barrier(0); } }
    __builtin_amdgcn_sched_barrier(0);
    {
    G1_LANES();
#pragma unroll
    for (int it = 0; it < 2; ++it)
#pragma unroll
        for (int ct = 0; ct < 2; ++ct) { f32x16 a0 = f32x16{}, a1 = f32x16{};
#pragma unroll
            for (int jt = 0; jt <= it; ++jt) { const int tl = (it == 0) ? 0 : (jt == 0 ? 1 : 2);
#pragma unroll
                for (int sp = 0; sp < 2; ++sp) { a0 = __builtin_amdgcn_mfma_f32_32x32x16_bf16(XA[tl][sp], UF[2 * jt + sp][ct], a0, 0, 0, 0); a1 = __builtin_amdgcn_mfma_f32_32x32x16_bf16(XA[tl][sp], WF[2 * jt + sp][ct], a1, 0, 0, 0); } }
            store_accfrag(ro, 24576 + (it * 2 + ct) * 2048, lane, a0);
            const int vo = 4 * hi * 128 + (32 * ct + swap23(r32)) * 2; const int a = 32 * ct + r32;
#pragma unroll
            for (int r = 0; r < 16; ++r) { const int i = 32 * it + crow(r, hi); const float qv = bf2f(TQ[i * 64 + a]);
                __builtin_amdgcn_raw_buffer_store_b16((short)f2bf(qv * egz[i] - a1[r]), ro, vo + (r & 3) * 128 + (r >> 2) * 1024, 8192 + 32 * it * 128, 0); }
            __builtin_amdgcn_sched_barrier(0); }
    }
    asm volatile("s_waitcnt lgkmcnt(0)" ::: "memory");
    UNLOCK_IF(16);
}
__device__ __forceinline__ void scan_chain(Frame& F, int chain, int dc) {
    const int w = F.wave, lane = F.lane, r32 = lane & 31, hi = lane >> 5, role = (w >> 1) & 1, rt = w & 1;
    LAS u32x4* SF = (LAS u32x4*)(F.lds + RING_OFF);
    const bf16* base = (const bf16*)(F.ws + WS_GDNI) + (size_t)chain * 68 * 16384; bf16* OG = (bf16*)(F.ws + WS_OG);
    for (int i = F.tid; i < 2 * 4 * 64; i += 512) SF[i] = (u32x4){0u, 0u, 0u, 0u};
    const bf16* Ab = base + (role ? 4096 : 0) + (32 * rt + r32) * 64 + 8 * hi; const bf16* Cb = base + (role ? 12288 : 8192) + ((rt * 2 + dc) * 64 + lane) * 16;
    struct Ops { bf16x8 a[4]; u32x4 c[2]; };
#define SC_LOAD(o, ci_) do { const bf16* A_ = Ab + (size_t)(ci_) * 16384; const bf16* C_ = Cb + (size_t)(ci_) * 16384; \
        _Pragma("unroll") for (int s_ = 0; s_ < 4; ++s_) (o).a[s_] = *(const GAS bf16x8*)(A_ + 16 * s_); (o).c[0] = *(const GAS u32x4*)C_; (o).c[1] = *(const GAS u32x4*)(C_ + 8); } while (0)
#define SC_STEP(o, ci_) do { f32x16 acc; \
        _Pragma("unroll") for (int q = 0; q < 4; ++q) { acc[2 * q] = bflo((o).c[0][q]); acc[2 * q + 1] = bfhi((o).c[0][q]); acc[8 + 2 * q] = bflo((o).c[1][q]); acc[8 + 2 * q + 1] = bfhi((o).c[1][q]); } \
        const LAS u32x4* Sb = SF + (((ci_) & 1) * 256) + lane; \
        _Pragma("unroll") for (int s_ = 0; s_ < 4; ++s_) { const u32x4 bw = Sb[s_ * 64]; acc = __builtin_amdgcn_mfma_f32_32x32x16_bf16((o).a[s_], __builtin_bit_cast(bf16x8, bw), acc, 0, 0, 0); } \
        SC_LOAD(o, ((ci_) + SCAN_PF < 68) ? (ci_) + SCAN_PF : 67);     \
        if (role == 0) { LAS u32x4* Sn = SF + ((((((ci_) + 1) & 1)) * 4 + 2 * rt) * 64) + lane; Sn[0] = __builtin_bit_cast(u32x4, acc_frag(acc, 0)); Sn[64] = __builtin_bit_cast(u32x4, acc_frag(acc, 1)); } \
        else { const ItemGeom G = item_geom(chain, (ci_)); LAS bf16* stg = (LAS bf16*)(F.lds + RING_OFF + 16384 + rt * 2048);     \
            _Pragma("unroll") for (int r = 0; r < 16; ++r) stg[crow(r, hi) * 32 + r32] = (bf16)f2bf(acc[r]); \
            asm volatile("s_waitcnt lgkmcnt(0)" ::: "memory"); \
            const u32x4 v0 = *(const LAS u32x4*)(stg + (lane >> 1) * 32 + (lane & 1) * 16), v1 = *(const LAS u32x4*)(stg + (lane >> 1) * 32 + (lane & 1) * 16 + 8); \
            GAS u32x4* po = (GAS u32x4*)(OG + (size_t)item_row(G, 32 * rt + (lane >> 1)) * 1024 + G.dir * 512 + G.h * 64 + 32 * dc + (lane & 1) * 16); po[0] = v0; po[1] = v1; } \
        asm volatile("s_waitcnt lgkmcnt(0)" ::: "memory"); __builtin_amdgcn_s_barrier(); asm volatile("" ::: "memory"); } while (0)
    if (w < 4) {
        Ops o[SCAN_PF];
#pragma unroll
        for (int k = 0; k < SCAN_PF; ++k) SC_LOAD(o[k], k);
        __syncthreads();
#pragma unroll
        for (int ci = 0; ci < 68; ++ci) SC_STEP(o[ci % SCAN_PF], ci);
        asm volatile("s_waitcnt vmcnt(0)" ::: "memory");
    } else {
        __syncthreads();
#pragma unroll 1
        for (int ci = 0; ci < 68; ++ci) { __builtin_amdgcn_s_barrier(); asm volatile("" ::: "memory"); }
    }
#undef SC_LOAD
#undef SC_STEP
}
}
__device__ __forceinline__ void l1_prep(Frame& F) {
    bf16* P = (bf16*)(F.ws + WS_PROJ2); bf16* KM = (bf16*)(F.ws + WS_KMLA); const int lane = F.lane;
    for (int r = F.gw; r < NR; r += F.NGW) { const int b = r / SROW, s = r - b * SROW; const bool isc = s < TC; const int p = s - TC; bf16* row = P + (size_t)r * OINP;
        { bf16* CQ = (bf16*)(F.ws + WS_CQN) + (size_t)r * 640;
          const v2u a = *(const GAS v2u*)(row + O_CQ + 4 * lane); const v2u c = (lane < 32) ? *(const GAS v2u*)(row + O_CQ + 256 + 4 * lane) : (v2u){0u, 0u}; const v2u k = *(const GAS v2u*)(row + O_CKV + 4 * lane);
          const float a0 = bflo(a.x), a1 = bfhi(a.x), a2 = bflo(a.y), a3 = bfhi(a.y), c0 = bflo(c.x), c1 = bfhi(c.x), c2 = bflo(c.y), c3 = bfhi(c.y), k0 = bflo(k.x), k1 = bfhi(k.x), k2 = bflo(k.y), k3 = bfhi(k.y);
          const float sq = wave_sum(a0 * a0 + a1 * a1 + a2 * a2 + a3 * a3 + c0 * c0 + c1 * c1 + c2 * c2 + c3 * c3), skv = wave_sum(k0 * k0 + k1 * k1 + k2 * k2 + k3 * k3);
          const float rq = 1.f / sqrtf(sq * (1.f / 384.f) + EPS), rk = 1.f / sqrtf(skv * (1.f / 256.f) + EPS);
          *(GAS v2u*)(CQ + 4 * lane) = (v2u){pk2(a0 * rq, a1 * rq), pk2(a2 * rq, a3 * rq)};
          if (lane < 32) *(GAS v2u*)(CQ + 256 + 4 * lane) = (v2u){pk2(c0 * rq, c1 * rq), pk2(c2 * rq, c3 * rq)};
          *(GAS v2u*)(CQ + 384 + 4 * lane) = (v2u){pk2(k0 * rk, k1 * rk), pk2(k2 * rk, k3 * rk)}; }
        if (lane < 16) { const int seg = lane >> 3, i = lane & 7, d0 = seg * 16 + i; float x0 = bf2f(row[O_KR + d0]), x1 = bf2f(row[O_KR + d0 + 8]);
            if (!isc) { const float pos = (float)(seg ? (p & 63) : (p >> 6)); const float ang = pos * __powf(10000.f, -(float)i * (1.f / 8.f)); float sn, cs; sincosf(ang, &sn, &cs);
                const float y0 = x0 * cs - x1 * sn, y1 = x1 * cs + x0 * sn; x0 = y0; x1 = y1; }
            const bf16 b0 = (bf16)f2bf(x0), b1 = (bf16)f2bf(x1);
#pragma unroll
            for (int h = 0; h < 8; ++h) { KM[(size_t)r * 768 + h * 96 + 64 + d0] = b0; KM[(size_t)r * 768 + h * 96 + 64 + d0 + 8] = b1; } }
        if (!isc) {
            const int pi = lane & 31, seg = pi >> 4, i = pi & 15, d0 = seg * 32 + i; const float pos = (float)(seg ? (p & 63) : (p >> 6));
            const float ang = pos * __powf(10000.f, -(float)i * (1.f / 16.f)); float sn, cs; sincosf(ang, &sn, &cs);
#pragma unroll
            for (int q = 0; q < 8; ++q) { const int hh = (lane >> 5) + 2 * q; bf16* base = row + (hh < 8 ? O_DQ + hh * 64 : O_DK + (hh - 8) * 64) + d0;
                const float x0 = bf2f(base[0]), x1 = bf2f(base[16]); base[0] = (bf16)f2bf(x0 * cs - x1 * sn); base[16] = (bf16)f2bf(x1 * cs + x0 * sn); } }
    }
}
__device__ __forceinline__ void l1_qrope(Frame& F) {
    bf16* QM = (bf16*)(F.ws + WS_QM); const int lane = F.lane;
    for (int r = F.gw; r < NR; r += F.NGW) { const int b = r / SROW, s = r - b * SROW; if (s < TC) continue; const int p = s - TC;
        const int pi = lane & 15, seg = pi >> 3, i = pi & 7, d0 = seg * 16 + i; const float pos = (float)(seg ? (p & 63) : (p >> 6));
        const float ang = pos * __powf(10000.f, -(float)i * (1.f / 8.f)); float sn, cs; sincosf(ang, &sn, &cs);
#pragma unroll
        for (int q = 0; q < 2; ++q) { const int h = (lane >> 4) + 4 * q; bf16* base = QM + (size_t)r * 768 + h * 96 + 64 + d0;
            const float x0 = bf2f(base[0]), x1 = bf2f(base[8]); base[0] = (bf16)f2bf(x0 * cs - x1 * sn); base[8] = (bf16)f2bf(x1 * cs + x0 * sn); } }
}
__device__ __forceinline__ void l1_attn_unit(Frame& F, int u) {
    if (u < 512) { const int b = u >> 7, qb = (u >> 3) & 15, h = u & 7; const size_t rq = (size_t)b * SROW + TC + qb * 256, r0 = (size_t)b * SROW;
        constexpr float SC = 0.10206207261596575f  , C = SC * 1.4426950408889634f, THRS = att::THR / SC;
        const bf16* QM = (const bf16*)(F.ws + WS_QM); const bf16* KM = (const bf16*)(F.ws + WS_KMLA); const bf16* VM = (const bf16*)(F.ws + WS_VMLA); bf16* MIX = (bf16*)(F.ws + WS_MIX);
        att::attn_unit<96, 64, 0, true>(QM + rq * 768 + h * 96, 768, KM + r0 * 768 + h * 96, 768, VM + r0 * 512 + h * 64, 512, MIX + rq * 1024 + h * 64, 1024, SROW / 64, 0, qb * 256, C, THRS, -3.0e38f, F.ldsg + RING_OFF);
    } else { const int v = u - 512, b = v >> 6, qb = (v >> 2) & 15, head = v & 3; const size_t rq = (size_t)b * SROW + TC + qb * 256, r0 = (size_t)b * SROW;
        constexpr float SC = 0.125f, C = SC * 1.4426950408889634f, THRS = att::THR / SC; constexpr float LAM_INIT = 0.35550906759096556f;
        const float* lp = F.in[I_OLAM]; const float lam = __expf(wave_sum(lp[F.lane] * lp[64 + F.lane])) - __expf(wave_sum(lp[128 + F.lane] * lp[192 + F.lane])) + LAM_INIT;
        const bf16* P = (const bf16*)(F.ws + WS_PROJ2); bf16* MIX = (bf16*)(F.ws + WS_MIX); const int hh = 2 * head;
        att::attn_unit<64, 128, 0, false, 1>(P + rq * OINP + O_DQ + hh * 64, OINP, P + r0 * OINP + O_DK + hh * 64, OINP, P + r0 * OINP + O_DV + head * 128, OINP, MIX, 1024, SROW / 64, 0, 0, C, THRS, -3.0e38f, F.ldsg + RING_OFF);
        att::attn_unit<64, 128, 0, false, 2>(P + rq * OINP + O_DQ + (hh + 1) * 64, OINP, P + r0 * OINP + O_DK + (hh + 1) * 64, OINP, P + r0 * OINP + O_DV + head * 128, OINP, MIX + rq * 1024 + 512 + head * 128, 1024, SROW / 64, 0, 0, C, THRS, -3.0e38f, F.ldsg + RING_OFF,
                                             lam, F.in[I_OSUBLN], 1.f - LAM_INIT); }
}
__device__ __forceinline__ void l1_diff_post(Frame& F) {
    const bf16* OD = (const bf16*)(F.ws + WS_ODIFF); bf16* MIX = (bf16*)(F.ws + WS_MIX); const int lane = F.lane; const float* lp = F.in[I_OLAM];
    constexpr float LAM_INIT = 0.35550906759096556f;
    const float s01 = wave_sum(lp[lane] * lp[64 + lane]), s23 = wave_sum(lp[128 + lane] * lp[192 + lane]); const float lam = __expf(s01) - __expf(s23) + LAM_INIT;
    const int head = lane >> 4, d = (lane & 15) * 8; const f32x4 w0 = *(const GAS f32x4*)(F.in[I_OSUBLN] + d), w1 = *(const GAS f32x4*)(F.in[I_OSUBLN] + d + 4);
    const float ww[8] = {w0.x, w0.y, w0.z, w0.w, w1.x, w1.y, w1.z, w1.w};
    for (int r = F.gw; r < NR; r += F.NGW) { const int b = r / SROW, s = r - b * SROW; if (s < TC) continue;
        const v4u a = *(const GAS v4u*)(OD + (size_t)r * 1024 + (2 * head) * 128 + d), c = *(const GAS v4u*)(OD + (size_t)r * 1024 + (2 * head + 1) * 128 + d);
        float o[8] = {bflo(a.x) - lam * bflo(c.x), bfhi(a.x) - lam * bfhi(c.x), bflo(a.y) - lam * bflo(c.y), bfhi(a.y) - lam * bfhi(c.y), bflo(a.z) - lam * bflo(c.z), bfhi(a.z) - lam * bfhi(c.z), bflo(a.w) - lam * bflo(c.w), bfhi(a.w) - lam * bfhi(c.w)};
        float ss = 0.f;
#pragma unroll
        for (int e = 0; e < 8; ++e) ss += o[e] * o[e];
        ss += __shfl_xor(ss, 1); ss += __shfl_xor(ss, 2); ss += __shfl_xor(ss, 4); ss += __shfl_xor(ss, 8);
        const float rs = (1.f - LAM_INIT) / sqrtf(ss * (1.f / 128.f) + EPS);
#pragma unroll
        for (int e = 0; e < 8; ++e) o[e] = o[e] * rs * ww[e];
        *(GAS v4u*)(MIX + (size_t)r * 1024 + 512 + head * 128 + d) = (v4u){pk2(o[0], o[1]), pk2(o[2], o[3]), pk2(o[4], o[5]), pk2(o[6], o[7])}; }
}
__device__ __forceinline__ void moe_bases(Frame& F, int (&base)[8], int& ntiles) { int acc = 0;
#pragma unroll
    for (int e = 0; e < 8; ++e) { base[e] = acc; const int c = (int)__hip_atomic_load((unsigned*)(F.ctl + CW_MOECNT + 64 * e), RLX_AGENT); acc += (c + 255) & ~255; }
    ntiles = acc >> 8; }
constexpr size_t META_TEXP = 640 * 1024, META_POS = 768 * 1024;
__device__ __forceinline__ int row_vcu(const Frame& F, int r) { return (r % F.NGW) >> 3; }
__device__ __forceinline__ void moe_gather(Frame& F) {
    int base[8], ntiles; moe_bases(F, base, ntiles);
    int* TEXP = (int*)(F.ws + WS_META + META_TEXP); int* POS = (int*)(F.ws + WS_META + META_POS);
    const int* TOPI = (const int*)(F.ws + WS_META + META_TOPI); const int* RANK = (const int*)(F.ws + WS_META + META_RANK);
    if (blockIdx.x == 0 && F.tid < 144) { const int t = F.tid; int e = 0;
#pragma unroll
        for (int q = 1; q < 8; ++q) if (t * 256 >= base[q]) e = q;
        TEXP[t] = e; if (t == 143) TEXP[144] = ntiles; }
    const bf16* FIN = (const bf16*)(F.ws + WS_FIN2); bf16* AS = (bf16*)(F.ws + WS_ASORT);
    for (int tk = F.gw; tk < NB * T; tk += F.NGW) { const int b = tk / T, t = tk - b * T; const size_t r = (size_t)b * SROW + TC + t;
        const GAS v4u* src = (const GAS v4u*)(FIN + r * D) + F.lane; const v4u x0 = src[0], x1 = src[64];
#pragma unroll
        for (int sl = 0; sl < 2; ++sl) { const int e = TOPI[tk * 2 + sl]; int bs = 0;
#pragma unroll
            for (int q = 0; q < 8; ++q) if (q == e) bs = base[q];
            const int pos = bs + ((const int*)(F.ws + WS_META + META_BLKB))[tok_vcu(F, b, t) * 8 + e] + RANK[tk * 2 + sl]; if (F.lane == 0) POS[tk * 2 + sl] = pos;
            GAS v4u* dst = (GAS v4u*)(AS + (size_t)pos * D) + F.lane; dst[0] = x0; dst[64] = x1; } }
}
__device__ __forceinline__ Row4 moe_out_row(Frame& F, const bf16* OR, int pos_) {
    const int pos = __builtin_amdgcn_readfirstlane(pos_), tile = pos >> 8, part = tile >= 68 ? 1 : 0, local = tile - 68 * part;
    if (local < 64) return ld_row_bf16(OR + (size_t)pos * D, F.lane);
    const float* P = (const float*)(F.ws + (part ? WS_WXGU : WS_FIN2)) + ((size_t)(local - 64) * 256 + (pos & 255)) * 1024; Row4 y = ld_row_f32(P, F.lane);
    for (int s = 1; s < DFX / MOE_KSL; ++s) { const Row4 p = ld_row_f32(P + (size_t)s * 4 * 256 * 1024, F.lane);
#pragma unroll
        for (int j = 0; j < 4; ++j) y.v[j] += p.v[j]; }
    return y; }
__device__ __forceinline__ void rows_final(Frame& F) {
    const bf16* OR = (const bf16*)(F.ws + WS_ASORT); const int* POS = (const int*)(F.ws + WS_META + META_POS); const float* TOPW = (const float*)(F.ws + WS_META + META_TOPW);
    const int wpb = F.NGW >> 2, b = F.gw / wpb, wl = F.gw - b * wpb; const Row4 W = ld_row_f32(F.in[I_ONORMS] + 3 * 1024, F.lane), Gt = ld_row_f32(modvec(F, 1, b, 5), F.lane);
    for (int t = wl; t < T; t += wpb) { const int tk = b * T + t; float* xr = F.out + (size_t)tk * D;
        Row4 x = ld_row_bf16((const bf16*)(F.ws + WS_XB) + (size_t)tk * D, F.lane); const Row4 y0 = moe_out_row(F, OR, POS[tk * 2]), y1 = moe_out_row(F, OR, POS[tk * 2 + 1]);
        const float w0 = TOPW[tk * 2], w1 = TOPW[tk * 2 + 1]; Row4 y;
#pragma unroll
        for (int j = 0; j < 4; ++j) y.v[j] = y0.v[j] * w0 + y1.v[j] * w1;
        add_gated_norm_r(x, y, W, Gt); st_row_f32(xr, F.lane, x); }
}
constexpr int N_PHASES = 26;
__global__ void __launch_bounds__(NWAVES * 64, 2) trunk_fwd(Args args) {
    extern __shared__ __attribute__((aligned(16))) unsigned char lds[];
    Frame F;
    F.lds = (LAS unsigned char*)lds; F.ldsg = (char*)lds;
    F.MISC = (volatile LAS unsigned*)(F.lds + MISC_OFF);
    F.wave = __builtin_amdgcn_readfirstlane((int)threadIdx.x >> 6);
#define REFRESH() do { int z_ = 0; asm volatile("" : "+v"(z_)); F.lane = (int)__builtin_amdgcn_mbcnt_hi(~0u, __builtin_amdgcn_mbcnt_lo(~0u, (unsigned)z_)); F.tid = F.wave * 64 + F.lane; } while (0)
    REFRESH();
    F.G = gridDim.x; { const int bx = blockIdx.x; F.vcu = (F.G % 8 == 0) ? (bx % 8) * (F.G / 8) + bx / 8 : bx; }
    F.gw = F.vcu * NWAVES + F.wave; F.NGW = F.G * NWAVES;
    F.in = args.in; F.out = args.out; F.ws = args.ws; F.ctl = (gu32*)(args.ws + WS_CTL);
    unsigned char* ws = args.ws;
    for (int u = F.tid; u < (LDS_BYTES - MISC_OFF) / 4; u += NWAVES * 64) ((LAS unsigned*)(F.lds + MISC_OFF))[u] = 0u;
    __syncthreads();
    XcdBarrier bar; bar.bar = (unsigned*)(F.ctl + CW_BAR); bar.x = 0; bar.st = nullptr;
    const int lo = args.ph_lo, hi = args.ph_hi;
    const bool use_bar = (hi - lo) > 1;
    if (use_bar) bar = xcd_barrier_post((unsigned*)(F.ctl + CW_BAR), F.MISC + 8);
#ifndef MK_ONLY
#define MK_ONLY_OK(k) true
#else
#define MK_ONLY_OK(k) ((k) == MK_ONLY)
#endif
#define IN(k) (MK_ONLY_OK(k) && lo <= (k) && (k) < hi && (k) <= MK_LAST_PHASE)
#ifndef PROBE_MULT
#define PROBE_MULT 4
#endif
#ifndef PROBE_SPAN
#define PROBE_SPAN 1
#endif
#ifndef SCAN_REP
#define SCAN_REP 1
#endif
#ifndef SWA_REP
#define SWA_REP 1
#endif
#ifndef CHK_MASK
#define CHK_MASK 0xffu
#endif
#ifndef MK_REP_MASK
#define MK_REP_MASK 0u
#endif
#define REPS(k) ((((unsigned)MK_REP_MASK >> (k)) & 1u) ? 2 : 1)
#ifdef PROBE_PHASE
#define STAMP(k) do { if (blockIdx.x == 0 && F.tid == 0) { const unsigned long long t_ = __builtin_amdgcn_s_memrealtime(); F.MISC[64 + 2 * (k)] = (unsigned)t_; F.MISC[65 + 2 * (k)] = (unsigned)(t_ >> 32); } } while (0)
#else
#define STAMP(k) do { } while (0)
#endif
#define SEAM(k) do { if (IN(k) && IN((k) + 1)) xcd_barrier(bar); STAMP((k) + 1); } while (0)
    typedef pg8::bf16_t pb;
    const int bid = blockIdx.x;

    STAMP(0);
    if (IN(0)) for (int rep_ = 0; rep_ < REPS(0); ++rep_) { REFRESH(); p0_prologue(F); } SEAM(0);
    if (IN(1)) for (int rep_ = 0; rep_ < REPS(1); ++rep_) { REFRESH(); p1_first_rows(F); } SEAM(1);
    if (IN(2)) for (int rep_ = 0; rep_ < REPS(2); ++rep_) { REFRESH();
        pg8::Gemm g{(const pb*)(ws + WS_ABUF), (const pb*)(ws + WS_WEIN), NR, EINP, 1024, 1024, 1024}; pg8::StaticOrder S; S.init(NR, EINP, F.G, bid);
        pg8::EpiStore E{(pb*)(ws + WS_PROJ), EINP, EINP / 256};
        pg8::gemm_phase<pg8::EpiStore, pg8::StaticOrder, PG8_ALIGN, PG8_SP2>(F.lds + RING_OFF, g, S, E); } SEAM(2);
    if (IN(3)) for (int rep_ = 0; rep_ < REPS(3); ++rep_) { REFRESH(); g0_prep(F); } SEAM(3);
#ifdef GDN_SLOW
    if (IN(5)) for (int rep_ = 0; rep_ < REPS(5); ++rep_) { REFRESH();
        if (F.G > 64) { if (bid < 64) gdn_chain(F, bid); else for (int u = bid - 64; u < 544; u += F.G - 64) swa_unit(F, u); }
        else { for (int c = bid; c < 64; c += F.G) gdn_chain(F, c); for (int u = bid; u < 544; u += F.G) swa_unit(F, u); } } SEAM(5);
#else
    if (IN(4)) for (int rep_ = 0; rep_ < REPS(4); ++rep_) { REFRESH();
#if G1_LOCK
        if ((F.wave & 3) == 0) for (int item = F.vcu * 2 + (F.wave >> 2); item < 64 * 68; item += F.G * 2) gdn::g1_item(F, item, F.lds + RING_OFF + (F.wave >> 2) * gdn::G1_WAVE_LDS, F.MISC + 16);
#else
        const int n_main = ((64 * 68) / (F.G * 4)) * (F.G * 4), n_late = (64 * 68 - n_main + 3) / 4;
        if (F.wave < 4) { const int R = n_main / (F.G * 4);
            _Pragma("unroll 1") for (int r = 0; r <= R; ++r) { int item;
                if (r < R) item = F.vcu * 4 + F.wave + r * F.G * 4; else { if (F.vcu >= n_late) break; item = n_main + F.vcu * 4 + F.wave; if (item >= 64 * 68) break; }
                gdn::g1_item(F, item, F.lds + RING_OFF + F.wave * gdn::G1_WAVE_LDS, F.MISC + 16); } }
        else p0_deferred(F, F.wave - 4, F.lds + RING_OFF + 4 * gdn::G1_WAVE_LDS + (F.wave - 4) * 8448);
        if (F.vcu >= n_late) { __syncthreads(); REFRESH();
            if (F.tid == 0) F.MISC[20] = __hip_atomic_fetch_add((unsigned*)(F.ctl + CW_SWAQ), 1u, RLX_AGENT);
            __syncthreads(); const int u = (int)F.MISC[20]; __syncthreads();
            if (u < 544) swa_unit(F, u); }
#endif
    } SEAM(4);
    if (IN(5)) for (int rep_ = 0; rep_ < REPS(5); ++rep_) { REFRESH();
        STAMP(30); if (bid < 128) for (int c = bid; c < 128; c += F.G) { gdn::scan_chain(F, c >> 1, c & 1); __syncthreads(); } STAMP(31);
        REFRESH();
        for (;;) { if (F.tid == 0) F.MISC[20] = __hip_atomic_fetch_add((unsigned*)(F.ctl + CW_SWAQ), 1u, RLX_AGENT);
            __syncthreads(); const int u = (int)F.MISC[20]; __syncthreads();
            if (u >= 544 * REPS(5) * SWA_REP) break;
            swa_unit(F, u % 544); } } SEAM(5);
#endif
    if (IN(6)) for (int rep_ = 0; rep_ < REPS(6); ++rep_) { REFRESH(); g4_gdn_out(F); } SEAM(6);
    if (IN(7)) for (int rep_ = 0; rep_ < REPS(7); ++rep_) { REFRESH();
        { pg8::Gemm g{(const pb*)(ws + WS_MIX), (const pb*)(ws + WS_WEOUT), NR, 1024, 1024, 1024, 1024}; pg8::LatOrder S; S.init(1024, F.G, bid);
          pg8::EpiStore E{(pb*)(ws + WS_YBUF), 1024, 4};
          pg8::gemm_phase<pg8::EpiStore, pg8::LatOrder, PG8_ALIGN, PG8_SP2>(F.lds + RING_OFF, g, S, E); }
        __syncthreads();
        { pg8::Gemm g{(const pb*)(ws + WS_MIX), (const pb*)(ws + WS_WEOUT), NR, 1024, 256, 1024, 1024}; pg8::CtxSplitOrder S; S.init(4, 256, F.G, bid);
          pg8::EpiPartF32 E{(float*)(ws + WS_PART), 256};
          pg8::gemm_phase<pg8::EpiPartF32, pg8::CtxSplitOrder, PG8_ALIGN, PG8_SP2>(F.lds + RING_OFF, g, S, E); } } SEAM(7);
    if (IN(8)) for (int rep_ = 0; rep_ < REPS(8); ++rep_) { REFRESH(); rows_mid<false>(F, (const bf16*)(ws + WS_YBUF), F.in[I_ENORMS] + 1024, 0, 2, F.in[I_ENORMS] + 2048, 0, 3, (bf16*)(ws + WS_ABUF), false, 4); } SEAM(8);
    if (IN(9)) for (int rep_ = 0; rep_ < REPS(9); ++rep_) { REFRESH();
        pg8::Gemm g{(const pb*)(ws + WS_ABUF), (const pb*)(ws + WS_WEGU), NR, 2 * DFF, 1024, 1024, 1024}; pg8::StaticOrder S; S.init(NR, 2 * DFF, F.G, bid);
        pg8::EpiSwiGLU E{(pb*)(ws + WS_HID), DFF, DFF / 128};
        pg8::gemm_phase<pg8::EpiSwiGLU, pg8::StaticOrder, PG8_ALIGN, PG8_SP2>(F.lds + RING_OFF, g, S, E); } SEAM(9);
    if (IN(10)) for (int rep_ = 0; rep_ < REPS(10); ++rep_) { REFRESH();
        { pg8::Gemm g{(const pb*)(ws + WS_HID), (const pb*)(ws + WS_WEDN), NR, 1024, DFF, DFF, DFF}; pg8::LatOrder S; S.init(1024, F.G, bid);
          pg8::EpiStore E{(pb*)(ws + WS_YBUF), 1024, 4};
          pg8::gemm_phase<pg8::EpiStore, pg8::LatOrder, PG8_ALIGN, PG8_SP2>(F.lds + RING_OFF, g, S, E); }
        __syncthreads();
        { pg8::Gemm g{(const pb*)(ws + WS_HID), (const pb*)(ws + WS_WEDN), NR, 1024, 256, DFF, DFF}; pg8::CtxSplitOrder S; S.init(11, 256, F.G, bid);
          pg8::EpiPartF32 E{(float*)(ws + WS_PART), 256};
          pg8::gemm_phase<pg8::EpiPartF32, pg8::CtxSplitOrder, PG8_ALIGN, PG8_SP2>(F.lds + RING_OFF, g, S, E); } } SEAM(10);
    if (IN(11)) for (int rep_ = 0; rep_ < REPS(11); ++rep_) { REFRESH(); rows_mid<false>(F, (const bf16*)(ws + WS_YBUF), F.in[I_ENORMS] + 3072, 0, 5, F.in[I_ONORMS], 1, 0, (bf16*)(ws + WS_ABUF), false, 11); } SEAM(11);
    if (IN(12)) for (int rep_ = 0; rep_ < REPS(12); ++rep_) { REFRESH();
        pg8::Gemm g{(const pb*)(ws + WS_ABUF), (const pb*)(ws + WS_WOIN), NR, OINP, 1024, 1024, 1024}; pg8::StaticOrder S; S.init(NR, OINP, F.G, bid);
        pg8::EpiStore E{(pb*)(ws + WS_PROJ2), OINP, OINP / 256};
        pg8::gemm_phase<pg8::EpiStore, pg8::StaticOrder, PG8_ALIGN, PG8_SP2>(F.lds + RING_OFF, g, S, E); } SEAM(12);
    if (IN(13)) for (int rep_ = 0; rep_ < REPS(13); ++rep_) { REFRESH(); l1_prep(F); } SEAM(13);
    if (IN(14)) for (int rep_ = 0; rep_ < REPS(14); ++rep_) { REFRESH();
#if !defined(T13) || T13 == 1
        { pg8::Gemm g{(const pb*)(ws + WS_CQN), (const pb*)(ws + WS_WUQ), NR, 768, 384, 640, 384}; pg8::LatOrder S; S.init(768, F.G, bid);
          pg8::EpiStore E{(pb*)(ws + WS_QM), 768, 3};
          pg8::gemm_phase<pg8::EpiStore, pg8::LatOrder, PG8_ALIGN, PG8_SP2>(F.lds + RING_OFF, g, S, E); }
#endif
        __syncthreads();
#if !defined(T13) || T13 == 2
        { pg8::Gemm g{(const pb*)(ws + WS_CQN) + 384, (const pb*)(ws + WS_WUKV), NR, 1024, 256, 640, 256}; pg8::StaticOrder S; S.init(NR, 1024, F.G, bid);
          pg8::EpiKV E{(pb*)(ws + WS_KMLA), (pb*)(ws + WS_VMLA)};
          pg8::gemm_phase<pg8::EpiKV, pg8::StaticOrder, PG8_ALIGN, PG8_SP2>(F.lds + RING_OFF, g, S, E); }
#endif
    } SEAM(14);
    STAMP(16);
    if (IN(16)) for (int rep_ = 0; rep_ < REPS(16); ++rep_) { REFRESH(); for (int u = F.vcu; u < 768; u += F.G) l1_attn_unit(F, u); } SEAM(16);
    STAMP(18);
    if (IN(18)) for (int rep_ = 0; rep_ < REPS(18); ++rep_) { REFRESH();
        pg8::Gemm g{(const pb*)(ws + WS_MIX), (const pb*)(ws + WS_WOOUT), NR, 1024, 1024, 1024, 1024}; pg8::LatOrder S; S.init(1024, F.G, bid);
        pg8::EpiStore E{(pb*)(ws + WS_Y2), 1024, 4};
        pg8::gemm_phase<pg8::EpiStore, pg8::LatOrder, PG8_ALIGN, PG8_SP2>(F.lds + RING_OFF, g, S, E); } SEAM(18);
    if (IN(19)) for (int rep_ = 0; rep_ < REPS(19); ++rep_) { REFRESH();
        router_table(F);
        if (F.wave >= 4) px_expert_weights(F);
        rows_mid<true>(F, (const bf16*)(ws + WS_Y2), F.in[I_ONORMS] + 1024, 1, 2, F.in[I_ONORMS] + 2048, 1, 3, (bf16*)(ws + WS_FIN2), true);
        if (F.wave < 4) px_expert_weights(F);
        router_tail(F); } SEAM(19);
    if (IN(20)) for (int rep_ = 0; rep_ < REPS(20); ++rep_) { REFRESH(); moe_gather(F); } SEAM(20);
#define MOE_PART(kgu, kdn, t0_, cap_) \
    if (IN(kgu)) for (int rep_ = 0; rep_ < REPS(kgu); ++rep_) { REFRESH(); int base[8], ntiles; moe_bases(F, base, ntiles); const int t0 = (t0_), ntl = (ntiles - t0 < 0) ? 0 : ((ntiles - t0 < (cap_)) ? ntiles - t0 : (cap_)); \
        pg8::Gemm g{(const pb*)(ws + WS_ASORT) + (size_t)t0 * 256 * 1024, (const pb*)(ws + WS_WXGU), 0, 0, 1024, 1024, 1024}; pg8::MoeOrder S; S.init(ntl, 28, F.G, bid, (const int*)(ws + WS_META + META_TEXP), t0); \
        pg8::EpiSwiGLU E{(pb*)(ws + WS_HIDX), DFX, 28}; \
        pg8::gemm_phase<pg8::EpiSwiGLU, pg8::MoeOrder, PG8_ALIGN, PG8_SP2>(F.lds + RING_OFF, g, S, E); } SEAM(kgu); \
    if (IN(kdn)) for (int rep_ = 0; rep_ < REPS(kdn); ++rep_) { REFRESH(); int base[8], ntiles; moe_bases(F, base, ntiles); const int t0 = (t0_), ntl = (ntiles - t0 < 0) ? 0 : ((ntiles - t0 < (cap_)) ? ntiles - t0 : (cap_)); \
        const int full = ntl < 64 ? ntl : 64, ex = ntl - full; \
        { pg8::Gemm g{(const pb*)(ws + WS_HIDX), (const pb*)(ws + WS_WXDN), 0, 0, DFX, DFX, DFX}; pg8::MoeOrder S; S.init(full, 4, F.G, bid, (const int*)(ws + WS_META + META_TEXP), t0); \
          pg8::EpiStore E{(pb*)(ws + WS_ASORT) + (size_t)t0 * 256 * 1024, 1024, 4}; \
          pg8::gemm_phase<pg8::EpiStore, pg8::MoeOrder, PG8_ALIGN, PG8_SP2>(F.lds + RING_OFF, g, S, E); } \
        if (ex > 0) { __syncthreads(); \
          pg8::Gemm g{(const pb*)(ws + WS_HIDX), (const pb*)(ws + WS_WXDN), 0, 0, MOE_KSL, DFX, DFX}; pg8::MoeSplitOrder S; S.init(ex, DFX / MOE_KSL, MOE_KSL, F.G, bid, (const int*)(ws + WS_META + META_TEXP), t0); \
          pg8::EpiMoePart E{(float*)(ws + ((t0_) ? WS_WXGU : WS_FIN2)), MOE_KSL}; \
          pg8::gemm_phase<pg8::EpiMoePart, pg8::MoeSplitOrder, PG8_ALIGN, PG8_SP2>(F.lds + RING_OFF, g, S, E); } } SEAM(kdn);
    MOE_PART(21, 22, 0, 68)
    MOE_PART(23, 24, 68, 68)
    if (IN(25)) for (int rep_ = 0; rep_ < REPS(25); ++rep_) { REFRESH(); rows_final(F);
#if defined(CHK_G1) || defined(CHK_SCAN)
        { const unsigned fb = __hip_atomic_load((unsigned*)(F.ctl + CW_CHK), RLX_AGENT) & CHK_MASK; if (fb != 0u) { VM_WAIT(); __syncthreads(); for (int i = F.gw * 64 + F.lane; i < NB * T * D; i += F.NGW * 64) F.out[i] = 0.f; } }
#endif
    }
#ifdef PROBE_PHASE
    STAMP(26);
    if (blockIdx.x == 0 && F.tid == 0) {
        const unsigned long long t0 = ((unsigned long long)F.MISC[65 + 2 * PROBE_PHASE] << 32) | F.MISC[64 + 2 * PROBE_PHASE], t1 = ((unsigned long long)F.MISC[65 + 2 * (PROBE_PHASE + PROBE_SPAN)] << 32) | F.MISC[64 + 2 * (PROBE_PHASE + PROBE_SPAN)];
        unsigned long long dly = (t1 - t0) * PROBE_MULT; if (dly > 2000000ull) dly = 2000000ull; const unsigned long long s0 = __builtin_amdgcn_s_memrealtime();
        while (__builtin_amdgcn_s_memrealtime() - s0 < dly) __builtin_amdgcn_s_sleep(8); }
#endif
#undef IN
#undef SEAM
}

extern "C" void kernel_launch(void* const* d_in, const int* in_sizes, int n_in, void* d_out, int out_size, void* d_ws, size_t ws_size, hipStream_t stream) {
    static int grid = 0;
    if (grid == 0) {
        if (n_in != 32 || in_sizes[0] != NB * T * D || out_size != NB * T * D || ws_size < WS_END) { fprintf(stderr, "kernel_launch: unexpected shapes: n_in %d in0 %d out %d ws %zu (need %zu)\n", n_in, n_in > 0 ? in_sizes[0] : -1, out_size, ws_size, (size_t)WS_END); grid = -1; return; }
        int dev = 0, cus = 0, per_cu = 0;
        if (hipGetDevice(&dev) != hipSuccess || hipDeviceGetAttribute(&cus, hipDeviceAttributeMultiprocessorCount, dev) != hipSuccess) { grid = -1; return; }
        if (hipFuncSetAttribute((const void*)trunk_fwd, hipFuncAttributeMaxDynamicSharedMemorySize, LDS_BYTES) != hipSuccess) { fprintf(stderr, "kernel_launch: hipFuncSetAttribute failed\n"); grid = -1; return; }
        if (hipOccupancyMaxActiveBlocksPerMultiprocessor(&per_cu, (const void*)trunk_fwd, NWAVES * 64, LDS_BYTES) != hipSuccess || per_cu < 1) fprintf(stderr, "kernel_launch: occupancy query reports %d\n", per_cu);
        (void)hipGetLastError();
        grid = cus;
    }
    if (grid < 0) return;
    if (hipMemsetAsync((char*)d_ws + WS_CTL, 0, CTL_ZERO_BYTES, stream) != hipSuccess) return;
#ifdef DIAG_POISON
    (void)hipMemsetAsync((char*)d_ws + WS_GDNI, 0xFF, (size_t)64 * 68 * 32768, stream);
    (void)hipMemsetAsync((char*)d_ws + WS_OG, 0xFF, (size_t)NR * 1024 * 2, stream);
    (void)hipMemsetAsync((char*)d_ws + WS_QKVN, 0xFF, (size_t)NR * 1536 * 2, stream);
    (void)hipMemsetAsync((char*)d_ws + WS_GB, 0xFF, (size_t)NR * 32 * 4, stream);
#endif
    Args a{};
    for (int i = 0; i < 32; ++i) a.in[i] = (const float*)d_in[i];
    a.out = (float*)d_out; a.ws = (unsigned char*)d_ws;
#if MK_N_LAUNCHES == 1
    a.ph_lo = 0; a.ph_hi = N_PHASES;
    hipLaunchKernelGGL(trunk_fwd, dim3(grid), dim3(NWAVES * 64), LDS_BYTES, stream, a);
#else
    for (int p = 0; p < N_PHASES && p <= MK_LAST_PHASE; ++p) { a.ph_lo = p; a.ph_hi = p + 1; hipLaunchKernelGGL(trunk_fwd, dim3(grid), dim3(NWAVES * 64), LDS_BYTES, stream, a); }
#endif
    const hipError_t le = hipPeekAtLastError();
    if (le != hipSuccess) fprintf(stderr, "kernel_launch: launch failed: %s\n", hipGetErrorName(le));
}
```

```cpp
#include <hip/hip_runtime.h>
#include <cstdio>
#include <cstdint>
#include <cmath>

#ifndef MK_N_LAUNCHES
#define MK_N_LAUNCHES 1
#endif
#define SOLVE_C_FMA 1
#define SOLVE_C_LOAD 1
#ifndef G1_LOCK
#define G1_LOCK 0
#ifndef SCAN_PF
#define SCAN_PF 8
#endif
#ifndef SCAN_UNROLL
#define SCAN_UNROLL 1
#endif
#ifndef MOE_KSL
#define MOE_KSL 512
#endif
#endif
#ifndef MK_LAST_PHASE
#define MK_LAST_PHASE 99
#endif

constexpr int NB = 4, T = 4096, TC = 256, SROW = T + TC  , NR = NB * SROW  , D = 1024;
constexpr int EIN = 2848, EINP = 3072, OIN = 2208, OINP = 2304, DFF = 2816, DFX = 3584, NEXP = 8;
constexpr float EPS = 1e-6f;
constexpr int E_Q = 0, E_K = 512, E_V = 1024, E_Z = 1536, E_GA = 2048, E_GB = 2064, E_SQ = 2080, E_SK = 2592, E_SV = 2720;
constexpr int O_CQ = 0, O_CKV = 384, O_KR = 640, O_DQ = 672, O_DK = 1184, O_DV = 1696;

constexpr size_t MiB = 1u << 20;
constexpr size_t WS_CTL = 0, CTL_ZERO_BYTES = 1 * MiB;
constexpr size_t WS_MODV = 1 * MiB;
constexpr size_t WS_GB = 2 * MiB;
constexpr size_t WS_META = 5 * MiB;
constexpr size_t WS_HCTX = 8 * MiB;
constexpr size_t WS_WEIN = 12 * MiB, WS_WEOUT = 18 * MiB, WS_WEGU = 20 * MiB, WS_WEDN = 31 * MiB, WS_WOIN = 37 * MiB, WS_WUQ = 42 * MiB, WS_WUKV = 43 * MiB, WS_WOOUT = 44 * MiB;
constexpr size_t WS_BIG = 46 * MiB;
constexpr size_t WS_PROJ = 46 * MiB, WS_QKVN = 148 * MiB;
constexpr size_t WS_PROJ2 = 46 * MiB, WS_QM = 123 * MiB, WS_VMLA = 149 * MiB, WS_KMLA = 167 * MiB, WS_ODIFF = 316 * MiB;
constexpr size_t WS_WXGU = 46 * MiB, WS_WXDN = 158 * MiB;
constexpr size_t WS_CQN = 214 * MiB;
constexpr size_t WS_ABUF = 214 * MiB, WS_MIX = 248 * MiB, WS_YBUF = 282 * MiB;
constexpr size_t WS_OG = 214 * MiB;
constexpr size_t WS_PART = 350 * MiB;
constexpr size_t WS_GDNI = 282 * MiB;
constexpr size_t WS_HID = 46 * MiB;
constexpr size_t WS_ASORT = 214 * MiB;
constexpr size_t WS_FIN2 = 282 * MiB;
constexpr size_t WS_Y2 = 316 * MiB;
constexpr size_t WS_HIDX = 316 * MiB;
constexpr size_t WS_XB = 436 * MiB;
constexpr size_t WS_END = 470 * MiB;
static_assert(WS_QKVN + (size_t)NR * 1536 * 2 <= 214 * MiB && WS_PROJ + (size_t)NR * EINP * 2 <= WS_QKVN, "layer-0 big region");
static_assert(WS_PROJ2 + (size_t)NR * OINP * 2 <= WS_QM && WS_QM + (size_t)NR * 768 * 2 <= WS_VMLA && WS_VMLA + (size_t)NR * 512 * 2 <= WS_KMLA && WS_KMLA + (size_t)NR * 768 * 2 <= 214 * MiB, "layer-1 big region");
static_assert(WS_WXGU + (size_t)NEXP * 7168 * 1024 * 2 <= WS_WXDN && WS_WXDN + (size_t)NEXP * 1024 * 3584 * 2 <= 214 * MiB, "expert weights");
static_assert(WS_HIDX + (size_t)17408 * 3584 * 2 <= WS_END && WS_ASORT + (size_t)34816 * 1024 * 2 <= WS_FIN2 && WS_HID + (size_t)NR * DFF * 2 <= 214 * MiB, "moe map");
constexpr size_t META_TOPI = 0, META_TOPW = 128 * 1024, META_RANK = 256 * 1024, META_RSTD = 384 * 1024, META_BLKB = 960 * 1024;
constexpr int CW_TMO = 0, CW_CODE = 1;
constexpr int CW_MOECNT = 64;
constexpr int CW_SWAQ = 2048;
constexpr int CW_CHK = 1024;
constexpr int CW_BAR = 4096;
constexpr int RING_OFF = 0, RING_BYTES = 141312;
constexpr int MISC_OFF = RING_BYTES;
constexpr int LDS_BYTES = 147456;
constexpr int NWAVES = 8;
namespace pg8 {
#define PG8_LAS __attribute__((address_space(3)))
typedef unsigned short bf16_t;
typedef short bf16x8 __attribute__((ext_vector_type(8)));
typedef float f32x4 __attribute__((ext_vector_type(4)));
typedef unsigned u32x4 __attribute__((ext_vector_type(4)));
constexpr int BM = 256, BK = 64, HALF = 128, HTB = HALF * BK * 2  , STAGE_BYTES = 8 * HTB, NXCD = 8, WGM = 8;

__host__ __device__ __forceinline__ int lds_byte(int r, int c) { const int st = (r >> 4) * 2 + (c >> 5), rr = r & 15, cc = c & 31, ob = rr * 64 + cc * 2; return st * 1024 + (ob ^ (((ob >> 9) & 1) << 5)); }
__host__ __device__ __forceinline__ void stage_rc(int b, int& R, int& C) { const int st = b / 1024, sb = b % 1024, swz = sb ^ (((sb >> 9) & 1) << 5); R = (st >> 1) * 16 + swz / 64; C = (st & 1) * 32 + (swz % 64) / 2; }
__host__ __device__ __forceinline__ int perm32(int rho) { const int n = rho >> 4, i = rho & 15; return 8 * (i >> 2) + 4 * n + (i & 3); }

struct Unit { int pm, pn, kof; };
struct Gemm { const bf16_t* A; const bf16_t* Bt; int M, N, K, lda, ldb; };

struct StaticOrder {
    int nM, nN, nwg, G, c;
    __host__ __device__ void init(int M, int N, int G_, int c_) { nM = M / BM; nN = N / BM; nwg = nM * nN; G = G_; c = c_; }
    __host__ __device__ bool next(int i, Unit& u) const {
        const long L = (long)i * G + c; if (L >= nwg) return false;
        int wgid = (int)L; { const int q = nwg / NXCD, r = nwg % NXCD, xcd = wgid % NXCD, off = wgid / NXCD; wgid = (xcd < r ? xcd * (q + 1) : r * (q + 1) + (xcd - r) * q) + off; }
        const int nig = WGM * nN, gid = wgid / nig, fm = gid * WGM, gsz = (nM - fm) < WGM ? (nM - fm) : WGM;
        u.pm = fm + ((wgid % nig) % gsz); u.pn = (wgid % nig) / gsz; u.kof = 0; return true;
    }
    __device__ __forceinline__ void a_ready(const Unit&) const {}
    __device__ __forceinline__ void done(const Unit&) const {}
};

__device__ __forceinline__ unsigned cvt_pk_bf16(float lo, float hi) { unsigned r; asm volatile("v_cvt_pk_bf16_f32 %0, %1, %2" : "=v"(r) : "v"(lo), "v"(hi)); return r; }
typedef float f32x2 __attribute__((ext_vector_type(2)));
template <class Epi, class Sched, bool ALIGN_EPI = false, bool SP2 = false>
__device__ __forceinline__ void gemm_phase(PG8_LAS unsigned char* lds, const Gemm g, const Sched& S, const Epi& E) {
    const int tid = threadIdx.x, wid = __builtin_amdgcn_readfirstlane(tid >> 6), lane = tid & 63, wr = wid >> 2, wc = wid & 3, fr = lane & 15, fq = lane >> 4;
    const int K = g.K, nt = K / BK;
    unsigned voffA[2], voffB[2];
#pragma unroll
    for (int i = 0; i < 2; ++i) { int R, C; stage_rc(tid * 16 + i * 8192, R, C); const int Rb = Epi::PERM ? ((R & ~31) + perm32(R & 31)) : R;
        voffA[i] = (unsigned)(R * g.lda + C) * 2u; voffB[i] = (unsigned)(Rb * g.ldb + C) * 2u; }
    const size_t kstep = (size_t)(BK * 2);
    const size_t hstepA = (size_t)HALF * g.lda * 2, hstepB = (size_t)HALF * g.ldb * 2;
    const size_t tstepA = 2 * hstepA, tstepB = 2 * hstepB;
    const unsigned ldsw = (unsigned)wid * 1024u;
    const int aoff = lds_byte(wr * 64 + fr, fq * 8), boff = lds_byte(wc * 32 + fr, fq * 8);
#define PG8_SA(b, h) (((b) * 2 + (h)) * HTB)
#define PG8_SB(b, h) ((4 + (b) * 2 + (h)) * HTB)
#define PG8_STAGE(bufoff, gbase, voff) do { _Pragma("unroll") for (int _i = 0; _i < 2; ++_i) \
        __builtin_amdgcn_global_load_lds((const unsigned*)((const char*)(gbase) + (voff)[_i]), (PG8_LAS unsigned*)(lds + (bufoff) + ldsw + _i * 8192), 16, 0, 0); } while (0)
#define PG8_LDA(dst, b, h) do { _Pragma("unroll") for (int m = 0; m < 4; ++m) _Pragma("unroll") for (int k = 0; k < 2; ++k) dst[m][k] = *(const PG8_LAS bf16x8*)(lds + PG8_SA(b, h) + aoff + m * 2048 + k * 1024); } while (0)
#define PG8_LDB(dst, b, h) do { _Pragma("unroll") for (int n = 0; n < 2; ++n) _Pragma("unroll") for (int k = 0; k < 2; ++k) dst[n][k] = *(const PG8_LAS bf16x8*)(lds + PG8_SB(b, h) + boff + n * 2048 + k * 1024); } while (0)
#define PG8_MMA(ai, bj, At, Bt) do { __builtin_amdgcn_s_setprio(1); _Pragma("unroll") for (int m = 0; m < 4; ++m) _Pragma("unroll") for (int n = 0; n < 2; ++n) _Pragma("unroll") for (int k = 0; k < 2; ++k) \
        acc[ai][bj][m][n] = __builtin_amdgcn_mfma_f32_16x16x32_bf16(Bt[n][k], At[m][k], acc[ai][bj][m][n], 0, 0, 0); __builtin_amdgcn_s_setprio(0); } while (0)
#define PG8_WAIT_V(n) asm volatile("s_waitcnt vmcnt(" #n ")" ::: "memory")
#define PG8_WAIT_L(n) asm volatile("s_waitcnt lgkmcnt(" #n ")" ::: "memory")
#define PG8_BAR __builtin_amdgcn_s_barrier()
#define PG8_SCHED __builtin_amdgcn_sched_barrier(0)
    Unit cur, nxt; int ui = 0;
    if (!S.next(0, cur)) return;
    f32x4 acc[2][2][4][2];
#pragma unroll
    for (int a = 0; a < 2; ++a)
#pragma unroll
        for (int b = 0; b < 2; ++b)
#pragma unroll
            for (int m = 0; m < 4; ++m)
#pragma unroll
                for (int n = 0; n < 2; ++n) acc[a][b][m][n] = (f32x4){0.f, 0.f, 0.f, 0.f};
    bf16x8 At[4][2], B0[2][2], B1[2][2];
    const char* cA = (const char*)g.A + (size_t)cur.pm * tstepA + (size_t)cur.kof * 2; const char* cB = (const char*)g.Bt + (size_t)cur.pn * tstepB + (size_t)cur.kof * 2;
    S.a_ready(cur);
    if constexpr (SP2) {
        PG8_STAGE(PG8_SB(0, 0), cB, voffB); PG8_STAGE(PG8_SB(0, 1), cB + hstepB, voffB); PG8_STAGE(PG8_SA(0, 0), cA, voffA); PG8_STAGE(PG8_SA(0, 1), cA + hstepA, voffA);
        if (wr == 1) PG8_BAR;
        PG8_WAIT_V(2); PG8_BAR;
        PG8_STAGE(PG8_SB(1, 0), cB + kstep, voffB); PG8_STAGE(PG8_SA(1, 0), cA + kstep, voffA); PG8_STAGE(PG8_SB(1, 1), cB + hstepB + kstep, voffB);
        PG8_WAIT_V(6); PG8_BAR;
    } else {
        PG8_STAGE(PG8_SB(0, 0), cB, voffB); PG8_STAGE(PG8_SA(0, 0), cA, voffA); PG8_STAGE(PG8_SB(0, 1), cB + hstepB, voffB); PG8_STAGE(PG8_SA(0, 1), cA + hstepA, voffA);
        if (wr == 1) PG8_BAR;
        PG8_WAIT_V(4); PG8_BAR;
        PG8_STAGE(PG8_SB(1, 0), cB + kstep, voffB); PG8_STAGE(PG8_SA(1, 0), cA + kstep, voffA); PG8_STAGE(PG8_SB(1, 1), cB + hstepB + kstep, voffB);
        PG8_WAIT_V(6); PG8_BAR;
    }
    for (;;) {
        const bool has_next = S.next(ui + 1, nxt);
        const char* nA = has_next ? (const char*)g.A + (size_t)nxt.pm * tstepA + (size_t)nxt.kof * 2 : cA; const char* nB = has_next ? (const char*)g.Bt + (size_t)nxt.pn * tstepB + (size_t)nxt.kof * 2 : cB;
        _Pragma("unroll 1") for (int t = 0; t < nt; t += 2) {
            const bool last = (t == nt - 2);
            const char* a1 = cA + (size_t)(t + 1) * kstep;
            const char* a2 = last ? nA : cA + (size_t)(t + 2) * kstep; const char* b2 = last ? nB : cB + (size_t)(t + 2) * kstep;
            const char* a3 = a2 + kstep; const char* b3 = b2 + kstep;
            if (last && has_next) S.a_ready(nxt);
            if constexpr (SP2) {
            PG8_LDB(B0, 0, 0); PG8_LDB(B1, 0, 1); PG8_SCHED; PG8_LDA(At, 0, 0); PG8_STAGE(PG8_SA(1, 1), a1 + hstepA, voffA);
            PG8_WAIT_V(8); PG8_WAIT_L(0); PG8_BAR; PG8_MMA(0, 0, At, B0); PG8_MMA(0, 1, At, B1); PG8_BAR; PG8_SCHED;
            PG8_LDA(At, 0, 1); PG8_STAGE(PG8_SB(0, 0), b2, voffB); PG8_STAGE(PG8_SB(0, 1), b2 + hstepB, voffB); PG8_STAGE(PG8_SA(0, 0), a2, voffA);
            PG8_WAIT_V(8); PG8_WAIT_L(0); PG8_BAR; PG8_MMA(1, 0, At, B0); PG8_MMA(1, 1, At, B1); PG8_BAR; PG8_SCHED;
            PG8_LDB(B0, 1, 0); PG8_LDB(B1, 1, 1); PG8_SCHED; PG8_LDA(At, 1, 0); PG8_STAGE(PG8_SA(0, 1), a2 + hstepA, voffA);
            PG8_WAIT_V(8); PG8_WAIT_L(0); PG8_BAR; PG8_MMA(0, 0, At, B0); PG8_MMA(0, 1, At, B1); PG8_BAR; PG8_SCHED;
            PG8_LDA(At, 1, 1); PG8_STAGE(PG8_SB(1, 0), b3, voffB); PG8_STAGE(PG8_SB(1, 1), b3 + hstepB, voffB); PG8_STAGE(PG8_SA(1, 0), a3, voffA);
            PG8_WAIT_V(8); PG8_WAIT_L(0); PG8_BAR; PG8_MMA(1, 0, At, B0); PG8_MMA(1, 1, At, B1); PG8_BAR; PG8_SCHED;
            } else {
            PG8_LDB(B0, 0, 0); PG8_SCHED; PG8_LDA(At, 0, 0); PG8_STAGE(PG8_SA(1, 1), a1 + hstepA, voffA);
            PG8_WAIT_L(8); PG8_BAR; PG8_WAIT_L(0); PG8_MMA(0, 0, At, B0); PG8_BAR; PG8_SCHED;
            PG8_LDB(B1, 0, 1); PG8_STAGE(PG8_SB(0, 0), b2, voffB);
            PG8_BAR; PG8_WAIT_L(0); PG8_MMA(0, 1, At, B1); PG8_BAR;
            PG8_LDA(At, 0, 1); PG8_STAGE(PG8_SA(0, 0), a2, voffA);
            PG8_BAR; PG8_WAIT_L(0); PG8_MMA(1, 0, At, B0); PG8_BAR; PG8_SCHED;
            PG8_STAGE(PG8_SB(0, 1), b2 + hstepB, voffB);
            PG8_WAIT_V(6); PG8_BAR; PG8_MMA(1, 1, At, B1); PG8_BAR;
            PG8_LDB(B0, 1, 0); PG8_SCHED; PG8_LDA(At, 1, 0); PG8_STAGE(PG8_SA(0, 1), a2 + hstepA, voffA);
            PG8_WAIT_L(8); PG8_BAR; PG8_WAIT_L(0); PG8_MMA(0, 0, At, B0); PG8_BAR; PG8_SCHED;
            PG8_LDB(B1, 1, 1); PG8_STAGE(PG8_SB(1, 0), b3, voffB);
            PG8_BAR; PG8_WAIT_L(0); PG8_MMA(0, 1, At, B1); PG8_BAR;
            PG8_LDA(At, 1, 1); PG8_STAGE(PG8_SA(1, 0), a3, voffA);
            PG8_BAR; PG8_WAIT_L(0); PG8_MMA(1, 0, At, B0); PG8_BAR; PG8_SCHED;
            PG8_STAGE(PG8_SB(1, 1), b3 + hstepB, voffB);
            PG8_WAIT_V(6); PG8_BAR; PG8_MMA(1, 1, At, B1); PG8_BAR;
            }
        }
        if constexpr (ALIGN_EPI) { if (wr == 0) PG8_BAR; }
        if constexpr (!Epi::AFTER_DRAIN) { E(acc, cur, wr, wc, fr, fq); S.done(cur); }
        if (!has_next) break;
#pragma unroll
        for (int a = 0; a < 2; ++a)
#pragma unroll
            for (int b = 0; b < 2; ++b)
#pragma unroll
                for (int m = 0; m < 4; ++m)
#pragma unroll
                    for (int n = 0; n < 2; ++n) acc[a][b][m][n] = (f32x4){0.f, 0.f, 0.f, 0.f};
        cur = nxt; cA = nA; cB = nB; ++ui;
        if constexpr (ALIGN_EPI) { if (wr == 1) PG8_BAR; }
    }
    PG8_WAIT_V(0);
    if constexpr (!ALIGN_EPI) { if (wr == 0) PG8_BAR; }
    PG8_BAR;
    if constexpr (Epi::AFTER_DRAIN) { E.fused(acc, cur, wr, wc, fr, fq, lds, wid, lane); S.done(cur); }
#undef PG8_SA
#undef PG8_SB
#undef PG8_STAGE
#undef PG8_LDA
#undef PG8_LDB
#undef PG8_MMA
#undef PG8_WAIT_V
#undef PG8_WAIT_L
#undef PG8_BAR
#undef PG8_SCHED
}
}
namespace pg8 {
struct EpiStore { static constexpr bool PERM = true, AFTER_DRAIN = false;
    bf16_t* O; int ldc; int nN;
    __device__ __forceinline__ void operator()(const f32x4 (&acc)[2][2][4][2], const Unit& u, int wr, int wc, int fr, int fq) const {
        const int row0 = u.pm * BM + wr * 64 + fr, col0 = (u.pn % nN) * BM + wc * 32 + 8 * fq;
#pragma unroll
        for (int ai = 0; ai < 2; ++ai)
#pragma unroll
            for (int m = 0; m < 4; ++m) { const int row = row0 + ai * HALF + m * 16;
                bf16_t* rowp = O + (size_t)row * ldc + col0;
#pragma unroll
                for (int bj = 0; bj < 2; ++bj) { const f32x4 v0 = acc[ai][bj][m][0], v1 = acc[ai][bj][m][1];
                    u32x4 w; w.x = cvt_pk_bf16(v0[0], v0[1]); w.y = cvt_pk_bf16(v0[2], v0[3]); w.z = cvt_pk_bf16(v1[0], v1[1]); w.w = cvt_pk_bf16(v1[2], v1[3]);
                    *(u32x4*)(rowp + bj * HALF) = w; } }
    }
};
struct EpiSwiGLU { static constexpr bool PERM = true, AFTER_DRAIN = false;
    bf16_t* O; int ldc; int nN;
    __device__ __forceinline__ void operator()(const f32x4 (&acc)[2][2][4][2], const Unit& u, int wr, int wc, int fr, int fq) const {
        const int row0 = u.pm * BM + wr * 64 + fr, col0 = (u.pn % nN) * HALF + wc * 32 + 8 * fq;
#pragma unroll
        for (int ai = 0; ai < 2; ++ai)
#pragma unroll
            for (int m = 0; m < 4; ++m) { bf16_t* rowp = O + (size_t)(row0 + ai * HALF + m * 16) * ldc + col0;
                float h[8];
#pragma unroll
                for (int n = 0; n < 2; ++n)
#pragma unroll
                    for (int j = 0; j < 4; ++j) { const float g = acc[ai][0][m][n][j], up = acc[ai][1][m][n][j]; h[n * 4 + j] = g * __builtin_amdgcn_rcpf(1.f + __expf(-g)) * up; }
                u32x4 w; w.x = cvt_pk_bf16(h[0], h[1]); w.y = cvt_pk_bf16(h[2], h[3]); w.z = cvt_pk_bf16(h[4], h[5]); w.w = cvt_pk_bf16(h[6], h[7]);
                *(u32x4*)rowp = w; }
    }
};
struct EpiKV { static constexpr bool PERM = true, AFTER_DRAIN = false;
    bf16_t* KM; bf16_t* VM;
    __device__ __forceinline__ void operator()(const f32x4 (&acc)[2][2][4][2], const Unit& u, int wr, int wc, int fr, int fq) const {
        const int row0 = u.pm * BM + wr * 64 + fr, within = wc * 32 + 8 * fq;
#pragma unroll
        for (int ai = 0; ai < 2; ++ai)
#pragma unroll
            for (int m = 0; m < 4; ++m) { const int row = row0 + ai * HALF + m * 16;
#pragma unroll
                for (int bj = 0; bj < 2; ++bj) { const int h = 2 * u.pn + bj; const f32x4 v0 = acc[ai][bj][m][0], v1 = acc[ai][bj][m][1];
                    u32x4 w; w.x = cvt_pk_bf16(v0[0], v0[1]); w.y = cvt_pk_bf16(v0[2], v0[3]); w.z = cvt_pk_bf16(v1[0], v1[1]); w.w = cvt_pk_bf16(v1[2], v1[3]);
                    bf16_t* p = (within < 64) ? KM + (size_t)row * 768 + h * 96 + within : VM + (size_t)row * 512 + h * 64 + (within - 64);
                    *(u32x4*)p = w; } }
    }
};
struct CtxSplitOrder { int nsl, ksl, G, c;
    __device__ void init(int nsl_, int ksl_, int G_, int c_) { nsl = nsl_; ksl = ksl_; G = G_; c = c_; }
    __device__ bool next(int i, Unit& u) const { const int L = i * G + c; if (L >= 16 * nsl) return false; const int sl = L >> 4, rem = L & 15; u.pm = (rem >> 2) * 17; u.pn = rem & 3; u.kof = sl * ksl; return true; }
    __device__ __forceinline__ void a_ready(const Unit&) const {}
    __device__ __forceinline__ void done(const Unit&) const {}
};
struct EpiPartF32 { static constexpr bool PERM = false, AFTER_DRAIN = false;
    float* P; int ksl;
    __device__ __forceinline__ void operator()(const f32x4 (&acc)[2][2][4][2], const Unit& u, int wr, int wc, int fr, int fq) const {
        float* base = P + ((size_t)(u.kof / ksl) * 1024 + (size_t)(u.pm / 17) * 256) * 1024; const int row0 = wr * 64 + fr, col0 = u.pn * BM + wc * 32 + 4 * fq;
#pragma unroll
        for (int ai = 0; ai < 2; ++ai)
#pragma unroll
            for (int m = 0; m < 4; ++m) { float* rowp = base + (size_t)(row0 + ai * HALF + m * 16) * 1024 + col0;
#pragma unroll
                for (int bj = 0; bj < 2; ++bj)
#pragma unroll
                    for (int n = 0; n < 2; ++n) *(f32x4*)(rowp + bj * HALF + n * 16) = acc[ai][bj][m][n]; }
    }
};
struct LatOrder { StaticOrder so;
    __device__ void init(int N, int G, int c) { so.nM = 64; so.nN = N / BM; so.nwg = 64 * so.nN; so.G = G; so.c = c; }
    __device__ bool next(int i, Unit& u) const { if (!so.next(i, u)) return false; u.pm = (u.pm >> 4) * 17 + 1 + (u.pm & 15); return true; }
    __device__ __forceinline__ void a_ready(const Unit&) const {}
    __device__ __forceinline__ void done(const Unit&) const {}
};
struct MoeOrder { StaticOrder so; const int* texp; int t0, nNe;
    __device__ void init(int ntiles, int nNe_, int G, int c, const int* texp_, int t0_) { so.nM = ntiles; so.nN = nNe_; so.nwg = ntiles * nNe_; so.G = G; so.c = c; texp = texp_; t0 = t0_; nNe = nNe_; }
    __device__ bool next(int i, Unit& u) const { if (!so.next(i, u)) return false; const int e = __builtin_amdgcn_readfirstlane(texp[t0 + u.pm]); u.pn = e * nNe + u.pn; return true; }
    __device__ __forceinline__ void a_ready(const Unit&) const {}
    __device__ __forceinline__ void done(const Unit&) const {}
};
struct MoeSplitOrder { int ex4, nsl, ksl, G, c, t0; const int* texp;
    __device__ void init(int ex, int nsl_, int ksl_, int G_, int c_, const int* texp_, int t0_) { ex4 = ex * 4; nsl = nsl_; ksl = ksl_; G = G_; c = c_; texp = texp_; t0 = t0_; }
    __device__ bool next(int i, Unit& u) const { const int L = i * G + c; if (L >= ex4 * nsl) return false; const int sl = L / ex4, rem = L - sl * ex4; u.pm = 64 + (rem >> 2);
        const int e = __builtin_amdgcn_readfirstlane(texp[t0 + u.pm]); u.pn = e * 4 + (rem & 3); u.kof = sl * ksl; return true; }
    __device__ __forceinline__ void a_ready(const Unit&) const {}
    __device__ __forceinline__ void done(const Unit&) const {}
};
struct EpiMoePart { static constexpr bool PERM = false, AFTER_DRAIN = false;
    float* P; int ksl;
    __device__ __forceinline__ void operator()(const f32x4 (&acc)[2][2][4][2], const Unit& u, int wr, int wc, int fr, int fq) const {
        float* base = P + ((size_t)(u.kof / ksl) * 4 + (size_t)(u.pm - 64)) * 256 * 1024; const int row0 = wr * 64 + fr, col0 = (u.pn & 3) * BM + wc * 32 + 4 * fq;
#pragma unroll
        for (int ai = 0; ai < 2; ++ai)
#pragma unroll
            for (int m = 0; m < 4; ++m) { float* rowp = base + (size_t)(row0 + ai * HALF + m * 16) * 1024 + col0;
#pragma unroll
                for (int bj = 0; bj < 2; ++bj)
#pragma unroll
                    for (int n = 0; n < 2; ++n) *(f32x4*)(rowp + bj * HALF + n * 16) = acc[ai][bj][m][n]; }
    }
};
}
#define PG8_SP2 true
#define PG8_ALIGN true
#define GAS __attribute__((address_space(1)))
#define LAS __attribute__((address_space(3)))
typedef unsigned short bf16;
typedef unsigned v4u __attribute__((ext_vector_type(4)));
typedef unsigned v2u __attribute__((ext_vector_type(2)));
typedef float f32x4 __attribute__((ext_vector_type(4)));
typedef short bf16x8 __attribute__((ext_vector_type(8)));
typedef GAS unsigned gu32;
#define RLX_AGENT __ATOMIC_RELAXED, __HIP_MEMORY_SCOPE_AGENT
#define LDS_WAIT() asm volatile("s_waitcnt lgkmcnt(0)" ::: "memory")
#define VM_WAIT() asm volatile("s_waitcnt vmcnt(0)" ::: "memory")
__device__ __forceinline__ unsigned f2bf(float f) { unsigned u = __builtin_bit_cast(unsigned, f); return (u + 0x7fffu + ((u >> 16) & 1u)) >> 16; }
__device__ __forceinline__ unsigned pk2(float lo, float hi) { return f2bf(lo) | (f2bf(hi) << 16); }
__device__ __forceinline__ float bf2f(unsigned short b) { return __builtin_bit_cast(float, ((unsigned)b) << 16); }
__device__ __forceinline__ float bflo(unsigned w) { return __builtin_bit_cast(float, w << 16); }
__device__ __forceinline__ float bfhi(unsigned w) { return __builtin_bit_cast(float, w & 0xffff0000u); }
__device__ __forceinline__ float wave_sum(float v) {
#pragma unroll
    for (int o = 1; o < 64; o <<= 1) v += __shfl_xor(v, o);
    return v;
}
__device__ __forceinline__ float siluf(float x) { return x / (1.f + __expf(-x)); }
#define XB_TMO      128
#define XB_XCNT(j)  (256  + 64 * (j))
#define XB_XSUB(j)  (1280 + 64 * (j))
#define XB_XGEN(j)  (2304 + 64 * (j))
#define XB_TOP      3328
#define XB_TOPGEN   3392
#define XCD_BAR_WORDS 3456
#define XB_SPIN_CAP (1u << 18)

__device__ __forceinline__ unsigned xb_ld(unsigned* p)              { return __hip_atomic_load(p, __ATOMIC_RELAXED, __HIP_MEMORY_SCOPE_AGENT); }
__device__ __forceinline__ unsigned xb_add(unsigned* p, unsigned v) { return __hip_atomic_fetch_add(p, v, __ATOMIC_RELAXED, __HIP_MEMORY_SCOPE_AGENT); }
__device__ __forceinline__ unsigned xb_xcc_id() { return (unsigned)__builtin_amdgcn_s_getreg((3 << 11) | 20) & 0xFu; }
#define XB_SPIN(cond, bar) do { unsigned _sp = 0; while (cond) { __builtin_amdgcn_s_sleep(1); \
    if ((++_sp & 255u) == 0u) { if (xb_ld(&(bar)[XB_TMO])) break; if (_sp > XB_SPIN_CAP) { atomicAdd(&(bar)[XB_TMO], 1u); break; } } } } while (0)

struct XcdBarrier {
    unsigned* bar; unsigned x;
    volatile LAS unsigned* st;
};

__device__ __forceinline__ XcdBarrier xcd_barrier_post(unsigned* bar, volatile LAS unsigned* st) {
    XcdBarrier b; b.bar = bar; b.x = xb_xcc_id(); b.st = st;
    if (threadIdx.x == 0) (void)xb_add(&bar[XB_XCNT(b.x)], 1u);
    return b;
}
__device__ __forceinline__ void xcd_barrier_complete(unsigned* bar, unsigned x, unsigned& nloc, unsigned& nx) {
    const unsigned G = gridDim.x * gridDim.y * gridDim.z;
    unsigned sum, cnt, mine, sp = 0u;
    for (;;) {
        sum = 0u; cnt = 0u; mine = 0u;
#pragma unroll
        for (unsigned j = 0; j < 16; ++j) { const unsigned c = xb_ld(&bar[XB_XCNT(j)]); sum += c; cnt += (c > 0u) ? 1u : 0u; mine = (j == x) ? c : mine; }
        if (sum == G) break;
        __builtin_amdgcn_s_sleep(1);
        if ((++sp & 255u) == 0u) { if (xb_ld(&bar[XB_TMO])) break; if (sp > XB_SPIN_CAP) { atomicAdd(&bar[XB_TMO], 1u); break; } }
    }
    nloc = mine > 0u ? mine : 1u; nx = cnt > 0u ? cnt : 1u;
}

__device__ __forceinline__ void xcd_barrier(const XcdBarrier& b) {
    asm volatile("s_waitcnt vmcnt(0)" ::: "memory");
    __syncthreads();
    if (threadIdx.x == 0) {
        unsigned* bar = b.bar;
        __builtin_amdgcn_s_waitcnt(0);
        unsigned nloc = b.st[0], nx = b.st[1];
        if (nloc == 0u) { xcd_barrier_complete(bar, b.x, nloc, nx); b.st[0] = nloc; b.st[1] = nx; }
        const unsigned old = xb_add(&bar[XB_XSUB(b.x)], 1u);
        const unsigned gen = old / nloc;
        if (old + 1u == (gen + 1u) * nloc) {
            __builtin_amdgcn_fence(__ATOMIC_RELEASE, "agent");
            asm volatile("s_waitcnt vmcnt(0)" ::: "memory");
            const unsigned og = xb_add(&bar[XB_TOP], 1u);
            const unsigned tg = og / nx;
            if (og + 1u == (tg + 1u) * nx) xb_add(&bar[XB_TOPGEN], 1u);
            else XB_SPIN(xb_ld(&bar[XB_TOPGEN]) == tg, bar);
            __builtin_amdgcn_fence(__ATOMIC_ACQUIRE, "agent");
            xb_add(&bar[XB_XGEN(b.x)], 1u);
            asm volatile("s_waitcnt vmcnt(0)" ::: "memory");
        } else {
            XB_SPIN(xb_ld(&bar[XB_XGEN(b.x)]) == gen, bar);
            __builtin_amdgcn_fence(__ATOMIC_ACQUIRE, "agent");
            asm volatile("s_waitcnt vmcnt(0)" ::: "memory");
        }
    }
    __syncthreads();
}
namespace att {
using bf16x8 = __attribute__((ext_vector_type(8))) short;
using s16x4  = __attribute__((ext_vector_type(4))) short;
using f32x16 = __attribute__((ext_vector_type(16))) float;
using u32x4  = __attribute__((ext_vector_type(4))) unsigned;
constexpr int NW = 8, QBLK = 32, KVBLK = 64;
constexpr size_t SHM_V = KVBLK * 128 * 2, SHM_K = KVBLK * 128 * 2, SHM_ATTN = 2 * SHM_V + 2 * SHM_K + NW * 64 * 4;
constexpr float THR = 8.f;
#define KSWZ(row, colB) ((row) * 256 + ((colB) ^ (((row) & 7) << 4)))
#define SBAR() __builtin_amdgcn_sched_barrier(0)
__device__ __forceinline__ int crow(int r, int hi) { return (r & 3) + 8 * (r >> 2) + 4 * hi; }
__device__ __forceinline__ unsigned cvtpk(float lo, float hi) { unsigned r; asm volatile("v_cvt_pk_bf16_f32 %0, %1, %2" : "=v"(r) : "v"(lo), "v"(hi)); return r; }
__device__ __forceinline__ void partialSM(f32x16& p0, f32x16& p1, float& m_reg, float& mn, float& alpha, float C, float thr_s) {
  float pmax = p0[0];
#pragma unroll
  for (int r = 1; r < 16; ++r) pmax = fmaxf(pmax, p0[r]);
#pragma unroll
  for (int r = 0; r < 16; ++r) pmax = fmaxf(pmax, p1[r]);
  { auto rr = __builtin_amdgcn_permlane32_swap(__float_as_uint(pmax), __float_as_uint(pmax), false, false);
    pmax = fmaxf(__uint_as_float(rr[0]), __uint_as_float(rr[1])); }
  if (__builtin_expect(__all(pmax - m_reg <= thr_s), 1)) { mn = m_reg; alpha = 1.f; }
  else { mn = fmaxf(m_reg, pmax); alpha = __builtin_amdgcn_exp2f((m_reg - mn) * C); m_reg = mn; }
  const float mnC = -mn * C;
#pragma unroll
  for (int r = 0; r < 16; ++r) p0[r] = fmaf(p0[r], C, mnC);
#pragma unroll
  for (int r = 0; r < 16; ++r) p1[r] = fmaf(p1[r], C, mnC);
#pragma unroll
  for (int r = 0; r < 16; ++r) p0[r] = __builtin_amdgcn_exp2f(p0[r]);
}
__device__ __forceinline__ void finishSM(f32x16& p0, f32x16& p1, float alpha, float& l_reg, bf16x8& pa0, bf16x8& pa1, bf16x8& pa2, bf16x8& pa3) {
#pragma unroll
  for (int r = 0; r < 16; ++r) p1[r] = __builtin_amdgcn_exp2f(p1[r]);
  float ps = 0;
#pragma unroll
  for (int r = 0; r < 16; ++r) ps += p0[r];
#pragma unroll
  for (int r = 0; r < 16; ++r) ps += p1[r];
  { auto rr = __builtin_amdgcn_permlane32_swap(__float_as_uint(ps), __float_as_uint(ps), false, false);
    ps = __uint_as_float(rr[0]) + __uint_as_float(rr[1]); }
  l_reg = l_reg * alpha + ps;
#define PK4(P, BASE, OUT) do { unsigned a0 = cvtpk(P[BASE + 0], P[BASE + 1]), a1 = cvtpk(P[BASE + 2], P[BASE + 3]);   \
    unsigned b0 = cvtpk(P[BASE + 4], P[BASE + 5]), b1 = cvtpk(P[BASE + 6], P[BASE + 7]);                              \
    auto r0 = __builtin_amdgcn_permlane32_swap(a0, b0, false, false); auto r1 = __builtin_amdgcn_permlane32_swap(a1, b1, false, false); \
    u32x4 w = {r0[0], r1[0], r0[1], r1[1]}; OUT = *reinterpret_cast<bf16x8*>(&w); } while (0)
  PK4(p0, 0, pa0); PK4(p0, 8, pa1); PK4(p1, 0, pa2); PK4(p1, 8, pa3);
#undef PK4
}
template <int DQK> __device__ __forceinline__ void qkt(f32x16& p0, f32x16& p1, const char* Ks, const bf16x8* qr, int r32, int hi) {
  p0 = f32x16{}; p1 = f32x16{};
#pragma unroll
  for (int d0 = 0; d0 < DQK / 16; ++d0) { const int cb = (d0 * 16 + hi * 8) * 2;
    const bf16x8 b0 = *reinterpret_cast<const bf16x8*>(Ks + KSWZ(r32, cb));
    const bf16x8 b1 = *reinterpret_cast<const bf16x8*>(Ks + KSWZ(32 + r32, cb));
    p0 = __builtin_amdgcn_mfma_f32_32x32x16_bf16(b0, qr[d0], p0, 0, 0, 0);
    p1 = __builtin_amdgcn_mfma_f32_32x32x16_bf16(b1, qr[d0], p1, 0, 0, 0); }
}
__device__ __forceinline__ int v_st(int k, int c) { const int kk = (k & ~0xC) | ((k & 4) << 1) | ((k & 8) >> 1); return ((kk >> 3) * 4 + (c >> 5)) * 512 + ((kk & 7) * 32 + (c & 31)) * 2; }
__device__ __forceinline__ int v_rd_base(int lane) { return ((lane & 3) << 3) | (((lane >> 2) & 3) << 6) | (((lane >> 4) & 1) << 5) | (((lane >> 5) & 1) << 8); }
constexpr int v_rd_off(int d0, int ks, int half) { return d0 * 512 + ks * 4096 + half * 2048; }
template <int OFF> __device__ __forceinline__ s16x4 tr_read(int vb) {
  s16x4 r; asm volatile("ds_read_b64_tr_b16 %0, %1 offset:%2" : "=&v"(r) : "v"(vb), "i"(OFF) : "memory"); return r;
}
template <int D0> __device__ __forceinline__ void pv_one(f32x16& od, int vb, bf16x8 pa0, bf16x8 pa1, bf16x8 pa2, bf16x8 pa3) {
  const s16x4 l0 = tr_read<v_rd_off(D0, 0, 0)>(vb), h0 = tr_read<v_rd_off(D0, 0, 1)>(vb), l1 = tr_read<v_rd_off(D0, 1, 0)>(vb), h1 = tr_read<v_rd_off(D0, 1, 1)>(vb);
  const s16x4 l2 = tr_read<v_rd_off(D0, 2, 0)>(vb), h2 = tr_read<v_rd_off(D0, 2, 1)>(vb), l3 = tr_read<v_rd_off(D0, 3, 0)>(vb), h3 = tr_read<v_rd_off(D0, 3, 1)>(vb);
  asm volatile("s_waitcnt lgkmcnt(0)" ::: "memory"); SBAR();
#define PK(L, H) (bf16x8){L[0], L[1], L[2], L[3], H[0], H[1], H[2], H[3]}
  od = __builtin_amdgcn_mfma_f32_32x32x16_bf16(pa0, PK(l0, h0), od, 0, 0, 0);
  od = __builtin_amdgcn_mfma_f32_32x32x16_bf16(pa1, PK(l1, h1), od, 0, 0, 0);
  od = __builtin_amdgcn_mfma_f32_32x32x16_bf16(pa2, PK(l2, h2), od, 0, 0, 0);
  od = __builtin_amdgcn_mfma_f32_32x32x16_bf16(pa3, PK(l3, h3), od, 0, 0, 0);
#undef PK
}
template <int DV> __device__ __forceinline__ void pv_all(f32x16* o, int vb, bf16x8 pa0, bf16x8 pa1, bf16x8 pa2, bf16x8 pa3) {
  pv_one<0>(o[0], vb, pa0, pa1, pa2, pa3); pv_one<1>(o[1], vb, pa0, pa1, pa2, pa3);
  if constexpr (DV > 64) { pv_one<2>(o[2], vb, pa0, pa1, pa2, pa3); pv_one<3>(o[3], vb, pa0, pa1, pa2, pa3); }
}
template <int DQK, int DV, int MODE, bool QROPE = false, int OUTMODE = 0>
__device__ __forceinline__ void attn_unit(const unsigned short* __restrict__ Qb, int ldq, const unsigned short* __restrict__ Kb, int ldk, const unsigned short* __restrict__ Vb, int ldv,
                                          unsigned short* __restrict__ Ob, int ldo, int NT, int lat0, int q0lat, float C, float thr_s, float sinkl2, char* lds, float lam = 0.f, const float* nw = nullptr, float nscale = 1.f) {
  int tid_ = threadIdx.x; asm volatile("" : "+v"(tid_));
  const int tid = tid_, wid = tid >> 6, lane = tid & 63, r32 = lane & 31, hi = lane >> 5;
  char* V_lds = lds; char* K_lds = lds + 2 * SHM_V;
  float* ws = (float*)(lds + 2 * SHM_V + 2 * SHM_K) + wid * 64; float* li_l = ws; float* al_l = ws + 32;
  float m_reg = -1e30f, l_reg = 0; f32x16 o[DV / 32]; bf16x8 qr[DQK / 16];
#pragma unroll
  for (int d = 0; d < DV / 32; ++d) o[d] = f32x16{};
  const unsigned short* Qw = Qb + (long)(wid * QBLK + r32) * ldq + hi * 8;
#pragma unroll
  for (int d0 = 0; d0 < DQK / 16; ++d0) qr[d0] = *reinterpret_cast<const bf16x8*>(Qw + d0 * 16);
  if constexpr (QROPE) {
    static_assert(DQK == 96, "QROPE is the MLA case");
    int t = q0lat + wid * QBLK + r32; asm volatile("" : "+v"(t));
#pragma unroll
    for (int part = 0; part < 2; ++part) { const float pos = (float)(part ? (t & 63) : (t >> 6)); u32x4 w = __builtin_bit_cast(u32x4, qr[4 + part]); u32x4 o;
#pragma unroll
      for (int q = 0; q < 4; ++q) { const unsigned pw = (unsigned)__shfl_xor((int)w[q], 32); float x0 = bflo(w[q]), x1 = bfhi(w[q]); const float p0 = bflo(pw), p1 = bfhi(pw);
        float s0, c0, s1, c1; sincosf(pos * __powf(10000.f, -(float)(2 * q) * 0.125f), &s0, &c0); sincosf(pos * __powf(10000.f, -(float)(2 * q + 1) * 0.125f), &s1, &c1);
        x0 = hi ? (x0 * c0 + p0 * s0) : (x0 * c0 - p0 * s0); x1 = hi ? (x1 * c1 + p1 * s1) : (x1 * c1 - p1 * s1); o[q] = cvtpk(x0, x1); }
      qr[4 + part] = __builtin_bit_cast(bf16x8, o); } }
  const int sr = tid >> 4, sc = (tid & 15) * 8, vst0 = v_st(sr, sc), vst1 = v_st(32 + sr, sc);
  const bool kact = sc < DQK, vact = sc < DV;
  const int vb0 = (int)(uintptr_t)V_lds + v_rd_base(lane);
  struct { bf16x8 vs0, vs1, ks0, ks1; } sr_[2];
#define TROW(j) ((MODE == 1 && (j) >= 4) ? (256 + lat0 + ((j) - 4) * 64) : (j) * 64)
#define SLOAD(i, j) do { const long k0_ = TROW(j); \
    if (vact) { sr_[i].vs0 = *reinterpret_cast<const bf16x8*>(&Vb[(k0_ + sr) * ldv + sc]); sr_[i].vs1 = *reinterpret_cast<const bf16x8*>(&Vb[(k0_ + 32 + sr) * ldv + sc]); } \
    if (kact) { sr_[i].ks0 = *reinterpret_cast<const bf16x8*>(&Kb[(k0_ + sr) * ldk + sc]); sr_[i].ks1 = *reinterpret_cast<const bf16x8*>(&Kb[(k0_ + 32 + sr) * ldk + sc]); } } while (0)
#define SWRITE(b, i) do { if (vact) { *(bf16x8*)(V_lds + (b) * SHM_V + vst0) = sr_[i].vs0; *(bf16x8*)(V_lds + (b) * SHM_V + vst1) = sr_[i].vs1; } \
    if (kact) { const int kc = sc * 2; *(bf16x8*)(K_lds + (b) * SHM_K + KSWZ(sr, kc)) = sr_[i].ks0; *(bf16x8*)(K_lds + (b) * SHM_K + KSWZ(32 + sr, kc)) = sr_[i].ks1; } } while (0)
#define RESC(a) do { if (__any((a) < 1.f)) { if (hi == 0) al_l[r32] = (a); asm volatile("s_waitcnt lgkmcnt(0)" ::: "memory"); \
    _Pragma("unroll") for (int d = 0; d < DV / 32; ++d) _Pragma("unroll") for (int r = 0; r < 16; ++r) o[d][r] *= al_l[crow(r, hi)]; } } while (0)
#define MASK(P0, P1, j) do { if (MODE == 1 && (j) >= 4) { const int kb_ = lat0 + ((j) - 4) * 64 + 4 * hi - (q0lat + wid * QBLK + r32); \
    _Pragma("unroll") for (int r = 0; r < 16; ++r) { const int dk_ = kb_ + (r & 3) + 8 * (r >> 2); if (dk_ > 128 || dk_ < -128) P0[r] = -1e30f; if (dk_ + 32 > 128 || dk_ + 32 < -128) P1[r] = -1e30f; } } } while (0)
  f32x16 pA0, pA1, pB0, pB1; float mnA, mnB, alA, alB; bf16x8 pa0, pa1, pa2, pa3;
  SLOAD(0, 0); asm volatile("s_waitcnt vmcnt(0)" ::: "memory"); SWRITE(0, 0); __syncthreads();
  qkt<DQK>(pA0, pA1, K_lds, qr, r32, hi); MASK(pA0, pA1, 0); partialSM(pA0, pA1, m_reg, mnA, alA, C, thr_s);
  SLOAD(1, 1); if (2 < NT) SLOAD(0, 2);
  asm volatile("s_waitcnt vmcnt(4)" ::: "memory"); SWRITE(1, 1); __syncthreads();
  for (int j = 1; j + 1 < NT; j += 2) {
    SBAR(); qkt<DQK>(pB0, pB1, K_lds + SHM_K, qr, r32, hi); MASK(pB0, pB1, j);
    finishSM(pA0, pA1, alA, l_reg, pa0, pa1, pa2, pa3); SBAR();
    SLOAD(1, j + 2); SBAR();
    pv_all<DV>(o, vb0, pa0, pa1, pa2, pa3); partialSM(pB0, pB1, m_reg, mnB, alB, C, thr_s);
    __syncthreads(); asm volatile("s_waitcnt vmcnt(4)" ::: "memory"); SWRITE(0, 0);
    RESC(alB); __syncthreads();
    SBAR(); qkt<DQK>(pA0, pA1, K_lds, qr, r32, hi); MASK(pA0, pA1, j + 1);
    finishSM(pB0, pB1, alB, l_reg, pa0, pa1, pa2, pa3); SBAR();
    if (j + 3 < NT) SLOAD(0, j + 3); SBAR();
    pv_all<DV>(o, vb0 + (int)SHM_V, pa0, pa1, pa2, pa3); partialSM(pA0, pA1, m_reg, mnA, alA, C, thr_s);
    __syncthreads(); asm volatile("s_waitcnt vmcnt(4)" ::: "memory"); SWRITE(1, 1);
    RESC(alA); __syncthreads();
  }
  SBAR(); qkt<DQK>(pB0, pB1, K_lds + SHM_K, qr, r32, hi); MASK(pB0, pB1, NT - 1);
  finishSM(pA0, pA1, alA, l_reg, pa0, pa1, pa2, pa3); SBAR();
  pv_all<DV>(o, vb0, pa0, pa1, pa2, pa3); partialSM(pB0, pB1, m_reg, mnB, alB, C, thr_s);
  __syncthreads(); RESC(alB);
  finishSM(pB0, pB1, alB, l_reg, pa0, pa1, pa2, pa3); SBAR();
  pv_all<DV>(o, vb0 + (int)SHM_V, pa0, pa1, pa2, pa3);
  if (sinkl2 > -1e29f) l_reg += __builtin_amdgcn_exp2f(sinkl2 - m_reg * C);
  if (hi == 0) li_l[r32] = l_reg; asm volatile("s_waitcnt lgkmcnt(0)" ::: "memory");
  float rli[16];
#pragma unroll
  for (int r = 0; r < 16; ++r) rli[r] = __builtin_amdgcn_rcpf(li_l[crow(r, hi)]);
  if constexpr (OUTMODE == 0) {
  unsigned short* Ow = Ob + (long)(wid * QBLK) * ldo;
#pragma unroll
  for (int r = 0; r < 16; ++r) { const int orow = crow(r, hi);
#pragma unroll
    for (int d0 = 0; d0 < DV / 32; ++d0) Ow[(long)orow * ldo + d0 * 32 + r32] = (unsigned short)f2bf(o[d0][r] * rli[r]); }
  } else {   int zo_ = 0; asm volatile("" : "+v"(zo_)); const int lane = (int)__builtin_amdgcn_mbcnt_hi(~0u, __builtin_amdgcn_mbcnt_lo(~0u, (unsigned)zo_)), r32 = lane & 31, hi = lane >> 5;
    unsigned short* stg = (unsigned short*)(lds + SHM_ATTN) + wid * 4096;
    if constexpr (OUTMODE == 1) {
#pragma unroll
      for (int d0 = 0; d0 < DV / 32; ++d0)
#pragma unroll
        for (int r = 0; r < 16; ++r) stg[(d0 * 16 + r) * 64 + lane] = (unsigned short)f2bf(o[d0][r] * rli[r]);
    } else {
      unsigned short* Ow = Ob + (long)(wid * QBLK) * ldo;
#pragma unroll
      for (int r = 0; r < 16; ++r) { float v[DV / 32]; float ss = 0.f;
#pragma unroll
        for (int d0 = 0; d0 < DV / 32; ++d0) { v[d0] = bf2f(stg[(d0 * 16 + r) * 64 + lane]) - lam * (o[d0][r] * rli[r]); ss += v[d0] * v[d0]; }
        ss += __shfl_xor(ss, 1); ss += __shfl_xor(ss, 2); ss += __shfl_xor(ss, 4); ss += __shfl_xor(ss, 8); ss += __shfl_xor(ss, 16);
        const float rs = nscale / sqrtf(ss * (1.f / (float)DV) + 1e-6f); const int orow = crow(r, hi);
#pragma unroll
        for (int d0 = 0; d0 < DV / 32; ++d0) Ow[(long)orow * ldo + d0 * 32 + r32] = (unsigned short)f2bf(v[d0] * rs * nw[d0 * 32 + r32]);
        __builtin_amdgcn_sched_barrier(0); }
    }
  }
  __syncthreads();
#undef TROW
#undef SLOAD
#undef SWRITE
#undef RESC
#undef MASK
}
#undef KSWZ
#undef SBAR
}
struct Args { const float* in[32]; float* out; unsigned char* ws; int ph_lo, ph_hi; };
struct Frame {
    LAS unsigned char* lds; char* ldsg;
    volatile LAS unsigned* MISC;
    gu32* ctl;
    int tid, lane, wave, vcu, G, gw, NGW;
    const float* const* in; float* out; unsigned char* ws;
};
enum { I_X = 0, I_C, I_CTX, I_CCTX, I_EMODW, I_EMODB, I_ENORMS, I_EWIN, I_ECONV, I_EALOG, I_EDTB, I_EGDNN, I_ESINK, I_EWOUT, I_EFG, I_EFU, I_EFD,
       I_OMODW, I_OMODB, I_ONORMS, I_OWIN, I_OQN, I_OKVN, I_OWUQ, I_OWUKV, I_OLAM, I_OSUBLN, I_OWOUT, I_OROUTER, I_OXG, I_OXU, I_OXD };

__device__ __forceinline__ void tr_load(float (&v)[32], const float* W, int N, int k0, int n0, const float* kscale, int lane) {
#pragma unroll
    for (int i = 0; i < 32; ++i) { const int kk = 2 * i + (lane >> 5); v[i] = W[(size_t)(k0 + kk) * N + n0 + (lane & 31)]; if (kscale) v[i] *= kscale[k0 + kk]; }
}
__device__ __forceinline__ void tr_store(const float (&v)[32], bf16* WT, int ldk, int k0, int drow0, LAS float* scr, int lane) {
#pragma unroll
    for (int i = 0; i < 32; ++i) scr[(2 * i + (lane >> 5)) * 33 + (lane & 31)] = v[i];
    LDS_WAIT(); asm volatile("" ::: "memory");
    const int c = lane & 7;
#pragma unroll
    for (int j = 0; j < 4; ++j) { const int n = (lane >> 3) + 8 * j; const LAS float* s = scr + (8 * c) * 33 + n;
        v4u o; o.x = pk2(s[0 * 33], s[1 * 33]); o.y = pk2(s[2 * 33], s[3 * 33]); o.z = pk2(s[4 * 33], s[5 * 33]); o.w = pk2(s[6 * 33], s[7 * 33]);
        *(GAS v4u*)(WT + (size_t)(drow0 + n) * ldk + k0 + 8 * c) = o; }
    LDS_WAIT(); asm volatile("" ::: "memory");
}
template <int MAP> __device__ __forceinline__ void transpose_job(Frame& F, const float* W, int K, int N, bf16* WT, const float* kscale, int first, int stride, LAS unsigned char* scrb) {
    LAS float* scr = (LAS float*)scrb;
    const int nblk = N / 32, items = (K / 64) * nblk;
    float vn[32];
    if (first < items) tr_load(vn, W, N, 64 * (first / nblk), 32 * (first % nblk), kscale, F.lane);
    for (int it = first; it < items; it += stride) { const int kb = it / nblk, nb = it % nblk, n0 = 32 * nb;
        const int drow0 = (MAP == 0) ? n0 : ((n0 >> 7) * 256 + (n0 & 127) + (MAP == 2 ? 128 : 0));
        float vc[32];
#pragma unroll
        for (int i = 0; i < 32; ++i) vc[i] = vn[i];
        const int nx = it + stride; if (nx < items) tr_load(vn, W, N, 64 * (nx / nblk), 32 * (nx % nblk), kscale, F.lane);
        tr_store(vc, WT, K, 64 * kb, drow0, scr, F.lane); }
}
__device__ __forceinline__ void zero_rows(Frame& F, bf16* WT, int row0, int nrows, int K) {
    const size_t n16 = (size_t)nrows * K / 8; GAS v4u* p = (GAS v4u*)(WT + (size_t)row0 * K);
    for (size_t i = (size_t)F.gw * 64 + F.lane; i < n16; i += (size_t)F.NGW * 64) p[i] = (v4u){0u, 0u, 0u, 0u};
}
__device__ __forceinline__ void modv_items(Frame& F) {
    LAS float* sc = (LAS float*)(F.lds + RING_OFF);
    LAS float* part = (LAS float*)(F.lds + RING_OFF + 20480);
    float* MODV = (float*)(F.ws + WS_MODV);
    const int nitems = 2 * 96;
    if ((int)blockIdx.x >= nitems) return;
    for (int i = F.tid; i < 5 * 1024; i += 512) { const int r = i >> 10, k = i & 1023; const float v = (r < 4) ? F.in[I_C][r * 1024 + k] : F.in[I_CCTX][k]; sc[i] = siluf(v); }
    __syncthreads();
    for (int it = blockIdx.x; it < nitems; it += F.G) {
        const int l = it / 96, n0 = (it % 96) * 64, col = F.tid & 63, ks = F.tid >> 6;
        const float* W = F.in[l ? I_OMODW : I_EMODW] + (size_t)(ks * 128) * 6144 + n0 + col;
        float a0 = 0, a1 = 0, a2 = 0, a3 = 0, a4 = 0;
#pragma unroll 8
        for (int k = 0; k < 128; ++k) { const float w = W[(size_t)k * 6144]; const int kk = ks * 128 + k;
            a0 += sc[kk] * w; a1 += sc[1024 + kk] * w; a2 += sc[2048 + kk] * w; a3 += sc[3072 + kk] * w; a4 += sc[4096 + kk] * w; }
        part[(ks * 5 + 0) * 64 + col] = a0; part[(ks * 5 + 1) * 64 + col] = a1; part[(ks * 5 + 2) * 64 + col] = a2; part[(ks * 5 + 3) * 64 + col] = a3; part[(ks * 5 + 4) * 64 + col] = a4;
        __syncthreads();
        if (F.tid < 320) { const int r = F.tid >> 6, c2 = F.tid & 63; float s = F.in[l ? I_OMODB : I_EMODB][n0 + c2];
#pragma unroll
            for (int q = 0; q < 8; ++q) s += part[(q * 5 + r) * 64 + c2];
            MODV[(size_t)(l * 5 + r) * 6144 + n0 + c2] = s; }
        __syncthreads();
    }
}
__device__ __forceinline__ const float* modvec(Frame& F, int l, int mr, int k) { return (const float*)(F.ws + WS_MODV) + (size_t)((l * 5 + mr) * 6 + k) * 1024; }

struct Row4 { f32x4 v[4]; };
__device__ __forceinline__ Row4 ld_row_f32(const float* p, int lane) { Row4 r; const GAS f32x4* q = (const GAS f32x4*)p + lane;
#pragma unroll
    for (int j = 0; j < 4; ++j) r.v[j] = q[64 * j]; return r; }
__device__ __forceinline__ Row4 ld_row_bf16(const bf16* p, int lane) { Row4 r; const GAS v2u* q = (const GAS v2u*)p + lane;
#pragma unroll
    for (int j = 0; j < 4; ++j) { const v2u w = q[64 * j]; r.v[j] = (f32x4){bflo(w.x), bfhi(w.x), bflo(w.y), bfhi(w.y)}; } return r; }
__device__ __forceinline__ void st_row_f32(float* p, int lane, const Row4& r) { GAS f32x4* q = (GAS f32x4*)p + lane;
#pragma unroll
    for (int j = 0; j < 4; ++j) q[64 * j] = r.v[j]; }
__device__ __forceinline__ void st_row_bf16(bf16* p, int lane, const Row4& r) { GAS v2u* q = (GAS v2u*)p + lane;
#pragma unroll
    for (int j = 0; j < 4; ++j) q[64 * j] = (v2u){pk2(r.v[j].x, r.v[j].y), pk2(r.v[j].z, r.v[j].w)}; }
__device__ __forceinline__ float row_rstd(const Row4& r) { float s = 0.f;
#pragma unroll
    for (int j = 0; j < 4; ++j) s += (r.v[j].x * r.v[j].x + r.v[j].y * r.v[j].y) + (r.v[j].z * r.v[j].z + r.v[j].w * r.v[j].w);
    return 1.f / sqrtf(wave_sum(s) * (1.f / 1024.f) + EPS); }
__device__ __forceinline__ float* xres_ptr(Frame& F, int r, int& mr) { const int b = r / SROW, s = r - b * SROW;
    if (s < TC) { mr = 4; return (float*)(F.ws + WS_HCTX) + (size_t)(b * TC + s) * D; }
    mr = b; return F.out + (size_t)(b * T + s - TC) * D; }
__device__ __forceinline__ Row4 norm_mod(const Row4& x, const float* w, const float* shift, const float* scale, int lane) {
    const float rs = row_rstd(x); const Row4 W = ld_row_f32(w, lane), SH = ld_row_f32(shift, lane), SC = ld_row_f32(scale, lane); Row4 a;
#pragma unroll
    for (int j = 0; j < 4; ++j) a.v[j] = (x.v[j] * rs * W.v[j]) * (SC.v[j] + 1.f) + SH.v[j];
    return a; }
__device__ __forceinline__ Row4 norm_mod_r(const Row4& x, const Row4& W, const Row4& SH, const Row4& SC) {
    const float rs = row_rstd(x); Row4 a;
#pragma unroll
    for (int j = 0; j < 4; ++j) a.v[j] = (x.v[j] * rs * W.v[j]) * (SC.v[j] + 1.f) + SH.v[j];
    return a; }
__device__ __forceinline__ void add_gated_norm_r(Row4& x, const Row4& y, const Row4& W, const Row4& G) {
    const float rs = row_rstd(y);
#pragma unroll
    for (int j = 0; j < 4; ++j) x.v[j] = x.v[j] + G.v[j] * (y.v[j] * rs * W.v[j]); }
__device__ __forceinline__ int tok_vcu(const Frame& F, int b, int t) { const int wpb = F.NGW >> 2; return (b * wpb + t % wpb) >> 3; }
__device__ __forceinline__ void add_gated_norm(Row4& x, const Row4& y, const float* w, const float* gate, int lane) {
    const float rs = row_rstd(y); const Row4 W = ld_row_f32(w, lane), G = ld_row_f32(gate, lane);
#pragma unroll
    for (int j = 0; j < 4; ++j) x.v[j] = x.v[j] + G.v[j] * (y.v[j] * rs * W.v[j]); }
__device__ __forceinline__ void p0_prologue(Frame& F) {
    modv_items(F);
    __syncthreads();
    transpose_job<0>(F, F.in[I_EWIN], 1024, EIN, (bf16*)(F.ws + WS_WEIN), nullptr, F.gw, F.NGW, F.lds + RING_OFF + F.wave * 16384);
    zero_rows(F, (bf16*)(F.ws + WS_WEIN), EIN, EINP - EIN, 1024);
}
__device__ __forceinline__ void p0_deferred(Frame& F, int w4, LAS unsigned char* scr) {
    const float* const* in = F.in; unsigned char* ws = F.ws; const int gw = F.vcu * 4 + w4, N = F.G * 4;
    transpose_job<0>(F, in[I_EWOUT], 1024, 1024, (bf16*)(ws + WS_WEOUT), nullptr, gw, N, scr);
    transpose_job<1>(F, in[I_EFG], 1024, DFF, (bf16*)(ws + WS_WEGU), nullptr, (gw + 512) % N, N, scr);
    transpose_job<2>(F, in[I_EFU], 1024, DFF, (bf16*)(ws + WS_WEGU), nullptr, (gw + 896) % N, N, scr);
    transpose_job<0>(F, in[I_EFD], DFF, 1024, (bf16*)(ws + WS_WEDN), nullptr, (gw + 256) % N, N, scr);
    transpose_job<0>(F, in[I_OWIN], 1024, OIN, (bf16*)(ws + WS_WOIN), nullptr, (gw + 640) % N, N, scr);
    transpose_job<0>(F, in[I_OWUQ], 384, 768, (bf16*)(ws + WS_WUQ), in[I_OQN], (gw + 720) % N, N, scr);
    transpose_job<0>(F, in[I_OWUKV], 256, 1024, (bf16*)(ws + WS_WUKV), in[I_OKVN], (gw + 864) % N, N, scr);
    transpose_job<0>(F, in[I_OWOUT], 1024, 1024, (bf16*)(ws + WS_WOOUT), nullptr, (gw + 992) % N, N, scr);
    { const size_t n16 = (size_t)(OINP - OIN) * 1024 / 8; GAS v4u* p = (GAS v4u*)((bf16*)(ws + WS_WOIN) + (size_t)OIN * 1024);
      for (size_t i = (size_t)gw * 64 + F.lane; i < n16; i += (size_t)N * 64) p[i] = (v4u){0u, 0u, 0u, 0u}; }
}
__device__ __forceinline__ void px_expert_weights(Frame& F) {
    for (int e = 0; e < NEXP; ++e) {
        transpose_job<1>(F, F.in[I_OXG] + (size_t)e * 1024 * DFX, 1024, DFX, (bf16*)(F.ws + WS_WXGU) + (size_t)e * 7168 * 1024, nullptr, (F.gw + e * 448) % F.NGW, F.NGW, F.lds + RING_OFF + F.wave * 8448);
        transpose_job<2>(F, F.in[I_OXU] + (size_t)e * 1024 * DFX, 1024, DFX, (bf16*)(F.ws + WS_WXGU) + (size_t)e * 7168 * 1024, nullptr, (F.gw + e * 448 + 224) % F.NGW, F.NGW, F.lds + RING_OFF + F.wave * 8448);
    }
}
__device__ __forceinline__ void px_expert_down(Frame& F, int wk, int nwk) {
    for (int e = 0; e < NEXP; ++e)
        transpose_job<0>(F, F.in[I_OXD] + (size_t)e * DFX * 1024, DFX, 1024, (bf16*)(F.ws + WS_WXDN) + (size_t)e * 1024 * DFX, nullptr, (wk + e * 448 + 112) % nwk, nwk, F.lds + RING_OFF + F.wave * 8448);
}
__device__ __forceinline__ void p1_first_rows(Frame& F) {
    bf16* A = (bf16*)(F.ws + WS_ABUF); const float* w0 = F.in[I_ENORMS]; const int wpb = F.NGW >> 2, b = F.gw / wpb, wl = F.gw - b * wpb;
    { const Row4 W = ld_row_f32(w0, F.lane), SH = ld_row_f32(modvec(F, 0, b, 0), F.lane), SC = ld_row_f32(modvec(F, 0, b, 1), F.lane);
      for (int t = wl; t < T; t += wpb) { const size_t tk = (size_t)b * T + t; const Row4 x = ld_row_f32(F.in[I_X] + tk * D, F.lane); st_row_bf16((bf16*)(F.ws + WS_XB) + tk * D, F.lane, x);
          const Row4 a = norm_mod_r(x, W, SH, SC); st_row_bf16(A + ((size_t)b * SROW + TC + t) * D, F.lane, a); } }
    for (int c = F.gw; c < NB * TC; c += F.NGW) { const int cb = c / TC, s = c - cb * TC;
        const Row4 x = ld_row_f32(F.in[I_CTX] + (size_t)c * D, F.lane); st_row_f32((float*)(F.ws + WS_HCTX) + (size_t)c * D, F.lane, x);
        const Row4 a = norm_mod(x, w0, modvec(F, 0, 4, 0), modvec(F, 0, 4, 1), F.lane); st_row_bf16(A + ((size_t)cb * SROW + s) * D, F.lane, a); }
}
constexpr int ROUTER_TAB_OFF = 69632;
__device__ __forceinline__ void router_table(Frame& F) {
    LAS f32x4* tab = (LAS f32x4*)(F.lds + RING_OFF + ROUTER_TAB_OFF); const float* Rw = F.in[I_OROUTER];
    for (int i = F.tid; i < 2048; i += 512) { const int ln = i & 63, h = (i >> 6) & 1, q = (i >> 7) & 3, j = i >> 9; tab[i] = *(const GAS f32x4*)(Rw + (size_t)(4 * ln + 256 * j + q) * 8 + 4 * h); }
    __syncthreads();
}
template <bool ROUTER> __device__ __forceinline__ void rows_mid(Frame& F, const bf16* Y, const float* wy, int lg, int kg, const float* w2, int l2, int ks2, bf16* Aout, bool lat_only, int nsl = 0) {
    const int wpb = F.NGW >> 2, b = F.gw / wpb, wl = F.gw - b * wpb;
    { const Row4 Wy = ld_row_f32(wy, F.lane), Gt = ld_row_f32(modvec(F, lg, b, kg), F.lane), W2 = ld_row_f32(w2, F.lane), SH = ld_row_f32(modvec(F, l2, b, ks2), F.lane), SC = ld_row_f32(modvec(F, l2, b, ks2 + 1), F.lane);
      for (int t = wl; t < T; t += wpb) { const size_t tk = (size_t)b * T + t, r = (size_t)b * SROW + TC + t; bf16* xr = (bf16*)(F.ws + WS_XB) + tk * D;
        Row4 x = ld_row_bf16(xr, F.lane); const Row4 y = ld_row_bf16(Y + r * D, F.lane);
        add_gated_norm_r(x, y, Wy, Gt); st_row_bf16(xr, F.lane, x);
        const Row4 a = norm_mod_r(x, W2, SH, SC);
        st_row_bf16(Aout + r * D, F.lane, a);
        if constexpr (ROUTER) {
            LAS const f32x4* Rt = (LAS const f32x4*)(F.lds + RING_OFF + ROUTER_TAB_OFF) + F.lane; float lg8[8];
#pragma unroll
            for (int e = 0; e < 8; ++e) lg8[e] = 0.f;
#pragma unroll
            for (int j = 0; j < 4; ++j)
#pragma unroll
                for (int q = 0; q < 4; ++q) { const f32x4 r0 = Rt[((j * 4 + q) * 2 + 0) * 64], r1 = Rt[((j * 4 + q) * 2 + 1) * 64]; const float av = a.v[j][q];
                    lg8[0] += av * r0.x; lg8[1] += av * r0.y; lg8[2] += av * r0.z; lg8[3] += av * r0.w; lg8[4] += av * r1.x; lg8[5] += av * r1.y; lg8[6] += av * r1.z; lg8[7] += av * r1.w; }
#pragma unroll
            for (int e = 0; e < 8; ++e) lg8[e] = wave_sum(lg8[e]);
            int i0 = 0; float v0 = lg8[0];
#pragma unroll
            for (int e = 1; e < 8; ++e) if (lg8[e] > v0) { v0 = lg8[e]; i0 = e; }
            int i1 = -1; float v1 = -3.0e38f;
#pragma unroll
            for (int e = 0; e < 8; ++e) if (e != i0 && lg8[e] > v1) { v1 = lg8[e]; i1 = e; }
            const float e1 = __expf(v1 - v0), w0 = 1.f / (1.f + e1), w1 = e1 * w0;
            if (F.lane == 0) {
                int* TOPI = (int*)(F.ws + WS_META + META_TOPI); float* TOPW = (float*)(F.ws + WS_META + META_TOPW); int* RANK = (int*)(F.ws + WS_META + META_RANK);
                TOPI[tk * 2] = i0; TOPI[tk * 2 + 1] = i1; TOPW[tk * 2] = w0; TOPW[tk * 2 + 1] = w1;
                RANK[tk * 2] = (int)__hip_atomic_fetch_add((LAS unsigned*)(F.MISC + 24 + i0), 1u, __ATOMIC_RELAXED, __HIP_MEMORY_SCOPE_WORKGROUP);
                RANK[tk * 2 + 1] = (int)__hip_atomic_fetch_add((LAS unsigned*)(F.MISC + 24 + i1), 1u, __ATOMIC_RELAXED, __HIP_MEMORY_SCOPE_WORKGROUP); }
        } } }
    if (!lat_only) for (int c = F.gw; c < NB * TC; c += F.NGW) { const int cb = c / TC, s = c - cb * TC; const size_t r = (size_t)cb * SROW + s; float* xr = (float*)(F.ws + WS_HCTX) + (size_t)c * D;
        Row4 x = ld_row_f32(xr, F.lane); Row4 y;
        if (nsl > 0) {
            const float* pp = (const float*)(F.ws + WS_PART) + (size_t)c * 1024; y = ld_row_f32(pp, F.lane);
            for (int q = 1; q < nsl; ++q) { const Row4 t = ld_row_f32(pp + (size_t)q * 1024 * 1024, F.lane);
#pragma unroll
                for (int j = 0; j < 4; ++j) y.v[j] = y.v[j] + t.v[j]; } }
        else y = ld_row_bf16(Y + r * D, F.lane);
        add_gated_norm(x, y, wy, modvec(F, lg, 4, kg), F.lane); st_row_f32(xr, F.lane, x);
        const Row4 a = norm_mod(x, w2, modvec(F, l2, 4, ks2), modvec(F, l2, 4, ks2 + 1), F.lane);
        st_row_bf16(Aout + r * D, F.lane, a); }
}
__device__ __forceinline__ void router_tail(Frame& F) {
    {
        __syncthreads();
        if (F.tid < 8) { ((int*)(F.ws + WS_META + META_BLKB))[F.vcu * 8 + F.tid] = (int)__hip_atomic_fetch_add((unsigned*)(F.ctl + CW_MOECNT + 64 * F.tid), F.MISC[24 + F.tid], RLX_AGENT); F.MISC[24 + F.tid] = 0u; }
    }
}
__device__ __forceinline__ void g0_prep(Frame& F) {
    const bf16* P = (const bf16*)(F.ws + WS_PROJ); bf16* PW = (bf16*)(F.ws + WS_PROJ); bf16* QK = (bf16*)(F.ws + WS_QKVN); float* GB = (float*)(F.ws + WS_GB);
    const float* cw = F.in[I_ECONV]; const int lane = F.lane;
#pragma unroll 1
    for (int part = 0; part < 3; ++part) { const int ch = part * 512 + 8 * lane; float w[5][8];
#pragma unroll
        for (int j = 0; j < 5; ++j) { const f32x4 w0 = *(const GAS f32x4*)(cw + j * 1536 + ch), w1 = *(const GAS f32x4*)(cw + j * 1536 + ch + 4); w[j][0] = w0.x; w[j][1] = w0.y; w[j][2] = w0.z; w[j][3] = w0.w; w[j][4] = w1.x; w[j][5] = w1.y; w[j][6] = w1.z; w[j][7] = w1.w; }
        v4u tn[5];
#define G0_TAPS(dst, r_) do { const int b_ = (r_) / SROW, s_ = (r_) - b_ * SROW; const bool c_ = s_ < TC; const int p_ = c_ ? s_ : s_ - TC, len_ = c_ ? TC : T; \
            _Pragma("unroll") for (int j = 0; j < 5; ++j) { const int pp = p_ + j - 2; dst[j] = (pp >= 0 && pp < len_) ? *(const GAS v4u*)(P + (size_t)((r_) + j - 2) * EINP + ch) : (v4u){0u, 0u, 0u, 0u}; } } while (0)
        if (F.gw < NR) G0_TAPS(tn, F.gw);
        for (int r = F.gw; r < NR; r += F.NGW) { v4u tc[5];
#pragma unroll
            for (int j = 0; j < 5; ++j) tc[j] = tn[j];
            if (r + F.NGW < NR) G0_TAPS(tn, r + F.NGW);
            float acc[8];
#pragma unroll
            for (int e = 0; e < 8; ++e) acc[e] = 0.f;
#pragma unroll
            for (int j = 0; j < 5; ++j) { const v4u xv = tc[j];
                acc[0] += bflo(xv.x) * w[j][0]; acc[1] += bfhi(xv.x) * w[j][1]; acc[2] += bflo(xv.y) * w[j][2]; acc[3] += bfhi(xv.y) * w[j][3];
                acc[4] += bflo(xv.z) * w[j][4]; acc[5] += bfhi(xv.z) * w[j][5]; acc[6] += bflo(xv.w) * w[j][6]; acc[7] += bfhi(xv.w) * w[j][7]; }
            float ss = 0.f;
#pragma unroll
            for (int e = 0; e < 8; ++e) { acc[e] = siluf(acc[e]); ss += acc[e] * acc[e]; }
            if (part < 2) { ss += __shfl_xor(ss, 1); ss += __shfl_xor(ss, 2); ss += __shfl_xor(ss, 4); const float sc = (part == 0 ? 0.125f : 1.f) / sqrtf(ss + EPS);
#pragma unroll
                for (int e = 0; e < 8; ++e) acc[e] *= sc; }
            *(GAS v4u*)(QK + (size_t)r * 1536 + ch) = (v4u){pk2(acc[0], acc[1]), pk2(acc[2], acc[3]), pk2(acc[4], acc[5]), pk2(acc[6], acc[7])}; }
#undef G0_TAPS
    }
    for (int r = F.gw; r < NR; r += F.NGW) { const int b = r / SROW, s = r - b * SROW; const bool isc = s < TC; const int p = isc ? s : s - TC;
        if (lane < 16) { const float ga = bf2f(P[(size_t)r * EINP + E_GA + lane]), gb = bf2f(P[(size_t)r * EINP + E_GB + lane]);
            const float xx = ga + F.in[I_EDTB][lane], sp = fmaxf(xx, 0.f) + log1pf(__expf(-fabsf(xx)));
            GB[(size_t)r * 32 + lane] = -__expf(F.in[I_EALOG][lane]) * sp; GB[(size_t)r * 32 + 16 + lane] = 1.f / (1.f + __expf(-gb)); }
        if (!isc) {
            const int pi = lane & 31, seg = pi >> 4, i = pi & 15, d0 = seg * 32 + i; const float pos = (float)(seg ? (p & 63) : (p >> 6));
            const float ang = pos * __powf(10000.f, -(float)i * (1.f / 16.f)); float sn, cs; sincosf(ang, &sn, &cs);
#pragma unroll
            for (int q = 0; q < 5; ++q) { const int hh = (lane >> 5) + 2 * q; bf16* base = PW + (size_t)r * EINP + (hh < 8 ? E_SQ + hh * 64 : E_SK + (hh - 8) * 64) + d0;
                const float x0 = bf2f(base[0]), x1 = bf2f(base[16]); base[0] = (bf16)f2bf(x0 * cs - x1 * sn); base[16] = (bf16)f2bf(x1 * cs + x0 * sn); }
        }
    }
}
constexpr int GP = 65, GLP = 68;
template <int I> struct SolveRow {
    static __device__ __forceinline__ void run(float (&x)[64], const LAS float* Ls) {
        SolveRow<I - 1>::run(x, Ls);
        float a = x[I];
#pragma unroll
        for (int j = 0; j < I; ++j) a -= Ls[I * GLP + j] * x[j];
        x[I] = a;
    }
};
template <> struct SolveRow<0> { static __device__ __forceinline__ void run(float (&)[64], const LAS float*) {} };

__device__ __forceinline__ void gdn_chain(Frame& F, int chain) {
    const int b = chain >> 4, h = (chain >> 1) & 7, dir = chain & 1;
    LAS float* Ss = (LAS float*)(F.lds + RING_OFF);
    LAS float* Qs = Ss + 64 * GP, *Ks = Qs + 64 * GP, *Vs = Ks + 64 * GP  , *ATs = Vs + 64 * GP, *Ws = ATs + 64 * GP, *VNs = Ws + 64 * GP;
    LAS float* Ls = VNs + 64 * GP;
    LAS float* gcs = Ls + 64 * GLP, *bts = gcs + 64;
    const bf16* QK = (const bf16*)(F.ws + WS_QKVN); const float* GB = (const float*)(F.ws + WS_GB); bf16* OG = (bf16*)(F.ws + WS_OG);
    const int tid = F.tid, lane = F.lane, w = F.wave;
    for (int i = tid; i < 64 * GP; i += 512) Ss[i] = 0.f;
    for (int ci = 0; ci < 68; ++ci) {
        const bool isc = ci < 4; const int n0 = (isc ? ci : ci - 4) * 64; const int rbase = b * SROW + (isc ? 0 : TC), len = isc ? TC : T;
        __syncthreads();
        for (int e = tid; e < 64 * 24; e += 512) { const int i = e / 24, c8 = e % 24, part = c8 >> 3, cc = (c8 & 7) * 8; const int n = n0 + i, row = rbase + (dir ? len - 1 - n : n);
            const v4u xv = *(const GAS v4u*)(QK + (size_t)row * 1536 + part * 512 + h * 64 + cc); LAS float* dst = (part == 0 ? Qs : part == 1 ? Ks : Vs) + i * GP + cc;
            dst[0] = bflo(xv.x); dst[1] = bfhi(xv.x); dst[2] = bflo(xv.y); dst[3] = bfhi(xv.y); dst[4] = bflo(xv.z); dst[5] = bfhi(xv.z); dst[6] = bflo(xv.w); dst[7] = bfhi(xv.w); }
        if (tid < 64) { const int n = n0 + tid, row = rbase + (dir ? len - 1 - n : n); float g = GB[(size_t)row * 32 + dir * 8 + h]; bts[tid] = GB[(size_t)row * 32 + 16 + dir * 8 + h];
#pragma unroll
            for (int o = 1; o < 64; o <<= 1) { const float t = __shfl_up(g, o); if (lane >= o) g += t; }
            gcs[tid] = g; }
        __syncthreads();
#pragma unroll 1
        for (int k = 0; k < 8; ++k) { const int i = w + 8 * k, j = lane; float kk = 0.f, qk = 0.f;
#pragma unroll 16
            for (int d = 0; d < 64; ++d) { const float kj = Ks[j * GP + d]; kk += Ks[i * GP + d] * kj; qk += Qs[i * GP + d] * kj; }
            const float dec = (j <= i) ? __expf(gcs[i] - gcs[j]) : 0.f;
            Ls[i * GLP + j] = (j < i) ? bts[i] * kk * dec : 0.f; ATs[i * GP + j] = qk * dec; }
        __syncthreads();
        if (tid < 128) { float x[64]; const int c = tid & 63; const bool isw = tid >= 64; int zz = 0; asm volatile("" : "+v"(zz));
            const LAS float* src = (isw ? Ks : Vs) + c; const LAS float* btz = bts + zz; const LAS float* gcz = gcs + zz;
#pragma unroll
            for (int i = 0; i < 64; ++i) { const float e = isw ? __expf(gcz[i]) : 1.f; x[i] = src[i * GP] * btz[i] * e; }
            SolveRow<63>::run(x, Ls + zz);
            LAS float* dst = isw ? Ws : Vs;
#pragma unroll
            for (int i = 0; i < 64; ++i) dst[i * GP + c] = x[i]; }
        __syncthreads();
#pragma unroll 1
        for (int k = 0; k < 8; ++k) { const int i = w + 8 * k, d = lane; float a = Vs[i * GP + d];
#pragma unroll 16
            for (int q = 0; q < 64; ++q) a -= Ws[i * GP + q] * Ss[q * GP + d];
            VNs[i * GP + d] = a; }
        __syncthreads();
#pragma unroll 1
        for (int k = 0; k < 8; ++k) { const int i = w + 8 * k, d = lane; float a = 0.f, c2 = 0.f;
#pragma unroll 16
            for (int q = 0; q < 64; ++q) { a += Qs[i * GP + q] * Ss[q * GP + d]; c2 += ATs[i * GP + q] * VNs[q * GP + d]; }
            const int n = n0 + i, row = rbase + (dir ? len - 1 - n : n);
            OG[(size_t)row * 1024 + dir * 512 + h * 64 + d] = (bf16)f2bf(a * __expf(gcs[i]) + c2); }
        __syncthreads();
        const float gl = gcs[63];
#pragma unroll 1
        for (int k = 0; k < 8; ++k) { const int a = w + 8 * k, d = lane; float acc = Ss[a * GP + d] * __expf(gl);
#pragma unroll 16
            for (int i = 0; i < 64; ++i) acc += Ks[i * GP + a] * __expf(gl - gcs[i]) * VNs[i * GP + d];
            Ss[a * GP + d] = acc; }
    }
    __syncthreads();
}
__device__ __forceinline__ void g4_gdn_out(Frame& F) {
    const bf16* OG = (const bf16*)(F.ws + WS_OG); const bf16* P = (const bf16*)(F.ws + WS_PROJ); bf16* MIX = (bf16*)(F.ws + WS_MIX); const float* gn = F.in[I_EGDNN]; const int lane = F.lane;
    const f32x4 g0 = *(const GAS f32x4*)(gn + (lane & 7) * 8), g1 = *(const GAS f32x4*)(gn + (lane & 7) * 8 + 4);
    for (int r = F.gw; r < NR; r += F.NGW) {
        const v4u a = *(const GAS v4u*)(OG + (size_t)r * 1024 + 8 * lane), c = *(const GAS v4u*)(OG + (size_t)r * 1024 + 512 + 8 * lane), z = *(const GAS v4u*)(P + (size_t)r * EINP + E_Z + 8 * lane);
        float o[8] = {bflo(a.x) + bflo(c.x), bfhi(a.x) + bfhi(c.x), bflo(a.y) + bflo(c.y), bfhi(a.y) + bfhi(c.y), bflo(a.z) + bflo(c.z), bfhi(a.z) + bfhi(c.z), bflo(a.w) + bflo(c.w), bfhi(a.w) + bfhi(c.w)};
        float ss = 0.f;
#pragma unroll
        for (int e = 0; e < 8; ++e) ss += o[e] * o[e];
        ss += __shfl_xor(ss, 1); ss += __shfl_xor(ss, 2); ss += __shfl_xor(ss, 4);
        const float rs = 1.f / sqrtf(ss * (1.f / 64.f) + EPS);
        const float zz[8] = {bflo(z.x), bfhi(z.x), bflo(z.y), bfhi(z.y), bflo(z.z), bfhi(z.z), bflo(z.w), bfhi(z.w)};
        const float gg[8] = {g0.x, g0.y, g0.z, g0.w, g1.x, g1.y, g1.z, g1.w};
#pragma unroll
        for (int e = 0; e < 8; ++e) o[e] = o[e] * rs * gg[e] * siluf(zz[e]);
        *(GAS v4u*)(MIX + (size_t)r * 1024 + 8 * lane) = (v4u){pk2(o[0], o[1]), pk2(o[2], o[3]), pk2(o[4], o[5]), pk2(o[6], o[7])}; }
}
__device__ __forceinline__ void swa_unit(Frame& F, int u) {
    const bf16* P = (const bf16*)(F.ws + WS_PROJ); bf16* MIX = (bf16*)(F.ws + WS_MIX);
    constexpr float SC = 0.125f, C = SC * 1.4426950408889634f, THRS = att::THR / SC;
    if (u < 512) { const int b = u >> 7, qb = (u >> 3) & 15, hq = u & 7, kvh = hq >> 2; const size_t rq = (size_t)b * SROW + TC + qb * 256, r0 = (size_t)b * SROW;
        const int lat0 = qb * 256 - 128 < 0 ? 0 : qb * 256 - 128, lend = qb * 256 + 384 > T ? T : qb * 256 + 384, NT = 4 + (lend - lat0) / 64;
        att::attn_unit<64, 64, 1>(P + rq * EINP + E_SQ + hq * 64, EINP, P + r0 * EINP + E_SK + kvh * 64, EINP, P + r0 * EINP + E_SV + kvh * 64, EINP,
                                  MIX + rq * 1024 + 512 + hq * 64, 1024, NT, lat0, qb * 256, C, THRS, F.in[I_ESINK][hq] * 1.4426950408889634f, F.ldsg + RING_OFF);
    } else { const int v = u - 512, b = v >> 3, hq = v & 7, kvh = hq >> 2; const size_t r0 = (size_t)b * SROW;
        att::attn_unit<64, 64, 2>(P + r0 * EINP + E_SQ + hq * 64, EINP, P + r0 * EINP + E_SK + kvh * 64, EINP, P + r0 * EINP + E_SV + kvh * 64, EINP,
                                  MIX + r0 * 1024 + 512 + hq * 64, 1024, 4, 0, 0, C, THRS, F.in[I_ESINK][hq] * 1.4426950408889634f, F.ldsg + RING_OFF); }
}
namespace gdn {
using bf16x8 = __attribute__((ext_vector_type(8))) short;
using f32x16 = __attribute__((ext_vector_type(16))) float;
using u32x4  = __attribute__((ext_vector_type(4))) unsigned;
__device__ __forceinline__ int crow(int r, int hi) { return (r & 3) + 8 * (r >> 2) + 4 * hi; }
typedef float f32x2_t __attribute__((ext_vector_type(2))); typedef __bf16 bf16x2_t __attribute__((ext_vector_type(2)));
__device__ __forceinline__ unsigned cvtpk(float lo, float hi) { f32x2_t v = {lo, hi}; bf16x2_t b = __builtin_convertvector(v, bf16x2_t); return __builtin_bit_cast(unsigned, b); }
__device__ __forceinline__ int swap23(int p) { return (p & ~0xC) | ((p & 4) << 1) | ((p & 8) >> 1); }
typedef float f32x4g __attribute__((ext_vector_type(4)));
template <int I> struct LRow {
    static constexpr int NQ = (I + 3) / 4, O = I * 128;
    static __device__ __forceinline__ void load(f32x4g (&b)[8], unsigned la) {
        if constexpr (NQ == 1) asm volatile("ds_read_b128 %0, %1 offset:%2\n\ts_waitcnt lgkmcnt(0)" : "=&v"(b[0]) : "v"(la), "i"(O));
        else if constexpr (NQ == 2) asm volatile("ds_read_b128 %0, %2 offset:%3\n\tds_read_b128 %1, %2 offset:%4\n\ts_waitcnt lgkmcnt(0)" : "=&v"(b[0]), "=&v"(b[1]) : "v"(la), "i"(O), "i"(O + 16));
        else if constexpr (NQ == 3) asm volatile("ds_read_b128 %0, %3 offset:%4\n\tds_read_b128 %1, %3 offset:%5\n\tds_read_b128 %2, %3 offset:%6\n\ts_waitcnt lgkmcnt(0)" : "=&v"(b[0]), "=&v"(b[1]), "=&v"(b[2]) : "v"(la), "i"(O), "i"(O + 16), "i"(O + 32));
        else if constexpr (NQ == 4) asm volatile("ds_read_b128 %0, %4 offset:%5\n\tds_read_b128 %1, %4 offset:%6\n\tds_read_b128 %2, %4 offset:%7\n\tds_read_b128 %3, %4 offset:%8\n\ts_waitcnt lgkmcnt(0)" : "=&v"(b[0]), "=&v"(b[1]), "=&v"(b[2]), "=&v"(b[3]) : "v"(la), "i"(O), "i"(O + 16), "i"(O + 32), "i"(O + 48));
        else if constexpr (NQ == 5) asm volatile("ds_read_b128 %0, %5 offset:%6\n\tds_read_b128 %1, %5 offset:%7\n\tds_read_b128 %2, %5 offset:%8\n\tds_read_b128 %3, %5 offset:%9\n\tds_read_b128 %4, %5 offset:%10\n\ts_waitcnt lgkmcnt(0)" : "=&v"(b[0]), "=&v"(b[1]), "=&v"(b[2]), "=&v"(b[3]), "=&v"(b[4]) : "v"(la), "i"(O), "i"(O + 16), "i"(O + 32), "i"(O + 48), "i"(O + 64));
        else if constexpr (NQ == 6) asm volatile("ds_read_b128 %0, %6 offset:%7\n\tds_read_b128 %1, %6 offset:%8\n\tds_read_b128 %2, %6 offset:%9\n\tds_read_b128 %3, %6 offset:%10\n\tds_read_b128 %4, %6 offset:%11\n\tds_read_b128 %5, %6 offset:%12\n\ts_waitcnt lgkmcnt(0)" : "=&v"(b[0]), "=&v"(b[1]), "=&v"(b[2]), "=&v"(b[3]), "=&v"(b[4]), "=&v"(b[5]) : "v"(la), "i"(O), "i"(O + 16), "i"(O + 32), "i"(O + 48), "i"(O + 64), "i"(O + 80));
        else if constexpr (NQ == 7) asm volatile("ds_read_b128 %0, %7 offset:%8\n\tds_read_b128 %1, %7 offset:%9\n\tds_read_b128 %2, %7 offset:%10\n\tds_read_b128 %3, %7 offset:%11\n\tds_read_b128 %4, %7 offset:%12\n\tds_read_b128 %5, %7 offset:%13\n\tds_read_b128 %6, %7 offset:%14\n\ts_waitcnt lgkmcnt(0)" : "=&v"(b[0]), "=&v"(b[1]), "=&v"(b[2]), "=&v"(b[3]), "=&v"(b[4]), "=&v"(b[5]), "=&v"(b[6]) : "v"(la), "i"(O), "i"(O + 16), "i"(O + 32), "i"(O + 48), "i"(O + 64), "i"(O + 80), "i"(O + 96));
        else asm volatile("ds_read_b128 %0, %8 offset:%9\n\tds_read_b128 %1, %8 offset:%10\n\tds_read_b128 %2, %8 offset:%11\n\tds_read_b128 %3, %8 offset:%12\n\tds_read_b128 %4, %8 offset:%13\n\tds_read_b128 %5, %8 offset:%14\n\tds_read_b128 %6, %8 offset:%15\n\tds_read_b128 %7, %8 offset:%16\n\ts_waitcnt lgkmcnt(0)" : "=&v"(b[0]), "=&v"(b[1]), "=&v"(b[2]), "=&v"(b[3]), "=&v"(b[4]), "=&v"(b[5]), "=&v"(b[6]), "=&v"(b[7]) : "v"(la), "i"(O), "i"(O + 16), "i"(O + 32), "i"(O + 48), "i"(O + 64), "i"(O + 80), "i"(O + 96), "i"(O + 112));
    }
};
template <int I> struct Solve32 {
    static __device__ __forceinline__ void run(float (&x)[32], unsigned la) {
#ifdef SOLVE_C_LOAD
        f32x4g b[8]; { const LAS f32x4g* Lp = (const LAS f32x4g*)(uintptr_t)(la + I * 128);
#pragma unroll
          for (int q = 0; q < (I + 3) / 4; ++q) b[q] = Lp[q]; }
#else
        f32x4g b[8]; LRow<I>::load(b, la);
#endif
        float a = x[I];
#pragma unroll
#ifdef SOLVE_C_FMA
        for (int j = 0; j < I; ++j) a = __builtin_fmaf(-b[j >> 2][j & 3], x[j], a);
#else
        for (int j = 0; j < I; ++j) asm volatile("v_fma_f32 %0, -%1, %2, %0" : "+v"(a) : "v"(b[j >> 2][j & 3]), "v"(x[j]));
#endif
        x[I] = a;
        if constexpr (I < 31) Solve32<I + 1>::run(x, la);
    }
};
__device__ __forceinline__ void solve32(float (&x)[32], unsigned la) { Solve32<1>::run(x, la); }
__device__ __forceinline__ void col_frags32(const float (&x)[32], bf16x8 (&F)[4][2], int s0) {
#pragma unroll
    for (int s = 0; s < 2; ++s) {
        const unsigned p0[4] = {cvtpk(x[16 * s + 0], x[16 * s + 1]), cvtpk(x[16 * s + 2], x[16 * s + 3]), cvtpk(x[16 * s + 8], x[16 * s + 9]), cvtpk(x[16 * s + 10], x[16 * s + 11])};
        const unsigned p1[4] = {cvtpk(x[16 * s + 4], x[16 * s + 5]), cvtpk(x[16 * s + 6], x[16 * s + 7]), cvtpk(x[16 * s + 12], x[16 * s + 13]), cvtpk(x[16 * s + 14], x[16 * s + 15])};
        u32x4 f0, f1;
#pragma unroll
        for (int q = 0; q < 4; ++q) { auto r = __builtin_amdgcn_permlane32_swap(p0[q], p1[q], false, false); f0[q] = r[0]; f1[q] = r[1]; }
        F[s0 + s][0] = __builtin_bit_cast(bf16x8, f0); F[s0 + s][1] = __builtin_bit_cast(bf16x8, f1); }
}
__device__ __forceinline__ void solve_blocked(float (&x1)[32], float (&x2)[32], unsigned la, const bf16x8 (&L21A)[2], bf16x8 (&F)[4][2]) {
    solve32(x1, la);
    col_frags32(x1, F, 0);
    f32x16 t0 = f32x16{}, t1 = f32x16{};
    t0 = __builtin_amdgcn_mfma_f32_32x32x16_bf16(L21A[0], F[0][0], t0, 0, 0, 0); t0 = __builtin_amdgcn_mfma_f32_32x32x16_bf16(L21A[1], F[1][0], t0, 0, 0, 0);
    t1 = __builtin_amdgcn_mfma_f32_32x32x16_bf16(L21A[0], F[0][1], t1, 0, 0, 0); t1 = __builtin_amdgcn_mfma_f32_32x32x16_bf16(L21A[1], F[1][1], t1, 0, 0, 0);
#pragma unroll
    for (int r = 0; r < 16; ++r) { const float e0 = t0[r], e1 = t1[r]; auto sw = __builtin_amdgcn_permlane32_swap(__float_as_uint(e0), __float_as_uint(e1), false, false);
        x2[(r & 3) + 8 * (r >> 2)] -= __uint_as_float(sw[0]); x2[(r & 3) + 8 * (r >> 2) + 4] -= __uint_as_float(sw[1]); }
    __builtin_amdgcn_sched_barrier(0);
    solve32(x2, la + 4096u);
    col_frags32(x2, F, 2);
}
__device__ __forceinline__ bf16x8 acc_frag(const f32x16& t, int sp) {
    u32x4 w;
    if (sp == 0) { w[0] = cvtpk(t[0], t[1]); w[1] = cvtpk(t[2], t[3]); w[2] = cvtpk(t[4], t[5]); w[3] = cvtpk(t[6], t[7]); }
    else { w[0] = cvtpk(t[8], t[9]); w[1] = cvtpk(t[10], t[11]); w[2] = cvtpk(t[12], t[13]); w[3] = cvtpk(t[14], t[15]); }
    return __builtin_bit_cast(bf16x8, w);
}
__device__ __forceinline__ void store_accfrag(__amdgpu_buffer_rsrc_t ro, int soff, int lane, const f32x16& t) {
    __builtin_amdgcn_raw_buffer_store_b128((u32x4){cvtpk(t[0], t[1]), cvtpk(t[2], t[3]), cvtpk(t[4], t[5]), cvtpk(t[6], t[7])}, ro, lane * 32, soff, 0);
    __builtin_amdgcn_raw_buffer_store_b128((u32x4){cvtpk(t[8], t[9]), cvtpk(t[10], t[11]), cvtpk(t[12], t[13]), cvtpk(t[14], t[15])}, ro, lane * 32 + 16, soff, 0);
}
struct ItemGeom { int b, h, dir, rbase, len, n0; };
__device__ __forceinline__ ItemGeom item_geom(int chain, int ci) { ItemGeom g; g.b = chain >> 4; g.h = (chain >> 1) & 7; g.dir = chain & 1; const bool isc = ci < 4;
    g.n0 = (isc ? ci : ci - 4) * 64; g.rbase = g.b * SROW + (isc ? 0 : TC); g.len = isc ? TC : T; return g; }
__device__ __forceinline__ int item_row(const ItemGeom& g, int i) { const int n = g.n0 + i; return g.rbase + (g.dir ? g.len - 1 - n : n); }

#define G1_LANES() int zs_ = 0; asm volatile("" : "+v"(zs_)); const int lane = (int)__builtin_amdgcn_mbcnt_hi(~0u, __builtin_amdgcn_mbcnt_lo(~0u, (unsigned)zs_)), r32 = lane & 31, hi = lane >> 5; (void)r32; (void)hi
__device__ __forceinline__ void pair_lock(volatile LAS unsigned* w) {
    for (;;) { unsigned got = 0u; if (__builtin_amdgcn_mbcnt_hi(~0u, __builtin_amdgcn_mbcnt_lo(~0u, 0u)) == 0u) got = (__hip_atomic_exchange((LAS unsigned*)w, 1u, __ATOMIC_RELAXED, __HIP_MEMORY_SCOPE_WORKGROUP) == 0u) ? 1u : 0u;
        got = (unsigned)__builtin_amdgcn_readfirstlane((int)got); if (got) break; __builtin_amdgcn_s_sleep(2); }
    asm volatile("s_waitcnt lgkmcnt(0)" ::: "memory"); }
__device__ __forceinline__ void pair_unlock(volatile LAS unsigned* w) { asm volatile("s_waitcnt vmcnt(0) lgkmcnt(0)" ::: "memory"); if (__builtin_amdgcn_mbcnt_hi(~0u, __builtin_amdgcn_mbcnt_lo(~0u, 0u)) == 0u) __hip_atomic_store((LAS unsigned*)w, 0u, __ATOMIC_RELAXED, __HIP_MEMORY_SCOPE_WORKGROUP); asm volatile("s_waitcnt lgkmcnt(0)" ::: "memory"); }
#ifndef G1_LOCK
#define G1_LOCK 0
#endif
#define LOCK_IF(m) do { if (G1_LOCK & (m)) pair_lock(lockw); } while (0)
#define UNLOCK_IF(m) do { if (G1_LOCK & (m)) pair_unlock(lockw); } while (0)
constexpr int G1_L = 0, G1_ARR = 8192, G1_TK = 9216, G1_TV = 17408, G1_TQ = 17408  , G1_WAVE_LDS = 26624;
__device__ __forceinline__ void g1_item(Frame& F, int item, LAS unsigned char* wl, volatile LAS unsigned* lockw) {
    int zz = 0; asm volatile("" : "+v"(zz)); __builtin_assume((unsigned)zz < 2u);
    const int chain = item / 68, ci = item - chain * 68; const ItemGeom G = item_geom(chain, ci); const int h = G.h;
    LAS float* Ls = (LAS float*)(wl + G1_L); LAS float* gcA = (LAS float*)(wl + G1_ARR), *btA = gcA + 64, *egA = gcA + 128, *etA = gcA + 192;
    const LAS bf16* TK = (const LAS bf16*)(wl + G1_TK); const LAS bf16* TV = (const LAS bf16*)(wl + G1_TV); const LAS bf16* TQ = (const LAS bf16*)(wl + G1_TQ);
    const bf16* QK = (const bf16*)(F.ws + WS_QKVN); const float* GB = (const float*)(F.ws + WS_GB);
    bf16* out = (bf16*)(F.ws + WS_GDNI) + (size_t)item * 16384;
    LOCK_IF(1);
    u32x4 tq[8];
    { G1_LANES(); u32x4 t[2][8];
#pragma unroll
      for (int j = 0; j < 8; ++j) { const int i = (lane >> 3) + 8 * j; const bf16* rp = QK + (size_t)item_row(G, i) * 1536 + h * 64 + (lane & 7) * 8;
          t[0][j] = *(const GAS u32x4*)(rp + 512); t[1][j] = *(const GAS u32x4*)(rp + 1024); tq[j] = *(const GAS u32x4*)rp; }
#pragma unroll
      for (int j = 0; j < 8; ++j) { const int o = ((lane >> 3) + 8 * j) * 128 + (lane & 7) * 16;
          *(LAS u32x4*)(wl + G1_TK + o) = t[0][j]; *(LAS u32x4*)(wl + G1_TV + o) = t[1][j]; } }
    float gl;
    { G1_LANES(); const int row = item_row(G, lane); float g = GB[(size_t)row * 32 + G.dir * 8 + h]; const float bt = GB[(size_t)row * 32 + 16 + G.dir * 8 + h];
#pragma unroll
      for (int o = 1; o < 64; o <<= 1) { const float t = __builtin_bit_cast(float, __builtin_amdgcn_ds_bpermute((lane - o) << 2, __builtin_bit_cast(int, g))); if (lane >= o) g += t; }
      gl = __builtin_bit_cast(float, __builtin_amdgcn_readlane(__builtin_bit_cast(int, g), 63)); gcA[lane] = g; btA[lane] = bt; egA[lane] = __expf(g); etA[lane] = __expf(gl - g); }
    asm volatile("s_waitcnt lgkmcnt(0)" ::: "memory");
    const LAS float* gcz = gcA + zz; const LAS float* btz = btA + zz; const LAS float* egz = egA + zz; const LAS float* etz = etA + zz;
    UNLOCK_IF(1); LOCK_IF(2);
    bf16x8 L21A[2];
    { G1_LANES(); bf16x8 Kf[2][4];
#pragma unroll
      for (int t = 0; t < 2; ++t)
#pragma unroll
          for (int s = 0; s < 4; ++s) Kf[t][s] = *(const LAS bf16x8*)(TK + (32 * t + r32) * 64 + 16 * s + 8 * hi);
#pragma unroll
      for (int t = 0; t < 2; ++t) { f32x16 acc = f32x16{};
#pragma unroll
          for (int s = 0; s < 4; ++s) acc = __builtin_amdgcn_mfma_f32_32x32x16_bf16(Kf[t][s], Kf[t][s], acc, 0, 0, 0);
          const float gcj = gcz[32 * t + r32];
#pragma unroll
          for (int r = 0; r < 16; ++r) { const int il = crow(r, hi), i = 32 * t + il; const float e = __expf(fminf(gcz[i] - gcj, 0.f)); const float v0 = btz[i] * acc[r] * e; Ls[t * 1024 + il * 32 + r32] = (r32 < il) ? v0 : 0.f; } }
      { f32x16 acc = f32x16{};
#pragma unroll
          for (int s = 0; s < 4; ++s) acc = __builtin_amdgcn_mfma_f32_32x32x16_bf16(Kf[0][s], Kf[1][s], acc, 0, 0, 0);
          const int i = 32 + r32; const float gci = gcz[i], bti = btz[i];
#pragma unroll
          for (int r = 0; r < 16; ++r) { const int j = crow(r, hi); acc[r] = bti * acc[r] * __expf(fminf(gci - gcz[j], 0.f)); }
          L21A[0] = acc_frag(acc, 0); L21A[1] = acc_frag(acc, 1); } }
    asm volatile("s_waitcnt lgkmcnt(0)" ::: "memory"); __builtin_amdgcn_sched_barrier(0);
    UNLOCK_IF(2); LOCK_IF(4);
    bf16x8 UF[4][2];
    const unsigned la = (unsigned)(uintptr_t)Ls + ((unsigned)zz << 4);
    { G1_LANES(); float x1[32], x2[32];
#pragma unroll
      for (int i = 0; i < 64; ++i) { const float v = bf2f(TV[i * 64 + lane]) * btz[i]; if (i < 32) x1[i & 31] = v; else x2[i & 31] = v; }
      asm volatile("s_waitcnt lgkmcnt(0)" ::: "memory");
#pragma unroll
      for (int j = 0; j < 8; ++j) *(LAS u32x4*)(wl + G1_TQ + ((lane >> 3) + 8 * j) * 128 + (lane & 7) * 16) = tq[j];
      solve_blocked(x1, x2, la, L21A, UF); }
    __builtin_amdgcn_sched_barrier(0);
    bf16x8 WF[4][2];
    { G1_LANES(); float x1[32], x2[32];
#pragma unroll
      for (int i = 0; i < 64; ++i) { const float v = bf2f(TK[i * 64 + lane]) * btz[i] * egz[i]; if (i < 32) x1[i & 31] = v; else x2[i & 31] = v; }
      solve_blocked(x1, x2, la, L21A, WF); }
    __builtin_amdgcn_sched_barrier(0);
    UNLOCK_IF(4); LOCK_IF(8);
    bf16x8 KTA[4][2];
    { G1_LANES(); float k1[32], k2[32];
#pragma unroll
      for (int i = 0; i < 32; ++i) { k1[i] = bf2f(TK[i * 64 + lane]) * etz[i]; k2[i] = bf2f(TK[(32 + i) * 64 + lane]) * etz[32 + i]; }
      col_frags32(k1, KTA, 0); col_frags32(k2, KTA, 2); }
    __builtin_amdgcn_sched_barrier(0);
    const __amdgpu_buffer_rsrc_t ro = __builtin_amdgcn_make_buffer_rsrc((void*)out, 0, 32768, 0x00020000);
    {
    G1_LANES();
    const float egl = __expf(gl);
#pragma unroll
    for (int at = 0; at < 2; ++at)
#pragma unroll
        for (int ct = 0; ct < 2; ++ct) { f32x16 a0 = f32x16{}, a1 = f32x16{};
#pragma unroll
            for (int s = 0; s < 4; ++s) { a0 = __builtin_amdgcn_mfma_f32_32x32x16_bf16(KTA[s][at], UF[s][ct], a0, 0, 0, 0); a1 = __builtin_amdgcn_mfma_f32_32x32x16_bf16(KTA[s][at], WF[s][ct], a1, 0, 0, 0); }
            store_accfrag(ro, 16384 + (at * 2 + ct) * 2048, lane, a0);
            const int vo = 4 * hi * 128 + (32 * ct + swap23(r32)) * 2;
#pragma unroll
            for (int r = 0; r < 16; ++r) { const float v = ((at == ct && crow(r, hi) == r32) ? egl : 0.f) - a1[r];
                __builtin_amdgcn_raw_buffer_store_b16((short)f2bf(v), ro, vo + (r & 3) * 128 + (r >> 2) * 1024, 32 * at * 128, 0); }
            __builtin_amdgcn_sched_barrier(0); }
    }
    UNLOCK_IF(8); LOCK_IF(16);
    bf16x8 XA[3][2];
    { G1_LANES(); bf16x8 Kf[4], Qf[2][4]; const LAS bf16* TK2 = TK + zz;
#pragma unroll
      for (int t = 0; t < 2; ++t)
#pragma unroll
          for (int s = 0; s < 4; ++s) Qf[t][s] = *(const LAS bf16x8*)(TQ + (32 * t + r32) * 64 + 16 * s + 8 * hi);
#pragma unroll
      for (int tl = 0; tl < 3; ++tl) { const int jt = tl == 2 ? 1 : 0, it = tl == 0 ? 0 : 1;
          if (tl != 1) {
#pragma unroll
              for (int s = 0; s < 4; ++s) Kf[s] = *(const LAS bf16x8*)(TK2 + (32 * jt + r32) * 64 + 16 * s + 8 * hi); }
          f32x16 acc = f32x16{};
#pragma unroll
          for (int s = 0; s < 4; ++s) acc = __builtin_amdgcn_mfma_f32_32x32x16_bf16(Kf[s], Qf[it][s], acc, 0, 0, 0);
          const int i = 32 * it + r32; const float gci = gcz[i];
#pragma unroll
          for (int r = 0; r < 16; ++r) { const int j = 32 * jt + crow(r, hi); const float e = __expf(fminf(gci - gcz[j], 0.f)); const float v0 = acc[r] * e; acc[r] = (j <= i) ? v0 : 0.f; }
          XA[tl][0] = acc_frag(acc, 0); XA[tl][1] = acc_frag(acc, 1); __builtin_amdgcn_sched_barrier(0); } }
    __builtin_amdgcn_sched_barrier(0);
    {
    G1_LANES();
#pragma unroll
    for (int it = 0; it < 2; ++it)
#pragma unroll
        for (int ct = 0; ct < 2; ++ct) { f32x16 a0 = f32x16{}, a1 = f32x16{};
#pragma unroll
            for (int jt = 0; jt <= it; ++jt) { const int tl = (it == 0) ? 0 : (jt == 0 ? 1 : 2);
#pragma unroll
                for (int sp = 0; sp < 2; ++sp) { a0 = __builtin_amdgcn_mfma_f32_32x32x16_bf16(XA[tl][sp], UF[2 * jt + sp][ct], a0, 0, 0, 0); a1 = __builtin_amdgcn_mfma_f32_32x32x16_bf16(XA[tl][sp], WF[2 * jt + sp][ct], a1, 0, 0, 0); } }
            store_accfrag(ro, 24576 + (it * 2 + ct) * 2048, lane, a0);
            const int vo = 4 * hi * 128 + (32 * ct + swap23(r32)) * 2; const int a = 32 * ct + r32;
#pragma unroll
            for (int r = 0; r < 16; ++r) { const int i = 32 * it + crow(r, hi); const float qv = bf2f(TQ[i * 64 + a]);
                __builtin_amdgcn_raw_buffer_store_b16((short)f2bf(qv * egz[i] - a1[r]), ro, vo + (r & 3) * 128 + (r >> 2) * 1024, 8192 + 32 * it * 128, 0); }
            __builtin_amdgcn_sched_barrier(0); }
    }
    asm volatile("s_waitcnt lgkmcnt(0)" ::: "memory");
    UNLOCK_IF(16);
}
__device__ __forceinline__ void scan_chain(Frame& F, int chain, int dc) {
    const int w = F.wave, lane = F.lane, r32 = lane & 31, hi = lane >> 5, role = (w >> 1) & 1, rt = w & 1;
    LAS u32x4* SF = (LAS u32x4*)(F.lds + RING_OFF);
    const bf16* base = (const bf16*)(F.ws + WS_GDNI) + (size_t)chain * 68 * 16384; bf16* OG = (bf16*)(F.ws + WS_OG);
    for (int i = F.tid; i < 2 * 4 * 64; i += 512) SF[i] = (u32x4){0u, 0u, 0u, 0u};
    const bf16* Ab = base + (role ? 4096 : 0) + (32 * rt + r32) * 64 + 8 * hi; const bf16* Cb = base + (role ? 12288 : 8192) + ((rt * 2 + dc) * 64 + lane) * 16;
    struct Ops { bf16x8 a[4]; u32x4 c[2]; };
#define SC_LOAD(o, ci_) do { const bf16* A_ = Ab + (size_t)(ci_) * 16384; const bf16* C_ = Cb + (size_t)(ci_) * 16384; \
        _Pragma("unroll") for (int s_ = 0; s_ < 4; ++s_) (o).a[s_] = *(const GAS bf16x8*)(A_ + 16 * s_); (o).c[0] = *(const GAS u32x4*)C_; (o).c[1] = *(const GAS u32x4*)(C_ + 8); } while (0)
#define SC_STEP(o, ci_) do { f32x16 acc; \
        _Pragma("unroll") for (int q = 0; q < 4; ++q) { acc[2 * q] = bflo((o).c[0][q]); acc[2 * q + 1] = bfhi((o).c[0][q]); acc[8 + 2 * q] = bflo((o).c[1][q]); acc[8 + 2 * q + 1] = bfhi((o).c[1][q]); } \
        const LAS u32x4* Sb = SF + (((ci_) & 1) * 256) + lane; \
        _Pragma("unroll") for (int s_ = 0; s_ < 4; ++s_) { const u32x4 bw = Sb[s_ * 64]; acc = __builtin_amdgcn_mfma_f32_32x32x16_bf16((o).a[s_], __builtin_bit_cast(bf16x8, bw), acc, 0, 0, 0); } \
        SC_LOAD(o, ((ci_) + SCAN_PF < 68) ? (ci_) + SCAN_PF : 67);     \
        if (role == 0) { LAS u32x4* Sn = SF + ((((((ci_) + 1) & 1)) * 4 + 2 * rt) * 64) + lane; Sn[0] = __builtin_bit_cast(u32x4, acc_frag(acc, 0)); Sn[64] = __builtin_bit_cast(u32x4, acc_frag(acc, 1)); } \
        else { const ItemGeom G = item_geom(chain, (ci_)); LAS bf16* stg = (LAS bf16*)(F.lds + RING_OFF + 16384 + rt * 2048);     \
            _Pragma("unroll") for (int r = 0; r < 16; ++r) stg[crow(r, hi) * 32 + r32] = (bf16)f2bf(acc[r]); \
            asm volatile("s_waitcnt lgkmcnt(0)" ::: "memory"); \
            const u32x4 v0 = *(const LAS u32x4*)(stg + (lane >> 1) * 32 + (lane & 1) * 16), v1 = *(const LAS u32x4*)(stg + (lane >> 1) * 32 + (lane & 1) * 16 + 8); \
            GAS u32x4* po = (GAS u32x4*)(OG + (size_t)item_row(G, 32 * rt + (lane >> 1)) * 1024 + G.dir * 512 + G.h * 64 + 32 * dc + (lane & 1) * 16); po[0] = v0; po[1] = v1; } \
        asm volatile("s_waitcnt lgkmcnt(0)" ::: "memory"); __builtin_amdgcn_s_barrier(); asm volatile("" ::: "memory"); } while (0)
    if (w < 4) {
        Ops o[SCAN_PF];
#pragma unroll
        for (int k = 0; k < SCAN_PF; ++k) SC_LOAD(o[k], k);
        __syncthreads();
#pragma unroll
        for (int ci = 0; ci < 68; ++ci) SC_STEP(o[ci % SCAN_PF], ci);
        asm volatile("s_waitcnt vmcnt(0)" ::: "memory");
    } else {
        __syncthreads();
#pragma unroll 1
        for (int ci = 0; ci < 68; ++ci) { __builtin_amdgcn_s_barrier(); asm volatile("" ::: "memory"); }
    }
#undef SC_LOAD
#undef SC_STEP
}
}
__device__ __forceinline__ void l1_prep(Frame& F) {
    bf16* P = (bf16*)(F.ws + WS_PROJ2); bf16* KM = (bf16*)(F.ws + WS_KMLA); const int lane = F.lane;
    for (int r = F.gw; r < NR; r += F.NGW) { const int b = r / SROW, s = r - b * SROW; const bool isc = s < TC; const int p = s - TC; bf16* row = P + (size_t)r * OINP;
        { bf16* CQ = (bf16*)(F.ws + WS_CQN) + (size_t)r * 640;
          const v2u a = *(const GAS v2u*)(row + O_CQ + 4 * lane); const v2u c = (lane < 32) ? *(const GAS v2u*)(row + O_CQ + 256 + 4 * lane) : (v2u){0u, 0u}; const v2u k = *(const GAS v2u*)(row + O_CKV + 4 * lane);
          const float a0 = bflo(a.x), a1 = bfhi(a.x), a2 = bflo(a.y), a3 = bfhi(a.y), c0 = bflo(c.x), c1 = bfhi(c.x), c2 = bflo(c.y), c3 = bfhi(c.y), k0 = bflo(k.x), k1 = bfhi(k.x), k2 = bflo(k.y), k3 = bfhi(k.y);
          const float sq = wave_sum(a0 * a0 + a1 * a1 + a2 * a2 + a3 * a3 + c0 * c0 + c1 * c1 + c2 * c2 + c3 * c3), skv = wave_sum(k0 * k0 + k1 * k1 + k2 * k2 + k3 * k3);
          const float rq = 1.f / sqrtf(sq * (1.f / 384.f) + EPS), rk = 1.f / sqrtf(skv * (1.f / 256.f) + EPS);
          *(GAS v2u*)(CQ + 4 * lane) = (v2u){pk2(a0 * rq, a1 * rq), pk2(a2 * rq, a3 * rq)};
          if (lane < 32) *(GAS v2u*)(CQ + 256 + 4 * lane) = (v2u){pk2(c0 * rq, c1 * rq), pk2(c2 * rq, c3 * rq)};
          *(GAS v2u*)(CQ + 384 + 4 * lane) = (v2u){pk2(k0 * rk, k1 * rk), pk2(k2 * rk, k3 * rk)}; }
        if (lane < 16) { const int seg = lane >> 3, i = lane & 7, d0 = seg * 16 + i; float x0 = bf2f(row[O_KR + d0]), x1 = bf2f(row[O_KR + d0 + 8]);
            if (!isc) { const float pos = (float)(seg ? (p & 63) : (p >> 6)); const float ang = pos * __powf(10000.f, -(float)i * (1.f / 8.f)); float sn, cs; sincosf(ang, &sn, &cs);
                const float y0 = x0 * cs - x1 * sn, y1 = x1 * cs + x0 * sn; x0 = y0; x1 = y1; }
            const bf16 b0 = (bf16)f2bf(x0), b1 = (bf16)f2bf(x1);
#pragma unroll
            for (int h = 0; h < 8; ++h) { KM[(size_t)r * 768 + h * 96 + 64 + d0] = b0; KM[(size_t)r * 768 + h * 96 + 64 + d0 + 8] = b1; } }
        if (!isc) {
            const int pi = lane & 31, seg = pi >> 4, i = pi & 15, d0 = seg * 32 + i; const float pos = (float)(seg ? (p & 63) : (p >> 6));
            const float ang = pos * __powf(10000.f, -(float)i * (1.f / 16.f)); float sn, cs; sincosf(ang, &sn, &cs);
#pragma unroll
            for (int q = 0; q < 8; ++q) { const int hh = (lane >> 5) + 2 * q; bf16* base = row + (hh < 8 ? O_DQ + hh * 64 : O_DK + (hh - 8) * 64) + d0;
                const float x0 = bf2f(base[0]), x1 = bf2f(base[16]); base[0] = (bf16)f2bf(x0 * cs - x1 * sn); base[16] = (bf16)f2bf(x1 * cs + x0 * sn); } }
    }
}
__device__ __forceinline__ void l1_qrope(Frame& F) {
    bf16* QM = (bf16*)(F.ws + WS_QM); const int lane = F.lane;
    for (int r = F.gw; r < NR; r += F.NGW) { const int b = r / SROW, s = r - b * SROW; if (s < TC) continue; const int p = s - TC;
        const int pi = lane & 15, seg = pi >> 3, i = pi & 7, d0 = seg * 16 + i; const float pos = (float)(seg ? (p & 63) : (p >> 6));
        const float ang = pos * __powf(10000.f, -(float)i * (1.f / 8.f)); float sn, cs; sincosf(ang, &sn, &cs);
#pragma unroll
        for (int q = 0; q < 2; ++q) { const int h = (lane >> 4) + 4 * q; bf16* base = QM + (size_t)r * 768 + h * 96 + 64 + d0;
            const float x0 = bf2f(base[0]), x1 = bf2f(base[8]); base[0] = (bf16)f2bf(x0 * cs - x1 * sn); base[8] = (bf16)f2bf(x1 * cs + x0 * sn); } }
}
__device__ __forceinline__ void l1_attn_unit(Frame& F, int u) {
    if (u < 512) { const int b = u >> 7, qb = (u >> 3) & 15, h = u & 7; const size_t rq = (size_t)b * SROW + TC + qb * 256, r0 = (size_t)b * SROW;
        constexpr float SC = 0.10206207261596575f  , C = SC * 1.4426950408889634f, THRS = att::THR / SC;
        const bf16* QM = (const bf16*)(F.ws + WS_QM); const bf16* KM = (const bf16*)(F.ws + WS_KMLA); const bf16* VM = (const bf16*)(F.ws + WS_VMLA); bf16* MIX = (bf16*)(F.ws + WS_MIX);
        att::attn_unit<96, 64, 0, true>(QM + rq * 768 + h * 96, 768, KM + r0 * 768 + h * 96, 768, VM + r0 * 512 + h * 64, 512, MIX + rq * 1024 + h * 64, 1024, SROW / 64, 0, qb * 256, C, THRS, -3.0e38f, F.ldsg + RING_OFF);
    } else { const int v = u - 512, b = v >> 6, qb = (v >> 2) & 15, head = v & 3; const size_t rq = (size_t)b * SROW + TC + qb * 256, r0 = (size_t)b * SROW;
        constexpr float SC = 0.125f, C = SC * 1.4426950408889634f, THRS = att::THR / SC; constexpr float LAM_INIT = 0.35550906759096556f;
        const float* lp = F.in[I_OLAM]; const float lam = __expf(wave_sum(lp[F.lane] * lp[64 + F.lane])) - __expf(wave_sum(lp[128 + F.lane] * lp[192 + F.lane])) + LAM_INIT;
        const bf16* P = (const bf16*)(F.ws + WS_PROJ2); bf16* MIX = (bf16*)(F.ws + WS_MIX); const int hh = 2 * head;
        att::attn_unit<64, 128, 0, false, 1>(P + rq * OINP + O_DQ + hh * 64, OINP, P + r0 * OINP + O_DK + hh * 64, OINP, P + r0 * OINP + O_DV + head * 128, OINP, MIX, 1024, SROW / 64, 0, 0, C, THRS, -3.0e38f, F.ldsg + RING_OFF);
        att::attn_unit<64, 128, 0, false, 2>(P + rq * OINP + O_DQ + (hh + 1) * 64, OINP, P + r0 * OINP + O_DK + (hh + 1) * 64, OINP, P + r0 * OINP + O_DV + head * 128, OINP, MIX + rq * 1024 + 512 + head * 128, 1024, SROW / 64, 0, 0, C, THRS, -3.0e38f, F.ldsg + RING_OFF,
                                             lam, F.in[I_OSUBLN], 1.f - LAM_INIT); }
}
__device__ __forceinline__ void l1_diff_post(Frame& F) {
    const bf16* OD = (const bf16*)(F.ws + WS_ODIFF); bf16* MIX = (bf16*)(F.ws + WS_MIX); const int lane = F.lane; const float* lp = F.in[I_OLAM];
    constexpr float LAM_INIT = 0.35550906759096556f;
    const float s01 = wave_sum(lp[lane] * lp[64 + lane]), s23 = wave_sum(lp[128 + lane] * lp[192 + lane]); const float lam = __expf(s01) - __expf(s23) + LAM_INIT;
    const int head = lane >> 4, d = (lane & 15) * 8; const f32x4 w0 = *(const GAS f32x4*)(F.in[I_OSUBLN] + d), w1 = *(const GAS f32x4*)(F.in[I_OSUBLN] + d + 4);
    const float ww[8] = {w0.x, w0.y, w0.z, w0.w, w1.x, w1.y, w1.z, w1.w};
    for (int r = F.gw; r < NR; r += F.NGW) { const int b = r / SROW, s = r - b * SROW; if (s < TC) continue;
        const v4u a = *(const GAS v4u*)(OD + (size_t)r * 1024 + (2 * head) * 128 + d), c = *(const GAS v4u*)(OD + (size_t)r * 1024 + (2 * head + 1) * 128 + d);
        float o[8] = {bflo(a.x) - lam * bflo(c.x), bfhi(a.x) - lam * bfhi(c.x), bflo(a.y) - lam * bflo(c.y), bfhi(a.y) - lam * bfhi(c.y), bflo(a.z) - lam * bflo(c.z), bfhi(a.z) - lam * bfhi(c.z), bflo(a.w) - lam * bflo(c.w), bfhi(a.w) - lam * bfhi(c.w)};
        float ss = 0.f;
#pragma unroll
        for (int e = 0; e < 8; ++e) ss += o[e] * o[e];
        ss += __shfl_xor(ss, 1); ss += __shfl_xor(ss, 2); ss += __shfl_xor(ss, 4); ss += __shfl_xor(ss, 8);
        const float rs = (1.f - LAM_INIT) / sqrtf(ss * (1.f / 128.f) + EPS);
#pragma unroll
        for (int e = 0; e < 8; ++e) o[e] = o[e] * rs * ww[e];
        *(GAS v4u*)(MIX + (size_t)r * 1024 + 512 + head * 128 + d) = (v4u){pk2(o[0], o[1]), pk2(o[2], o[3]), pk2(o[4], o[5]), pk2(o[6], o[7])}; }
}
__device__ __forceinline__ void moe_bases(Frame& F, int (&base)[8], int& ntiles) { int acc = 0;
#pragma unroll
    for (int e = 0; e < 8; ++e) { base[e] = acc; const int c = (int)__hip_atomic_load((unsigned*)(F.ctl + CW_MOECNT + 64 * e), RLX_AGENT); acc += (c + 255) & ~255; }
    ntiles = acc >> 8; }
constexpr size_t META_TEXP = 640 * 1024, META_POS = 768 * 1024;
__device__ __forceinline__ int row_vcu(const Frame& F, int r) { return (r % F.NGW) >> 3; }
__device__ __forceinline__ void moe_gather(Frame& F) {
    int base[8], ntiles; moe_bases(F, base, ntiles);
    int* TEXP = (int*)(F.ws + WS_META + META_TEXP); int* POS = (int*)(F.ws + WS_META + META_POS);
    const int* TOPI = (const int*)(F.ws + WS_META + META_TOPI); const int* RANK = (const int*)(F.ws + WS_META + META_RANK);
    if (blockIdx.x == 0 && F.tid < 144) { const int t = F.tid; int e = 0;
#pragma unroll
        for (int q = 1; q < 8; ++q) if (t * 256 >= base[q]) e = q;
        TEXP[t] = e; if (t == 143) TEXP[144] = ntiles; }
    const bf16* FIN = (const bf16*)(F.ws + WS_FIN2); bf16* AS = (bf16*)(F.ws + WS_ASORT);
    for (int tk = F.gw; tk < NB * T; tk += F.NGW) { const int b = tk / T, t = tk - b * T; const size_t r = (size_t)b * SROW + TC + t;
        const GAS v4u* src = (const GAS v4u*)(FIN + r * D) + F.lane; const v4u x0 = src[0], x1 = src[64];
#pragma unroll
        for (int sl = 0; sl < 2; ++sl) { const int e = TOPI[tk * 2 + sl]; int bs = 0;
#pragma unroll
            for (int q = 0; q < 8; ++q) if (q == e) bs = base[q];
            const int pos = bs + ((const int*)(F.ws + WS_META + META_BLKB))[tok_vcu(F, b, t) * 8 + e] + RANK[tk * 2 + sl]; if (F.lane == 0) POS[tk * 2 + sl] = pos;
            GAS v4u* dst = (GAS v4u*)(AS + (size_t)pos * D) + F.lane; dst[0] = x0; dst[64] = x1; } }
}
__device__ __forceinline__ Row4 moe_out_row(Frame& F, const bf16* OR, int pos_) {
    const int pos = __builtin_amdgcn_readfirstlane(pos_), tile = pos >> 8, part = tile >= 68 ? 1 : 0, local = tile - 68 * part;
    if (local < 64) return ld_row_bf16(OR + (size_t)pos * D, F.lane);
    const float* P = (const float*)(F.ws + (part ? WS_WXGU : WS_FIN2)) + ((size_t)(local - 64) * 256 + (pos & 255)) * 1024; Row4 y = ld_row_f32(P, F.lane);
    for (int s = 1; s < DFX / MOE_KSL; ++s) { const Row4 p = ld_row_f32(P + (size_t)s * 4 * 256 * 1024, F.lane);
#pragma unroll
        for (int j = 0; j < 4; ++j) y.v[j] += p.v[j]; }
    return y; }
__device__ __forceinline__ void rows_final(Frame& F) {
    const bf16* OR = (const bf16*)(F.ws + WS_ASORT); const int* POS = (const int*)(F.ws + WS_META + META_POS); const float* TOPW = (const float*)(F.ws + WS_META + META_TOPW);
    const int wpb = F.NGW >> 2, b = F.gw / wpb, wl = F.gw - b * wpb; const Row4 W = ld_row_f32(F.in[I_ONORMS] + 3 * 1024, F.lane), Gt = ld_row_f32(modvec(F, 1, b, 5), F.lane);
    for (int t = wl; t < T; t += wpb) { const int tk = b * T + t; float* xr = F.out + (size_t)tk * D;
        Row4 x = ld_row_bf16((const bf16*)(F.ws + WS_XB) + (size_t)tk * D, F.lane); const Row4 y0 = moe_out_row(F, OR, POS[tk * 2]), y1 = moe_out_row(F, OR, POS[tk * 2 + 1]);
        const float w0 = TOPW[tk * 2], w1 = TOPW[tk * 2 + 1]; Row4 y;
#pragma unroll
        for (int j = 0; j < 4; ++j) y.v[j] = y0.v[j] * w0 + y1.v[j] * w1;
        add_gated_norm_r(x, y, W, Gt); st_row_f32(xr, F.lane, x); }
}
constexpr int N_PHASES = 26;
__global__ void __launch_bounds__(NWAVES * 64, 2) trunk_fwd(Args args) {
    extern __shared__ __attribute__((aligned(16))) unsigned char lds[];
    Frame F;
    F.lds = (LAS unsigned char*)lds; F.ldsg = (char*)lds;
    F.MISC = (volatile LAS unsigned*)(F.lds + MISC_OFF);
    F.wave = __builtin_amdgcn_readfirstlane((int)threadIdx.x >> 6);
#define REFRESH() do { int z_ = 0; asm volatile("" : "+v"(z_)); F.lane = (int)__builtin_amdgcn_mbcnt_hi(~0u, __builtin_amdgcn_mbcnt_lo(~0u, (unsigned)z_)); F.tid = F.wave * 64 + F.lane; } while (0)
    REFRESH();
    F.G = gridDim.x; { const int bx = blockIdx.x; F.vcu = (F.G % 8 == 0) ? (bx % 8) * (F.G / 8) + bx / 8 : bx; }
    F.gw = F.vcu * NWAVES + F.wave; F.NGW = F.G * NWAVES;
    F.in = args.in; F.out = args.out; F.ws = args.ws; F.ctl = (gu32*)(args.ws + WS_CTL);
    unsigned char* ws = args.ws;
    for (int u = F.tid; u < (LDS_BYTES - MISC_OFF) / 4; u += NWAVES * 64) ((LAS unsigned*)(F.lds + MISC_OFF))[u] = 0u;
    __syncthreads();
    XcdBarrier bar; bar.bar = (unsigned*)(F.ctl + CW_BAR); bar.x = 0; bar.st = nullptr;
    const int lo = args.ph_lo, hi = args.ph_hi;
    const bool use_bar = (hi - lo) > 1;
    if (use_bar) bar = xcd_barrier_post((unsigned*)(F.ctl + CW_BAR), F.MISC + 8);
#ifndef MK_ONLY
#define MK_ONLY_OK(k) true
#else
#define MK_ONLY_OK(k) ((k) == MK_ONLY)
#endif
#define IN(k) (MK_ONLY_OK(k) && lo <= (k) && (k) < hi && (k) <= MK_LAST_PHASE)
#ifndef PROBE_MULT
#define PROBE_MULT 4
#endif
#ifndef PROBE_SPAN
#define PROBE_SPAN 1
#endif
#ifndef SCAN_REP
#define SCAN_REP 1
#endif
#ifndef SWA_REP
#define SWA_REP 1
#endif
#ifndef CHK_MASK
#define CHK_MASK 0xffu
#endif
#ifndef MK_REP_MASK
#define MK_REP_MASK 0u
#endif
#define REPS(k) ((((unsigned)MK_REP_MASK >> (k)) & 1u) ? 2 : 1)
#ifdef PROBE_PHASE
#define STAMP(k) do { if (blockIdx.x == 0 && F.tid == 0) { const unsigned long long t_ = __builtin_amdgcn_s_memrealtime(); F.MISC[64 + 2 * (k)] = (unsigned)t_; F.MISC[65 + 2 * (k)] = (unsigned)(t_ >> 32); } } while (0)
#else
#define STAMP(k) do { } while (0)
#endif
#define SEAM(k) do { if (IN(k) && IN((k) + 1)) xcd_barrier(bar); STAMP((k) + 1); } while (0)
    typedef pg8::bf16_t pb;
    const int bid = blockIdx.x;

    STAMP(0);
    if (IN(0)) for (int rep_ = 0; rep_ < REPS(0); ++rep_) { REFRESH(); p0_prologue(F); } SEAM(0);
    if (IN(1)) for (int rep_ = 0; rep_ < REPS(1); ++rep_) { REFRESH(); p1_first_rows(F); } SEAM(1);
    if (IN(2)) for (int rep_ = 0; rep_ < REPS(2); ++rep_) { REFRESH();
        pg8::Gemm g{(const pb*)(ws + WS_ABUF), (const pb*)(ws + WS_WEIN), NR, EINP, 1024, 1024, 1024}; pg8::StaticOrder S; S.init(NR, EINP, F.G, bid);
        pg8::EpiStore E{(pb*)(ws + WS_PROJ), EINP, EINP / 256};
        pg8::gemm_phase<pg8::EpiStore, pg8::StaticOrder, PG8_ALIGN, PG8_SP2>(F.lds + RING_OFF, g, S, E); } SEAM(2);
    if (IN(3)) for (int rep_ = 0; rep_ < REPS(3); ++rep_) { REFRESH(); g0_prep(F); } SEAM(3);
#ifdef GDN_SLOW
    if (IN(5)) for (int rep_ = 0; rep_ < REPS(5); ++rep_) { REFRESH();
        if (F.G > 64) { if (bid < 64) gdn_chain(F, bid); else for (int u = bid - 64; u < 544; u += F.G - 64) swa_unit(F, u); }
        else { for (int c = bid; c < 64; c += F.G) gdn_chain(F, c); for (int u = bid; u < 544; u += F.G) swa_unit(F, u); } } SEAM(5);
#else
    if (IN(4)) for (int rep_ = 0; rep_ < REPS(4); ++rep_) { REFRESH();
#if G1_LOCK
        if ((F.wave & 3) == 0) for (int item = F.vcu * 2 + (F.wave >> 2); item < 64 * 68; item += F.G * 2) gdn::g1_item(F, item, F.lds + RING_OFF + (F.wave >> 2) * gdn::G1_WAVE_LDS, F.MISC + 16);
#else
        const int n_main = ((64 * 68) / (F.G * 4)) * (F.G * 4), n_late = (64 * 68 - n_main + 3) / 4;
        if (F.wave < 4) { const int R = n_main / (F.G * 4);
            _Pragma("unroll 1") for (int r = 0; r <= R; ++r) { int item;
                if (r < R) item = F.vcu * 4 + F.wave + r * F.G * 4; else { if (F.vcu >= n_late) break; item = n_main + F.vcu * 4 + F.wave; if (item >= 64 * 68) break; }
                gdn::g1_item(F, item, F.lds + RING_OFF + F.wave * gdn::G1_WAVE_LDS, F.MISC + 16); } }
        else p0_deferred(F, F.wave - 4, F.lds + RING_OFF + 4 * gdn::G1_WAVE_LDS + (F.wave - 4) * 8448);
        if (F.vcu >= n_late) { __syncthreads(); REFRESH();
            if (F.tid == 0) F.MISC[20] = __hip_atomic_fetch_add((unsigned*)(F.ctl + CW_SWAQ), 1u, RLX_AGENT);
            __syncthreads(); const int u = (int)F.MISC[20]; __syncthreads();
            if (u < 544) swa_unit(F, u); }
#endif
    } SEAM(4);
    if (IN(5)) for (int rep_ = 0; rep_ < REPS(5); ++rep_) { REFRESH();
        STAMP(30); if (bid < 128) for (int c = bid; c < 128; c += F.G) { gdn::scan_chain(F, c >> 1, c & 1); __syncthreads(); } STAMP(31);
        REFRESH();
        for (;;) { if (F.tid == 0) F.MISC[20] = __hip_atomic_fetch_add((unsigned*)(F.ctl + CW_SWAQ), 1u, RLX_AGENT);
            __syncthreads(); const int u = (int)F.MISC[20]; __syncthreads();
            if (u >= 544 * REPS(5) * SWA_REP) break;
            swa_unit(F, u % 544); } } SEAM(5);
#endif
    if (IN(6)) for (int rep_ = 0; rep_ < REPS(6); ++rep_) { REFRESH(); g4_gdn_out(F); } SEAM(6);
    if (IN(7)) for (int rep_ = 0; rep_ < REPS(7); ++rep_) { REFRESH();
        { pg8::Gemm g{(const pb*)(ws + WS_MIX), (const pb*)(ws + WS_WEOUT), NR, 1024, 1024, 1024, 1024}; pg8::LatOrder S; S.init(1024, F.G, bid);
          pg8::EpiStore E{(pb*)(ws + WS_YBUF), 1024, 4};
          pg8::gemm_phase<pg8::EpiStore, pg8::LatOrder, PG8_ALIGN, PG8_SP2>(F.lds + RING_OFF, g, S, E); }
        __syncthreads();
        { pg8::Gemm g{(const pb*)(ws + WS_MIX), (const pb*)(ws + WS_WEOUT), NR, 1024, 256, 1024, 1024}; pg8::CtxSplitOrder S; S.init(4, 256, F.G, bid);
          pg8::EpiPartF32 E{(float*)(ws + WS_PART), 256};
          pg8::gemm_phase<pg8::EpiPartF32, pg8::CtxSplitOrder, PG8_ALIGN, PG8_SP2>(F.lds + RING_OFF, g, S, E); } } SEAM(7);
    if (IN(8)) for (int rep_ = 0; rep_ < REPS(8); ++rep_) { REFRESH(); rows_mid<false>(F, (const bf16*)(ws + WS_YBUF), F.in[I_ENORMS] + 1024, 0, 2, F.in[I_ENORMS] + 2048, 0, 3, (bf16*)(ws + WS_ABUF), false, 4); } SEAM(8);
    if (IN(9)) for (int rep_ = 0; rep_ < REPS(9); ++rep_) { REFRESH();
        pg8::Gemm g{(const pb*)(ws + WS_ABUF), (const pb*)(ws + WS_WEGU), NR, 2 * DFF, 1024, 1024, 1024}; pg8::StaticOrder S; S.init(NR, 2 * DFF, F.G, bid);
        pg8::EpiSwiGLU E{(pb*)(ws + WS_HID), DFF, DFF / 128};
        pg8::gemm_phase<pg8::EpiSwiGLU, pg8::StaticOrder, PG8_ALIGN, PG8_SP2>(F.lds + RING_OFF, g, S, E); } SEAM(9);
    if (IN(10)) for (int rep_ = 0; rep_ < REPS(10); ++rep_) { REFRESH();
        { pg8::Gemm g{(const pb*)(ws + WS_HID), (const pb*)(ws + WS_WEDN), NR, 1024, DFF, DFF, DFF}; pg8::LatOrder S; S.init(1024, F.G, bid);
          pg8::EpiStore E{(pb*)(ws + WS_YBUF), 1024, 4};
          pg8::gemm_phase<pg8::EpiStore, pg8::LatOrder, PG8_ALIGN, PG8_SP2>(F.lds + RING_OFF, g, S, E); }
        __syncthreads();
        { pg8::Gemm g{(const pb*)(ws + WS_HID), (const pb*)(ws + WS_WEDN), NR, 1024, 256, DFF, DFF}; pg8::CtxSplitOrder S; S.init(11, 256, F.G, bid);
          pg8::EpiPartF32 E{(float*)(ws + WS_PART), 256};
          pg8::gemm_phase<pg8::EpiPartF32, pg8::CtxSplitOrder, PG8_ALIGN, PG8_SP2>(F.lds + RING_OFF, g, S, E); } } SEAM(10);
    if (IN(11)) for (int rep_ = 0; rep_ < REPS(11); ++rep_) { REFRESH(); rows_mid<false>(F, (const bf16*)(ws + WS_YBUF), F.in[I_ENORMS] + 3072, 0, 5, F.in[I_ONORMS], 1, 0, (bf16*)(ws + WS_ABUF), false, 11); } SEAM(11);
    if (IN(12)) for (int rep_ = 0; rep_ < REPS(12); ++rep_) { REFRESH();
        pg8::Gemm g{(const pb*)(ws + WS_ABUF), (const pb*)(ws + WS_WOIN), NR, OINP, 1024, 1024, 1024}; pg8::StaticOrder S; S.init(NR, OINP, F.G, bid);
        pg8::EpiStore E{(pb*)(ws + WS_PROJ2), OINP, OINP / 256};
        pg8::gemm_phase<pg8::EpiStore, pg8::StaticOrder, PG8_ALIGN, PG8_SP2>(F.lds + RING_OFF, g, S, E); } SEAM(12);
    if (IN(13)) for (int rep_ = 0; rep_ < REPS(13); ++rep_) { REFRESH(); l1_prep(F); } SEAM(13);
    if (IN(14)) for (int rep_ = 0; rep_ < REPS(14); ++rep_) { REFRESH();
#if !defined(T13) || T13 == 1
        { pg8::Gemm g{(const pb*)(ws + WS_CQN), (const pb*)(ws + WS_WUQ), NR, 768, 384, 640, 384}; pg8::LatOrder S; S.init(768, F.G, bid);
          pg8::EpiStore E{(pb*)(ws + WS_QM), 768, 3};
          pg8::gemm_phase<pg8::EpiStore, pg8::LatOrder, PG8_ALIGN, PG8_SP2>(F.lds + RING_OFF, g, S, E); }
#endif
        __syncthreads();
#if !defined(T13) || T13 == 2
        { pg8::Gemm g{(const pb*)(ws + WS_CQN) + 384, (const pb*)(ws + WS_WUKV), NR, 1024, 256, 640, 256}; pg8::StaticOrder S; S.init(NR, 1024, F.G, bid);
          pg8::EpiKV E{(pb*)(ws + WS_KMLA), (pb*)(ws + WS_VMLA)};
          pg8::gemm_phase<pg8::EpiKV, pg8::StaticOrder, PG8_ALIGN, PG8_SP2>(F.lds + RING_OFF, g, S, E); }
#endif
    } SEAM(14);
    STAMP(16);
    if (IN(16)) for (int rep_ = 0; rep_ < REPS(16); ++rep_) { REFRESH(); for (int u = F.vcu; u < 768; u += F.G) l1_attn_unit(F, u); } SEAM(16);
    STAMP(18);
    if (IN(18)) for (int rep_ = 0; rep_ < REPS(18); ++rep_) { REFRESH();
        pg8::Gemm g{(const pb*)(ws + WS_MIX), (const pb*)(ws + WS_WOOUT), NR, 1024, 1024, 1024, 1024}; pg8::LatOrder S; S.init(1024, F.G, bid);
        pg8::EpiStore E{(pb*)(ws + WS_Y2), 1024, 4};
        pg8::gemm_phase<pg8::EpiStore, pg8::LatOrder, PG8_ALIGN, PG8_SP2>(F.lds + RING_OFF, g, S, E); } SEAM(18);
    if (IN(19)) for (int rep_ = 0; rep_ < REPS(19); ++rep_) { REFRESH();
        router_table(F);
        if (F.wave >= 4) px_expert_weights(F);
        rows_mid<true>(F, (const bf16*)(ws + WS_Y2), F.in[I_ONORMS] + 1024, 1, 2, F.in[I_ONORMS] + 2048, 1, 3, (bf16*)(ws + WS_FIN2), true);
        if (F.wave < 4) px_expert_weights(F);
        router_tail(F); } SEAM(19);
    if (IN(20)) for (int rep_ = 0; rep_ < REPS(20); ++rep_) { REFRESH(); moe_gather(F); } SEAM(20);
#define MOE_PART(kgu, kdn, t0_, cap_) \
    if (IN(kgu)) for (int rep_ = 0; rep_ < REPS(kgu); ++rep_) { REFRESH(); int base[8], ntiles; moe_bases(F, base, ntiles); const int t0 = (t0_), ntl = (ntiles - t0 < 0) ? 0 : ((ntiles - t0 < (cap_)) ? ntiles - t0 : (cap_)); \
        pg8::Gemm g{(const pb*)(ws + WS_ASORT) + (size_t)t0 * 256 * 1024, (const pb*)(ws + WS_WXGU), 0, 0, 1024, 1024, 1024}; pg8::MoeOrder S; S.init(ntl, 28, F.G, bid, (const int*)(ws + WS_META + META_TEXP), t0); \
        pg8::EpiSwiGLU E{(pb*)(ws + WS_HIDX), DFX, 28}; \
        pg8::gemm_phase<pg8::EpiSwiGLU, pg8::MoeOrder, PG8_ALIGN, PG8_SP2>(F.lds + RING_OFF, g, S, E); \
        if ((t0_) == 0) { const int nu = ntl * 28, remu = nu % F.G, first = remu ? remu : 0, ns = F.G - first;     \
            if (bid >= first) { __syncthreads(); px_expert_down(F, (bid - first) * NWAVES + F.wave, ns * NWAVES); } } } SEAM(kgu); \
    if (IN(kdn)) for (int rep_ = 0; rep_ < REPS(kdn); ++rep_) { REFRESH(); int base[8], ntiles; moe_bases(F, base, ntiles); const int t0 = (t0_), ntl = (ntiles - t0 < 0) ? 0 : ((ntiles - t0 < (cap_)) ? ntiles - t0 : (cap_)); \
        const int full = ntl < 64 ? ntl : 64, ex = ntl - full; \
        { pg8::Gemm g{(const pb*)(ws + WS_HIDX), (const pb*)(ws + WS_WXDN), 0, 0, DFX, DFX, DFX}; pg8::MoeOrder S; S.init(full, 4, F.G, bid, (const int*)(ws + WS_META + META_TEXP), t0); \
          pg8::EpiStore E{(pb*)(ws + WS_ASORT) + (size_t)t0 * 256 * 1024, 1024, 4}; \
          pg8::gemm_phase<pg8::EpiStore, pg8::MoeOrder, PG8_ALIGN, PG8_SP2>(F.lds + RING_OFF, g, S, E); } \
        if (ex > 0) { __syncthreads(); \
          pg8::Gemm g{(const pb*)(ws + WS_HIDX), (const pb*)(ws + WS_WXDN), 0, 0, MOE_KSL, DFX, DFX}; pg8::MoeSplitOrder S; S.init(ex, DFX / MOE_KSL, MOE_KSL, F.G, bid, (const int*)(ws + WS_META + META_TEXP), t0); \
          pg8::EpiMoePart E{(float*)(ws + ((t0_) ? WS_WXGU : WS_FIN2)), MOE_KSL}; \
          pg8::gemm_phase<pg8::EpiMoePart, pg8::MoeSplitOrder, PG8_ALIGN, PG8_SP2>(F.lds + RING_OFF, g, S, E); } } SEAM(kdn);
    MOE_PART(21, 22, 0, 68)
    MOE_PART(23, 24, 68, 68)
    if (IN(25)) for (int rep_ = 0; rep_ < REPS(25); ++rep_) { REFRESH(); rows_final(F);
#if defined(CHK_G1) || defined(CHK_SCAN)
        { const unsigned fb = __hip_atomic_load((unsigned*)(F.ctl + CW_CHK), RLX_AGENT) & CHK_MASK; if (fb != 0u) { VM_WAIT(); __syncthreads(); for (int i = F.gw * 64 + F.lane; i < NB * T * D; i += F.NGW * 64) F.out[i] = 0.f; } }
#endif
    }
#ifdef PROBE_PHASE
    STAMP(26);
    if (blockIdx.x == 0 && F.tid == 0) {
        const unsigned long long t0 = ((unsigned long long)F.MISC[65 + 2 * PROBE_PHASE] << 32) | F.MISC[64 + 2 * PROBE_PHASE], t1 = ((unsigned long long)F.MISC[65 + 2 * (PROBE_PHASE + PROBE_SPAN)] << 32) | F.MISC[64 + 2 * (PROBE_PHASE + PROBE_SPAN)];
        unsigned long long dly = (t1 - t0) * PROBE_MULT; if (dly > 2000000ull) dly = 2000000ull; const unsigned long long s0 = __builtin_amdgcn_s_memrealtime();
        while (__builtin_amdgcn_s_memrealtime() - s0 < dly) __builtin_amdgcn_s_sleep(8); }
#endif
#undef IN
#undef SEAM
}

extern "C" void kernel_launch(void* const* d_in, const int* in_sizes, int n_in, void* d_out, int out_size, void* d_ws, size_t ws_size, hipStream_t stream) {
    static int grid = 0;
    if (grid == 0) {
        if (n_in != 32 || in_sizes[0] != NB * T * D || out_size != NB * T * D || ws_size < WS_END) { fprintf(stderr, "kernel_launch: unexpected shapes: n_in %d in0 %d out %d ws %zu (need %zu)\n", n_in, n_in > 0 ? in_sizes[0] : -1, out_size, ws_size, (size_t)WS_END); grid = -1; return; }
        int dev = 0, cus = 0, per_cu = 0;
        if (hipGetDevice(&dev) != hipSuccess || hipDeviceGetAttribute(&cus, hipDeviceAttributeMultiprocessorCount, dev) != hipSuccess) { grid = -1; return; }
        if (hipFuncSetAttribute((const void*)trunk_fwd, hipFuncAttributeMaxDynamicSharedMemorySize, LDS_BYTES) != hipSuccess) { fprintf(stderr, "kernel_launch: hipFuncSetAttribute failed\n"); grid = -1; return; }
        if (hipOccupancyMaxActiveBlocksPerMultiprocessor(&per_cu, (const void*)trunk_fwd, NWAVES * 64, LDS_BYTES) != hipSuccess || per_cu < 1) fprintf(stderr, "kernel_launch: occupancy query reports %d\n", per_cu);
        (void)hipGetLastError();
        grid = cus;
    }
    if (grid < 0) return;
    if (hipMemsetAsync((char*)d_ws + WS_CTL, 0, CTL_ZERO_BYTES, stream) != hipSuccess) return;
#ifdef DIAG_POISON
    (void)hipMemsetAsync((char*)d_ws + WS_GDNI, 0xFF, (size_t)64 * 68 * 32768, stream);
    (void)hipMemsetAsync((char*)d_ws + WS_OG, 0xFF, (size_t)NR * 1024 * 2, stream);
    (void)hipMemsetAsync((char*)d_ws + WS_QKVN, 0xFF, (size_t)NR * 1536 * 2, stream);
    (void)hipMemsetAsync((char*)d_ws + WS_GB, 0xFF, (size_t)NR * 32 * 4, stream);
#endif
    Args a{};
    for (int i = 0; i < 32; ++i) a.in[i] = (const float*)d_in[i];
    a.out = (float*)d_out; a.ws = (unsigned char*)d_ws;
#if MK_N_LAUNCHES == 1
    a.ph_lo = 0; a.ph_hi = N_PHASES;
    hipLaunchKernelGGL(trunk_fwd, dim3(grid), dim3(NWAVES * 64), LDS_BYTES, stream, a);
#else
    for (int p = 0; p < N_PHASES && p <= MK_LAST_PHASE; ++p) { a.ph_lo = p; a.ph_hi = p + 1; hipLaunchKernelGGL(trunk_fwd, dim3(grid), dim3(NWAVES * 64), LDS_BYTES, stream, a); }
#endif
    const hipError_t le = hipPeekAtLastError();
    if (le != hipSuccess) fprintf(stderr, "kernel_launch: launch failed: %s\n", hipGetErrorName(le));
}
```

```cpp
#include <hip/hip_runtime.h>
#include <cstdio>
#include <cstdint>
#include <cmath>

#ifndef MK_N_LAUNCHES
#define MK_N_LAUNCHES 1
#endif
#define SOLVE_C_FMA 1
#define SOLVE_C_LOAD 1
#ifndef G1_LOCK
#define G1_LOCK 0
#ifndef SCAN_PF
#define SCAN_PF 8
#endif
#ifndef SCAN_UNROLL
#define SCAN_UNROLL 1
#endif
#ifndef MOE_KSL
#define MOE_KSL 512
#endif
#endif
#ifndef MK_LAST_PHASE
#define MK_LAST_PHASE 99
#endif

constexpr int NB = 4, T = 4096, TC = 256, SROW = T + TC  , NR = NB * SROW  , D = 1024;
constexpr int EIN = 2848, EINP = 3072, OIN = 2208, OINP = 2304, DFF = 2816, DFX = 3584, NEXP = 8;
constexpr float EPS = 1e-6f;
constexpr int E_Q = 0, E_K = 512, E_V = 1024, E_Z = 1536, E_GA = 2048, E_GB = 2064, E_SQ = 2080, E_SK = 2592, E_SV = 2720;
constexpr int O_CQ = 0, O_CKV = 384, O_KR = 640, O_DQ = 672, O_DK = 1184, O_DV = 1696;

constexpr size_t MiB = 1u << 20;
constexpr size_t WS_CTL = 0, CTL_ZERO_BYTES = 1 * MiB;
constexpr size_t WS_MODV = 1 * MiB;
constexpr size_t WS_GB = 2 * MiB;
constexpr size_t WS_META = 5 * MiB;
constexpr size_t WS_HCTX = 8 * MiB;
constexpr size_t WS_WEIN = 12 * MiB, WS_WEOUT = 18 * MiB, WS_WEGU = 20 * MiB, WS_WEDN = 31 * MiB, WS_WOIN = 37 * MiB, WS_WUQ = 42 * MiB, WS_WUKV = 43 * MiB, WS_WOOUT = 44 * MiB;
constexpr size_t WS_BIG = 46 * MiB;
constexpr size_t WS_PROJ = 46 * MiB, WS_QKVN = 148 * MiB;
constexpr size_t WS_PROJ2 = 46 * MiB, WS_QM = 123 * MiB, WS_VMLA = 149 * MiB, WS_KMLA = 167 * MiB, WS_ODIFF = 316 * MiB;
constexpr size_t WS_WXGU = 46 * MiB, WS_WXDN = 158 * MiB;
constexpr size_t WS_CQN = 214 * MiB;
constexpr size_t WS_ABUF = 214 * MiB, WS_MIX = 248 * MiB, WS_YBUF = 282 * MiB;
constexpr size_t WS_OG = 214 * MiB;
constexpr size_t WS_PART = 350 * MiB;
constexpr size_t WS_GDNI = 282 * MiB;
constexpr size_t WS_HID = 46 * MiB;
constexpr size_t WS_ASORT = 214 * MiB;
constexpr size_t WS_FIN2 = 282 * MiB;
constexpr size_t WS_Y2 = 316 * MiB;
constexpr size_t WS_HIDX = 316 * MiB;
constexpr size_t WS_XB = 436 * MiB;
constexpr size_t WS_END = 470 * MiB;
static_assert(WS_QKVN + (size_t)NR * 1536 * 2 <= 214 * MiB && WS_PROJ + (size_t)NR * EINP * 2 <= WS_QKVN, "layer-0 big region");
static_assert(WS_PROJ2 + (size_t)NR * OINP * 2 <= WS_QM && WS_QM + (size_t)NR * 768 * 2 <= WS_VMLA && WS_VMLA + (size_t)NR * 512 * 2 <= WS_KMLA && WS_KMLA + (size_t)NR * 768 * 2 <= 214 * MiB, "layer-1 big region");
static_assert(WS_WXGU + (size_t)NEXP * 7168 * 1024 * 2 <= WS_WXDN && WS_WXDN + (size_t)NEXP * 1024 * 3584 * 2 <= 214 * MiB, "expert weights");
static_assert(WS_HIDX + (size_t)17408 * 3584 * 2 <= WS_END && WS_ASORT + (size_t)34816 * 1024 * 2 <= WS_FIN2 && WS_HID + (size_t)NR * DFF * 2 <= 214 * MiB, "moe map");
constexpr size_t META_TOPI = 0, META_TOPW = 128 * 1024, META_RANK = 256 * 1024, META_RSTD = 384 * 1024, META_BLKB = 960 * 1024;
constexpr int CW_TMO = 0, CW_CODE = 1;
constexpr int CW_MOECNT = 64;
constexpr int CW_SWAQ = 2048;
constexpr int CW_CHK = 1024;
constexpr int CW_BAR = 4096;
constexpr int RING_OFF = 0, RING_BYTES = 141312;
constexpr int MISC_OFF = RING_BYTES;
constexpr int LDS_BYTES = 147456;
constexpr int NWAVES = 8;
namespace pg8 {
#define PG8_LAS __attribute__((address_space(3)))
typedef unsigned short bf16_t;
typedef short bf16x8 __attribute__((ext_vector_type(8)));
typedef float f32x4 __attribute__((ext_vector_type(4)));
typedef unsigned u32x4 __attribute__((ext_vector_type(4)));
constexpr int BM = 256, BK = 64, HALF = 128, HTB = HALF * BK * 2  , STAGE_BYTES = 8 * HTB, NXCD = 8, WGM = 8;

__host__ __device__ __forceinline__ int lds_byte(int r, int c) { const int st = (r >> 4) * 2 + (c >> 5), rr = r & 15, cc = c & 31, ob = rr * 64 + cc * 2; return st * 1024 + (ob ^ (((ob >> 9) & 1) << 5)); }
__host__ __device__ __forceinline__ void stage_rc(int b, int& R, int& C) { const int st = b / 1024, sb = b % 1024, swz = sb ^ (((sb >> 9) & 1) << 5); R = (st >> 1) * 16 + swz / 64; C = (st & 1) * 32 + (swz % 64) / 2; }
__host__ __device__ __forceinline__ int perm32(int rho) { const int n = rho >> 4, i = rho & 15; return 8 * (i >> 2) + 4 * n + (i & 3); }

struct Unit { int pm, pn, kof; };
struct Gemm { const bf16_t* A; const bf16_t* Bt; int M, N, K, lda, ldb; };

struct StaticOrder {
    int nM, nN, nwg, G, c;
    __host__ __device__ void init(int M, int N, int G_, int c_) { nM = M / BM; nN = N / BM; nwg = nM * nN; G = G_; c = c_; }
    __host__ __device__ bool next(int i, Unit& u) const {
        const long L = (long)i * G + c; if (L >= nwg) return false;
        int wgid = (int)L; { const int q = nwg / NXCD, r = nwg % NXCD, xcd = wgid % NXCD, off = wgid / NXCD; wgid = (xcd < r ? xcd * (q + 1) : r * (q + 1) + (xcd - r) * q) + off; }
        const int nig = WGM * nN, gid = wgid / nig, fm = gid * WGM, gsz = (nM - fm) < WGM ? (nM - fm) : WGM;
        u.pm = fm + ((wgid % nig) % gsz); u.pn = (wgid % nig) / gsz; u.kof = 0; return true;
    }
    __device__ __forceinline__ void a_ready(const Unit&) const {}
    __device__ __forceinline__ void done(const Unit&) const {}
};

__device__ __forceinline__ unsigned cvt_pk_bf16(float lo, float hi) { unsigned r; asm volatile("v_cvt_pk_bf16_f32 %0, %1, %2" : "=v"(r) : "v"(lo), "v"(hi)); return r; }
typedef float f32x2 __attribute__((ext_vector_type(2)));
template <class Epi, class Sched, bool ALIGN_EPI = false, bool SP2 = false>
__device__ __forceinline__ void gemm_phase(PG8_LAS unsigned char* lds, const Gemm g, const Sched& S, const Epi& E) {
    const int tid = threadIdx.x, wid = __builtin_amdgcn_readfirstlane(tid >> 6), lane = tid & 63, wr = wid >> 2, wc = wid & 3, fr = lane & 15, fq = lane >> 4;
    const int K = g.K, nt = K / BK;
    unsigned voffA[2], voffB[2];
#pragma unroll
    for (int i = 0; i < 2; ++i) { int R, C; stage_rc(tid * 16 + i * 8192, R, C); const int Rb = Epi::PERM ? ((R & ~31) + perm32(R & 31)) : R;
        voffA[i] = (unsigned)(R * g.lda + C) * 2u; voffB[i] = (unsigned)(Rb * g.ldb + C) * 2u; }
    const size_t kstep = (size_t)(BK * 2);
    const size_t hstepA = (size_t)HALF * g.lda * 2, hstepB = (size_t)HALF * g.ldb * 2;
    const size_t tstepA = 2 * hstepA, tstepB = 2 * hstepB;
    const unsigned ldsw = (unsigned)wid * 1024u;
    const int aoff = lds_byte(wr * 64 + fr, fq * 8), boff = lds_byte(wc * 32 + fr, fq * 8);
#define PG8_SA(b, h) (((b) * 2 + (h)) * HTB)
#define PG8_SB(b, h) ((4 + (b) * 2 + (h)) * HTB)
#define PG8_STAGE(bufoff, gbase, voff) do { _Pragma("unroll") for (int _i = 0; _i < 2; ++_i) \
        __builtin_amdgcn_global_load_lds((const unsigned*)((const char*)(gbase) + (voff)[_i]), (PG8_LAS unsigned*)(lds + (bufoff) + ldsw + _i * 8192), 16, 0, 0); } while (0)
#define PG8_LDA(dst, b, h) do { _Pragma("unroll") for (int m = 0; m < 4; ++m) _Pragma("unroll") for (int k = 0; k < 2; ++k) dst[m][k] = *(const PG8_LAS bf16x8*)(lds + PG8_SA(b, h) + aoff + m * 2048 + k * 1024); } while (0)
#define PG8_LDB(dst, b, h) do { _Pragma("unroll") for (int n = 0; n < 2; ++n) _Pragma("unroll") for (int k = 0; k < 2; ++k) dst[n][k] = *(const PG8_LAS bf16x8*)(lds + PG8_SB(b, h) + boff + n * 2048 + k * 1024); } while (0)
#define PG8_MMA(ai, bj, At, Bt) do { __builtin_amdgcn_s_setprio(1); _Pragma("unroll") for (int m = 0; m < 4; ++m) _Pragma("unroll") for (int n = 0; n < 2; ++n) _Pragma("unroll") for (int k = 0; k < 2; ++k) \
        acc[ai][bj][m][n] = __builtin_amdgcn_mfma_f32_16x16x32_bf16(Bt[n][k], At[m][k], acc[ai][bj][m][n], 0, 0, 0); __builtin_amdgcn_s_setprio(0); } while (0)
#define PG8_WAIT_V(n) asm volatile("s_waitcnt vmcnt(" #n ")" ::: "memory")
#define PG8_WAIT_L(n) asm volatile("s_waitcnt lgkmcnt(" #n ")" ::: "memory")
#define PG8_BAR __builtin_amdgcn_s_barrier()
#define PG8_SCHED __builtin_amdgcn_sched_barrier(0)
    Unit cur, nxt; int ui = 0;
    if (!S.next(0, cur)) return;
    f32x4 acc[2][2][4][2];
#pragma unroll
    for (int a = 0; a < 2; ++a)
#pragma unroll
        for (int b = 0; b < 2; ++b)
#pragma unroll
            for (int m = 0; m < 4; ++m)
#pragma unroll
                for (int n = 0; n < 2; ++n) acc[a][b][m][n] = (f32x4){0.f, 0.f, 0.f, 0.f};
    bf16x8 At[4][2], B0[2][2], B1[2][2];
    const char* cA = (const char*)g.A + (size_t)cur.pm * tstepA + (size_t)cur.kof * 2; const char* cB = (const char*)g.Bt + (size_t)cur.pn * tstepB + (size_t)cur.kof * 2;
    S.a_ready(cur);
    if constexpr (SP2) {
        PG8_STAGE(PG8_SB(0, 0), cB, voffB); PG8_STAGE(PG8_SB(0, 1), cB + hstepB, voffB); PG8_STAGE(PG8_SA(0, 0), cA, voffA); PG8_STAGE(PG8_SA(0, 1), cA + hstepA, voffA);
        if (wr == 1) PG8_BAR;
        PG8_WAIT_V(2); PG8_BAR;
        PG8_STAGE(PG8_SB(1, 0), cB + kstep, voffB); PG8_STAGE(PG8_SA(1, 0), cA + kstep, voffA); PG8_STAGE(PG8_SB(1, 1), cB + hstepB + kstep, voffB);
        PG8_WAIT_V(6); PG8_BAR;
    } else {
        PG8_STAGE(PG8_SB(0, 0), cB, voffB); PG8_STAGE(PG8_SA(0, 0), cA, voffA); PG8_STAGE(PG8_SB(0, 1), cB + hstepB, voffB); PG8_STAGE(PG8_SA(0, 1), cA + hstepA, voffA);
        if (wr == 1) PG8_BAR;
        PG8_WAIT_V(4); PG8_BAR;
        PG8_STAGE(PG8_SB(1, 0), cB + kstep, voffB); PG8_STAGE(PG8_SA(1, 0), cA + kstep, voffA); PG8_STAGE(PG8_SB(1, 1), cB + hstepB + kstep, voffB);
        PG8_WAIT_V(6); PG8_BAR;
    }
    for (;;) {
        const bool has_next = S.next(ui + 1, nxt);
        const char* nA = has_next ? (const char*)g.A + (size_t)nxt.pm * tstepA + (size_t)nxt.kof * 2 : cA; const char* nB = has_next ? (const char*)g.Bt + (size_t)nxt.pn * tstepB + (size_t)nxt.kof * 2 : cB;
        _Pragma("unroll 1") for (int t = 0; t < nt; t += 2) {
            const bool last = (t == nt - 2);
            const char* a1 = cA + (size_t)(t + 1) * kstep;
            const char* a2 = last ? nA : cA + (size_t)(t + 2) * kstep; const char* b2 = last ? nB : cB + (size_t)(t + 2) * kstep;
            const char* a3 = a2 + kstep; const char* b3 = b2 + kstep;
            if (last && has_next) S.a_ready(nxt);
            if constexpr (SP2) {
            PG8_LDB(B0, 0, 0); PG8_LDB(B1, 0, 1); PG8_SCHED; PG8_LDA(At, 0, 0); PG8_STAGE(PG8_SA(1, 1), a1 + hstepA, voffA);
            PG8_WAIT_V(8); PG8_WAIT_L(0); PG8_BAR; PG8_MMA(0, 0, At, B0); PG8_MMA(0, 1, At, B1); PG8_BAR; PG8_SCHED;
            PG8_LDA(At, 0, 1); PG8_STAGE(PG8_SB(0, 0), b2, voffB); PG8_STAGE(PG8_SB(0, 1), b2 + hstepB, voffB); PG8_STAGE(PG8_SA(0, 0), a2, voffA);
            PG8_WAIT_V(8); PG8_WAIT_L(0); PG8_BAR; PG8_MMA(1, 0, At, B0); PG8_MMA(1, 1, At, B1); PG8_BAR; PG8_SCHED;
            PG8_LDB(B0, 1, 0); PG8_LDB(B1, 1, 1); PG8_SCHED; PG8_LDA(At, 1, 0); PG8_STAGE(PG8_SA(0, 1), a2 + hstepA, voffA);
            PG8_WAIT_V(8); PG8_WAIT_L(0); PG8_BAR; PG8_MMA(0, 0, At, B0); PG8_MMA(0, 1, At, B1); PG8_BAR; PG8_SCHED;
            PG8_LDA(At, 1, 1); PG8_STAGE(PG8_SB(1, 0), b3, voffB); PG8_STAGE(PG8_SB(1, 1), b3 + hstepB, voffB); PG8_STAGE(PG8_SA(1, 0), a3, voffA);
            PG8_WAIT_V(8); PG8_WAIT_L(0); PG8_BAR; PG8_MMA(1, 0, At, B0); PG8_MMA(1, 1, At, B1); PG8_BAR; PG8_SCHED;
            } else {
            PG8_LDB(B0, 0, 0); PG8_SCHED; PG8_LDA(At, 0, 0); PG8_STAGE(PG8_SA(1, 1), a1 + hstepA, voffA);
            PG8_WAIT_L(8); PG8_BAR; PG8_WAIT_L(0); PG8_MMA(0, 0, At, B0); PG8_BAR; PG8_SCHED;
            PG8_LDB(B1, 0, 1); PG8_STAGE(PG8_SB(0, 0), b2, voffB);
            PG8_BAR; PG8_WAIT_L(0); PG8_MMA(0, 1, At, B1); PG8_BAR;
            PG8_LDA(At, 0, 1); PG8_STAGE(PG8_SA(0, 0), a2, voffA);
            PG8_BAR; PG8_WAIT_L(0); PG8_MMA(1, 0, At, B0); PG8_BAR; PG8_SCHED;
            PG8_STAGE(PG8_SB(0, 1), b2 + hstepB, voffB);
            PG8_WAIT_V(6); PG8_BAR; PG8_MMA(1, 1, At, B1); PG8_BAR;
            PG8_LDB(B0, 1, 0); PG8_SCHED; PG8_LDA(At, 1, 0); PG8_STAGE(PG8_SA(0, 1), a2 + hstepA, voffA);
            PG8_WAIT_L(8); PG8_BAR; PG8_WAIT_L(0); PG8_MMA(0, 0, At, B0); PG8_BAR; PG8_SCHED;
            PG8_LDB(B1, 1, 1); PG8_STAGE(PG8_SB(1, 0), b3, voffB);
            PG8_BAR; PG8_WAIT_L(0); PG8_MMA(0, 1, At, B1); PG8_BAR;
            PG8_LDA(At, 1, 1); PG8_STAGE(PG8_SA(1, 0), a3, voffA);
            PG8_BAR; PG8_WAIT_L(0); PG8_MMA(1, 0, At, B0); PG8_BAR; PG8_SCHED;
            PG8_STAGE(PG8_SB(1, 1), b3 + hstepB, voffB);
            PG8_WAIT_V(6); PG8_BAR; PG8_MMA(1, 1, At, B1); PG8_BAR;
            }
        }
        if constexpr (ALIGN_EPI) { if (wr == 0) PG8_BAR; }
        if constexpr (!Epi::AFTER_DRAIN) { E(acc, cur, wr, wc, fr, fq); S.done(cur); }
        if (!has_next) break;
#pragma unroll
        for (int a = 0; a < 2; ++a)
#pragma unroll
            for (int b = 0; b < 2; ++b)
#pragma unroll
                for (int m = 0; m < 4; ++m)
#pragma unroll
                    for (int n = 0; n < 2; ++n) acc[a][b][m][n] = (f32x4){0.f, 0.f, 0.f, 0.f};
        cur = nxt; cA = nA; cB = nB; ++ui;
        if constexpr (ALIGN_EPI) { if (wr == 1) PG8_BAR; }
    }
    PG8_WAIT_V(0);
    if constexpr (!ALIGN_EPI) { if (wr == 0) PG8_BAR; }
    PG8_BAR;
    if constexpr (Epi::AFTER_DRAIN) { E.fused(acc, cur, wr, wc, fr, fq, lds, wid, lane); S.done(cur); }
#undef PG8_SA
#undef PG8_SB
#undef PG8_STAGE
#undef PG8_LDA
#undef PG8_LDB
#undef PG8_MMA
#undef PG8_WAIT_V
#undef PG8_WAIT_L
#undef PG8_BAR
#undef PG8_SCHED
}
}
namespace pg8 {
struct EpiStore { static constexpr bool PERM = true, AFTER_DRAIN = false;
    bf16_t* O; int ldc; int nN;
    __device__ __forceinline__ void operator()(const f32x4 (&acc)[2][2][4][2], const Unit& u, int wr, int wc, int fr, int fq) const {
        const int row0 = u.pm * BM + wr * 64 + fr, col0 = (u.pn % nN) * BM + wc * 32 + 8 * fq;
#pragma unroll
        for (int ai = 0; ai < 2; ++ai)
#pragma unroll
            for (int m = 0; m < 4; ++m) { const int row = row0 + ai * HALF + m * 16;
                bf16_t* rowp = O + (size_t)row * ldc + col0;
#pragma unroll
                for (int bj = 0; bj < 2; ++bj) { const f32x4 v0 = acc[ai][bj][m][0], v1 = acc[ai][bj][m][1];
                    u32x4 w; w.x = cvt_pk_bf16(v0[0], v0[1]); w.y = cvt_pk_bf16(v0[2], v0[3]); w.z = cvt_pk_bf16(v1[0], v1[1]); w.w = cvt_pk_bf16(v1[2], v1[3]);
                    *(u32x4*)(rowp + bj * HALF) = w; } }
    }
};
struct EpiSwiGLU { static constexpr bool PERM = true, AFTER_DRAIN = false;
    bf16_t* O; int ldc; int nN;
    __device__ __forceinline__ void operator()(const f32x4 (&acc)[2][2][4][2], const Unit& u, int wr, int wc, int fr, int fq) const {
        const int row0 = u.pm * BM + wr * 64 + fr, col0 = (u.pn % nN) * HALF + wc * 32 + 8 * fq;
#pragma unroll
        for (int ai = 0; ai < 2; ++ai)
#pragma unroll
            for (int m = 0; m < 4; ++m) { bf16_t* rowp = O + (size_t)(row0 + ai * HALF + m * 16) * ldc + col0;
                float h[8];
#pragma unroll
                for (int n = 0; n < 2; ++n)
#pragma unroll
                    for (int j = 0; j < 4; ++j) { const float g = acc[ai][0][m][n][j], up = acc[ai][1][m][n][j]; h[n * 4 + j] = g * __builtin_amdgcn_rcpf(1.f + __expf(-g)) * up; }
                u32x4 w; w.x = cvt_pk_bf16(h[0], h[1]); w.y = cvt_pk_bf16(h[2], h[3]); w.z = cvt_pk_bf16(h[4], h[5]); w.w = cvt_pk_bf16(h[6], h[7]);
                *(u32x4*)rowp = w; }
    }
};
struct EpiKV { static constexpr bool PERM = true, AFTER_DRAIN = false;
    bf16_t* KM; bf16_t* VM;
    __device__ __forceinline__ void operator()(const f32x4 (&acc)[2][2][4][2], const Unit& u, int wr, int wc, int fr, int fq) const {
        const int row0 = u.pm * BM + wr * 64 + fr, within = wc * 32 + 8 * fq;
#pragma unroll
        for (int ai = 0; ai < 2; ++ai)
#pragma unroll
            for (int m = 0; m < 4; ++m) { const int row = row0 + ai * HALF + m * 16;
#pragma unroll
                for (int bj = 0; bj < 2; ++bj) { const int h = 2 * u.pn + bj; const f32x4 v0 = acc[ai][bj][m][0], v1 = acc[ai][bj][m][1];
                    u32x4 w; w.x = cvt_pk_bf16(v0[0], v0[1]); w.y = cvt_pk_bf16(v0[2], v0[3]); w.z = cvt_pk_bf16(v1[0], v1[1]); w.w = cvt_pk_bf16(v1[2], v1[3]);
                    bf16_t* p = (within < 64) ? KM + (size_t)row * 768 + h * 96 + within : VM + (size_t)row * 512 + h * 64 + (within - 64);
                    *(u32x4*)p = w; } }
    }
};
struct CtxSplitOrder { int nsl, ksl, G, c;
    __device__ void init(int nsl_, int ksl_, int G_, int c_) { nsl = nsl_; ksl = ksl_; G = G_; c = c_; }
    __device__ bool next(int i, Unit& u) const { const int L = i * G + c; if (L >= 16 * nsl) return false; const int sl = L >> 4, rem = L & 15; u.pm = (rem >> 2) * 17; u.pn = rem & 3; u.kof = sl * ksl; return true; }
    __device__ __forceinline__ void a_ready(const Unit&) const {}
    __device__ __forceinline__ void done(const Unit&) const {}
};
struct EpiPartF32 { static constexpr bool PERM = false, AFTER_DRAIN = false;
    float* P; int ksl;
    __device__ __forceinline__ void operator()(const f32x4 (&acc)[2][2][4][2], const Unit& u, int wr, int wc, int fr, int fq) const {
        float* base = P + ((size_t)(u.kof / ksl) * 1024 + (size_t)(u.pm / 17) * 256) * 1024; const int row0 = wr * 64 + fr, col0 = u.pn * BM + wc * 32 + 4 * fq;
#pragma unroll
        for (int ai = 0; ai < 2; ++ai)
#pragma unroll
            for (int m = 0; m < 4; ++m) { float* rowp = base + (size_t)(row0 + ai * HALF + m * 16) * 1024 + col0;
#pragma unroll
                for (int bj = 0; bj < 2; ++bj)
#pragma unroll
                    for (int n = 0; n < 2; ++n) *(f32x4*)(rowp + bj * HALF + n * 16) = acc[ai][bj][m][n]; }
    }
};
struct LatOrder { StaticOrder so;
    __device__ void init(int N, int G, int c) { so.nM = 64; so.nN = N / BM; so.nwg = 64 * so.nN; so.G = G; so.c = c; }
    __device__ bool next(int i, Unit& u) const { if (!so.next(i, u)) return false; u.pm = (u.pm >> 4) * 17 + 1 + (u.pm & 15); return true; }
    __device__ __forceinline__ void a_ready(const Unit&) const {}
    __device__ __forceinline__ void done(const Unit&) const {}
};
struct MoeOrder { StaticOrder so; const int* texp; int t0, nNe;
    __device__ void init(int ntiles, int nNe_, int G, int c, const int* texp_, int t0_) { so.nM = ntiles; so.nN = nNe_; so.nwg = ntiles * nNe_; so.G = G; so.c = c; texp = texp_; t0 = t0_; nNe = nNe_; }
    __device__ bool next(int i, Unit& u) const { if (!so.next(i, u)) return false; const int e = __builtin_amdgcn_readfirstlane(texp[t0 + u.pm]); u.pn = e * nNe + u.pn; return true; }
    __device__ __forceinline__ void a_ready(const Unit&) const {}
    __device__ __forceinline__ void done(const Unit&) const {}
};
struct MoeSplitOrder { int ex4, nsl, ksl, G, c, t0; const int* texp;
    __device__ void init(int ex, int nsl_, int ksl_, int G_, int c_, const int* texp_, int t0_) { ex4 = ex * 4; nsl = nsl_; ksl = ksl_; G = G_; c = c_; texp = texp_; t0 = t0_; }
    __device__ bool next(int i, Unit& u) const { const int L = i * G + c; if (L >= ex4 * nsl) return false; const int sl = L / ex4, rem = L - sl * ex4; u.pm = 64 + (rem >> 2);
        const int e = __builtin_amdgcn_readfirstlane(texp[t0 + u.pm]); u.pn = e * 4 + (rem & 3); u.kof = sl * ksl; return true; }
    __device__ __forceinline__ void a_ready(const Unit&) const {}
    __device__ __forceinline__ void done(const Unit&) const {}
};
struct EpiMoePart { static constexpr bool PERM = false, AFTER_DRAIN = false;
    float* P; int ksl;
    __device__ __forceinline__ void operator()(const f32x4 (&acc)[2][2][4][2], const Unit& u, int wr, int wc, int fr, int fq) const {
        float* base = P + ((size_t)(u.kof / ksl) * 4 + (size_t)(u.pm - 64)) * 256 * 1024; const int row0 = wr * 64 + fr, col0 = (u.pn & 3) * BM + wc * 32 + 4 * fq;
#pragma unroll
        for (int ai = 0; ai < 2; ++ai)
#pragma unroll
            for (int m = 0; m < 4; ++m) { float* rowp = base + (size_t)(row0 + ai * HALF + m * 16) * 1024 + col0;
#pragma unroll
                for (int bj = 0; bj < 2; ++bj)
#pragma unroll
                    for (int n = 0; n < 2; ++n) *(f32x4*)(rowp + bj * HALF + n * 16) = acc[ai][bj][m][n]; }
    }
};
}
#define PG8_SP2 true
#define PG8_ALIGN true
#define GAS __attribute__((address_space(1)))
#define LAS __attribute__((address_space(3)))
typedef unsigned short bf16;
typedef unsigned v4u __attribute__((ext_vector_type(4)));
typedef unsigned v2u __attribute__((ext_vector_type(2)));
typedef float f32x4 __attribute__((ext_vector_type(4)));
typedef short bf16x8 __attribute__((ext_vector_type(8)));
typedef GAS unsigned gu32;
#define RLX_AGENT __ATOMIC_RELAXED, __HIP_MEMORY_SCOPE_AGENT
#define LDS_WAIT() asm volatile("s_waitcnt lgkmcnt(0)" ::: "memory")
#define VM_WAIT() asm volatile("s_waitcnt vmcnt(0)" ::: "memory")
__device__ __forceinline__ unsigned f2bf(float f) { unsigned u = __builtin_bit_cast(unsigned, f); return (u + 0x7fffu + ((u >> 16) & 1u)) >> 16; }
__device__ __forceinline__ unsigned pk2(float lo, float hi) { return f2bf(lo) | (f2bf(hi) << 16); }
__device__ __forceinline__ float bf2f(unsigned short b) { return __builtin_bit_cast(float, ((unsigned)b) << 16); }
__device__ __forceinline__ float bflo(unsigned w) { return __builtin_bit_cast(float, w << 16); }
__device__ __forceinline__ float bfhi(unsigned w) { return __builtin_bit_cast(float, w & 0xffff0000u); }
__device__ __forceinline__ float wave_sum(float v) {
#pragma unroll
    for (int o = 1; o < 64; o <<= 1) v += __shfl_xor(v, o);
    return v;
}
__device__ __forceinline__ float siluf(float x) { return x / (1.f + __expf(-x)); }
#define XB_TMO      128
#define XB_XCNT(j)  (256  + 64 * (j))
#define XB_XSUB(j)  (1280 + 64 * (j))
#define XB_XGEN(j)  (2304 + 64 * (j))
#define XB_TOP      3328
#define XB_TOPGEN   3392
#define XCD_BAR_WORDS 3456
#define XB_SPIN_CAP (1u << 18)

__device__ __forceinline__ unsigned xb_ld(unsigned* p)              { return __hip_atomic_load(p, __ATOMIC_RELAXED, __HIP_MEMORY_SCOPE_AGENT); }
__device__ __forceinline__ unsigned xb_add(unsigned* p, unsigned v) { return __hip_atomic_fetch_add(p, v, __ATOMIC_RELAXED, __HIP_MEMORY_SCOPE_AGENT); }
__device__ __forceinline__ unsigned xb_xcc_id() { return (unsigned)__builtin_amdgcn_s_getreg((3 << 11) | 20) & 0xFu; }
#define XB_SPIN(cond, bar) do { unsigned _sp = 0; while (cond) { __builtin_amdgcn_s_sleep(1); \
    if ((++_sp & 255u) == 0u) { if (xb_ld(&(bar)[XB_TMO])) break; if (_sp > XB_SPIN_CAP) { atomicAdd(&(bar)[XB_TMO], 1u); break; } } } } while (0)

struct XcdBarrier {
    unsigned* bar; unsigned x;
    volatile LAS unsigned* st;
};

__device__ __forceinline__ XcdBarrier xcd_barrier_post(unsigned* bar, volatile LAS unsigned* st) {
    XcdBarrier b; b.bar = bar; b.x = xb_xcc_id(); b.st = st;
    if (threadIdx.x == 0) (void)xb_add(&bar[XB_XCNT(b.x)], 1u);
    return b;
}
__device__ __forceinline__ void xcd_barrier_complete(unsigned* bar, unsigned x, unsigned& nloc, unsigned& nx) {
    const unsigned G = gridDim.x * gridDim.y * gridDim.z;
    unsigned sum, cnt, mine, sp = 0u;
    for (;;) {
        sum = 0u; cnt = 0u; mine = 0u;
#pragma unroll
        for (unsigned j = 0; j < 16; ++j) { const unsigned c = xb_ld(&bar[XB_XCNT(j)]); sum += c; cnt += (c > 0u) ? 1u : 0u; mine = (j == x) ? c : mine; }
        if (sum == G) break;
        __builtin_amdgcn_s_sleep(1);
        if ((++sp & 255u) == 0u) { if (xb_ld(&bar[XB_TMO])) break; if (sp > XB_SPIN_CAP) { atomicAdd(&bar[XB_TMO], 1u); break; } }
    }
    nloc = mine > 0u ? mine : 1u; nx = cnt > 0u ? cnt : 1u;
}

__device__ __forceinline__ void xcd_barrier(const XcdBarrier& b) {
    asm volatile("s_waitcnt vmcnt(0)" ::: "memory");
    __syncthreads();
    if (threadIdx.x == 0) {
        unsigned* bar = b.bar;
        __builtin_amdgcn_s_waitcnt(0);
        unsigned nloc = b.st[0], nx = b.st[1];
        if (nloc == 0u) { xcd_barrier_complete(bar, b.x, nloc, nx); b.st[0] = nloc; b.st[1] = nx; }
        const unsigned old = xb_add(&bar[XB_XSUB(b.x)], 1u);
        const unsigned gen = old / nloc;
        if (old + 1u == (gen + 1u) * nloc) {
            __builtin_amdgcn_fence(__ATOMIC_RELEASE, "agent");
            asm volatile("s_waitcnt vmcnt(0)" ::: "memory");
            const unsigned og = xb_add(&bar[XB_TOP], 1u);
            const unsigned tg = og / nx;
            if (og + 1u == (tg + 1u) * nx) xb_add(&bar[XB_TOPGEN], 1u);
            else XB_SPIN(xb_ld(&bar[XB_TOPGEN]) == tg, bar);
            __builtin_amdgcn_fence(__ATOMIC_ACQUIRE, "agent");
            xb_add(&bar[XB_XGEN(b.x)], 1u);
            asm volatile("s_waitcnt vmcnt(0)" ::: "memory");
        } else {
            XB_SPIN(xb_ld(&bar[XB_XGEN(b.x)]) == gen, bar);
            __builtin_amdgcn_fence(__ATOMIC_ACQUIRE, "agent");
            asm volatile("s_waitcnt vmcnt(0)" ::: "memory");
        }
    }
    __syncthreads();
}
namespace att {
using bf16x8 = __attribute__((ext_vector_type(8))) short;
using s16x4  = __attribute__((ext_vector_type(4))) short;
using f32x16 = __attribute__((ext_vector_type(16))) float;
using u32x4  = __attribute__((ext_vector_type(4))) unsigned;
constexpr int NW = 8, QBLK = 32, KVBLK = 64;
constexpr size_t SHM_V = KVBLK * 128 * 2, SHM_K = KVBLK * 128 * 2, SHM_ATTN = 2 * SHM_V + 2 * SHM_K + NW * 64 * 4;
constexpr float THR = 8.f;
#define KSWZ(row, colB) ((row) * 256 + ((colB) ^ (((row) & 7) << 4)))
#define SBAR() __builtin_amdgcn_sched_barrier(0)
__device__ __forceinline__ int crow(int r, int hi) { return (r & 3) + 8 * (r >> 2) + 4 * hi; }
__device__ __forceinline__ unsigned cvtpk(float lo, float hi) { unsigned r; asm volatile("v_cvt_pk_bf16_f32 %0, %1, %2" : "=v"(r) : "v"(lo), "v"(hi)); return r; }
__device__ __forceinline__ void partialSM(f32x16& p0, f32x16& p1, float& m_reg, float& mn, float& alpha, float C, float thr_s) {
  float pmax = p0[0];
#pragma unroll
  for (int r = 1; r < 16; ++r) pmax = fmaxf(pmax, p0[r]);
#pragma unroll
  for (int r = 0; r < 16; ++r) pmax = fmaxf(pmax, p1[r]);
  { auto rr = __builtin_amdgcn_permlane32_swap(__float_as_uint(pmax), __float_as_uint(pmax), false, false);
    pmax = fmaxf(__uint_as_float(rr[0]), __uint_as_float(rr[1])); }
  if (__builtin_expect(__all(pmax - m_reg <= thr_s), 1)) { mn = m_reg; alpha = 1.f; }
  else { mn = fmaxf(m_reg, pmax); alpha = __builtin_amdgcn_exp2f((m_reg - mn) * C); m_reg = mn; }
  const float mnC = -mn * C;
#pragma unroll
  for (int r = 0; r < 16; ++r) p0[r] = fmaf(p0[r], C, mnC);
#pragma unroll
  for (int r = 0; r < 16; ++r) p1[r] = fmaf(p1[r], C, mnC);
#pragma unroll
  for (int r = 0; r < 16; ++r) p0[r] = __builtin_amdgcn_exp2f(p0[r]);
}
__device__ __forceinline__ void finishSM(f32x16& p0, f32x16& p1, float alpha, float& l_reg, bf16x8& pa0, bf16x8& pa1, bf16x8& pa2, bf16x8& pa3) {
#pragma unroll
  for (int r = 0; r < 16; ++r) p1[r] = __builtin_amdgcn_exp2f(p1[r]);
  float ps = 0;
#pragma unroll
  for (int r = 0; r < 16; ++r) ps += p0[r];
#pragma unroll
  for (int r = 0; r < 16; ++r) ps += p1[r];
  { auto rr = __builtin_amdgcn_permlane32_swap(__float_as_uint(ps), __float_as_uint(ps), false, false);
    ps = __uint_as_float(rr[0]) + __uint_as_float(rr[1]); }
  l_reg = l_reg * alpha + ps;
#define PK4(P, BASE, OUT) do { unsigned a0 = cvtpk(P[BASE + 0], P[BASE + 1]), a1 = cvtpk(P[BASE + 2], P[BASE + 3]);   \
    unsigned b0 = cvtpk(P[BASE + 4], P[BASE + 5]), b1 = cvtpk(P[BASE + 6], P[BASE + 7]);                              \
    auto r0 = __builtin_amdgcn_permlane32_swap(a0, b0, false, false); auto r1 = __builtin_amdgcn_permlane32_swap(a1, b1, false, false); \
    u32x4 w = {r0[0], r1[0], r0[1], r1[1]}; OUT = *reinterpret_cast<bf16x8*>(&w); } while (0)
  PK4(p0, 0, pa0); PK4(p0, 8, pa1); PK4(p1, 0, pa2); PK4(p1, 8, pa3);
#undef PK4
}
template <int DQK> __device__ __forceinline__ void qkt(f32x16& p0, f32x16& p1, const char* Ks, const bf16x8* qr, int r32, int hi) {
  p0 = f32x16{}; p1 = f32x16{};
#pragma unroll
  for (int d0 = 0; d0 < DQK / 16; ++d0) { const int cb = (d0 * 16 + hi * 8) * 2;
    const bf16x8 b0 = *reinterpret_cast<const bf16x8*>(Ks + KSWZ(r32, cb));
    const bf16x8 b1 = *reinterpret_cast<const bf16x8*>(Ks + KSWZ(32 + r32, cb));
    p0 = __builtin_amdgcn_mfma_f32_32x32x16_bf16(b0, qr[d0], p0, 0, 0, 0);
    p1 = __builtin_amdgcn_mfma_f32_32x32x16_bf16(b1, qr[d0], p1, 0, 0, 0); }
}
__device__ __forceinline__ int v_st(int k, int c) { const int kk = (k & ~0xC) | ((k & 4) << 1) | ((k & 8) >> 1); return ((kk >> 3) * 4 + (c >> 5)) * 512 + ((kk & 7) * 32 + (c & 31)) * 2; }
__device__ __forceinline__ int v_rd_base(int lane) { return ((lane & 3) << 3) | (((lane >> 2) & 3) << 6) | (((lane >> 4) & 1) << 5) | (((lane >> 5) & 1) << 8); }
constexpr int v_rd_off(int d0, int ks, int half) { return d0 * 512 + ks * 4096 + half * 2048; }
template <int OFF> __device__ __forceinline__ s16x4 tr_read(int vb) {
  s16x4 r; asm volatile("ds_read_b64_tr_b16 %0, %1 offset:%2" : "=&v"(r) : "v"(vb), "i"(OFF) : "memory"); return r;
}
template <int D0> __device__ __forceinline__ void pv_one(f32x16& od, int vb, bf16x8 pa0, bf16x8 pa1, bf16x8 pa2, bf16x8 pa3) {
  const s16x4 l0 = tr_read<v_rd_off(D0, 0, 0)>(vb), h0 = tr_read<v_rd_off(D0, 0, 1)>(vb), l1 = tr_read<v_rd_off(D0, 1, 0)>(vb), h1 = tr_read<v_rd_off(D0, 1, 1)>(vb);
  const s16x4 l2 = tr_read<v_rd_off(D0, 2, 0)>(vb), h2 = tr_read<v_rd_off(D0, 2, 1)>(vb), l3 = tr_read<v_rd_off(D0, 3, 0)>(vb), h3 = tr_read<v_rd_off(D0, 3, 1)>(vb);
  asm volatile("s_waitcnt lgkmcnt(0)" ::: "memory"); SBAR();
#define PK(L, H) (bf16x8){L[0], L[1], L[2], L[3], H[0], H[1], H[2], H[3]}
  od = __builtin_amdgcn_mfma_f32_32x32x16_bf16(pa0, PK(l0, h0), od, 0, 0, 0);
  od = __builtin_amdgcn_mfma_f32_32x32x16_bf16(pa1, PK(l1, h1), od, 0, 0, 0);
  od = __builtin_amdgcn_mfma_f32_32x32x16_bf16(pa2, PK(l2, h2), od, 0, 0, 0);
  od = __builtin_amdgcn_mfma_f32_32x32x16_bf16(pa3, PK(l3, h3), od, 0, 0, 0);
#undef PK
}
template <int DV> __device__ __forceinline__ void pv_all(f32x16* o, int vb, bf16x8 pa0, bf16x8 pa1, bf16x8 pa2, bf16x8 pa3) {
  pv_one<0>(o[0], vb, pa0, pa1, pa2, pa3); pv_one<1>(o[1], vb, pa0, pa1, pa2, pa3);
  if constexpr (DV > 64) { pv_one<2>(o[2], vb, pa0, pa1, pa2, pa3); pv_one<3>(o[3], vb, pa0, pa1, pa2, pa3); }
}
template <int DQK, int DV, int MODE, bool QROPE = false, int OUTMODE = 0>
__device__ __forceinline__ void attn_unit(const unsigned short* __restrict__ Qb, int ldq, const unsigned short* __restrict__ Kb, int ldk, const unsigned short* __restrict__ Vb, int ldv,
                                          unsigned short* __restrict__ Ob, int ldo, int NT, int lat0, int q0lat, float C, float thr_s, float sinkl2, char* lds, float lam = 0.f, const float* nw = nullptr, float nscale = 1.f) {
  int tid_ = threadIdx.x; asm volatile("" : "+v"(tid_));
  const int tid = tid_, wid = tid >> 6, lane = tid & 63, r32 = lane & 31, hi = lane >> 5;
  char* V_lds = lds; char* K_lds = lds + 2 * SHM_V;
  float* ws = (float*)(lds + 2 * SHM_V + 2 * SHM_K) + wid * 64; float* li_l = ws; float* al_l = ws + 32;
  float m_reg = -1e30f, l_reg = 0; f32x16 o[DV / 32]; bf16x8 qr[DQK / 16];
#pragma unroll
  for (int d = 0; d < DV / 32; ++d) o[d] = f32x16{};
  const unsigned short* Qw = Qb + (long)(wid * QBLK + r32) * ldq + hi * 8;
#pragma unroll
  for (int d0 = 0; d0 < DQK / 16; ++d0) qr[d0] = *reinterpret_cast<const bf16x8*>(Qw + d0 * 16);
  if constexpr (QROPE) {
    static_assert(DQK == 96, "QROPE is the MLA case");
    int t = q0lat + wid * QBLK + r32; asm volatile("" : "+v"(t));
#pragma unroll
    for (int part = 0; part < 2; ++part) { const float pos = (float)(part ? (t & 63) : (t >> 6)); u32x4 w = __builtin_bit_cast(u32x4, qr[4 + part]); u32x4 o;
#pragma unroll
      for (int q = 0; q < 4; ++q) { const unsigned pw = (unsigned)__shfl_xor((int)w[q], 32); float x0 = bflo(w[q]), x1 = bfhi(w[q]); const float p0 = bflo(pw), p1 = bfhi(pw);
        float s0, c0, s1, c1; sincosf(pos * __powf(10000.f, -(float)(2 * q) * 0.125f), &s0, &c0); sincosf(pos * __powf(10000.f, -(float)(2 * q + 1) * 0.125f), &s1, &c1);
        x0 = hi ? (x0 * c0 + p0 * s0) : (x0 * c0 - p0 * s0); x1 = hi ? (x1 * c1 + p1 * s1) : (x1 * c1 - p1 * s1); o[q] = cvtpk(x0, x1); }
      qr[4 + part] = __builtin_bit_cast(bf16x8, o); } }
  const int sr = tid >> 4, sc = (tid & 15) * 8, vst0 = v_st(sr, sc), vst1 = v_st(32 + sr, sc);
  const bool kact = sc < DQK, vact = sc < DV;
  const int vb0 = (int)(uintptr_t)V_lds + v_rd_base(lane);
  struct { bf16x8 vs0, vs1, ks0, ks1; } sr_[2];
#define TROW(j) ((MODE == 1 && (j) >= 4) ? (256 + lat0 + ((j) - 4) * 64) : (j) * 64)
#define SLOAD(i, j) do { const long k0_ = TROW(j); \
    if (vact) { sr_[i].vs0 = *reinterpret_cast<const bf16x8*>(&Vb[(k0_ + sr) * ldv + sc]); sr_[i].vs1 = *reinterpret_cast<const bf16x8*>(&Vb[(k0_ + 32 + sr) * ldv + sc]); } \
    if (kact) { sr_[i].ks0 = *reinterpret_cast<const bf16x8*>(&Kb[(k0_ + sr) * ldk + sc]); sr_[i].ks1 = *reinterpret_cast<const bf16x8*>(&Kb[(k0_ + 32 + sr) * ldk + sc]); } } while (0)
#define SWRITE(b, i) do { if (vact) { *(bf16x8*)(V_lds + (b) * SHM_V + vst0) = sr_[i].vs0; *(bf16x8*)(V_lds + (b) * SHM_V + vst1) = sr_[i].vs1; } \
    if (kact) { const int kc = sc * 2; *(bf16x8*)(K_lds + (b) * SHM_K + KSWZ(sr, kc)) = sr_[i].ks0; *(bf16x8*)(K_lds + (b) * SHM_K + KSWZ(32 + sr, kc)) = sr_[i].ks1; } } while (0)
#define RESC(a) do { if (__any((a) < 1.f)) { if (hi == 0) al_l[r32] = (a); asm volatile("s_waitcnt lgkmcnt(0)" ::: "memory"); \
    _Pragma("unroll") for (int d = 0; d < DV / 32; ++d) _Pragma("unroll") for (int r = 0; r < 16; ++r) o[d][r] *= al_l[crow(r, hi)]; } } while (0)
#define MASK(P0, P1, j) do { if (MODE == 1 && (j) >= 4) { const int kb_ = lat0 + ((j) - 4) * 64 + 4 * hi - (q0lat + wid * QBLK + r32); \
    _Pragma("unroll") for (int r = 0; r < 16; ++r) { const int dk_ = kb_ + (r & 3) + 8 * (r >> 2); if (dk_ > 128 || dk_ < -128) P0[r] = -1e30f; if (dk_ + 32 > 128 || dk_ + 32 < -128) P1[r] = -1e30f; } } } while (0)
  f32x16 pA0, pA1, pB0, pB1; float mnA, mnB, alA, alB; bf16x8 pa0, pa1, pa2, pa3;
  SLOAD(0, 0); asm volatile("s_waitcnt vmcnt(0)" ::: "memory"); SWRITE(0, 0); __syncthreads();
  qkt<DQK>(pA0, pA1, K_lds, qr, r32, hi); MASK(pA0, pA1, 0); partialSM(pA0, pA1, m_reg, mnA, alA, C, thr_s);
  SLOAD(1, 1); if (2 < NT) SLOAD(0, 2);
  asm volatile("s_waitcnt vmcnt(4)" ::: "memory"); SWRITE(1, 1); __syncthreads();
  for (int j = 1; j + 1 < NT; j += 2) {
    SBAR(); qkt<DQK>(pB0, pB1, K_lds + SHM_K, qr, r32, hi); MASK(pB0, pB1, j);
    finishSM(pA0, pA1, alA, l_reg, pa0, pa1, pa2, pa3); SBAR();
    SLOAD(1, j + 2); SBAR();
    pv_all<DV>(o, vb0, pa0, pa1, pa2, pa3); partialSM(pB0, pB1, m_reg, mnB, alB, C, thr_s);
    __syncthreads(); asm volatile("s_waitcnt vmcnt(4)" ::: "memory"); SWRITE(0, 0);
    RESC(alB); __syncthreads();
    SBAR(); qkt<DQK>(pA0, pA1, K_lds, qr, r32, hi); MASK(pA0, pA1, j + 1);
    finishSM(pB0, pB1, alB, l_reg, pa0, pa1, pa2, pa3); SBAR();
    if (j + 3 < NT) SLOAD(0, j + 3); SBAR();
    pv_all<DV>(o, vb0 + (int)SHM_V, pa0, pa1, pa2, pa3); partialSM(pA0, pA1, m_reg, mnA, alA, C, thr_s);
    __syncthreads(); asm volatile("s_waitcnt vmcnt(4)" ::: "memory"); SWRITE(1, 1);
    RESC(alA); __syncthreads();
  }
  SBAR(); qkt<DQK>(pB0, pB1, K_lds + SHM_K, qr, r32, hi); MASK(pB0, pB1, NT - 1);
  finishSM(pA0, pA1, alA, l_reg, pa0, pa1, pa2, pa3); SBAR();
  pv_all<DV>(o, vb0, pa0, pa1, pa2, pa3); partialSM(pB0, pB1, m_reg, mnB, alB, C, thr_s);
  __syncthreads(); RESC(alB);
  finishSM(pB0, pB1, alB, l_reg, pa0, pa1, pa2, pa3); SBAR();
  pv_all<DV>(o, vb0 + (int)SHM_V, pa0, pa1, pa2, pa3);
  if (sinkl2 > -1e29f) l_reg += __builtin_amdgcn_exp2f(sinkl2 - m_reg * C);
  if (hi == 0) li_l[r32] = l_reg; asm volatile("s_waitcnt lgkmcnt(0)" ::: "memory");
  float rli[16];
#pragma unroll
  for (int r = 0; r < 16; ++r) rli[r] = __builtin_amdgcn_rcpf(li_l[crow(r, hi)]);
  if constexpr (OUTMODE == 0) {
  unsigned short* Ow = Ob + (long)(wid * QBLK) * ldo;
#pragma unroll
  for (int r = 0; r < 16; ++r) { const int orow = crow(r, hi);
#pragma unroll
    for (int d0 = 0; d0 < DV / 32; ++d0) Ow[(long)orow * ldo + d0 * 32 + r32] = (unsigned short)f2bf(o[d0][r] * rli[r]); }
  } else {   int zo_ = 0; asm volatile("" : "+v"(zo_)); const int lane = (int)__builtin_amdgcn_mbcnt_hi(~0u, __builtin_amdgcn_mbcnt_lo(~0u, (unsigned)zo_)), r32 = lane & 31, hi = lane >> 5;
    unsigned short* stg = (unsigned short*)(lds + SHM_ATTN) + wid * 4096;
    if constexpr (OUTMODE == 1) {
#pragma unroll
      for (int d0 = 0; d0 < DV / 32; ++d0)
#pragma unroll
        for (int r = 0; r < 16; ++r) stg[(d0 * 16 + r) * 64 + lane] = (unsigned short)f2bf(o[d0][r] * rli[r]);
    } else {
      unsigned short* Ow = Ob + (long)(wid * QBLK) * ldo;
#pragma unroll
      for (int r = 0; r < 16; ++r) { float v[DV / 32]; float ss = 0.f;
#pragma unroll
        for (int d0 = 0; d0 < DV / 32; ++d0) { v[d0] = bf2f(stg[(d0 * 16 + r) * 64 + lane]) - lam * (o[d0][r] * rli[r]); ss += v[d0] * v[d0]; }
        ss += __shfl_xor(ss, 1); ss += __shfl_xor(ss, 2); ss += __shfl_xor(ss, 4); ss += __shfl_xor(ss, 8); ss += __shfl_xor(ss, 16);
        const float rs = nscale / sqrtf(ss * (1.f / (float)DV) + 1e-6f); const int orow = crow(r, hi);
#pragma unroll
        for (int d0 = 0; d0 < DV / 32; ++d0) Ow[(long)orow * ldo + d0 * 32 + r32] = (unsigned short)f2bf(v[d0] * rs * nw[d0 * 32 + r32]);
        __builtin_amdgcn_sched_barrier(0); }
    }
  }
  __syncthreads();
#undef TROW
#undef SLOAD
#undef SWRITE
#undef RESC
#undef MASK
}
#undef KSWZ
#undef SBAR
}
struct Args { const float* in[32]; float* out; unsigned char* ws; int ph_lo, ph_hi; };
struct Frame {
    LAS unsigned char* lds; char* ldsg;
    volatile LAS unsigned* MISC;
    gu32* ctl;
    int tid, lane, wave, vcu, G, gw, NGW;
    const float* const* in; float* out; unsigned char* ws;
};
enum { I_X = 0, I_C, I_CTX, I_CCTX, I_EMODW, I_EMODB, I_ENORMS, I_EWIN, I_ECONV, I_EALOG, I_EDTB, I_EGDNN, I_ESINK, I_EWOUT, I_EFG, I_EFU, I_EFD,
       I_OMODW, I_OMODB, I_ONORMS, I_OWIN, I_OQN, I_OKVN, I_OWUQ, I_OWUKV, I_OLAM, I_OSUBLN, I_OWOUT, I_OROUTER, I_OXG, I_OXU, I_OXD };

__device__ __forceinline__ void tr_load(float (&v)[32], const float* W, int N, int k0, int n0, const float* kscale, int lane) {
#pragma unroll
    for (int i = 0; i < 32; ++i) { const int kk = 2 * i + (lane >> 5); v[i] = W[(size_t)(k0 + kk) * N + n0 + (lane & 31)]; if (kscale) v[i] *= kscale[k0 + kk]; }
}
__device__ __forceinline__ void tr_store(const float (&v)[32], bf16* WT, int ldk, int k0, int drow0, LAS float* scr, int lane) {
#pragma unroll
    for (int i = 0; i < 32; ++i) scr[(2 * i + (lane >> 5)) * 33 + (lane & 31)] = v[i];
    LDS_WAIT(); asm volatile("" ::: "memory");
    const int c = lane & 7;
#pragma unroll
    for (int j = 0; j < 4; ++j) { const int n = (lane >> 3) + 8 * j; const LAS float* s = scr + (8 * c) * 33 + n;
        v4u o; o.x = pk2(s[0 * 33], s[1 * 33]); o.y = pk2(s[2 * 33], s[3 * 33]); o.z = pk2(s[4 * 33], s[5 * 33]); o.w = pk2(s[6 * 33], s[7 * 33]);
        *(GAS v4u*)(WT + (size_t)(drow0 + n) * ldk + k0 + 8 * c) = o; }
    LDS_WAIT(); asm volatile("" ::: "memory");
}
template <int MAP> __device__ __forceinline__ void transpose_job(Frame& F, const float* W, int K, int N, bf16* WT, const float* kscale, int first, int stride, LAS unsigned char* scrb) {
    LAS float* scr = (LAS float*)scrb;
    const int nblk = N / 32, items = (K / 64) * nblk;
    float vn[32];
    if (first < items) tr_load(vn, W, N, 64 * (first / nblk), 32 * (first % nblk), kscale, F.lane);
    for (int it = first; it < items; it += stride) { const int kb = it / nblk, nb = it % nblk, n0 = 32 * nb;
        const int drow0 = (MAP == 0) ? n0 : ((n0 >> 7) * 256 + (n0 & 127) + (MAP == 2 ? 128 : 0));
        float vc[32];
#pragma unroll
        for (int i = 0; i < 32; ++i) vc[i] = vn[i];
        const int nx = it + stride; if (nx < items) tr_load(vn, W, N, 64 * (nx / nblk), 32 * (nx % nblk), kscale, F.lane);
        tr_store(vc, WT, K, 64 * kb, drow0, scr, F.lane); }
}
__device__ __forceinline__ void zero_rows(Frame& F, bf16* WT, int row0, int nrows, int K) {
    const size_t n16 = (size_t)nrows * K / 8; GAS v4u* p = (GAS v4u*)(WT + (size_t)row0 * K);
    for (size_t i = (size_t)F.gw * 64 + F.lane; i < n16; i += (size_t)F.NGW * 64) p[i] = (v4u){0u, 0u, 0u, 0u};
}
__device__ __forceinline__ void modv_items(Frame& F) {
    LAS float* sc = (LAS float*)(F.lds + RING_OFF);
    LAS float* part = (LAS float*)(F.lds + RING_OFF + 20480);
    float* MODV = (float*)(F.ws + WS_MODV);
    const int nitems = 2 * 96;
    if ((int)blockIdx.x >= nitems) return;
    for (int i = F.tid; i < 5 * 1024; i += 512) { const int r = i >> 10, k = i & 1023; const float v = (r < 4) ? F.in[I_C][r * 1024 + k] : F.in[I_CCTX][k]; sc[i] = siluf(v); }
    __syncthreads();
    for (int it = blockIdx.x; it < nitems; it += F.G) {
        const int l = it / 96, n0 = (it % 96) * 64, col = F.tid & 63, ks = F.tid >> 6;
        const float* W = F.in[l ? I_OMODW : I_EMODW] + (size_t)(ks * 128) * 6144 + n0 + col;
        float a0 = 0, a1 = 0, a2 = 0, a3 = 0, a4 = 0;
#pragma unroll 8
        for (int k = 0; k < 128; ++k) { const float w = W[(size_t)k * 6144]; const int kk = ks * 128 + k;
            a0 += sc[kk] * w; a1 += sc[1024 + kk] * w; a2 += sc[2048 + kk] * w; a3 += sc[3072 + kk] * w; a4 += sc[4096 + kk] * w; }
        part[(ks * 5 + 0) * 64 + col] = a0; part[(ks * 5 + 1) * 64 + col] = a1; part[(ks * 5 + 2) * 64 + col] = a2; part[(ks * 5 + 3) * 64 + col] = a3; part[(ks * 5 + 4) * 64 + col] = a4;
        __syncthreads();
        if (F.tid < 320) { const int r = F.tid >> 6, c2 = F.tid & 63; float s = F.in[l ? I_OMODB : I_EMODB][n0 + c2];
#pragma unroll
            for (int q = 0; q < 8; ++q) s += part[(q * 5 + r) * 64 + c2];
            MODV[(size_t)(l * 5 + r) * 6144 + n0 + c2] = s; }
        __syncthreads();
    }
}
__device__ __forceinline__ const float* modvec(Frame& F, int l, int mr, int k) { return (const float*)(F.ws + WS_MODV) + (size_t)((l * 5 + mr) * 6 + k) * 1024; }

struct Row4 { f32x4 v[4]; };
__device__ __forceinline__ Row4 ld_row_f32(const float* p, int lane) { Row4 r; const GAS f32x4* q = (const GAS f32x4*)p + lane;
#pragma unroll
    for (int j = 0; j < 4; ++j) r.v[j] = q[64 * j]; return r; }
__device__ __forceinline__ Row4 ld_row_bf16(const bf16* p, int lane) { Row4 r; const GAS v2u* q = (const GAS v2u*)p + lane;
#pragma unroll
    for (int j = 0; j < 4; ++j) { const v2u w = q[64 * j]; r.v[j] = (f32x4){bflo(w.x), bfhi(w.x), bflo(w.y), bfhi(w.y)}; } return r; }
__device__ __forceinline__ void st_row_f32(float* p, int lane, const Row4& r) { GAS f32x4* q = (GAS f32x4*)p + lane;
#pragma unroll
    for (int j = 0; j < 4; ++j) q[64 * j] = r.v[j]; }
__device__ __forceinline__ void st_row_bf16(bf16* p, int lane, const Row4& r) { GAS v2u* q = (GAS v2u*)p + lane;
#pragma unroll
    for (int j = 0; j < 4; ++j) q[64 * j] = (v2u){pk2(r.v[j].x, r.v[j].y), pk2(r.v[j].z, r.v[j].w)}; }
__device__ __forceinline__ float row_rstd(const Row4& r) { float s = 0.f;
#pragma unroll
    for (int j = 0; j < 4; ++j) s += (r.v[j].x * r.v[j].x + r.v[j].y * r.v[j].y) + (r.v[j].z * r.v[j].z + r.v[j].w * r.v[j].w);
    return 1.f / sqrtf(wave_sum(s) * (1.f / 1024.f) + EPS); }
__device__ __forceinline__ float* xres_ptr(Frame& F, int r, int& mr) { const int b = r / SROW, s = r - b * SROW;
    if (s < TC) { mr = 4; return (float*)(F.ws + WS_HCTX) + (size_t)(b * TC + s) * D; }
    mr = b; return F.out + (size_t)(b * T + s - TC) * D; }
__device__ __forceinline__ Row4 norm_mod(const Row4& x, const float* w, const float* shift, const float* scale, int lane) {
    const float rs = row_rstd(x); const Row4 W = ld_row_f32(w, lane), SH = ld_row_f32(shift, lane), SC = ld_row_f32(scale, lane); Row4 a;
#pragma unroll
    for (int j = 0; j < 4; ++j) a.v[j] = (x.v[j] * rs * W.v[j]) * (SC.v[j] + 1.f) + SH.v[j];
    return a; }
__device__ __forceinline__ Row4 norm_mod_r(const Row4& x, const Row4& W, const Row4& SH, const Row4& SC) {
    const float rs = row_rstd(x); Row4 a;
#pragma unroll
    for (int j = 0; j < 4; ++j) a.v[j] = (x.v[j] * rs * W.v[j]) * (SC.v[j] + 1.f) + SH.v[j];
    return a; }
__device__ __forceinline__ void add_gated_norm_r(Row4& x, const Row4& y, const Row4& W, const Row4& G) {
    const float rs = row_rstd(y);
#pragma unroll
    for (int j = 0; j < 4; ++j) x.v[j] = x.v[j] + G.v[j] * (y.v[j] * rs * W.v[j]); }
__device__ __forceinline__ int tok_vcu(const Frame& F, int b, int t) { const int wpb = F.NGW >> 2; return (b * wpb + t % wpb) >> 3; }
__device__ __forceinline__ void add_gated_norm(Row4& x, const Row4& y, const float* w, const float* gate, int lane) {
    const float rs = row_rstd(y); const Row4 W = ld_row_f32(w, lane), G = ld_row_f32(gate, lane);
#pragma unroll
    for (int j = 0; j < 4; ++j) x.v[j] = x.v[j] + G.v[j] * (y.v[j] * rs * W.v[j]); }
__device__ __forceinline__ void p0_prologue(Frame& F) {
    modv_items(F);
    __syncthreads();
    transpose_job<0>(F, F.in[I_EWIN], 1024, EIN, (bf16*)(F.ws + WS_WEIN), nullptr, F.gw, F.NGW, F.lds + RING_OFF + F.wave * 16384);
    zero_rows(F, (bf16*)(F.ws + WS_WEIN), EIN, EINP - EIN, 1024);
}
__device__ __forceinline__ void p0_deferred(Frame& F, int w4, LAS unsigned char* scr) {
    const float* const* in = F.in; unsigned char* ws = F.ws; const int gw = F.vcu * 4 + w4, N = F.G * 4;
    transpose_job<0>(F, in[I_EWOUT], 1024, 1024, (bf16*)(ws + WS_WEOUT), nullptr, gw, N, scr);
    transpose_job<1>(F, in[I_EFG], 1024, DFF, (bf16*)(ws + WS_WEGU), nullptr, (gw + 512) % N, N, scr);
    transpose_job<2>(F, in[I_EFU], 1024, DFF, (bf16*)(ws + WS_WEGU), nullptr, (gw + 896) % N, N, scr);
    transpose_job<0>(F, in[I_EFD], DFF, 1024, (bf16*)(ws + WS_WEDN), nullptr, (gw + 256) % N, N, scr);
    transpose_job<0>(F, in[I_OWIN], 1024, OIN, (bf16*)(ws + WS_WOIN), nullptr, (gw + 640) % N, N, scr);
    transpose_job<0>(F, in[I_OWUQ], 384, 768, (bf16*)(ws + WS_WUQ), in[I_OQN], (gw + 720) % N, N, scr);
    transpose_job<0>(F, in[I_OWUKV], 256, 1024, (bf16*)(ws + WS_WUKV), in[I_OKVN], (gw + 864) % N, N, scr);
    transpose_job<0>(F, in[I_OWOUT], 1024, 1024, (bf16*)(ws + WS_WOOUT), nullptr, (gw + 992) % N, N, scr);
    { const size_t n16 = (size_t)(OINP - OIN) * 1024 / 8; GAS v4u* p = (GAS v4u*)((bf16*)(ws + WS_WOIN) + (size_t)OIN * 1024);
      for (size_t i = (size_t)gw * 64 + F.lane; i < n16; i += (size_t)N * 64) p[i] = (v4u){0u, 0u, 0u, 0u}; }
}
__device__ __forceinline__ void px_expert_weights(Frame& F) {
    for (int e = 0; e < NEXP; ++e) {
        transpose_job<1>(F, F.in[I_OXG] + (size_t)e * 1024 * DFX, 1024, DFX, (bf16*)(F.ws + WS_WXGU) + (size_t)e * 7168 * 1024, nullptr, (F.gw + e * 448) % F.NGW, F.NGW, F.lds + RING_OFF + F.wave * 8448);
        transpose_job<2>(F, F.in[I_OXU] + (size_t)e * 1024 * DFX, 1024, DFX, (bf16*)(F.ws + WS_WXGU) + (size_t)e * 7168 * 1024, nullptr, (F.gw + e * 448 + 224) % F.NGW, F.NGW, F.lds + RING_OFF + F.wave * 8448);
    }
}
__device__ __forceinline__ void px_expert_down(Frame& F, int wk, int nwk, int e0, int e1) {
    for (int e = e0; e < e1; ++e)
        transpose_job<0>(F, F.in[I_OXD] + (size_t)e * DFX * 1024, DFX, 1024, (bf16*)(F.ws + WS_WXDN) + (size_t)e * 1024 * DFX, nullptr, (wk + e * 448 + 112) % nwk, nwk, F.lds + RING_OFF + F.wave * 8448);
}
__device__ __forceinline__ void p1_first_rows(Frame& F) {
    bf16* A = (bf16*)(F.ws + WS_ABUF); const float* w0 = F.in[I_ENORMS]; const int wpb = F.NGW >> 2, b = F.gw / wpb, wl = F.gw - b * wpb;
    { const Row4 W = ld_row_f32(w0, F.lane), SH = ld_row_f32(modvec(F, 0, b, 0), F.lane), SC = ld_row_f32(modvec(F, 0, b, 1), F.lane);
      for (int t = wl; t < T; t += wpb) { const size_t tk = (size_t)b * T + t; const Row4 x = ld_row_f32(F.in[I_X] + tk * D, F.lane); st_row_bf16((bf16*)(F.ws + WS_XB) + tk * D, F.lane, x);
          const Row4 a = norm_mod_r(x, W, SH, SC); st_row_bf16(A + ((size_t)b * SROW + TC + t) * D, F.lane, a); } }
    for (int c = F.gw; c < NB * TC; c += F.NGW) { const int cb = c / TC, s = c - cb * TC;
        const Row4 x = ld_row_f32(F.in[I_CTX] + (size_t)c * D, F.lane); st_row_f32((float*)(F.ws + WS_HCTX) + (size_t)c * D, F.lane, x);
        const Row4 a = norm_mod(x, w0, modvec(F, 0, 4, 0), modvec(F, 0, 4, 1), F.lane); st_row_bf16(A + ((size_t)cb * SROW + s) * D, F.lane, a); }
}
constexpr int ROUTER_TAB_OFF = 69632;
__device__ __forceinline__ void router_table(Frame& F) {
    LAS f32x4* tab = (LAS f32x4*)(F.lds + RING_OFF + ROUTER_TAB_OFF); const float* Rw = F.in[I_OROUTER];
    for (int i = F.tid; i < 2048; i += 512) { const int ln = i & 63, h = (i >> 6) & 1, q = (i >> 7) & 3, j = i >> 9; tab[i] = *(const GAS f32x4*)(Rw + (size_t)(4 * ln + 256 * j + q) * 8 + 4 * h); }
    __syncthreads();
}
template <bool ROUTER> __device__ __forceinline__ void rows_mid(Frame& F, const bf16* Y, const float* wy, int lg, int kg, const float* w2, int l2, int ks2, bf16* Aout, bool lat_only, int nsl = 0) {
    const int wpb = F.NGW >> 2, b = F.gw / wpb, wl = F.gw - b * wpb;
    { const Row4 Wy = ld_row_f32(wy, F.lane), Gt = ld_row_f32(modvec(F, lg, b, kg), F.lane), W2 = ld_row_f32(w2, F.lane), SH = ld_row_f32(modvec(F, l2, b, ks2), F.lane), SC = ld_row_f32(modvec(F, l2, b, ks2 + 1), F.lane);
      for (int t = wl; t < T; t += wpb) { const size_t tk = (size_t)b * T + t, r = (size_t)b * SROW + TC + t; bf16* xr = (bf16*)(F.ws + WS_XB) + tk * D;
        Row4 x = ld_row_bf16(xr, F.lane); const Row4 y = ld_row_bf16(Y + r * D, F.lane);
        add_gated_norm_r(x, y, Wy, Gt); st_row_bf16(xr, F.lane, x);
        const Row4 a = norm_mod_r(x, W2, SH, SC);
        st_row_bf16(Aout + r * D, F.lane, a);
        if constexpr (ROUTER) {
            LAS const f32x4* Rt = (LAS const f32x4*)(F.lds + RING_OFF + ROUTER_TAB_OFF) + F.lane; float lg8[8];
#pragma unroll
            for (int e = 0; e < 8; ++e) lg8[e] = 0.f;
#pragma unroll
            for (int j = 0; j < 4; ++j)
#pragma unroll
                for (int q = 0; q < 4; ++q) { const f32x4 r0 = Rt[((j * 4 + q) * 2 + 0) * 64], r1 = Rt[((j * 4 + q) * 2 + 1) * 64]; const float av = a.v[j][q];
                    lg8[0] += av * r0.x; lg8[1] += av * r0.y; lg8[2] += av * r0.z; lg8[3] += av * r0.w; lg8[4] += av * r1.x; lg8[5] += av * r1.y; lg8[6] += av * r1.z; lg8[7] += av * r1.w; }
#pragma unroll
            for (int e = 0; e < 8; ++e) lg8[e] = wave_sum(lg8[e]);
            int i0 = 0; float v0 = lg8[0];
#pragma unroll
            for (int e = 1; e < 8; ++e) if (lg8[e] > v0) { v0 = lg8[e]; i0 = e; }
            int i1 = -1; float v1 = -3.0e38f;
#pragma unroll
            for (int e = 0; e < 8; ++e) if (e != i0 && lg8[e] > v1) { v1 = lg8[e]; i1 = e; }
            const float e1 = __expf(v1 - v0), w0 = 1.f / (1.f + e1), w1 = e1 * w0;
            if (F.lane == 0) {
                int* TOPI = (int*)(F.ws + WS_META + META_TOPI); float* TOPW = (float*)(F.ws + WS_META + META_TOPW); int* RANK = (int*)(F.ws + WS_META + META_RANK);
                TOPI[tk * 2] = i0; TOPI[tk * 2 + 1] = i1; TOPW[tk * 2] = w0; TOPW[tk * 2 + 1] = w1;
                RANK[tk * 2] = (int)__hip_atomic_fetch_add((LAS unsigned*)(F.MISC + 24 + i0), 1u, __ATOMIC_RELAXED, __HIP_MEMORY_SCOPE_WORKGROUP);
                RANK[tk * 2 + 1] = (int)__hip_atomic_fetch_add((LAS unsigned*)(F.MISC + 24 + i1), 1u, __ATOMIC_RELAXED, __HIP_MEMORY_SCOPE_WORKGROUP); }
        } } }
    if (!lat_only) for (int c = F.gw; c < NB * TC; c += F.NGW) { const int cb = c / TC, s = c - cb * TC; const size_t r = (size_t)cb * SROW + s; float* xr = (float*)(F.ws + WS_HCTX) + (size_t)c * D;
        Row4 x = ld_row_f32(xr, F.lane); Row4 y;
        if (nsl > 0) {
            const float* pp = (const float*)(F.ws + WS_PART) + (size_t)c * 1024; y = ld_row_f32(pp, F.lane);
            for (int q = 1; q < nsl; ++q) { const Row4 t = ld_row_f32(pp + (size_t)q * 1024 * 1024, F.lane);
#pragma unroll
                for (int j = 0; j < 4; ++j) y.v[j] = y.v[j] + t.v[j]; } }
        else y = ld_row_bf16(Y + r * D, F.lane);
        add_gated_norm(x, y, wy, modvec(F, lg, 4, kg), F.lane); st_row_f32(xr, F.lane, x);
        const Row4 a = norm_mod(x, w2, modvec(F, l2, 4, ks2), modvec(F, l2, 4, ks2 + 1), F.lane);
        st_row_bf16(Aout + r * D, F.lane, a); }
}
__device__ __forceinline__ void router_tail(Frame& F) {
    {
        __syncthreads();
        if (F.tid < 8) { ((int*)(F.ws + WS_META + META_BLKB))[F.vcu * 8 + F.tid] = (int)__hip_atomic_fetch_add((unsigned*)(F.ctl + CW_MOECNT + 64 * F.tid), F.MISC[24 + F.tid], RLX_AGENT); F.MISC[24 + F.tid] = 0u; }
    }
}
__device__ __forceinline__ void g0_prep(Frame& F) {
    const bf16* P = (const bf16*)(F.ws + WS_PROJ); bf16* PW = (bf16*)(F.ws + WS_PROJ); bf16* QK = (bf16*)(F.ws + WS_QKVN); float* GB = (float*)(F.ws + WS_GB);
    const float* cw = F.in[I_ECONV]; const int lane = F.lane;
#pragma unroll 1
    for (int part = 0; part < 3; ++part) { const int ch = part * 512 + 8 * lane; float w[5][8];
#pragma unroll
        for (int j = 0; j < 5; ++j) { const f32x4 w0 = *(const GAS f32x4*)(cw + j * 1536 + ch), w1 = *(const GAS f32x4*)(cw + j * 1536 + ch + 4); w[j][0] = w0.x; w[j][1] = w0.y; w[j][2] = w0.z; w[j][3] = w0.w; w[j][4] = w1.x; w[j][5] = w1.y; w[j][6] = w1.z; w[j][7] = w1.w; }
        v4u tn[5];
#define G0_TAPS(dst, r_) do { const int b_ = (r_) / SROW, s_ = (r_) - b_ * SROW; const bool c_ = s_ < TC; const int p_ = c_ ? s_ : s_ - TC, len_ = c_ ? TC : T; \
            _Pragma("unroll") for (int j = 0; j < 5; ++j) { const int pp = p_ + j - 2; dst[j] = (pp >= 0 && pp < len_) ? *(const GAS v4u*)(P + (size_t)((r_) + j - 2) * EINP + ch) : (v4u){0u, 0u, 0u, 0u}; } } while (0)
        if (F.gw < NR) G0_TAPS(tn, F.gw);
        for (int r = F.gw; r < NR; r += F.NGW) { v4u tc[5];
#pragma unroll
            for (int j = 0; j < 5; ++j) tc[j] = tn[j];
            if (r + F.NGW < NR) G0_TAPS(tn, r + F.NGW);
            float acc[8];
#pragma unroll
            for (int e = 0; e < 8; ++e) acc[e] = 0.f;
#pragma unroll
            for (int j = 0; j < 5; ++j) { const v4u xv = tc[j];
                acc[0] += bflo(xv.x) * w[j][0]; acc[1] += bfhi(xv.x) * w[j][1]; acc[2] += bflo(xv.y) * w[j][2]; acc[3] += bfhi(xv.y) * w[j][3];
                acc[4] += bflo(xv.z) * w[j][4]; acc[5] += bfhi(xv.z) * w[j][5]; acc[6] += bflo(xv.w) * w[j][6]; acc[7] += bfhi(xv.w) * w[j][7]; }
            float ss = 0.f;
#pragma unroll
            for (int e = 0; e < 8; ++e) { acc[e] = siluf(acc[e]); ss += acc[e] * acc[e]; }
            if (part < 2) { ss += __shfl_xor(ss, 1); ss += __shfl_xor(ss, 2); ss += __shfl_xor(ss, 4); const float sc = (part == 0 ? 0.125f : 1.f) / sqrtf(ss + EPS);
#pragma unroll
                for (int e = 0; e < 8; ++e) acc[e] *= sc; }
            *(GAS v4u*)(QK + (size_t)r * 1536 + ch) = (v4u){pk2(acc[0], acc[1]), pk2(acc[2], acc[3]), pk2(acc[4], acc[5]), pk2(acc[6], acc[7])}; }
#undef G0_TAPS
    }
    for (int r = F.gw; r < NR; r += F.NGW) { const int b = r / SROW, s = r - b * SROW; const bool isc = s < TC; const int p = isc ? s : s - TC;
        if (lane < 16) { const float ga = bf2f(P[(size_t)r * EINP + E_GA + lane]), gb = bf2f(P[(size_t)r * EINP + E_GB + lane]);
            const float xx = ga + F.in[I_EDTB][lane], sp = fmaxf(xx, 0.f) + log1pf(__expf(-fabsf(xx)));
            GB[(size_t)r * 32 + lane] = -__expf(F.in[I_EALOG][lane]) * sp; GB[(size_t)r * 32 + 16 + lane] = 1.f / (1.f + __expf(-gb)); }
        if (!isc) {
            const int pi = lane & 31, seg = pi >> 4, i = pi & 15, d0 = seg * 32 + i; const float pos = (float)(seg ? (p & 63) : (p >> 6));
            const float ang = pos * __powf(10000.f, -(float)i * (1.f / 16.f)); float sn, cs; sincosf(ang, &sn, &cs);
#pragma unroll
            for (int q = 0; q < 5; ++q) { const int hh = (lane >> 5) + 2 * q; bf16* base = PW + (size_t)r * EINP + (hh < 8 ? E_SQ + hh * 64 : E_SK + (hh - 8) * 64) + d0;
                const float x0 = bf2f(base[0]), x1 = bf2f(base[16]); base[0] = (bf16)f2bf(x0 * cs - x1 * sn); base[16] = (bf16)f2bf(x1 * cs + x0 * sn); }
        }
    }
}
constexpr int GP = 65, GLP = 68;
template <int I> struct SolveRow {
    static __device__ __forceinline__ void run(float (&x)[64], const LAS float* Ls) {
        SolveRow<I - 1>::run(x, Ls);
        float a = x[I];
#pragma unroll
        for (int j = 0; j < I; ++j) a -= Ls[I * GLP + j] * x[j];
        x[I] = a;
    }
};
template <> struct SolveRow<0> { static __device__ __forceinline__ void run(float (&)[64], const LAS float*) {} };

__device__ __forceinline__ void gdn_chain(Frame& F, int chain) {
    const int b = chain >> 4, h = (chain >> 1) & 7, dir = chain & 1;
    LAS float* Ss = (LAS float*)(F.lds + RING_OFF);
    LAS float* Qs = Ss + 64 * GP, *Ks = Qs + 64 * GP, *Vs = Ks + 64 * GP  , *ATs = Vs + 64 * GP, *Ws = ATs + 64 * GP, *VNs = Ws + 64 * GP;
    LAS float* Ls = VNs + 64 * GP;
    LAS float* gcs = Ls + 64 * GLP, *bts = gcs + 64;
    const bf16* QK = (const bf16*)(F.ws + WS_QKVN); const float* GB = (const float*)(F.ws + WS_GB); bf16* OG = (bf16*)(F.ws + WS_OG);
    const int tid = F.tid, lane = F.lane, w = F.wave;
    for (int i = tid; i < 64 * GP; i += 512) Ss[i] = 0.f;
    for (int ci = 0; ci < 68; ++ci) {
        const bool isc = ci < 4; const int n0 = (isc ? ci : ci - 4) * 64; const int rbase = b * SROW + (isc ? 0 : TC), len = isc ? TC : T;
        __syncthreads();
        for (int e = tid; e < 64 * 24; e += 512) { const int i = e / 24, c8 = e % 24, part = c8 >> 3, cc = (c8 & 7) * 8; const int n = n0 + i, row = rbase + (dir ? len - 1 - n : n);
            const v4u xv = *(const GAS v4u*)(QK + (size_t)row * 1536 + part * 512 + h * 64 + cc); LAS float* dst = (part == 0 ? Qs : part == 1 ? Ks : Vs) + i * GP + cc;
            dst[0] = bflo(xv.x); dst[1] = bfhi(xv.x); dst[2] = bflo(xv.y); dst[3] = bfhi(xv.y); dst[4] = bflo(xv.z); dst[5] = bfhi(xv.z); dst[6] = bflo(xv.w); dst[7] = bfhi(xv.w); }
        if (tid < 64) { const int n = n0 + tid, row = rbase + (dir ? len - 1 - n : n); float g = GB[(size_t)row * 32 + dir * 8 + h]; bts[tid] = GB[(size_t)row * 32 + 16 + dir * 8 + h];
#pragma unroll
            for (int o = 1; o < 64; o <<= 1) { const float t = __shfl_up(g, o); if (lane >= o) g += t; }
            gcs[tid] = g; }
        __syncthreads();
#pragma unroll 1
        for (int k = 0; k < 8; ++k) { const int i = w + 8 * k, j = lane; float kk = 0.f, qk = 0.f;
#pragma unroll 16
            for (int d = 0; d < 64; ++d) { const float kj = Ks[j * GP + d]; kk += Ks[i * GP + d] * kj; qk += Qs[i * GP + d] * kj; }
            const float dec = (j <= i) ? __expf(gcs[i] - gcs[j]) : 0.f;
            Ls[i * GLP + j] = (j < i) ? bts[i] * kk * dec : 0.f; ATs[i * GP + j] = qk * dec; }
        __syncthreads();
        if (tid < 128) { float x[64]; const int c = tid & 63; const bool isw = tid >= 64; int zz = 0; asm volatile("" : "+v"(zz));
            const LAS float* src = (isw ? Ks : Vs) + c; const LAS float* btz = bts + zz; const LAS float* gcz = gcs + zz;
#pragma unroll
            for (int i = 0; i < 64; ++i) { const float e = isw ? __expf(gcz[i]) : 1.f; x[i] = src[i * GP] * btz[i] * e; }
            SolveRow<63>::run(x, Ls + zz);
            LAS float* dst = isw ? Ws : Vs;
#pragma unroll
            for (int i = 0; i < 64; ++i) dst[i * GP + c] = x[i]; }
        __syncthreads();
#pragma unroll 1
        for (int k = 0; k < 8; ++k) { const int i = w + 8 * k, d = lane; float a = Vs[i * GP + d];
#pragma unroll 16
            for (int q = 0; q < 64; ++q) a -= Ws[i * GP + q] * Ss[q * GP + d];
            VNs[i * GP + d] = a; }
        __syncthreads();
#pragma unroll 1
        for (int k = 0; k < 8; ++k) { const int i = w + 8 * k, d = lane; float a = 0.f, c2 = 0.f;
#pragma unroll 16
            for (int q = 0; q < 64; ++q) { a += Qs[i * GP + q] * Ss[q * GP + d]; c2 += ATs[i * GP + q] * VNs[q * GP + d]; }
            const int n = n0 + i, row = rbase + (dir ? len - 1 - n : n);
            OG[(size_t)row * 1024 + dir * 512 + h * 64 + d] = (bf16)f2bf(a * __expf(gcs[i]) + c2); }
        __syncthreads();
        const float gl = gcs[63];
#pragma unroll 1
        for (int k = 0; k < 8; ++k) { const int a = w + 8 * k, d = lane; float acc = Ss[a * GP + d] * __expf(gl);
#pragma unroll 16
            for (int i = 0; i < 64; ++i) acc += Ks[i * GP + a] * __expf(gl - gcs[i]) * VNs[i * GP + d];
            Ss[a * GP + d] = acc; }
    }
    __syncthreads();
}
__device__ __forceinline__ void g4_gdn_out(Frame& F) {
    const bf16* OG = (const bf16*)(F.ws + WS_OG); const bf16* P = (const bf16*)(F.ws + WS_PROJ); bf16* MIX = (bf16*)(F.ws + WS_MIX); const float* gn = F.in[I_EGDNN]; const int lane = F.lane;
    const f32x4 g0 = *(const GAS f32x4*)(gn + (lane & 7) * 8), g1 = *(const GAS f32x4*)(gn + (lane & 7) * 8 + 4);
    for (int r = F.gw; r < NR; r += F.NGW) {
        const v4u a = *(const GAS v4u*)(OG + (size_t)r * 1024 + 8 * lane), c = *(const GAS v4u*)(OG + (size_t)r * 1024 + 512 + 8 * lane), z = *(const GAS v4u*)(P + (size_t)r * EINP + E_Z + 8 * lane);
        float o[8] = {bflo(a.x) + bflo(c.x), bfhi(a.x) + bfhi(c.x), bflo(a.y) + bflo(c.y), bfhi(a.y) + bfhi(c.y), bflo(a.z) + bflo(c.z), bfhi(a.z) + bfhi(c.z), bflo(a.w) + bflo(c.w), bfhi(a.w) + bfhi(c.w)};
        float ss = 0.f;
#pragma unroll
        for (int e = 0; e < 8; ++e) ss += o[e] * o[e];
        ss += __shfl_xor(ss, 1); ss += __shfl_xor(ss, 2); ss += __shfl_xor(ss, 4);
        const float rs = 1.f / sqrtf(ss * (1.f / 64.f) + EPS);
        const float zz[8] = {bflo(z.x), bfhi(z.x), bflo(z.y), bfhi(z.y), bflo(z.z), bfhi(z.z), bflo(z.w), bfhi(z.w)};
        const float gg[8] = {g0.x, g0.y, g0.z, g0.w, g1.x, g1.y, g1.z, g1.w};
#pragma unroll
        for (int e = 0; e < 8; ++e) o[e] = o[e] * rs * gg[e] * siluf(zz[e]);
        *(GAS v4u*)(MIX + (size_t)r * 1024 + 8 * lane) = (v4u){pk2(o[0], o[1]), pk2(o[2], o[3]), pk2(o[4], o[5]), pk2(o[6], o[7])}; }
}
__device__ __forceinline__ void swa_unit(Frame& F, int u) {
    const bf16* P = (const bf16*)(F.ws + WS_PROJ); bf16* MIX = (bf16*)(F.ws + WS_MIX);
    constexpr float SC = 0.125f, C = SC * 1.4426950408889634f, THRS = att::THR / SC;
    if (u < 512) { const int b = u >> 7, qb = (u >> 3) & 15, hq = u & 7, kvh = hq >> 2; const size_t rq = (size_t)b * SROW + TC + qb * 256, r0 = (size_t)b * SROW;
        const int lat0 = qb * 256 - 128 < 0 ? 0 : qb * 256 - 128, lend = qb * 256 + 384 > T ? T : qb * 256 + 384, NT = 4 + (lend - lat0) / 64;
        att::attn_unit<64, 64, 1>(P + rq * EINP + E_SQ + hq * 64, EINP, P + r0 * EINP + E_SK + kvh * 64, EINP, P + r0 * EINP + E_SV + kvh * 64, EINP,
                                  MIX + rq * 1024 + 512 + hq * 64, 1024, NT, lat0, qb * 256, C, THRS, F.in[I_ESINK][hq] * 1.4426950408889634f, F.ldsg + RING_OFF);
    } else { const int v = u - 512, b = v >> 3, hq = v & 7, kvh = hq >> 2; const size_t r0 = (size_t)b * SROW;
        att::attn_unit<64, 64, 2>(P + r0 * EINP + E_SQ + hq * 64, EINP, P + r0 * EINP + E_SK + kvh * 64, EINP, P + r0 * EINP + E_SV + kvh * 64, EINP,
                                  MIX + r0 * 1024 + 512 + hq * 64, 1024, 4, 0, 0, C, THRS, F.in[I_ESINK][hq] * 1.4426950408889634f, F.ldsg + RING_OFF); }
}
namespace gdn {
using bf16x8 = __attribute__((ext_vector_type(8))) short;
using f32x16 = __attribute__((ext_vector_type(16))) float;
using u32x4  = __attribute__((ext_vector_type(4))) unsigned;
__device__ __forceinline__ int crow(int r, int hi) { return (r & 3) + 8 * (r >> 2) + 4 * hi; }
typedef float f32x2_t __attribute__((ext_vector_type(2))); typedef __bf16 bf16x2_t __attribute__((ext_vector_type(2)));
__device__ __forceinline__ unsigned cvtpk(float lo, float hi) { f32x2_t v = {lo, hi}; bf16x2_t b = __builtin_convertvector(v, bf16x2_t); return __builtin_bit_cast(unsigned, b); }
__device__ __forceinline__ int swap23(int p) { return (p & ~0xC) | ((p & 4) << 1) | ((p & 8) >> 1); }
typedef float f32x4g __attribute__((ext_vector_type(4)));
template <int I> struct LRow {
    static constexpr int NQ = (I + 3) / 4, O = I * 128;
    static __device__ __forceinline__ void load(f32x4g (&b)[8], unsigned la) {
        if constexpr (NQ == 1) asm volatile("ds_read_b128 %0, %1 offset:%2\n\ts_waitcnt lgkmcnt(0)" : "=&v"(b[0]) : "v"(la), "i"(O));
        else if constexpr (NQ == 2) asm volatile("ds_read_b128 %0, %2 offset:%3\n\tds_read_b128 %1, %2 offset:%4\n\ts_waitcnt lgkmcnt(0)" : "=&v"(b[0]), "=&v"(b[1]) : "v"(la), "i"(O), "i"(O + 16));
        else if constexpr (NQ == 3) asm volatile("ds_read_b128 %0, %3 offset:%4\n\tds_read_b128 %1, %3 offset:%5\n\tds_read_b128 %2, %3 offset:%6\n\ts_waitcnt lgkmcnt(0)" : "=&v"(b[0]), "=&v"(b[1]), "=&v"(b[2]) : "v"(la), "i"(O), "i"(O + 16), "i"(O + 32));
        else if constexpr (NQ == 4) asm volatile("ds_read_b128 %0, %4 offset:%5\n\tds_read_b128 %1, %4 offset:%6\n\tds_read_b128 %2, %4 offset:%7\n\tds_read_b128 %3, %4 offset:%8\n\ts_waitcnt lgkmcnt(0)" : "=&v"(b[0]), "=&v"(b[1]), "=&v"(b[2]), "=&v"(b[3]) : "v"(la), "i"(O), "i"(O + 16), "i"(O + 32), "i"(O + 48));
        else if constexpr (NQ == 5) asm volatile("ds_read_b128 %0, %5 offset:%6\n\tds_read_b128 %1, %5 offset:%7\n\tds_read_b128 %2, %5 offset:%8\n\tds_read_b128 %3, %5 offset:%9\n\tds_read_b128 %4, %5 offset:%10\n\ts_waitcnt lgkmcnt(0)" : "=&v"(b[0]), "=&v"(b[1]), "=&v"(b[2]), "=&v"(b[3]), "=&v"(b[4]) : "v"(la), "i"(O), "i"(O + 16), "i"(O + 32), "i"(O + 48), "i"(O + 64));
        else if constexpr (NQ == 6) asm volatile("ds_read_b128 %0, %6 offset:%7\n\tds_read_b128 %1, %6 offset:%8\n\tds_read_b128 %2, %6 offset:%9\n\tds_read_b128 %3, %6 offset:%10\n\tds_read_b128 %4, %6 offset:%11\n\tds_read_b128 %5, %6 offset:%12\n\ts_waitcnt lgkmcnt(0)" : "=&v"(b[0]), "=&v"(b[1]), "=&v"(b[2]), "=&v"(b[3]), "=&v"(b[4]), "=&v"(b[5]) : "v"(la), "i"(O), "i"(O + 16), "i"(O + 32), "i"(O + 48), "i"(O + 64), "i"(O + 80));
        else if constexpr (NQ == 7) asm volatile("ds_read_b128 %0, %7 offset:%8\n\tds_read_b128 %1, %7 offset:%9\n\tds_read_b128 %2, %7 offset:%10\n\tds_read_b128 %3, %7 offset:%11\n\tds_read_b128 %4, %7 offset:%12\n\tds_read_b128 %5, %7 offset:%13\n\tds_read_b128 %6, %7 offset:%14\n\ts_waitcnt lgkmcnt(0)" : "=&v"(b[0]), "=&v"(b[1]), "=&v"(b[2]), "=&v"(b[3]), "=&v"(b[4]), "=&v"(b[5]), "=&v"(b[6]) : "v"(la), "i"(O), "i"(O + 16), "i"(O + 32), "i"(O + 48), "i"(O + 64), "i"(O + 80), "i"(O + 96));
        else asm volatile("ds_read_b128 %0, %8 offset:%9\n\tds_read_b128 %1, %8 offset:%10\n\tds_read_b128 %2, %8 offset:%11\n\tds_read_b128 %3, %8 offset:%12\n\tds_read_b128 %4, %8 offset:%13\n\tds_read_b128 %5, %8 offset:%14\n\tds_read_b128 %6, %8 offset:%15\n\tds_read_b128 %7, %8 offset:%16\n\ts_waitcnt lgkmcnt(0)" : "=&v"(b[0]), "=&v"(b[1]), "=&v"(b[2]), "=&v"(b[3]), "=&v"(b[4]), "=&v"(b[5]), "=&v"(b[6]), "=&v"(b[7]) : "v"(la), "i"(O), "i"(O + 16), "i"(O + 32), "i"(O + 48), "i"(O + 64), "i"(O + 80), "i"(O + 96), "i"(O + 112));
    }
};
template <int I> struct Solve32 {
    static __device__ __forceinline__ void run(float (&x)[32], unsigned la) {
#ifdef SOLVE_C_LOAD
        f32x4g b[8]; { const LAS f32x4g* Lp = (const LAS f32x4g*)(uintptr_t)(la + I * 128);
#pragma unroll
          for (int q = 0; q < (I + 3) / 4; ++q) b[q] = Lp[q]; }
#else
        f32x4g b[8]; LRow<I>::load(b, la);
#endif
        float a = x[I];
#pragma unroll
#ifdef SOLVE_C_FMA
        for (int j = 0; j < I; ++j) a = __builtin_fmaf(-b[j >> 2][j & 3], x[j], a);
#else
        for (int j = 0; j < I; ++j) asm volatile("v_fma_f32 %0, -%1, %2, %0" : "+v"(a) : "v"(b[j >> 2][j & 3]), "v"(x[j]));
#endif
        x[I] = a;
        if constexpr (I < 31) Solve32<I + 1>::run(x, la);
    }
};
__device__ __forceinline__ void solve32(float (&x)[32], unsigned la) { Solve32<1>::run(x, la); }
__device__ __forceinline__ void col_frags32(const float (&x)[32], bf16x8 (&F)[4][2], int s0) {
#pragma unroll
    for (int s = 0; s < 2; ++s) {
        const unsigned p0[4] = {cvtpk(x[16 * s + 0], x[16 * s + 1]), cvtpk(x[16 * s + 2], x[16 * s + 3]), cvtpk(x[16 * s + 8], x[16 * s + 9]), cvtpk(x[16 * s + 10], x[16 * s + 11])};
        const unsigned p1[4] = {cvtpk(x[16 * s + 4], x[16 * s + 5]), cvtpk(x[16 * s + 6], x[16 * s + 7]), cvtpk(x[16 * s + 12], x[16 * s + 13]), cvtpk(x[16 * s + 14], x[16 * s + 15])};
        u32x4 f0, f1;
#pragma unroll
        for (int q = 0; q < 4; ++q) { auto r = __builtin_amdgcn_permlane32_swap(p0[q], p1[q], false, false); f0[q] = r[0]; f1[q] = r[1]; }
        F[s0 + s][0] = __builtin_bit_cast(bf16x8, f0); F[s0 + s][1] = __builtin_bit_cast(bf16x8, f1); }
}
__device__ __forceinline__ void solve_blocked(float (&x1)[32], float (&x2)[32], unsigned la, const bf16x8 (&L21A)[2], bf16x8 (&F)[4][2]) {
    solve32(x1, la);
    col_frags32(x1, F, 0);
    f32x16 t0 = f32x16{}, t1 = f32x16{};
    t0 = __builtin_amdgcn_mfma_f32_32x32x16_bf16(L21A[0], F[0][0], t0, 0, 0, 0); t0 = __builtin_amdgcn_mfma_f32_32x32x16_bf16(L21A[1], F[1][0], t0, 0, 0, 0);
    t1 = __builtin_amdgcn_mfma_f32_32x32x16_bf16(L21A[0], F[0][1], t1, 0, 0, 0); t1 = __builtin_amdgcn_mfma_f32_32x32x16_bf16(L21A[1], F[1][1], t1, 0, 0, 0);
#pragma unroll
    for (int r = 0; r < 16; ++r) { const float e0 = t0[r], e1 = t1[r]; auto sw = __builtin_amdgcn_permlane32_swap(__float_as_uint(e0), __float_as_uint(e1), false, false);
        x2[(r & 3) + 8 * (r >> 2)] -= __uint_as_float(sw[0]); x2[(r & 3) + 8 * (r >> 2) + 4] -= __uint_as_float(sw[1]); }
    __builtin_amdgcn_sched_barrier(0);
    solve32(x2, la + 4096u);
    col_frags32(x2, F, 2);
}
__device__ __forceinline__ bf16x8 acc_frag(const f32x16& t, int sp) {
    u32x4 w;
    if (sp == 0) { w[0] = cvtpk(t[0], t[1]); w[1] = cvtpk(t[2], t[3]); w[2] = cvtpk(t[4], t[5]); w[3] = cvtpk(t[6], t[7]); }
    else { w[0] = cvtpk(t[8], t[9]); w[1] = cvtpk(t[10], t[11]); w[2] = cvtpk(t[12], t[13]); w[3] = cvtpk(t[14], t[15]); }
    return __builtin_bit_cast(bf16x8, w);
}
__device__ __forceinline__ void store_accfrag(__amdgpu_buffer_rsrc_t ro, int soff, int lane, const f32x16& t) {
    __builtin_amdgcn_raw_buffer_store_b128((u32x4){cvtpk(t[0], t[1]), cvtpk(t[2], t[3]), cvtpk(t[4], t[5]), cvtpk(t[6], t[7])}, ro, lane * 32, soff, 0);
    __builtin_amdgcn_raw_buffer_store_b128((u32x4){cvtpk(t[8], t[9]), cvtpk(t[10], t[11]), cvtpk(t[12], t[13]), cvtpk(t[14], t[15])}, ro, lane * 32 + 16, soff, 0);
}
struct ItemGeom { int b, h, dir, rbase, len, n0; };
__device__ __forceinline__ ItemGeom item_geom(int chain, int ci) { ItemGeom g; g.b = chain >> 4; g.h = (chain >> 1) & 7; g.dir = chain & 1; const bool isc = ci < 4;
    g.n0 = (isc ? ci : ci - 4) * 64; g.rbase = g.b * SROW + (isc ? 0 : TC); g.len = isc ? TC : T; return g; }
__device__ __forceinline__ int item_row(const ItemGeom& g, int i) { const int n = g.n0 + i; return g.rbase + (g.dir ? g.len - 1 - n : n); }

#define G1_LANES() int zs_ = 0; asm volatile("" : "+v"(zs_)); const int lane = (int)__builtin_amdgcn_mbcnt_hi(~0u, __builtin_amdgcn_mbcnt_lo(~0u, (unsigned)zs_)), r32 = lane & 31, hi = lane >> 5; (void)r32; (void)hi
__device__ __forceinline__ void pair_lock(volatile LAS unsigned* w) {
    for (;;) { unsigned got = 0u; if (__builtin_amdgcn_mbcnt_hi(~0u, __builtin_amdgcn_mbcnt_lo(~0u, 0u)) == 0u) got = (__hip_atomic_exchange((LAS unsigned*)w, 1u, __ATOMIC_RELAXED, __HIP_MEMORY_SCOPE_WORKGROUP) == 0u) ? 1u : 0u;
        got = (unsigned)__builtin_amdgcn_readfirstlane((int)got); if (got) break; __builtin_amdgcn_s_sleep(2); }
    asm volatile("s_waitcnt lgkmcnt(0)" ::: "memory"); }
__device__ __forceinline__ void pair_unlock(volatile LAS unsigned* w) { asm volatile("s_waitcnt vmcnt(0) lgkmcnt(0)" ::: "memory"); if (__builtin_amdgcn_mbcnt_hi(~0u, __builtin_amdgcn_mbcnt_lo(~0u, 0u)) == 0u) __hip_atomic_store((LAS unsigned*)w, 0u, __ATOMIC_RELAXED, __HIP_MEMORY_SCOPE_WORKGROUP); asm volatile("s_waitcnt lgkmcnt(0)" ::: "memory"); }
#ifndef G1_LOCK
#define G1_LOCK 0
#endif
#define LOCK_IF(m) do { if (G1_LOCK & (m)) pair_lock(lockw); } while (0)
#define UNLOCK_IF(m) do { if (G1_LOCK & (m)) pair_unlock(lockw); } while (0)
constexpr int G1_L = 0, G1_ARR = 8192, G1_TK = 9216, G1_TV = 17408, G1_TQ = 17408  , G1_WAVE_LDS = 26624;
__device__ __forceinline__ void g1_item(Frame& F, int item, LAS unsigned char* wl, volatile LAS unsigned* lockw) {
    int zz = 0; asm volatile("" : "+v"(zz)); __builtin_assume((unsigned)zz < 2u);
    const int chain = item / 68, ci = item - chain * 68; const ItemGeom G = item_geom(chain, ci); const int h = G.h;
    LAS float* Ls = (LAS float*)(wl + G1_L); LAS float* gcA = (LAS float*)(wl + G1_ARR), *btA = gcA + 64, *egA = gcA + 128, *etA = gcA + 192;
    const LAS bf16* TK = (const LAS bf16*)(wl + G1_TK); const LAS bf16* TV = (const LAS bf16*)(wl + G1_TV); const LAS bf16* TQ = (const LAS bf16*)(wl + G1_TQ);
    const bf16* QK = (const bf16*)(F.ws + WS_QKVN); const float* GB = (const float*)(F.ws + WS_GB);
    bf16* out = (bf16*)(F.ws + WS_GDNI) + (size_t)item * 16384;
    LOCK_IF(1);
    u32x4 tq[8];
    { G1_LANES(); u32x4 t[2][8];
#pragma unroll
      for (int j = 0; j < 8; ++j) { const int i = (lane >> 3) + 8 * j; const bf16* rp = QK + (size_t)item_row(G, i) * 1536 + h * 64 + (lane & 7) * 8;
          t[0][j] = *(const GAS u32x4*)(rp + 512); t[1][j] = *(const GAS u32x4*)(rp + 1024); tq[j] = *(const GAS u32x4*)rp; }
#pragma unroll
      for (int j = 0; j < 8; ++j) { const int o = ((lane >> 3) + 8 * j) * 128 + (lane & 7) * 16;
          *(LAS u32x4*)(wl + G1_TK + o) = t[0][j]; *(LAS u32x4*)(wl + G1_TV + o) = t[1][j]; } }
    float gl;
    { G1_LANES(); const int row = item_row(G, lane); float g = GB[(size_t)row * 32 + G.dir * 8 + h]; const float bt = GB[(size_t)row * 32 + 16 + G.dir * 8 + h];
#pragma unroll
      for (int o = 1; o < 64; o <<= 1) { const float t = __builtin_bit_cast(float, __builtin_amdgcn_ds_bpermute((lane - o) << 2, __builtin_bit_cast(int, g))); if (lane >= o) g += t; }
      gl = __builtin_bit_cast(float, __builtin_amdgcn_readlane(__builtin_bit_cast(int, g), 63)); gcA[lane] = g; btA[lane] = bt; egA[lane] = __expf(g); etA[lane] = __expf(gl - g); }
    asm volatile("s_waitcnt lgkmcnt(0)" ::: "memory");
    const LAS float* gcz = gcA + zz; const LAS float* btz = btA + zz; const LAS float* egz = egA + zz; const LAS float* etz = etA + zz;
    UNLOCK_IF(1); LOCK_IF(2);
    bf16x8 L21A[2];
    { G1_LANES(); bf16x8 Kf[2][4];
#pragma unroll
      for (int t = 0; t < 2; ++t)
#pragma unroll
          for (int s = 0; s < 4; ++s) Kf[t][s] = *(const LAS bf16x8*)(TK + (32 * t + r32) * 64 + 16 * s + 8 * hi);
#pragma unroll
      for (int t = 0; t < 2; ++t) { f32x16 acc = f32x16{};
#pragma unroll
          for (int s = 0; s < 4; ++s) acc = __builtin_amdgcn_mfma_f32_32x32x16_bf16(Kf[t][s], Kf[t][s], acc, 0, 0, 0);
          const float gcj = gcz[32 * t + r32];
#pragma unroll
          for (int r = 0; r < 16; ++r) { const int il = crow(r, hi), i = 32 * t + il; const float e = __expf(fminf(gcz[i] - gcj, 0.f)); const float v0 = btz[i] * acc[r] * e; Ls[t * 1024 + il * 32 + r32] = (r32 < il) ? v0 : 0.f; } }
      { f32x16 acc = f32x16{};
#pragma unroll
          for (int s = 0; s < 4; ++s) acc = __builtin_amdgcn_mfma_f32_32x32x16_bf16(Kf[0][s], Kf[1][s], acc, 0, 0, 0);
          const int i = 32 + r32; const float gci = gcz[i], bti = btz[i];
#pragma unroll
          for (int r = 0; r < 16; ++r) { const int j = crow(r, hi); acc[r] = bti * acc[r] * __expf(fminf(gci - gcz[j], 0.f)); }
          L21A[0] = acc_frag(acc, 0); L21A[1] = acc_frag(acc, 1); } }
    asm volatile("s_waitcnt lgkmcnt(0)" ::: "memory"); __builtin_amdgcn_sched_barrier(0);
    UNLOCK_IF(2); LOCK_IF(4);
    bf16x8 UF[4][2];
    const unsigned la = (unsigned)(uintptr_t)Ls + ((unsigned)zz << 4);
    { G1_LANES(); float x1[32], x2[32];
#pragma unroll
      for (int i = 0; i < 64; ++i) { const float v = bf2f(TV[i * 64 + lane]) * btz[i]; if (i < 32) x1[i & 31] = v; else x2[i & 31] = v; }
      asm volatile("s_waitcnt lgkmcnt(0)" ::: "memory");
#pragma unroll
      for (int j = 0; j < 8; ++j) *(LAS u32x4*)(wl + G1_TQ + ((lane >> 3) + 8 * j) * 128 + (lane & 7) * 16) = tq[j];
      solve_blocked(x1, x2, la, L21A, UF); }
    __builtin_amdgcn_sched_barrier(0);
    bf16x8 WF[4][2];
    { G1_LANES(); float x1[32], x2[32];
#pragma unroll
      for (int i = 0; i < 64; ++i) { const float v = bf2f(TK[i * 64 + lane]) * btz[i] * egz[i]; if (i < 32) x1[i & 31] = v; else x2[i & 31] = v; }
      solve_blocked(x1, x2, la, L21A, WF); }
    __builtin_amdgcn_sched_barrier(0);
    UNLOCK_IF(4); LOCK_IF(8);
    bf16x8 KTA[4][2];
    { G1_LANES(); float k1[32], k2[32];
#pragma unroll
      for (int i = 0; i < 32; ++i) { k1[i] = bf2f(TK[i * 64 + lane]) * etz[i]; k2[i] = bf2f(TK[(32 + i) * 64 + lane]) * etz[32 + i]; }
      col_frags32(k1, KTA, 0); col_frags32(k2, KTA, 2); }
    __builtin_amdgcn_sched_barrier(0);
    const __amdgpu_buffer_rsrc_t ro = __builtin_amdgcn_make_buffer_rsrc((void*)out, 0, 32768, 0x00020000);
    {
    G1_LANES();
    const float egl = __expf(gl);
#pragma unroll
    for (int at = 0; at < 2; ++at)
#pragma unroll
        for (int ct = 0; ct < 2; ++ct) { f32x16 a0 = f32x16{}, a1 = f32x16{};
#pragma unroll
            for (int s = 0; s < 4; ++s) { a0 = __builtin_amdgcn_mfma_f32_32x32x16_bf16(KTA[s][at], UF[s][ct], a0, 0, 0, 0); a1 = __builtin_amdgcn_mfma_f32_32x32x16_bf16(KTA[s][at], WF[s][ct], a1, 0, 0, 0); }
            store_accfrag(ro, 16384 + (at * 2 + ct) * 2048, lane, a0);
            const int vo = 4 * hi * 128 + (32 * ct + swap23(r32)) * 2;
#pragma unroll
            for (int r = 0; r < 16; ++r) { const float v = ((at == ct && crow(r, hi) == r32) ? egl : 0.f) - a1[r];
                __builtin_amdgcn_raw_buffer_store_b16((short)f2bf(v), ro, vo + (r & 3) * 128 + (r >> 2) * 1024, 32 * at * 128, 0); }
            __builtin_amdgcn_sched_barrier(0); }
    }
    UNLOCK_IF(8); LOCK_IF(16);
    bf16x8 XA[3][2];
    { G1_LANES(); bf16x8 Kf[4], Qf[2][4]; const LAS bf16* TK2 = TK + zz;
#pragma unroll
      for (int t = 0; t < 2; ++t)
#pragma unroll
          for (int s = 0; s < 4; ++s) Qf[t][s] = *(const LAS bf16x8*)(TQ + (32 * t + r32) * 64 + 16 * s + 8 * hi);
#pragma unroll
      for (int tl = 0; tl < 3; ++tl) { const int jt = tl == 2 ? 1 : 0, it = tl == 0 ? 0 : 1;
          if (tl != 1) {
#pragma unroll
              for (int s = 0; s < 4; ++s) Kf[s] = *(const LAS bf16x8*)(TK2 + (32 * jt + r32) * 64 + 16 * s + 8 * hi); }
          f32x16 acc = f32x16{};
#pragma unroll
          for (int s = 0; s < 4; ++s) acc = __builtin_amdgcn_mfma_f32_32x32x16_bf16(Kf[s], Qf[it][s], acc, 0, 0, 0);
          const int i = 32 * it + r32; const float gci = gcz[i];
#pragma unroll
          for (int r = 0; r < 16; ++r) { const int j = 32 * jt + crow(r, hi); const float e = __expf(fminf(gci - gcz[j], 0.f)); const float v0 = acc[r] * e; acc[r] = (j <= i) ? v0 : 0.f; }
          XA[tl][0] = acc_frag(acc, 0); XA[tl][1] = acc_frag(acc, 1); __builtin_amdgcn_sched_barrier(0); } }
    __builtin_amdgcn_sched_barrier(0);
    {
    G1_LANES();
#pragma unroll
    for (int it = 0; it < 2; ++it)
#pragma unroll
        for (int ct = 0; ct < 2; ++ct) { f32x16 a0 = f32x16{}, a1 = f32x16{};
#pragma unroll
            for (int jt = 0; jt <= it; ++jt) { const int tl = (it == 0) ? 0 : (jt == 0 ? 1 : 2);
#pragma unroll
                for (int sp = 0; sp < 2; ++sp) { a0 = __builtin_amdgcn_mfma_f32_32x32x16_bf16(XA[tl][sp], UF[2 * jt + sp][ct], a0, 0, 0, 0); a1 = __builtin_amdgcn_mfma_f32_32x32x16_bf16(XA[tl][sp], WF[2 * jt + sp][ct], a1, 0, 0, 0); } }
            store_accfrag(ro, 24576 + (it * 2 + ct) * 2048, lane, a0);
            const int vo = 4 * hi * 128 + (32 * ct + swap23(r32)) * 2; const int a = 32 * ct + r32;
#pragma unroll
            for (int r = 0; r < 16; ++r) { const int i = 32 * it + crow(r, hi); const float qv = bf2f(TQ[i * 64 + a]);
                __builtin_amdgcn_raw_buffer_store_b16((short)f2bf(qv * egz[i] - a1[r]), ro, vo + (r & 3) * 128 + (r >> 2) * 1024, 8192 + 32 * it * 128, 0); }
            __builtin_amdgcn_sched_barrier(0); }
    }
    asm volatile("s_waitcnt lgkmcnt(0)" ::: "memory");
    UNLOCK_IF(16);
}
__device__ __forceinline__ void scan_chain(Frame& F, int chain, int dc) {
    const int w = F.wave, lane = F.lane, r32 = lane & 31, hi = lane >> 5, role = (w >> 1) & 1, rt = w & 1;
    LAS u32x4* SF = (LAS u32x4*)(F.lds + RING_OFF);
    const bf16* base = (const bf16*)(F.ws + WS_GDNI) + (size_t)chain * 68 * 16384; bf16* OG = (bf16*)(F.ws + WS_OG);
    for (int i = F.tid; i < 2 * 4 * 64; i += 512) SF[i] = (u32x4){0u, 0u, 0u, 0u};
    const bf16* Ab = base + (role ? 4096 : 0) + (32 * rt + r32) * 64 + 8 * hi; const bf16* Cb = base + (role ? 12288 : 8192) + ((rt * 2 + dc) * 64 + lane) * 16;
    struct Ops { bf16x8 a[4]; u32x4 c[2]; };
#define SC_LOAD(o, ci_) do { const bf16* A_ = Ab + (size_t)(ci_) * 16384; const bf16* C_ = Cb + (size_t)(ci_) * 16384; \
        _Pragma("unroll") for (int s_ = 0; s_ < 4; ++s_) (o).a[s_] = *(const GAS bf16x8*)(A_ + 16 * s_); (o).c[0] = *(const GAS u32x4*)C_; (o).c[1] = *(const GAS u32x4*)(C_ + 8); } while (0)
#define SC_STEP(o, ci_) do { f32x16 acc; \
        _Pragma("unroll") for (int q = 0; q < 4; ++q) { acc[2 * q] = bflo((o).c[0][q]); acc[2 * q + 1] = bfhi((o).c[0][q]); acc[8 + 2 * q] = bflo((o).c[1][q]); acc[8 + 2 * q + 1] = bfhi((o).c[1][q]); } \
        const LAS u32x4* Sb = SF + (((ci_) & 1) * 256) + lane; \
        _Pragma("unroll") for (int s_ = 0; s_ < 4; ++s_) { const u32x4 bw = Sb[s_ * 64]; acc = __builtin_amdgcn_mfma_f32_32x32x16_bf16((o).a[s_], __builtin_bit_cast(bf16x8, bw), acc, 0, 0, 0); } \
        SC_LOAD(o, ((ci_) + SCAN_PF < 68) ? (ci_) + SCAN_PF : 67);     \
        if (role == 0) { LAS u32x4* Sn = SF + ((((((ci_) + 1) & 1)) * 4 + 2 * rt) * 64) + lane; Sn[0] = __builtin_bit_cast(u32x4, acc_frag(acc, 0)); Sn[64] = __builtin_bit_cast(u32x4, acc_frag(acc, 1)); } \
        else { const ItemGeom G = item_geom(chain, (ci_)); LAS bf16* stg = (LAS bf16*)(F.lds + RING_OFF + 16384 + rt * 2048);     \
            _Pragma("unroll") for (int r = 0; r < 16; ++r) stg[crow(r, hi) * 32 + r32] = (bf16)f2bf(acc[r]); \
            asm volatile("s_waitcnt lgkmcnt(0)" ::: "memory"); \
            const u32x4 v0 = *(const LAS u32x4*)(stg + (lane >> 1) * 32 + (lane & 1) * 16), v1 = *(const LAS u32x4*)(stg + (lane >> 1) * 32 + (lane & 1) * 16 + 8); \
            GAS u32x4* po = (GAS u32x4*)(OG + (size_t)item_row(G, 32 * rt + (lane >> 1)) * 1024 + G.dir * 512 + G.h * 64 + 32 * dc + (lane & 1) * 16); po[0] = v0; po[1] = v1; } \
        asm volatile("s_waitcnt lgkmcnt(0)" ::: "memory"); __builtin_amdgcn_s_barrier(); asm volatile("" ::: "memory"); } while (0)
    if (w < 4) {
        Ops o[SCAN_PF];
#pragma unroll
        for (int k = 0; k < SCAN_PF; ++k) SC_LOAD(o[k], k);
        __syncthreads();
#pragma unroll
        for (int ci = 0; ci < 68; ++ci) SC_STEP(o[ci % SCAN_PF], ci);
        asm volatile("s_waitcnt vmcnt(0)" ::: "memory");
    } else {
        __syncthreads();
#pragma unroll 1
        for (int ci = 0; ci < 68; ++ci) { __builtin_amdgcn_s_barrier(); asm volatile("" ::: "memory"); }
    }
#undef SC_LOAD
#undef SC_STEP
}
}
__device__ __forceinline__ void l1_prep(Frame& F) {
    bf16* P = (bf16*)(F.ws + WS_PROJ2); bf16* KM = (bf16*)(F.ws + WS_KMLA); const int lane = F.lane;
    for (int r = F.gw; r < NR; r += F.NGW) { const int b = r / SROW, s = r - b * SROW; const bool isc = s < TC; const int p = s - TC; bf16* row = P + (size_t)r * OINP;
        { bf16* CQ = (bf16*)(F.ws + WS_CQN) + (size_t)r * 640;
          const v2u a = *(const GAS v2u*)(row + O_CQ + 4 * lane); const v2u c = (lane < 32) ? *(const GAS v2u*)(row + O_CQ + 256 + 4 * lane) : (v2u){0u, 0u}; const v2u k = *(const GAS v2u*)(row + O_CKV + 4 * lane);
          const float a0 = bflo(a.x), a1 = bfhi(a.x), a2 = bflo(a.y), a3 = bfhi(a.y), c0 = bflo(c.x), c1 = bfhi(c.x), c2 = bflo(c.y), c3 = bfhi(c.y), k0 = bflo(k.x), k1 = bfhi(k.x), k2 = bflo(k.y), k3 = bfhi(k.y);
          const float sq = wave_sum(a0 * a0 + a1 * a1 + a2 * a2 + a3 * a3 + c0 * c0 + c1 * c1 + c2 * c2 + c3 * c3), skv = wave_sum(k0 * k0 + k1 * k1 + k2 * k2 + k3 * k3);
          const float rq = 1.f / sqrtf(sq * (1.f / 384.f) + EPS), rk = 1.f / sqrtf(skv * (1.f / 256.f) + EPS);
          *(GAS v2u*)(CQ + 4 * lane) = (v2u){pk2(a0 * rq, a1 * rq), pk2(a2 * rq, a3 * rq)};
          if (lane < 32) *(GAS v2u*)(CQ + 256 + 4 * lane) = (v2u){pk2(c0 * rq, c1 * rq), pk2(c2 * rq, c3 * rq)};
          *(GAS v2u*)(CQ + 384 + 4 * lane) = (v2u){pk2(k0 * rk, k1 * rk), pk2(k2 * rk, k3 * rk)}; }
        if (lane < 16) { const int seg = lane >> 3, i = lane & 7, d0 = seg * 16 + i; float x0 = bf2f(row[O_KR + d0]), x1 = bf2f(row[O_KR + d0 + 8]);
            if (!isc) { const float pos = (float)(seg ? (p & 63) : (p >> 6)); const float ang = pos * __powf(10000.f, -(float)i * (1.f / 8.f)); float sn, cs; sincosf(ang, &sn, &cs);
                const float y0 = x0 * cs - x1 * sn, y1 = x1 * cs + x0 * sn; x0 = y0; x1 = y1; }
            const bf16 b0 = (bf16)f2bf(x0), b1 = (bf16)f2bf(x1);
#pragma unroll
            for (int h = 0; h < 8; ++h) { KM[(size_t)r * 768 + h * 96 + 64 + d0] = b0; KM[(size_t)r * 768 + h * 96 + 64 + d0 + 8] = b1; } }
        if (!isc) {
            const int pi = lane & 31, seg = pi >> 4, i = pi & 15, d0 = seg * 32 + i; const float pos = (float)(seg ? (p & 63) : (p >> 6));
            const float ang = pos * __powf(10000.f, -(float)i * (1.f / 16.f)); float sn, cs; sincosf(ang, &sn, &cs);
#pragma unroll
            for (int q = 0; q < 8; ++q) { const int hh = (lane >> 5) + 2 * q; bf16* base = row + (hh < 8 ? O_DQ + hh * 64 : O_DK + (hh - 8) * 64) + d0;
                const float x0 = bf2f(base[0]), x1 = bf2f(base[16]); base[0] = (bf16)f2bf(x0 * cs - x1 * sn); base[16] = (bf16)f2bf(x1 * cs + x0 * sn); } }
    }
}
__device__ __forceinline__ void l1_qrope(Frame& F) {
    bf16* QM = (bf16*)(F.ws + WS_QM); const int lane = F.lane;
    for (int r = F.gw; r < NR; r += F.NGW) { const int b = r / SROW, s = r - b * SROW; if (s < TC) continue; const int p = s - TC;
        const int pi = lane & 15, seg = pi >> 3, i = pi & 7, d0 = seg * 16 + i; const float pos = (float)(seg ? (p & 63) : (p >> 6));
        const float ang = pos * __powf(10000.f, -(float)i * (1.f / 8.f)); float sn, cs; sincosf(ang, &sn, &cs);
#pragma unroll
        for (int q = 0; q < 2; ++q) { const int h = (lane >> 4) + 4 * q; bf16* base = QM + (size_t)r * 768 + h * 96 + 64 + d0;
            const float x0 = bf2f(base[0]), x1 = bf2f(base[8]); base[0] = (bf16)f2bf(x0 * cs - x1 * sn); base[8] = (bf16)f2bf(x1 * cs + x0 * sn); } }
}
__device__ __forceinline__ void l1_attn_unit(Frame& F, int u) {
    if (u < 512) { const int b = u >> 7, qb = (u >> 3) & 15, h = u & 7; const size_t rq = (size_t)b * SROW + TC + qb * 256, r0 = (size_t)b * SROW;
        constexpr float SC = 0.10206207261596575f  , C = SC * 1.4426950408889634f, THRS = att::THR / SC;
        const bf16* QM = (const bf16*)(F.ws + WS_QM); const bf16* KM = (const bf16*)(F.ws + WS_KMLA); const bf16* VM = (const bf16*)(F.ws + WS_VMLA); bf16* MIX = (bf16*)(F.ws + WS_MIX);
        att::attn_unit<96, 64, 0, true>(QM + rq * 768 + h * 96, 768, KM + r0 * 768 + h * 96, 768, VM + r0 * 512 + h * 64, 512, MIX + rq * 1024 + h * 64, 1024, SROW / 64, 0, qb * 256, C, THRS, -3.0e38f, F.ldsg + RING_OFF);
    } else { const int v = u - 512, b = v >> 6, qb = (v >> 2) & 15, head = v & 3; const size_t rq = (size_t)b * SROW + TC + qb * 256, r0 = (size_t)b * SROW;
        constexpr float SC = 0.125f, C = SC * 1.4426950408889634f, THRS = att::THR / SC; constexpr float LAM_INIT = 0.35550906759096556f;
        const float* lp = F.in[I_OLAM]; const float lam = __expf(wave_sum(lp[F.lane] * lp[64 + F.lane])) - __expf(wave_sum(lp[128 + F.lane] * lp[192 + F.lane])) + LAM_INIT;
        const bf16* P = (const bf16*)(F.ws + WS_PROJ2); bf16* MIX = (bf16*)(F.ws + WS_MIX); const int hh = 2 * head;
        att::attn_unit<64, 128, 0, false, 1>(P + rq * OINP + O_DQ + hh * 64, OINP, P + r0 * OINP + O_DK + hh * 64, OINP, P + r0 * OINP + O_DV + head * 128, OINP, MIX, 1024, SROW / 64, 0, 0, C, THRS, -3.0e38f, F.ldsg + RING_OFF);
        att::attn_unit<64, 128, 0, false, 2>(P + rq * OINP + O_DQ + (hh + 1) * 64, OINP, P + r0 * OINP + O_DK + (hh + 1) * 64, OINP, P + r0 * OINP + O_DV + head * 128, OINP, MIX + rq * 1024 + 512 + head * 128, 1024, SROW / 64, 0, 0, C, THRS, -3.0e38f, F.ldsg + RING_OFF,
                                             lam, F.in[I_OSUBLN], 1.f - LAM_INIT); }
}
__device__ __forceinline__ void l1_diff_post(Frame& F) {
    const bf16* OD = (const bf16*)(F.ws + WS_ODIFF); bf16* MIX = (bf16*)(F.ws + WS_MIX); const int lane = F.lane; const float* lp = F.in[I_OLAM];
    constexpr float LAM_INIT = 0.35550906759096556f;
    const float s01 = wave_sum(lp[lane] * lp[64 + lane]), s23 = wave_sum(lp[128 + lane] * lp[192 + lane]); const float lam = __expf(s01) - __expf(s23) + LAM_INIT;
    const int head = lane >> 4, d = (lane & 15) * 8; const f32x4 w0 = *(const GAS f32x4*)(F.in[I_OSUBLN] + d), w1 = *(const GAS f32x4*)(F.in[I_OSUBLN] + d + 4);
    const float ww[8] = {w0.x, w0.y, w0.z, w0.w, w1.x, w1.y, w1.z, w1.w};
    for (int r = F.gw; r < NR; r += F.NGW) { const int b = r / SROW, s = r - b * SROW; if (s < TC) continue;
        const v4u a = *(const GAS v4u*)(OD + (size_t)r * 1024 + (2 * head) * 128 + d), c = *(const GAS v4u*)(OD + (size_t)r * 1024 + (2 * head + 1) * 128 + d);
        float o[8] = {bflo(a.x) - lam * bflo(c.x), bfhi(a.x) - lam * bfhi(c.x), bflo(a.y) - lam * bflo(c.y), bfhi(a.y) - lam * bfhi(c.y), bflo(a.z) - lam * bflo(c.z), bfhi(a.z) - lam * bfhi(c.z), bflo(a.w) - lam * bflo(c.w), bfhi(a.w) - lam * bfhi(c.w)};
        float ss = 0.f;
#pragma unroll
        for (int e = 0; e < 8; ++e) ss += o[e] * o[e];
        ss += __shfl_xor(ss, 1); ss += __shfl_xor(ss, 2); ss += __shfl_xor(ss, 4); ss += __shfl_xor(ss, 8);
        const float rs = (1.f - LAM_INIT) / sqrtf(ss * (1.f / 128.f) + EPS);
#pragma unroll
        for (int e = 0; e < 8; ++e) o[e] = o[e] * rs * ww[e];
        *(GAS v4u*)(MIX + (size_t)r * 1024 + 512 + head * 128 + d) = (v4u){pk2(o[0], o[1]), pk2(o[2], o[3]), pk2(o[4], o[5]), pk2(o[6], o[7])}; }
}
__device__ __forceinline__ void moe_bases(Frame& F, int (&base)[8], int& ntiles) { int acc = 0;
#pragma unroll
    for (int e = 0; e < 8; ++e) { base[e] = acc; const int c = (int)__hip_atomic_load((unsigned*)(F.ctl + CW_MOECNT + 64 * e), RLX_AGENT); acc += (c + 255) & ~255; }
    ntiles = acc >> 8; }
constexpr size_t META_TEXP = 640 * 1024, META_POS = 768 * 1024;
__device__ __forceinline__ int row_vcu(const Frame& F, int r) { return (r % F.NGW) >> 3; }
__device__ __forceinline__ void moe_gather(Frame& F) {
    int base[8], ntiles; moe_bases(F, base, ntiles);
    int* TEXP = (int*)(F.ws + WS_META + META_TEXP); int* POS = (int*)(F.ws + WS_META + META_POS);
    const int* TOPI = (const int*)(F.ws + WS_META + META_TOPI); const int* RANK = (const int*)(F.ws + WS_META + META_RANK);
    if (blockIdx.x == 0 && F.tid < 144) { const int t = F.tid; int e = 0;
#pragma unroll
        for (int q = 1; q < 8; ++q) if (t * 256 >= base[q]) e = q;
        TEXP[t] = e; if (t == 143) TEXP[144] = ntiles; }
    const bf16* FIN = (const bf16*)(F.ws + WS_FIN2); bf16* AS = (bf16*)(F.ws + WS_ASORT);
    for (int tk = F.gw; tk < NB * T; tk += F.NGW) { const int b = tk / T, t = tk - b * T; const size_t r = (size_t)b * SROW + TC + t;
        const GAS v4u* src = (const GAS v4u*)(FIN + r * D) + F.lane; const v4u x0 = src[0], x1 = src[64];
#pragma unroll
        for (int sl = 0; sl < 2; ++sl) { const int e = TOPI[tk * 2 + sl]; int bs = 0;
#pragma unroll
            for (int q = 0; q < 8; ++q) if (q == e) bs = base[q];
            const int pos = bs + ((const int*)(F.ws + WS_META + META_BLKB))[tok_vcu(F, b, t) * 8 + e] + RANK[tk * 2 + sl]; if (F.lane == 0) POS[tk * 2 + sl] = pos;
            GAS v4u* dst = (GAS v4u*)(AS + (size_t)pos * D) + F.lane; dst[0] = x0; dst[64] = x1; } }
}
__device__ __forceinline__ Row4 moe_out_row(Frame& F, const bf16* OR, int pos_) {
    const int pos = __builtin_amdgcn_readfirstlane(pos_), tile = pos >> 8, part = tile >= 68 ? 1 : 0, local = tile - 68 * part;
    if (local < 64) return ld_row_bf16(OR + (size_t)pos * D, F.lane);
    const float* P = (const float*)(F.ws + (part ? WS_WXGU : WS_FIN2)) + ((size_t)(local - 64) * 256 + (pos & 255)) * 1024; Row4 y = ld_row_f32(P, F.lane);
    for (int s = 1; s < DFX / MOE_KSL; ++s) { const Row4 p = ld_row_f32(P + (size_t)s * 4 * 256 * 1024, F.lane);
#pragma unroll
        for (int j = 0; j < 4; ++j) y.v[j] += p.v[j]; }
    return y; }
__device__ __forceinline__ void rows_final(Frame& F) {
    const bf16* OR = (const bf16*)(F.ws + WS_ASORT); const int* POS = (const int*)(F.ws + WS_META + META_POS); const float* TOPW = (const float*)(F.ws + WS_META + META_TOPW);
    const int wpb = F.NGW >> 2, b = F.gw / wpb, wl = F.gw - b * wpb; const Row4 W = ld_row_f32(F.in[I_ONORMS] + 3 * 1024, F.lane), Gt = ld_row_f32(modvec(F, 1, b, 5), F.lane);
    for (int t = wl; t < T; t += wpb) { const int tk = b * T + t; float* xr = F.out + (size_t)tk * D;
        Row4 x = ld_row_bf16((const bf16*)(F.ws + WS_XB) + (size_t)tk * D, F.lane); const Row4 y0 = moe_out_row(F, OR, POS[tk * 2]), y1 = moe_out_row(F, OR, POS[tk * 2 + 1]);
        const float w0 = TOPW[tk * 2], w1 = TOPW[tk * 2 + 1]; Row4 y;
#pragma unroll
        for (int j = 0; j < 4; ++j) y.v[j] = y0.v[j] * w0 + y1.v[j] * w1;
        add_gated_norm_r(x, y, W, Gt); st_row_f32(xr, F.lane, x); }
}
constexpr int N_PHASES = 26;
__global__ void __launch_bounds__(NWAVES * 64, 2) trunk_fwd(Args args) {
    extern __shared__ __attribute__((aligned(16))) unsigned char lds[];
    Frame F;
    F.lds = (LAS unsigned char*)lds; F.ldsg = (char*)lds;
    F.MISC = (volatile LAS unsigned*)(F.lds + MISC_OFF);
    F.wave = __builtin_amdgcn_readfirstlane((int)threadIdx.x >> 6);
#define REFRESH() do { int z_ = 0; asm volatile("" : "+v"(z_)); F.lane = (int)__builtin_amdgcn_mbcnt_hi(~0u, __builtin_amdgcn_mbcnt_lo(~0u, (unsigned)z_)); F.tid = F.wave * 64 + F.lane; } while (0)
    REFRESH();
    F.G = gridDim.x; { const int bx = blockIdx.x; F.vcu = (F.G % 8 == 0) ? (bx % 8) * (F.G / 8) + bx / 8 : bx; }
    F.gw = F.vcu * NWAVES + F.wave; F.NGW = F.G * NWAVES;
    F.in = args.in; F.out = args.out; F.ws = args.ws; F.ctl = (gu32*)(args.ws + WS_CTL);
    unsigned char* ws = args.ws;
    for (int u = F.tid; u < (LDS_BYTES - MISC_OFF) / 4; u += NWAVES * 64) ((LAS unsigned*)(F.lds + MISC_OFF))[u] = 0u;
    __syncthreads();
    XcdBarrier bar; bar.bar = (unsigned*)(F.ctl + CW_BAR); bar.x = 0; bar.st = nullptr;
    const int lo = args.ph_lo, hi = args.ph_hi;
    const bool use_bar = (hi - lo) > 1;
    if (use_bar) bar = xcd_barrier_post((unsigned*)(F.ctl + CW_BAR), F.MISC + 8);
#ifndef MK_ONLY
#define MK_ONLY_OK(k) true
#else
#define MK_ONLY_OK(k) ((k) == MK_ONLY)
#endif
#define IN(k) (MK_ONLY_OK(k) && lo <= (k) && (k) < hi && (k) <= MK_LAST_PHASE)
#ifndef PROBE_MULT
#define PROBE_MULT 4
#endif
#ifndef PROBE_SPAN
#define PROBE_SPAN 1
#endif
#ifndef SCAN_REP
#define SCAN_REP 1
#endif
#ifndef SWA_REP
#define SWA_REP 1
#endif
#ifndef CHK_MASK
#define CHK_MASK 0xffu
#endif
#ifndef MK_REP_MASK
#define MK_REP_MASK 0u
#endif
#define REPS(k) ((((unsigned)MK_REP_MASK >> (k)) & 1u) ? 2 : 1)
#ifdef PROBE_PHASE
#define STAMP(k) do { if (blockIdx.x == 0 && F.tid == 0) { const unsigned long long t_ = __builtin_amdgcn_s_memrealtime(); F.MISC[64 + 2 * (k)] = (unsigned)t_; F.MISC[65 + 2 * (k)] = (unsigned)(t_ >> 32); } } while (0)
#else
#define STAMP(k) do { } while (0)
#endif
#define SEAM(k) do { if (IN(k) && IN((k) + 1)) xcd_barrier(bar); STAMP((k) + 1); } while (0)
    typedef pg8::bf16_t pb;
    const int bid = blockIdx.x;

    STAMP(0);
    if (IN(0)) for (int rep_ = 0; rep_ < REPS(0); ++rep_) { REFRESH(); p0_prologue(F); } SEAM(0);
    if (IN(1)) for (int rep_ = 0; rep_ < REPS(1); ++rep_) { REFRESH(); p1_first_rows(F); } SEAM(1);
    if (IN(2)) for (int rep_ = 0; rep_ < REPS(2); ++rep_) { REFRESH();
        pg8::Gemm g{(const pb*)(ws + WS_ABUF), (const pb*)(ws + WS_WEIN), NR, EINP, 1024, 1024, 1024}; pg8::StaticOrder S; S.init(NR, EINP, F.G, bid);
        pg8::EpiStore E{(pb*)(ws + WS_PROJ), EINP, EINP / 256};
        pg8::gemm_phase<pg8::EpiStore, pg8::StaticOrder, PG8_ALIGN, PG8_SP2>(F.lds + RING_OFF, g, S, E); } SEAM(2);
    if (IN(3)) for (int rep_ = 0; rep_ < REPS(3); ++rep_) { REFRESH(); g0_prep(F); } SEAM(3);
#ifdef GDN_SLOW
    if (IN(5)) for (int rep_ = 0; rep_ < REPS(5); ++rep_) { REFRESH();
        if (F.G > 64) { if (bid < 64) gdn_chain(F, bid); else for (int u = bid - 64; u < 544; u += F.G - 64) swa_unit(F, u); }
        else { for (int c = bid; c < 64; c += F.G) gdn_chain(F, c); for (int u = bid; u < 544; u += F.G) swa_unit(F, u); } } SEAM(5);
#else
    if (IN(4)) for (int rep_ = 0; rep_ < REPS(4); ++rep_) { REFRESH();
#if G1_LOCK
        if ((F.wave & 3) == 0) for (int item = F.vcu * 2 + (F.wave >> 2); item < 64 * 68; item += F.G * 2) gdn::g1_item(F, item, F.lds + RING_OFF + (F.wave >> 2) * gdn::G1_WAVE_LDS, F.MISC + 16);
#else
        const int n_main = ((64 * 68) / (F.G * 4)) * (F.G * 4), n_late = (64 * 68 - n_main + 3) / 4;
        if (F.wave < 4) { const int R = n_main / (F.G * 4);
            _Pragma("unroll 1") for (int r = 0; r <= R; ++r) { int item;
                if (r < R) item = F.vcu * 4 + F.wave + r * F.G * 4; else { if (F.vcu >= n_late) break; item = n_main + F.vcu * 4 + F.wave; if (item >= 64 * 68) break; }
                gdn::g1_item(F, item, F.lds + RING_OFF + F.wave * gdn::G1_WAVE_LDS, F.MISC + 16); } }
        else p0_deferred(F, F.wave - 4, F.lds + RING_OFF + 4 * gdn::G1_WAVE_LDS + (F.wave - 4) * 8448);
        if (F.vcu >= n_late) { __syncthreads(); REFRESH();
            if (F.tid == 0) F.MISC[20] = __hip_atomic_fetch_add((unsigned*)(F.ctl + CW_SWAQ), 1u, RLX_AGENT);
            __syncthreads(); const int u = (int)F.MISC[20]; __syncthreads();
            if (u < 544) swa_unit(F, u); }
#endif
    } SEAM(4);
    if (IN(5)) for (int rep_ = 0; rep_ < REPS(5); ++rep_) { REFRESH();
        STAMP(30); if (bid < 128) for (int c = bid; c < 128; c += F.G) { gdn::scan_chain(F, c >> 1, c & 1); __syncthreads(); } STAMP(31);
        REFRESH();
        for (;;) { if (F.tid == 0) F.MISC[20] = __hip_atomic_fetch_add((unsigned*)(F.ctl + CW_SWAQ), 1u, RLX_AGENT);
            __syncthreads(); const int u = (int)F.MISC[20]; __syncthreads();
            if (u >= 544 * REPS(5) * SWA_REP) break;
            swa_unit(F, u % 544); } } SEAM(5);
#endif
    if (IN(6)) for (int rep_ = 0; rep_ < REPS(6); ++rep_) { REFRESH(); g4_gdn_out(F); } SEAM(6);
    if (IN(7)) for (int rep_ = 0; rep_ < REPS(7); ++rep_) { REFRESH();
        { pg8::Gemm g{(const pb*)(ws + WS_MIX), (const pb*)(ws + WS_WEOUT), NR, 1024, 1024, 1024, 1024}; pg8::LatOrder S; S.init(1024, F.G, bid);
          pg8::EpiStore E{(pb*)(ws + WS_YBUF), 1024, 4};
          pg8::gemm_phase<pg8::EpiStore, pg8::LatOrder, PG8_ALIGN, PG8_SP2>(F.lds + RING_OFF, g, S, E); }
        __syncthreads();
        { pg8::Gemm g{(const pb*)(ws + WS_MIX), (const pb*)(ws + WS_WEOUT), NR, 1024, 256, 1024, 1024}; pg8::CtxSplitOrder S; S.init(4, 256, F.G, bid);
          pg8::EpiPartF32 E{(float*)(ws + WS_PART), 256};
          pg8::gemm_phase<pg8::EpiPartF32, pg8::CtxSplitOrder, PG8_ALIGN, PG8_SP2>(F.lds + RING_OFF, g, S, E); } } SEAM(7);
    if (IN(8)) for (int rep_ = 0; rep_ < REPS(8); ++rep_) { REFRESH(); rows_mid<false>(F, (const bf16*)(ws + WS_YBUF), F.in[I_ENORMS] + 1024, 0, 2, F.in[I_ENORMS] + 2048, 0, 3, (bf16*)(ws + WS_ABUF), false, 4); } SEAM(8);
    if (IN(9)) for (int rep_ = 0; rep_ < REPS(9); ++rep_) { REFRESH();
        pg8::Gemm g{(const pb*)(ws + WS_ABUF), (const pb*)(ws + WS_WEGU), NR, 2 * DFF, 1024, 1024, 1024}; pg8::StaticOrder S; S.init(NR, 2 * DFF, F.G, bid);
        pg8::EpiSwiGLU E{(pb*)(ws + WS_HID), DFF, DFF / 128};
        pg8::gemm_phase<pg8::EpiSwiGLU, pg8::StaticOrder, PG8_ALIGN, PG8_SP2>(F.lds + RING_OFF, g, S, E); } SEAM(9);
    if (IN(10)) for (int rep_ = 0; rep_ < REPS(10); ++rep_) { REFRESH();
        { pg8::Gemm g{(const pb*)(ws + WS_HID), (const pb*)(ws + WS_WEDN), NR, 1024, DFF, DFF, DFF}; pg8::LatOrder S; S.init(1024, F.G, bid);
          pg8::EpiStore E{(pb*)(ws + WS_YBUF), 1024, 4};
          pg8::gemm_phase<pg8::EpiStore, pg8::LatOrder, PG8_ALIGN, PG8_SP2>(F.lds + RING_OFF, g, S, E); }
        __syncthreads();
        { pg8::Gemm g{(const pb*)(ws + WS_HID), (const pb*)(ws + WS_WEDN), NR, 1024, 256, DFF, DFF}; pg8::CtxSplitOrder S; S.init(11, 256, F.G, bid);
          pg8::EpiPartF32 E{(float*)(ws + WS_PART), 256};
          pg8::gemm_phase<pg8::EpiPartF32, pg8::CtxSplitOrder, PG8_ALIGN, PG8_SP2>(F.lds + RING_OFF, g, S, E); } } SEAM(10);
    if (IN(11)) for (int rep_ = 0; rep_ < REPS(11); ++rep_) { REFRESH(); rows_mid<false>(F, (const bf16*)(ws + WS_YBUF), F.in[I_ENORMS] + 3072, 0, 5, F.in[I_ONORMS], 1, 0, (bf16*)(ws + WS_ABUF), false, 11); } SEAM(11);
    if (IN(12)) for (int rep_ = 0; rep_ < REPS(12); ++rep_) { REFRESH();
        pg8::Gemm g{(const pb*)(ws + WS_ABUF), (const pb*)(ws + WS_WOIN), NR, OINP, 1024, 1024, 1024}; pg8::StaticOrder S; S.init(NR, OINP, F.G, bid);
        pg8::EpiStore E{(pb*)(ws + WS_PROJ2), OINP, OINP / 256};
        pg8::gemm_phase<pg8::EpiStore, pg8::StaticOrder, PG8_ALIGN, PG8_SP2>(F.lds + RING_OFF, g, S, E); } SEAM(12);
    if (IN(13)) for (int rep_ = 0; rep_ < REPS(13); ++rep_) { REFRESH(); l1_prep(F); } SEAM(13);
    if (IN(14)) for (int rep_ = 0; rep_ < REPS(14); ++rep_) { REFRESH();
#if !defined(T13) || T13 == 1
        { pg8::Gemm g{(const pb*)(ws + WS_CQN), (const pb*)(ws + WS_WUQ), NR, 768, 384, 640, 384}; pg8::LatOrder S; S.init(768, F.G, bid);
          pg8::EpiStore E{(pb*)(ws + WS_QM), 768, 3};
          pg8::gemm_phase<pg8::EpiStore, pg8::LatOrder, PG8_ALIGN, PG8_SP2>(F.lds + RING_OFF, g, S, E); }
#endif
        __syncthreads();
#if !defined(T13) || T13 == 2
        { pg8::Gemm g{(const pb*)(ws + WS_CQN) + 384, (const pb*)(ws + WS_WUKV), NR, 1024, 256, 640, 256}; pg8::StaticOrder S; S.init(NR, 1024, F.G, bid);
          pg8::EpiKV E{(pb*)(ws + WS_KMLA), (pb*)(ws + WS_VMLA)};
          pg8::gemm_phase<pg8::EpiKV, pg8::StaticOrder, PG8_ALIGN, PG8_SP2>(F.lds + RING_OFF, g, S, E); }
#endif
    } SEAM(14);
    STAMP(16);
    if (IN(16)) for (int rep_ = 0; rep_ < REPS(16); ++rep_) { REFRESH(); for (int u = F.vcu; u < 768; u += F.G) l1_attn_unit(F, u); } SEAM(16);
    STAMP(18);
    if (IN(18)) for (int rep_ = 0; rep_ < REPS(18); ++rep_) { REFRESH();
        pg8::Gemm g{(const pb*)(ws + WS_MIX), (const pb*)(ws + WS_WOOUT), NR, 1024, 1024, 1024, 1024}; pg8::LatOrder S; S.init(1024, F.G, bid);
        pg8::EpiStore E{(pb*)(ws + WS_Y2), 1024, 4};
        pg8::gemm_phase<pg8::EpiStore, pg8::LatOrder, PG8_ALIGN, PG8_SP2>(F.lds + RING_OFF, g, S, E); } SEAM(18);
    if (IN(19)) for (int rep_ = 0; rep_ < REPS(19); ++rep_) { REFRESH();
        router_table(F);
        if (F.wave >= 4) px_expert_weights(F);
        rows_mid<true>(F, (const bf16*)(ws + WS_Y2), F.in[I_ONORMS] + 1024, 1, 2, F.in[I_ONORMS] + 2048, 1, 3, (bf16*)(ws + WS_FIN2), true);
        if (F.wave < 4) px_expert_weights(F);
        router_tail(F); } SEAM(19);
    if (IN(20)) for (int rep_ = 0; rep_ < REPS(20); ++rep_) { REFRESH(); moe_gather(F); } SEAM(20);
#define MOE_PART(kgu, kdn, t0_, cap_) \
    if (IN(kgu)) for (int rep_ = 0; rep_ < REPS(kgu); ++rep_) { REFRESH(); int base[8], ntiles; moe_bases(F, base, ntiles); const int t0 = (t0_), ntl = (ntiles - t0 < 0) ? 0 : ((ntiles - t0 < (cap_)) ? ntiles - t0 : (cap_)); \
        pg8::Gemm g{(const pb*)(ws + WS_ASORT) + (size_t)t0 * 256 * 1024, (const pb*)(ws + WS_WXGU), 0, 0, 1024, 1024, 1024}; pg8::MoeOrder S; S.init(ntl, 28, F.G, bid, (const int*)(ws + WS_META + META_TEXP), t0); \
        pg8::EpiSwiGLU E{(pb*)(ws + WS_HIDX), DFX, 28}; \
        pg8::gemm_phase<pg8::EpiSwiGLU, pg8::MoeOrder, PG8_ALIGN, PG8_SP2>(F.lds + RING_OFF, g, S, E); \
        if ((t0_) == 0 && ntl > 0) { const int nu = ntl * 28, remu = nu % F.G, first = remu ? remu : 0, ns = F.G - first;     \
            const int esp = ((const int*)(ws + WS_META + META_TEXP))[ntl - 1]; \
            if (bid >= first) { __syncthreads(); px_expert_down(F, (bid - first) * NWAVES + F.wave, ns * NWAVES, 0, esp + 1); } } } SEAM(kgu); \
    if (IN(kdn)) for (int rep_ = 0; rep_ < REPS(kdn); ++rep_) { REFRESH(); int base[8], ntiles; moe_bases(F, base, ntiles); const int t0 = (t0_), ntl = (ntiles - t0 < 0) ? 0 : ((ntiles - t0 < (cap_)) ? ntiles - t0 : (cap_)); \
        const int full = ntl < 64 ? ntl : 64, ex = ntl - full; \
        { pg8::Gemm g{(const pb*)(ws + WS_HIDX), (const pb*)(ws + WS_WXDN), 0, 0, DFX, DFX, DFX}; pg8::MoeOrder S; S.init(full, 4, F.G, bid, (const int*)(ws + WS_META + META_TEXP), t0); \
          pg8::EpiStore E{(pb*)(ws + WS_ASORT) + (size_t)t0 * 256 * 1024, 1024, 4}; \
          pg8::gemm_phase<pg8::EpiStore, pg8::MoeOrder, PG8_ALIGN, PG8_SP2>(F.lds + RING_OFF, g, S, E); } \
        if (ex > 0) { __syncthreads(); \
          pg8::Gemm g{(const pb*)(ws + WS_HIDX), (const pb*)(ws + WS_WXDN), 0, 0, MOE_KSL, DFX, DFX}; pg8::MoeSplitOrder S; S.init(ex, DFX / MOE_KSL, MOE_KSL, F.G, bid, (const int*)(ws + WS_META + META_TEXP), t0); \
          pg8::EpiMoePart E{(float*)(ws + ((t0_) ? WS_WXGU : WS_FIN2)), MOE_KSL}; \
          pg8::gemm_phase<pg8::EpiMoePart, pg8::MoeSplitOrder, PG8_ALIGN, PG8_SP2>(F.lds + RING_OFF, g, S, E); } \
        if ((t0_) == 0 && ntl > 0) { const int nsu = ex * 4 * (DFX / MOE_KSL), first = nsu < F.G ? nsu : 0, ns = F.G - first;     \
            const int esp = ((const int*)(ws + WS_META + META_TEXP))[ntl - 1]; \
            if (bid >= first && esp + 1 < NEXP) { __syncthreads(); px_expert_down(F, (bid - first) * NWAVES + F.wave, ns * NWAVES, esp + 1, NEXP); } } } SEAM(kdn);
    MOE_PART(21, 22, 0, 68)
    MOE_PART(23, 24, 68, 68)
    if (IN(25)) for (int rep_ = 0; rep_ < REPS(25); ++rep_) { REFRESH(); rows_final(F);
#if defined(CHK_G1) || defined(CHK_SCAN)
        { const unsigned fb = __hip_atomic_load((unsigned*)(F.ctl + CW_CHK), RLX_AGENT) & CHK_MASK; if (fb != 0u) { VM_WAIT(); __syncthreads(); for (int i = F.gw * 64 + F.lane; i < NB * T * D; i += F.NGW * 64) F.out[i] = 0.f; } }
#endif
    }
#ifdef PROBE_PHASE
    STAMP(26);
    if (blockIdx.x == 0 && F.tid == 0) {
        const unsigned long long t0 = ((unsigned long long)F.MISC[65 + 2 * PROBE_PHASE] << 32) | F.MISC[64 + 2 * PROBE_PHASE], t1 = ((unsigned long long)F.MISC[65 + 2 * (PROBE_PHASE + PROBE_SPAN)] << 32) | F.MISC[64 + 2 * (PROBE_PHASE + PROBE_SPAN)];
        unsigned long long dly = (t1 - t0) * PROBE_MULT; if (dly > 2000000ull) dly = 2000000ull; const unsigned long long s0 = __builtin_amdgcn_s_memrealtime();
        while (__builtin_amdgcn_s_memrealtime() - s0 < dly) __builtin_amdgcn_s_sleep(8); }
#endif
#undef IN
#undef SEAM
}

extern "C" void kernel_launch(void* const* d_in, const int* in_sizes, int n_in, void* d_out, int out_size, void* d_ws, size_t ws_size, hipStream_t stream) {
    static int grid = 0;
    if (grid == 0) {
        if (n_in != 32 || in_sizes[0] != NB * T * D || out_size != NB * T * D || ws_size < WS_END) { fprintf(stderr, "kernel_launch: unexpected shapes: n_in %d in0 %d out %d ws %zu (need %zu)\n", n_in, n_in > 0 ? in_sizes[0] : -1, out_size, ws_size, (size_t)WS_END); grid = -1; return; }
        int dev = 0, cus = 0, per_cu = 0;
        if (hipGetDevice(&dev) != hipSuccess || hipDeviceGetAttribute(&cus, hipDeviceAttributeMultiprocessorCount, dev) != hipSuccess) { grid = -1; return; }
        if (hipFuncSetAttribute((const void*)trunk_fwd, hipFuncAttributeMaxDynamicSharedMemorySize, LDS_BYTES) != hipSuccess) { fprintf(stderr, "kernel_launch: hipFuncSetAttribute failed\n"); grid = -1; return; }
        if (hipOccupancyMaxActiveBlocksPerMultiprocessor(&per_cu, (const void*)trunk_fwd, NWAVES * 64, LDS_BYTES) != hipSuccess || per_cu < 1) fprintf(stderr, "kernel_launch: occupancy query reports %d\n", per_cu);
        (void)hipGetLastError();
        grid = cus;
    }
    if (grid < 0) return;
    if (hipMemsetAsync((char*)d_ws + WS_CTL, 0, CTL_ZERO_BYTES, stream) != hipSuccess) return;
#ifdef DIAG_POISON
    (void)hipMemsetAsync((char*)d_ws + WS_GDNI, 0xFF, (size_t)64 * 68 * 32768, stream);
    (void)hipMemsetAsync((char*)d_ws + WS_OG, 0xFF, (size_t)NR * 1024 * 2, stream);
    (void)hipMemsetAsync((char*)d_ws + WS_QKVN, 0xFF, (size_t)NR * 1536 * 2, stream);
    (void)hipMemsetAsync((char*)d_ws + WS_GB, 0xFF, (size_t)NR * 32 * 4, stream);
#endif
    Args a{};
    for (int i = 0; i < 32; ++i) a.in[i] = (const float*)d_in[i];
    a.out = (float*)d_out; a.ws = (unsigned char*)d_ws;
#if MK_N_LAUNCHES == 1
    a.ph_lo = 0; a.ph_hi = N_PHASES;
    hipLaunchKernelGGL(trunk_fwd, dim3(grid), dim3(NWAVES * 64), LDS_BYTES, stream, a);
#else
    for (int p = 0; p < N_PHASES && p <= MK_LAST_PHASE; ++p) { a.ph_lo = p; a.ph_hi = p + 1; hipLaunchKernelGGL(trunk_fwd, dim3(grid), dim3(NWAVES * 64), LDS_BYTES, stream, a); }
#endif
    const hipError_t le = hipPeekAtLastError();
    if (le != hipSuccess) fprintf(stderr, "kernel_launch: launch failed: %s\n", hipGetErrorName(le));
}
```

```cpp
#include <hip/hip_runtime.h>
#include <cstdio>
#include <cstdint>
#include <cmath>

#ifndef MK_N_LAUNCHES
#define MK_N_LAUNCHES 1
#endif
#define SOLVE_C_FMA 1
#define SOLVE_C_LOAD 1
#ifndef G1_LOCK
#define G1_LOCK 0
#ifndef SCAN_PF
#define SCAN_PF 8
#endif
#ifndef SCAN_UNROLL
#define SCAN_UNROLL 1
#endif
#ifndef MOE_KSL
#define MOE_KSL 512
#endif
#endif
#ifndef MK_LAST_PHASE
#define MK_LAST_PHASE 99
#endif

constexpr int NB = 4, T = 4096, TC = 256, SROW = T + TC  , NR = NB * SROW  , D = 1024;
constexpr int EIN = 2848, EINP = 3072, OIN = 2208, OINP = 2304, DFF = 2816, DFX = 3584, NEXP = 8;
constexpr float EPS = 1e-6f;
constexpr int E_Q = 0, E_K = 512, E_V = 1024, E_Z = 1536, E_GA = 2048, E_GB = 2064, E_SQ = 2080, E_SK = 2592, E_SV = 2720;
constexpr int O_CQ = 0, O_CKV = 384, O_KR = 640, O_DQ = 672, O_DK = 1184, O_DV = 1696;

constexpr size_t MiB = 1u << 20;
constexpr size_t WS_CTL = 0, CTL_ZERO_BYTES = 1 * MiB;
constexpr size_t WS_MODV = 1 * MiB;
constexpr size_t WS_GB = 2 * MiB;
constexpr size_t WS_META = 5 * MiB;
constexpr size_t WS_HCTX = 8 * MiB;
constexpr size_t WS_WEIN = 12 * MiB, WS_WEOUT = 18 * MiB, WS_WEGU = 20 * MiB, WS_WEDN = 31 * MiB, WS_WOIN = 37 * MiB, WS_WUQ = 42 * MiB, WS_WUKV = 43 * MiB, WS_WOOUT = 44 * MiB;
constexpr size_t WS_BIG = 46 * MiB;
constexpr size_t WS_PROJ = 46 * MiB, WS_QKVN = 148 * MiB;
constexpr size_t WS_PROJ2 = 46 * MiB, WS_QM = 123 * MiB, WS_VMLA = 149 * MiB, WS_KMLA = 167 * MiB, WS_ODIFF = 316 * MiB;
constexpr size_t WS_WXGU = 46 * MiB, WS_WXDN = 158 * MiB;
constexpr size_t WS_CQN = 214 * MiB;
constexpr size_t WS_ABUF = 214 * MiB, WS_MIX = 248 * MiB, WS_YBUF = 282 * MiB;
constexpr size_t WS_OG = 214 * MiB;
constexpr size_t WS_PART = 350 * MiB;
constexpr size_t WS_GDNI = 282 * MiB;
constexpr size_t WS_HID = 46 * MiB;
constexpr size_t WS_ASORT = 214 * MiB;
constexpr size_t WS_FIN2 = 282 * MiB;
constexpr size_t WS_Y2 = 316 * MiB;
constexpr size_t WS_HIDX = 316 * MiB;
constexpr size_t WS_XB = 436 * MiB;
constexpr size_t WS_END = 470 * MiB;
static_assert(WS_QKVN + (size_t)NR * 1536 * 2 <= 214 * MiB && WS_PROJ + (size_t)NR * EINP * 2 <= WS_QKVN, "layer-0 big region");
static_assert(WS_PROJ2 + (size_t)NR * OINP * 2 <= WS_QM && WS_QM + (size_t)NR * 768 * 2 <= WS_VMLA && WS_VMLA + (size_t)NR * 512 * 2 <= WS_KMLA && WS_KMLA + (size_t)NR * 768 * 2 <= 214 * MiB, "layer-1 big region");
static_assert(WS_WXGU + (size_t)NEXP * 7168 * 1024 * 2 <= WS_WXDN && WS_WXDN + (size_t)NEXP * 1024 * 3584 * 2 <= 214 * MiB, "expert weights");
static_assert(WS_HIDX + (size_t)17408 * 3584 * 2 <= WS_END && WS_ASORT + (size_t)34816 * 1024 * 2 <= WS_FIN2 && WS_HID + (size_t)NR * DFF * 2 <= 214 * MiB, "moe map");
constexpr size_t META_TOPI = 0, META_TOPW = 128 * 1024, META_RANK = 256 * 1024, META_RSTD = 384 * 1024, META_BLKB = 960 * 1024;
constexpr int CW_TMO = 0, CW_CODE = 1;
constexpr int CW_MOECNT = 64;
constexpr int CW_SWAQ = 2048;
constexpr int CW_CHK = 1024;
constexpr int CW_BAR = 4096;
constexpr int RING_OFF = 0, RING_BYTES = 141312;
constexpr int MISC_OFF = RING_BYTES;
constexpr int LDS_BYTES = 147456;
constexpr int NWAVES = 8;
namespace pg8 {
#define PG8_LAS __attribute__((address_space(3)))
typedef unsigned short bf16_t;
typedef short bf16x8 __attribute__((ext_vector_type(8)));
typedef float f32x4 __attribute__((ext_vector_type(4)));
typedef unsigned u32x4 __attribute__((ext_vector_type(4)));
constexpr int BM = 256, BK = 64, HALF = 128, HTB = HALF * BK * 2  , STAGE_BYTES = 8 * HTB, NXCD = 8, WGM = 8;

__host__ __device__ __forceinline__ int lds_byte(int r, int c) { const int st = (r >> 4) * 2 + (c >> 5), rr = r & 15, cc = c & 31, ob = rr * 64 + cc * 2; return st * 1024 + (ob ^ (((ob >> 9) & 1) << 5)); }
__host__ __device__ __forceinline__ void stage_rc(int b, int& R, int& C) { const int st = b / 1024, sb = b % 1024, swz = sb ^ (((sb >> 9) & 1) << 5); R = (st >> 1) * 16 + swz / 64; C = (st & 1) * 32 + (swz % 64) / 2; }
__host__ __device__ __forceinline__ int perm32(int rho) { const int n = rho >> 4, i = rho & 15; return 8 * (i >> 2) + 4 * n + (i & 3); }

struct Unit { int pm, pn, kof; };
struct Gemm { const bf16_t* A; const bf16_t* Bt; int M, N, K, lda, ldb; };

struct StaticOrder {
    int nM, nN, nwg, G, c;
    __host__ __device__ void init(int M, int N, int G_, int c_) { nM = M / BM; nN = N / BM; nwg = nM * nN; G = G_; c = c_; }
    __host__ __device__ bool next(int i, Unit& u) const {
        const long L = (long)i * G + c; if (L >= nwg) return false;
        int wgid = (int)L; { const int q = nwg / NXCD, r = nwg % NXCD, xcd = wgid % NXCD, off = wgid / NXCD; wgid = (xcd < r ? xcd * (q + 1) : r * (q + 1) + (xcd - r) * q) + off; }
        const int nig = WGM * nN, gid = wgid / nig, fm = gid * WGM, gsz = (nM - fm) < WGM ? (nM - fm) : WGM;
        u.pm = fm + ((wgid % nig) % gsz); u.pn = (wgid % nig) / gsz; u.kof = 0; return true;
    }
    __device__ __forceinline__ void a_ready(const Unit&) const {}
    __device__ __forceinline__ void done(const Unit&) const {}
};

__device__ __forceinline__ unsigned cvt_pk_bf16(float lo, float hi) { unsigned r; asm volatile("v_cvt_pk_bf16_f32 %0, %1, %2" : "=v"(r) : "v"(lo), "v"(hi)); return r; }
typedef float f32x2 __attribute__((ext_vector_type(2)));
template <class Epi, class Sched, bool ALIGN_EPI = false, bool SP2 = false>
__device__ __forceinline__ void gemm_phase(PG8_LAS unsigned char* lds, const Gemm g, const Sched& S, const Epi& E) {
    const int tid = threadIdx.x, wid = __builtin_amdgcn_readfirstlane(tid >> 6), lane = tid & 63, wr = wid >> 2, wc = wid & 3, fr = lane & 15, fq = lane >> 4;
    const int K = g.K, nt = K / BK;
    unsigned voffA[2], voffB[2];
#pragma unroll
    for (int i = 0; i < 2; ++i) { int R, C; stage_rc(tid * 16 + i * 8192, R, C); const int Rb = Epi::PERM ? ((R & ~31) + perm32(R & 31)) : R;
        voffA[i] = (unsigned)(R * g.lda + C) * 2u; voffB[i] = (unsigned)(Rb * g.ldb + C) * 2u; }
    const size_t kstep = (size_t)(BK * 2);
    const size_t hstepA = (size_t)HALF * g.lda * 2, hstepB = (size_t)HALF * g.ldb * 2;
    const size_t tstepA = 2 * hstepA, tstepB = 2 * hstepB;
    const unsigned ldsw = (unsigned)wid * 1024u;
    const int aoff = lds_byte(wr * 64 + fr, fq * 8), boff = lds_byte(wc * 32 + fr, fq * 8);
#define PG8_SA(b, h) (((b) * 2 + (h)) * HTB)
#define PG8_SB(b, h) ((4 + (b) * 2 + (h)) * HTB)
#define PG8_STAGE(bufoff, gbase, voff) do { _Pragma("unroll") for (int _i = 0; _i < 2; ++_i) \
        __builtin_amdgcn_global_load_lds((const unsigned*)((const char*)(gbase) + (voff)[_i]), (PG8_LAS unsigned*)(lds + (bufoff) + ldsw + _i * 8192), 16, 0, 0); } while (0)
#define PG8_LDA(dst, b, h) do { _Pragma("unroll") for (int m = 0; m < 4; ++m) _Pragma("unroll") for (int k = 0; k < 2; ++k) dst[m][k] = *(const PG8_LAS bf16x8*)(lds + PG8_SA(b, h) + aoff + m * 2048 + k * 1024); } while (0)
#define PG8_LDB(dst, b, h) do { _Pragma("unroll") for (int n = 0; n < 2; ++n) _Pragma("unroll") for (int k = 0; k < 2; ++k) dst[n][k] = *(const PG8_LAS bf16x8*)(lds + PG8_SB(b, h) + boff + n * 2048 + k * 1024); } while (0)
#define PG8_MMA(ai, bj, At, Bt) do { __builtin_amdgcn_s_setprio(1); _Pragma("unroll") for (int m = 0; m < 4; ++m) _Pragma("unroll") for (int n = 0; n < 2; ++n) _Pragma("unroll") for (int k = 0; k < 2; ++k) \
        acc[ai][bj][m][n] = __builtin_amdgcn_mfma_f32_16x16x32_bf16(Bt[n][k], At[m][k], acc[ai][bj][m][n], 0, 0, 0); __builtin_amdgcn_s_setprio(0); } while (0)
#define PG8_WAIT_V(n) asm volatile("s_waitcnt vmcnt(" #n ")" ::: "memory")
#define PG8_WAIT_L(n) asm volatile("s_waitcnt lgkmcnt(" #n ")" ::: "memory")
#define PG8_BAR __builtin_amdgcn_s_barrier()
#define PG8_SCHED __builtin_amdgcn_sched_barrier(0)
    Unit cur, nxt; int ui = 0;
    if (!S.next(0, cur)) return;
    f32x4 acc[2][2][4][2];
#pragma unroll
    for (int a = 0; a < 2; ++a)
#pragma unroll
        for (int b = 0; b < 2; ++b)
#pragma unroll
            for (int m = 0; m < 4; ++m)
#pragma unroll
                for (int n = 0; n < 2; ++n) acc[a][b][m][n] = (f32x4){0.f, 0.f, 0.f, 0.f};
    bf16x8 At[4][2], B0[2][2], B1[2][2];
    const char* cA = (const char*)g.A + (size_t)cur.pm * tstepA + (size_t)cur.kof * 2; const char* cB = (const char*)g.Bt + (size_t)cur.pn * tstepB + (size_t)cur.kof * 2;
    S.a_ready(cur);
    if constexpr (SP2) {
        PG8_STAGE(PG8_SB(0, 0), cB, voffB); PG8_STAGE(PG8_SB(0, 1), cB + hstepB, voffB); PG8_STAGE(PG8_SA(0, 0), cA, voffA); PG8_STAGE(PG8_SA(0, 1), cA + hstepA, voffA);
        if (wr == 1) PG8_BAR;
        PG8_WAIT_V(2); PG8_BAR;
        PG8_STAGE(PG8_SB(1, 0), cB + kstep, voffB); PG8_STAGE(PG8_SA(1, 0), cA + kstep, voffA); PG8_STAGE(PG8_SB(1, 1), cB + hstepB + kstep, voffB);
        PG8_WAIT_V(6); PG8_BAR;
    } else {
        PG8_STAGE(PG8_SB(0, 0), cB, voffB); PG8_STAGE(PG8_SA(0, 0), cA, voffA); PG8_STAGE(PG8_SB(0, 1), cB + hstepB, voffB); PG8_STAGE(PG8_SA(0, 1), cA + hstepA, voffA);
        if (wr == 1) PG8_BAR;
        PG8_WAIT_V(4); PG8_BAR;
        PG8_STAGE(PG8_SB(1, 0), cB + kstep, voffB); PG8_STAGE(PG8_SA(1, 0), cA + kstep, voffA); PG8_STAGE(PG8_SB(1, 1), cB + hstepB + kstep, voffB);
        PG8_WAIT_V(6); PG8_BAR;
    }
    for (;;) {
        const bool has_next = S.next(ui + 1, nxt);
        const char* nA = has_next ? (const char*)g.A + (size_t)nxt.pm * tstepA + (size_t)nxt.kof * 2 : cA; const char* nB = has_next ? (const char*)g.Bt + (size_t)nxt.pn * tstepB + (size_t)nxt.kof * 2 : cB;
        _Pragma("unroll 1") for (int t = 0; t < nt; t += 2) {
            const bool last = (t == nt - 2);
            const char* a1 = cA + (size_t)(t + 1) * kstep;
            const char* a2 = last ? nA : cA + (size_t)(t + 2) * kstep; const char* b2 = last ? nB : cB + (size_t)(t + 2) * kstep;
            const char* a3 = a2 + kstep; const char* b3 = b2 + kstep;
            if (last && has_next) S.a_ready(nxt);
            if constexpr (SP2) {
            PG8_LDB(B0, 0, 0); PG8_LDB(B1, 0, 1); PG8_SCHED; PG8_LDA(At, 0, 0); PG8_STAGE(PG8_SA(1, 1), a1 + hstepA, voffA);
            PG8_WAIT_V(8); PG8_WAIT_L(0); PG8_BAR; PG8_MMA(0, 0, At, B0); PG8_MMA(0, 1, At, B1); PG8_BAR; PG8_SCHED;
            PG8_LDA(At, 0, 1); PG8_STAGE(PG8_SB(0, 0), b2, voffB); PG8_STAGE(PG8_SB(0, 1), b2 + hstepB, voffB); PG8_STAGE(PG8_SA(0, 0), a2, voffA);
            PG8_WAIT_V(8); PG8_WAIT_L(0); PG8_BAR; PG8_MMA(1, 0, At, B0); PG8_MMA(1, 1, At, B1); PG8_BAR; PG8_SCHED;
            PG8_LDB(B0, 1, 0); PG8_LDB(B1, 1, 1); PG8_SCHED; PG8_LDA(At, 1, 0); PG8_STAGE(PG8_SA(0, 1), a2 + hstepA, voffA);
            PG8_WAIT_V(8); PG8_WAIT_L(0); PG8_BAR; PG8_MMA(0, 0, At, B0); PG8_MMA(0, 1, At, B1); PG8_BAR; PG8_SCHED;
            PG8_LDA(At, 1, 1); PG8_STAGE(PG8_SB(1, 0), b3, voffB); PG8_STAGE(PG8_SB(1, 1), b3 + hstepB, voffB); PG8_STAGE(PG8_SA(1, 0), a3, voffA);
            PG8_WAIT_V(8); PG8_WAIT_L(0); PG8_BAR; PG8_MMA(1, 0, At, B0); PG8_MMA(1, 1, At, B1); PG8_BAR; PG8_SCHED;
            } else {
            PG8_LDB(B0, 0, 0); PG8_SCHED; PG8_LDA(At, 0, 0); PG8_STAGE(PG8_SA(1, 1), a1 + hstepA, voffA);
            PG8_WAIT_L(8); PG8_BAR; PG8_WAIT_L(0); PG8_MMA(0, 0, At, B0); PG8_BAR; PG8_SCHED;
            PG8_LDB(B1, 0, 1); PG8_STAGE(PG8_SB(0, 0), b2, voffB);
            PG8_BAR; PG8_WAIT_L(0); PG8_MMA(0, 1, At, B1); PG8_BAR;
            PG8_LDA(At, 0, 1); PG8_STAGE(PG8_SA(0, 0), a2, voffA);
            PG8_BAR; PG8_WAIT_L(0); PG8_MMA(1, 0, At, B0); PG8_BAR; PG8_SCHED;
            PG8_STAGE(PG8_SB(0, 1), b2 + hstepB, voffB);
            PG8_WAIT_V(6); PG8_BAR; PG8_MMA(1, 1, At, B1); PG8_BAR;
            PG8_LDB(B0, 1, 0); PG8_SCHED; PG8_LDA(At, 1, 0); PG8_STAGE(PG8_SA(0, 1), a2 + hstepA, voffA);
            PG8_WAIT_L(8); PG8_BAR; PG8_WAIT_L(0); PG8_MMA(0, 0, At, B0); PG8_BAR; PG8_SCHED;
            PG8_LDB(B1, 1, 1); PG8_STAGE(PG8_SB(1, 0), b3, voffB);
            PG8_BAR; PG8_WAIT_L(0); PG8_MMA(0, 1, At, B1); PG8_BAR;
            PG8_LDA(At, 1, 1); PG8_STAGE(PG8_SA(1, 0), a3, voffA);
            PG8_BAR; PG8_WAIT_L(0); PG8_MMA(1, 0, At, B0); PG8_BAR; PG8_SCHED;
            PG8_STAGE(PG8_SB(1, 1), b3 + hstepB, voffB);
            PG8_WAIT_V(6); PG8_BAR; PG8_MMA(1, 1, At, B1); PG8_BAR;
            }
        }
        if constexpr (ALIGN_EPI) { if (wr == 0) PG8_BAR; }
        if constexpr (!Epi::AFTER_DRAIN) { E(acc, cur, wr, wc, fr, fq); S.done(cur); }
        if (!has_next) break;
#pragma unroll
        for (int a = 0; a < 2; ++a)
#pragma unroll
            for (int b = 0; b < 2; ++b)
#pragma unroll
                for (int m = 0; m < 4; ++m)
#pragma unroll
                    for (int n = 0; n < 2; ++n) acc[a][b][m][n] = (f32x4){0.f, 0.f, 0.f, 0.f};
        cur = nxt; cA = nA; cB = nB; ++ui;
        if constexpr (ALIGN_EPI) { if (wr == 1) PG8_BAR; }
    }
    PG8_WAIT_V(0);
    if constexpr (!ALIGN_EPI) { if (wr == 0) PG8_BAR; }
    PG8_BAR;
    if constexpr (Epi::AFTER_DRAIN) { E.fused(acc, cur, wr, wc, fr, fq, lds, wid, lane); S.done(cur); }
#undef PG8_SA
#undef PG8_SB
#undef PG8_STAGE
#undef PG8_LDA
#undef PG8_LDB
#undef PG8_MMA
#undef PG8_WAIT_V
#undef PG8_WAIT_L
#undef PG8_BAR
#undef PG8_SCHED
}
}
namespace pg8 {
struct EpiStore { static constexpr bool PERM = true, AFTER_DRAIN = false;
    bf16_t* O; int ldc; int nN;
    __device__ __forceinline__ void operator()(const f32x4 (&acc)[2][2][4][2], const Unit& u, int wr, int wc, int fr, int fq) const {
        const int row0 = u.pm * BM + wr * 64 + fr, col0 = (u.pn % nN) * BM + wc * 32 + 8 * fq;
#pragma unroll
        for (int ai = 0; ai < 2; ++ai)
#pragma unroll
            for (int m = 0; m < 4; ++m) { const int row = row0 + ai * HALF + m * 16;
                bf16_t* rowp = O + (size_t)row * ldc + col0;
#pragma unroll
                for (int bj = 0; bj < 2; ++bj) { const f32x4 v0 = acc[ai][bj][m][0], v1 = acc[ai][bj][m][1];
                    u32x4 w; w.x = cvt_pk_bf16(v0[0], v0[1]); w.y = cvt_pk_bf16(v0[2], v0[3]); w.z = cvt_pk_bf16(v1[0], v1[1]); w.w = cvt_pk_bf16(v1[2], v1[3]);
                    *(u32x4*)(rowp + bj * HALF) = w; } }
    }
};
struct EpiSwiGLU { static constexpr bool PERM = true, AFTER_DRAIN = false;
    bf16_t* O; int ldc; int nN;
    __device__ __forceinline__ void operator()(const f32x4 (&acc)[2][2][4][2], const Unit& u, int wr, int wc, int fr, int fq) const {
        const int row0 = u.pm * BM + wr * 64 + fr, col0 = (u.pn % nN) * HALF + wc * 32 + 8 * fq;
#pragma unroll
        for (int ai = 0; ai < 2; ++ai)
#pragma unroll
            for (int m = 0; m < 4; ++m) { bf16_t* rowp = O + (size_t)(row0 + ai * HALF + m * 16) * ldc + col0;
                float h[8];
#pragma unroll
                for (int n = 0; n < 2; ++n)
#pragma unroll
                    for (int j = 0; j < 4; ++j) { const float g = acc[ai][0][m][n][j], up = acc[ai][1][m][n][j]; h[n * 4 + j] = g * __builtin_amdgcn_rcpf(1.f + __expf(-g)) * up; }
                u32x4 w; w.x = cvt_pk_bf16(h[0], h[1]); w.y = cvt_pk_bf16(h[2], h[3]); w.z = cvt_pk_bf16(h[4], h[5]); w.w = cvt_pk_bf16(h[6], h[7]);
                *(u32x4*)rowp = w; }
    }
};
struct EpiKV { static constexpr bool PERM = true, AFTER_DRAIN = false;
    bf16_t* KM; bf16_t* VM;
    __device__ __forceinline__ void operator()(const f32x4 (&acc)[2][2][4][2], const Unit& u, int wr, int wc, int fr, int fq) const {
        const int row0 = u.pm * BM + wr * 64 + fr, within = wc * 32 + 8 * fq;
#pragma unroll
        for (int ai = 0; ai < 2; ++ai)
#pragma unroll
            for (int m = 0; m < 4; ++m) { const int row = row0 + ai * HALF + m * 16;
#pragma unroll
                for (int bj = 0; bj < 2; ++bj) { const int h = 2 * u.pn + bj; const f32x4 v0 = acc[ai][bj][m][0], v1 = acc[ai][bj][m][1];
                    u32x4 w; w.x = cvt_pk_bf16(v0[0], v0[1]); w.y = cvt_pk_bf16(v0[2], v0[3]); w.z = cvt_pk_bf16(v1[0], v1[1]); w.w = cvt_pk_bf16(v1[2], v1[3]);
                    bf16_t* p = (within < 64) ? KM + (size_t)row * 768 + h * 96 + within : VM + (size_t)row * 512 + h * 64 + (within - 64);
                    *(u32x4*)p = w; } }
    }
};
struct CtxSplitOrder { int nsl, ksl, G, c;
    __device__ void init(int nsl_, int ksl_, int G_, int c_) { nsl = nsl_; ksl = ksl_; G = G_; c = c_; }
    __device__ bool next(int i, Unit& u) const { const int L = i * G + c; if (L >= 16 * nsl) return false; const int sl = L >> 4, rem = L & 15; u.pm = (rem >> 2) * 17; u.pn = rem & 3; u.kof = sl * ksl; return true; }
    __device__ __forceinline__ void a_ready(const Unit&) const {}
    __device__ __forceinline__ void done(const Unit&) const {}
};
struct EpiPartF32 { static constexpr bool PERM = false, AFTER_DRAIN = false;
    float* P; int ksl;
    __device__ __forceinline__ void operator()(const f32x4 (&acc)[2][2][4][2], const Unit& u, int wr, int wc, int fr, int fq) const {
        float* base = P + ((size_t)(u.kof / ksl) * 1024 + (size_t)(u.pm / 17) * 256) * 1024; const int row0 = wr * 64 + fr, col0 = u.pn * BM + wc * 32 + 4 * fq;
#pragma unroll
        for (int ai = 0; ai < 2; ++ai)
#pragma unroll
            for (int m = 0; m < 4; ++m) { float* rowp = base + (size_t)(row0 + ai * HALF + m * 16) * 1024 + col0;
#pragma unroll
                for (int bj = 0; bj < 2; ++bj)
#pragma unroll
                    for (int n = 0; n < 2; ++n) *(f32x4*)(rowp + bj * HALF + n * 16) = acc[ai][bj][m][n]; }
    }
};
struct LatOrder { StaticOrder so;
    __device__ void init(int N, int G, int c) { so.nM = 64; so.nN = N / BM; so.nwg = 64 * so.nN; so.G = G; so.c = c; }
    __device__ bool next(int i, Unit& u) const { if (!so.next(i, u)) return false; u.pm = (u.pm >> 4) * 17 + 1 + (u.pm & 15); return true; }
    __device__ __forceinline__ void a_ready(const Unit&) const {}
    __device__ __forceinline__ void done(const Unit&) const {}
};
struct MoeOrder { StaticOrder so; const int* texp; int t0, nNe;
    __device__ void init(int ntiles, int nNe_, int G, int c, const int* texp_, int t0_) { so.nM = ntiles; so.nN = nNe_; so.nwg = ntiles * nNe_; so.G = G; so.c = c; texp = texp_; t0 = t0_; nNe = nNe_; }
    __device__ bool next(int i, Unit& u) const { if (!so.next(i, u)) return false; const int e = __builtin_amdgcn_readfirstlane(texp[t0 + u.pm]); u.pn = e * nNe + u.pn; return true; }
    __device__ __forceinline__ void a_ready(const Unit&) const {}
    __device__ __forceinline__ void done(const Unit&) const {}
};
struct MoeSplitOrder { int ex4, nsl, ksl, G, c, t0; const int* texp;
    __device__ void init(int ex, int nsl_, int ksl_, int G_, int c_, const int* texp_, int t0_) { ex4 = ex * 4; nsl = nsl_; ksl = ksl_; G = G_; c = c_; texp = texp_; t0 = t0_; }
    __device__ bool next(int i, Unit& u) const { const int L = i * G + c; if (L >= ex4 * nsl) return false; const int sl = L / ex4, rem = L - sl * ex4; u.pm = 64 + (rem >> 2);
        const int e = __builtin_amdgcn_readfirstlane(texp[t0 + u.pm]); u.pn = e * 4 + (rem & 3); u.kof = sl * ksl; return true; }
    __device__ __forceinline__ void a_ready(const Unit&) const {}
    __device__ __forceinline__ void done(const Unit&) const {}
};
struct EpiMoePart { static constexpr bool PERM = false, AFTER_DRAIN = false;
    float* P; int ksl;
    __device__ __forceinline__ void operator()(const f32x4 (&acc)[2][2][4][2], const Unit& u, int wr, int wc, int fr, int fq) const {
        float* base = P + ((size_t)(u.kof / ksl) * 4 + (size_t)(u.pm - 64)) * 256 * 1024; const int row0 = wr * 64 + fr, col0 = (u.pn & 3) * BM + wc * 32 + 4 * fq;
#pragma unroll
        for (int ai = 0; ai < 2; ++ai)
#pragma unroll
            for (int m = 0; m < 4; ++m) { float* rowp = base + (size_t)(row0 + ai * HALF + m * 16) * 1024 + col0;
#pragma unroll
                for (int bj = 0; bj < 2; ++bj)
#pragma unroll
                    for (int n = 0; n < 2; ++n) *(f32x4*)(rowp + bj * HALF + n * 16) = acc[ai][bj][m][n]; }
    }
};
}
#define PG8_SP2 true
#define PG8_ALIGN true
#define GAS __attribute__((address_space(1)))
#define LAS __attribute__((address_space(3)))
typedef unsigned short bf16;
typedef unsigned v4u __attribute__((ext_vector_type(4)));
typedef unsigned v2u __attribute__((ext_vector_type(2)));
typedef float f32x4 __attribute__((ext_vector_type(4)));
typedef short bf16x8 __attribute__((ext_vector_type(8)));
typedef GAS unsigned gu32;
#define RLX_AGENT __ATOMIC_RELAXED, __HIP_MEMORY_SCOPE_AGENT
#define LDS_WAIT() asm volatile("s_waitcnt lgkmcnt(0)" ::: "memory")
#define VM_WAIT() asm volatile("s_waitcnt vmcnt(0)" ::: "memory")
__device__ __forceinline__ unsigned f2bf(float f) { unsigned u = __builtin_bit_cast(unsigned, f); return (u + 0x7fffu + ((u >> 16) & 1u)) >> 16; }
__device__ __forceinline__ unsigned pk2(float lo, float hi) { return f2bf(lo) | (f2bf(hi) << 16); }
__device__ __forceinline__ float bf2f(unsigned short b) { return __builtin_bit_cast(float, ((unsigned)b) << 16); }
__device__ __forceinline__ float bflo(unsigned w) { return __builtin_bit_cast(float, w << 16); }
__device__ __forceinline__ float bfhi(unsigned w) { return __builtin_bit_cast(float, w & 0xffff0000u); }
__device__ __forceinline__ float wave_sum(float v) {
#pragma unroll
    for (int o = 1; o < 64; o <<= 1) v += __shfl_xor(v, o);
    return v;
}
__device__ __forceinline__ float siluf(float x) { return x / (1.f + __expf(-x)); }
#define XB_TMO      128
#define XB_XCNT(j)  (256  + 64 * (j))
#define XB_XSUB(j)  (1280 + 64 * (j))
#define XB_XGEN(j)  (2304 + 64 * (j))
#define XB_TOP      3328
#define XB_TOPGEN   3392
#define XCD_BAR_WORDS 3456
#define XB_SPIN_CAP (1u << 18)

__device__ __forceinline__ unsigned xb_ld(unsigned* p)              { return __hip_atomic_load(p, __ATOMIC_RELAXED, __HIP_MEMORY_SCOPE_AGENT); }
__device__ __forceinline__ unsigned xb_add(unsigned* p, unsigned v) { return __hip_atomic_fetch_add(p, v, __ATOMIC_RELAXED, __HIP_MEMORY_SCOPE_AGENT); }
__device__ __forceinline__ unsigned xb_xcc_id() { return (unsigned)__builtin_amdgcn_s_getreg((3 << 11) | 20) & 0xFu; }
#define XB_SPIN(cond, bar) do { unsigned _sp = 0; while (cond) { __builtin_amdgcn_s_sleep(1); \
    if ((++_sp & 255u) == 0u) { if (xb_ld(&(bar)[XB_TMO])) break; if (_sp > XB_SPIN_CAP) { atomicAdd(&(bar)[XB_TMO], 1u); break; } } } } while (0)

struct XcdBarrier {
    unsigned* bar; unsigned x;
    volatile LAS unsigned* st;
};

__device__ __forceinline__ XcdBarrier xcd_barrier_post(unsigned* bar, volatile LAS unsigned* st) {
    XcdBarrier b; b.bar = bar; b.x = xb_xcc_id(); b.st = st;
    if (threadIdx.x == 0) (void)xb_add(&bar[XB_XCNT(b.x)], 1u);
    return b;
}
__device__ __forceinline__ void xcd_barrier_complete(unsigned* bar, unsigned x, unsigned& nloc, unsigned& nx) {
    const unsigned G = gridDim.x * gridDim.y * gridDim.z;
    unsigned sum, cnt, mine, sp = 0u;
    for (;;) {
        sum = 0u; cnt = 0u; mine = 0u;
#pragma unroll
        for (unsigned j = 0; j < 16; ++j) { const unsigned c = xb_ld(&bar[XB_XCNT(j)]); sum += c; cnt += (c > 0u) ? 1u : 0u; mine = (j == x) ? c : mine; }
        if (sum == G) break;
        __builtin_amdgcn_s_sleep(1);
        if ((++sp & 255u) == 0u) { if (xb_ld(&bar[XB_TMO])) break; if (sp > XB_SPIN_CAP) { atomicAdd(&bar[XB_TMO], 1u); break; } }
    }
    nloc = mine > 0u ? mine : 1u; nx = cnt > 0u ? cnt : 1u;
}

__device__ __forceinline__ void xcd_barrier(const XcdBarrier& b) {
    asm volatile("s_waitcnt vmcnt(0)" ::: "memory");
    __syncthreads();
    if (threadIdx.x == 0) {
        unsigned* bar = b.bar;
        __builtin_amdgcn_s_waitcnt(0);
        unsigned nloc = b.st[0], nx = b.st[1];
        if (nloc == 0u) { xcd_barrier_complete(bar, b.x, nloc, nx); b.st[0] = nloc; b.st[1] = nx; }
        const unsigned old = xb_add(&bar[XB_XSUB(b.x)], 1u);
        const unsigned gen = old / nloc;
        if (old + 1u == (gen + 1u) * nloc) {
            __builtin_amdgcn_fence(__ATOMIC_RELEASE, "agent");
            asm volatile("s_waitcnt vmcnt(0)" ::: "memory");
            const unsigned og = xb_add(&bar[XB_TOP], 1u);
            const unsigned tg = og / nx;
            if (og + 1u == (tg + 1u) * nx) xb_add(&bar[XB_TOPGEN], 1u);
            else XB_SPIN(xb_ld(&bar[XB_TOPGEN]) == tg, bar);
            __builtin_amdgcn_fence(__ATOMIC_ACQUIRE, "agent");
            xb_add(&bar[XB_XGEN(b.x)], 1u);
            asm volatile("s_waitcnt vmcnt(0)" ::: "memory");
        } else {
            XB_SPIN(xb_ld(&bar[XB_XGEN(b.x)]) == gen, bar);
            __builtin_amdgcn_fence(__ATOMIC_ACQUIRE, "agent");
            asm volatile("s_waitcnt vmcnt(0)" ::: "memory");
        }
    }
    __syncthreads();
}
namespace att {
using bf16x8 = __attribute__((ext_vector_type(8))) short;
using s16x4  = __attribute__((ext_vector_type(4))) short;
using f32x16 = __attribute__((ext_vector_type(16))) float;
using u32x4  = __attribute__((ext_vector_type(4))) unsigned;
constexpr int NW = 8, QBLK = 32, KVBLK = 64;
constexpr size_t SHM_V = KVBLK * 128 * 2, SHM_K = KVBLK * 128 * 2, SHM_ATTN = 2 * SHM_V + 2 * SHM_K + NW * 64 * 4;
constexpr float THR = 8.f;
#define KSWZ(row, colB) ((row) * 256 + ((colB) ^ (((row) & 7) << 4)))
#define SBAR() __builtin_amdgcn_sched_barrier(0)
__device__ __forceinline__ int crow(int r, int hi) { return (r & 3) + 8 * (r >> 2) + 4 * hi; }
__device__ __forceinline__ unsigned cvtpk(float lo, float hi) { unsigned r; asm volatile("v_cvt_pk_bf16_f32 %0, %1, %2" : "=v"(r) : "v"(lo), "v"(hi)); return r; }
__device__ __forceinline__ void partialSM(f32x16& p0, f32x16& p1, float& m_reg, float& mn, float& alpha, float C, float thr_s) {
  float pmax = p0[0];
#pragma unroll
  for (int r = 1; r < 16; ++r) pmax = fmaxf(pmax, p0[r]);
#pragma unroll
  for (int r = 0; r < 16; ++r) pmax = fmaxf(pmax, p1[r]);
  { auto rr = __builtin_amdgcn_permlane32_swap(__float_as_uint(pmax), __float_as_uint(pmax), false, false);
    pmax = fmaxf(__uint_as_float(rr[0]), __uint_as_float(rr[1])); }
  if (__builtin_expect(__all(pmax - m_reg <= thr_s), 1)) { mn = m_reg; alpha = 1.f; }
  else { mn = fmaxf(m_reg, pmax); alpha = __builtin_amdgcn_exp2f((m_reg - mn) * C); m_reg = mn; }
  const float mnC = -mn * C;
#pragma unroll
  for (int r = 0; r < 16; ++r) p0[r] = fmaf(p0[r], C, mnC);
#pragma unroll
  for (int r = 0; r < 16; ++r) p1[r] = fmaf(p1[r], C, mnC);
#pragma unroll
  for (int r = 0; r < 16; ++r) p0[r] = __builtin_amdgcn_exp2f(p0[r]);
}
__device__ __forceinline__ void finishSM(f32x16& p0, f32x16& p1, float alpha, float& l_reg, bf16x8& pa0, bf16x8& pa1, bf16x8& pa2, bf16x8& pa3) {
#pragma unroll
  for (int r = 0; r < 16; ++r) p1[r] = __builtin_amdgcn_exp2f(p1[r]);
  float ps = 0;
#pragma unroll
  for (int r = 0; r < 16; ++r) ps += p0[r];
#pragma unroll
  for (int r = 0; r < 16; ++r) ps += p1[r];
  { auto rr = __builtin_amdgcn_permlane32_swap(__float_as_uint(ps), __float_as_uint(ps), false, false);
    ps = __uint_as_float(rr[0]) + __uint_as_float(rr[1]); }
  l_reg = l_reg * alpha + ps;
#define PK4(P, BASE, OUT) do { unsigned a0 = cvtpk(P[BASE + 0], P[BASE + 1]), a1 = cvtpk(P[BASE + 2], P[BASE + 3]);   \
    unsigned b0 = cvtpk(P[BASE + 4], P[BASE + 5]), b1 = cvtpk(P[BASE + 6], P[BASE + 7]);                              \
    auto r0 = __builtin_amdgcn_permlane32_swap(a0, b0, false, false); auto r1 = __builtin_amdgcn_permlane32_swap(a1, b1, false, false); \
    u32x4 w = {r0[0], r1[0], r0[1], r1[1]}; OUT = *reinterpret_cast<bf16x8*>(&w); } while (0)
  PK4(p0, 0, pa0); PK4(p0, 8, pa1); PK4(p1, 0, pa2); PK4(p1, 8, pa3);
#undef PK4
}
template <int DQK> __device__ __forceinline__ void qkt(f32x16& p0, f32x16& p1, const char* Ks, const bf16x8* qr, int r32, int hi) {
  p0 = f32x16{}; p1 = f32x16{};
#pragma unroll
  for (int d0 = 0; d0 < DQK / 16; ++d0) { const int cb = (d0 * 16 + hi * 8) * 2;
    const bf16x8 b0 = *reinterpret_cast<const bf16x8*>(Ks + KSWZ(r32, cb));
    const bf16x8 b1 = *reinterpret_cast<const bf16x8*>(Ks + KSWZ(32 + r32, cb));
    p0 = __builtin_amdgcn_mfma_f32_32x32x16_bf16(b0, qr[d0], p0, 0, 0, 0);
    p1 = __builtin_amdgcn_mfma_f32_32x32x16_bf16(b1, qr[d0], p1, 0, 0, 0); }
}
__device__ __forceinline__ int v_st(int k, int c) { const int kk = (k & ~0xC) | ((k & 4) << 1) | ((k & 8) >> 1); return ((kk >> 3) * 4 + (c >> 5)) * 512 + ((kk & 7) * 32 + (c & 31)) * 2; }
__device__ __forceinline__ int v_rd_base(int lane) { return ((lane & 3) << 3) | (((lane >> 2) & 3) << 6) | (((lane >> 4) & 1) << 5) | (((lane >> 5) & 1) << 8); }
constexpr int v_rd_off(int d0, int ks, int half) { return d0 * 512 + ks * 4096 + half * 2048; }
template <int OFF> __device__ __forceinline__ s16x4 tr_read(int vb) {
  s16x4 r; asm volatile("ds_read_b64_tr_b16 %0, %1 offset:%2" : "=&v"(r) : "v"(vb), "i"(OFF) : "memory"); return r;
}
template <int D0> __device__ __forceinline__ void pv_one(f32x16& od, int vb, bf16x8 pa0, bf16x8 pa1, bf16x8 pa2, bf16x8 pa3) {
  const s16x4 l0 = tr_read<v_rd_off(D0, 0, 0)>(vb), h0 = tr_read<v_rd_off(D0, 0, 1)>(vb), l1 = tr_read<v_rd_off(D0, 1, 0)>(vb), h1 = tr_read<v_rd_off(D0, 1, 1)>(vb);
  const s16x4 l2 = tr_read<v_rd_off(D0, 2, 0)>(vb), h2 = tr_read<v_rd_off(D0, 2, 1)>(vb), l3 = tr_read<v_rd_off(D0, 3, 0)>(vb), h3 = tr_read<v_rd_off(D0, 3, 1)>(vb);
  asm volatile("s_waitcnt lgkmcnt(0)" ::: "memory"); SBAR();
#define PK(L, H) (bf16x8){L[0], L[1], L[2], L[3], H[0], H[1], H[2], H[3]}
  od = __builtin_amdgcn_mfma_f32_32x32x16_bf16(pa0, PK(l0, h0), od, 0, 0, 0);
  od = __builtin_amdgcn_mfma_f32_32x32x16_bf16(pa1, PK(l1, h1), od, 0, 0, 0);
  od = __builtin_amdgcn_mfma_f32_32x32x16_bf16(pa2, PK(l2, h2), od, 0, 0, 0);
  od = __builtin_amdgcn_mfma_f32_32x32x16_bf16(pa3, PK(l3, h3), od, 0, 0, 0);
#undef PK
}
template <int DV> __device__ __forceinline__ void pv_all(f32x16* o, int vb, bf16x8 pa0, bf16x8 pa1, bf16x8 pa2, bf16x8 pa3) {
  pv_one<0>(o[0], vb, pa0, pa1, pa2, pa3); pv_one<1>(o[1], vb, pa0, pa1, pa2, pa3);
  if constexpr (DV > 64) { pv_one<2>(o[2], vb, pa0, pa1, pa2, pa3); pv_one<3>(o[3], vb, pa0, pa1, pa2, pa3); }
}
template <int DQK, int DV, int MODE, bool QROPE = false, int OUTMODE = 0>
__device__ __forceinline__ void attn_unit(const unsigned short* __restrict__ Qb, int ldq, const unsigned short* __restrict__ Kb, int ldk, const unsigned short* __restrict__ Vb, int ldv,
                                          unsigned short* __restrict__ Ob, int ldo, int NT, int lat0, int q0lat, float C, float thr_s, float sinkl2, char* lds, float lam = 0.f, const float* nw = nullptr, float nscale = 1.f) {
  int tid_ = threadIdx.x; asm volatile("" : "+v"(tid_));
  const int tid = tid_, wid = tid >> 6, lane = tid & 63, r32 = lane & 31, hi = lane >> 5;
  char* V_lds = lds; char* K_lds = lds + 2 * SHM_V;
  float* ws = (float*)(lds + 2 * SHM_V + 2 * SHM_K) + wid * 64; float* li_l = ws; float* al_l = ws + 32;
  float m_reg = -1e30f, l_reg = 0; f32x16 o[DV / 32]; bf16x8 qr[DQK / 16];
#pragma unroll
  for (int d = 0; d < DV / 32; ++d) o[d] = f32x16{};
  const unsigned short* Qw = Qb + (long)(wid * QBLK + r32) * ldq + hi * 8;
#pragma unroll
  for (int d0 = 0; d0 < DQK / 16; ++d0) qr[d0] = *reinterpret_cast<const bf16x8*>(Qw + d0 * 16);
  if constexpr (QROPE) {
    static_assert(DQK == 96, "QROPE is the MLA case");
    int t = q0lat + wid * QBLK + r32; asm volatile("" : "+v"(t));
#pragma unroll
    for (int part = 0; part < 2; ++part) { const float pos = (float)(part ? (t & 63) : (t >> 6)); u32x4 w = __builtin_bit_cast(u32x4, qr[4 + part]); u32x4 o;
#pragma unroll
      for (int q = 0; q < 4; ++q) { const unsigned pw = (unsigned)__shfl_xor((int)w[q], 32); float x0 = bflo(w[q]), x1 = bfhi(w[q]); const float p0 = bflo(pw), p1 = bfhi(pw);
        float s0, c0, s1, c1; sincosf(pos * __powf(10000.f, -(float)(2 * q) * 0.125f), &s0, &c0); sincosf(pos * __powf(10000.f, -(float)(2 * q + 1) * 0.125f), &s1, &c1);
        x0 = hi ? (x0 * c0 + p0 * s0) : (x0 * c0 - p0 * s0); x1 = hi ? (x1 * c1 + p1 * s1) : (x1 * c1 - p1 * s1); o[q] = cvtpk(x0, x1); }
      qr[4 + part] = __builtin_bit_cast(bf16x8, o); } }
  const int sr = tid >> 4, sc = (tid & 15) * 8, vst0 = v_st(sr, sc), vst1 = v_st(32 + sr, sc);
  const bool kact = sc < DQK, vact = sc < DV;
  const int vb0 = (int)(uintptr_t)V_lds + v_rd_base(lane);
  struct { bf16x8 vs0, vs1, ks0, ks1; } sr_[2];
#define TROW(j) ((MODE == 1 && (j) >= 4) ? (256 + lat0 + ((j) - 4) * 64) : (j) * 64)
#define SLOAD(i, j) do { const long k0_ = TROW(j); \
    if (vact) { sr_[i].vs0 = *reinterpret_cast<const bf16x8*>(&Vb[(k0_ + sr) * ldv + sc]); sr_[i].vs1 = *reinterpret_cast<const bf16x8*>(&Vb[(k0_ + 32 + sr) * ldv + sc]); } \
    if (kact) { sr_[i].ks0 = *reinterpret_cast<const bf16x8*>(&Kb[(k0_ + sr) * ldk + sc]); sr_[i].ks1 = *reinterpret_cast<const bf16x8*>(&Kb[(k0_ + 32 + sr) * ldk + sc]); } } while (0)
#define SWRITE(b, i) do { if (vact) { *(bf16x8*)(V_lds + (b) * SHM_V + vst0) = sr_[i].vs0; *(bf16x8*)(V_lds + (b) * SHM_V + vst1) = sr_[i].vs1; } \
    if (kact) { const int kc = sc * 2; *(bf16x8*)(K_lds + (b) * SHM_K + KSWZ(sr, kc)) = sr_[i].ks0; *(bf16x8*)(K_lds + (b) * SHM_K + KSWZ(32 + sr, kc)) = sr_[i].ks1; } } while (0)
#define RESC(a) do { if (__any((a) < 1.f)) { if (hi == 0) al_l[r32] = (a); asm volatile("s_waitcnt lgkmcnt(0)" ::: "memory"); \
    _Pragma("unroll") for (int d = 0; d < DV / 32; ++d) _Pragma("unroll") for (int r = 0; r < 16; ++r) o[d][r] *= al_l[crow(r, hi)]; } } while (0)
#define MASK(P0, P1, j) do { if (MODE == 1 && (j) >= 4) { const int kb_ = lat0 + ((j) - 4) * 64 + 4 * hi - (q0lat + wid * QBLK + r32); \
    _Pragma("unroll") for (int r = 0; r < 16; ++r) { const int dk_ = kb_ + (r & 3) + 8 * (r >> 2); if (dk_ > 128 || dk_ < -128) P0[r] = -1e30f; if (dk_ + 32 > 128 || dk_ + 32 < -128) P1[r] = -1e30f; } } } while (0)
  f32x16 pA0, pA1, pB0, pB1; float mnA, mnB, alA, alB; bf16x8 pa0, pa1, pa2, pa3;
  SLOAD(0, 0); asm volatile("s_waitcnt vmcnt(0)" ::: "memory"); SWRITE(0, 0); __syncthreads();
  qkt<DQK>(pA0, pA1, K_lds, qr, r32, hi); MASK(pA0, pA1, 0); partialSM(pA0, pA1, m_reg, mnA, alA, C, thr_s);
  SLOAD(1, 1); if (2 < NT) SLOAD(0, 2);
  asm volatile("s_waitcnt vmcnt(4)" ::: "memory"); SWRITE(1, 1); __syncthreads();
  for (int j = 1; j + 1 < NT; j += 2) {
    SBAR(); qkt<DQK>(pB0, pB1, K_lds + SHM_K, qr, r32, hi); MASK(pB0, pB1, j);
    finishSM(pA0, pA1, alA, l_reg, pa0, pa1, pa2, pa3); SBAR();
    SLOAD(1, j + 2); SBAR();
    pv_all<DV>(o, vb0, pa0, pa1, pa2, pa3); partialSM(pB0, pB1, m_reg, mnB, alB, C, thr_s);
    __syncthreads(); asm volatile("s_waitcnt vmcnt(4)" ::: "memory"); SWRITE(0, 0);
    RESC(alB); __syncthreads();
    SBAR(); qkt<DQK>(pA0, pA1, K_lds, qr, r32, hi); MASK(pA0, pA1, j + 1);
    finishSM(pB0, pB1, alB, l_reg, pa0, pa1, pa2, pa3); SBAR();
    if (j + 3 < NT) SLOAD(0, j + 3); SBAR();
    pv_all<DV>(o, vb0 + (int)SHM_V, pa0, pa1, pa2, pa3); partialSM(pA0, pA1, m_reg, mnA, alA, C, thr_s);
    __syncthreads(); asm volatile("s_waitcnt vmcnt(4)" ::: "memory"); SWRITE(1, 1);
    RESC(alA); __syncthreads();
  }
  SBAR(); qkt<DQK>(pB0, pB1, K_lds + SHM_K, qr, r32, hi); MASK(pB0, pB1, NT - 1);
  finishSM(pA0, pA1, alA, l_reg, pa0, pa1, pa2, pa3); SBAR();
  pv_all<DV>(o, vb0, pa0, pa1, pa2, pa3); partialSM(pB0, pB1, m_reg, mnB, alB, C, thr_s);
  __syncthreads(); RESC(alB);
  finishSM(pB0, pB1, alB, l_reg, pa0, pa1, pa2, pa3); SBAR();
  pv_all<DV>(o, vb0 + (int)SHM_V, pa0, pa1, pa2, pa3);
  if (sinkl2 > -1e29f) l_reg += __builtin_amdgcn_exp2f(sinkl2 - m_reg * C);
  if (hi == 0) li_l[r32] = l_reg; asm volatile("s_waitcnt lgkmcnt(0)" ::: "memory");
  float rli[16];
#pragma unroll
  for (int r = 0; r < 16; ++r) rli[r] = __builtin_amdgcn_rcpf(li_l[crow(r, hi)]);
  if constexpr (OUTMODE == 0) {
  unsigned short* Ow = Ob + (long)(wid * QBLK) * ldo;
#pragma unroll
  for (int r = 0; r < 16; ++r) { const int orow = crow(r, hi);
#pragma unroll
    for (int d0 = 0; d0 < DV / 32; ++d0) Ow[(long)orow * ldo + d0 * 32 + r32] = (unsigned short)f2bf(o[d0][r] * rli[r]); }
  } else {   int zo_ = 0; asm volatile("" : "+v"(zo_)); const int lane = (int)__builtin_amdgcn_mbcnt_hi(~0u, __builtin_amdgcn_mbcnt_lo(~0u, (unsigned)zo_)), r32 = lane & 31, hi = lane >> 5;
    unsigned short* stg = (unsigned short*)(lds + SHM_ATTN) + wid * 4096;
    if constexpr (OUTMODE == 1) {
#pragma unroll
      for (int d0 = 0; d0 < DV / 32; ++d0)
#pragma unroll
        for (int r = 0; r < 16; ++r) stg[(d0 * 16 + r) * 64 + lane] = (unsigned short)f2bf(o[d0][r] * rli[r]);
    } else {
      unsigned short* Ow = Ob + (long)(wid * QBLK) * ldo;
#pragma unroll
      for (int r = 0; r < 16; ++r) { float v[DV / 32]; float ss = 0.f;
#pragma unroll
        for (int d0 = 0; d0 < DV / 32; ++d0) { v[d0] = bf2f(stg[(d0 * 16 + r) * 64 + lane]) - lam * (o[d0][r] * rli[r]); ss += v[d0] * v[d0]; }
        ss += __shfl_xor(ss, 1); ss += __shfl_xor(ss, 2); ss += __shfl_xor(ss, 4); ss += __shfl_xor(ss, 8); ss += __shfl_xor(ss, 16);
        const float rs = nscale / sqrtf(ss * (1.f / (float)DV) + 1e-6f); const int orow = crow(r, hi);
#pragma unroll
        for (int d0 = 0; d0 < DV / 32; ++d0) Ow[(long)orow * ldo + d0 * 32 + r32] = (unsigned short)f2bf(v[d0] * rs * nw[d0 * 32 + r32]);
        __builtin_amdgcn_sched_barrier(0); }
    }
  }
  __syncthreads();
#undef TROW
#undef SLOAD
#undef SWRITE
#undef RESC
#undef MASK
}
#undef KSWZ
#undef SBAR
}
struct Args { const float* in[32]; float* out; unsigned char* ws; int ph_lo, ph_hi; };
struct Frame {
    LAS unsigned char* lds; char* ldsg;
    volatile LAS unsigned* MISC;
    gu32* ctl;
    int tid, lane, wave, vcu, G, gw, NGW;
    const float* const* in; float* out; unsigned char* ws;
};
enum { I_X = 0, I_C, I_CTX, I_CCTX, I_EMODW, I_EMODB, I_ENORMS, I_EWIN, I_ECONV, I_EALOG, I_EDTB, I_EGDNN, I_ESINK, I_EWOUT, I_EFG, I_EFU, I_EFD,
       I_OMODW, I_OMODB, I_ONORMS, I_OWIN, I_OQN, I_OKVN, I_OWUQ, I_OWUKV, I_OLAM, I_OSUBLN, I_OWOUT, I_OROUTER, I_OXG, I_OXU, I_OXD };

__device__ __forceinline__ void tr_load(float (&v)[32], const float* W, int N, int k0, int n0, const float* kscale, int lane) {
#pragma unroll
    for (int i = 0; i < 32; ++i) { const int kk = 2 * i + (lane >> 5); v[i] = W[(size_t)(k0 + kk) * N + n0 + (lane & 31)]; if (kscale) v[i] *= kscale[k0 + kk]; }
}
__device__ __forceinline__ void tr_store(const float (&v)[32], bf16* WT, int ldk, int k0, int drow0, LAS float* scr, int lane) {
#pragma unroll
    for (int i = 0; i < 32; ++i) scr[(2 * i + (lane >> 5)) * 33 + (lane & 31)] = v[i];
    LDS_WAIT(); asm volatile("" ::: "memory");
    const int c = lane & 7;
#pragma unroll
    for (int j = 0; j < 4; ++j) { const int n = (lane >> 3) + 8 * j; const LAS float* s = scr + (8 * c) * 33 + n;
        v4u o; o.x = pk2(s[0 * 33], s[1 * 33]); o.y = pk2(s[2 * 33], s[3 * 33]); o.z = pk2(s[4 * 33], s[5 * 33]); o.w = pk2(s[6 * 33], s[7 * 33]);
        *(GAS v4u*)(WT + (size_t)(drow0 + n) * ldk + k0 + 8 * c) = o; }
    LDS_WAIT(); asm volatile("" ::: "memory");
}
template <int MAP> __device__ __forceinline__ void transpose_job(Frame& F, const float* W, int K, int N, bf16* WT, const float* kscale, int first, int stride, LAS unsigned char* scrb) {
    LAS float* scr = (LAS float*)scrb;
    const int nblk = N / 32, items = (K / 64) * nblk;
    float vn[32];
    if (first < items) tr_load(vn, W, N, 64 * (first / nblk), 32 * (first % nblk), kscale, F.lane);
    for (int it = first; it < items; it += stride) { const int kb = it / nblk, nb = it % nblk, n0 = 32 * nb;
        const int drow0 = (MAP == 0) ? n0 : ((n0 >> 7) * 256 + (n0 & 127) + (MAP == 2 ? 128 : 0));
        float vc[32];
#pragma unroll
        for (int i = 0; i < 32; ++i) vc[i] = vn[i];
        const int nx = it + stride; if (nx < items) tr_load(vn, W, N, 64 * (nx / nblk), 32 * (nx % nblk), kscale, F.lane);
        tr_store(vc, WT, K, 64 * kb, drow0, scr, F.lane); }
}
__device__ __forceinline__ void zero_rows(Frame& F, bf16* WT, int row0, int nrows, int K) {
    const size_t n16 = (size_t)nrows * K / 8; GAS v4u* p = (GAS v4u*)(WT + (size_t)row0 * K);
    for (size_t i = (size_t)F.gw * 64 + F.lane; i < n16; i += (size_t)F.NGW * 64) p[i] = (v4u){0u, 0u, 0u, 0u};
}
__device__ __forceinline__ void modv_items(Frame& F) {
    LAS float* sc = (LAS float*)(F.lds + RING_OFF);
    LAS float* part = (LAS float*)(F.lds + RING_OFF + 20480);
    float* MODV = (float*)(F.ws + WS_MODV);
    const int nitems = 2 * 96;
    if ((int)blockIdx.x >= nitems) return;
    for (int i = F.tid; i < 5 * 1024; i += 512) { const int r = i >> 10, k = i & 1023; const float v = (r < 4) ? F.in[I_C][r * 1024 + k] : F.in[I_CCTX][k]; sc[i] = siluf(v); }
    __syncthreads();
    for (int it = blockIdx.x; it < nitems; it += F.G) {
        const int l = it / 96, n0 = (it % 96) * 64, col = F.tid & 63, ks = F.tid >> 6;
        const float* W = F.in[l ? I_OMODW : I_EMODW] + (size_t)(ks * 128) * 6144 + n0 + col;
        float a0 = 0, a1 = 0, a2 = 0, a3 = 0, a4 = 0;
#pragma unroll 8
        for (int k = 0; k < 128; ++k) { const float w = W[(size_t)k * 6144]; const int kk = ks * 128 + k;
            a0 += sc[kk] * w; a1 += sc[1024 + kk] * w; a2 += sc[2048 + kk] * w; a3 += sc[3072 + kk] * w; a4 += sc[4096 + kk] * w; }
        part[(ks * 5 + 0) * 64 + col] = a0; part[(ks * 5 + 1) * 64 + col] = a1; part[(ks * 5 + 2) * 64 + col] = a2; part[(ks * 5 + 3) * 64 + col] = a3; part[(ks * 5 + 4) * 64 + col] = a4;
        __syncthreads();
        if (F.tid < 320) { const int r = F.tid >> 6, c2 = F.tid & 63; float s = F.in[l ? I_OMODB : I_EMODB][n0 + c2];
#pragma unroll
            for (int q = 0; q < 8; ++q) s += part[(q * 5 + r) * 64 + c2];
            MODV[(size_t)(l * 5 + r) * 6144 + n0 + c2] = s; }
        __syncthreads();
    }
}
__device__ __forceinline__ const float* modvec(Frame& F, int l, int mr, int k) { return (const float*)(F.ws + WS_MODV) + (size_t)((l * 5 + mr) * 6 + k) * 1024; }

struct Row4 { f32x4 v[4]; };
__device__ __forceinline__ Row4 ld_row_f32(const float* p, int lane) { Row4 r; const GAS f32x4* q = (const GAS f32x4*)p + lane;
#pragma unroll
    for (int j = 0; j < 4; ++j) r.v[j] = q[64 * j]; return r; }
__device__ __forceinline__ Row4 ld_row_bf16(const bf16* p, int lane) { Row4 r; const GAS v2u* q = (const GAS v2u*)p + lane;
#pragma unroll
    for (int j = 0; j < 4; ++j) { const v2u w = q[64 * j]; r.v[j] = (f32x4){bflo(w.x), bfhi(w.x), bflo(w.y), bfhi(w.y)}; } return r; }
__device__ __forceinline__ void st_row_f32(float* p, int lane, const Row4& r) { GAS f32x4* q = (GAS f32x4*)p + lane;
#pragma unroll
    for (int j = 0; j < 4; ++j) q[64 * j] = r.v[j]; }
__device__ __forceinline__ void st_row_bf16(bf16* p, int lane, const Row4& r) { GAS v2u* q = (GAS v2u*)p + lane;
#pragma unroll
    for (int j = 0; j < 4; ++j) q[64 * j] = (v2u){pk2(r.v[j].x, r.v[j].y), pk2(r.v[j].z, r.v[j].w)}; }
__device__ __forceinline__ float row_rstd(const Row4& r) { float s = 0.f;
#pragma unroll
    for (int j = 0; j < 4; ++j) s += (r.v[j].x * r.v[j].x + r.v[j].y * r.v[j].y) + (r.v[j].z * r.v[j].z + r.v[j].w * r.v[j].w);
    return 1.f / sqrtf(wave_sum(s) * (1.f / 1024.f) + EPS); }
__device__ __forceinline__ float* xres_ptr(Frame& F, int r, int& mr) { const int b = r / SROW, s = r - b * SROW;
    if (s < TC) { mr = 4; return (float*)(F.ws + WS_HCTX) + (size_t)(b * TC + s) * D; }
    mr = b; return F.out + (size_t)(b * T + s - TC) * D; }
__device__ __forceinline__ Row4 norm_mod(const Row4& x, const float* w, const float* shift, const float* scale, int lane) {
    const float rs = row_rstd(x); const Row4 W = ld_row_f32(w, lane), SH = ld_row_f32(shift, lane), SC = ld_row_f32(scale, lane); Row4 a;
#pragma unroll
    for (int j = 0; j < 4; ++j) a.v[j] = (x.v[j] * rs * W.v[j]) * (SC.v[j] + 1.f) + SH.v[j];
    return a; }
__device__ __forceinline__ Row4 norm_mod_r(const Row4& x, const Row4& W, const Row4& SH, const Row4& SC) {
    const float rs = row_rstd(x); Row4 a;
#pragma unroll
    for (int j = 0; j < 4; ++j) a.v[j] = (x.v[j] * rs * W.v[j]) * (SC.v[j] + 1.f) + SH.v[j];
    return a; }
__device__ __forceinline__ void add_gated_norm_r(Row4& x, const Row4& y, const Row4& W, const Row4& G) {
    const float rs = row_rstd(y);
#pragma unroll
    for (int j = 0; j < 4; ++j) x.v[j] = x.v[j] + G.v[j] * (y.v[j] * rs * W.v[j]); }
__device__ __forceinline__ int tok_vcu(const Frame& F, int b, int t) { const int wpb = F.NGW >> 2; return (b * wpb + t % wpb) >> 3; }
__device__ __forceinline__ void add_gated_norm(Row4& x, const Row4& y, const float* w, const float* gate, int lane) {
    const float rs = row_rstd(y); const Row4 W = ld_row_f32(w, lane), G = ld_row_f32(gate, lane);
#pragma unroll
    for (int j = 0; j < 4; ++j) x.v[j] = x.v[j] + G.v[j] * (y.v[j] * rs * W.v[j]); }
__device__ __forceinline__ void p0_prologue(Frame& F) {
    modv_items(F);
    __syncthreads();
    transpose_job<0>(F, F.in[I_EWIN], 1024, EIN, (bf16*)(F.ws + WS_WEIN), nullptr, F.gw, F.NGW, F.lds + RING_OFF + F.wave * 16384);
    zero_rows(F, (bf16*)(F.ws + WS_WEIN), EIN, EINP - EIN, 1024);
}
__device__ __forceinline__ void p0_deferred(Frame& F, int w4, LAS unsigned char* scr) {
    const float* const* in = F.in; unsigned char* ws = F.ws; const int gw = F.vcu * 4 + w4, N = F.G * 4;
    transpose_job<0>(F, in[I_EWOUT], 1024, 1024, (bf16*)(ws + WS_WEOUT), nullptr, gw, N, scr);
    transpose_job<1>(F, in[I_EFG], 1024, DFF, (bf16*)(ws + WS_WEGU), nullptr, (gw + 512) % N, N, scr);
    transpose_job<2>(F, in[I_EFU], 1024, DFF, (bf16*)(ws + WS_WEGU), nullptr, (gw + 896) % N, N, scr);
    transpose_job<0>(F, in[I_EFD], DFF, 1024, (bf16*)(ws + WS_WEDN), nullptr, (gw + 256) % N, N, scr);
    transpose_job<0>(F, in[I_OWIN], 1024, OIN, (bf16*)(ws + WS_WOIN), nullptr, (gw + 640) % N, N, scr);
    transpose_job<0>(F, in[I_OWUQ], 384, 768, (bf16*)(ws + WS_WUQ), in[I_OQN], (gw + 720) % N, N, scr);
    transpose_job<0>(F, in[I_OWUKV], 256, 1024, (bf16*)(ws + WS_WUKV), in[I_OKVN], (gw + 864) % N, N, scr);
    transpose_job<0>(F, in[I_OWOUT], 1024, 1024, (bf16*)(ws + WS_WOOUT), nullptr, (gw + 992) % N, N, scr);
    { const size_t n16 = (size_t)(OINP - OIN) * 1024 / 8; GAS v4u* p = (GAS v4u*)((bf16*)(ws + WS_WOIN) + (size_t)OIN * 1024);
      for (size_t i = (size_t)gw * 64 + F.lane; i < n16; i += (size_t)N * 64) p[i] = (v4u){0u, 0u, 0u, 0u}; }
}
__device__ __forceinline__ void px_expert_weights(Frame& F) {
    for (int e = 0; e < NEXP; ++e) {
        transpose_job<1>(F, F.in[I_OXG] + (size_t)e * 1024 * DFX, 1024, DFX, (bf16*)(F.ws + WS_WXGU) + (size_t)e * 7168 * 1024, nullptr, (F.gw + e * 448) % F.NGW, F.NGW, F.lds + RING_OFF + F.wave * 8448);
        transpose_job<2>(F, F.in[I_OXU] + (size_t)e * 1024 * DFX, 1024, DFX, (bf16*)(F.ws + WS_WXGU) + (size_t)e * 7168 * 1024, nullptr, (F.gw + e * 448 + 224) % F.NGW, F.NGW, F.lds + RING_OFF + F.wave * 8448);
    }
}
__device__ __forceinline__ void px_expert_down(Frame& F, int wk, int nwk, int e0, int e1) {
    for (int e = e0; e < e1; ++e)
        transpose_job<0>(F, F.in[I_OXD] + (size_t)e * DFX * 1024, DFX, 1024, (bf16*)(F.ws + WS_WXDN) + (size_t)e * 1024 * DFX, nullptr, (wk + e * 448 + 112) % nwk, nwk, F.lds + RING_OFF + F.wave * 8448);
}
__device__ __forceinline__ void p1_first_rows(Frame& F) {
    bf16* A = (bf16*)(F.ws + WS_ABUF); const float* w0 = F.in[I_ENORMS]; const int wpb = F.NGW >> 2, b = F.gw / wpb, wl = F.gw - b * wpb;
    { const Row4 W = ld_row_f32(w0, F.lane), SH = ld_row_f32(modvec(F, 0, b, 0), F.lane), SC = ld_row_f32(modvec(F, 0, b, 1), F.lane);
      for (int t = wl; t < T; t += wpb) { const size_t tk = (size_t)b * T + t; const Row4 x = ld_row_f32(F.in[I_X] + tk * D, F.lane); st_row_bf16((bf16*)(F.ws + WS_XB) + tk * D, F.lane, x);
          const Row4 a = norm_mod_r(x, W, SH, SC); st_row_bf16(A + ((size_t)b * SROW + TC + t) * D, F.lane, a); } }
    for (int c = F.gw; c < NB * TC; c += F.NGW) { const int cb = c / TC, s = c - cb * TC;
        const Row4 x = ld_row_f32(F.in[I_CTX] + (size_t)c * D, F.lane); st_row_f32((float*)(F.ws + WS_HCTX) + (size_t)c * D, F.lane, x);
        const Row4 a = norm_mod(x, w0, modvec(F, 0, 4, 0), modvec(F, 0, 4, 1), F.lane); st_row_bf16(A + ((size_t)cb * SROW + s) * D, F.lane, a); }
}
constexpr int ROUTER_TAB_OFF = 69632;
__device__ __forceinline__ void router_table(Frame& F) {
    LAS f32x4* tab = (LAS f32x4*)(F.lds + RING_OFF + ROUTER_TAB_OFF); const float* Rw = F.in[I_OROUTER];
    for (int i = F.tid; i < 2048; i += 512) { const int ln = i & 63, h = (i >> 6) & 1, q = (i >> 7) & 3, j = i >> 9; tab[i] = *(const GAS f32x4*)(Rw + (size_t)(4 * ln + 256 * j + q) * 8 + 4 * h); }
    __syncthreads();
}
template <bool ROUTER> __device__ __forceinline__ void rows_mid(Frame& F, const bf16* Y, const float* wy, int lg, int kg, const float* w2, int l2, int ks2, bf16* Aout, bool lat_only, int nsl = 0) {
    const int wpb = F.NGW >> 2, b = F.gw / wpb, wl = F.gw - b * wpb;
    { const Row4 Wy = ld_row_f32(wy, F.lane), Gt = ld_row_f32(modvec(F, lg, b, kg), F.lane), W2 = ld_row_f32(w2, F.lane), SH = ld_row_f32(modvec(F, l2, b, ks2), F.lane), SC = ld_row_f32(modvec(F, l2, b, ks2 + 1), F.lane);
      for (int t = wl; t < T; t += wpb) { const size_t tk = (size_t)b * T + t, r = (size_t)b * SROW + TC + t; bf16* xr = (bf16*)(F.ws + WS_XB) + tk * D;
        Row4 x = ld_row_bf16(xr, F.lane); const Row4 y = ld_row_bf16(Y + r * D, F.lane);
        add_gated_norm_r(x, y, Wy, Gt); st_row_bf16(xr, F.lane, x);
        const Row4 a = norm_mod_r(x, W2, SH, SC);
        st_row_bf16(Aout + r * D, F.lane, a);
        if constexpr (ROUTER) {
            LAS const f32x4* Rt = (LAS const f32x4*)(F.lds + RING_OFF + ROUTER_TAB_OFF) + F.lane; float lg8[8];
#pragma unroll
            for (int e = 0; e < 8; ++e) lg8[e] = 0.f;
#pragma unroll
            for (int j = 0; j < 4; ++j)
#pragma unroll
                for (int q = 0; q < 4; ++q) { const f32x4 r0 = Rt[((j * 4 + q) * 2 + 0) * 64], r1 = Rt[((j * 4 + q) * 2 + 1) * 64]; const float av = a.v[j][q];
                    lg8[0] += av * r0.x; lg8[1] += av * r0.y; lg8[2] += av * r0.z; lg8[3] += av * r0.w; lg8[4] += av * r1.x; lg8[5] += av * r1.y; lg8[6] += av * r1.z; lg8[7] += av * r1.w; }
#pragma unroll
            for (int e = 0; e < 8; ++e) lg8[e] = wave_sum(lg8[e]);
            int i0 = 0; float v0 = lg8[0];
#pragma unroll
            for (int e = 1; e < 8; ++e) if (lg8[e] > v0) { v0 = lg8[e]; i0 = e; }
            int i1 = -1; float v1 = -3.0e38f;
#pragma unroll
            for (int e = 0; e < 8; ++e) if (e != i0 && lg8[e] > v1) { v1 = lg8[e]; i1 = e; }
            const float e1 = __expf(v1 - v0), w0 = 1.f / (1.f + e1), w1 = e1 * w0;
            if (F.lane == 0) {
                int* TOPI = (int*)(F.ws + WS_META + META_TOPI); float* TOPW = (float*)(F.ws + WS_META + META_TOPW); int* RANK = (int*)(F.ws + WS_META + META_RANK);
                TOPI[tk * 2] = i0; TOPI[tk * 2 + 1] = i1; TOPW[tk * 2] = w0; TOPW[tk * 2 + 1] = w1;
                RANK[tk * 2] = (int)__hip_atomic_fetch_add((LAS unsigned*)(F.MISC + 24 + i0), 1u, __ATOMIC_RELAXED, __HIP_MEMORY_SCOPE_WORKGROUP);
                RANK[tk * 2 + 1] = (int)__hip_atomic_fetch_add((LAS unsigned*)(F.MISC + 24 + i1), 1u, __ATOMIC_RELAXED, __HIP_MEMORY_SCOPE_WORKGROUP); }
        } } }
    if (!lat_only) for (int c = F.gw; c < NB * TC; c += F.NGW) { const int cb = c / TC, s = c - cb * TC; const size_t r = (size_t)cb * SROW + s; float* xr = (float*)(F.ws + WS_HCTX) + (size_t)c * D;
        Row4 x = ld_row_f32(xr, F.lane); Row4 y;
        if (nsl > 0) {
            const float* pp = (const float*)(F.ws + WS_PART) + (size_t)c * 1024; y = ld_row_f32(pp, F.lane);
            for (int q = 1; q < nsl; ++q) { const Row4 t = ld_row_f32(pp + (size_t)q * 1024 * 1024, F.lane);
#pragma unroll
                for (int j = 0; j < 4; ++j) y.v[j] = y.v[j] + t.v[j]; } }
        else y = ld_row_bf16(Y + r * D, F.lane);
        add_gated_norm(x, y, wy, modvec(F, lg, 4, kg), F.lane); st_row_f32(xr, F.lane, x);
        const Row4 a = norm_mod(x, w2, modvec(F, l2, 4, ks2), modvec(F, l2, 4, ks2 + 1), F.lane);
        st_row_bf16(Aout + r * D, F.lane, a); }
}
__device__ __forceinline__ void router_tail(Frame& F) {
    {
        __syncthreads();
        if (F.tid < 8) { ((int*)(F.ws + WS_META + META_BLKB))[F.vcu * 8 + F.tid] = (int)__hip_atomic_fetch_add((unsigned*)(F.ctl + CW_MOECNT + 64 * F.tid), F.MISC[24 + F.tid], RLX_AGENT); F.MISC[24 + F.tid] = 0u; }
    }
}
__device__ __forceinline__ void g0_prep(Frame& F) {
    const bf16* P = (const bf16*)(F.ws + WS_PROJ); bf16* PW = (bf16*)(F.ws + WS_PROJ); bf16* QK = (bf16*)(F.ws + WS_QKVN); float* GB = (float*)(F.ws + WS_GB);
    const float* cw = F.in[I_ECONV]; const int lane = F.lane;
#pragma unroll 1
    for (int part = 0; part < 3; ++part) { const int ch = part * 512 + 8 * lane; float w[5][8];
#pragma unroll
        for (int j = 0; j < 5; ++j) { const f32x4 w0 = *(const GAS f32x4*)(cw + j * 1536 + ch), w1 = *(const GAS f32x4*)(cw + j * 1536 + ch + 4); w[j][0] = w0.x; w[j][1] = w0.y; w[j][2] = w0.z; w[j][3] = w0.w; w[j][4] = w1.x; w[j][5] = w1.y; w[j][6] = w1.z; w[j][7] = w1.w; }
        v4u tn[5];
#define G0_TAPS(dst, r_) do { const int b_ = (r_) / SROW, s_ = (r_) - b_ * SROW; const bool c_ = s_ < TC; const int p_ = c_ ? s_ : s_ - TC, len_ = c_ ? TC : T; \
            _Pragma("unroll") for (int j = 0; j < 5; ++j) { const int pp = p_ + j - 2; dst[j] = (pp >= 0 && pp < len_) ? *(const GAS v4u*)(P + (size_t)((r_) + j - 2) * EINP + ch) : (v4u){0u, 0u, 0u, 0u}; } } while (0)
        if (F.gw < NR) G0_TAPS(tn, F.gw);
        for (int r = F.gw; r < NR; r += F.NGW) { v4u tc[5];
#pragma unroll
            for (int j = 0; j < 5; ++j) tc[j] = tn[j];
            if (r + F.NGW < NR) G0_TAPS(tn, r + F.NGW);
            float acc[8];
#pragma unroll
            for (int e = 0; e < 8; ++e) acc[e] = 0.f;
#pragma unroll
            for (int j = 0; j < 5; ++j) { const v4u xv = tc[j];
                acc[0] += bflo(xv.x) * w[j][0]; acc[1] += bfhi(xv.x) * w[j][1]; acc[2] += bflo(xv.y) * w[j][2]; acc[3] += bfhi(xv.y) * w[j][3];
                acc[4] += bflo(xv.z) * w[j][4]; acc[5] += bfhi(xv.z) * w[j][5]; acc[6] += bflo(xv.w) * w[j][6]; acc[7] += bfhi(xv.w) * w[j][7]; }
            float ss = 0.f;
#pragma unroll
            for (int e = 0; e < 8; ++e) { acc[e] = siluf(acc[e]); ss += acc[e] * acc[e]; }
            if (part < 2) { ss += __shfl_xor(ss, 1); ss += __shfl_xor(ss, 2); ss += __shfl_xor(ss, 4); const float sc = (part == 0 ? 0.125f : 1.f) / sqrtf(ss + EPS);
#pragma unroll
                for (int e = 0; e < 8; ++e) acc[e] *= sc; }
            *(GAS v4u*)(QK + (size_t)r * 1536 + ch) = (v4u){pk2(acc[0], acc[1]), pk2(acc[2], acc[3]), pk2(acc[4], acc[5]), pk2(acc[6], acc[7])}; }
#undef G0_TAPS
    }
    for (int r = F.gw; r < NR; r += F.NGW) { const int b = r / SROW, s = r - b * SROW; const bool isc = s < TC; const int p = isc ? s : s - TC;
        if (lane < 16) { const float ga = bf2f(P[(size_t)r * EINP + E_GA + lane]), gb = bf2f(P[(size_t)r * EINP + E_GB + lane]);
            const float xx = ga + F.in[I_EDTB][lane], sp = fmaxf(xx, 0.f) + log1pf(__expf(-fabsf(xx)));
            GB[(size_t)r * 32 + lane] = -__expf(F.in[I_EALOG][lane]) * sp; GB[(size_t)r * 32 + 16 + lane] = 1.f / (1.f + __expf(-gb)); }
        if (!isc) {
            const int pi = lane & 31, seg = pi >> 4, i = pi & 15, d0 = seg * 32 + i; const float pos = (float)(seg ? (p & 63) : (p >> 6));
            const float ang = pos * __powf(10000.f, -(float)i * (1.f / 16.f)); float sn, cs; sincosf(ang, &sn, &cs);
#pragma unroll
            for (int q = 0; q < 5; ++q) { const int hh = (lane >> 5) + 2 * q; bf16* base = PW + (size_t)r * EINP + (hh < 8 ? E_SQ + hh * 64 : E_SK + (hh - 8) * 64) + d0;
                const float x0 = bf2f(base[0]), x1 = bf2f(base[16]); base[0] = (bf16)f2bf(x0 * cs - x1 * sn); base[16] = (bf16)f2bf(x1 * cs + x0 * sn); }
        }
    }
}
constexpr int GP = 65, GLP = 68;
template <int I> struct SolveRow {
    static __device__ __forceinline__ void run(float (&x)[64], const LAS float* Ls) {
        SolveRow<I - 1>::run(x, Ls);
        float a = x[I];
#pragma unroll
        for (int j = 0; j < I; ++j) a -= Ls[I * GLP + j] * x[j];
        x[I] = a;
    }
};
template <> struct SolveRow<0> { static __device__ __forceinline__ void run(float (&)[64], const LAS float*) {} };

__device__ __forceinline__ void gdn_chain(Frame& F, int chain) {
    const int b = chain >> 4, h = (chain >> 1) & 7, dir = chain & 1;
    LAS float* Ss = (LAS float*)(F.lds + RING_OFF);
    LAS float* Qs = Ss + 64 * GP, *Ks = Qs + 64 * GP, *Vs = Ks + 64 * GP  , *ATs = Vs + 64 * GP, *Ws = ATs + 64 * GP, *VNs = Ws + 64 * GP;
    LAS float* Ls = VNs + 64 * GP;
    LAS float* gcs = Ls + 64 * GLP, *bts = gcs + 64;
    const bf16* QK = (const bf16*)(F.ws + WS_QKVN); const float* GB = (const float*)(F.ws + WS_GB); bf16* OG = (bf16*)(F.ws + WS_OG);
    const int tid = F.tid, lane = F.lane, w = F.wave;
    for (int i = tid; i < 64 * GP; i += 512) Ss[i] = 0.f;
    for (int ci = 0; ci < 68; ++ci) {
        const bool isc = ci < 4; const int n0 = (isc ? ci : ci - 4) * 64; const int rbase = b * SROW + (isc ? 0 : TC), len = isc ? TC : T;
        __syncthreads();
        for (int e = tid; e < 64 * 24; e += 512) { const int i = e / 24, c8 = e % 24, part = c8 >> 3, cc = (c8 & 7) * 8; const int n = n0 + i, row = rbase + (dir ? len - 1 - n : n);
            const v4u xv = *(const GAS v4u*)(QK + (size_t)row * 1536 + part * 512 + h * 64 + cc); LAS float* dst = (part == 0 ? Qs : part == 1 ? Ks : Vs) + i * GP + cc;
            dst[0] = bflo(xv.x); dst[1] = bfhi(xv.x); dst[2] = bflo(xv.y); dst[3] = bfhi(xv.y); dst[4] = bflo(xv.z); dst[5] = bfhi(xv.z); dst[6] = bflo(xv.w); dst[7] = bfhi(xv.w); }
        if (tid < 64) { const int n = n0 + tid, row = rbase + (dir ? len - 1 - n : n); float g = GB[(size_t)row * 32 + dir * 8 + h]; bts[tid] = GB[(size_t)row * 32 + 16 + dir * 8 + h];
#pragma unroll
            for (int o = 1; o < 64; o <<= 1) { const float t = __shfl_up(g, o); if (lane >= o) g += t; }
            gcs[tid] = g; }
        __syncthreads();
#pragma unroll 1
        for (int k = 0; k < 8; ++k) { const int i = w + 8 * k, j = lane; float kk = 0.f, qk = 0.f;
#pragma unroll 16
            for (int d = 0; d < 64; ++d) { const float kj = Ks[j * GP + d]; kk += Ks[i * GP + d] * kj; qk += Qs[i * GP + d] * kj; }
            const float dec = (j <= i) ? __expf(gcs[i] - gcs[j]) : 0.f;
            Ls[i * GLP + j] = (j < i) ? bts[i] * kk * dec : 0.f; ATs[i * GP + j] = qk * dec; }
        __syncthreads();
        if (tid < 128) { float x[64]; const int c = tid & 63; const bool isw = tid >= 64; int zz = 0; asm volatile("" : "+v"(zz));
            const LAS float* src = (isw ? Ks : Vs) + c; const LAS float* btz = bts + zz; const LAS float* gcz = gcs + zz;
#pragma unroll
            for (int i = 0; i < 64; ++i) { const float e = isw ? __expf(gcz[i]) : 1.f; x[i] = src[i * GP] * btz[i] * e; }
            SolveRow<63>::run(x, Ls + zz);
            LAS float* dst = isw ? Ws : Vs;
#pragma unroll
            for (int i = 0; i < 64; ++i) dst[i * GP + c] = x[i]; }
        __syncthreads();
#pragma unroll 1
        for (int k = 0; k < 8; ++k) { const int i = w + 8 * k, d = lane; float a = Vs[i * GP + d];
#pragma unroll 16
            for (int q = 0; q < 64; ++q) a -= Ws[i * GP + q] * Ss[q * GP + d];
            VNs[i * GP + d] = a; }
        __syncthreads();
#pragma unroll 1
        for (int k = 0; k < 8; ++k) { const int i = w + 8 * k, d = lane; float a = 0.f, c2 = 0.f;
#pragma unroll 16
            for (int q = 0; q < 64; ++q) { a += Qs[i * GP + q] * Ss[q * GP + d]; c2 += ATs[i * GP + q] * VNs[q * GP + d]; }
            const int n = n0 + i, row = rbase + (dir ? len - 1 - n : n);
            OG[(size_t)row * 1024 + dir * 512 + h * 64 + d] = (bf16)f2bf(a * __expf(gcs[i]) + c2); }
        __syncthreads();
        const float gl = gcs[63];
#pragma unroll 1
        for (int k = 0; k < 8; ++k) { const int a = w + 8 * k, d = lane; float acc = Ss[a * GP + d] * __expf(gl);
#pragma unroll 16
            for (int i = 0; i < 64; ++i) acc += Ks[i * GP + a] * __expf(gl - gcs[i]) * VNs[i * GP + d];
            Ss[a * GP + d] = acc; }
    }
    __syncthreads();
}
__device__ __forceinline__ void g4_gdn_out(Frame& F) {
    const bf16* OG = (const bf16*)(F.ws + WS_OG); const bf16* P = (const bf16*)(F.ws + WS_PROJ); bf16* MIX = (bf16*)(F.ws + WS_MIX); const float* gn = F.in[I_EGDNN]; const int lane = F.lane;
    const f32x4 g0 = *(const GAS f32x4*)(gn + (lane & 7) * 8), g1 = *(const GAS f32x4*)(gn + (lane & 7) * 8 + 4);
    for (int r = F.gw; r < NR; r += F.NGW) {
        const v4u a = *(const GAS v4u*)(OG + (size_t)r * 1024 + 8 * lane), c = *(const GAS v4u*)(OG + (size_t)r * 1024 + 512 + 8 * lane), z = *(const GAS v4u*)(P + (size_t)r * EINP + E_Z + 8 * lane);
        float o[8] = {bflo(a.x) + bflo(c.x), bfhi(a.x) + bfhi(c.x), bflo(a.y) + bflo(c.y), bfhi(a.y) + bfhi(c.y), bflo(a.z) + bflo(c.z), bfhi(a.z) + bfhi(c.z), bflo(a.w) + bflo(c.w), bfhi(a.w) + bfhi(c.w)};
        float ss = 0.f;
#pragma unroll
        for (int e = 0; e < 8; ++e) ss += o[e] * o[e];
        ss += __shfl_xor(ss, 1); ss += __shfl_xor(ss, 2); ss += __shfl_xor(ss, 4);
        const float rs = 1.f / sqrtf(ss * (1.f / 64.f) + EPS);
        const float zz[8] = {bflo(z.x), bfhi(z.x), bflo(z.y), bfhi(z.y), bflo(z.z), bfhi(z.z), bflo(z.w), bfhi(z.w)};
        const float gg[8] = {g0.x, g0.y, g0.z, g0.w, g1.x, g1.y, g1.z, g1.w};
#pragma unroll
        for (int e = 0; e < 8; ++e) o[e] = o[e] * rs * gg[e] * siluf(zz[e]);
        *(GAS v4u*)(MIX + (size_t)r * 1024 + 8 * lane) = (v4u){pk2(o[0], o[1]), pk2(o[2], o[3]), pk2(o[4], o[5]), pk2(o[6], o[7])}; }
}
__device__ __forceinline__ void swa_unit(Frame& F, int u) {
    const bf16* P = (const bf16*)(F.ws + WS_PROJ); bf16* MIX = (bf16*)(F.ws + WS_MIX);
    constexpr float SC = 0.125f, C = SC * 1.4426950408889634f, THRS = att::THR / SC;
    if (u < 512) { const int b = u >> 7, qb = (u >> 3) & 15, hq = u & 7, kvh = hq >> 2; const size_t rq = (size_t)b * SROW + TC + qb * 256, r0 = (size_t)b * SROW;
        const int lat0 = qb * 256 - 128 < 0 ? 0 : qb * 256 - 128, lend = qb * 256 + 384 > T ? T : qb * 256 + 384, NT = 4 + (lend - lat0) / 64;
        att::attn_unit<64, 64, 1>(P + rq * EINP + E_SQ + hq * 64, EINP, P + r0 * EINP + E_SK + kvh * 64, EINP, P + r0 * EINP + E_SV + kvh * 64, EINP,
                                  MIX + rq * 1024 + 512 + hq * 64, 1024, NT, lat0, qb * 256, C, THRS, F.in[I_ESINK][hq] * 1.4426950408889634f, F.ldsg + RING_OFF);
    } else { const int v = u - 512, b = v >> 3, hq = v & 7, kvh = hq >> 2; const size_t r0 = (size_t)b * SROW;
        att::attn_unit<64, 64, 2>(P + r0 * EINP + E_SQ + hq * 64, EINP, P + r0 * EINP + E_SK + kvh * 64, EINP, P + r0 * EINP + E_SV + kvh * 64, EINP,
                                  MIX + r0 * 1024 + 512 + hq * 64, 1024, 4, 0, 0, C, THRS, F.in[I_ESINK][hq] * 1.4426950408889634f, F.ldsg + RING_OFF); }
}
namespace gdn {
using bf16x8 = __attribute__((ext_vector_type(8))) short;
using f32x16 = __attribute__((ext_vector_type(16))) float;
using u32x4  = __attribute__((ext_vector_type(4))) unsigned;
__device__ __forceinline__ int crow(int r, int hi) { return (r & 3) + 8 * (r >> 2) + 4 * hi; }
typedef float f32x2_t __attribute__((ext_vector_type(2))); typedef __bf16 bf16x2_t __attribute__((ext_vector_type(2)));
__device__ __forceinline__ unsigned cvtpk(float lo, float hi) { f32x2_t v = {lo, hi}; bf16x2_t b = __builtin_convertvector(v, bf16x2_t); return __builtin_bit_cast(unsigned, b); }
__device__ __forceinline__ int swap23(int p) { return (p & ~0xC) | ((p & 4) << 1) | ((p & 8) >> 1); }
typedef float f32x4g __attribute__((ext_vector_type(4)));
template <int I> struct LRow {
    static constexpr int NQ = (I + 3) / 4, O = I * 128;
    static __device__ __forceinline__ void load(f32x4g (&b)[8], unsigned la) {
        if constexpr (NQ == 1) asm volatile("ds_read_b128 %0, %1 offset:%2\n\ts_waitcnt lgkmcnt(0)" : "=&v"(b[0]) : "v"(la), "i"(O));
        else if constexpr (NQ == 2) asm volatile("ds_read_b128 %0, %2 offset:%3\n\tds_read_b128 %1, %2 offset:%4\n\ts_waitcnt lgkmcnt(0)" : "=&v"(b[0]), "=&v"(b[1]) : "v"(la), "i"(O), "i"(O + 16));
        else if constexpr (NQ == 3) asm volatile("ds_read_b128 %0, %3 offset:%4\n\tds_read_b128 %1, %3 offset:%5\n\tds_read_b128 %2, %3 offset:%6\n\ts_waitcnt lgkmcnt(0)" : "=&v"(b[0]), "=&v"(b[1]), "=&v"(b[2]) : "v"(la), "i"(O), "i"(O + 16), "i"(O + 32));
        else if constexpr (NQ == 4) asm volatile("ds_read_b128 %0, %4 offset:%5\n\tds_read_b128 %1, %4 offset:%6\n\tds_read_b128 %2, %4 offset:%7\n\tds_read_b128 %3, %4 offset:%8\n\ts_waitcnt lgkmcnt(0)" : "=&v"(b[0]), "=&v"(b[1]), "=&v"(b[2]), "=&v"(b[3]) : "v"(la), "i"(O), "i"(O + 16), "i"(O + 32), "i"(O + 48));
        else if constexpr (NQ == 5) asm volatile("ds_read_b128 %0, %5 offset:%6\n\tds_read_b128 %1, %5 offset:%7\n\tds_read_b128 %2, %5 offset:%8\n\tds_read_b128 %3, %5 offset:%9\n\tds_read_b128 %4, %5 offset:%10\n\ts_waitcnt lgkmcnt(0)" : "=&v"(b[0]), "=&v"(b[1]), "=&v"(b[2]), "=&v"(b[3]), "=&v"(b[4]) : "v"(la), "i"(O), "i"(O + 16), "i"(O + 32), "i"(O + 48), "i"(O + 64));
        else if constexpr (NQ == 6) asm volatile("ds_read_b128 %0, %6 offset:%7\n\tds_read_b128 %1, %6 offset:%8\n\tds_read_b128 %2, %6 offset:%9\n\tds_read_b128 %3, %6 offset:%10\n\tds_read_b128 %4, %6 offset:%11\n\tds_read_b128 %5, %6 offset:%12\n\ts_waitcnt lgkmcnt(0)" : "=&v"(b[0]), "=&v"(b[1]), "=&v"(b[2]), "=&v"(b[3]), "=&v"(b[4]), "=&v"(b[5]) : "v"(la), "i"(O), "i"(O + 16), "i"(O + 32), "i"(O + 48), "i"(O + 64), "i"(O + 80));
        else if constexpr (NQ == 7) asm volatile("ds_read_b128 %0, %7 offset:%8\n\tds_read_b128 %1, %7 offset:%9\n\tds_read_b128 %2, %7 offset:%10\n\tds_read_b128 %3, %7 offset:%11\n\tds_read_b128 %4, %7 offset:%12\n\tds_read_b128 %5, %7 offset:%13\n\tds_read_b128 %6, %7 offset:%14\n\ts_waitcnt lgkmcnt(0)" : "=&v"(b[0]), "=&v"(b[1]), "=&v"(b[2]), "=&v"(b[3]), "=&v"(b[4]), "=&v"(b[5]), "=&v"(b[6]) : "v"(la), "i"(O), "i"(O + 16), "i"(O + 32), "i"(O + 48), "i"(O + 64), "i"(O + 80), "i"(O + 96));
        else asm volatile("ds_read_b128 %0, %8 offset:%9\n\tds_read_b128 %1, %8 offset:%10\n\tds_read_b128 %2, %8 offset:%11\n\tds_read_b128 %3, %8 offset:%12\n\tds_read_b128 %4, %8 offset:%13\n\tds_read_b128 %5, %8 offset:%14\n\tds_read_b128 %6, %8 offset:%15\n\tds_read_b128 %7, %8 offset:%16\n\ts_waitcnt lgkmcnt(0)" : "=&v"(b[0]), "=&v"(b[1]), "=&v"(b[2]), "=&v"(b[3]), "=&v"(b[4]), "=&v"(b[5]), "=&v"(b[6]), "=&v"(b[7]) : "v"(la), "i"(O), "i"(O + 16), "i"(O + 32), "i"(O + 48), "i"(O + 64), "i"(O + 80), "i"(O + 96), "i"(O + 112));
    }
};
template <int I> struct Solve32 {
    static __device__ __forceinline__ void run(float (&x)[32], unsigned la) {
#ifdef SOLVE_C_LOAD
        f32x4g b[8]; { const LAS f32x4g* Lp = (const LAS f32x4g*)(uintptr_t)(la + I * 128);
#pragma unroll
          for (int q = 0; q < (I + 3) / 4; ++q) b[q] = Lp[q]; }
#else
        f32x4g b[8]; LRow<I>::load(b, la);
#endif
        float a = x[I];
#pragma unroll
#ifdef SOLVE_C_FMA
        for (int j = 0; j < I; ++j) a = __builtin_fmaf(-b[j >> 2][j & 3], x[j], a);
#else
        for (int j = 0; j < I; ++j) asm volatile("v_fma_f32 %0, -%1, %2, %0" : "+v"(a) : "v"(b[j >> 2][j & 3]), "v"(x[j]));
#endif
        x[I] = a;
        if constexpr (I < 31) Solve32<I + 1>::run(x, la);
    }
};
__device__ __forceinline__ void solve32(float (&x)[32], unsigned la) { Solve32<1>::run(x, la); }
__device__ __forceinline__ void col_frags32(const float (&x)[32], bf16x8 (&F)[4][2], int s0) {
#pragma unroll
    for (int s = 0; s < 2; ++s) {
        const unsigned p0[4] = {cvtpk(x[16 * s + 0], x[16 * s + 1]), cvtpk(x[16 * s + 2], x[16 * s + 3]), cvtpk(x[16 * s + 8], x[16 * s + 9]), cvtpk(x[16 * s + 10], x[16 * s + 11])};
        const unsigned p1[4] = {cvtpk(x[16 * s + 4], x[16 * s + 5]), cvtpk(x[16 * s + 6], x[16 * s + 7]), cvtpk(x[16 * s + 12], x[16 * s + 13]), cvtpk(x[16 * s + 14], x[16 * s + 15])};
        u32x4 f0, f1;
#pragma unroll
        for (int q = 0; q < 4; ++q) { auto r = __builtin_amdgcn_permlane32_swap(p0[q], p1[q], false, false); f0[q] = r[0]; f1[q] = r[1]; }
        F[s0 + s][0] = __builtin_bit_cast(bf16x8, f0); F[s0 + s][1] = __builtin_bit_cast(bf16x8, f1); }
}
__device__ __forceinline__ void solve_blocked(float (&x1)[32], float (&x2)[32], unsigned la, const bf16x8 (&L21A)[2], bf16x8 (&F)[4][2]) {
    solve32(x1, la);
    col_frags32(x1, F, 0);
    f32x16 t0 = f32x16{}, t1 = f32x16{};
    t0 = __builtin_amdgcn_mfma_f32_32x32x16_bf16(L21A[0], F[0][0], t0, 0, 0, 0); t0 = __builtin_amdgcn_mfma_f32_32x32x16_bf16(L21A[1], F[1][0], t0, 0, 0, 0);
    t1 = __builtin_amdgcn_mfma_f32_32x32x16_bf16(L21A[0], F[0][1], t1, 0, 0, 0); t1 = __builtin_amdgcn_mfma_f32_32x32x16_bf16(L21A[1], F[1][1], t1, 0, 0, 0);
#pragma unroll
    for (int r = 0; r < 16; ++r) { const float e0 = t0[r], e1 = t1[r]; auto sw = __builtin_amdgcn_permlane32_swap(__float_as_uint(e0), __float_as_uint(e1), false, false);
        x2[(r & 3) + 8 * (r >> 2)] -= __uint_as_float(sw[0]); x2[(r & 3) + 8 * (r >> 2) + 4] -= __uint_as_float(sw[1]); }
    __builtin_amdgcn_sched_barrier(0);
    solve32(x2, la + 4096u);
    col_frags32(x2, F, 2);
}
__device__ __forceinline__ bf16x8 acc_frag(const f32x16& t, int sp) {
    u32x4 w;
    if (sp == 0) { w[0] = cvtpk(t[0], t[1]); w[1] = cvtpk(t[2], t[3]); w[2] = cvtpk(t[4], t[5]); w[3] = cvtpk(t[6], t[7]); }
    else { w[0] = cvtpk(t[8], t[9]); w[1] = cvtpk(t[10], t[11]); w[2] = cvtpk(t[12], t[13]); w[3] = cvtpk(t[14], t[15]); }
    return __builtin_bit_cast(bf16x8, w);
}
__device__ __forceinline__ void store_accfrag(__amdgpu_buffer_rsrc_t ro, int soff, int lane, const f32x16& t) {
    __builtin_amdgcn_raw_buffer_store_b128((u32x4){cvtpk(t[0], t[1]), cvtpk(t[2], t[3]), cvtpk(t[4], t[5]), cvtpk(t[6], t[7])}, ro, lane * 32, soff, 0);
    __builtin_amdgcn_raw_buffer_store_b128((u32x4){cvtpk(t[8], t[9]), cvtpk(t[10], t[11]), cvtpk(t[12], t[13]), cvtpk(t[14], t[15])}, ro, lane * 32 + 16, soff, 0);
}
struct ItemGeom { int b, h, dir, rbase, len, n0; };
__device__ __forceinline__ ItemGeom item_geom(int chain, int ci) { ItemGeom g; g.b = chain >> 4; g.h = (chain >> 1) & 7; g.dir = chain & 1; const bool isc = ci < 4;
    g.n0 = (isc ? ci : ci - 4) * 64; g.rbase = g.b * SROW + (isc ? 0 : TC); g.len = isc ? TC : T; return g; }
__device__ __forceinline__ int item_row(const ItemGeom& g, int i) { const int n = g.n0 + i; return g.rbase + (g.dir ? g.len - 1 - n : n); }

#define G1_LANES() int zs_ = 0; asm volatile("" : "+v"(zs_)); const int lane = (int)__builtin_amdgcn_mbcnt_hi(~0u, __builtin_amdgcn_mbcnt_lo(~0u, (unsigned)zs_)), r32 = lane & 31, hi = lane >> 5; (void)r32; (void)hi
__device__ __forceinline__ void pair_lock(volatile LAS unsigned* w) {
    for (;;) { unsigned got = 0u; if (__builtin_amdgcn_mbcnt_hi(~0u, __builtin_amdgcn_mbcnt_lo(~0u, 0u)) == 0u) got = (__hip_atomic_exchange((LAS unsigned*)w, 1u, __ATOMIC_RELAXED, __HIP_MEMORY_SCOPE_WORKGROUP) == 0u) ? 1u : 0u;
        got = (unsigned)__builtin_amdgcn_readfirstlane((int)got); if (got) break; __builtin_amdgcn_s_sleep(2); }
    asm volatile("s_waitcnt lgkmcnt(0)" ::: "memory"); }
__device__ __forceinline__ void pair_unlock(volatile LAS unsigned* w) { asm volatile("s_waitcnt vmcnt(0) lgkmcnt(0)" ::: "memory"); if (__builtin_amdgcn_mbcnt_hi(~0u, __builtin_amdgcn_mbcnt_lo(~0u, 0u)) == 0u) __hip_atomic_store((LAS unsigned*)w, 0u, __ATOMIC_RELAXED, __HIP_MEMORY_SCOPE_WORKGROUP); asm volatile("s_waitcnt lgkmcnt(0)" ::: "memory"); }
#ifndef G1_LOCK
#define G1_LOCK 0
#endif
#define LOCK_IF(m) do { if (G1_LOCK & (m)) pair_lock(lockw); } while (0)
#define UNLOCK_IF(m) do { if (G1_LOCK & (m)) pair_unlock(lockw); } while (0)
constexpr int G1_L = 0, G1_ARR = 8192, G1_TK = 9216, G1_TV = 17408, G1_TQ = 17408  , G1_WAVE_LDS = 26624;
__device__ __forceinline__ void g1_item(Frame& F, int item, LAS unsigned char* wl, volatile LAS unsigned* lockw) {
    int zz = 0; asm volatile("" : "+v"(zz)); __builtin_assume((unsigned)zz < 2u);
    const int chain = item / 68, ci = item - chain * 68; const ItemGeom G = item_geom(chain, ci); const int h = G.h;
    LAS float* Ls = (LAS float*)(wl + G1_L); LAS float* gcA = (LAS float*)(wl + G1_ARR), *btA = gcA + 64, *egA = gcA + 128, *etA = gcA + 192;
    const LAS bf16* TK = (const LAS bf16*)(wl + G1_TK); const LAS bf16* TV = (const LAS bf16*)(wl + G1_TV); const LAS bf16* TQ = (const LAS bf16*)(wl + G1_TQ);
    const bf16* QK = (const bf16*)(F.ws + WS_QKVN); const float* GB = (const float*)(F.ws + WS_GB);
    bf16* out = (bf16*)(F.ws + WS_GDNI) + (size_t)item * 16384;
    LOCK_IF(1);
    u32x4 tq[8];
    { G1_LANES(); u32x4 t[2][8];
#pragma unroll
      for (int j = 0; j < 8; ++j) { const int i = (lane >> 3) + 8 * j; const bf16* rp = QK + (size_t)item_row(G, i) * 1536 + h * 64 + (lane & 7) * 8;
          t[0][j] = *(const GAS u32x4*)(rp + 512); t[1][j] = *(const GAS u32x4*)(rp + 1024); tq[j] = *(const GAS u32x4*)rp; }
#pragma unroll
      for (int j = 0; j < 8; ++j) { const int o = ((lane >> 3) + 8 * j) * 128 + (lane & 7) * 16;
          *(LAS u32x4*)(wl + G1_TK + o) = t[0][j]; *(LAS u32x4*)(wl + G1_TV + o) = t[1][j]; } }
    float gl;
    { G1_LANES(); const int row = item_row(G, lane); float g = GB[(size_t)row * 32 + G.dir * 8 + h]; const float bt = GB[(size_t)row * 32 + 16 + G.dir * 8 + h];
#pragma unroll
      for (int o = 1; o < 64; o <<= 1) { const float t = __builtin_bit_cast(float, __builtin_amdgcn_ds_bpermute((lane - o) << 2, __builtin_bit_cast(int, g))); if (lane >= o) g += t; }
      gl = __builtin_bit_cast(float, __builtin_amdgcn_readlane(__builtin_bit_cast(int, g), 63)); gcA[lane] = g; btA[lane] = bt; egA[lane] = __expf(g); etA[lane] = __expf(gl - g); }
    asm volatile("s_waitcnt lgkmcnt(0)" ::: "memory");
    const LAS float* gcz = gcA + zz; const LAS float* btz = btA + zz; const LAS float* egz = egA + zz; const LAS float* etz = etA + zz;
    UNLOCK_IF(1); LOCK_IF(2);
    bf16x8 L21A[2];
    { G1_LANES(); bf16x8 Kf[2][4];
#pragma unroll
      for (int t = 0; t < 2; ++t)
#pragma unroll
          for (int s = 0; s < 4; ++s) Kf[t][s] = *(const LAS bf16x8*)(TK + (32 * t + r32) * 64 + 16 * s + 8 * hi);
#pragma unroll
      for (int t = 0; t < 2; ++t) { f32x16 acc = f32x16{};
#pragma unroll
          for (int s = 0; s < 4; ++s) acc = __builtin_amdgcn_mfma_f32_32x32x16_bf16(Kf[t][s], Kf[t][s], acc, 0, 0, 0);
          const float gcj = gcz[32 * t + r32];
#pragma unroll
          for (int r = 0; r < 16; ++r) { const int il = crow(r, hi), i = 32 * t + il; const float e = __expf(fminf(gcz[i] - gcj, 0.f)); const float v0 = btz[i] * acc[r] * e; Ls[t * 1024 + il * 32 + r32] = (r32 < il) ? v0 : 0.f; } }
      { f32x16 acc = f32x16{};
#pragma unroll
          for (int s = 0; s < 4; ++s) acc = __builtin_amdgcn_mfma_f32_32x32x16_bf16(Kf[0][s], Kf[1][s], acc, 0, 0, 0);
          const int i = 32 + r32; const float gci = gcz[i], bti = btz[i];
#pragma unroll
          for (int r = 0; r < 16; ++r) { const int j = crow(r, hi); acc[r] = bti * acc[r] * __expf(fminf(gci - gcz[j], 0.f)); }
          L21A[0] = acc_frag(acc, 0); L21A[1] = acc_frag(acc, 1); } }
    asm volatile("s_waitcnt lgkmcnt(0)" ::: "memory"); __builtin_amdgcn_sched_barrier(0);
    UNLOCK_IF(2); LOCK_IF(4);
    bf16x8 UF[4][2];
    const unsigned la = (unsigned)(uintptr_t)Ls + ((unsigned)zz << 4);
    { G1_LANES(); float x1[32], x2[32];
#pragma unroll
      for (int i = 0; i < 64; ++i) { const float v = bf2f(TV[i * 64 + lane]) * btz[i]; if (i < 32) x1[i & 31] = v; else x2[i & 31] = v; }
      asm volatile("s_waitcnt lgkmcnt(0)" ::: "memory");
#pragma unroll
      for (int j = 0; j < 8; ++j) *(LAS u32x4*)(wl + G1_TQ + ((lane >> 3) + 8 * j) * 128 + (lane & 7) * 16) = tq[j];
      solve_blocked(x1, x2, la, L21A, UF); }
    __builtin_amdgcn_sched_barrier(0);
    bf16x8 WF[4][2];
    { G1_LANES(); float x1[32], x2[32];
#pragma unroll
      for (int i = 0; i < 64; ++i) { const float v = bf2f(TK[i * 64 + lane]) * btz[i] * egz[i]; if (i < 32) x1[i & 31] = v; else x2[i & 31] = v; }
      solve_blocked(x1, x2, la, L21A, WF); }
    __builtin_amdgcn_sched_barrier(0);
    UNLOCK_IF(4); LOCK_IF(8);
    bf16x8 KTA[4][2];
    { G1_LANES(); float k1[32], k2[32];
#pragma unroll
      for (int i = 0; i < 32; ++i) { k1[i] = bf2f(TK[i * 64 + lane]) * etz[i]; k2[i] = bf2f(TK[(32 + i) * 64 + lane]) * etz[32 + i]; }
      col_frags32(k1, KTA, 0); col_frags32(k2, KTA, 2); }
    __builtin_amdgcn_sched_barrier(0);
    const __amdgpu_buffer_rsrc_t ro = __builtin_amdgcn_make_buffer_rsrc((void*)out, 0, 32768, 0x00020000);
    {
    G1_LANES();
    const float egl = __expf(gl);
#pragma unroll
    for (int at = 0; at < 2; ++at)
#pragma unroll
        for (int ct = 0; ct < 2; ++ct) { f32x16 a0 = f32x16{}, a1 = f32x16{};
#pragma unroll
            for (int s = 0; s < 4; ++s) { a0 = __builtin_amdgcn_mfma_f32_32x32x16_bf16(KTA[s][at], UF[s][ct], a0, 0, 0, 0); a1 = __builtin_amdgcn_mfma_f32_32x32x16_bf16(KTA[s][at], WF[s][ct], a1, 0, 0, 0); }
            store_accfrag(ro, 16384 + (at * 2 + ct) * 2048, lane, a0);
            const int vo = 4 * hi * 128 + (32 * ct + swap23(r32)) * 2;
#pragma unroll
            for (int r = 0; r < 16; ++r) { const float v = ((at == ct && crow(r, hi) == r32) ? egl : 0.f) - a1[r];
                __builtin_amdgcn_raw_buffer_store_b16((short)f2bf(v), ro, vo + (r & 3) * 128 + (r >> 2) * 1024, 32 * at * 128, 0); }
            __builtin_amdgcn_sched_barrier(0); }
    }
    UNLOCK_IF(8); LOCK_IF(16);
    bf16x8 XA[3][2];
    { G1_LANES(); bf16x8 Kf[4], Qf[2][4]; const LAS bf16* TK2 = TK + zz;
#pragma unroll
      for (int t = 0; t < 2; ++t)
#pragma unroll
          for (int s = 0; s < 4; ++s) Qf[t][s] = *(const LAS bf16x8*)(TQ + (32 * t + r32) * 64 + 16 * s + 8 * hi);
#pragma unroll
      for (int tl = 0; tl < 3; ++tl) { const int jt = tl == 2 ? 1 : 0, it = tl == 0 ? 0 : 1;
          if (tl != 1) {
#pragma unroll
              for (int s = 0; s < 4; ++s) Kf[s] = *(const LAS bf16x8*)(TK2 + (32 * jt + r32) * 64 + 16 * s + 8 * hi); }
          f32x16 acc = f32x16{};
#pragma unroll
          for (int s = 0; s < 4; ++s) acc = __builtin_amdgcn_mfma_f32_32x32x16_bf16(Kf[s], Qf[it][s], acc, 0, 0, 0);
          const int i = 32 * it + r32; const float gci = gcz[i];
#pragma unroll
          for (int r = 0; r < 16; ++r) { const int j = 32 * jt + crow(r, hi); const float e = __expf(fminf(gci - gcz[j], 0.f)); const float v0 = acc[r] * e; acc[r] = (j <= i) ? v0 : 0.f; }
          XA[tl][0] = acc_frag(acc, 0); XA[tl][1] = acc_frag(acc, 1); __builtin_amdgcn_sched_barrier(0); } }
    __builtin_amdgcn_sched_barrier(0);
    {
    G1_LANES();
#pragma unroll
    for (int it = 0; it < 2; ++it)
#pragma unroll
        for (int ct = 0; ct < 2; ++ct) { f32x16 a0 = f32x16{}, a1 = f32x16{};
#pragma unroll
            for (int jt = 0; jt <= it; ++jt) { const int tl = (it == 0) ? 0 : (jt == 0 ? 1 : 2);
#pragma unroll
                for (int sp = 0; sp < 2; ++sp) { a0 = __builtin_amdgcn_mfma_f32_32x32x16_bf16(XA[tl][sp], UF[2 * jt + sp][ct], a0, 0, 0, 0); a1 = __builtin_amdgcn_mfma_f32_32x32x16_bf16(XA[tl][sp], WF[2 * jt + sp][ct], a1, 0, 0, 0); } }
            store_accfrag(ro, 24576 + (it * 2 + ct) * 2048, lane, a0);
            const int vo = 4 * hi * 128 + (32 * ct + swap23(r32)) * 2; const int a = 32 * ct + r32;
#pragma unroll
            for (int r = 0; r < 16; ++r) { const int i = 32 * it + crow(r, hi); const float qv = bf2f(TQ[i * 64 + a]);
                __builtin_amdgcn_raw_buffer_store_b16((short)f2bf(qv * egz[i] - a1[r]), ro, vo + (r & 3) * 128 + (r >> 2) * 1024, 8192 + 32 * it * 128, 0); }
            __builtin_amdgcn_sched_barrier(0); }
    }
    asm volatile("s_waitcnt lgkmcnt(0)" ::: "memory");
    UNLOCK_IF(16);
}
__device__ __forceinline__ void scan_chain(Frame& F, int chain, int dc) {
    const int w = F.wave, lane = F.lane, r32 = lane & 31, hi = lane >> 5, role = (w >> 1) & 1, rt = w & 1;
    LAS u32x4* SF = (LAS u32x4*)(F.lds + RING_OFF);
    const bf16* base = (const bf16*)(F.ws + WS_GDNI) + (size_t)chain * 68 * 16384; bf16* OG = (bf16*)(F.ws + WS_OG);
    for (int i = F.tid; i < 2 * 4 * 64; i += 512) SF[i] = (u32x4){0u, 0u, 0u, 0u};
    const bf16* Ab = base + (role ? 4096 : 0) + (32 * rt + r32) * 64 + 8 * hi; const bf16* Cb = base + (role ? 12288 : 8192) + ((rt * 2 + dc) * 64 + lane) * 16;
    struct Ops { bf16x8 a[4]; u32x4 c[2]; };
#define SC_LOAD(o, ci_) do { const bf16* A_ = Ab + (size_t)(ci_) * 16384; const bf16* C_ = Cb + (size_t)(ci_) * 16384; \
        _Pragma("unroll") for (int s_ = 0; s_ < 4; ++s_) (o).a[s_] = *(const GAS bf16x8*)(A_ + 16 * s_); (o).c[0] = *(const GAS u32x4*)C_; (o).c[1] = *(const GAS u32x4*)(C_ + 8); } while (0)
#define SC_STEP(o, ci_) do { f32x16 acc; \
        _Pragma("unroll") for (int q = 0; q < 4; ++q) { acc[2 * q] = bflo((o).c[0][q]); acc[2 * q + 1] = bfhi((o).c[0][q]); acc[8 + 2 * q] = bflo((o).c[1][q]); acc[8 + 2 * q + 1] = bfhi((o).c[1][q]); } \
        const LAS u32x4* Sb = SF + (((ci_) & 1) * 256) + lane; \
        _Pragma("unroll") for (int s_ = 0; s_ < 4; ++s_) { const u32x4 bw = Sb[s_ * 64]; acc = __builtin_amdgcn_mfma_f32_32x32x16_bf16((o).a[s_], __builtin_bit_cast(bf16x8, bw), acc, 0, 0, 0); } \
        SC_LOAD(o, ((ci_) + SCAN_PF < 68) ? (ci_) + SCAN_PF : 67);     \
        if (role == 0) { LAS u32x4* Sn = SF + ((((((ci_) + 1) & 1)) * 4 + 2 * rt) * 64) + lane; Sn[0] = __builtin_bit_cast(u32x4, acc_frag(acc, 0)); Sn[64] = __builtin_bit_cast(u32x4, acc_frag(acc, 1)); } \
        else { const ItemGeom G = item_geom(chain, (ci_)); LAS bf16* stg = (LAS bf16*)(F.lds + RING_OFF + 16384 + rt * 2048);     \
            _Pragma("unroll") for (int r = 0; r < 16; ++r) stg[crow(r, hi) * 32 + r32] = (bf16)f2bf(acc[r]); \
            asm volatile("s_waitcnt lgkmcnt(0)" ::: "memory"); \
            const u32x4 v0 = *(const LAS u32x4*)(stg + (lane >> 1) * 32 + (lane & 1) * 16), v1 = *(const LAS u32x4*)(stg + (lane >> 1) * 32 + (lane & 1) * 16 + 8); \
            GAS u32x4* po = (GAS u32x4*)(OG + (size_t)item_row(G, 32 * rt + (lane >> 1)) * 1024 + G.dir * 512 + G.h * 64 + 32 * dc + (lane & 1) * 16); po[0] = v0; po[1] = v1; } \
        asm volatile("s_waitcnt lgkmcnt(0)" ::: "memory"); __builtin_amdgcn_s_barrier(); asm volatile("" ::: "memory"); } while (0)
    if (w < 4) {
        Ops o[SCAN_PF];
#pragma unroll
        for (int k = 0; k < SCAN_PF; ++k) SC_LOAD(o[k], k);
        __syncthreads();
#pragma unroll
        for (int ci = 0; ci < 68; ++ci) SC_STEP(o[ci % SCAN_PF], ci);
        asm volatile("s_waitcnt vmcnt(0)" ::: "memory");
    } else {
        __syncthreads();
#pragma unroll 1
        for (int ci = 0; ci < 68; ++ci) { __builtin_amdgcn_s_barrier(); asm volatile("" ::: "memory"); }
    }
#undef SC_LOAD
#undef SC_STEP
}
}
__device__ __forceinline__ void l1_prep(Frame& F) {
    bf16* P = (bf16*)(F.ws + WS_PROJ2); bf16* KM = (bf16*)(F.ws + WS_KMLA); const int lane = F.lane;
    for (int r = F.gw; r < NR; r += F.NGW) { const int b = r / SROW, s = r - b * SROW; const bool isc = s < TC; const int p = s - TC; bf16* row = P + (size_t)r * OINP;
        { bf16* CQ = (bf16*)(F.ws + WS_CQN) + (size_t)r * 640;
          const v2u a = *(const GAS v2u*)(row + O_CQ + 4 * lane); const v2u c = (lane < 32) ? *(const GAS v2u*)(row + O_CQ + 256 + 4 * lane) : (v2u){0u, 0u}; const v2u k = *(const GAS v2u*)(row + O_CKV + 4 * lane);
          const float a0 = bflo(a.x), a1 = bfhi(a.x), a2 = bflo(a.y), a3 = bfhi(a.y), c0 = bflo(c.x), c1 = bfhi(c.x), c2 = bflo(c.y), c3 = bfhi(c.y), k0 = bflo(k.x), k1 = bfhi(k.x), k2 = bflo(k.y), k3 = bfhi(k.y);
          const float sq = wave_sum(a0 * a0 + a1 * a1 + a2 * a2 + a3 * a3 + c0 * c0 + c1 * c1 + c2 * c2 + c3 * c3), skv = wave_sum(k0 * k0 + k1 * k1 + k2 * k2 + k3 * k3);
          const float rq = 1.f / sqrtf(sq * (1.f / 384.f) + EPS), rk = 1.f / sqrtf(skv * (1.f / 256.f) + EPS);
          *(GAS v2u*)(CQ + 4 * lane) = (v2u){pk2(a0 * rq, a1 * rq), pk2(a2 * rq, a3 * rq)};
          if (lane < 32) *(GAS v2u*)(CQ + 256 + 4 * lane) = (v2u){pk2(c0 * rq, c1 * rq), pk2(c2 * rq, c3 * rq)};
          *(GAS v2u*)(CQ + 384 + 4 * lane) = (v2u){pk2(k0 * rk, k1 * rk), pk2(k2 * rk, k3 * rk)}; }
        if (lane < 16) { const int seg = lane >> 3, i = lane & 7, d0 = seg * 16 + i; float x0 = bf2f(row[O_KR + d0]), x1 = bf2f(row[O_KR + d0 + 8]);
            if (!isc) { const float pos = (float)(seg ? (p & 63) : (p >> 6)); const float ang = pos * __powf(10000.f, -(float)i * (1.f / 8.f)); float sn, cs; sincosf(ang, &sn, &cs);
                const float y0 = x0 * cs - x1 * sn, y1 = x1 * cs + x0 * sn; x0 = y0; x1 = y1; }
            const bf16 b0 = (bf16)f2bf(x0), b1 = (bf16)f2bf(x1);
#pragma unroll
            for (int h = 0; h < 8; ++h) { KM[(size_t)r * 768 + h * 96 + 64 + d0] = b0; KM[(size_t)r * 768 + h * 96 + 64 + d0 + 8] = b1; } }
        if (!isc) {
            const int pi = lane & 31, seg = pi >> 4, i = pi & 15, d0 = seg * 32 + i; const float pos = (float)(seg ? (p & 63) : (p >> 6));
            const float ang = pos * __powf(10000.f, -(float)i * (1.f / 16.f)); float sn, cs; sincosf(ang, &sn, &cs);
#pragma unroll
            for (int q = 0; q < 8; ++q) { const int hh = (lane >> 5) + 2 * q; bf16* base = row + (hh < 8 ? O_DQ + hh * 64 : O_DK + (hh - 8) * 64) + d0;
                const float x0 = bf2f(base[0]), x1 = bf2f(base[16]); base[0] = (bf16)f2bf(x0 * cs - x1 * sn); base[16] = (bf16)f2bf(x1 * cs + x0 * sn); } }
    }
}
__device__ __forceinline__ void l1_qrope(Frame& F) {
    bf16* QM = (bf16*)(F.ws + WS_QM); const int lane = F.lane;
    for (int r = F.gw; r < NR; r += F.NGW) { const int b = r / SROW, s = r - b * SROW; if (s < TC) continue; const int p = s - TC;
        const int pi = lane & 15, seg = pi >> 3, i = pi & 7, d0 = seg * 16 + i; const float pos = (float)(seg ? (p & 63) : (p >> 6));
        const float ang = pos * __powf(10000.f, -(float)i * (1.f / 8.f)); float sn, cs; sincosf(ang, &sn, &cs);
#pragma unroll
        for (int q = 0; q < 2; ++q) { const int h = (lane >> 4) + 4 * q; bf16* base = QM + (size_t)r * 768 + h * 96 + 64 + d0;
            const float x0 = bf2f(base[0]), x1 = bf2f(base[8]); base[0] = (bf16)f2bf(x0 * cs - x1 * sn); base[8] = (bf16)f2bf(x1 * cs + x0 * sn); } }
}
__device__ __forceinline__ void l1_attn_unit(Frame& F, int u) {
    if (u < 512) { const int b = u >> 7, qb = (u >> 3) & 15, h = u & 7; const size_t rq = (size_t)b * SROW + TC + qb * 256, r0 = (size_t)b * SROW;
        constexpr float SC = 0.10206207261596575f  , C = SC * 1.4426950408889634f, THRS = att::THR / SC;
        const bf16* QM = (const bf16*)(F.ws + WS_QM); const bf16* KM = (const bf16*)(F.ws + WS_KMLA); const bf16* VM = (const bf16*)(F.ws + WS_VMLA); bf16* MIX = (bf16*)(F.ws + WS_MIX);
        att::attn_unit<96, 64, 0, true>(QM + rq * 768 + h * 96, 768, KM + r0 * 768 + h * 96, 768, VM + r0 * 512 + h * 64, 512, MIX + rq * 1024 + h * 64, 1024, SROW / 64, 0, qb * 256, C, THRS, -3.0e38f, F.ldsg + RING_OFF);
    } else { const int v = u - 512, b = v >> 6, qb = (v >> 2) & 15, head = v & 3; const size_t rq = (size_t)b * SROW + TC + qb * 256, r0 = (size_t)b * SROW;
        constexpr float SC = 0.125f, C = SC * 1.4426950408889634f, THRS = att::THR / SC; constexpr float LAM_INIT = 0.35550906759096556f;
        const float* lp = F.in[I_OLAM]; const float lam = __expf(wave_sum(lp[F.lane] * lp[64 + F.lane])) - __expf(wave_sum(lp[128 + F.lane] * lp[192 + F.lane])) + LAM_INIT;
        const bf16* P = (const bf16*)(F.ws + WS_PROJ2); bf16* MIX = (bf16*)(F.ws + WS_MIX); const int hh = 2 * head;
        att::attn_unit<64, 128, 0, false, 1>(P + rq * OINP + O_DQ + hh * 64, OINP, P + r0 * OINP + O_DK + hh * 64, OINP, P + r0 * OINP + O_DV + head * 128, OINP, MIX, 1024, SROW / 64, 0, 0, C, THRS, -3.0e38f, F.ldsg + RING_OFF);
        att::attn_unit<64, 128, 0, false, 2>(P + rq * OINP + O_DQ + (hh + 1) * 64, OINP, P + r0 * OINP + O_DK + (hh + 1) * 64, OINP, P + r0 * OINP + O_DV + head * 128, OINP, MIX + rq * 1024 + 512 + head * 128, 1024, SROW / 64, 0, 0, C, THRS, -3.0e38f, F.ldsg + RING_OFF,
                                             lam, F.in[I_OSUBLN], 1.f - LAM_INIT); }
}
__device__ __forceinline__ void l1_diff_post(Frame& F) {
    const bf16* OD = (const bf16*)(F.ws + WS_ODIFF); bf16* MIX = (bf16*)(F.ws + WS_MIX); const int lane = F.lane; const float* lp = F.in[I_OLAM];
    constexpr float LAM_INIT = 0.35550906759096556f;
    const float s01 = wave_sum(lp[lane] * lp[64 + lane]), s23 = wave_sum(lp[128 + lane] * lp[192 + lane]); const float lam = __expf(s01) - __expf(s23) + LAM_INIT;
    const int head = lane >> 4, d = (lane & 15) * 8; const f32x4 w0 = *(const GAS f32x4*)(F.in[I_OSUBLN] + d), w1 = *(const GAS f32x4*)(F.in[I_OSUBLN] + d + 4);
    const float ww[8] = {w0.x, w0.y, w0.z, w0.w, w1.x, w1.y, w1.z, w1.w};
    for (int r = F.gw; r < NR; r += F.NGW) { const int b = r / SROW, s = r - b * SROW; if (s < TC) continue;
        const v4u a = *(const GAS v4u*)(OD + (size_t)r * 1024 + (2 * head) * 128 + d), c = *(const GAS v4u*)(OD + (size_t)r * 1024 + (2 * head + 1) * 128 + d);
        float o[8] = {bflo(a.x) - lam * bflo(c.x), bfhi(a.x) - lam * bfhi(c.x), bflo(a.y) - lam * bflo(c.y), bfhi(a.y) - lam * bfhi(c.y), bflo(a.z) - lam * bflo(c.z), bfhi(a.z) - lam * bfhi(c.z), bflo(a.w) - lam * bflo(c.w), bfhi(a.w) - lam * bfhi(c.w)};
        float ss = 0.f;
#pragma unroll
        for (int e = 0; e < 8; ++e) ss += o[e] * o[e];
        ss += __shfl_xor(ss, 1); ss += __shfl_xor(ss, 2); ss += __shfl_xor(ss, 4); ss += __shfl_xor(ss, 8);
        const float rs = (1.f - LAM_INIT) / sqrtf(ss * (1.f / 128.f) + EPS);
#pragma unroll
        for (int e = 0; e < 8; ++e) o[e] = o[e] * rs * ww[e];
        *(GAS v4u*)(MIX + (size_t)r * 1024 + 512 + head * 128 + d) = (v4u){pk2(o[0], o[1]), pk2(o[2], o[3]), pk2(o[4], o[5]), pk2(o[6], o[7])}; }
}
__device__ __forceinline__ void moe_bases(Frame& F, int (&base)[8], int& ntiles) { int acc = 0;
#pragma unroll
    for (int e = 0; e < 8; ++e) { base[e] = acc; const int c = (int)__hip_atomic_load((unsigned*)(F.ctl + CW_MOECNT + 64 * e), RLX_AGENT); acc += (c + 255) & ~255; }
    ntiles = acc >> 8; }
constexpr size_t META_TEXP = 640 * 1024, META_POS = 768 * 1024;
__device__ __forceinline__ int row_vcu(const Frame& F, int r) { return (r % F.NGW) >> 3; }
__device__ __forceinline__ void moe_gather(Frame& F) {
    int base[8], ntiles; moe_bases(F, base, ntiles);
    int* TEXP = (int*)(F.ws + WS_META + META_TEXP); int* POS = (int*)(F.ws + WS_META + META_POS);
    const int* TOPI = (const int*)(F.ws + WS_META + META_TOPI); const int* RANK = (const int*)(F.ws + WS_META + META_RANK);
    if (blockIdx.x == 0 && F.tid < 144) { const int t = F.tid; int e = 0;
#pragma unroll
        for (int q = 1; q < 8; ++q) if (t * 256 >= base[q]) e = q;
        TEXP[t] = e; if (t == 143) TEXP[144] = ntiles; }
    const bf16* FIN = (const bf16*)(F.ws + WS_FIN2); bf16* AS = (bf16*)(F.ws + WS_ASORT);
    for (int tk0 = F.gw; tk0 < NB * T; tk0 += 8 * F.NGW) { int posl = 0;
        { const int i = F.lane >> 1, sl = F.lane & 1, tk = tk0 + i * F.NGW;
          if (F.lane < 16 && tk < NB * T) { const int b = tk / T, t = tk - b * T; const int e = TOPI[tk * 2 + sl]; int bs = 0;
#pragma unroll
              for (int q = 0; q < 8; ++q) if (q == e) bs = base[q];
              posl = bs + ((const int*)(F.ws + WS_META + META_BLKB))[tok_vcu(F, b, t) * 8 + e] + RANK[tk * 2 + sl]; POS[tk * 2 + sl] = posl; } }
#pragma unroll
        for (int i = 0; i < 8; ++i) { const int tk = tk0 + i * F.NGW; if (tk < NB * T) { const int b = tk / T, t = tk - b * T; const size_t r = (size_t)b * SROW + TC + t;
            const GAS v4u* src = (const GAS v4u*)(FIN + r * D) + F.lane; const v4u x0 = src[0], x1 = src[64];
            const int p0 = __builtin_amdgcn_readlane(posl, 2 * i), p1 = __builtin_amdgcn_readlane(posl, 2 * i + 1);
            GAS v4u* d0 = (GAS v4u*)(AS + (size_t)p0 * D) + F.lane; d0[0] = x0; d0[64] = x1;
            GAS v4u* d1 = (GAS v4u*)(AS + (size_t)p1 * D) + F.lane; d1[0] = x0; d1[64] = x1; } } }
}
__device__ __forceinline__ Row4 moe_out_row(Frame& F, const bf16* OR, int pos_) {
    const int pos = __builtin_amdgcn_readfirstlane(pos_), tile = pos >> 8, part = tile >= 68 ? 1 : 0, local = tile - 68 * part;
    if (local < 64) return ld_row_bf16(OR + (size_t)pos * D, F.lane);
    const float* P = (const float*)(F.ws + (part ? WS_WXGU : WS_FIN2)) + ((size_t)(local - 64) * 256 + (pos & 255)) * 1024; Row4 y = ld_row_f32(P, F.lane);
    for (int s = 1; s < DFX / MOE_KSL; ++s) { const Row4 p = ld_row_f32(P + (size_t)s * 4 * 256 * 1024, F.lane);
#pragma unroll
        for (int j = 0; j < 4; ++j) y.v[j] += p.v[j]; }
    return y; }
__device__ __forceinline__ void rows_final(Frame& F) {
    const bf16* OR = (const bf16*)(F.ws + WS_ASORT); const int* POS = (const int*)(F.ws + WS_META + META_POS); const float* TOPW = (const float*)(F.ws + WS_META + META_TOPW);
    const int wpb = F.NGW >> 2, b = F.gw / wpb, wl = F.gw - b * wpb; const Row4 W = ld_row_f32(F.in[I_ONORMS] + 3 * 1024, F.lane), Gt = ld_row_f32(modvec(F, 1, b, 5), F.lane);
    for (int t = wl; t < T; t += wpb) { const int tk = b * T + t; float* xr = F.out + (size_t)tk * D;
        Row4 x = ld_row_bf16((const bf16*)(F.ws + WS_XB) + (size_t)tk * D, F.lane); const Row4 y0 = moe_out_row(F, OR, POS[tk * 2]), y1 = moe_out_row(F, OR, POS[tk * 2 + 1]);
        const float w0 = TOPW[tk * 2], w1 = TOPW[tk * 2 + 1]; Row4 y;
#pragma unroll
        for (int j = 0; j < 4; ++j) y.v[j] = y0.v[j] * w0 + y1.v[j] * w1;
        add_gated_norm_r(x, y, W, Gt); st_row_f32(xr, F.lane, x); }
}
constexpr int N_PHASES = 26;
__global__ void __launch_bounds__(NWAVES * 64, 2) trunk_fwd(Args args) {
    extern __shared__ __attribute__((aligned(16))) unsigned char lds[];
    Frame F;
    F.lds = (LAS unsigned char*)lds; F.ldsg = (char*)lds;
    F.MISC = (volatile LAS unsigned*)(F.lds + MISC_OFF);
    F.wave = __builtin_amdgcn_readfirstlane((int)threadIdx.x >> 6);
#define REFRESH() do { int z_ = 0; asm volatile("" : "+v"(z_)); F.lane = (int)__builtin_amdgcn_mbcnt_hi(~0u, __builtin_amdgcn_mbcnt_lo(~0u, (unsigned)z_)); F.tid = F.wave * 64 + F.lane; } while (0)
    REFRESH();
    F.G = gridDim.x; { const int bx = blockIdx.x; F.vcu = (F.G % 8 == 0) ? (bx % 8) * (F.G / 8) + bx / 8 : bx; }
    F.gw = F.vcu * NWAVES + F.wave; F.NGW = F.G * NWAVES;
    F.in = args.in; F.out = args.out; F.ws = args.ws; F.ctl = (gu32*)(args.ws + WS_CTL);
    unsigned char* ws = args.ws;
    for (int u = F.tid; u < (LDS_BYTES - MISC_OFF) / 4; u += NWAVES * 64) ((LAS unsigned*)(F.lds + MISC_OFF))[u] = 0u;
    __syncthreads();
    XcdBarrier bar; bar.bar = (unsigned*)(F.ctl + CW_BAR); bar.x = 0; bar.st = nullptr;
    const int lo = args.ph_lo, hi = args.ph_hi;
    const bool use_bar = (hi - lo) > 1;
    if (use_bar) bar = xcd_barrier_post((unsigned*)(F.ctl + CW_BAR), F.MISC + 8);
#ifndef MK_ONLY
#define MK_ONLY_OK(k) true
#else
#define MK_ONLY_OK(k) ((k) == MK_ONLY)
#endif
#define IN(k) (MK_ONLY_OK(k) && lo <= (k) && (k) < hi && (k) <= MK_LAST_PHASE)
#ifndef PROBE_MULT
#define PROBE_MULT 4
#endif
#ifndef PROBE_SPAN
#define PROBE_SPAN 1
#endif
#ifndef SCAN_REP
#define SCAN_REP 1
#endif
#ifndef SWA_REP
#define SWA_REP 1
#endif
#ifndef CHK_MASK
#define CHK_MASK 0xffu
#endif
#ifndef MK_REP_MASK
#define MK_REP_MASK 0u
#endif
#define REPS(k) ((((unsigned)MK_REP_MASK >> (k)) & 1u) ? 2 : 1)
#ifdef PROBE_PHASE
#define STAMP(k) do { if (blockIdx.x == 0 && F.tid == 0) { const unsigned long long t_ = __builtin_amdgcn_s_memrealtime(); F.MISC[64 + 2 * (k)] = (unsigned)t_; F.MISC[65 + 2 * (k)] = (unsigned)(t_ >> 32); } } while (0)
#else
#define STAMP(k) do { } while (0)
#endif
#define SEAM(k) do { if (IN(k) && IN((k) + 1)) xcd_barrier(bar); STAMP((k) + 1); } while (0)
    typedef pg8::bf16_t pb;
    const int bid = blockIdx.x;

    STAMP(0);
    if (IN(0)) for (int rep_ = 0; rep_ < REPS(0); ++rep_) { REFRESH(); p0_prologue(F); } SEAM(0);
    if (IN(1)) for (int rep_ = 0; rep_ < REPS(1); ++rep_) { REFRESH(); p1_first_rows(F); } SEAM(1);
    if (IN(2)) for (int rep_ = 0; rep_ < REPS(2); ++rep_) { REFRESH();
        pg8::Gemm g{(const pb*)(ws + WS_ABUF), (const pb*)(ws + WS_WEIN), NR, EINP, 1024, 1024, 1024}; pg8::StaticOrder S; S.init(NR, EINP, F.G, bid);
        pg8::EpiStore E{(pb*)(ws + WS_PROJ), EINP, EINP / 256};
        pg8::gemm_phase<pg8::EpiStore, pg8::StaticOrder, PG8_ALIGN, PG8_SP2>(F.lds + RING_OFF, g, S, E); } SEAM(2);
    if (IN(3)) for (int rep_ = 0; rep_ < REPS(3); ++rep_) { REFRESH(); g0_prep(F); } SEAM(3);
#ifdef GDN_SLOW
    if (IN(5)) for (int rep_ = 0; rep_ < REPS(5); ++rep_) { REFRESH();
        if (F.G > 64) { if (bid < 64) gdn_chain(F, bid); else for (int u = bid - 64; u < 544; u += F.G - 64) swa_unit(F, u); }
        else { for (int c = bid; c < 64; c += F.G) gdn_chain(F, c); for (int u = bid; u < 544; u += F.G) swa_unit(F, u); } } SEAM(5);
#else
    if (IN(4)) for (int rep_ = 0; rep_ < REPS(4); ++rep_) { REFRESH();
#if G1_LOCK
        if ((F.wave & 3) == 0) for (int item = F.vcu * 2 + (F.wave >> 2); item < 64 * 68; item += F.G * 2) gdn::g1_item(F, item, F.lds + RING_OFF + (F.wave >> 2) * gdn::G1_WAVE_LDS, F.MISC + 16);
#else
        const int n_main = ((64 * 68) / (F.G * 4)) * (F.G * 4), n_late = (64 * 68 - n_main + 3) / 4;
        if (F.wave < 4) { const int R = n_main / (F.G * 4);
            _Pragma("unroll 1") for (int r = 0; r <= R; ++r) { int item;
                if (r < R) item = F.vcu * 4 + F.wave + r * F.G * 4; else { if (F.vcu >= n_late) break; item = n_main + F.vcu * 4 + F.wave; if (item >= 64 * 68) break; }
                gdn::g1_item(F, item, F.lds + RING_OFF + F.wave * gdn::G1_WAVE_LDS, F.MISC + 16); } }
        else p0_deferred(F, F.wave - 4, F.lds + RING_OFF + 4 * gdn::G1_WAVE_LDS + (F.wave - 4) * 8448);
        if (F.vcu >= n_late) { __syncthreads(); REFRESH();
            if (F.tid == 0) F.MISC[20] = __hip_atomic_fetch_add((unsigned*)(F.ctl + CW_SWAQ), 1u, RLX_AGENT);
            __syncthreads(); const int u = (int)F.MISC[20]; __syncthreads();
            if (u < 544) swa_unit(F, u); }
#endif
    } SEAM(4);
    if (IN(5)) for (int rep_ = 0; rep_ < REPS(5); ++rep_) { REFRESH();
        STAMP(30); if (bid < 128) for (int c = bid; c < 128; c += F.G) { gdn::scan_chain(F, c >> 1, c & 1); __syncthreads(); } STAMP(31);
        REFRESH();
        for (;;) { if (F.tid == 0) F.MISC[20] = __hip_atomic_fetch_add((unsigned*)(F.ctl + CW_SWAQ), 1u, RLX_AGENT);
            __syncthreads(); const int u = (int)F.MISC[20]; __syncthreads();
            if (u >= 544 * REPS(5) * SWA_REP) break;
            swa_unit(F, u % 544); } } SEAM(5);
#endif
    if (IN(6)) for (int rep_ = 0; rep_ < REPS(6); ++rep_) { REFRESH(); g4_gdn_out(F); } SEAM(6);
    if (IN(7)) for (int rep_ = 0; rep_ < REPS(7); ++rep_) { REFRESH();
        { pg8::Gemm g{(const pb*)(ws + WS_MIX), (const pb*)(ws + WS_WEOUT), NR, 1024, 1024, 1024, 1024}; pg8::LatOrder S; S.init(1024, F.G, bid);
          pg8::EpiStore E{(pb*)(ws + WS_YBUF), 1024, 4};
          pg8::gemm_phase<pg8::EpiStore, pg8::LatOrder, PG8_ALIGN, PG8_SP2>(F.lds + RING_OFF, g, S, E); }
        __syncthreads();
        { pg8::Gemm g{(const pb*)(ws + WS_MIX), (const pb*)(ws + WS_WEOUT), NR, 1024, 256, 1024, 1024}; pg8::CtxSplitOrder S; S.init(4, 256, F.G, bid);
          pg8::EpiPartF32 E{(float*)(ws + WS_PART), 256};
          pg8::gemm_phase<pg8::EpiPartF32, pg8::CtxSplitOrder, PG8_ALIGN, PG8_SP2>(F.lds + RING_OFF, g, S, E); } } SEAM(7);
    if (IN(8)) for (int rep_ = 0; rep_ < REPS(8); ++rep_) { REFRESH(); rows_mid<false>(F, (const bf16*)(ws + WS_YBUF), F.in[I_ENORMS] + 1024, 0, 2, F.in[I_ENORMS] + 2048, 0, 3, (bf16*)(ws + WS_ABUF), false, 4); } SEAM(8);
    if (IN(9)) for (int rep_ = 0; rep_ < REPS(9); ++rep_) { REFRESH();
        pg8::Gemm g{(const pb*)(ws + WS_ABUF), (const pb*)(ws + WS_WEGU), NR, 2 * DFF, 1024, 1024, 1024}; pg8::StaticOrder S; S.init(NR, 2 * DFF, F.G, bid);
        pg8::EpiSwiGLU E{(pb*)(ws + WS_HID), DFF, DFF / 128};
        pg8::gemm_phase<pg8::EpiSwiGLU, pg8::StaticOrder, PG8_ALIGN, PG8_SP2>(F.lds + RING_OFF, g, S, E); } SEAM(9);
    if (IN(10)) for (int rep_ = 0; rep_ < REPS(10); ++rep_) { REFRESH();
        { pg8::Gemm g{(const pb*)(ws + WS_HID), (const pb*)(ws + WS_WEDN), NR, 1024, DFF, DFF, DFF}; pg8::LatOrder S; S.init(1024, F.G, bid);
          pg8::EpiStore E{(pb*)(ws + WS_YBUF), 1024, 4};
          pg8::gemm_phase<pg8::EpiStore, pg8::LatOrder, PG8_ALIGN, PG8_SP2>(F.lds + RING_OFF, g, S, E); }
        __syncthreads();
        { pg8::Gemm g{(const pb*)(ws + WS_HID), (const pb*)(ws + WS_WEDN), NR, 1024, 256, DFF, DFF}; pg8::CtxSplitOrder S; S.init(11, 256, F.G, bid);
          pg8::EpiPartF32 E{(float*)(ws + WS_PART), 256};
          pg8::gemm_phase<pg8::EpiPartF32, pg8::CtxSplitOrder, PG8_ALIGN, PG8_SP2>(F.lds + RING_OFF, g, S, E); } } SEAM(10);
    if (IN(11)) for (int rep_ = 0; rep_ < REPS(11); ++rep_) { REFRESH(); rows_mid<false>(F, (const bf16*)(ws + WS_YBUF), F.in[I_ENORMS] + 3072, 0, 5, F.in[I_ONORMS], 1, 0, (bf16*)(ws + WS_ABUF), false, 11); } SEAM(11);
    if (IN(12)) for (int rep_ = 0; rep_ < REPS(12); ++rep_) { REFRESH();
        pg8::Gemm g{(const pb*)(ws + WS_ABUF), (const pb*)(ws + WS_WOIN), NR, OINP, 1024, 1024, 1024}; pg8::StaticOrder S; S.init(NR, OINP, F.G, bid);
        pg8::EpiStore E{(pb*)(ws + WS_PROJ2), OINP, OINP / 256};
        pg8::gemm_phase<pg8::EpiStore, pg8::StaticOrder, PG8_ALIGN, PG8_SP2>(F.lds + RING_OFF, g, S, E); } SEAM(12);
    if (IN(13)) for (int rep_ = 0; rep_ < REPS(13); ++rep_) { REFRESH(); l1_prep(F); } SEAM(13);
    if (IN(14)) for (int rep_ = 0; rep_ < REPS(14); ++rep_) { REFRESH();
#if !defined(T13) || T13 == 1
        { pg8::Gemm g{(const pb*)(ws + WS_CQN), (const pb*)(ws + WS_WUQ), NR, 768, 384, 640, 384}; pg8::LatOrder S; S.init(768, F.G, bid);
          pg8::EpiStore E{(pb*)(ws + WS_QM), 768, 3};
          pg8::gemm_phase<pg8::EpiStore, pg8::LatOrder, PG8_ALIGN, PG8_SP2>(F.lds + RING_OFF, g, S, E); }
#endif
        __syncthreads();
#if !defined(T13) || T13 == 2
        { pg8::Gemm g{(const pb*)(ws + WS_CQN) + 384, (const pb*)(ws + WS_WUKV), NR, 1024, 256, 640, 256}; pg8::StaticOrder S; S.init(NR, 1024, F.G, bid);
          pg8::EpiKV E{(pb*)(ws + WS_KMLA), (pb*)(ws + WS_VMLA)};
          pg8::gemm_phase<pg8::EpiKV, pg8::StaticOrder, PG8_ALIGN, PG8_SP2>(F.lds + RING_OFF, g, S, E); }
#endif
    } SEAM(14);
    STAMP(16);
    if (IN(16)) for (int rep_ = 0; rep_ < REPS(16); ++rep_) { REFRESH(); for (int u = F.vcu; u < 768; u += F.G) l1_attn_unit(F, u); } SEAM(16);
    STAMP(18);
    if (IN(18)) for (int rep_ = 0; rep_ < REPS(18); ++rep_) { REFRESH();
        pg8::Gemm g{(const pb*)(ws + WS_MIX), (const pb*)(ws + WS_WOOUT), NR, 1024, 1024, 1024, 1024}; pg8::LatOrder S; S.init(1024, F.G, bid);
        pg8::EpiStore E{(pb*)(ws + WS_Y2), 1024, 4};
        pg8::gemm_phase<pg8::EpiStore, pg8::LatOrder, PG8_ALIGN, PG8_SP2>(F.lds + RING_OFF, g, S, E); } SEAM(18);
    if (IN(19)) for (int rep_ = 0; rep_ < REPS(19); ++rep_) { REFRESH();
        router_table(F);
        if (F.wave >= 4) px_expert_weights(F);
        rows_mid<true>(F, (const bf16*)(ws + WS_Y2), F.in[I_ONORMS] + 1024, 1, 2, F.in[I_ONORMS] + 2048, 1, 3, (bf16*)(ws + WS_FIN2), true);
        if (F.wave < 4) px_expert_weights(F);
        router_tail(F); } SEAM(19);
    if (IN(20)) for (int rep_ = 0; rep_ < REPS(20); ++rep_) { REFRESH(); moe_gather(F); } SEAM(20);
#define MOE_PART(kgu, kdn, t0_, cap_) \
    if (IN(kgu)) for (int rep_ = 0; rep_ < REPS(kgu); ++rep_) { REFRESH(); int base[8], ntiles; moe_bases(F, base, ntiles); const int t0 = (t0_), ntl = (ntiles - t0 < 0) ? 0 : ((ntiles - t0 < (cap_)) ? ntiles - t0 : (cap_)); \
        pg8::Gemm g{(const pb*)(ws + WS_ASORT) + (size_t)t0 * 256 * 1024, (const pb*)(ws + WS_WXGU), 0, 0, 1024, 1024, 1024}; pg8::MoeOrder S; S.init(ntl, 28, F.G, bid, (const int*)(ws + WS_META + META_TEXP), t0); \
        pg8::EpiSwiGLU E{(pb*)(ws + WS_HIDX), DFX, 28}; \
        pg8::gemm_phase<pg8::EpiSwiGLU, pg8::MoeOrder, PG8_ALIGN, PG8_SP2>(F.lds + RING_OFF, g, S, E); \
        if ((t0_) == 0 && ntl > 0) { const int nu = ntl * 28, remu = nu % F.G, first = remu ? remu : 0, ns = F.G - first;     \
            const int esp = ((const int*)(ws + WS_META + META_TEXP))[ntl - 1]; \
            if (bid >= first) { __syncthreads(); px_expert_down(F, (bid - first) * NWAVES + F.wave, ns * NWAVES, 0, esp + 1); } } } SEAM(kgu); \
    if (IN(kdn)) for (int rep_ = 0; rep_ < REPS(kdn); ++rep_) { REFRESH(); int base[8], ntiles; moe_bases(F, base, ntiles); const int t0 = (t0_), ntl = (ntiles - t0 < 0) ? 0 : ((ntiles - t0 < (cap_)) ? ntiles - t0 : (cap_)); \
        const int full = ntl < 64 ? ntl : 64, ex = ntl - full; \
        { pg8::Gemm g{(const pb*)(ws + WS_HIDX), (const pb*)(ws + WS_WXDN), 0, 0, DFX, DFX, DFX}; pg8::MoeOrder S; S.init(full, 4, F.G, bid, (const int*)(ws + WS_META + META_TEXP), t0); \
          pg8::EpiStore E{(pb*)(ws + WS_ASORT) + (size_t)t0 * 256 * 1024, 1024, 4}; \
          pg8::gemm_phase<pg8::EpiStore, pg8::MoeOrder, PG8_ALIGN, PG8_SP2>(F.lds + RING_OFF, g, S, E); } \
        if (ex > 0) { __syncthreads(); \
          pg8::Gemm g{(const pb*)(ws + WS_HIDX), (const pb*)(ws + WS_WXDN), 0, 0, MOE_KSL, DFX, DFX}; pg8::MoeSplitOrder S; S.init(ex, DFX / MOE_KSL, MOE_KSL, F.G, bid, (const int*)(ws + WS_META + META_TEXP), t0); \
          pg8::EpiMoePart E{(float*)(ws + ((t0_) ? WS_WXGU : WS_FIN2)), MOE_KSL}; \
          pg8::gemm_phase<pg8::EpiMoePart, pg8::MoeSplitOrder, PG8_ALIGN, PG8_SP2>(F.lds + RING_OFF, g, S, E); } \
        if ((t0_) == 0 && ntl > 0) { const int nsu = ex * 4 * (DFX / MOE_KSL), first = nsu < F.G ? nsu : 0, ns = F.G - first;     \
            const int esp = ((const int*)(ws + WS_META + META_TEXP))[ntl - 1]; \
            if (bid >= first && esp + 1 < NEXP) { __syncthreads(); px_expert_down(F, (bid - first) * NWAVES + F.wave, ns * NWAVES, esp + 1, NEXP); } } } SEAM(kdn);
    MOE_PART(21, 22, 0, 68)
    MOE_PART(23, 24, 68, 68)
    if (IN(25)) for (int rep_ = 0; rep_ < REPS(25); ++rep_) { REFRESH(); rows_final(F);
#if defined(CHK_G1) || defined(CHK_SCAN)
        { const unsigned fb = __hip_atomic_load((unsigned*)(F.ctl + CW_CHK), RLX_AGENT) & CHK_MASK; if (fb != 0u) { VM_WAIT(); __syncthreads(); for (int i = F.gw * 64 + F.lane; i < NB * T * D; i += F.NGW * 64) F.out[i] = 0.f; } }
#endif
    }
#ifdef PROBE_PHASE
    STAMP(26);
    if (blockIdx.x == 0 && F.tid == 0) {
        const unsigned long long t0 = ((unsigned long long)F.MISC[65 + 2 * PROBE_PHASE] << 32) | F.MISC[64 + 2 * PROBE_PHASE], t1 = ((unsigned long long)F.MISC[65 + 2 * (PROBE_PHASE + PROBE_SPAN)] << 32) | F.MISC[64 + 2 * (PROBE_PHASE + PROBE_SPAN)];
        unsigned long long dly = (t1 - t0) * PROBE_MULT; if (dly > 2000000ull) dly = 2000000ull; const unsigned long long s0 = __builtin_amdgcn_s_memrealtime();
        while (__builtin_amdgcn_s_memrealtime() - s0 < dly) __builtin_amdgcn_s_sleep(8); }
#endif
#undef IN
#undef SEAM
}

extern "C" void kernel_launch(void* const* d_in, const int* in_sizes, int n_in, void* d_out, int out_size, void* d_ws, size_t ws_size, hipStream_t stream) {
    static int grid = 0;
    if (grid == 0) {
        if (n_in != 32 || in_sizes[0] != NB * T * D || out_size != NB * T * D || ws_size < WS_END) { fprintf(stderr, "kernel_launch: unexpected shapes: n_in %d in0 %d out %d ws %zu (need %zu)\n", n_in, n_in > 0 ? in_sizes[0] : -1, out_size, ws_size, (size_t)WS_END); grid = -1; return; }
        int dev = 0, cus = 0, per_cu = 0;
        if (hipGetDevice(&dev) != hipSuccess || hipDeviceGetAttribute(&cus, hipDeviceAttributeMultiprocessorCount, dev) != hipSuccess) { grid = -1; return; }
        if (hipFuncSetAttribute((const void*)trunk_fwd, hipFuncAttributeMaxDynamicSharedMemorySize, LDS_BYTES) != hipSuccess) { fprintf(stderr, "kernel_launch: hipFuncSetAttribute failed\n"); grid = -1; return; }
        if (hipOccupancyMaxActiveBlocksPerMultiprocessor(&per_cu, (const void*)trunk_fwd, NWAVES * 64, LDS_BYTES) != hipSuccess || per_cu < 1) fprintf(stderr, "kernel_launch: occupancy query reports %d\n", per_cu);
        (void)hipGetLastError();
        grid = cus;
    }
    if (grid < 0) return;
    if (hipMemsetAsync((char*)d_ws + WS_CTL, 0, CTL_ZERO_BYTES, stream) != hipSuccess) return;
#ifdef DIAG_POISON
    (void)hipMemsetAsync((char*)d_ws + WS_GDNI, 0xFF, (size_t)64 * 68 * 32768, stream);
    (void)hipMemsetAsync((char*)d_ws + WS_OG, 0xFF, (size_t)NR * 1024 * 2, stream);
    (void)hipMemsetAsync((char*)d_ws + WS_QKVN, 0xFF, (size_t)NR * 1536 * 2, stream);
    (void)hipMemsetAsync((char*)d_ws + WS_GB, 0xFF, (size_t)NR * 32 * 4, stream);
#endif
    Args a{};
    for (int i = 0; i < 32; ++i) a.in[i] = (const float*)d_in[i];
    a.out = (float*)d_out; a.ws = (unsigned char*)d_ws;
#if MK_N_LAUNCHES == 1
    a.ph_lo = 0; a.ph_hi = N_PHASES;
    hipLaunchKernelGGL(trunk_fwd, dim3(grid), dim3(NWAVES * 64), LDS_BYTES, stream, a);
#else
    for (int p = 0; p < N_PHASES && p <= MK_LAST_PHASE; ++p) { a.ph_lo = p; a.ph_hi = p + 1; hipLaunchKernelGGL(trunk_fwd, dim3(grid), dim3(NWAVES * 64), LDS_BYTES, stream, a); }
#endif
    const hipError_t le = hipPeekAtLastError();
    if (le != hipSuccess) fprintf(stderr, "kernel_launch: launch failed: %s\n", hipGetErrorName(le));
}
```

```cpp
#include <hip/hip_runtime.h>
#include <cstdio>
#include <cstdint>
#include <cmath>

#ifndef MK_N_LAUNCHES
#define MK_N_LAUNCHES 1
#endif
#define SOLVE_C_FMA 1
#define SOLVE_C_LOAD 1
#ifndef G1_LOCK
#define G1_LOCK 0
#ifndef SCAN_PF
#define SCAN_PF 8
#endif
#ifndef SCAN_UNROLL
#define SCAN_UNROLL 1
#endif
#ifndef MOE_KSL
#define MOE_KSL 512
#endif
#endif
#ifndef MK_LAST_PHASE
#define MK_LAST_PHASE 99
#endif

constexpr int NB = 4, T = 4096, TC = 256, SROW = T + TC  , NR = NB * SROW  , D = 1024;
constexpr int EIN = 2848, EINP = 3072, OIN = 2208, OINP = 2304, DFF = 2816, DFX = 3584, NEXP = 8;
constexpr float EPS = 1e-6f;
constexpr int E_Q = 0, E_K = 512, E_V = 1024, E_Z = 1536, E_GA = 2048, E_GB = 2064, E_SQ = 2080, E_SK = 2592, E_SV = 2720;
constexpr int O_CQ = 0, O_CKV = 384, O_KR = 640, O_DQ = 672, O_DK = 1184, O_DV = 1696;

constexpr size_t MiB = 1u << 20;
constexpr size_t WS_CTL = 0, CTL_ZERO_BYTES = 1 * MiB;
constexpr size_t WS_MODV = 1 * MiB;
constexpr size_t WS_GB = 2 * MiB;
constexpr size_t WS_META = 5 * MiB;
constexpr size_t WS_HCTX = 8 * MiB;
constexpr size_t WS_WEIN = 12 * MiB, WS_WEOUT = 18 * MiB, WS_WEGU = 20 * MiB, WS_WEDN = 31 * MiB, WS_WOIN = 37 * MiB, WS_WUQ = 42 * MiB, WS_WUKV = 43 * MiB, WS_WOOUT = 44 * MiB;
constexpr size_t WS_BIG = 46 * MiB;
constexpr size_t WS_PROJ = 46 * MiB, WS_QKVN = 148 * MiB;
constexpr size_t WS_PROJ2 = 46 * MiB, WS_QM = 123 * MiB, WS_VMLA = 149 * MiB, WS_KMLA = 167 * MiB, WS_ODIFF = 316 * MiB;
constexpr size_t WS_WXGU = 46 * MiB, WS_WXDN = 158 * MiB;
constexpr size_t WS_CQN = 214 * MiB;
constexpr size_t WS_ABUF = 214 * MiB, WS_MIX = 248 * MiB, WS_YBUF = 282 * MiB;
constexpr size_t WS_OG = 214 * MiB;
constexpr size_t WS_PART = 350 * MiB;
constexpr size_t WS_GDNI = 282 * MiB;
constexpr size_t WS_HID = 46 * MiB;
constexpr size_t WS_ASORT = 214 * MiB;
constexpr size_t WS_FIN2 = 282 * MiB;
constexpr size_t WS_Y2 = 316 * MiB;
constexpr size_t WS_HIDX = 316 * MiB;
constexpr size_t WS_XB = 436 * MiB;
constexpr size_t WS_END = 470 * MiB;
static_assert(WS_QKVN + (size_t)NR * 1536 * 2 <= 214 * MiB && WS_PROJ + (size_t)NR * EINP * 2 <= WS_QKVN, "layer-0 big region");
static_assert(WS_PROJ2 + (size_t)NR * OINP * 2 <= WS_QM && WS_QM + (size_t)NR * 768 * 2 <= WS_VMLA && WS_VMLA + (size_t)NR * 512 * 2 <= WS_KMLA && WS_KMLA + (size_t)NR * 768 * 2 <= 214 * MiB, "layer-1 big region");
static_assert(WS_WXGU + (size_t)NEXP * 7168 * 1024 * 2 <= WS_WXDN && WS_WXDN + (size_t)NEXP * 1024 * 3584 * 2 <= 214 * MiB, "expert weights");
static_assert(WS_HIDX + (size_t)17408 * 3584 * 2 <= WS_END && WS_ASORT + (size_t)34816 * 1024 * 2 <= WS_FIN2 && WS_HID + (size_t)NR * DFF * 2 <= 214 * MiB, "moe map");
constexpr size_t META_TOPI = 0, META_TOPW = 128 * 1024, META_RANK = 256 * 1024, META_RSTD = 384 * 1024, META_BLKB = 960 * 1024;
constexpr int CW_TMO = 0, CW_CODE = 1;
constexpr int CW_MOECNT = 64;
constexpr int CW_SWAQ = 2048;
constexpr int CW_CHK = 1024;
constexpr int CW_BAR = 4096;
constexpr int RING_OFF = 0, RING_BYTES = 141312;
constexpr int MISC_OFF = RING_BYTES;
constexpr int LDS_BYTES = 147456;
constexpr int NWAVES = 8;
namespace pg8 {
#define PG8_LAS __attribute__((address_space(3)))
typedef unsigned short bf16_t;
typedef short bf16x8 __attribute__((ext_vector_type(8)));
typedef float f32x4 __attribute__((ext_vector_type(4)));
typedef unsigned u32x4 __attribute__((ext_vector_type(4)));
constexpr int BM = 256, BK = 64, HALF = 128, HTB = HALF * BK * 2  , STAGE_BYTES = 8 * HTB, NXCD = 8, WGM = 8;

__host__ __device__ __forceinline__ int lds_byte(int r, int c) { const int st = (r >> 4) * 2 + (c >> 5), rr = r & 15, cc = c & 31, ob = rr * 64 + cc * 2; return st * 1024 + (ob ^ (((ob >> 9) & 1) << 5)); }
__host__ __device__ __forceinline__ void stage_rc(int b, int& R, int& C) { const int st = b / 1024, sb = b % 1024, swz = sb ^ (((sb >> 9) & 1) << 5); R = (st >> 1) * 16 + swz / 64; C = (st & 1) * 32 + (swz % 64) / 2; }
__host__ __device__ __forceinline__ int perm32(int rho) { const int n = rho >> 4, i = rho & 15; return 8 * (i >> 2) + 4 * n + (i & 3); }

struct Unit { int pm, pn, kof; };
struct Gemm { const bf16_t* A; const bf16_t* Bt; int M, N, K, lda, ldb; };

struct StaticOrder {
    int nM, nN, nwg, G, c;
    __host__ __device__ void init(int M, int N, int G_, int c_) { nM = M / BM; nN = N / BM; nwg = nM * nN; G = G_; c = c_; }
    __host__ __device__ bool next(int i, Unit& u) const {
        const long L = (long)i * G + c; if (L >= nwg) return false;
        int wgid = (int)L; { const int q = nwg / NXCD, r = nwg % NXCD, xcd = wgid % NXCD, off = wgid / NXCD; wgid = (xcd < r ? xcd * (q + 1) : r * (q + 1) + (xcd - r) * q) + off; }
        const int nig = WGM * nN, gid = wgid / nig, fm = gid * WGM, gsz = (nM - fm) < WGM ? (nM - fm) : WGM;
        u.pm = fm + ((wgid % nig) % gsz); u.pn = (wgid % nig) / gsz; u.kof = 0; return true;
    }
    __device__ __forceinline__ void a_ready(const Unit&) const {}
    __device__ __forceinline__ void done(const Unit&) const {}
};

__device__ __forceinline__ unsigned cvt_pk_bf16(float lo, float hi) { unsigned r; asm volatile("v_cvt_pk_bf16_f32 %0, %1, %2" : "=v"(r) : "v"(lo), "v"(hi)); return r; }
typedef float f32x2 __attribute__((ext_vector_type(2)));
template <class Epi, class Sched, bool ALIGN_EPI = false, bool SP2 = false>
__device__ __forceinline__ void gemm_phase(PG8_LAS unsigned char* lds, const Gemm g, const Sched& S, const Epi& E) {
    const int tid = threadIdx.x, wid = __builtin_amdgcn_readfirstlane(tid >> 6), lane = tid & 63, wr = wid >> 2, wc = wid & 3, fr = lane & 15, fq = lane >> 4;
    const int K = g.K, nt = K / BK;
    unsigned voffA[2], voffB[2];
#pragma unroll
    for (int i = 0; i < 2; ++i) { int R, C; stage_rc(tid * 16 + i * 8192, R, C); const int Rb = Epi::PERM ? ((R & ~31) + perm32(R & 31)) : R;
        voffA[i] = (unsigned)(R * g.lda + C) * 2u; voffB[i] = (unsigned)(Rb * g.ldb + C) * 2u; }
    const size_t kstep = (size_t)(BK * 2);
    const size_t hstepA = (size_t)HALF * g.lda * 2, hstepB = (size_t)HALF * g.ldb * 2;
    const size_t tstepA = 2 * hstepA, tstepB = 2 * hstepB;
    const unsigned ldsw = (unsigned)wid * 1024u;
    const int aoff = lds_byte(wr * 64 + fr, fq * 8), boff = lds_byte(wc * 32 + fr, fq * 8);
#define PG8_SA(b, h) (((b) * 2 + (h)) * HTB)
#define PG8_SB(b, h) ((4 + (b) * 2 + (h)) * HTB)
#define PG8_STAGE(bufoff, gbase, voff) do { _Pragma("unroll") for (int _i = 0; _i < 2; ++_i) \
        __builtin_amdgcn_global_load_lds((const unsigned*)((const char*)(gbase) + (voff)[_i]), (PG8_LAS unsigned*)(lds + (bufoff) + ldsw + _i * 8192), 16, 0, 0); } while (0)
#define PG8_LDA(dst, b, h) do { _Pragma("unroll") for (int m = 0; m < 4; ++m) _Pragma("unroll") for (int k = 0; k < 2; ++k) dst[m][k] = *(const PG8_LAS bf16x8*)(lds + PG8_SA(b, h) + aoff + m * 2048 + k * 1024); } while (0)
#define PG8_LDB(dst, b, h) do { _Pragma("unroll") for (int n = 0; n < 2; ++n) _Pragma("unroll") for (int k = 0; k < 2; ++k) dst[n][k] = *(const PG8_LAS bf16x8*)(lds + PG8_SB(b, h) + boff + n * 2048 + k * 1024); } while (0)
#define PG8_MMA(ai, bj, At, Bt) do { __builtin_amdgcn_s_setprio(1); _Pragma("unroll") for (int m = 0; m < 4; ++m) _Pragma("unroll") for (int n = 0; n < 2; ++n) _Pragma("unroll") for (int k = 0; k < 2; ++k) \
        acc[ai][bj][m][n] = __builtin_amdgcn_mfma_f32_16x16x32_bf16(Bt[n][k], At[m][k], acc[ai][bj][m][n], 0, 0, 0); __builtin_amdgcn_s_setprio(0); } while (0)
#define PG8_WAIT_V(n) asm volatile("s_waitcnt vmcnt(" #n ")" ::: "memory")
#define PG8_WAIT_L(n) asm volatile("s_waitcnt lgkmcnt(" #n ")" ::: "memory")
#define PG8_BAR __builtin_amdgcn_s_barrier()
#define PG8_SCHED __builtin_amdgcn_sched_barrier(0)
    Unit cur, nxt; int ui = 0;
    if (!S.next(0, cur)) return;
    f32x4 acc[2][2][4][2];
#pragma unroll
    for (int a = 0; a < 2; ++a)
#pragma unroll
        for (int b = 0; b < 2; ++b)
#pragma unroll
            for (int m = 0; m < 4; ++m)
#pragma unroll
                for (int n = 0; n < 2; ++n) acc[a][b][m][n] = (f32x4){0.f, 0.f, 0.f, 0.f};
    bf16x8 At[4][2], B0[2][2], B1[2][2];
    const char* cA = (const char*)g.A + (size_t)cur.pm * tstepA + (size_t)cur.kof * 2; const char* cB = (const char*)g.Bt + (size_t)cur.pn * tstepB + (size_t)cur.kof * 2;
    S.a_ready(cur);
    if constexpr (SP2) {
        PG8_STAGE(PG8_SB(0, 0), cB, voffB); PG8_STAGE(PG8_SB(0, 1), cB + hstepB, voffB); PG8_STAGE(PG8_SA(0, 0), cA, voffA); PG8_STAGE(PG8_SA(0, 1), cA + hstepA, voffA);
        if (wr == 1) PG8_BAR;
        PG8_WAIT_V(2); PG8_BAR;
        PG8_STAGE(PG8_SB(1, 0), cB + kstep, voffB); PG8_STAGE(PG8_SA(1, 0), cA + kstep, voffA); PG8_STAGE(PG8_SB(1, 1), cB + hstepB + kstep, voffB);
        PG8_WAIT_V(6); PG8_BAR;
    } else {
        PG8_STAGE(PG8_SB(0, 0), cB, voffB); PG8_STAGE(PG8_SA(0, 0), cA, voffA); PG8_STAGE(PG8_SB(0, 1), cB + hstepB, voffB); PG8_STAGE(PG8_SA(0, 1), cA + hstepA, voffA);
        if (wr == 1) PG8_BAR;
        PG8_WAIT_V(4); PG8_BAR;
        PG8_STAGE(PG8_SB(1, 0), cB + kstep, voffB); PG8_STAGE(PG8_SA(1, 0), cA + kstep, voffA); PG8_STAGE(PG8_SB(1, 1), cB + hstepB + kstep, voffB);
        PG8_WAIT_V(6); PG8_BAR;
    }
    for (;;) {
        const bool has_next = S.next(ui + 1, nxt);
        const char* nA = has_next ? (const char*)g.A + (size_t)nxt.pm * tstepA + (size_t)nxt.kof * 2 : cA; const char* nB = has_next ? (const char*)g.Bt + (size_t)nxt.pn * tstepB + (size_t)nxt.kof * 2 : cB;
        _Pragma("unroll 1") for (int t = 0; t < nt; t += 2) {
            const bool last = (t == nt - 2);
            const char* a1 = cA + (size_t)(t + 1) * kstep;
            const char* a2 = last ? nA : cA + (size_t)(t + 2) * kstep; const char* b2 = last ? nB : cB + (size_t)(t + 2) * kstep;
            const char* a3 = a2 + kstep; const char* b3 = b2 + kstep;
            if (last && has_next) S.a_ready(nxt);
            if constexpr (SP2) {
            PG8_LDB(B0, 0, 0); PG8_LDB(B1, 0, 1); PG8_SCHED; PG8_LDA(At, 0, 0); PG8_STAGE(PG8_SA(1, 1), a1 + hstepA, voffA);
            PG8_WAIT_V(8); PG8_WAIT_L(0); PG8_BAR; PG8_MMA(0, 0, At, B0); PG8_MMA(0, 1, At, B1); PG8_BAR; PG8_SCHED;
            PG8_LDA(At, 0, 1); PG8_STAGE(PG8_SB(0, 0), b2, voffB); PG8_STAGE(PG8_SB(0, 1), b2 + hstepB, voffB); PG8_STAGE(PG8_SA(0, 0), a2, voffA);
            PG8_WAIT_V(8); PG8_WAIT_L(0); PG8_BAR; PG8_MMA(1, 0, At, B0); PG8_MMA(1, 1, At, B1); PG8_BAR; PG8_SCHED;
            PG8_LDB(B0, 1, 0); PG8_LDB(B1, 1, 1); PG8_SCHED; PG8_LDA(At, 1, 0); PG8_STAGE(PG8_SA(0, 1), a2 + hstepA, voffA);
            PG8_WAIT_V(8); PG8_WAIT_L(0); PG8_BAR; PG8_MMA(0, 0, At, B0); PG8_MMA(0, 1, At, B1); PG8_BAR; PG8_SCHED;
            PG8_LDA(At, 1, 1); PG8_STAGE(PG8_SB(1, 0), b3, voffB); PG8_STAGE(PG8_SB(1, 1), b3 + hstepB, voffB); PG8_STAGE(PG8_SA(1, 0), a3, voffA);
            PG8_WAIT_V(8); PG8_WAIT_L(0); PG8_BAR; PG8_MMA(1, 0, At, B0); PG8_MMA(1, 1, At, B1); PG8_BAR; PG8_SCHED;
            } else {
            PG8_LDB(B0, 0, 0); PG8_SCHED; PG8_LDA(At, 0, 0); PG8_STAGE(PG8_SA(1, 1), a1 + hstepA, voffA);
            PG8_WAIT_L(8); PG8_BAR; PG8_WAIT_L(0); PG8_MMA(0, 0, At, B0); PG8_BAR; PG8_SCHED;
            PG8_LDB(B1, 0, 1); PG8_STAGE(PG8_SB(0, 0), b2, voffB);
            PG8_BAR; PG8_WAIT_L(0); PG8_MMA(0, 1, At, B1); PG8_BAR;
            PG8_LDA(At, 0, 1); PG8_STAGE(PG8_SA(0, 0), a2, voffA);
            PG8_BAR; PG8_WAIT_L(0); PG8_MMA(1, 0, At, B0); PG8_BAR; PG8_SCHED;
            PG8_STAGE(PG8_SB(0, 1), b2 + hstepB, voffB);
            PG8_WAIT_V(6); PG8_BAR; PG8_MMA(1, 1, At, B1); PG8_BAR;
            PG8_LDB(B0, 1, 0); PG8_SCHED; PG8_LDA(At, 1, 0); PG8_STAGE(PG8_SA(0, 1), a2 + hstepA, voffA);
            PG8_WAIT_L(8); PG8_BAR; PG8_WAIT_L(0); PG8_MMA(0, 0, At, B0); PG8_BAR; PG8_SCHED;
            PG8_LDB(B1, 1, 1); PG8_STAGE(PG8_SB(1, 0), b3, voffB);
            PG8_BAR; PG8_WAIT_L(0); PG8_MMA(0, 1, At, B1); PG8_BAR;
            PG8_LDA(At, 1, 1); PG8_STAGE(PG8_SA(1, 0), a3, voffA);
            PG8_BAR; PG8_WAIT_L(0); PG8_MMA(1, 0, At, B0); PG8_BAR; PG8_SCHED;
            PG8_STAGE(PG8_SB(1, 1), b3 + hstepB, voffB);
            PG8_WAIT_V(6); PG8_BAR; PG8_MMA(1, 1, At, B1); PG8_BAR;
            }
        }
        if constexpr (ALIGN_EPI) { if (wr == 0) PG8_BAR; }
        if constexpr (!Epi::AFTER_DRAIN) { E(acc, cur, wr, wc, fr, fq); S.done(cur); }
        if (!has_next) break;
#pragma unroll
        for (int a = 0; a < 2; ++a)
#pragma unroll
            for (int b = 0; b < 2; ++b)
#pragma unroll
                for (int m = 0; m < 4; ++m)
#pragma unroll
                    for (int n = 0; n < 2; ++n) acc[a][b][m][n] = (f32x4){0.f, 0.f, 0.f, 0.f};
        cur = nxt; cA = nA; cB = nB; ++ui;
        if constexpr (ALIGN_EPI) { if (wr == 1) PG8_BAR; }
    }
    PG8_WAIT_V(0);
    if constexpr (!ALIGN_EPI) { if (wr == 0) PG8_BAR; }
    PG8_BAR;
    if constexpr (Epi::AFTER_DRAIN) { E.fused(acc, cur, wr, wc, fr, fq, lds, wid, lane); S.done(cur); }
#undef PG8_SA
#undef PG8_SB
#undef PG8_STAGE
#undef PG8_LDA
#undef PG8_LDB
#undef PG8_MMA
#undef PG8_WAIT_V
#undef PG8_WAIT_L
#undef PG8_BAR
#undef PG8_SCHED
}
}
namespace pg8 {
struct EpiStore { static constexpr bool PERM = true, AFTER_DRAIN = false;
    bf16_t* O; int ldc; int nN;
    __device__ __forceinline__ void operator()(const f32x4 (&acc)[2][2][4][2], const Unit& u, int wr, int wc, int fr, int fq) const {
        const int row0 = u.pm * BM + wr * 64 + fr, col0 = (u.pn % nN) * BM + wc * 32 + 8 * fq;
#pragma unroll
        for (int ai = 0; ai < 2; ++ai)
#pragma unroll
            for (int m = 0; m < 4; ++m) { const int row = row0 + ai * HALF + m * 16;
                bf16_t* rowp = O + (size_t)row * ldc + col0;
#pragma unroll
                for (int bj = 0; bj < 2; ++bj) { const f32x4 v0 = acc[ai][bj][m][0], v1 = acc[ai][bj][m][1];
                    u32x4 w; w.x = cvt_pk_bf16(v0[0], v0[1]); w.y = cvt_pk_bf16(v0[2], v0[3]); w.z = cvt_pk_bf16(v1[0], v1[1]); w.w = cvt_pk_bf16(v1[2], v1[3]);
                    *(u32x4*)(rowp + bj * HALF) = w; } }
    }
};
struct EpiSwiGLU { static constexpr bool PERM = true, AFTER_DRAIN = false;
    bf16_t* O; int ldc; int nN;
    __device__ __forceinline__ void operator()(const f32x4 (&acc)[2][2][4][2], const Unit& u, int wr, int wc, int fr, int fq) const {
        const int row0 = u.pm * BM + wr * 64 + fr, col0 = (u.pn % nN) * HALF + wc * 32 + 8 * fq;
#pragma unroll
        for (int ai = 0; ai < 2; ++ai)
#pragma unroll
            for (int m = 0; m < 4; ++m) { bf16_t* rowp = O + (size_t)(row0 + ai * HALF + m * 16) * ldc + col0;
                float h[8];
#pragma unroll
                for (int n = 0; n < 2; ++n)
#pragma unroll
                    for (int j = 0; j < 4; ++j) { const float g = acc[ai][0][m][n][j], up = acc[ai][1][m][n][j]; h[n * 4 + j] = g * __builtin_amdgcn_rcpf(1.f + __expf(-g)) * up; }
                u32x4 w; w.x = cvt_pk_bf16(h[0], h[1]); w.y = cvt_pk_bf16(h[2], h[3]); w.z = cvt_pk_bf16(h[4], h[5]); w.w = cvt_pk_bf16(h[6], h[7]);
                *(u32x4*)rowp = w; }
    }
};
struct EpiKV { static constexpr bool PERM = true, AFTER_DRAIN = false;
    bf16_t* KM; bf16_t* VM;
    __device__ __forceinline__ void operator()(const f32x4 (&acc)[2][2][4][2], const Unit& u, int wr, int wc, int fr, int fq) const {
        const int row0 = u.pm * BM + wr * 64 + fr, within = wc * 32 + 8 * fq;
#pragma unroll
        for (int ai = 0; ai < 2; ++ai)
#pragma unroll
            for (int m = 0; m < 4; ++m) { const int row = row0 + ai * HALF + m * 16;
#pragma unroll
                for (int bj = 0; bj < 2; ++bj) { const int h = 2 * u.pn + bj; const f32x4 v0 = acc[ai][bj][m][0], v1 = acc[ai][bj][m][1];
                    u32x4 w; w.x = cvt_pk_bf16(v0[0], v0[1]); w.y = cvt_pk_bf16(v0[2], v0[3]); w.z = cvt_pk_bf16(v1[0], v1[1]); w.w = cvt_pk_bf16(v1[2], v1[3]);
                    bf16_t* p = (within < 64) ? KM + (size_t)row * 768 + h * 96 + within : VM + (size_t)row * 512 + h * 64 + (within - 64);
                    *(u32x4*)p = w; } }
    }
};
struct CtxSplitOrder { int nsl, ksl, G, c;
    __device__ void init(int nsl_, int ksl_, int G_, int c_) { nsl = nsl_; ksl = ksl_; G = G_; c = c_; }
    __device__ bool next(int i, Unit& u) const { const int L = i * G + c; if (L >= 16 * nsl) return false; const int sl = L >> 4, rem = L & 15; u.pm = (rem >> 2) * 17; u.pn = rem & 3; u.kof = sl * ksl; return true; }
    __device__ __forceinline__ void a_ready(const Unit&) const {}
    __device__ __forceinline__ void done(const Unit&) const {}
};
struct EpiPartF32 { static constexpr bool PERM = false, AFTER_DRAIN = false;
    float* P; int ksl;
    __device__ __forceinline__ void operator()(const f32x4 (&acc)[2][2][4][2], const Unit& u, int wr, int wc, int fr, int fq) const {
        float* base = P + ((size_t)(u.kof / ksl) * 1024 + (size_t)(u.pm / 17) * 256) * 1024; const int row0 = wr * 64 + fr, col0 = u.pn * BM + wc * 32 + 4 * fq;
#pragma unroll
        for (int ai = 0; ai < 2; ++ai)
#pragma unroll
            for (int m = 0; m < 4; ++m) { float* rowp = base + (size_t)(row0 + ai * HALF + m * 16) * 1024 + col0;
#pragma unroll
                for (int bj = 0; bj < 2; ++bj)
#pragma unroll
                    for (int n = 0; n < 2; ++n) *(f32x4*)(rowp + bj * HALF + n * 16) = acc[ai][bj][m][n]; }
    }
};
struct LatOrder { StaticOrder so;
    __device__ void init(int N, int G, int c) { so.nM = 64; so.nN = N / BM; so.nwg = 64 * so.nN; so.G = G; so.c = c; }
    __device__ bool next(int i, Unit& u) const { if (!so.next(i, u)) return false; u.pm = (u.pm >> 4) * 17 + 1 + (u.pm & 15); return true; }
    __device__ __forceinline__ void a_ready(const Unit&) const {}
    __device__ __forceinline__ void done(const Unit&) const {}
};
struct MoeOrder { StaticOrder so; const int* texp; int t0, nNe;
    __device__ void init(int ntiles, int nNe_, int G, int c, const int* texp_, int t0_) { so.nM = ntiles; so.nN = nNe_; so.nwg = ntiles * nNe_; so.G = G; so.c = c; texp = texp_; t0 = t0_; nNe = nNe_; }
    __device__ bool next(int i, Unit& u) const { if (!so.next(i, u)) return false; const int e = __builtin_amdgcn_readfirstlane(texp[t0 + u.pm]); u.pn = e * nNe + u.pn; return true; }
    __device__ __forceinline__ void a_ready(const Unit&) const {}
    __device__ __forceinline__ void done(const Unit&) const {}
};
struct MoeSplitOrder { int ex4, nsl, ksl, G, c, t0; const int* texp;
    __device__ void init(int ex, int nsl_, int ksl_, int G_, int c_, const int* texp_, int t0_) { ex4 = ex * 4; nsl = nsl_; ksl = ksl_; G = G_; c = c_; texp = texp_; t0 = t0_; }
    __device__ bool next(int i, Unit& u) const { const int L = i * G + c; if (L >= ex4 * nsl) return false; const int sl = L / ex4, rem = L - sl * ex4; u.pm = 64 + (rem >> 2);
        const int e = __builtin_amdgcn_readfirstlane(texp[t0 + u.pm]); u.pn = e * 4 + (rem & 3); u.kof = sl * ksl; return true; }
    __device__ __forceinline__ void a_ready(const Unit&) const {}
    __device__ __forceinline__ void done(const Unit&) const {}
};
struct EpiMoePart { static constexpr bool PERM = false, AFTER_DRAIN = false;
    float* P; int ksl;
    __device__ __forceinline__ void operator()(const f32x4 (&acc)[2][2][4][2], const Unit& u, int wr, int wc, int fr, int fq) const {
        float* base = P + ((size_t)(u.kof / ksl) * 4 + (size_t)(u.pm - 64)) * 256 * 1024; const int row0 = wr * 64 + fr, col0 = (u.pn & 3) * BM + wc * 32 + 4 * fq;
#pragma unroll
        for (int ai = 0; ai < 2; ++ai)
#pragma unroll
            for (int m = 0; m < 4; ++m) { float* rowp = base + (size_t)(row0 + ai * HALF + m * 16) * 1024 + col0;
#pragma unroll
                for (int bj = 0; bj < 2; ++bj)
#pragma unroll
                    for (int n = 0; n < 2; ++n) *(f32x4*)(rowp + bj * HALF + n * 16) = acc[ai][bj][m][n]; }
    }
};
}
#define PG8_SP2 true
#define PG8_ALIGN true
#define GAS __attribute__((address_space(1)))
#define LAS __attribute__((address_space(3)))
typedef unsigned short bf16;
typedef unsigned v4u __attribute__((ext_vector_type(4)));
typedef unsigned v2u __attribute__((ext_vector_type(2)));
typedef float f32x4 __attribute__((ext_vector_type(4)));
typedef short bf16x8 __attribute__((ext_vector_type(8)));
typedef GAS unsigned gu32;
#define RLX_AGENT __ATOMIC_RELAXED, __HIP_MEMORY_SCOPE_AGENT
#define LDS_WAIT() asm volatile("s_waitcnt lgkmcnt(0)" ::: "memory")
#define VM_WAIT() asm volatile("s_waitcnt vmcnt(0)" ::: "memory")
__device__ __forceinline__ unsigned f2bf(float f) { unsigned u = __builtin_bit_cast(unsigned, f); return (u + 0x7fffu + ((u >> 16) & 1u)) >> 16; }
__device__ __forceinline__ unsigned pk2(float lo, float hi) { return f2bf(lo) | (f2bf(hi) << 16); }
__device__ __forceinline__ float bf2f(unsigned short b) { return __builtin_bit_cast(float, ((unsigned)b) << 16); }
__device__ __forceinline__ float bflo(unsigned w) { return __builtin_bit_cast(float, w << 16); }
__device__ __forceinline__ float bfhi(unsigned w) { return __builtin_bit_cast(float, w & 0xffff0000u); }
__device__ __forceinline__ float wave_sum(float v) {
#pragma unroll
    for (int o = 1; o < 64; o <<= 1) v += __shfl_xor(v, o);
    return v;
}
__device__ __forceinline__ float siluf(float x) { return x / (1.f + __expf(-x)); }
#define XB_TMO      128
#define XB_XCNT(j)  (256  + 64 * (j))
#define XB_XSUB(j)  (1280 + 64 * (j))
#define XB_XGEN(j)  (2304 + 64 * (j))
#define XB_TOP      3328
#define XB_TOPGEN   3392
#define XCD_BAR_WORDS 3456
#define XB_SPIN_CAP (1u << 18)

__device__ __forceinline__ unsigned xb_ld(unsigned* p)              { return __hip_atomic_load(p, __ATOMIC_RELAXED, __HIP_MEMORY_SCOPE_AGENT); }
__device__ __forceinline__ unsigned xb_add(unsigned* p, unsigned v) { return __hip_atomic_fetch_add(p, v, __ATOMIC_RELAXED, __HIP_MEMORY_SCOPE_AGENT); }
__device__ __forceinline__ unsigned xb_xcc_id() { return (unsigned)__builtin_amdgcn_s_getreg((3 << 11) | 20) & 0xFu; }
#define XB_SPIN(cond, bar) do { unsigned _sp = 0; while (cond) { __builtin_amdgcn_s_sleep(1); \
    if ((++_sp & 255u) == 0u) { if (xb_ld(&(bar)[XB_TMO])) break; if (_sp > XB_SPIN_CAP) { atomicAdd(&(bar)[XB_TMO], 1u); break; } } } } while (0)

struct XcdBarrier {
    unsigned* bar; unsigned x;
    volatile LAS unsigned* st;
};

__device__ __forceinline__ XcdBarrier xcd_barrier_post(unsigned* bar, volatile LAS unsigned* st) {
    XcdBarrier b; b.bar = bar; b.x = xb_xcc_id(); b.st = st;
    if (threadIdx.x == 0) (void)xb_add(&bar[XB_XCNT(b.x)], 1u);
    return b;
}
__device__ __forceinline__ void xcd_barrier_complete(unsigned* bar, unsigned x, unsigned& nloc, unsigned& nx) {
    const unsigned G = gridDim.x * gridDim.y * gridDim.z;
    unsigned sum, cnt, mine, sp = 0u;
    for (;;) {
        sum = 0u; cnt = 0u; mine = 0u;
#pragma unroll
        for (unsigned j = 0; j < 16; ++j) { const unsigned c = xb_ld(&bar[XB_XCNT(j)]); sum += c; cnt += (c > 0u) ? 1u : 0u; mine = (j == x) ? c : mine; }
        if (sum == G) break;
        __builtin_amdgcn_s_sleep(1);
        if ((++sp & 255u) == 0u) { if (xb_ld(&bar[XB_TMO])) break; if (sp > XB_SPIN_CAP) { atomicAdd(&bar[XB_TMO], 1u); break; } }
    }
    nloc = mine > 0u ? mine : 1u; nx = cnt > 0u ? cnt : 1u;
}

__device__ __forceinline__ void xcd_barrier(const XcdBarrier& b) {
    asm volatile("s_waitcnt vmcnt(0)" ::: "memory");
    __syncthreads();
    if (threadIdx.x == 0) {
        unsigned* bar = b.bar;
        __builtin_amdgcn_s_waitcnt(0);
        unsigned nloc = b.st[0], nx = b.st[1];
        if (nloc == 0u) { xcd_barrier_complete(bar, b.x, nloc, nx); b.st[0] = nloc; b.st[1] = nx; }
        const unsigned old = xb_add(&bar[XB_XSUB(b.x)], 1u);
        const unsigned gen = old / nloc;
        if (old + 1u == (gen + 1u) * nloc) {
            __builtin_amdgcn_fence(__ATOMIC_RELEASE, "agent");
            asm volatile("s_waitcnt vmcnt(0)" ::: "memory");
            const unsigned og = xb_add(&bar[XB_TOP], 1u);
            const unsigned tg = og / nx;
            if (og + 1u == (tg + 1u) * nx) xb_add(&bar[XB_TOPGEN], 1u);
            else XB_SPIN(xb_ld(&bar[XB_TOPGEN]) == tg, bar);
            __builtin_amdgcn_fence(__ATOMIC_ACQUIRE, "agent");
            xb_add(&bar[XB_XGEN(b.x)], 1u);
            asm volatile("s_waitcnt vmcnt(0)" ::: "memory");
        } else {
            XB_SPIN(xb_ld(&bar[XB_XGEN(b.x)]) == gen, bar);
            __builtin_amdgcn_fence(__ATOMIC_ACQUIRE, "agent");
            asm volatile("s_waitcnt vmcnt(0)" ::: "memory");
        }
    }
    __syncthreads();
}
namespace att {
using bf16x8 = __attribute__((ext_vector_type(8))) short;
using s16x4  = __attribute__((ext_vector_type(4))) short;
using f32x16 = __attribute__((ext_vector_type(16))) float;
using u32x4  = __attribute__((ext_vector_type(4))) unsigned;
constexpr int NW = 8, QBLK = 32, KVBLK = 64;
constexpr size_t SHM_V = KVBLK * 128 * 2, SHM_K = KVBLK * 128 * 2, SHM_ATTN = 2 * SHM_V + 2 * SHM_K + NW * 64 * 4;
constexpr float THR = 8.f;
#define KSWZ(row, colB) ((row) * 256 + ((colB) ^ (((row) & 7) << 4)))
#define SBAR() __builtin_amdgcn_sched_barrier(0)
__device__ __forceinline__ int crow(int r, int hi) { return (r & 3) + 8 * (r >> 2) + 4 * hi; }
__device__ __forceinline__ unsigned cvtpk(float lo, float hi) { unsigned r; asm volatile("v_cvt_pk_bf16_f32 %0, %1, %2" : "=v"(r) : "v"(lo), "v"(hi)); return r; }
__device__ __forceinline__ void partialSM(f32x16& p0, f32x16& p1, float& m_reg, float& mn, float& alpha, float C, float thr_s) {
  float pmax = p0[0];
#pragma unroll
  for (int r = 1; r < 16; ++r) pmax = fmaxf(pmax, p0[r]);
#pragma unroll
  for (int r = 0; r < 16; ++r) pmax = fmaxf(pmax, p1[r]);
  { auto rr = __builtin_amdgcn_permlane32_swap(__float_as_uint(pmax), __float_as_uint(pmax), false, false);
    pmax = fmaxf(__uint_as_float(rr[0]), __uint_as_float(rr[1])); }
  if (__builtin_expect(__all(pmax - m_reg <= thr_s), 1)) { mn = m_reg; alpha = 1.f; }
  else { mn = fmaxf(m_reg, pmax); alpha = __builtin_amdgcn_exp2f((m_reg - mn) * C); m_reg = mn; }
  const float mnC = -mn * C;
#pragma unroll
  for (int r = 0; r < 16; ++r) p0[r] = fmaf(p0[r], C, mnC);
#pragma unroll
  for (int r = 0; r < 16; ++r) p1[r] = fmaf(p1[r], C, mnC);
#pragma unroll
  for (int r = 0; r < 16; ++r) p0[r] = __builtin_amdgcn_exp2f(p0[r]);
}
__device__ __forceinline__ void finishSM(f32x16& p0, f32x16& p1, float alpha, float& l_reg, bf16x8& pa0, bf16x8& pa1, bf16x8& pa2, bf16x8& pa3) {
#pragma unroll
  for (int r = 0; r < 16; ++r) p1[r] = __builtin_amdgcn_exp2f(p1[r]);
  float ps = 0;
#pragma unroll
  for (int r = 0; r < 16; ++r) ps += p0[r];
#pragma unroll
  for (int r = 0; r < 16; ++r) ps += p1[r];
  { auto rr = __builtin_amdgcn_permlane32_swap(__float_as_uint(ps), __float_as_uint(ps), false, false);
    ps = __uint_as_float(rr[0]) + __uint_as_float(rr[1]); }
  l_reg = l_reg * alpha + ps;
#define PK4(P, BASE, OUT) do { unsigned a0 = cvtpk(P[BASE + 0], P[BASE + 1]), a1 = cvtpk(P[BASE + 2], P[BASE + 3]);   \
    unsigned b0 = cvtpk(P[BASE + 4], P[BASE + 5]), b1 = cvtpk(P[BASE + 6], P[BASE + 7]);                              \
    auto r0 = __builtin_amdgcn_permlane32_swap(a0, b0, false, false); auto r1 = __builtin_amdgcn_permlane32_swap(a1, b1, false, false); \
    u32x4 w = {r0[0], r1[0], r0[1], r1[1]}; OUT = *reinterpret_cast<bf16x8*>(&w); } while (0)
  PK4(p0, 0, pa0); PK4(p0, 8, pa1); PK4(p1, 0, pa2); PK4(p1, 8, pa3);
#undef PK4
}
template <int DQK> __device__ __forceinline__ void qkt(f32x16& p0, f32x16& p1, const char* Ks, const bf16x8* qr, int r32, int hi) {
  p0 = f32x16{}; p1 = f32x16{};
#pragma unroll
  for (int d0 = 0; d0 < DQK / 16; ++d0) { const int cb = (d0 * 16 + hi * 8) * 2;
    const bf16x8 b0 = *reinterpret_cast<const bf16x8*>(Ks + KSWZ(r32, cb));
    const bf16x8 b1 = *reinterpret_cast<const bf16x8*>(Ks + KSWZ(32 + r32, cb));
    p0 = __builtin_amdgcn_mfma_f32_32x32x16_bf16(b0, qr[d0], p0, 0, 0, 0);
    p1 = __builtin_amdgcn_mfma_f32_32x32x16_bf16(b1, qr[d0], p1, 0, 0, 0); }
}
__device__ __forceinline__ int v_st(int k, int c) { const int kk = (k & ~0xC) | ((k & 4) << 1) | ((k & 8) >> 1); return ((kk >> 3) * 4 + (c >> 5)) * 512 + ((kk & 7) * 32 + (c & 31)) * 2; }
__device__ __forceinline__ int v_rd_base(int lane) { return ((lane & 3) << 3) | (((lane >> 2) & 3) << 6) | (((lane >> 4) & 1) << 5) | (((lane >> 5) & 1) << 8); }
constexpr int v_rd_off(int d0, int ks, int half) { return d0 * 512 + ks * 4096 + half * 2048; }
template <int OFF> __device__ __forceinline__ s16x4 tr_read(int vb) {
  s16x4 r; asm volatile("ds_read_b64_tr_b16 %0, %1 offset:%2" : "=&v"(r) : "v"(vb), "i"(OFF) : "memory"); return r;
}
template <int D0> __device__ __forceinline__ void pv_one(f32x16& od, int vb, bf16x8 pa0, bf16x8 pa1, bf16x8 pa2, bf16x8 pa3) {
  const s16x4 l0 = tr_read<v_rd_off(D0, 0, 0)>(vb), h0 = tr_read<v_rd_off(D0, 0, 1)>(vb), l1 = tr_read<v_rd_off(D0, 1, 0)>(vb), h1 = tr_read<v_rd_off(D0, 1, 1)>(vb);
  const s16x4 l2 = tr_read<v_rd_off(D0, 2, 0)>(vb), h2 = tr_read<v_rd_off(D0, 2, 1)>(vb), l3 = tr_read<v_rd_off(D0, 3, 0)>(vb), h3 = tr_read<v_rd_off(D0, 3, 1)>(vb);
  asm volatile("s_waitcnt lgkmcnt(0)" ::: "memory"); SBAR();
#define PK(L, H) (bf16x8){L[0], L[1], L[2], L[3], H[0], H[1], H[2], H[3]}
  od = __builtin_amdgcn_mfma_f32_32x32x16_bf16(pa0, PK(l0, h0), od, 0, 0, 0);
  od = __builtin_amdgcn_mfma_f32_32x32x16_bf16(pa1, PK(l1, h1), od, 0, 0, 0);
  od = __builtin_amdgcn_mfma_f32_32x32x16_bf16(pa2, PK(l2, h2), od, 0, 0, 0);
  od = __builtin_amdgcn_mfma_f32_32x32x16_bf16(pa3, PK(l3, h3), od, 0, 0, 0);
#undef PK
}
template <int DV> __device__ __forceinline__ void pv_all(f32x16* o, int vb, bf16x8 pa0, bf16x8 pa1, bf16x8 pa2, bf16x8 pa3) {
  pv_one<0>(o[0], vb, pa0, pa1, pa2, pa3); pv_one<1>(o[1], vb, pa0, pa1, pa2, pa3);
  if constexpr (DV > 64) { pv_one<2>(o[2], vb, pa0, pa1, pa2, pa3); pv_one<3>(o[3], vb, pa0, pa1, pa2, pa3); }
}
template <int DQK, int DV, int MODE, bool QROPE = false, int OUTMODE = 0>
__device__ __forceinline__ void attn_unit(const unsigned short* __restrict__ Qb, int ldq, const unsigned short* __restrict__ Kb, int ldk, const unsigned short* __restrict__ Vb, int ldv,
                                          unsigned short* __restrict__ Ob, int ldo, int NT, int lat0, int q0lat, float C, float thr_s, float sinkl2, char* lds, float lam = 0.f, const float* nw = nullptr, float nscale = 1.f) {
  int tid_ = threadIdx.x; asm volatile("" : "+v"(tid_));
  const int tid = tid_, wid = tid >> 6, lane = tid & 63, r32 = lane & 31, hi = lane >> 5;
  char* V_lds = lds; char* K_lds = lds + 2 * SHM_V;
  float* ws = (float*)(lds + 2 * SHM_V + 2 * SHM_K) + wid * 64; float* li_l = ws; float* al_l = ws + 32;
  float m_reg = -1e30f, l_reg = 0; f32x16 o[DV / 32]; bf16x8 qr[DQK / 16];
#pragma unroll
  for (int d = 0; d < DV / 32; ++d) o[d] = f32x16{};
  const unsigned short* Qw = Qb + (long)(wid * QBLK + r32) * ldq + hi * 8;
#pragma unroll
  for (int d0 = 0; d0 < DQK / 16; ++d0) qr[d0] = *reinterpret_cast<const bf16x8*>(Qw + d0 * 16);
  if constexpr (QROPE) {
    static_assert(DQK == 96, "QROPE is the MLA case");
    int t = q0lat + wid * QBLK + r32; asm volatile("" : "+v"(t));
#pragma unroll
    for (int part = 0; part < 2; ++part) { const float pos = (float)(part ? (t & 63) : (t >> 6)); u32x4 w = __builtin_bit_cast(u32x4, qr[4 + part]); u32x4 o;
#pragma unroll
      for (int q = 0; q < 4; ++q) { const unsigned pw = (unsigned)__shfl_xor((int)w[q], 32); float x0 = bflo(w[q]), x1 = bfhi(w[q]); const float p0 = bflo(pw), p1 = bfhi(pw);
        float s0, c0, s1, c1; sincosf(pos * __powf(10000.f, -(float)(2 * q) * 0.125f), &s0, &c0); sincosf(pos * __powf(10000.f, -(float)(2 * q + 1) * 0.125f), &s1, &c1);
        x0 = hi ? (x0 * c0 + p0 * s0) : (x0 * c0 - p0 * s0); x1 = hi ? (x1 * c1 + p1 * s1) : (x1 * c1 - p1 * s1); o[q] = cvtpk(x0, x1); }
      qr[4 + part] = __builtin_bit_cast(bf16x8, o); } }
  const int sr = tid >> 4, sc = (tid & 15) * 8, vst0 = v_st(sr, sc), vst1 = v_st(32 + sr, sc);
  const bool kact = sc < DQK, vact = sc < DV;
  const int vb0 = (int)(uintptr_t)V_lds + v_rd_base(lane);
  struct { bf16x8 vs0, vs1, ks0, ks1; } sr_[2];
#define TROW(j) ((MODE == 1 && (j) >= 4) ? (256 + lat0 + ((j) - 4) * 64) : (j) * 64)
#define SLOAD(i, j) do { const long k0_ = TROW(j); \
    if (vact) { sr_[i].vs0 = *reinterpret_cast<const bf16x8*>(&Vb[(k0_ + sr) * ldv + sc]); sr_[i].vs1 = *reinterpret_cast<const bf16x8*>(&Vb[(k0_ + 32 + sr) * ldv + sc]); } \
    if (kact) { sr_[i].ks0 = *reinterpret_cast<const bf16x8*>(&Kb[(k0_ + sr) * ldk + sc]); sr_[i].ks1 = *reinterpret_cast<const bf16x8*>(&Kb[(k0_ + 32 + sr) * ldk + sc]); } } while (0)
#define SWRITE(b, i) do { if (vact) { *(bf16x8*)(V_lds + (b) * SHM_V + vst0) = sr_[i].vs0; *(bf16x8*)(V_lds + (b) * SHM_V + vst1) = sr_[i].vs1; } \
    if (kact) { const int kc = sc * 2; *(bf16x8*)(K_lds + (b) * SHM_K + KSWZ(sr, kc)) = sr_[i].ks0; *(bf16x8*)(K_lds + (b) * SHM_K + KSWZ(32 + sr, kc)) = sr_[i].ks1; } } while (0)
#define RESC(a) do { if (__any((a) < 1.f)) { if (hi == 0) al_l[r32] = (a); asm volatile("s_waitcnt lgkmcnt(0)" ::: "memory"); \
    _Pragma("unroll") for (int d = 0; d < DV / 32; ++d) _Pragma("unroll") for (int r = 0; r < 16; ++r) o[d][r] *= al_l[crow(r, hi)]; } } while (0)
#define MASK(P0, P1, j) do { if (MODE == 1 && (j) >= 4) { const int kb_ = lat0 + ((j) - 4) * 64 + 4 * hi - (q0lat + wid * QBLK + r32); \
    _Pragma("unroll") for (int r = 0; r < 16; ++r) { const int dk_ = kb_ + (r & 3) + 8 * (r >> 2); if (dk_ > 128 || dk_ < -128) P0[r] = -1e30f; if (dk_ + 32 > 128 || dk_ + 32 < -128) P1[r] = -1e30f; } } } while (0)
  f32x16 pA0, pA1, pB0, pB1; float mnA, mnB, alA, alB; bf16x8 pa0, pa1, pa2, pa3;
  SLOAD(0, 0); asm volatile("s_waitcnt vmcnt(0)" ::: "memory"); SWRITE(0, 0); __syncthreads();
  qkt<DQK>(pA0, pA1, K_lds, qr, r32, hi); MASK(pA0, pA1, 0); partialSM(pA0, pA1, m_reg, mnA, alA, C, thr_s);
  SLOAD(1, 1); if (2 < NT) SLOAD(0, 2);
  asm volatile("s_waitcnt vmcnt(4)" ::: "memory"); SWRITE(1, 1); __syncthreads();
  for (int j = 1; j + 1 < NT; j += 2) {
    SBAR(); qkt<DQK>(pB0, pB1, K_lds + SHM_K, qr, r32, hi); MASK(pB0, pB1, j);
    finishSM(pA0, pA1, alA, l_reg, pa0, pa1, pa2, pa3); SBAR();
    SLOAD(1, j + 2); SBAR();
    pv_all<DV>(o, vb0, pa0, pa1, pa2, pa3); partialSM(pB0, pB1, m_reg, mnB, alB, C, thr_s);
    __syncthreads(); asm volatile("s_waitcnt vmcnt(4)" ::: "memory"); SWRITE(0, 0);
    RESC(alB); __syncthreads();
    SBAR(); qkt<DQK>(pA0, pA1, K_lds, qr, r32, hi); MASK(pA0, pA1, j + 1);
    finishSM(pB0, pB1, alB, l_reg, pa0, pa1, pa2, pa3); SBAR();
    if (j + 3 < NT) SLOAD(0, j + 3); SBAR();
    pv_all<DV>(o, vb0 + (int)SHM_V, pa0, pa1, pa2, pa3); partialSM(pA0, pA1, m_reg, mnA, alA, C, thr_s);
    __syncthreads(); asm volatile("s_waitcnt vmcnt(4)" ::: "memory"); SWRITE(1, 1);
    RESC(alA); __syncthreads();
  }
  SBAR(); qkt<DQK>(pB0, pB1, K_lds + SHM_K, qr, r32, hi); MASK(pB0, pB1, NT - 1);
  finishSM(pA0, pA1, alA, l_reg, pa0, pa1, pa2, pa3); SBAR();
  pv_all<DV>(o, vb0, pa0, pa1, pa2, pa3); partialSM(pB0, pB1, m_reg, mnB, alB, C, thr_s);
  __syncthreads(); RESC(alB);
  finishSM(pB0, pB1, alB, l_reg, pa0, pa1, pa2, pa3); SBAR();
  pv_all<DV>(o, vb0 + (int)SHM_V, pa0, pa1, pa2, pa3);
  if (sinkl2 > -1e29f) l_reg += __builtin_amdgcn_exp2f(sinkl2 - m_reg * C);
  if (hi == 0) li_l[r32] = l_reg; asm volatile("s_waitcnt lgkmcnt(0)" ::: "memory");
  float rli[16];
#pragma unroll
  for (int r = 0; r < 16; ++r) rli[r] = __builtin_amdgcn_rcpf(li_l[crow(r, hi)]);
  if constexpr (OUTMODE == 0) {
  unsigned short* Ow = Ob + (long)(wid * QBLK) * ldo;
#pragma unroll
  for (int r = 0; r < 16; ++r) { const int orow = crow(r, hi);
#pragma unroll
    for (int d0 = 0; d0 < DV / 32; ++d0) Ow[(long)orow * ldo + d0 * 32 + r32] = (unsigned short)f2bf(o[d0][r] * rli[r]); }
  } else {   int zo_ = 0; asm volatile("" : "+v"(zo_)); const int lane = (int)__builtin_amdgcn_mbcnt_hi(~0u, __builtin_amdgcn_mbcnt_lo(~0u, (unsigned)zo_)), r32 = lane & 31, hi = lane >> 5;
    unsigned short* stg = (unsigned short*)(lds + SHM_ATTN) + wid * 4096;
    if constexpr (OUTMODE == 1) {
#pragma unroll
      for (int d0 = 0; d0 < DV / 32; ++d0)
#pragma unroll
        for (int r = 0; r < 16; ++r) stg[(d0 * 16 + r) * 64 + lane] = (unsigned short)f2bf(o[d0][r] * rli[r]);
    } else {
      unsigned short* Ow = Ob + (long)(wid * QBLK) * ldo;
#pragma unroll
      for (int r = 0; r < 16; ++r) { float v[DV / 32]; float ss = 0.f;
#pragma unroll
        for (int d0 = 0; d0 < DV / 32; ++d0) { v[d0] = bf2f(stg[(d0 * 16 + r) * 64 + lane]) - lam * (o[d0][r] * rli[r]); ss += v[d0] * v[d0]; }
        ss += __shfl_xor(ss, 1); ss += __shfl_xor(ss, 2); ss += __shfl_xor(ss, 4); ss += __shfl_xor(ss, 8); ss += __shfl_xor(ss, 16);
        const float rs = nscale / sqrtf(ss * (1.f / (float)DV) + 1e-6f); const int orow = crow(r, hi);
#pragma unroll
        for (int d0 = 0; d0 < DV / 32; ++d0) Ow[(long)orow * ldo + d0 * 32 + r32] = (unsigned short)f2bf(v[d0] * rs * nw[d0 * 32 + r32]);
        __builtin_amdgcn_sched_barrier(0); }
    }
  }
  __syncthreads();
#undef TROW
#undef SLOAD
#undef SWRITE
#undef RESC
#undef MASK
}
#undef KSWZ
#undef SBAR
}
struct Args { const float* in[32]; float* out; unsigned char* ws; int ph_lo, ph_hi; };
struct Frame {
    LAS unsigned char* lds; char* ldsg;
    volatile LAS unsigned* MISC;
    gu32* ctl;
    int tid, lane, wave, vcu, G, gw, NGW;
    const float* const* in; float* out; unsigned char* ws;
};
enum { I_X = 0, I_C, I_CTX, I_CCTX, I_EMODW, I_EMODB, I_ENORMS, I_EWIN, I_ECONV, I_EALOG, I_EDTB, I_EGDNN, I_ESINK, I_EWOUT, I_EFG, I_EFU, I_EFD,
       I_OMODW, I_OMODB, I_ONORMS, I_OWIN, I_OQN, I_OKVN, I_OWUQ, I_OWUKV, I_OLAM, I_OSUBLN, I_OWOUT, I_OROUTER, I_OXG, I_OXU, I_OXD };

__device__ __forceinline__ void tr_load(float (&v)[32], const float* W, int N, int k0, int n0, const float* kscale, int lane) {
#pragma unroll
    for (int i = 0; i < 32; ++i) { const int kk = 2 * i + (lane >> 5); v[i] = W[(size_t)(k0 + kk) * N + n0 + (lane & 31)]; if (kscale) v[i] *= kscale[k0 + kk]; }
}
__device__ __forceinline__ void tr_store(const float (&v)[32], bf16* WT, int ldk, int k0, int drow0, LAS float* scr, int lane) {
#pragma unroll
    for (int i = 0; i < 32; ++i) scr[(2 * i + (lane >> 5)) * 33 + (lane & 31)] = v[i];
    LDS_WAIT(); asm volatile("" ::: "memory");
    const int c = lane & 7;
#pragma unroll
    for (int j = 0; j < 4; ++j) { const int n = (lane >> 3) + 8 * j; const LAS float* s = scr + (8 * c) * 33 + n;
        v4u o; o.x = pk2(s[0 * 33], s[1 * 33]); o.y = pk2(s[2 * 33], s[3 * 33]); o.z = pk2(s[4 * 33], s[5 * 33]); o.w = pk2(s[6 * 33], s[7 * 33]);
        *(GAS v4u*)(WT + (size_t)(drow0 + n) * ldk + k0 + 8 * c) = o; }
    LDS_WAIT(); asm volatile("" ::: "memory");
}
template <int MAP> __device__ __forceinline__ void transpose_job(Frame& F, const float* W, int K, int N, bf16* WT, const float* kscale, int first, int stride, LAS unsigned char* scrb) {
    LAS float* scr = (LAS float*)scrb;
    const int nblk = N / 32, items = (K / 64) * nblk;
    float vn[32];
    if (first < items) tr_load(vn, W, N, 64 * (first / nblk), 32 * (first % nblk), kscale, F.lane);
    for (int it = first; it < items; it += stride) { const int kb = it / nblk, nb = it % nblk, n0 = 32 * nb;
        const int drow0 = (MAP == 0) ? n0 : ((n0 >> 7) * 256 + (n0 & 127) + (MAP == 2 ? 128 : 0));
        float vc[32];
#pragma unroll
        for (int i = 0; i < 32; ++i) vc[i] = vn[i];
        const int nx = it + stride; if (nx < items) tr_load(vn, W, N, 64 * (nx / nblk), 32 * (nx % nblk), kscale, F.lane);
        tr_store(vc, WT, K, 64 * kb, drow0, scr, F.lane); }
}
__device__ __forceinline__ void zero_rows(Frame& F, bf16* WT, int row0, int nrows, int K) {
    const size_t n16 = (size_t)nrows * K / 8; GAS v4u* p = (GAS v4u*)(WT + (size_t)row0 * K);
    for (size_t i = (size_t)F.gw * 64 + F.lane; i < n16; i += (size_t)F.NGW * 64) p[i] = (v4u){0u, 0u, 0u, 0u};
}
__device__ __forceinline__ void modv_items(Frame& F) {
    LAS float* sc = (LAS float*)(F.lds + RING_OFF);
    LAS float* part = (LAS float*)(F.lds + RING_OFF + 20480);
    float* MODV = (float*)(F.ws + WS_MODV);
    const int nitems = 2 * 96;
    if ((int)blockIdx.x >= nitems) return;
    for (int i = F.tid; i < 5 * 1024; i += 512) { const int r = i >> 10, k = i & 1023; const float v = (r < 4) ? F.in[I_C][r * 1024 + k] : F.in[I_CCTX][k]; sc[i] = siluf(v); }
    __syncthreads();
    for (int it = blockIdx.x; it < nitems; it += F.G) {
        const int l = it / 96, n0 = (it % 96) * 64, col = F.tid & 63, ks = F.tid >> 6;
        const float* W = F.in[l ? I_OMODW : I_EMODW] + (size_t)(ks * 128) * 6144 + n0 + col;
        float a0 = 0, a1 = 0, a2 = 0, a3 = 0, a4 = 0;
#pragma unroll 8
        for (int k = 0; k < 128; ++k) { const float w = W[(size_t)k * 6144]; const int kk = ks * 128 + k;
            a0 += sc[kk] * w; a1 += sc[1024 + kk] * w; a2 += sc[2048 + kk] * w; a3 += sc[3072 + kk] * w; a4 += sc[4096 + kk] * w; }
        part[(ks * 5 + 0) * 64 + col] = a0; part[(ks * 5 + 1) * 64 + col] = a1; part[(ks * 5 + 2) * 64 + col] = a2; part[(ks * 5 + 3) * 64 + col] = a3; part[(ks * 5 + 4) * 64 + col] = a4;
        __syncthreads();
        if (F.tid < 320) { const int r = F.tid >> 6, c2 = F.tid & 63; float s = F.in[l ? I_OMODB : I_EMODB][n0 + c2];
#pragma unroll
            for (int q = 0; q < 8; ++q) s += part[(q * 5 + r) * 64 + c2];
            MODV[(size_t)(l * 5 + r) * 6144 + n0 + c2] = s; }
        __syncthreads();
    }
}
__device__ __forceinline__ const float* modvec(Frame& F, int l, int mr, int k) { return (const float*)(F.ws + WS_MODV) + (size_t)((l * 5 + mr) * 6 + k) * 1024; }

struct Row4 { f32x4 v[4]; };
__device__ __forceinline__ Row4 ld_row_f32(const float* p, int lane) { Row4 r; const GAS f32x4* q = (const GAS f32x4*)p + lane;
#pragma unroll
    for (int j = 0; j < 4; ++j) r.v[j] = q[64 * j]; return r; }
__device__ __forceinline__ Row4 ld_row_bf16(const bf16* p, int lane) { Row4 r; const GAS v2u* q = (const GAS v2u*)p + lane;
#pragma unroll
    for (int j = 0; j < 4; ++j) { const v2u w = q[64 * j]; r.v[j] = (f32x4){bflo(w.x), bfhi(w.x), bflo(w.y), bfhi(w.y)}; } return r; }
__device__ __forceinline__ void st_row_f32(float* p, int lane, const Row4& r) { GAS f32x4* q = (GAS f32x4*)p + lane;
#pragma unroll
    for (int j = 0; j < 4; ++j) q[64 * j] = r.v[j]; }
__device__ __forceinline__ void st_row_bf16(bf16* p, int lane, const Row4& r) { GAS v2u* q = (GAS v2u*)p + lane;
#pragma unroll
    for (int j = 0; j < 4; ++j) q[64 * j] = (v2u){pk2(r.v[j].x, r.v[j].y), pk2(r.v[j].z, r.v[j].w)}; }
__device__ __forceinline__ float row_rstd(const Row4& r) { float s = 0.f;
#pragma unroll
    for (int j = 0; j < 4; ++j) s += (r.v[j].x * r.v[j].x + r.v[j].y * r.v[j].y) + (r.v[j].z * r.v[j].z + r.v[j].w * r.v[j].w);
    return 1.f / sqrtf(wave_sum(s) * (1.f / 1024.f) + EPS); }
__device__ __forceinline__ float* xres_ptr(Frame& F, int r, int& mr) { const int b = r / SROW, s = r - b * SROW;
    if (s < TC) { mr = 4; return (float*)(F.ws + WS_HCTX) + (size_t)(b * TC + s) * D; }
    mr = b; return F.out + (size_t)(b * T + s - TC) * D; }
__device__ __forceinline__ Row4 norm_mod(const Row4& x, const float* w, const float* shift, const float* scale, int lane) {
    const float rs = row_rstd(x); const Row4 W = ld_row_f32(w, lane), SH = ld_row_f32(shift, lane), SC = ld_row_f32(scale, lane); Row4 a;
#pragma unroll
    for (int j = 0; j < 4; ++j) a.v[j] = (x.v[j] * rs * W.v[j]) * (SC.v[j] + 1.f) + SH.v[j];
    return a; }
__device__ __forceinline__ Row4 norm_mod_r(const Row4& x, const Row4& W, const Row4& SH, const Row4& SC) {
    const float rs = row_rstd(x); Row4 a;
#pragma unroll
    for (int j = 0; j < 4; ++j) a.v[j] = (x.v[j] * rs * W.v[j]) * (SC.v[j] + 1.f) + SH.v[j];
    return a; }
__device__ __forceinline__ void add_gated_norm_r(Row4& x, const Row4& y, const Row4& W, const Row4& G) {
    const float rs = row_rstd(y);
#pragma unroll
    for (int j = 0; j < 4; ++j) x.v[j] = x.v[j] + G.v[j] * (y.v[j] * rs * W.v[j]); }
__device__ __forceinline__ int tok_vcu(const Frame& F, int b, int t) { const int wpb = F.NGW >> 2; return (b * wpb + t % wpb) >> 3; }
__device__ __forceinline__ void add_gated_norm(Row4& x, const Row4& y, const float* w, const float* gate, int lane) {
    const float rs = row_rstd(y); const Row4 W = ld_row_f32(w, lane), G = ld_row_f32(gate, lane);
#pragma unroll
    for (int j = 0; j < 4; ++j) x.v[j] = x.v[j] + G.v[j] * (y.v[j] * rs * W.v[j]); }
__device__ __forceinline__ void p0_prologue(Frame& F) {
    modv_items(F);
    __syncthreads();
    transpose_job<0>(F, F.in[I_EWIN], 1024, EIN, (bf16*)(F.ws + WS_WEIN), nullptr, F.gw, F.NGW, F.lds + RING_OFF + F.wave * 16384);
    zero_rows(F, (bf16*)(F.ws + WS_WEIN), EIN, EINP - EIN, 1024);
}
__device__ __forceinline__ void p0_deferred(Frame& F, int w4, LAS unsigned char* scr) {
    const float* const* in = F.in; unsigned char* ws = F.ws; const int gw = F.vcu * 4 + w4, N = F.G * 4;
    transpose_job<0>(F, in[I_EWOUT], 1024, 1024, (bf16*)(ws + WS_WEOUT), nullptr, gw, N, scr);
    transpose_job<1>(F, in[I_EFG], 1024, DFF, (bf16*)(ws + WS_WEGU), nullptr, (gw + 512) % N, N, scr);
    transpose_job<2>(F, in[I_EFU], 1024, DFF, (bf16*)(ws + WS_WEGU), nullptr, (gw + 896) % N, N, scr);
    transpose_job<0>(F, in[I_EFD], DFF, 1024, (bf16*)(ws + WS_WEDN), nullptr, (gw + 256) % N, N, scr);
    transpose_job<0>(F, in[I_OWIN], 1024, OIN, (bf16*)(ws + WS_WOIN), nullptr, (gw + 640) % N, N, scr);
    transpose_job<0>(F, in[I_OWUQ], 384, 768, (bf16*)(ws + WS_WUQ), in[I_OQN], (gw + 720) % N, N, scr);
    transpose_job<0>(F, in[I_OWUKV], 256, 1024, (bf16*)(ws + WS_WUKV), in[I_OKVN], (gw + 864) % N, N, scr);
    transpose_job<0>(F, in[I_OWOUT], 1024, 1024, (bf16*)(ws + WS_WOOUT), nullptr, (gw + 992) % N, N, scr);
    { const size_t n16 = (size_t)(OINP - OIN) * 1024 / 8; GAS v4u* p = (GAS v4u*)((bf16*)(ws + WS_WOIN) + (size_t)OIN * 1024);
      for (size_t i = (size_t)gw * 64 + F.lane; i < n16; i += (size_t)N * 64) p[i] = (v4u){0u, 0u, 0u, 0u}; }
}
__device__ __forceinline__ void px_expert_weights(Frame& F) {
    for (int e = 0; e < NEXP; ++e) {
        transpose_job<1>(F, F.in[I_OXG] + (size_t)e * 1024 * DFX, 1024, DFX, (bf16*)(F.ws + WS_WXGU) + (size_t)e * 7168 * 1024, nullptr, (F.gw + e * 448) % F.NGW, F.NGW, F.lds + RING_OFF + F.wave * 8448);
        transpose_job<2>(F, F.in[I_OXU] + (size_t)e * 1024 * DFX, 1024, DFX, (bf16*)(F.ws + WS_WXGU) + (size_t)e * 7168 * 1024, nullptr, (F.gw + e * 448 + 224) % F.NGW, F.NGW, F.lds + RING_OFF + F.wave * 8448);
    }
}
__device__ __forceinline__ void px_expert_down(Frame& F, int wk, int nwk, int e0, int e1) {
    for (int e = e0; e < e1; ++e)
        transpose_job<0>(F, F.in[I_OXD] + (size_t)e * DFX * 1024, DFX, 1024, (bf16*)(F.ws + WS_WXDN) + (size_t)e * 1024 * DFX, nullptr, (wk + e * 448 + 112) % nwk, nwk, F.lds + RING_OFF + F.wave * 8448);
}
__device__ __forceinline__ void p1_first_rows(Frame& F) {
    bf16* A = (bf16*)(F.ws + WS_ABUF); const float* w0 = F.in[I_ENORMS]; const int wpb = F.NGW >> 2, b = F.gw / wpb, wl = F.gw - b * wpb;
    { const Row4 W = ld_row_f32(w0, F.lane), SH = ld_row_f32(modvec(F, 0, b, 0), F.lane), SC = ld_row_f32(modvec(F, 0, b, 1), F.lane);
      for (int t = wl; t < T; t += wpb) { const size_t tk = (size_t)b * T + t; const Row4 x = ld_row_f32(F.in[I_X] + tk * D, F.lane); st_row_bf16((bf16*)(F.ws + WS_XB) + tk * D, F.lane, x);
          const Row4 a = norm_mod_r(x, W, SH, SC); st_row_bf16(A + ((size_t)b * SROW + TC + t) * D, F.lane, a); } }
    for (int c = F.gw; c < NB * TC; c += F.NGW) { const int cb = c / TC, s = c - cb * TC;
        const Row4 x = ld_row_f32(F.in[I_CTX] + (size_t)c * D, F.lane); st_row_f32((float*)(F.ws + WS_HCTX) + (size_t)c * D, F.lane, x);
        const Row4 a = norm_mod(x, w0, modvec(F, 0, 4, 0), modvec(F, 0, 4, 1), F.lane); st_row_bf16(A + ((size_t)cb * SROW + s) * D, F.lane, a); }
}
constexpr int ROUTER_TAB_OFF = 69632;
__device__ __forceinline__ void router_table(Frame& F) {
    LAS f32x4* tab = (LAS f32x4*)(F.lds + RING_OFF + ROUTER_TAB_OFF); const float* Rw = F.in[I_OROUTER];
    for (int i = F.tid; i < 2048; i += 512) { const int ln = i & 63, h = (i >> 6) & 1, q = (i >> 7) & 3, j = i >> 9; tab[i] = *(const GAS f32x4*)(Rw + (size_t)(4 * ln + 256 * j + q) * 8 + 4 * h); }
    __syncthreads();
}
template <bool ROUTER> __device__ __forceinline__ void rows_mid(Frame& F, const bf16* Y, const float* wy, int lg, int kg, const float* w2, int l2, int ks2, bf16* Aout, bool lat_only, int nsl = 0) {
    const int wpb = F.NGW >> 2, b = F.gw / wpb, wl = F.gw - b * wpb;
    { const Row4 Wy = ld_row_f32(wy, F.lane), Gt = ld_row_f32(modvec(F, lg, b, kg), F.lane), W2 = ld_row_f32(w2, F.lane), SH = ld_row_f32(modvec(F, l2, b, ks2), F.lane), SC = ld_row_f32(modvec(F, l2, b, ks2 + 1), F.lane);
      for (int t = wl; t < T; t += wpb) { const size_t tk = (size_t)b * T + t, r = (size_t)b * SROW + TC + t; bf16* xr = (bf16*)(F.ws + WS_XB) + tk * D;
        Row4 x = ld_row_bf16(xr, F.lane); const Row4 y = ld_row_bf16(Y + r * D, F.lane);
        add_gated_norm_r(x, y, Wy, Gt); st_row_bf16(xr, F.lane, x);
        const Row4 a = norm_mod_r(x, W2, SH, SC);
        st_row_bf16(Aout + r * D, F.lane, a);
        if constexpr (ROUTER) {
            LAS const f32x4* Rt = (LAS const f32x4*)(F.lds + RING_OFF + ROUTER_TAB_OFF) + F.lane; float lg8[8];
#pragma unroll
            for (int e = 0; e < 8; ++e) lg8[e] = 0.f;
#pragma unroll
            for (int j = 0; j < 4; ++j)
#pragma unroll
                for (int q = 0; q < 4; ++q) { const f32x4 r0 = Rt[((j * 4 + q) * 2 + 0) * 64], r1 = Rt[((j * 4 + q) * 2 + 1) * 64]; const float av = a.v[j][q];
                    lg8[0] += av * r0.x; lg8[1] += av * r0.y; lg8[2] += av * r0.z; lg8[3] += av * r0.w; lg8[4] += av * r1.x; lg8[5] += av * r1.y; lg8[6] += av * r1.z; lg8[7] += av * r1.w; }
#pragma unroll
            for (int e = 0; e < 8; ++e) lg8[e] = wave_sum(lg8[e]);
            int i0 = 0; float v0 = lg8[0];
#pragma unroll
            for (int e = 1; e < 8; ++e) if (lg8[e] > v0) { v0 = lg8[e]; i0 = e; }
            int i1 = -1; float v1 = -3.0e38f;
#pragma unroll
            for (int e = 0; e < 8; ++e) if (e != i0 && lg8[e] > v1) { v1 = lg8[e]; i1 = e; }
            const float e1 = __expf(v1 - v0), w0 = 1.f / (1.f + e1), w1 = e1 * w0;
            if (F.lane == 0) {
                int* TOPI = (int*)(F.ws + WS_META + META_TOPI); float* TOPW = (float*)(F.ws + WS_META + META_TOPW); int* RANK = (int*)(F.ws + WS_META + META_RANK);
                TOPI[tk * 2] = i0; TOPI[tk * 2 + 1] = i1; TOPW[tk * 2] = w0; TOPW[tk * 2 + 1] = w1;
                RANK[tk * 2] = (int)__hip_atomic_fetch_add((LAS unsigned*)(F.MISC + 24 + i0), 1u, __ATOMIC_RELAXED, __HIP_MEMORY_SCOPE_WORKGROUP);
                RANK[tk * 2 + 1] = (int)__hip_atomic_fetch_add((LAS unsigned*)(F.MISC + 24 + i1), 1u, __ATOMIC_RELAXED, __HIP_MEMORY_SCOPE_WORKGROUP); }
        } } }
    if (!lat_only) for (int c = F.gw; c < NB * TC; c += F.NGW) { const int cb = c / TC, s = c - cb * TC; const size_t r = (size_t)cb * SROW + s; float* xr = (float*)(F.ws + WS_HCTX) + (size_t)c * D;
        Row4 x = ld_row_f32(xr, F.lane); Row4 y;
        if (nsl > 0) {
            const float* pp = (const float*)(F.ws + WS_PART) + (size_t)c * 1024; y = ld_row_f32(pp, F.lane);
            for (int q = 1; q < nsl; ++q) { const Row4 t = ld_row_f32(pp + (size_t)q * 1024 * 1024, F.lane);
#pragma unroll
                for (int j = 0; j < 4; ++j) y.v[j] = y.v[j] + t.v[j]; } }
        else y = ld_row_bf16(Y + r * D, F.lane);
        add_gated_norm(x, y, wy, modvec(F, lg, 4, kg), F.lane); st_row_f32(xr, F.lane, x);
        const Row4 a = norm_mod(x, w2, modvec(F, l2, 4, ks2), modvec(F, l2, 4, ks2 + 1), F.lane);
        st_row_bf16(Aout + r * D, F.lane, a); }
}
__device__ __forceinline__ void router_tail(Frame& F) {
    {
        __syncthreads();
        if (F.tid < 8) { ((int*)(F.ws + WS_META + META_BLKB))[F.vcu * 8 + F.tid] = (int)__hip_atomic_fetch_add((unsigned*)(F.ctl + CW_MOECNT + 64 * F.tid), F.MISC[24 + F.tid], RLX_AGENT); F.MISC[24 + F.tid] = 0u; }
    }
}
__device__ __forceinline__ void g0_prep(Frame& F) {
    const bf16* P = (const bf16*)(F.ws + WS_PROJ); bf16* PW = (bf16*)(F.ws + WS_PROJ); bf16* QK = (bf16*)(F.ws + WS_QKVN); float* GB = (float*)(F.ws + WS_GB);
    const float* cw = F.in[I_ECONV]; const int lane = F.lane;
#pragma unroll 1
    for (int part = 0; part < 3; ++part) { const int ch = part * 512 + 8 * lane; float w[5][8];
#pragma unroll
        for (int j = 0; j < 5; ++j) { const f32x4 w0 = *(const GAS f32x4*)(cw + j * 1536 + ch), w1 = *(const GAS f32x4*)(cw + j * 1536 + ch + 4); w[j][0] = w0.x; w[j][1] = w0.y; w[j][2] = w0.z; w[j][3] = w0.w; w[j][4] = w1.x; w[j][5] = w1.y; w[j][6] = w1.z; w[j][7] = w1.w; }
        v4u tn[5];
#define G0_TAPS(dst, r_) do { const int b_ = (r_) / SROW, s_ = (r_) - b_ * SROW; const bool c_ = s_ < TC; const int p_ = c_ ? s_ : s_ - TC, len_ = c_ ? TC : T; \
            _Pragma("unroll") for (int j = 0; j < 5; ++j) { const int pp = p_ + j - 2; dst[j] = (pp >= 0 && pp < len_) ? *(const GAS v4u*)(P + (size_t)((r_) + j - 2) * EINP + ch) : (v4u){0u, 0u, 0u, 0u}; } } while (0)
        if (F.gw < NR) G0_TAPS(tn, F.gw);
        for (int r = F.gw; r < NR; r += F.NGW) { v4u tc[5];
#pragma unroll
            for (int j = 0; j < 5; ++j) tc[j] = tn[j];
            if (r + F.NGW < NR) G0_TAPS(tn, r + F.NGW);
            float acc[8];
#pragma unroll
            for (int e = 0; e < 8; ++e) acc[e] = 0.f;
#pragma unroll
            for (int j = 0; j < 5; ++j) { const v4u xv = tc[j];
                acc[0] += bflo(xv.x) * w[j][0]; acc[1] += bfhi(xv.x) * w[j][1]; acc[2] += bflo(xv.y) * w[j][2]; acc[3] += bfhi(xv.y) * w[j][3];
                acc[4] += bflo(xv.z) * w[j][4]; acc[5] += bfhi(xv.z) * w[j][5]; acc[6] += bflo(xv.w) * w[j][6]; acc[7] += bfhi(xv.w) * w[j][7]; }
            float ss = 0.f;
#pragma unroll
            for (int e = 0; e < 8; ++e) { acc[e] = siluf(acc[e]); ss += acc[e] * acc[e]; }
            if (part < 2) { ss += __shfl_xor(ss, 1); ss += __shfl_xor(ss, 2); ss += __shfl_xor(ss, 4); const float sc = (part == 0 ? 0.125f : 1.f) / sqrtf(ss + EPS);
#pragma unroll
                for (int e = 0; e < 8; ++e) acc[e] *= sc; }
            *(GAS v4u*)(QK + (size_t)r * 1536 + ch) = (v4u){pk2(acc[0], acc[1]), pk2(acc[2], acc[3]), pk2(acc[4], acc[5]), pk2(acc[6], acc[7])}; }
#undef G0_TAPS
    }
    for (int r = F.gw; r < NR; r += F.NGW) { const int b = r / SROW, s = r - b * SROW; const bool isc = s < TC; const int p = isc ? s : s - TC;
        if (lane < 16) { const float ga = bf2f(P[(size_t)r * EINP + E_GA + lane]), gb = bf2f(P[(size_t)r * EINP + E_GB + lane]);
            const float xx = ga + F.in[I_EDTB][lane], sp = fmaxf(xx, 0.f) + log1pf(__expf(-fabsf(xx)));
            GB[(size_t)r * 32 + lane] = -__expf(F.in[I_EALOG][lane]) * sp; GB[(size_t)r * 32 + 16 + lane] = 1.f / (1.f + __expf(-gb)); }
        if (!isc) {
            const int pi = lane & 31, seg = pi >> 4, i = pi & 15, d0 = seg * 32 + i; const float pos = (float)(seg ? (p & 63) : (p >> 6));
            const float ang = pos * __powf(10000.f, -(float)i * (1.f / 16.f)); float sn, cs; sincosf(ang, &sn, &cs);
#pragma unroll
            for (int q = 0; q < 5; ++q) { const int hh = (lane >> 5) + 2 * q; bf16* base = PW + (size_t)r * EINP + (hh < 8 ? E_SQ + hh * 64 : E_SK + (hh - 8) * 64) + d0;
                const float x0 = bf2f(base[0]), x1 = bf2f(base[16]); base[0] = (bf16)f2bf(x0 * cs - x1 * sn); base[16] = (bf16)f2bf(x1 * cs + x0 * sn); }
        }
    }
}
constexpr int GP = 65, GLP = 68;
template <int I> struct SolveRow {
    static __device__ __forceinline__ void run(float (&x)[64], const LAS float* Ls) {
        SolveRow<I - 1>::run(x, Ls);
        float a = x[I];
#pragma unroll
        for (int j = 0; j < I; ++j) a -= Ls[I * GLP + j] * x[j];
        x[I] = a;
    }
};
template <> struct SolveRow<0> { static __device__ __forceinline__ void run(float (&)[64], const LAS float*) {} };

__device__ __forceinline__ void gdn_chain(Frame& F, int chain) {
    const int b = chain >> 4, h = (chain >> 1) & 7, dir = chain & 1;
    LAS float* Ss = (LAS float*)(F.lds + RING_OFF);
    LAS float* Qs = Ss + 64 * GP, *Ks = Qs + 64 * GP, *Vs = Ks + 64 * GP  , *ATs = Vs + 64 * GP, *Ws = ATs + 64 * GP, *VNs = Ws + 64 * GP;
    LAS float* Ls = VNs + 64 * GP;
    LAS float* gcs = Ls + 64 * GLP, *bts = gcs + 64;
    const bf16* QK = (const bf16*)(F.ws + WS_QKVN); const float* GB = (const float*)(F.ws + WS_GB); bf16* OG = (bf16*)(F.ws + WS_OG);
    const int tid = F.tid, lane = F.lane, w = F.wave;
    for (int i = tid; i < 64 * GP; i += 512) Ss[i] = 0.f;
    for (int ci = 0; ci < 68; ++ci) {
        const bool isc = ci < 4; const int n0 = (isc ? ci : ci - 4) * 64; const int rbase = b * SROW + (isc ? 0 : TC), len = isc ? TC : T;
        __syncthreads();
        for (int e = tid; e < 64 * 24; e += 512) { const int i = e / 24, c8 = e % 24, part = c8 >> 3, cc = (c8 & 7) * 8; const int n = n0 + i, row = rbase + (dir ? len - 1 - n : n);
            const v4u xv = *(const GAS v4u*)(QK + (size_t)row * 1536 + part * 512 + h * 64 + cc); LAS float* dst = (part == 0 ? Qs : part == 1 ? Ks : Vs) + i * GP + cc;
            dst[0] = bflo(xv.x); dst[1] = bfhi(xv.x); dst[2] = bflo(xv.y); dst[3] = bfhi(xv.y); dst[4] = bflo(xv.z); dst[5] = bfhi(xv.z); dst[6] = bflo(xv.w); dst[7] = bfhi(xv.w); }
        if (tid < 64) { const int n = n0 + tid, row = rbase + (dir ? len - 1 - n : n); float g = GB[(size_t)row * 32 + dir * 8 + h]; bts[tid] = GB[(size_t)row * 32 + 16 + dir * 8 + h];
#pragma unroll
            for (int o = 1; o < 64; o <<= 1) { const float t = __shfl_up(g, o); if (lane >= o) g += t; }
            gcs[tid] = g; }
        __syncthreads();
#pragma unroll 1
        for (int k = 0; k < 8; ++k) { const int i = w + 8 * k, j = lane; float kk = 0.f, qk = 0.f;
#pragma unroll 16
            for (int d = 0; d < 64; ++d) { const float kj = Ks[j * GP + d]; kk += Ks[i * GP + d] * kj; qk += Qs[i * GP + d] * kj; }
            const float dec = (j <= i) ? __expf(gcs[i] - gcs[j]) : 0.f;
            Ls[i * GLP + j] = (j < i) ? bts[i] * kk * dec : 0.f; ATs[i * GP + j] = qk * dec; }
        __syncthreads();
        if (tid < 128) { float x[64]; const int c = tid & 63; const bool isw = tid >= 64; int zz = 0; asm volatile("" : "+v"(zz));
            const LAS float* src = (isw ? Ks : Vs) + c; const LAS float* btz = bts + zz; const LAS float* gcz = gcs + zz;
#pragma unroll
            for (int i = 0; i < 64; ++i) { const float e = isw ? __expf(gcz[i]) : 1.f; x[i] = src[i * GP] * btz[i] * e; }
            SolveRow<63>::run(x, Ls + zz);
            LAS float* dst = isw ? Ws : Vs;
#pragma unroll
            for (int i = 0; i < 64; ++i) dst[i * GP + c] = x[i]; }
        __syncthreads();
#pragma unroll 1
        for (int k = 0; k < 8; ++k) { const int i = w + 8 * k, d = lane; float a = Vs[i * GP + d];
#pragma unroll 16
            for (int q = 0; q < 64; ++q) a -= Ws[i * GP + q] * Ss[q * GP + d];
            VNs[i * GP + d] = a; }
        __syncthreads();
#pragma unroll 1
        for (int k = 0; k < 8; ++k) { const int i = w + 8 * k, d = lane; float a = 0.f, c2 = 0.f;
#pragma unroll 16
            for (int q = 0; q < 64; ++q) { a += Qs[i * GP + q] * Ss[q * GP + d]; c2 += ATs[i * GP + q] * VNs[q * GP + d]; }
            const int n = n0 + i, row = rbase + (dir ? len - 1 - n : n);
            OG[(size_t)row * 1024 + dir * 512 + h * 64 + d] = (bf16)f2bf(a * __expf(gcs[i]) + c2); }
        __syncthreads();
        const float gl = gcs[63];
#pragma unroll 1
        for (int k = 0; k < 8; ++k) { const int a = w + 8 * k, d = lane; float acc = Ss[a * GP + d] * __expf(gl);
#pragma unroll 16
            for (int i = 0; i < 64; ++i) acc += Ks[i * GP + a] * __expf(gl - gcs[i]) * VNs[i * GP + d];
            Ss[a * GP + d] = acc; }
    }
    __syncthreads();
}
__device__ __forceinline__ void g4_gdn_out(Frame& F) {
    const bf16* OG = (const bf16*)(F.ws + WS_OG); const bf16* P = (const bf16*)(F.ws + WS_PROJ); bf16* MIX = (bf16*)(F.ws + WS_MIX); const float* gn = F.in[I_EGDNN]; const int lane = F.lane;
    const f32x4 g0 = *(const GAS f32x4*)(gn + (lane & 7) * 8), g1 = *(const GAS f32x4*)(gn + (lane & 7) * 8 + 4);
    for (int r = F.gw; r < NR; r += F.NGW) {
        const v4u a = *(const GAS v4u*)(OG + (size_t)r * 1024 + 8 * lane), c = *(const GAS v4u*)(OG + (size_t)r * 1024 + 512 + 8 * lane), z = *(const GAS v4u*)(P + (size_t)r * EINP + E_Z + 8 * lane);
        float o[8] = {bflo(a.x) + bflo(c.x), bfhi(a.x) + bfhi(c.x), bflo(a.y) + bflo(c.y), bfhi(a.y) + bfhi(c.y), bflo(a.z) + bflo(c.z), bfhi(a.z) + bfhi(c.z), bflo(a.w) + bflo(c.w), bfhi(a.w) + bfhi(c.w)};
        float ss = 0.f;
#pragma unroll
        for (int e = 0; e < 8; ++e) ss += o[e] * o[e];
        ss += __shfl_xor(ss, 1); ss += __shfl_xor(ss, 2); ss += __shfl_xor(ss, 4);
        const float rs = 1.f / sqrtf(ss * (1.f / 64.f) + EPS);
        const float zz[8] = {bflo(z.x), bfhi(z.x), bflo(z.y), bfhi(z.y), bflo(z.z), bfhi(z.z), bflo(z.w), bfhi(z.w)};
        const float gg[8] = {g0.x, g0.y, g0.z, g0.w, g1.x, g1.y, g1.z, g1.w};
#pragma unroll
        for (int e = 0; e < 8; ++e) o[e] = o[e] * rs * gg[e] * siluf(zz[e]);
        *(GAS v4u*)(MIX + (size_t)r * 1024 + 8 * lane) = (v4u){pk2(o[0], o[1]), pk2(o[2], o[3]), pk2(o[4], o[5]), pk2(o[6], o[7])}; }
}
__device__ __forceinline__ void swa_unit(Frame& F, int u) {
    const bf16* P = (const bf16*)(F.ws + WS_PROJ); bf16* MIX = (bf16*)(F.ws + WS_MIX);
    constexpr float SC = 0.125f, C = SC * 1.4426950408889634f, THRS = att::THR / SC;
    if (u < 512) { const int b = u >> 7, qb = (u >> 3) & 15, hq = u & 7, kvh = hq >> 2; const size_t rq = (size_t)b * SROW + TC + qb * 256, r0 = (size_t)b * SROW;
        const int lat0 = qb * 256 - 128 < 0 ? 0 : qb * 256 - 128, lend = qb * 256 + 384 > T ? T : qb * 256 + 384, NT = 4 + (lend - lat0) / 64;
        att::attn_unit<64, 64, 1>(P + rq * EINP + E_SQ + hq * 64, EINP, P + r0 * EINP + E_SK + kvh * 64, EINP, P + r0 * EINP + E_SV + kvh * 64, EINP,
                                  MIX + rq * 1024 + 512 + hq * 64, 1024, NT, lat0, qb * 256, C, THRS, F.in[I_ESINK][hq] * 1.4426950408889634f, F.ldsg + RING_OFF);
    } else { const int v = u - 512, b = v >> 3, hq = v & 7, kvh = hq >> 2; const size_t r0 = (size_t)b * SROW;
        att::attn_unit<64, 64, 2>(P + r0 * EINP + E_SQ + hq * 64, EINP, P + r0 * EINP + E_SK + kvh * 64, EINP, P + r0 * EINP + E_SV + kvh * 64, EINP,
                                  MIX + r0 * 1024 + 512 + hq * 64, 1024, 4, 0, 0, C, THRS, F.in[I_ESINK][hq] * 1.4426950408889634f, F.ldsg + RING_OFF); }
}
namespace gdn {
using bf16x8 = __attribute__((ext_vector_type(8))) short;
using f32x16 = __attribute__((ext_vector_type(16))) float;
using u32x4  = __attribute__((ext_vector_type(4))) unsigned;
__device__ __forceinline__ int crow(int r, int hi) { return (r & 3) + 8 * (r >> 2) + 4 * hi; }
typedef float f32x2_t __attribute__((ext_vector_type(2))); typedef __bf16 bf16x2_t __attribute__((ext_vector_type(2)));
__device__ __forceinline__ unsigned cvtpk(float lo, float hi) { f32x2_t v = {lo, hi}; bf16x2_t b = __builtin_convertvector(v, bf16x2_t); return __builtin_bit_cast(unsigned, b); }
__device__ __forceinline__ int swap23(int p) { return (p & ~0xC) | ((p & 4) << 1) | ((p & 8) >> 1); }
typedef float f32x4g __attribute__((ext_vector_type(4)));
template <int I> struct LRow {
    static constexpr int NQ = (I + 3) / 4, O = I * 128;
    static __device__ __forceinline__ void load(f32x4g (&b)[8], unsigned la) {
        if constexpr (NQ == 1) asm volatile("ds_read_b128 %0, %1 offset:%2\n\ts_waitcnt lgkmcnt(0)" : "=&v"(b[0]) : "v"(la), "i"(O));
        else if constexpr (NQ == 2) asm volatile("ds_read_b128 %0, %2 offset:%3\n\tds_read_b128 %1, %2 offset:%4\n\ts_waitcnt lgkmcnt(0)" : "=&v"(b[0]), "=&v"(b[1]) : "v"(la), "i"(O), "i"(O + 16));
        else if constexpr (NQ == 3) asm volatile("ds_read_b128 %0, %3 offset:%4\n\tds_read_b128 %1, %3 offset:%5\n\tds_read_b128 %2, %3 offset:%6\n\ts_waitcnt lgkmcnt(0)" : "=&v"(b[0]), "=&v"(b[1]), "=&v"(b[2]) : "v"(la), "i"(O), "i"(O + 16), "i"(O + 32));
        else if constexpr (NQ == 4) asm volatile("ds_read_b128 %0, %4 offset:%5\n\tds_read_b128 %1, %4 offset:%6\n\tds_read_b128 %2, %4 offset:%7\n\tds_read_b128 %3, %4 offset:%8\n\ts_waitcnt lgkmcnt(0)" : "=&v"(b[0]), "=&v"(b[1]), "=&v"(b[2]), "=&v"(b[3]) : "v"(la), "i"(O), "i"(O + 16), "i"(O + 32), "i"(O + 48));
        else if constexpr (NQ == 5) asm volatile("ds_read_b128 %0, %5 offset:%6\n\tds_read_b128 %1, %5 offset:%7\n\tds_read_b128 %2, %5 offset:%8\n\tds_read_b128 %3, %5 offset:%9\n\tds_read_b128 %4, %5 offset:%10\n\ts_waitcnt lgkmcnt(0)" : "=&v"(b[0]), "=&v"(b[1]), "=&v"(b[2]), "=&v"(b[3]), "=&v"(b[4]) : "v"(la), "i"(O), "i"(O + 16), "i"(O + 32), "i"(O + 48), "i"(O + 64));
        else if constexpr (NQ == 6) asm volatile("ds_read_b128 %0, %6 offset:%7\n\tds_read_b128 %1, %6 offset:%8\n\tds_read_b128 %2, %6 offset:%9\n\tds_read_b128 %3, %6 offset:%10\n\tds_read_b128 %4, %6 offset:%11\n\tds_read_b128 %5, %6 offset:%12\n\ts_waitcnt lgkmcnt(0)" : "=&v"(b[0]), "=&v"(b[1]), "=&v"(b[2]), "=&v"(b[3]), "=&v"(b[4]), "=&v"(b[5]) : "v"(la), "i"(O), "i"(O + 16), "i"(O + 32), "i"(O + 48), "i"(O + 64), "i"(O + 80));
        else if constexpr (NQ == 7) asm volatile("ds_read_b128 %0, %7 offset:%8\n\tds_read_b128 %1, %7 offset:%9\n\tds_read_b128 %2, %7 offset:%10\n\tds_read_b128 %3, %7 offset:%11\n\tds_read_b128 %4, %7 offset:%12\n\tds_read_b128 %5, %7 offset:%13\n\tds_read_b128 %6, %7 offset:%14\n\ts_waitcnt lgkmcnt(0)" : "=&v"(b[0]), "=&v"(b[1]), "=&v"(b[2]), "=&v"(b[3]), "=&v"(b[4]), "=&v"(b[5]), "=&v"(b[6]) : "v"(la), "i"(O), "i"(O + 16), "i"(O + 32), "i"(O + 48), "i"(O + 64), "i"(O + 80), "i"(O + 96));
        else asm volatile("ds_read_b128 %0, %8 offset:%9\n\tds_read_b128 %1, %8 offset:%10\n\tds_read_b128 %2, %8 offset:%11\n\tds_read_b128 %3, %8 offset:%12\n\tds_read_b128 %4, %8 offset:%13\n\tds_read_b128 %5, %8 offset:%14\n\tds_read_b128 %6, %8 offset:%15\n\tds_read_b128 %7, %8 offset:%16\n\ts_waitcnt lgkmcnt(0)" : "=&v"(b[0]), "=&v"(b[1]), "=&v"(b[2]), "=&v"(b[3]), "=&v"(b[4]), "=&v"(b[5]), "=&v"(b[6]), "=&v"(b[7]) : "v"(la), "i"(O), "i"(O + 16), "i"(O + 32), "i"(O + 48), "i"(O + 64), "i"(O + 80), "i"(O + 96), "i"(O + 112));
    }
};
template <int I> struct Solve32 {
    static __device__ __forceinline__ void run(float (&x)[32], unsigned la) {
#ifdef SOLVE_C_LOAD
        f32x4g b[8]; { const LAS f32x4g* Lp = (const LAS f32x4g*)(uintptr_t)(la + I * 128);
#pragma unroll
          for (int q = 0; q < (I + 3) / 4; ++q) b[q] = Lp[q]; }
#else
        f32x4g b[8]; LRow<I>::load(b, la);
#endif
        float a = x[I];
#pragma unroll
#ifdef SOLVE_C_FMA
        for (int j = 0; j < I; ++j) a = __builtin_fmaf(-b[j >> 2][j & 3], x[j], a);
#else
        for (int j = 0; j < I; ++j) asm volatile("v_fma_f32 %0, -%1, %2, %0" : "+v"(a) : "v"(b[j >> 2][j & 3]), "v"(x[j]));
#endif
        x[I] = a;
        if constexpr (I < 31) Solve32<I + 1>::run(x, la);
    }
};
__device__ __forceinline__ void solve32(float (&x)[32], unsigned la) { Solve32<1>::run(x, la); }
__device__ __forceinline__ void col_frags32(const float (&x)[32], bf16x8 (&F)[4][2], int s0) {
#pragma unroll
    for (int s = 0; s < 2; ++s) {
        const unsigned p0[4] = {cvtpk(x[16 * s + 0], x[16 * s + 1]), cvtpk(x[16 * s + 2], x[16 * s + 3]), cvtpk(x[16 * s + 8], x[16 * s + 9]), cvtpk(x[16 * s + 10], x[16 * s + 11])};
        const unsigned p1[4] = {cvtpk(x[16 * s + 4], x[16 * s + 5]), cvtpk(x[16 * s + 6], x[16 * s + 7]), cvtpk(x[16 * s + 12], x[16 * s + 13]), cvtpk(x[16 * s + 14], x[16 * s + 15])};
        u32x4 f0, f1;
#pragma unroll
        for (int q = 0; q < 4; ++q) { auto r = __builtin_amdgcn_permlane32_swap(p0[q], p1[q], false, false); f0[q] = r[0]; f1[q] = r[1]; }
        F[s0 + s][0] = __builtin_bit_cast(bf16x8, f0); F[s0 + s][1] = __builtin_bit_cast(bf16x8, f1); }
}
__device__ __forceinline__ void solve_blocked(float (&x1)[32], float (&x2)[32], unsigned la, const bf16x8 (&L21A)[2], bf16x8 (&F)[4][2]) {
    solve32(x1, la);
    col_frags32(x1, F, 0);
    f32x16 t0 = f32x16{}, t1 = f32x16{};
    t0 = __builtin_amdgcn_mfma_f32_32x32x16_bf16(L21A[0], F[0][0], t0, 0, 0, 0); t0 = __builtin_amdgcn_mfma_f32_32x32x16_bf16(L21A[1], F[1][0], t0, 0, 0, 0);
    t1 = __builtin_amdgcn_mfma_f32_32x32x16_bf16(L21A[0], F[0][1], t1, 0, 0, 0); t1 = __builtin_amdgcn_mfma_f32_32x32x16_bf16(L21A[1], F[1][1], t1, 0, 0, 0);
#pragma unroll
    for (int r = 0; r < 16; ++r) { const float e0 = t0[r], e1 = t1[r]; auto sw = __builtin_amdgcn_permlane32_swap(__float_as_uint(e0), __float_as_uint(e1), false, false);
        x2[(r & 3) + 8 * (r >> 2)] -= __uint_as_float(sw[0]); x2[(r & 3) + 8 * (r >> 2) + 4] -= __uint_as_float(sw[1]); }
    __builtin_amdgcn_sched_barrier(0);
    solve32(x2, la + 4096u);
    col_frags32(x2, F, 2);
}
__device__ __forceinline__ bf16x8 acc_frag(const f32x16& t, int sp) {
    u32x4 w;
    if (sp == 0) { w[0] = cvtpk(t[0], t[1]); w[1] = cvtpk(t[2], t[3]); w[2] = cvtpk(t[4], t[5]); w[3] = cvtpk(t[6], t[7]); }
    else { w[0] = cvtpk(t[8], t[9]); w[1] = cvtpk(t[10], t[11]); w[2] = cvtpk(t[12], t[13]); w[3] = cvtpk(t[14], t[15]); }
    return __builtin_bit_cast(bf16x8, w);
}
__device__ __forceinline__ void store_accfrag(__amdgpu_buffer_rsrc_t ro, int soff, int lane, const f32x16& t) {
    __builtin_amdgcn_raw_buffer_store_b128((u32x4){cvtpk(t[0], t[1]), cvtpk(t[2], t[3]), cvtpk(t[4], t[5]), cvtpk(t[6], t[7])}, ro, lane * 32, soff, 0);
    __builtin_amdgcn_raw_buffer_store_b128((u32x4){cvtpk(t[8], t[9]), cvtpk(t[10], t[11]), cvtpk(t[12], t[13]), cvtpk(t[14], t[15])}, ro, lane * 32 + 16, soff, 0);
}
struct ItemGeom { int b, h, dir, rbase, len, n0; };
__device__ __forceinline__ ItemGeom item_geom(int chain, int ci) { ItemGeom g; g.b = chain >> 4; g.h = (chain >> 1) & 7; g.dir = chain & 1; const bool isc = ci < 4;
    g.n0 = (isc ? ci : ci - 4) * 64; g.rbase = g.b * SROW + (isc ? 0 : TC); g.len = isc ? TC : T; return g; }
__device__ __forceinline__ int item_row(const ItemGeom& g, int i) { const int n = g.n0 + i; return g.rbase + (g.dir ? g.len - 1 - n : n); }

#define G1_LANES() int zs_ = 0; asm volatile("" : "+v"(zs_)); const int lane = (int)__builtin_amdgcn_mbcnt_hi(~0u, __builtin_amdgcn_mbcnt_lo(~0u, (unsigned)zs_)), r32 = lane & 31, hi = lane >> 5; (void)r32; (void)hi
__device__ __forceinline__ void pair_lock(volatile LAS unsigned* w) {
    for (;;) { unsigned got = 0u; if (__builtin_amdgcn_mbcnt_hi(~0u, __builtin_amdgcn_mbcnt_lo(~0u, 0u)) == 0u) got = (__hip_atomic_exchange((LAS unsigned*)w, 1u, __ATOMIC_RELAXED, __HIP_MEMORY_SCOPE_WORKGROUP) == 0u) ? 1u : 0u;
        got = (unsigned)__builtin_amdgcn_readfirstlane((int)got); if (got) break; __builtin_amdgcn_s_sleep(2); }
    asm volatile("s_waitcnt lgkmcnt(0)" ::: "memory"); }
__device__ __forceinline__ void pair_unlock(volatile LAS unsigned* w) { asm volatile("s_waitcnt vmcnt(0) lgkmcnt(0)" ::: "memory"); if (__builtin_amdgcn_mbcnt_hi(~0u, __builtin_amdgcn_mbcnt_lo(~0u, 0u)) == 0u) __hip_atomic_store((LAS unsigned*)w, 0u, __ATOMIC_RELAXED, __HIP_MEMORY_SCOPE_WORKGROUP); asm volatile("s_waitcnt lgkmcnt(0)" ::: "memory"); }
#ifndef G1_LOCK
#define G1_LOCK 0
#endif
#define LOCK_IF(m) do { if (G1_LOCK & (m)) pair_lock(lockw); } while (0)
#define UNLOCK_IF(m) do { if (G1_LOCK & (m)) pair_unlock(lockw); } while (0)
constexpr int G1_L = 0, G1_ARR = 8192, G1_TK = 9216, G1_TV = 17408, G1_TQ = 17408  , G1_WAVE_LDS = 26624;
__device__ __forceinline__ void g1_item(Frame& F, int item, LAS unsigned char* wl, volatile LAS unsigned* lockw) {
    int zz = 0; asm volatile("" : "+v"(zz)); __builtin_assume((unsigned)zz < 2u);
    const int chain = item / 68, ci = item - chain * 68; const ItemGeom G = item_geom(chain, ci); const int h = G.h;
    LAS float* Ls = (LAS float*)(wl + G1_L); LAS float* gcA = (LAS float*)(wl + G1_ARR), *btA = gcA + 64, *egA = gcA + 128, *etA = gcA + 192;
    const LAS bf16* TK = (const LAS bf16*)(wl + G1_TK); const LAS bf16* TV = (const LAS bf16*)(wl + G1_TV); const LAS bf16* TQ = (const LAS bf16*)(wl + G1_TQ);
    const bf16* QK = (const bf16*)(F.ws + WS_QKVN); const float* GB = (const float*)(F.ws + WS_GB);
    bf16* out = (bf16*)(F.ws + WS_GDNI) + (size_t)item * 16384;
    LOCK_IF(1);
    u32x4 tq[8];
    { G1_LANES(); u32x4 t[2][8];
#pragma unroll
      for (int j = 0; j < 8; ++j) { const int i = (lane >> 3) + 8 * j; const bf16* rp = QK + (size_t)item_row(G, i) * 1536 + h * 64 + (lane & 7) * 8;
          t[0][j] = *(const GAS u32x4*)(rp + 512); t[1][j] = *(const GAS u32x4*)(rp + 1024); tq[j] = *(const GAS u32x4*)rp; }
#pragma unroll
      for (int j = 0; j < 8; ++j) { const int o = ((lane >> 3) + 8 * j) * 128 + (lane & 7) * 16;
          *(LAS u32x4*)(wl + G1_TK + o) = t[0][j]; *(LAS u32x4*)(wl + G1_TV + o) = t[1][j]; } }
    float gl;
    { G1_LANES(); const int row = item_row(G, lane); float g = GB[(size_t)row * 32 + G.dir * 8 + h]; const float bt = GB[(size_t)row * 32 + 16 + G.dir * 8 + h];
#pragma unroll
      for (int o = 1; o < 64; o <<= 1) { const float t = __builtin_bit_cast(float, __builtin_amdgcn_ds_bpermute((lane - o) << 2, __builtin_bit_cast(int, g))); if (lane >= o) g += t; }
      gl = __builtin_bit_cast(float, __builtin_amdgcn_readlane(__builtin_bit_cast(int, g), 63)); gcA[lane] = g; btA[lane] = bt; egA[lane] = __expf(g); etA[lane] = __expf(gl - g); }
    asm volatile("s_waitcnt lgkmcnt(0)" ::: "memory");
    const LAS float* gcz = gcA + zz; const LAS float* btz = btA + zz; const LAS float* egz = egA + zz; const LAS float* etz = etA + zz;
    UNLOCK_IF(1); LOCK_IF(2);
    bf16x8 L21A[2];
    { G1_LANES(); bf16x8 Kf[2][4];
#pragma unroll
      for (int t = 0; t < 2; ++t)
#pragma unroll
          for (int s = 0; s < 4; ++s) Kf[t][s] = *(const LAS bf16x8*)(TK + (32 * t + r32) * 64 + 16 * s + 8 * hi);
#pragma unroll
      for (int t = 0; t < 2; ++t) { f32x16 acc = f32x16{};
#pragma unroll
          for (int s = 0; s < 4; ++s) acc = __builtin_amdgcn_mfma_f32_32x32x16_bf16(Kf[t][s], Kf[t][s], acc, 0, 0, 0);
          const float gcj = gcz[32 * t + r32];
#pragma unroll
          for (int r = 0; r < 16; ++r) { const int il = crow(r, hi), i = 32 * t + il; const float e = __expf(fminf(gcz[i] - gcj, 0.f)); const float v0 = btz[i] * acc[r] * e; Ls[t * 1024 + il * 32 + r32] = (r32 < il) ? v0 : 0.f; } }
      { f32x16 acc = f32x16{};
#pragma unroll
          for (int s = 0; s < 4; ++s) acc = __builtin_amdgcn_mfma_f32_32x32x16_bf16(Kf[0][s], Kf[1][s], acc, 0, 0, 0);
          const int i = 32 + r32; const float gci = gcz[i], bti = btz[i];
#pragma unroll
          for (int r = 0; r < 16; ++r) { const int j = crow(r, hi); acc[r] = bti * acc[r] * __expf(fminf(gci - gcz[j], 0.f)); }
          L21A[0] = acc_frag(acc, 0); L21A[1] = acc_frag(acc, 1); } }
    asm volatile("s_waitcnt lgkmcnt(0)" ::: "memory"); __builtin_amdgcn_sched_barrier(0);
    UNLOCK_IF(2); LOCK_IF(4);
    bf16x8 UF[4][2];
    const unsigned la = (unsigned)(uintptr_t)Ls + ((unsigned)zz << 4);
    { G1_LANES(); float x1[32], x2[32];
#pragma unroll
      for (int i = 0; i < 64; ++i) { const float v = bf2f(TV[i * 64 + lane]) * btz[i]; if (i < 32) x1[i & 31] = v; else x2[i & 31] = v; }
      asm volatile("s_waitcnt lgkmcnt(0)" ::: "memory");
#pragma unroll
      for (int j = 0; j < 8; ++j) *(LAS u32x4*)(wl + G1_TQ + ((lane >> 3) + 8 * j) * 128 + (lane & 7) * 16) = tq[j];
      solve_blocked(x1, x2, la, L21A, UF); }
    __builtin_amdgcn_sched_barrier(0);
    bf16x8 WF[4][2];
    { G1_LANES(); float x1[32], x2[32];
#pragma unroll
      for (int i = 0; i < 64; ++i) { const float v = bf2f(TK[i * 64 + lane]) * btz[i] * egz[i]; if (i < 32) x1[i & 31] = v; else x2[i & 31] = v; }
      solve_blocked(x1, x2, la, L21A, WF); }
    __builtin_amdgcn_sched_barrier(0);
    UNLOCK_IF(4); LOCK_IF(8);
    bf16x8 KTA[4][2];
    { G1_LANES(); float k1[32], k2[32];
#pragma unroll
      for (int i = 0; i < 32; ++i) { k1[i] = bf2f(TK[i * 64 + lane]) * etz[i]; k2[i] = bf2f(TK[(32 + i) * 64 + lane]) * etz[32 + i]; }
      col_frags32(k1, KTA, 0); col_frags32(k2, KTA, 2); }
    __builtin_amdgcn_sched_barrier(0);
    const __amdgpu_buffer_rsrc_t ro = __builtin_amdgcn_make_buffer_rsrc((void*)out, 0, 32768, 0x00020000);
    {
    G1_LANES();
    const float egl = __expf(gl);
#pragma unroll
    for (int at = 0; at < 2; ++at)
#pragma unroll
        for (int ct = 0; ct < 2; ++ct) { f32x16 a0 = f32x16{}, a1 = f32x16{};
#pragma unroll
            for (int s = 0; s < 4; ++s) { a0 = __builtin_amdgcn_mfma_f32_32x32x16_bf16(KTA[s][at], UF[s][ct], a0, 0, 0, 0); a1 = __builtin_amdgcn_mfma_f32_32x32x16_bf16(KTA[s][at], WF[s][ct], a1, 0, 0, 0); }
            store_accfrag(ro, 16384 + (at * 2 + ct) * 2048, lane, a0);
            const int vo = 4 * hi * 128 + (32 * ct + swap23(r32)) * 2;
#pragma unroll
            for (int r = 0; r < 16; ++r) { const float v = ((at == ct && crow(r, hi) == r32) ? egl : 0.f) - a1[r];
                __builtin_amdgcn_raw_buffer_store_b16((short)f2bf(v), ro, vo + (r & 3) * 128 + (r >> 2) * 1024, 32 * at * 128, 0); }
            __builtin_amdgcn_sched_barrier(0); }
    }
    UNLOCK_IF(8); LOCK_IF(16);
    bf16x8 XA[3][2];
    { G1_LANES(); bf16x8 Kf[4], Qf[2][4]; const LAS bf16* TK2 = TK + zz;
#pragma unroll
      for (int t = 0; t < 2; ++t)
#pragma unroll
          for (int s = 0; s < 4; ++s) Qf[t][s] = *(const LAS bf16x8*)(TQ + (32 * t + r32) * 64 + 16 * s + 8 * hi);
#pragma unroll
      for (int tl = 0; tl < 3; ++tl) { const int jt = tl == 2 ? 1 : 0, it = tl == 0 ? 0 : 1;
          if (tl != 1) {
#pragma unroll
              for (int s = 0; s < 4; ++s) Kf[s] = *(const LAS bf16x8*)(TK2 + (32 * jt + r32) * 64 + 16 * s + 8 * hi); }
          f32x16 acc = f32x16{};
#pragma unroll
          for (int s = 0; s < 4; ++s) acc = __builtin_amdgcn_mfma_f32_32x32x16_bf16(Kf[s], Qf[it][s], acc, 0, 0, 0);
          const int i = 32 * it + r32; const float gci = gcz[i];
#pragma unroll
          for (int r = 0; r < 16; ++r) { const int j = 32 * jt + crow(r, hi); const float e = __expf(fminf(gci - gcz[j], 0.f)); const float v0 = acc[r] * e; acc[r] = (j <= i) ? v0 : 0.f; }
          XA[tl][0] = acc_frag(acc, 0); XA[tl][1] = acc_frag(acc, 1); __builtin_amdgcn_sched_barrier(0); } }
    __builtin_amdgcn_sched_barrier(0);
    {
    G1_LANES();
#pragma unroll
    for (int it = 0; it < 2; ++it)
#pragma unroll
        for (int ct = 0; ct < 2; ++ct) { f32x16 a0 = f32x16{}, a1 = f32x16{};
#pragma unroll
            for (int jt = 0; jt <= it; ++jt) { const int tl = (it == 0) ? 0 : (jt == 0 ? 1 : 2);
#pragma unroll
                for (int sp = 0; sp < 2; ++sp) { a0 = __builtin_amdgcn_mfma_f32_32x32x16_bf16(XA[tl][sp], UF[2 * jt + sp][ct], a0, 0, 0, 0); a1 = __builtin_amdgcn_mfma_f32_32x32x16_bf16(XA[tl][sp], WF[2 * jt + sp][ct], a1, 0, 0, 0); } }
            store_accfrag(ro, 24576 + (it * 2 + ct) * 2048, lane, a0);
            const int vo = 4 * hi * 128 + (32 * ct + swap23(r32)) * 2; const int a = 32 * ct + r32;
#pragma unroll
            for (int r = 0; r < 16; ++r) { const int i = 32 * it + crow(r, hi); const float qv = bf2f(TQ[i * 64 + a]);
                __builtin_amdgcn_raw_buffer_store_b16((short)f2bf(qv * egz[i] - a1[r]), ro, vo + (r & 3) * 128 + (r >> 2) * 1024, 8192 + 32 * it * 128, 0); }
            __builtin_amdgcn_sched_barrier(0); }
    }
    asm volatile("s_waitcnt lgkmcnt(0)" ::: "memory");
    UNLOCK_IF(16);
}
__device__ __forceinline__ void scan_chain(Frame& F, int chain, int dc) {
    const int w = F.wave, lane = F.lane, r32 = lane & 31, hi = lane >> 5, role = (w >> 1) & 1, rt = w & 1;
    LAS u32x4* SF = (LAS u32x4*)(F.lds + RING_OFF);
    const bf16* base = (const bf16*)(F.ws + WS_GDNI) + (size_t)chain * 68 * 16384; bf16* OG = (bf16*)(F.ws + WS_OG);
    for (int i = F.tid; i < 2 * 4 * 64; i += 512) SF[i] = (u32x4){0u, 0u, 0u, 0u};
    const bf16* Ab = base + (role ? 4096 : 0) + (32 * rt + r32) * 64 + 8 * hi; const bf16* Cb = base + (role ? 12288 : 8192) + ((rt * 2 + dc) * 64 + lane) * 16;
    struct Ops { bf16x8 a[4]; u32x4 c[2]; };
#define SC_LOAD(o, ci_) do { const bf16* A_ = Ab + (size_t)(ci_) * 16384; const bf16* C_ = Cb + (size_t)(ci_) * 16384; \
        _Pragma("unroll") for (int s_ = 0; s_ < 4; ++s_) (o).a[s_] = *(const GAS bf16x8*)(A_ + 16 * s_); (o).c[0] = *(const GAS u32x4*)C_; (o).c[1] = *(const GAS u32x4*)(C_ + 8); } while (0)
#define SC_STEP(o, ci_) do { f32x16 acc; \
        _Pragma("unroll") for (int q = 0; q < 4; ++q) { acc[2 * q] = bflo((o).c[0][q]); acc[2 * q + 1] = bfhi((o).c[0][q]); acc[8 + 2 * q] = bflo((o).c[1][q]); acc[8 + 2 * q + 1] = bfhi((o).c[1][q]); } \
        const LAS u32x4* Sb = SF + (((ci_) & 1) * 256) + lane; \
        _Pragma("unroll") for (int s_ = 0; s_ < 4; ++s_) { const u32x4 bw = Sb[s_ * 64]; acc = __builtin_amdgcn_mfma_f32_32x32x16_bf16((o).a[s_], __builtin_bit_cast(bf16x8, bw), acc, 0, 0, 0); } \
        SC_LOAD(o, ((ci_) + SCAN_PF < 68) ? (ci_) + SCAN_PF : 67);     \
        if (role == 0) { LAS u32x4* Sn = SF + ((((((ci_) + 1) & 1)) * 4 + 2 * rt) * 64) + lane; Sn[0] = __builtin_bit_cast(u32x4, acc_frag(acc, 0)); Sn[64] = __builtin_bit_cast(u32x4, acc_frag(acc, 1)); } \
        else { const ItemGeom G = item_geom(chain, (ci_)); LAS bf16* stg = (LAS bf16*)(F.lds + RING_OFF + 16384 + rt * 2048);     \
            _Pragma("unroll") for (int r = 0; r < 16; ++r) stg[crow(r, hi) * 32 + r32] = (bf16)f2bf(acc[r]); \
            asm volatile("s_waitcnt lgkmcnt(0)" ::: "memory"); \
            const u32x4 v0 = *(const LAS u32x4*)(stg + (lane >> 1) * 32 + (lane & 1) * 16), v1 = *(const LAS u32x4*)(stg + (lane >> 1) * 32 + (lane & 1) * 16 + 8); \
            GAS u32x4* po = (GAS u32x4*)(OG + (size_t)item_row(G, 32 * rt + (lane >> 1)) * 1024 + G.dir * 512 + G.h * 64 + 32 * dc + (lane & 1) * 16); po[0] = v0; po[1] = v1; } \
        asm volatile("s_waitcnt lgkmcnt(0)" ::: "memory"); __builtin_amdgcn_s_barrier(); asm volatile("" ::: "memory"); } while (0)
    if (w < 4) {
        Ops o[SCAN_PF];
#pragma unroll
        for (int k = 0; k < SCAN_PF; ++k) SC_LOAD(o[k], k);
        __syncthreads();
#pragma unroll
        for (int ci = 0; ci < 68; ++ci) SC_STEP(o[ci % SCAN_PF], ci);
        asm volatile("s_waitcnt vmcnt(0)" ::: "memory");
    } else {
        __syncthreads();
#pragma unroll 1
        for (int ci = 0; ci < 68; ++ci) { __builtin_amdgcn_s_barrier(); asm volatile("" ::: "memory"); }
    }
#undef SC_LOAD
#undef SC_STEP
}
}
__device__ __forceinline__ void l1_prep(Frame& F) {
    bf16* P = (bf16*)(F.ws + WS_PROJ2); bf16* KM = (bf16*)(F.ws + WS_KMLA); const int lane = F.lane;
    for (int r = F.gw; r < NR; r += F.NGW) { const int b = r / SROW, s = r - b * SROW; const bool isc = s < TC; const int p = s - TC; bf16* row = P + (size_t)r * OINP;
        { bf16* CQ = (bf16*)(F.ws + WS_CQN) + (size_t)r * 640;
          const v2u a = *(const GAS v2u*)(row + O_CQ + 4 * lane); const v2u c = (lane < 32) ? *(const GAS v2u*)(row + O_CQ + 256 + 4 * lane) : (v2u){0u, 0u}; const v2u k = *(const GAS v2u*)(row + O_CKV + 4 * lane);
          const float a0 = bflo(a.x), a1 = bfhi(a.x), a2 = bflo(a.y), a3 = bfhi(a.y), c0 = bflo(c.x), c1 = bfhi(c.x), c2 = bflo(c.y), c3 = bfhi(c.y), k0 = bflo(k.x), k1 = bfhi(k.x), k2 = bflo(k.y), k3 = bfhi(k.y);
          const float sq = wave_sum(a0 * a0 + a1 * a1 + a2 * a2 + a3 * a3 + c0 * c0 + c1 * c1 + c2 * c2 + c3 * c3), skv = wave_sum(k0 * k0 + k1 * k1 + k2 * k2 + k3 * k3);
          const float rq = 1.f / sqrtf(sq * (1.f / 384.f) + EPS), rk = 1.f / sqrtf(skv * (1.f / 256.f) + EPS);
          *(GAS v2u*)(CQ + 4 * lane) = (v2u){pk2(a0 * rq, a1 * rq), pk2(a2 * rq, a3 * rq)};
          if (lane < 32) *(GAS v2u*)(CQ + 256 + 4 * lane) = (v2u){pk2(c0 * rq, c1 * rq), pk2(c2 * rq, c3 * rq)};
          *(GAS v2u*)(CQ + 384 + 4 * lane) = (v2u){pk2(k0 * rk, k1 * rk), pk2(k2 * rk, k3 * rk)}; }
        if (lane < 16) { const int seg = lane >> 3, i = lane & 7, d0 = seg * 16 + i; float x0 = bf2f(row[O_KR + d0]), x1 = bf2f(row[O_KR + d0 + 8]);
            if (!isc) { const float pos = (float)(seg ? (p & 63) : (p >> 6)); const float ang = pos * __powf(10000.f, -(float)i * (1.f / 8.f)); float sn, cs; sincosf(ang, &sn, &cs);
                const float y0 = x0 * cs - x1 * sn, y1 = x1 * cs + x0 * sn; x0 = y0; x1 = y1; }
            const bf16 b0 = (bf16)f2bf(x0), b1 = (bf16)f2bf(x1);
#pragma unroll
            for (int h = 0; h < 8; ++h) { KM[(size_t)r * 768 + h * 96 + 64 + d0] = b0; KM[(size_t)r * 768 + h * 96 + 64 + d0 + 8] = b1; } }
        if (!isc) {
            const int pi = lane & 31, seg = pi >> 4, i = pi & 15, d0 = seg * 32 + i; const float pos = (float)(seg ? (p & 63) : (p >> 6));
            const float ang = pos * __powf(10000.f, -(float)i * (1.f / 16.f)); float sn, cs; sincosf(ang, &sn, &cs);
#pragma unroll
            for (int q = 0; q < 8; ++q) { const int hh = (lane >> 5) + 2 * q; bf16* base = row + (hh < 8 ? O_DQ + hh * 64 : O_DK + (hh - 8) * 64) + d0;
                const float x0 = bf2f(base[0]), x1 = bf2f(base[16]); base[0] = (bf16)f2bf(x0 * cs - x1 * sn); base[16] = (bf16)f2bf(x1 * cs + x0 * sn); } }
    }
}
__device__ __forceinline__ void l1_qrope(Frame& F) {
    bf16* QM = (bf16*)(F.ws + WS_QM); const int lane = F.lane;
    for (int r = F.gw; r < NR; r += F.NGW) { const int b = r / SROW, s = r - b * SROW; if (s < TC) continue; const int p = s - TC;
        const int pi = lane & 15, seg = pi >> 3, i = pi & 7, d0 = seg * 16 + i; const float pos = (float)(seg ? (p & 63) : (p >> 6));
        const float ang = pos * __powf(10000.f, -(float)i * (1.f / 8.f)); float sn, cs; sincosf(ang, &sn, &cs);
#pragma unroll
        for (int q = 0; q < 2; ++q) { const int h = (lane >> 4) + 4 * q; bf16* base = QM + (size_t)r * 768 + h * 96 + 64 + d0;
            const float x0 = bf2f(base[0]), x1 = bf2f(base[8]); base[0] = (bf16)f2bf(x0 * cs - x1 * sn); base[8] = (bf16)f2bf(x1 * cs + x0 * sn); } }
}
__device__ __forceinline__ void l1_attn_unit(Frame& F, int u) {
    if (u < 512) { const int b = u >> 7, qb = (u >> 3) & 15, h = u & 7; const size_t rq = (size_t)b * SROW + TC + qb * 256, r0 = (size_t)b * SROW;
        constexpr float SC = 0.10206207261596575f  , C = SC * 1.4426950408889634f, THRS = att::THR / SC;
        const bf16* QM = (const bf16*)(F.ws + WS_QM); const bf16* KM = (const bf16*)(F.ws + WS_KMLA); const bf16* VM = (const bf16*)(F.ws + WS_VMLA); bf16* MIX = (bf16*)(F.ws + WS_MIX);
        att::attn_unit<96, 64, 0, true>(QM + rq * 768 + h * 96, 768, KM + r0 * 768 + h * 96, 768, VM + r0 * 512 + h * 64, 512, MIX + rq * 1024 + h * 64, 1024, SROW / 64, 0, qb * 256, C, THRS, -3.0e38f, F.ldsg + RING_OFF);
    } else { const int v = u - 512, b = v >> 6, qb = (v >> 2) & 15, head = v & 3; const size_t rq = (size_t)b * SROW + TC + qb * 256, r0 = (size_t)b * SROW;
        constexpr float SC = 0.125f, C = SC * 1.4426950408889634f, THRS = att::THR / SC; constexpr float LAM_INIT = 0.35550906759096556f;
        const float* lp = F.in[I_OLAM]; const float lam = __expf(wave_sum(lp[F.lane] * lp[64 + F.lane])) - __expf(wave_sum(lp[128 + F.lane] * lp[192 + F.lane])) + LAM_INIT;
        const bf16* P = (const bf16*)(F.ws + WS_PROJ2); bf16* MIX = (bf16*)(F.ws + WS_MIX); const int hh = 2 * head;
        att::attn_unit<64, 128, 0, false, 1>(P + rq * OINP + O_DQ + hh * 64, OINP, P + r0 * OINP + O_DK + hh * 64, OINP, P + r0 * OINP + O_DV + head * 128, OINP, MIX, 1024, SROW / 64, 0, 0, C, THRS, -3.0e38f, F.ldsg + RING_OFF);
        att::attn_unit<64, 128, 0, false, 2>(P + rq * OINP + O_DQ + (hh + 1) * 64, OINP, P + r0 * OINP + O_DK + (hh + 1) * 64, OINP, P + r0 * OINP + O_DV + head * 128, OINP, MIX + rq * 1024 + 512 + head * 128, 1024, SROW / 64, 0, 0, C, THRS, -3.0e38f, F.ldsg + RING_OFF,
                                             lam, F.in[I_OSUBLN], 1.f - LAM_INIT); }
}
__device__ __forceinline__ void l1_diff_post(Frame& F) {
    const bf16* OD = (const bf16*)(F.ws + WS_ODIFF); bf16* MIX = (bf16*)(F.ws + WS_MIX); const int lane = F.lane; const float* lp = F.in[I_OLAM];
    constexpr float LAM_INIT = 0.35550906759096556f;
    const float s01 = wave_sum(lp[lane] * lp[64 + lane]), s23 = wave_sum(lp[128 + lane] * lp[192 + lane]); const float lam = __expf(s01) - __expf(s23) + LAM_INIT;
    const int head = lane >> 4, d = (lane & 15) * 8; const f32x4 w0 = *(const GAS f32x4*)(F.in[I_OSUBLN] + d), w1 = *(const GAS f32x4*)(F.in[I_OSUBLN] + d + 4);
    const float ww[8] = {w0.x, w0.y, w0.z, w0.w, w1.x, w1.y, w1.z, w1.w};
    for (int r = F.gw; r < NR; r += F.NGW) { const int b = r / SROW, s = r - b * SROW; if (s < TC) continue;
        const v4u a = *(const GAS v4u*)(OD + (size_t)r * 1024 + (2 * head) * 128 + d), c = *(const GAS v4u*)(OD + (size_t)r * 1024 + (2 * head + 1) * 128 + d);
        float o[8] = {bflo(a.x) - lam * bflo(c.x), bfhi(a.x) - lam * bfhi(c.x), bflo(a.y) - lam * bflo(c.y), bfhi(a.y) - lam * bfhi(c.y), bflo(a.z) - lam * bflo(c.z), bfhi(a.z) - lam * bfhi(c.z), bflo(a.w) - lam * bflo(c.w), bfhi(a.w) - lam * bfhi(c.w)};
        float ss = 0.f;
#pragma unroll
        for (int e = 0; e < 8; ++e) ss += o[e] * o[e];
        ss += __shfl_xor(ss, 1); ss += __shfl_xor(ss, 2); ss += __shfl_xor(ss, 4); ss += __shfl_xor(ss, 8);
        const float rs = (1.f - LAM_INIT) / sqrtf(ss * (1.f / 128.f) + EPS);
#pragma unroll
        for (int e = 0; e < 8; ++e) o[e] = o[e] * rs * ww[e];
        *(GAS v4u*)(MIX + (size_t)r * 1024 + 512 + head * 128 + d) = (v4u){pk2(o[0], o[1]), pk2(o[2], o[3]), pk2(o[4], o[5]), pk2(o[6], o[7])}; }
}
__device__ __forceinline__ void moe_bases(Frame& F, int (&base)[8], int& ntiles) { int acc = 0;
#pragma unroll
    for (int e = 0; e < 8; ++e) { base[e] = acc; const int c = (int)__hip_atomic_load((unsigned*)(F.ctl + CW_MOECNT + 64 * e), RLX_AGENT); acc += (c + 255) & ~255; }
    ntiles = acc >> 8; }
constexpr size_t META_TEXP = 640 * 1024, META_POS = 768 * 1024;
__device__ __forceinline__ int row_vcu(const Frame& F, int r) { return (r % F.NGW) >> 3; }
__device__ __forceinline__ void moe_gather(Frame& F) {
    int base[8], ntiles; moe_bases(F, base, ntiles);
    int* TEXP = (int*)(F.ws + WS_META + META_TEXP); int* POS = (int*)(F.ws + WS_META + META_POS);
    const int* TOPI = (const int*)(F.ws + WS_META + META_TOPI); const int* RANK = (const int*)(F.ws + WS_META + META_RANK);
    if (blockIdx.x == 0 && F.tid < 144) { const int t = F.tid; int e = 0;
#pragma unroll
        for (int q = 1; q < 8; ++q) if (t * 256 >= base[q]) e = q;
        TEXP[t] = e; if (t == 143) TEXP[144] = ntiles; }
    const bf16* FIN = (const bf16*)(F.ws + WS_FIN2); bf16* AS = (bf16*)(F.ws + WS_ASORT);
    for (int tk0 = F.gw; tk0 < NB * T; tk0 += 8 * F.NGW) { int posl = 0;
        { const int i = F.lane >> 1, sl = F.lane & 1, tk = tk0 + i * F.NGW;
          if (F.lane < 16 && tk < NB * T) { const int b = tk / T, t = tk - b * T; const int e = TOPI[tk * 2 + sl]; int bs = 0;
#pragma unroll
              for (int q = 0; q < 8; ++q) if (q == e) bs = base[q];
              posl = bs + ((const int*)(F.ws + WS_META + META_BLKB))[tok_vcu(F, b, t) * 8 + e] + RANK[tk * 2 + sl]; POS[tk * 2 + sl] = posl; } }
#pragma unroll
        for (int i = 0; i < 8; ++i) { const int tk = tk0 + i * F.NGW; if (tk < NB * T) { const int b = tk / T, t = tk - b * T; const size_t r = (size_t)b * SROW + TC + t;
            const GAS v4u* src = (const GAS v4u*)(FIN + r * D) + F.lane; const v4u x0 = src[0], x1 = src[64];
            const int p0 = __builtin_amdgcn_readlane(posl, 2 * i), p1 = __builtin_amdgcn_readlane(posl, 2 * i + 1);
            GAS v4u* d0 = (GAS v4u*)(AS + (size_t)p0 * D) + F.lane; d0[0] = x0; d0[64] = x1;
            GAS v4u* d1 = (GAS v4u*)(AS + (size_t)p1 * D) + F.lane; d1[0] = x0; d1[64] = x1; } } }
}
__device__ __forceinline__ Row4 moe_out_row(Frame& F, const bf16* OR, int pos_) {
    const int pos = __builtin_amdgcn_readfirstlane(pos_), tile = pos >> 8, part = tile >= 68 ? 1 : 0, local = tile - 68 * part;
    if (local < 64) return ld_row_bf16(OR + (size_t)pos * D, F.lane);
    const float* P = (const float*)(F.ws + (part ? WS_WXGU : WS_FIN2)) + ((size_t)(local - 64) * 256 + (pos & 255)) * 1024; Row4 y = ld_row_f32(P, F.lane);
    for (int s = 1; s < DFX / MOE_KSL; ++s) { const Row4 p = ld_row_f32(P + (size_t)s * 4 * 256 * 1024, F.lane);
#pragma unroll
        for (int j = 0; j < 4; ++j) y.v[j] += p.v[j]; }
    return y; }
__device__ __forceinline__ void rows_final(Frame& F) {
    const bf16* OR = (const bf16*)(F.ws + WS_ASORT); const int* POS = (const int*)(F.ws + WS_META + META_POS); const float* TOPW = (const float*)(F.ws + WS_META + META_TOPW);
    const int wpb = F.NGW >> 2, b = F.gw / wpb, wl = F.gw - b * wpb; const Row4 W = ld_row_f32(F.in[I_ONORMS] + 3 * 1024, F.lane), Gt = ld_row_f32(modvec(F, 1, b, 5), F.lane);
    for (int t0 = wl; t0 < T; t0 += 8 * wpb) { int posl = 0; float wgl = 0.f;
        { const int i = F.lane >> 1, sl = F.lane & 1, t = t0 + i * wpb; if (F.lane < 16 && t < T) { posl = POS[(b * T + t) * 2 + sl]; wgl = TOPW[(b * T + t) * 2 + sl]; } }
#pragma unroll
        for (int i = 0; i < 8; ++i) { const int t = t0 + i * wpb; if (t < T) { const int tk = b * T + t; float* xr = F.out + (size_t)tk * D;
            Row4 x = ld_row_bf16((const bf16*)(F.ws + WS_XB) + (size_t)tk * D, F.lane);
            const Row4 y0 = moe_out_row(F, OR, __builtin_amdgcn_readlane(posl, 2 * i)), y1 = moe_out_row(F, OR, __builtin_amdgcn_readlane(posl, 2 * i + 1));
            const float w0 = __uint_as_float((unsigned)__builtin_amdgcn_readlane((int)__float_as_uint(wgl), 2 * i)), w1 = __uint_as_float((unsigned)__builtin_amdgcn_readlane((int)__float_as_uint(wgl), 2 * i + 1)); Row4 y;
#pragma unroll
            for (int j = 0; j < 4; ++j) y.v[j] = y0.v[j] * w0 + y1.v[j] * w1;
            add_gated_norm_r(x, y, W, Gt); st_row_f32(xr, F.lane, x); } } }
}
constexpr int N_PHASES = 26;
__global__ void __launch_bounds__(NWAVES * 64, 2) trunk_fwd(Args args) {
    extern __shared__ __attribute__((aligned(16))) unsigned char lds[];
    Frame F;
    F.lds = (LAS unsigned char*)lds; F.ldsg = (char*)lds;
    F.MISC = (volatile LAS unsigned*)(F.lds + MISC_OFF);
    F.wave = __builtin_amdgcn_readfirstlane((int)threadIdx.x >> 6);
#define REFRESH() do { int z_ = 0; asm volatile("" : "+v"(z_)); F.lane = (int)__builtin_amdgcn_mbcnt_hi(~0u, __builtin_amdgcn_mbcnt_lo(~0u, (unsigned)z_)); F.tid = F.wave * 64 + F.lane; } while (0)
    REFRESH();
    F.G = gridDim.x; { const int bx = blockIdx.x; F.vcu = (F.G % 8 == 0) ? (bx % 8) * (F.G / 8) + bx / 8 : bx; }
    F.gw = F.vcu * NWAVES + F.wave; F.NGW = F.G * NWAVES;
    F.in = args.in; F.out = args.out; F.ws = args.ws; F.ctl = (gu32*)(args.ws + WS_CTL);
    unsigned char* ws = args.ws;
    for (int u = F.tid; u < (LDS_BYTES - MISC_OFF) / 4; u += NWAVES * 64) ((LAS unsigned*)(F.lds + MISC_OFF))[u] = 0u;
    __syncthreads();
    XcdBarrier bar; bar.bar = (unsigned*)(F.ctl + CW_BAR); bar.x = 0; bar.st = nullptr;
    const int lo = args.ph_lo, hi = args.ph_hi;
    const bool use_bar = (hi - lo) > 1;
    if (use_bar) bar = xcd_barrier_post((unsigned*)(F.ctl + CW_BAR), F.MISC + 8);
#ifndef MK_ONLY
#define MK_ONLY_OK(k) true
#else
#define MK_ONLY_OK(k) ((k) == MK_ONLY)
#endif
#define IN(k) (MK_ONLY_OK(k) && lo <= (k) && (k) < hi && (k) <= MK_LAST_PHASE)
#ifndef PROBE_MULT
#define PROBE_MULT 4
#endif
#ifndef PROBE_SPAN
#define PROBE_SPAN 1
#endif
#ifndef SCAN_REP
#define SCAN_REP 1
#endif
#ifndef SWA_REP
#define SWA_REP 1
#endif
#ifndef CHK_MASK
#define CHK_MASK 0xffu
#endif
#ifndef MK_REP_MASK
#define MK_REP_MASK 0u
#endif
#define REPS(k) ((((unsigned)MK_REP_MASK >> (k)) & 1u) ? 2 : 1)
#ifdef PROBE_PHASE
#define STAMP(k) do { if (blockIdx.x == 0 && F.tid == 0) { const unsigned long long t_ = __builtin_amdgcn_s_memrealtime(); F.MISC[64 + 2 * (k)] = (unsigned)t_; F.MISC[65 + 2 * (k)] = (unsigned)(t_ >> 32); } } while (0)
#else
#define STAMP(k) do { } while (0)
#endif
#define SEAM(k) do { if (IN(k) && IN((k) + 1)) xcd_barrier(bar); STAMP((k) + 1); } while (0)
    typedef pg8::bf16_t pb;
    const int bid = blockIdx.x;

    STAMP(0);
    if (IN(0)) for (int rep_ = 0; rep_ < REPS(0); ++rep_) { REFRESH(); p0_prologue(F); } SEAM(0);
    if (IN(1)) for (int rep_ = 0; rep_ < REPS(1); ++rep_) { REFRESH(); p1_first_rows(F); } SEAM(1);
    if (IN(2)) for (int rep_ = 0; rep_ < REPS(2); ++rep_) { REFRESH();
        pg8::Gemm g{(const pb*)(ws + WS_ABUF), (const pb*)(ws + WS_WEIN), NR, EINP, 1024, 1024, 1024}; pg8::StaticOrder S; S.init(NR, EINP, F.G, bid);
        pg8::EpiStore E{(pb*)(ws + WS_PROJ), EINP, EINP / 256};
        pg8::gemm_phase<pg8::EpiStore, pg8::StaticOrder, PG8_ALIGN, PG8_SP2>(F.lds + RING_OFF, g, S, E); } SEAM(2);
    if (IN(3)) for (int rep_ = 0; rep_ < REPS(3); ++rep_) { REFRESH(); g0_prep(F); } SEAM(3);
#ifdef GDN_SLOW
    if (IN(5)) for (int rep_ = 0; rep_ < REPS(5); ++rep_) { REFRESH();
        if (F.G > 64) { if (bid < 64) gdn_chain(F, bid); else for (int u = bid - 64; u < 544; u += F.G - 64) swa_unit(F, u); }
        else { for (int c = bid; c < 64; c += F.G) gdn_chain(F, c); for (int u = bid; u < 544; u += F.G) swa_unit(F, u); } } SEAM(5);
#else
    if (IN(4)) for (int rep_ = 0; rep_ < REPS(4); ++rep_) { REFRESH();
#if G1_LOCK
        if ((F.wave & 3) == 0) for (int item = F.vcu * 2 + (F.wave >> 2); item < 64 * 68; item += F.G * 2) gdn::g1_item(F, item, F.lds + RING_OFF + (F.wave >> 2) * gdn::G1_WAVE_LDS, F.MISC + 16);
#else
        const int n_main = ((64 * 68) / (F.G * 4)) * (F.G * 4), n_late = (64 * 68 - n_main + 3) / 4;
        if (F.wave < 4) { const int R = n_main / (F.G * 4);
            _Pragma("unroll 1") for (int r = 0; r <= R; ++r) { int item;
                if (r < R) item = F.vcu * 4 + F.wave + r * F.G * 4; else { if (F.vcu >= n_late) break; item = n_main + F.vcu * 4 + F.wave; if (item >= 64 * 68) break; }
                gdn::g1_item(F, item, F.lds + RING_OFF + F.wave * gdn::G1_WAVE_LDS, F.MISC + 16); } }
        else p0_deferred(F, F.wave - 4, F.lds + RING_OFF + 4 * gdn::G1_WAVE_LDS + (F.wave - 4) * 8448);
        if (F.vcu >= n_late) { __syncthreads(); REFRESH();
            if (F.tid == 0) F.MISC[20] = __hip_atomic_fetch_add((unsigned*)(F.ctl + CW_SWAQ), 1u, RLX_AGENT);
            __syncthreads(); const int u = (int)F.MISC[20]; __syncthreads();
            if (u < 544) swa_unit(F, u); }
#endif
    } SEAM(4);
    if (IN(5)) for (int rep_ = 0; rep_ < REPS(5); ++rep_) { REFRESH();
        STAMP(30); if (bid < 128) for (int c = bid; c < 128; c += F.G) { gdn::scan_chain(F, c >> 1, c & 1); __syncthreads(); } STAMP(31);
        REFRESH();
        for (;;) { if (F.tid == 0) F.MISC[20] = __hip_atomic_fetch_add((unsigned*)(F.ctl + CW_SWAQ), 1u, RLX_AGENT);
            __syncthreads(); const int u = (int)F.MISC[20]; __syncthreads();
            if (u >= 544 * REPS(5) * SWA_REP) break;
            swa_unit(F, u % 544); } } SEAM(5);
#endif
    if (IN(6)) for (int rep_ = 0; rep_ < REPS(6); ++rep_) { REFRESH(); g4_gdn_out(F); } SEAM(6);
    if (IN(7)) for (int rep_ = 0; rep_ < REPS(7); ++rep_) { REFRESH();
        { pg8::Gemm g{(const pb*)(ws + WS_MIX), (const pb*)(ws + WS_WEOUT), NR, 1024, 1024, 1024, 1024}; pg8::LatOrder S; S.init(1024, F.G, bid);
          pg8::EpiStore E{(pb*)(ws + WS_YBUF), 1024, 4};
          pg8::gemm_phase<pg8::EpiStore, pg8::LatOrder, PG8_ALIGN, PG8_SP2>(F.lds + RING_OFF, g, S, E); }
        __syncthreads();
        { pg8::Gemm g{(const pb*)(ws + WS_MIX), (const pb*)(ws + WS_WEOUT), NR, 1024, 256, 1024, 1024}; pg8::CtxSplitOrder S; S.init(4, 256, F.G, bid);
          pg8::EpiPartF32 E{(float*)(ws + WS_PART), 256};
          pg8::gemm_phase<pg8::EpiPartF32, pg8::CtxSplitOrder, PG8_ALIGN, PG8_SP2>(F.lds + RING_OFF, g, S, E); } } SEAM(7);
    if (IN(8)) for (int rep_ = 0; rep_ < REPS(8); ++rep_) { REFRESH(); rows_mid<false>(F, (const bf16*)(ws + WS_YBUF), F.in[I_ENORMS] + 1024, 0, 2, F.in[I_ENORMS] + 2048, 0, 3, (bf16*)(ws + WS_ABUF), false, 4); } SEAM(8);
    if (IN(9)) for (int rep_ = 0; rep_ < REPS(9); ++rep_) { REFRESH();
        pg8::Gemm g{(const pb*)(ws + WS_ABUF), (const pb*)(ws + WS_WEGU), NR, 2 * DFF, 1024, 1024, 1024}; pg8::StaticOrder S; S.init(NR, 2 * DFF, F.G, bid);
        pg8::EpiSwiGLU E{(pb*)(ws + WS_HID), DFF, DFF / 128};
        pg8::gemm_phase<pg8::EpiSwiGLU, pg8::StaticOrder, PG8_ALIGN, PG8_SP2>(F.lds + RING_OFF, g, S, E); } SEAM(9);
    if (IN(10)) for (int rep_ = 0; rep_ < REPS(10); ++rep_) { REFRESH();
        { pg8::Gemm g{(const pb*)(ws + WS_HID), (const pb*)(ws + WS_WEDN), NR, 1024, DFF, DFF, DFF}; pg8::LatOrder S; S.init(1024, F.G, bid);
          pg8::EpiStore E{(pb*)(ws + WS_YBUF), 1024, 4};
          pg8::gemm_phase<pg8::EpiStore, pg8::LatOrder, PG8_ALIGN, PG8_SP2>(F.lds + RING_OFF, g, S, E); }
        __syncthreads();
        { pg8::Gemm g{(const pb*)(ws + WS_HID), (const pb*)(ws + WS_WEDN), NR, 1024, 256, DFF, DFF}; pg8::CtxSplitOrder S; S.init(11, 256, F.G, bid);
          pg8::EpiPartF32 E{(float*)(ws + WS_PART), 256};
          pg8::gemm_phase<pg8::EpiPartF32, pg8::CtxSplitOrder, PG8_ALIGN, PG8_SP2>(F.lds + RING_OFF, g, S, E); } } SEAM(10);
    if (IN(11)) for (int rep_ = 0; rep_ < REPS(11); ++rep_) { REFRESH(); rows_mid<false>(F, (const bf16*)(ws + WS_YBUF), F.in[I_ENORMS] + 3072, 0, 5, F.in[I_ONORMS], 1, 0, (bf16*)(ws + WS_ABUF), false, 11); } SEAM(11);
    if (IN(12)) for (int rep_ = 0; rep_ < REPS(12); ++rep_) { REFRESH();
        pg8::Gemm g{(const pb*)(ws + WS_ABUF), (const pb*)(ws + WS_WOIN), NR, OINP, 1024, 1024, 1024}; pg8::StaticOrder S; S.init(NR, OINP, F.G, bid);
        pg8::EpiStore E{(pb*)(ws + WS_PROJ2), OINP, OINP / 256};
        pg8::gemm_phase<pg8::EpiStore, pg8::StaticOrder, PG8_ALIGN, PG8_SP2>(F.lds + RING_OFF, g, S, E); } SEAM(12);
    if (IN(13)) for (int rep_ = 0; rep_ < REPS(13); ++rep_) { REFRESH(); l1_prep(F); } SEAM(13);
    if (IN(14)) for (int rep_ = 0; rep_ < REPS(14); ++rep_) { REFRESH();
#if !defined(T13) || T13 == 1
        { pg8::Gemm g{(const pb*)(ws + WS_CQN), (const pb*)(ws + WS_WUQ), NR, 768, 384, 640, 384}; pg8::LatOrder S; S.init(768, F.G, bid);
          pg8::EpiStore E{(pb*)(ws + WS_QM), 768, 3};
          pg8::gemm_phase<pg8::EpiStore, pg8::LatOrder, PG8_ALIGN, PG8_SP2>(F.lds + RING_OFF, g, S, E); }
#endif
        __syncthreads();
#if !defined(T13) || T13 == 2
        { pg8::Gemm g{(const pb*)(ws + WS_CQN) + 384, (const pb*)(ws + WS_WUKV), NR, 1024, 256, 640, 256}; pg8::StaticOrder S; S.init(NR, 1024, F.G, bid);
          pg8::EpiKV E{(pb*)(ws + WS_KMLA), (pb*)(ws + WS_VMLA)};
          pg8::gemm_phase<pg8::EpiKV, pg8::StaticOrder, PG8_ALIGN, PG8_SP2>(F.lds + RING_OFF, g, S, E); }
#endif
    } SEAM(14);
    STAMP(16);
    if (IN(16)) for (int rep_ = 0; rep_ < REPS(16); ++rep_) { REFRESH(); for (int u = F.vcu; u < 768; u += F.G) l1_attn_unit(F, u); } SEAM(16);
    STAMP(18);
    if (IN(18)) for (int rep_ = 0; rep_ < REPS(18); ++rep_) { REFRESH();
        pg8::Gemm g{(const pb*)(ws + WS_MIX), (const pb*)(ws + WS_WOOUT), NR, 1024, 1024, 1024, 1024}; pg8::LatOrder S; S.init(1024, F.G, bid);
        pg8::EpiStore E{(pb*)(ws + WS_Y2), 1024, 4};
        pg8::gemm_phase<pg8::EpiStore, pg8::LatOrder, PG8_ALIGN, PG8_SP2>(F.lds + RING_OFF, g, S, E); } SEAM(18);
    if (IN(19)) for (int rep_ = 0; rep_ < REPS(19); ++rep_) { REFRESH();
        router_table(F);
        if (F.wave >= 4) px_expert_weights(F);
        rows_mid<true>(F, (const bf16*)(ws + WS_Y2), F.in[I_ONORMS] + 1024, 1, 2, F.in[I_ONORMS] + 2048, 1, 3, (bf16*)(ws + WS_FIN2), true);
        if (F.wave < 4) px_expert_weights(F);
        router_tail(F); } SEAM(19);
    if (IN(20)) for (int rep_ = 0; rep_ < REPS(20); ++rep_) { REFRESH(); moe_gather(F); } SEAM(20);
#define MOE_PART(kgu, kdn, t0_, cap_) \
    if (IN(kgu)) for (int rep_ = 0; rep_ < REPS(kgu); ++rep_) { REFRESH(); int base[8], ntiles; moe_bases(F, base, ntiles); const int t0 = (t0_), ntl = (ntiles - t0 < 0) ? 0 : ((ntiles - t0 < (cap_)) ? ntiles - t0 : (cap_)); \
        pg8::Gemm g{(const pb*)(ws + WS_ASORT) + (size_t)t0 * 256 * 1024, (const pb*)(ws + WS_WXGU), 0, 0, 1024, 1024, 1024}; pg8::MoeOrder S; S.init(ntl, 28, F.G, bid, (const int*)(ws + WS_META + META_TEXP), t0); \
        pg8::EpiSwiGLU E{(pb*)(ws + WS_HIDX), DFX, 28}; \
        pg8::gemm_phase<pg8::EpiSwiGLU, pg8::MoeOrder, PG8_ALIGN, PG8_SP2>(F.lds + RING_OFF, g, S, E); \
        if ((t0_) == 0 && ntl > 0) { const int nu = ntl * 28, remu = nu % F.G, first = remu ? remu : 0, ns = F.G - first;     \
            const int esp = ((const int*)(ws + WS_META + META_TEXP))[ntl - 1]; \
            if (bid >= first) { __syncthreads(); px_expert_down(F, (bid - first) * NWAVES + F.wave, ns * NWAVES, 0, esp + 1); } } } SEAM(kgu); \
    if (IN(kdn)) for (int rep_ = 0; rep_ < REPS(kdn); ++rep_) { REFRESH(); int base[8], ntiles; moe_bases(F, base, ntiles); const int t0 = (t0_), ntl = (ntiles - t0 < 0) ? 0 : ((ntiles - t0 < (cap_)) ? ntiles - t0 : (cap_)); \
        const int full = ntl < 64 ? ntl : 64, ex = ntl - full; \
        { pg8::Gemm g{(const pb*)(ws + WS_HIDX), (const pb*)(ws + WS_WXDN), 0, 0, DFX, DFX, DFX}; pg8::MoeOrder S; S.init(full, 4, F.G, bid, (const int*)(ws + WS_META + META_TEXP), t0); \
          pg8::EpiStore E{(pb*)(ws + WS_ASORT) + (size_t)t0 * 256 * 1024, 1024, 4}; \
          pg8::gemm_phase<pg8::EpiStore, pg8::MoeOrder, PG8_ALIGN, PG8_SP2>(F.lds + RING_OFF, g, S, E); } \
        if (ex > 0) { __syncthreads(); \
          pg8::Gemm g{(const pb*)(ws + WS_HIDX), (const pb*)(ws + WS_WXDN), 0, 0, MOE_KSL, DFX, DFX}; pg8::MoeSplitOrder S; S.init(ex, DFX / MOE_KSL, MOE_KSL, F.G, bid, (const int*)(ws + WS_META + META_TEXP), t0); \
          pg8::EpiMoePart E{(float*)(ws + ((t0_) ? WS_WXGU : WS_FIN2)), MOE_KSL}; \
          pg8::gemm_phase<pg8::EpiMoePart, pg8::MoeSplitOrder, PG8_ALIGN, PG8_SP2>(F.lds + RING_OFF, g, S, E); } \
        if ((t0_) == 0 && ntl > 0) { const int nsu = ex * 4 * (DFX / MOE_KSL), first = nsu < F.G ? nsu : 0, ns = F.G - first;     \
            const int esp = ((const int*)(ws + WS_META + META_TEXP))[ntl - 1]; \
            if (bid >= first && esp + 1 < NEXP) { __syncthreads(); px_expert_down(F, (bid - first) * NWAVES + F.wave, ns * NWAVES, esp + 1, NEXP); } } } SEAM(kdn);
    MOE_PART(21, 22, 0, 68)
    MOE_PART(23, 24, 68, 68)
    if (IN(25)) for (int rep_ = 0; rep_ < REPS(25); ++rep_) { REFRESH(); rows_final(F);
#if defined(CHK_G1) || defined(CHK_SCAN)
        { const unsigned fb = __hip_atomic_load((unsigned*)(F.ctl + CW_CHK), RLX_AGENT) & CHK_MASK; if (fb != 0u) { VM_WAIT(); __syncthreads(); for (int i = F.gw * 64 + F.lane; i < NB * T * D; i += F.NGW * 64) F.out[i] = 0.f; } }
#endif
    }
#ifdef PROBE_PHASE
    STAMP(26);
    if (blockIdx.x == 0 && F.tid == 0) {
        const unsigned long long t0 = ((unsigned long long)F.MISC[65 + 2 * PROBE_PHASE] << 32) | F.MISC[64 + 2 * PROBE_PHASE], t1 = ((unsigned long long)F.MISC[65 + 2 * (PROBE_PHASE + PROBE_SPAN)] << 32) | F.MISC[64 + 2 * (PROBE_PHASE + PROBE_SPAN)];
        unsigned long long dly = (t1 - t0) * PROBE_MULT; if (dly > 2000000ull) dly = 2000000ull; const unsigned long long s0 = __builtin_amdgcn_s_memrealtime();
        while (__builtin_amdgcn_s_memrealtime() - s0 < dly) __builtin_amdgcn_s_sleep(8); }
#endif
#undef IN
#undef SEAM
}

extern "C" void kernel_launch(void* const* d_in, const int* in_sizes, int n_in, void* d_out, int out_size, void* d_ws, size_t ws_size, hipStream_t stream) {
    static int grid = 0;
    if (grid == 0) {
        if (n_in != 32 || in_sizes[0] != NB * T * D || out_size != NB * T * D || ws_size < WS_END) { fprintf(stderr, "kernel_launch: unexpected shapes: n_in %d in0 %d out %d ws %zu (need %zu)\n", n_in, n_in > 0 ? in_sizes[0] : -1, out_size, ws_size, (size_t)WS_END); grid = -1; return; }
        int dev = 0, cus = 0, per_cu = 0;
        if (hipGetDevice(&dev) != hipSuccess || hipDeviceGetAttribute(&cus, hipDeviceAttributeMultiprocessorCount, dev) != hipSuccess) { grid = -1; return; }
        if (hipFuncSetAttribute((const void*)trunk_fwd, hipFuncAttributeMaxDynamicSharedMemorySize, LDS_BYTES) != hipSuccess) { fprintf(stderr, "kernel_launch: hipFuncSetAttribute failed\n"); grid = -1; return; }
        if (hipOccupancyMaxActiveBlocksPerMultiprocessor(&per_cu, (const void*)trunk_fwd, NWAVES * 64, LDS_BYTES) != hipSuccess || per_cu < 1) fprintf(stderr, "kernel_launch: occupancy query reports %d\n", per_cu);
        (void)hipGetLastError();
        grid = cus;
    }
    if (grid < 0) return;
    if (hipMemsetAsync((char*)d_ws + WS_CTL, 0, CTL_ZERO_BYTES, stream) != hipSuccess) return;
#ifdef DIAG_POISON
    (void)hipMemsetAsync((char*)d_ws + WS_GDNI, 0xFF, (size_t)64 * 68 * 32768, stream);
    (void)hipMemsetAsync((char*)d_ws + WS_OG, 0xFF, (size_t)NR * 1024 * 2, stream);
    (void)hipMemsetAsync((char*)d_ws + WS_QKVN, 0xFF, (size_t)NR * 1536 * 2, stream);
    (void)hipMemsetAsync((char*)d_ws + WS_GB, 0xFF, (size_t)NR * 32 * 4, stream);
#endif
    Args a{};
    for (int i = 0; i < 32; ++i) a.in[i] = (const float*)d_in[i];
    a.out = (float*)d_out; a.ws = (unsigned char*)d_ws;
#if MK_N_LAUNCHES == 1
    a.ph_lo = 0; a.ph_hi = N_PHASES;
    hipLaunchKernelGGL(trunk_fwd, dim3(grid), dim3(NWAVES * 64), LDS_BYTES, stream, a);
#else
    for (int p = 0; p < N_PHASES && p <= MK_LAST_PHASE; ++p) { a.ph_lo = p; a.ph_hi = p + 1; hipLaunchKernelGGL(trunk_fwd, dim3(grid), dim3(NWAVES * 64), LDS_BYTES, stream, a); }
#endif
    const hipError_t le = hipPeekAtLastError();
    if (le != hipSuccess) fprintf(stderr, "kernel_launch: launch failed: %s\n", hipGetErrorName(le));
}
```

```cpp
#include <hip/hip_runtime.h>
#include <cstdio>
#include <cstdint>
#include <cmath>

#ifndef MK_N_LAUNCHES
#define MK_N_LAUNCHES 1
#endif
#define SOLVE_C_FMA 1
#define SOLVE_C_LOAD 1
#ifndef G1_LOCK
#define G1_LOCK 0
#ifndef SCAN_PF
#define SCAN_PF 8
#endif
#ifndef SCAN_UNROLL
#define SCAN_UNROLL 1
#endif
#ifndef MOE_KSL
#define MOE_KSL 512
#endif
#endif
#ifndef MK_LAST_PHASE
#define MK_LAST_PHASE 99
#endif

constexpr int NB = 4, T = 4096, TC = 256, SROW = T + TC  , NR = NB * SROW  , D = 1024;
constexpr int EIN = 2848, EINP = 3072, OIN = 2208, OINP = 2304, DFF = 2816, DFX = 3584, NEXP = 8;
constexpr float EPS = 1e-6f;
constexpr int E_Q = 0, E_K = 512, E_V = 1024, E_Z = 1536, E_GA = 2048, E_GB = 2064, E_SQ = 2080, E_SK = 2592, E_SV = 2720;
constexpr int O_CQ = 0, O_CKV = 384, O_KR = 640, O_DQ = 672, O_DK = 1184, O_DV = 1696;

constexpr size_t MiB = 1u << 20;
constexpr size_t WS_CTL = 0, CTL_ZERO_BYTES = 1 * MiB;
constexpr size_t WS_MODV = 1 * MiB;
constexpr size_t WS_GB = 2 * MiB;
constexpr size_t WS_META = 5 * MiB;
constexpr size_t WS_HCTX = 8 * MiB;
constexpr size_t WS_WEIN = 12 * MiB, WS_WEOUT = 18 * MiB, WS_WEGU = 20 * MiB, WS_WEDN = 31 * MiB, WS_WOIN = 37 * MiB, WS_WUQ = 42 * MiB, WS_WUKV = 43 * MiB, WS_WOOUT = 44 * MiB;
constexpr size_t WS_BIG = 46 * MiB;
constexpr size_t WS_PROJ = 46 * MiB, WS_QKVN = 148 * MiB;
constexpr size_t WS_PROJ2 = 46 * MiB, WS_QM = 123 * MiB, WS_VMLA = 149 * MiB, WS_KMLA = 167 * MiB, WS_ODIFF = 316 * MiB;
constexpr size_t WS_WXGU = 46 * MiB, WS_WXDN = 158 * MiB;
constexpr size_t WS_CQN = 214 * MiB;
constexpr size_t WS_ABUF = 214 * MiB, WS_MIX = 248 * MiB, WS_YBUF = 282 * MiB;
constexpr size_t WS_OG = 214 * MiB;
constexpr size_t WS_PART = 350 * MiB;
constexpr size_t WS_GDNI = 282 * MiB;
constexpr size_t WS_HID = 46 * MiB;
constexpr size_t WS_ASORT = 214 * MiB;
constexpr size_t WS_FIN2 = 282 * MiB;
constexpr size_t WS_Y2 = 316 * MiB;
constexpr size_t WS_HIDX = 316 * MiB;
constexpr size_t WS_XB = 436 * MiB;
constexpr size_t WS_END = 470 * MiB;
static_assert(WS_QKVN + (size_t)NR * 1536 * 2 <= 214 * MiB && WS_PROJ + (size_t)NR * EINP * 2 <= WS_QKVN, "layer-0 big region");
static_assert(WS_PROJ2 + (size_t)NR * OINP * 2 <= WS_QM && WS_QM + (size_t)NR * 768 * 2 <= WS_VMLA && WS_VMLA + (size_t)NR * 512 * 2 <= WS_KMLA && WS_KMLA + (size_t)NR * 768 * 2 <= 214 * MiB, "layer-1 big region");
static_assert(WS_WXGU + (size_t)NEXP * 7168 * 1024 * 2 <= WS_WXDN && WS_WXDN + (size_t)NEXP * 1024 * 3584 * 2 <= 214 * MiB, "expert weights");
static_assert(WS_HIDX + (size_t)17408 * 3584 * 2 <= WS_END && WS_ASORT + (size_t)34816 * 1024 * 2 <= WS_FIN2 && WS_HID + (size_t)NR * DFF * 2 <= 214 * MiB, "moe map");
constexpr size_t META_TOPI = 0, META_TOPW = 128 * 1024, META_RANK = 256 * 1024, META_RSTD = 384 * 1024, META_BLKB = 960 * 1024;
constexpr int CW_TMO = 0, CW_CODE = 1;
constexpr int CW_MOECNT = 64;
constexpr int CW_SWAQ = 2048;
constexpr int CW_CHK = 1024;
constexpr int CW_BAR = 4096;
constexpr int RING_OFF = 0, RING_BYTES = 141312;
constexpr int MISC_OFF = RING_BYTES;
constexpr int LDS_BYTES = 147456;
constexpr int NWAVES = 8;
namespace pg8 {
#define PG8_LAS __attribute__((address_space(3)))
typedef unsigned short bf16_t;
typedef short bf16x8 __attribute__((ext_vector_type(8)));
typedef float f32x4 __attribute__((ext_vector_type(4)));
typedef unsigned u32x4 __attribute__((ext_vector_type(4)));
constexpr int BM = 256, BK = 64, HALF = 128, HTB = HALF * BK * 2  , STAGE_BYTES = 8 * HTB, NXCD = 8, WGM = 8;

__host__ __device__ __forceinline__ int lds_byte(int r, int c) { const int st = (r >> 4) * 2 + (c >> 5), rr = r & 15, cc = c & 31, ob = rr * 64 + cc * 2; return st * 1024 + (ob ^ (((ob >> 9) & 1) << 5)); }
__host__ __device__ __forceinline__ void stage_rc(int b, int& R, int& C) { const int st = b / 1024, sb = b % 1024, swz = sb ^ (((sb >> 9) & 1) << 5); R = (st >> 1) * 16 + swz / 64; C = (st & 1) * 32 + (swz % 64) / 2; }
__host__ __device__ __forceinline__ int perm32(int rho) { const int n = rho >> 4, i = rho & 15; return 8 * (i >> 2) + 4 * n + (i & 3); }

struct Unit { int pm, pn, kof; };
struct Gemm { const bf16_t* A; const bf16_t* Bt; int M, N, K, lda, ldb; };

struct StaticOrder {
    int nM, nN, nwg, G, c;
    __host__ __device__ void init(int M, int N, int G_, int c_) { nM = M / BM; nN = N / BM; nwg = nM * nN; G = G_; c = c_; }
    __host__ __device__ bool next(int i, Unit& u) const {
        const long L = (long)i * G + c; if (L >= nwg) return false;
        int wgid = (int)L; { const int q = nwg / NXCD, r = nwg % NXCD, xcd = wgid % NXCD, off = wgid / NXCD; wgid = (xcd < r ? xcd * (q + 1) : r * (q + 1) + (xcd - r) * q) + off; }
        const int nig = WGM * nN, gid = wgid / nig, fm = gid * WGM, gsz = (nM - fm) < WGM ? (nM - fm) : WGM;
        u.pm = fm + ((wgid % nig) % gsz); u.pn = (wgid % nig) / gsz; u.kof = 0; return true;
    }
    __device__ __forceinline__ void a_ready(const Unit&) const {}
    __device__ __forceinline__ void done(const Unit&) const {}
};

__device__ __forceinline__ unsigned cvt_pk_bf16(float lo, float hi) { unsigned r; asm volatile("v_cvt_pk_bf16_f32 %0, %1, %2" : "=v"(r) : "v"(lo), "v"(hi)); return r; }
typedef float f32x2 __attribute__((ext_vector_type(2)));
template <class Epi, class Sched, bool ALIGN_EPI = false, bool SP2 = false>
__device__ __forceinline__ void gemm_phase(PG8_LAS unsigned char* lds, const Gemm g, const Sched& S, const Epi& E) {
    const int tid = threadIdx.x, wid = __builtin_amdgcn_readfirstlane(tid >> 6), lane = tid & 63, wr = wid >> 2, wc = wid & 3, fr = lane & 15, fq = lane >> 4;
    const int K = g.K, nt = K / BK;
    unsigned voffA[2], voffB[2];
#pragma unroll
    for (int i = 0; i < 2; ++i) { int R, C; stage_rc(tid * 16 + i * 8192, R, C); const int Rb = Epi::PERM ? ((R & ~31) + perm32(R & 31)) : R;
        voffA[i] = (unsigned)(R * g.lda + C) * 2u; voffB[i] = (unsigned)(Rb * g.ldb + C) * 2u; }
    const size_t kstep = (size_t)(BK * 2);
    const size_t hstepA = (size_t)HALF * g.lda * 2, hstepB = (size_t)HALF * g.ldb * 2;
    const size_t tstepA = 2 * hstepA, tstepB = 2 * hstepB;
    const unsigned ldsw = (unsigned)wid * 1024u;
    const int aoff = lds_byte(wr * 64 + fr, fq * 8), boff = lds_byte(wc * 32 + fr, fq * 8);
#define PG8_SA(b, h) (((b) * 2 + (h)) * HTB)
#define PG8_SB(b, h) ((4 + (b) * 2 + (h)) * HTB)
#define PG8_STAGE(bufoff, gbase, voff) do { _Pragma("unroll") for (int _i = 0; _i < 2; ++_i) \
        __builtin_amdgcn_global_load_lds((const unsigned*)((const char*)(gbase) + (voff)[_i]), (PG8_LAS unsigned*)(lds + (bufoff) + ldsw + _i * 8192), 16, 0, 0); } while (0)
#define PG8_LDA(dst, b, h) do { _Pragma("unroll") for (int m = 0; m < 4; ++m) _Pragma("unroll") for (int k = 0; k < 2; ++k) dst[m][k] = *(const PG8_LAS bf16x8*)(lds + PG8_SA(b, h) + aoff + m * 2048 + k * 1024); } while (0)
#define PG8_LDB(dst, b, h) do { _Pragma("unroll") for (int n = 0; n < 2; ++n) _Pragma("unroll") for (int k = 0; k < 2; ++k) dst[n][k] = *(const PG8_LAS bf16x8*)(lds + PG8_SB(b, h) + boff + n * 2048 + k * 1024); } while (0)
#define PG8_MMA(ai, bj, At, Bt) do { __builtin_amdgcn_s_setprio(1); _Pragma("unroll") for (int m = 0; m < 4; ++m) _Pragma("unroll") for (int n = 0; n < 2; ++n) _Pragma("unroll") for (int k = 0; k < 2; ++k) \
        acc[ai][bj][m][n] = __builtin_amdgcn_mfma_f32_16x16x32_bf16(Bt[n][k], At[m][k], acc[ai][bj][m][n], 0, 0, 0); __builtin_amdgcn_s_setprio(0); } while (0)
#define PG8_WAIT_V(n) asm volatile("s_waitcnt vmcnt(" #n ")" ::: "memory")
#define PG8_WAIT_L(n) asm volatile("s_waitcnt lgkmcnt(" #n ")" ::: "memory")
#define PG8_BAR __builtin_amdgcn_s_barrier()
#define PG8_SCHED __builtin_amdgcn_sched_barrier(0)
    Unit cur, nxt; int ui = 0;
    if (!S.next(0, cur)) return;
    f32x4 acc[2][2][4][2];
#pragma unroll
    for (int a = 0; a < 2; ++a)
#pragma unroll
        for (int b = 0; b < 2; ++b)
#pragma unroll
            for (int m = 0; m < 4; ++m)
#pragma unroll
                for (int n = 0; n < 2; ++n) acc[a][b][m][n] = (f32x4){0.f, 0.f, 0.f, 0.f};
    bf16x8 At[4][2], B0[2][2], B1[2][2];
    const char* cA = (const char*)g.A + (size_t)cur.pm * tstepA + (size_t)cur.kof * 2; const char* cB = (const char*)g.Bt + (size_t)cur.pn * tstepB + (size_t)cur.kof * 2;
    S.a_ready(cur);
    if constexpr (SP2) {
        PG8_STAGE(PG8_SB(0, 0), cB, voffB); PG8_STAGE(PG8_SB(0, 1), cB + hstepB, voffB); PG8_STAGE(PG8_SA(0, 0), cA, voffA); PG8_STAGE(PG8_SA(0, 1), cA + hstepA, voffA);
        if (wr == 1) PG8_BAR;
        PG8_WAIT_V(2); PG8_BAR;
        PG8_STAGE(PG8_SB(1, 0), cB + kstep, voffB); PG8_STAGE(PG8_SA(1, 0), cA + kstep, voffA); PG8_STAGE(PG8_SB(1, 1), cB + hstepB + kstep, voffB);
        PG8_WAIT_V(6); PG8_BAR;
    } else {
        PG8_STAGE(PG8_SB(0, 0), cB, voffB); PG8_STAGE(PG8_SA(0, 0), cA, voffA); PG8_STAGE(PG8_SB(0, 1), cB + hstepB, voffB); PG8_STAGE(PG8_SA(0, 1), cA + hstepA, voffA);
        if (wr == 1) PG8_BAR;
        PG8_WAIT_V(4); PG8_BAR;
        PG8_STAGE(PG8_SB(1, 0), cB + kstep, voffB); PG8_STAGE(PG8_SA(1, 0), cA + kstep, voffA); PG8_STAGE(PG8_SB(1, 1), cB + hstepB + kstep, voffB);
        PG8_WAIT_V(6); PG8_BAR;
    }
    for (;;) {
        const bool has_next = S.next(ui + 1, nxt);
        const char* nA = has_next ? (const char*)g.A + (size_t)nxt.pm * tstepA + (size_t)nxt.kof * 2 : cA; const char* nB = has_next ? (const char*)g.Bt + (size_t)nxt.pn * tstepB + (size_t)nxt.kof * 2 : cB;
        _Pragma("unroll 1") for (int t = 0; t < nt; t += 2) {
            const bool last = (t == nt - 2);
            const char* a1 = cA + (size_t)(t + 1) * kstep;
            const char* a2 = last ? nA : cA + (size_t)(t + 2) * kstep; const char* b2 = last ? nB : cB + (size_t)(t + 2) * kstep;
            const char* a3 = a2 + kstep; const char* b3 = b2 + kstep;
            if (last && has_next) S.a_ready(nxt);
            if constexpr (SP2) {
            PG8_LDB(B0, 0, 0); PG8_LDB(B1, 0, 1); PG8_SCHED; PG8_LDA(At, 0, 0); PG8_STAGE(PG8_SA(1, 1), a1 + hstepA, voffA);
            PG8_WAIT_V(8); PG8_WAIT_L(0); PG8_BAR; PG8_MMA(0, 0, At, B0); PG8_MMA(0, 1, At, B1); PG8_BAR; PG8_SCHED;
            PG8_LDA(At, 0, 1); PG8_STAGE(PG8_SB(0, 0), b2, voffB); PG8_STAGE(PG8_SB(0, 1), b2 + hstepB, voffB); PG8_STAGE(PG8_SA(0, 0), a2, voffA);
            PG8_WAIT_V(8); PG8_WAIT_L(0); PG8_BAR; PG8_MMA(1, 0, At, B0); PG8_MMA(1, 1, At, B1); PG8_BAR; PG8_SCHED;
            PG8_LDB(B0, 1, 0); PG8_LDB(B1, 1, 1); PG8_SCHED; PG8_LDA(At, 1, 0); PG8_STAGE(PG8_SA(0, 1), a2 + hstepA, voffA);
            PG8_WAIT_V(8); PG8_WAIT_L(0); PG8_BAR; PG8_MMA(0, 0, At, B0); PG8_MMA(0, 1, At, B1); PG8_BAR; PG8_SCHED;
            PG8_LDA(At, 1, 1); PG8_STAGE(PG8_SB(1, 0), b3, voffB); PG8_STAGE(PG8_SB(1, 1), b3 + hstepB, voffB); PG8_STAGE(PG8_SA(1, 0), a3, voffA);
            PG8_WAIT_V(8); PG8_WAIT_L(0); PG8_BAR; PG8_MMA(1, 0, At, B0); PG8_MMA(1, 1, At, B1); PG8_BAR; PG8_SCHED;
            } else {
            PG8_LDB(B0, 0, 0); PG8_SCHED; PG8_LDA(At, 0, 0); PG8_STAGE(PG8_SA(1, 1), a1 + hstepA, voffA);
            PG8_WAIT_L(8); PG8_BAR; PG8_WAIT_L(0); PG8_MMA(0, 0, At, B0); PG8_BAR; PG8_SCHED;
            PG8_LDB(B1, 0, 1); PG8_STAGE(PG8_SB(0, 0), b2, voffB);
            PG8_BAR; PG8_WAIT_L(0); PG8_MMA(0, 1, At, B1); PG8_BAR;
            PG8_LDA(At, 0, 1); PG8_STAGE(PG8_SA(0, 0), a2, voffA);
            PG8_BAR; PG8_WAIT_L(0); PG8_MMA(1, 0, At, B0); PG8_BAR; PG8_SCHED;
            PG8_STAGE(PG8_SB(0, 1), b2 + hstepB, voffB);
            PG8_WAIT_V(6); PG8_BAR; PG8_MMA(1, 1, At, B1); PG8_BAR;
            PG8_LDB(B0, 1, 0); PG8_SCHED; PG8_LDA(At, 1, 0); PG8_STAGE(PG8_SA(0, 1), a2 + hstepA, voffA);
            PG8_WAIT_L(8); PG8_BAR; PG8_WAIT_L(0); PG8_MMA(0, 0, At, B0); PG8_BAR; PG8_SCHED;
            PG8_LDB(B1, 1, 1); PG8_STAGE(PG8_SB(1, 0), b3, voffB);
            PG8_BAR; PG8_WAIT_L(0); PG8_MMA(0, 1, At, B1); PG8_BAR;
            PG8_LDA(At, 1, 1); PG8_STAGE(PG8_SA(1, 0), a3, voffA);
            PG8_BAR; PG8_WAIT_L(0); PG8_MMA(1, 0, At, B0); PG8_BAR; PG8_SCHED;
            PG8_STAGE(PG8_SB(1, 1), b3 + hstepB, voffB);
            PG8_WAIT_V(6); PG8_BAR; PG8_MMA(1, 1, At, B1); PG8_BAR;
            }
        }
        if constexpr (ALIGN_EPI) { if (wr == 0) PG8_BAR; }
        if constexpr (!Epi::AFTER_DRAIN) { E(acc, cur, wr, wc, fr, fq); S.done(cur); }
        if (!has_next) break;
#pragma unroll
        for (int a = 0; a < 2; ++a)
#pragma unroll
            for (int b = 0; b < 2; ++b)
#pragma unroll
                for (int m = 0; m < 4; ++m)
#pragma unroll
                    for (int n = 0; n < 2; ++n) acc[a][b][m][n] = (f32x4){0.f, 0.f, 0.f, 0.f};
        cur = nxt; cA = nA; cB = nB; ++ui;
        if constexpr (ALIGN_EPI) { if (wr == 1) PG8_BAR; }
    }
    PG8_WAIT_V(0);
    if constexpr (!ALIGN_EPI) { if (wr == 0) PG8_BAR; }
    PG8_BAR;
    if constexpr (Epi::AFTER_DRAIN) { E.fused(acc, cur, wr, wc, fr, fq, lds, wid, lane); S.done(cur); }
#undef PG8_SA
#undef PG8_SB
#undef PG8_STAGE
#undef PG8_LDA
#undef PG8_LDB
#undef PG8_MMA
#undef PG8_WAIT_V
#undef PG8_WAIT_L
#undef PG8_BAR
#undef PG8_SCHED
}
}
namespace pg8 {
struct EpiStore { static constexpr bool PERM = true, AFTER_DRAIN = false;
    bf16_t* O; int ldc; int nN;
    __device__ __forceinline__ void operator()(const f32x4 (&acc)[2][2][4][2], const Unit& u, int wr, int wc, int fr, int fq) const {
        const int row0 = u.pm * BM + wr * 64 + fr, col0 = (u.pn % nN) * BM + wc * 32 + 8 * fq;
#pragma unroll
        for (int ai = 0; ai < 2; ++ai)
#pragma unroll
            for (int m = 0; m < 4; ++m) { const int row = row0 + ai * HALF + m * 16;
                bf16_t* rowp = O + (size_t)row * ldc + col0;
#pragma unroll
                for (int bj = 0; bj < 2; ++bj) { const f32x4 v0 = acc[ai][bj][m][0], v1 = acc[ai][bj][m][1];
                    u32x4 w; w.x = cvt_pk_bf16(v0[0], v0[1]); w.y = cvt_pk_bf16(v0[2], v0[3]); w.z = cvt_pk_bf16(v1[0], v1[1]); w.w = cvt_pk_bf16(v1[2], v1[3]);
                    *(u32x4*)(rowp + bj * HALF) = w; } }
    }
};
struct EpiSwiGLU { static constexpr bool PERM = true, AFTER_DRAIN = false;
    bf16_t* O; int ldc; int nN;
    __device__ __forceinline__ void operator()(const f32x4 (&acc)[2][2][4][2], const Unit& u, int wr, int wc, int fr, int fq) const {
        const int row0 = u.pm * BM + wr * 64 + fr, col0 = (u.pn % nN) * HALF + wc * 32 + 8 * fq;
#pragma unroll
        for (int ai = 0; ai < 2; ++ai)
#pragma unroll
            for (int m = 0; m < 4; ++m) { bf16_t* rowp = O + (size_t)(row0 + ai * HALF + m * 16) * ldc + col0;
                float h[8];
#pragma unroll
                for (int n = 0; n < 2; ++n)
#pragma unroll
                    for (int j = 0; j < 4; ++j) { const float g = acc[ai][0][m][n][j], up = acc[ai][1][m][n][j]; h[n * 4 + j] = g * __builtin_amdgcn_rcpf(1.f + __expf(-g)) * up; }
                u32x4 w; w.x = cvt_pk_bf16(h[0], h[1]); w.y = cvt_pk_bf16(h[2], h[3]); w.z = cvt_pk_bf16(h[4], h[5]); w.w = cvt_pk_bf16(h[6], h[7]);
                *(u32x4*)rowp = w; }
    }
};
struct EpiKV { static constexpr bool PERM = true, AFTER_DRAIN = false;
    bf16_t* KM; bf16_t* VM;
    __device__ __forceinline__ void operator()(const f32x4 (&acc)[2][2][4][2], const Unit& u, int wr, int wc, int fr, int fq) const {
        const int row0 = u.pm * BM + wr * 64 + fr, within = wc * 32 + 8 * fq;
#pragma unroll
        for (int ai = 0; ai < 2; ++ai)
#pragma unroll
            for (int m = 0; m < 4; ++m) { const int row = row0 + ai * HALF + m * 16;
#pragma unroll
                for (int bj = 0; bj < 2; ++bj) { const int h = 2 * u.pn + bj; const f32x4 v0 = acc[ai][bj][m][0], v1 = acc[ai][bj][m][1];
                    u32x4 w; w.x = cvt_pk_bf16(v0[0], v0[1]); w.y = cvt_pk_bf16(v0[2], v0[3]); w.z = cvt_pk_bf16(v1[0], v1[1]); w.w = cvt_pk_bf16(v1[2], v1[3]);
                    bf16_t* p = (within < 64) ? KM + (size_t)row * 768 + h * 96 + within : VM + (size_t)row * 512 + h * 64 + (within - 64);
                    *(u32x4*)p = w; } }
    }
};
struct CtxSplitOrder { int nsl, ksl, G, c;
    __device__ void init(int nsl_, int ksl_, int G_, int c_) { nsl = nsl_; ksl = ksl_; G = G_; c = c_; }
    __device__ bool next(int i, Unit& u) const { const int L = i * G + c; if (L >= 16 * nsl) return false; const int sl = L >> 4, rem = L & 15; u.pm = (rem >> 2) * 17; u.pn = rem & 3; u.kof = sl * ksl; return true; }
    __device__ __forceinline__ void a_ready(const Unit&) const {}
    __device__ __forceinline__ void done(const Unit&) const {}
};
struct EpiPartF32 { static constexpr bool PERM = false, AFTER_DRAIN = false;
    float* P; int ksl;
    __device__ __forceinline__ void operator()(const f32x4 (&acc)[2][2][4][2], const Unit& u, int wr, int wc, int fr, int fq) const {
        float* base = P + ((size_t)(u.kof / ksl) * 1024 + (size_t)(u.pm / 17) * 256) * 1024; const int row0 = wr * 64 + fr, col0 = u.pn * BM + wc * 32 + 4 * fq;
#pragma unroll
        for (int ai = 0; ai < 2; ++ai)
#pragma unroll
            for (int m = 0; m < 4; ++m) { float* rowp = base + (size_t)(row0 + ai * HALF + m * 16) * 1024 + col0;
#pragma unroll
                for (int bj = 0; bj < 2; ++bj)
#pragma unroll
                    for (int n = 0; n < 2; ++n) *(f32x4*)(rowp + bj * HALF + n * 16) = acc[ai][bj][m][n]; }
    }
};
struct LatOrder { StaticOrder so;
    __device__ void init(int N, int G, int c) { so.nM = 64; so.nN = N / BM; so.nwg = 64 * so.nN; so.G = G; so.c = c; }
    __device__ bool next(int i, Unit& u) const { if (!so.next(i, u)) return false; u.pm = (u.pm >> 4) * 17 + 1 + (u.pm & 15); return true; }
    __device__ __forceinline__ void a_ready(const Unit&) const {}
    __device__ __forceinline__ void done(const Unit&) const {}
};
struct MoeOrder { StaticOrder so; const int* texp; int t0, nNe;
    __device__ void init(int ntiles, int nNe_, int G, int c, const int* texp_, int t0_) { so.nM = ntiles; so.nN = nNe_; so.nwg = ntiles * nNe_; so.G = G; so.c = c; texp = texp_; t0 = t0_; nNe = nNe_; }
    __device__ bool next(int i, Unit& u) const { if (!so.next(i, u)) return false; const int e = __builtin_amdgcn_readfirstlane(texp[t0 + u.pm]); u.pn = e * nNe + u.pn; return true; }
    __device__ __forceinline__ void a_ready(const Unit&) const {}
    __device__ __forceinline__ void done(const Unit&) const {}
};
struct MoeSplitOrder { int ex4, nsl, ksl, G, c, t0; const int* texp;
    __device__ void init(int ex, int nsl_, int ksl_, int G_, int c_, const int* texp_, int t0_) { ex4 = ex * 4; nsl = nsl_; ksl = ksl_; G = G_; c = c_; texp = texp_; t0 = t0_; }
    __device__ bool next(int i, Unit& u) const { const int L = i * G + c; if (L >= ex4 * nsl) return false; const int sl = L / ex4, rem = L - sl * ex4; u.pm = 64 + (rem >> 2);
        const int e = __builtin_amdgcn_readfirstlane(texp[t0 + u.pm]); u.pn = e * 4 + (rem & 3); u.kof = sl * ksl; return true; }
    __device__ __forceinline__ void a_ready(const Unit&) const {}
    __device__ __forceinline__ void done(const Unit&) const {}
};
struct EpiMoePart { static constexpr bool PERM = false, AFTER_DRAIN = false;
    float* P; int ksl;
    __device__ __forceinline__ void operator()(const f32x4 (&acc)[2][2][4][2], const Unit& u, int wr, int wc, int fr, int fq) const {
        float* base = P + ((size_t)(u.kof / ksl) * 4 + (size_t)(u.pm - 64)) * 256 * 1024; const int row0 = wr * 64 + fr, col0 = (u.pn & 3) * BM + wc * 32 + 4 * fq;
#pragma unroll
        for (int ai = 0; ai < 2; ++ai)
#pragma unroll
            for (int m = 0; m < 4; ++m) { float* rowp = base + (size_t)(row0 + ai * HALF + m * 16) * 1024 + col0;
#pragma unroll
                for (int bj = 0; bj < 2; ++bj)
#pragma unroll
                    for (int n = 0; n < 2; ++n) *(f32x4*)(rowp + bj * HALF + n * 16) = acc[ai][bj][m][n]; }
    }
};
}
#define PG8_SP2 true
#define PG8_ALIGN true
#define GAS __attribute__((address_space(1)))
#define LAS __attribute__((address_space(3)))
typedef unsigned short bf16;
typedef unsigned v4u __attribute__((ext_vector_type(4)));
typedef unsigned v2u __attribute__((ext_vector_type(2)));
typedef float f32x4 __attribute__((ext_vector_type(4)));
typedef short bf16x8 __attribute__((ext_vector_type(8)));
typedef GAS unsigned gu32;
#define RLX_AGENT __ATOMIC_RELAXED, __HIP_MEMORY_SCOPE_AGENT
#define LDS_WAIT() asm volatile("s_waitcnt lgkmcnt(0)" ::: "memory")
#define VM_WAIT() asm volatile("s_waitcnt vmcnt(0)" ::: "memory")
__device__ __forceinline__ unsigned f2bf(float f) { unsigned u = __builtin_bit_cast(unsigned, f); return (u + 0x7fffu + ((u >> 16) & 1u)) >> 16; }
__device__ __forceinline__ unsigned pk2(float lo, float hi) { return f2bf(lo) | (f2bf(hi) << 16); }
__device__ __forceinline__ float bf2f(unsigned short b) { return __builtin_bit_cast(float, ((unsigned)b) << 16); }
__device__ __forceinline__ float bflo(unsigned w) { return __builtin_bit_cast(float, w << 16); }
__device__ __forceinline__ float bfhi(unsigned w) { return __builtin_bit_cast(float, w & 0xffff0000u); }
__device__ __forceinline__ float wave_sum(float v) {
#pragma unroll
    for (int o = 1; o < 64; o <<= 1) v += __shfl_xor(v, o);
    return v;
}
__device__ __forceinline__ float siluf(float x) { return x * __builtin_amdgcn_rcpf(1.f + __expf(-x)); }
#define XB_TMO      128
#define XB_XCNT(j)  (256  + 64 * (j))
#define XB_XSUB(j)  (1280 + 64 * (j))
#define XB_XGEN(j)  (2304 + 64 * (j))
#define XB_TOP      3328
#define XB_TOPGEN   3392
#define XCD_BAR_WORDS 3456
#define XB_SPIN_CAP (1u << 18)

__device__ __forceinline__ unsigned xb_ld(unsigned* p)              { return __hip_atomic_load(p, __ATOMIC_RELAXED, __HIP_MEMORY_SCOPE_AGENT); }
__device__ __forceinline__ unsigned xb_add(unsigned* p, unsigned v) { return __hip_atomic_fetch_add(p, v, __ATOMIC_RELAXED, __HIP_MEMORY_SCOPE_AGENT); }
__device__ __forceinline__ unsigned xb_xcc_id() { return (unsigned)__builtin_amdgcn_s_getreg((3 << 11) | 20) & 0xFu; }
#define XB_SPIN(cond, bar) do { unsigned _sp = 0; while (cond) { __builtin_amdgcn_s_sleep(1); \
    if ((++_sp & 255u) == 0u) { if (xb_ld(&(bar)[XB_TMO])) break; if (_sp > XB_SPIN_CAP) { atomicAdd(&(bar)[XB_TMO], 1u); break; } } } } while (0)

struct XcdBarrier {
    unsigned* bar; unsigned x;
    volatile LAS unsigned* st;
};

__device__ __forceinline__ XcdBarrier xcd_barrier_post(unsigned* bar, volatile LAS unsigned* st) {
    XcdBarrier b; b.bar = bar; b.x = xb_xcc_id(); b.st = st;
    if (threadIdx.x == 0) (void)xb_add(&bar[XB_XCNT(b.x)], 1u);
    return b;
}
__device__ __forceinline__ void xcd_barrier_complete(unsigned* bar, unsigned x, unsigned& nloc, unsigned& nx) {
    const unsigned G = gridDim.x * gridDim.y * gridDim.z;
    unsigned sum, cnt, mine, sp = 0u;
    for (;;) {
        sum = 0u; cnt = 0u; mine = 0u;
#pragma unroll
        for (unsigned j = 0; j < 16; ++j) { const unsigned c = xb_ld(&bar[XB_XCNT(j)]); sum += c; cnt += (c > 0u) ? 1u : 0u; mine = (j == x) ? c : mine; }
        if (sum == G) break;
        __builtin_amdgcn_s_sleep(1);
        if ((++sp & 255u) == 0u) { if (xb_ld(&bar[XB_TMO])) break; if (sp > XB_SPIN_CAP) { atomicAdd(&bar[XB_TMO], 1u); break; } }
    }
    nloc = mine > 0u ? mine : 1u; nx = cnt > 0u ? cnt : 1u;
}

__device__ __forceinline__ void xcd_barrier(const XcdBarrier& b) {
    asm volatile("s_waitcnt vmcnt(0)" ::: "memory");
    __syncthreads();
    if (threadIdx.x == 0) {
        unsigned* bar = b.bar;
        __builtin_amdgcn_s_waitcnt(0);
        unsigned nloc = b.st[0], nx = b.st[1];
        if (nloc == 0u) { xcd_barrier_complete(bar, b.x, nloc, nx); b.st[0] = nloc; b.st[1] = nx; }
        const unsigned old = xb_add(&bar[XB_XSUB(b.x)], 1u);
        const unsigned gen = old / nloc;
        if (old + 1u == (gen + 1u) * nloc) {
            __builtin_amdgcn_fence(__ATOMIC_RELEASE, "agent");
            asm volatile("s_waitcnt vmcnt(0)" ::: "memory");
            const unsigned og = xb_add(&bar[XB_TOP], 1u);
            const unsigned tg = og / nx;
            if (og + 1u == (tg + 1u) * nx) xb_add(&bar[XB_TOPGEN], 1u);
            else XB_SPIN(xb_ld(&bar[XB_TOPGEN]) == tg, bar);
            __builtin_amdgcn_fence(__ATOMIC_ACQUIRE, "agent");
            xb_add(&bar[XB_XGEN(b.x)], 1u);
            asm volatile("s_waitcnt vmcnt(0)" ::: "memory");
        } else {
            XB_SPIN(xb_ld(&bar[XB_XGEN(b.x)]) == gen, bar);
            __builtin_amdgcn_fence(__ATOMIC_ACQUIRE, "agent");
            asm volatile("s_waitcnt vmcnt(0)" ::: "memory");
        }
    }
    __syncthreads();
}
namespace att {
using bf16x8 = __attribute__((ext_vector_type(8))) short;
using s16x4  = __attribute__((ext_vector_type(4))) short;
using f32x16 = __attribute__((ext_vector_type(16))) float;
using u32x4  = __attribute__((ext_vector_type(4))) unsigned;
constexpr int NW = 8, QBLK = 32, KVBLK = 64;
constexpr size_t SHM_V = KVBLK * 128 * 2, SHM_K = KVBLK * 128 * 2, SHM_ATTN = 2 * SHM_V + 2 * SHM_K + NW * 64 * 4;
constexpr float THR = 8.f;
#define KSWZ(row, colB) ((row) * 256 + ((colB) ^ (((row) & 7) << 4)))
#define SBAR() __builtin_amdgcn_sched_barrier(0)
__device__ __forceinline__ int crow(int r, int hi) { return (r & 3) + 8 * (r >> 2) + 4 * hi; }
__device__ __forceinline__ unsigned cvtpk(float lo, float hi) { unsigned r; asm volatile("v_cvt_pk_bf16_f32 %0, %1, %2" : "=v"(r) : "v"(lo), "v"(hi)); return r; }
__device__ __forceinline__ void partialSM(f32x16& p0, f32x16& p1, float& m_reg, float& mn, float& alpha, float C, float thr_s) {
  float pmax = p0[0];
#pragma unroll
  for (int r = 1; r < 16; ++r) pmax = fmaxf(pmax, p0[r]);
#pragma unroll
  for (int r = 0; r < 16; ++r) pmax = fmaxf(pmax, p1[r]);
  { auto rr = __builtin_amdgcn_permlane32_swap(__float_as_uint(pmax), __float_as_uint(pmax), false, false);
    pmax = fmaxf(__uint_as_float(rr[0]), __uint_as_float(rr[1])); }
  if (__builtin_expect(__all(pmax - m_reg <= thr_s), 1)) { mn = m_reg; alpha = 1.f; }
  else { mn = fmaxf(m_reg, pmax); alpha = __builtin_amdgcn_exp2f((m_reg - mn) * C); m_reg = mn; }
  const float mnC = -mn * C;
#pragma unroll
  for (int r = 0; r < 16; ++r) p0[r] = fmaf(p0[r], C, mnC);
#pragma unroll
  for (int r = 0; r < 16; ++r) p1[r] = fmaf(p1[r], C, mnC);
#pragma unroll
  for (int r = 0; r < 16; ++r) p0[r] = __builtin_amdgcn_exp2f(p0[r]);
}
__device__ __forceinline__ void finishSM(f32x16& p0, f32x16& p1, float alpha, float& l_reg, bf16x8& pa0, bf16x8& pa1, bf16x8& pa2, bf16x8& pa3) {
#pragma unroll
  for (int r = 0; r < 16; ++r) p1[r] = __builtin_amdgcn_exp2f(p1[r]);
  float ps = 0;
#pragma unroll
  for (int r = 0; r < 16; ++r) ps += p0[r];
#pragma unroll
  for (int r = 0; r < 16; ++r) ps += p1[r];
  { auto rr = __builtin_amdgcn_permlane32_swap(__float_as_uint(ps), __float_as_uint(ps), false, false);
    ps = __uint_as_float(rr[0]) + __uint_as_float(rr[1]); }
  l_reg = l_reg * alpha + ps;
#define PK4(P, BASE, OUT) do { unsigned a0 = cvtpk(P[BASE + 0], P[BASE + 1]), a1 = cvtpk(P[BASE + 2], P[BASE + 3]);   \
    unsigned b0 = cvtpk(P[BASE + 4], P[BASE + 5]), b1 = cvtpk(P[BASE + 6], P[BASE + 7]);                              \
    auto r0 = __builtin_amdgcn_permlane32_swap(a0, b0, false, false); auto r1 = __builtin_amdgcn_permlane32_swap(a1, b1, false, false); \
    u32x4 w = {r0[0], r1[0], r0[1], r1[1]}; OUT = *reinterpret_cast<bf16x8*>(&w); } while (0)
  PK4(p0, 0, pa0); PK4(p0, 8, pa1); PK4(p1, 0, pa2); PK4(p1, 8, pa3);
#undef PK4
}
template <int DQK> __device__ __forceinline__ void qkt(f32x16& p0, f32x16& p1, const char* Ks, const bf16x8* qr, int r32, int hi) {
  p0 = f32x16{}; p1 = f32x16{};
#pragma unroll
  for (int d0 = 0; d0 < DQK / 16; ++d0) { const int cb = (d0 * 16 + hi * 8) * 2;
    const bf16x8 b0 = *reinterpret_cast<const bf16x8*>(Ks + KSWZ(r32, cb));
    const bf16x8 b1 = *reinterpret_cast<const bf16x8*>(Ks + KSWZ(32 + r32, cb));
    p0 = __builtin_amdgcn_mfma_f32_32x32x16_bf16(b0, qr[d0], p0, 0, 0, 0);
    p1 = __builtin_amdgcn_mfma_f32_32x32x16_bf16(b1, qr[d0], p1, 0, 0, 0); }
}
__device__ __forceinline__ int v_st(int k, int c) { const int kk = (k & ~0xC) | ((k & 4) << 1) | ((k & 8) >> 1); return ((kk >> 3) * 4 + (c >> 5)) * 512 + ((kk & 7) * 32 + (c & 31)) * 2; }
__device__ __forceinline__ int v_rd_base(int lane) { return ((lane & 3) << 3) | (((lane >> 2) & 3) << 6) | (((lane >> 4) & 1) << 5) | (((lane >> 5) & 1) << 8); }
constexpr int v_rd_off(int d0, int ks, int half) { return d0 * 512 + ks * 4096 + half * 2048; }
template <int OFF> __device__ __forceinline__ s16x4 tr_read(int vb) {
  s16x4 r; asm volatile("ds_read_b64_tr_b16 %0, %1 offset:%2" : "=&v"(r) : "v"(vb), "i"(OFF) : "memory"); return r;
}
template <int D0> __device__ __forceinline__ void pv_one(f32x16& od, int vb, bf16x8 pa0, bf16x8 pa1, bf16x8 pa2, bf16x8 pa3) {
  const s16x4 l0 = tr_read<v_rd_off(D0, 0, 0)>(vb), h0 = tr_read<v_rd_off(D0, 0, 1)>(vb), l1 = tr_read<v_rd_off(D0, 1, 0)>(vb), h1 = tr_read<v_rd_off(D0, 1, 1)>(vb);
  const s16x4 l2 = tr_read<v_rd_off(D0, 2, 0)>(vb), h2 = tr_read<v_rd_off(D0, 2, 1)>(vb), l3 = tr_read<v_rd_off(D0, 3, 0)>(vb), h3 = tr_read<v_rd_off(D0, 3, 1)>(vb);
  asm volatile("s_waitcnt lgkmcnt(0)" ::: "memory"); SBAR();
#define PK(L, H) (bf16x8){L[0], L[1], L[2], L[3], H[0], H[1], H[2], H[3]}
  od = __builtin_amdgcn_mfma_f32_32x32x16_bf16(pa0, PK(l0, h0), od, 0, 0, 0);
  od = __builtin_amdgcn_mfma_f32_32x32x16_bf16(pa1, PK(l1, h1), od, 0, 0, 0);
  od = __builtin_amdgcn_mfma_f32_32x32x16_bf16(pa2, PK(l2, h2), od, 0, 0, 0);
  od = __builtin_amdgcn_mfma_f32_32x32x16_bf16(pa3, PK(l3, h3), od, 0, 0, 0);
#undef PK
}
template <int DV> __device__ __forceinline__ void pv_all(f32x16* o, int vb, bf16x8 pa0, bf16x8 pa1, bf16x8 pa2, bf16x8 pa3) {
  pv_one<0>(o[0], vb, pa0, pa1, pa2, pa3); pv_one<1>(o[1], vb, pa0, pa1, pa2, pa3);
  if constexpr (DV > 64) { pv_one<2>(o[2], vb, pa0, pa1, pa2, pa3); pv_one<3>(o[3], vb, pa0, pa1, pa2, pa3); }
}
template <int DQK, int DV, int MODE, bool QROPE = false, int OUTMODE = 0>
__device__ __forceinline__ void attn_unit(const unsigned short* __restrict__ Qb, int ldq, const unsigned short* __restrict__ Kb, int ldk, const unsigned short* __restrict__ Vb, int ldv,
                                          unsigned short* __restrict__ Ob, int ldo, int NT, int lat0, int q0lat, float C, float thr_s, float sinkl2, char* lds, float lam = 0.f, const float* nw = nullptr, float nscale = 1.f) {
  int tid_ = threadIdx.x; asm volatile("" : "+v"(tid_));
  const int tid = tid_, wid = tid >> 6, lane = tid & 63, r32 = lane & 31, hi = lane >> 5;
  char* V_lds = lds; char* K_lds = lds + 2 * SHM_V;
  float* ws = (float*)(lds + 2 * SHM_V + 2 * SHM_K) + wid * 64; float* li_l = ws; float* al_l = ws + 32;
  float m_reg = -1e30f, l_reg = 0; f32x16 o[DV / 32]; bf16x8 qr[DQK / 16];
#pragma unroll
  for (int d = 0; d < DV / 32; ++d) o[d] = f32x16{};
  const unsigned short* Qw = Qb + (long)(wid * QBLK + r32) * ldq + hi * 8;
#pragma unroll
  for (int d0 = 0; d0 < DQK / 16; ++d0) qr[d0] = *reinterpret_cast<const bf16x8*>(Qw + d0 * 16);
  if constexpr (QROPE) {
    static_assert(DQK == 96, "QROPE is the MLA case");
    int t = q0lat + wid * QBLK + r32; asm volatile("" : "+v"(t));
#pragma unroll
    for (int part = 0; part < 2; ++part) { const float pos = (float)(part ? (t & 63) : (t >> 6)); u32x4 w = __builtin_bit_cast(u32x4, qr[4 + part]); u32x4 o;
#pragma unroll
      for (int q = 0; q < 4; ++q) { const unsigned pw = (unsigned)__shfl_xor((int)w[q], 32); float x0 = bflo(w[q]), x1 = bfhi(w[q]); const float p0 = bflo(pw), p1 = bfhi(pw);
        float s0, c0, s1, c1; sincosf(pos * __powf(10000.f, -(float)(2 * q) * 0.125f), &s0, &c0); sincosf(pos * __powf(10000.f, -(float)(2 * q + 1) * 0.125f), &s1, &c1);
        x0 = hi ? (x0 * c0 + p0 * s0) : (x0 * c0 - p0 * s0); x1 = hi ? (x1 * c1 + p1 * s1) : (x1 * c1 - p1 * s1); o[q] = cvtpk(x0, x1); }
      qr[4 + part] = __builtin_bit_cast(bf16x8, o); } }
  const int sr = tid >> 4, sc = (tid & 15) * 8, vst0 = v_st(sr, sc), vst1 = v_st(32 + sr, sc);
  const bool kact = sc < DQK, vact = sc < DV;
  const int vb0 = (int)(uintptr_t)V_lds + v_rd_base(lane);
  struct { bf16x8 vs0, vs1, ks0, ks1; } sr_[2];
#define TROW(j) ((MODE == 1 && (j) >= 4) ? (256 + lat0 + ((j) - 4) * 64) : (j) * 64)
#define SLOAD(i, j) do { const long k0_ = TROW(j); \
    if (vact) { sr_[i].vs0 = *reinterpret_cast<const bf16x8*>(&Vb[(k0_ + sr) * ldv + sc]); sr_[i].vs1 = *reinterpret_cast<const bf16x8*>(&Vb[(k0_ + 32 + sr) * ldv + sc]); } \
    if (kact) { sr_[i].ks0 = *reinterpret_cast<const bf16x8*>(&Kb[(k0_ + sr) * ldk + sc]); sr_[i].ks1 = *reinterpret_cast<const bf16x8*>(&Kb[(k0_ + 32 + sr) * ldk + sc]); } } while (0)
#define SWRITE(b, i) do { if (vact) { *(bf16x8*)(V_lds + (b) * SHM_V + vst0) = sr_[i].vs0; *(bf16x8*)(V_lds + (b) * SHM_V + vst1) = sr_[i].vs1; } \
    if (kact) { const int kc = sc * 2; *(bf16x8*)(K_lds + (b) * SHM_K + KSWZ(sr, kc)) = sr_[i].ks0; *(bf16x8*)(K_lds + (b) * SHM_K + KSWZ(32 + sr, kc)) = sr_[i].ks1; } } while (0)
#define RESC(a) do { if (__any((a) < 1.f)) { if (hi == 0) al_l[r32] = (a); asm volatile("s_waitcnt lgkmcnt(0)" ::: "memory"); \
    _Pragma("unroll") for (int d = 0; d < DV / 32; ++d) _Pragma("unroll") for (int r = 0; r < 16; ++r) o[d][r] *= al_l[crow(r, hi)]; } } while (0)
#define MASK(P0, P1, j) do { if (MODE == 1 && (j) >= 4) { const int kb_ = lat0 + ((j) - 4) * 64 + 4 * hi - (q0lat + wid * QBLK + r32); \
    _Pragma("unroll") for (int r = 0; r < 16; ++r) { const int dk_ = kb_ + (r & 3) + 8 * (r >> 2); if (dk_ > 128 || dk_ < -128) P0[r] = -1e30f; if (dk_ + 32 > 128 || dk_ + 32 < -128) P1[r] = -1e30f; } } } while (0)
  f32x16 pA0, pA1, pB0, pB1; float mnA, mnB, alA, alB; bf16x8 pa0, pa1, pa2, pa3;
  SLOAD(0, 0); asm volatile("s_waitcnt vmcnt(0)" ::: "memory"); SWRITE(0, 0); __syncthreads();
  qkt<DQK>(pA0, pA1, K_lds, qr, r32, hi); MASK(pA0, pA1, 0); partialSM(pA0, pA1, m_reg, mnA, alA, C, thr_s);
  SLOAD(1, 1); if (2 < NT) SLOAD(0, 2);
  asm volatile("s_waitcnt vmcnt(4)" ::: "memory"); SWRITE(1, 1); __syncthreads();
  for (int j = 1; j + 1 < NT; j += 2) {
    SBAR(); qkt<DQK>(pB0, pB1, K_lds + SHM_K, qr, r32, hi); MASK(pB0, pB1, j);
    finishSM(pA0, pA1, alA, l_reg, pa0, pa1, pa2, pa3); SBAR();
    SLOAD(1, j + 2); SBAR();
    pv_all<DV>(o, vb0, pa0, pa1, pa2, pa3); partialSM(pB0, pB1, m_reg, mnB, alB, C, thr_s);
    __syncthreads(); asm volatile("s_waitcnt vmcnt(4)" ::: "memory"); SWRITE(0, 0);
    RESC(alB); __syncthreads();
    SBAR(); qkt<DQK>(pA0, pA1, K_lds, qr, r32, hi); MASK(pA0, pA1, j + 1);
    finishSM(pB0, pB1, alB, l_reg, pa0, pa1, pa2, pa3); SBAR();
    if (j + 3 < NT) SLOAD(0, j + 3); SBAR();
    pv_all<DV>(o, vb0 + (int)SHM_V, pa0, pa1, pa2, pa3); partialSM(pA0, pA1, m_reg, mnA, alA, C, thr_s);
    __syncthreads(); asm volatile("s_waitcnt vmcnt(4)" ::: "memory"); SWRITE(1, 1);
    RESC(alA); __syncthreads();
  }
  SBAR(); qkt<DQK>(pB0, pB1, K_lds + SHM_K, qr, r32, hi); MASK(pB0, pB1, NT - 1);
  finishSM(pA0, pA1, alA, l_reg, pa0, pa1, pa2, pa3); SBAR();
  pv_all<DV>(o, vb0, pa0, pa1, pa2, pa3); partialSM(pB0, pB1, m_reg, mnB, alB, C, thr_s);
  __syncthreads(); RESC(alB);
  finishSM(pB0, pB1, alB, l_reg, pa0, pa1, pa2, pa3); SBAR();
  pv_all<DV>(o, vb0 + (int)SHM_V, pa0, pa1, pa2, pa3);
  if (sinkl2 > -1e29f) l_reg += __builtin_amdgcn_exp2f(sinkl2 - m_reg * C);
  if (hi == 0) li_l[r32] = l_reg; asm volatile("s_waitcnt lgkmcnt(0)" ::: "memory");
  float rli[16];
#pragma unroll
  for (int r = 0; r < 16; ++r) rli[r] = __builtin_amdgcn_rcpf(li_l[crow(r, hi)]);
  if constexpr (OUTMODE == 0) {
  unsigned short* Ow = Ob + (long)(wid * QBLK) * ldo;
#pragma unroll
  for (int r = 0; r < 16; ++r) { const int orow = crow(r, hi);
#pragma unroll
    for (int d0 = 0; d0 < DV / 32; ++d0) Ow[(long)orow * ldo + d0 * 32 + r32] = (unsigned short)f2bf(o[d0][r] * rli[r]); }
  } else {   int zo_ = 0; asm volatile("" : "+v"(zo_)); const int lane = (int)__builtin_amdgcn_mbcnt_hi(~0u, __builtin_amdgcn_mbcnt_lo(~0u, (unsigned)zo_)), r32 = lane & 31, hi = lane >> 5;
    unsigned short* stg = (unsigned short*)(lds + SHM_ATTN) + wid * 4096;
    if constexpr (OUTMODE == 1) {
#pragma unroll
      for (int d0 = 0; d0 < DV / 32; ++d0)
#pragma unroll
        for (int r = 0; r < 16; ++r) stg[(d0 * 16 + r) * 64 + lane] = (unsigned short)f2bf(o[d0][r] * rli[r]);
    } else {
      unsigned short* Ow = Ob + (long)(wid * QBLK) * ldo;
#pragma unroll
      for (int r = 0; r < 16; ++r) { float v[DV / 32]; float ss = 0.f;
#pragma unroll
        for (int d0 = 0; d0 < DV / 32; ++d0) { v[d0] = bf2f(stg[(d0 * 16 + r) * 64 + lane]) - lam * (o[d0][r] * rli[r]); ss += v[d0] * v[d0]; }
        ss += __shfl_xor(ss, 1); ss += __shfl_xor(ss, 2); ss += __shfl_xor(ss, 4); ss += __shfl_xor(ss, 8); ss += __shfl_xor(ss, 16);
        const float rs = nscale / sqrtf(ss * (1.f / (float)DV) + 1e-6f); const int orow = crow(r, hi);
#pragma unroll
        for (int d0 = 0; d0 < DV / 32; ++d0) Ow[(long)orow * ldo + d0 * 32 + r32] = (unsigned short)f2bf(v[d0] * rs * nw[d0 * 32 + r32]);
        __builtin_amdgcn_sched_barrier(0); }
    }
  }
  __syncthreads();
#undef TROW
#undef SLOAD
#undef SWRITE
#undef RESC
#undef MASK
}
#undef KSWZ
#undef SBAR
}
struct Args { const float* in[32]; float* out; unsigned char* ws; int ph_lo, ph_hi; };
struct Frame {
    LAS unsigned char* lds; char* ldsg;
    volatile LAS unsigned* MISC;
    gu32* ctl;
    int tid, lane, wave, vcu, G, gw, NGW;
    const float* const* in; float* out; unsigned char* ws;
};
enum { I_X = 0, I_C, I_CTX, I_CCTX, I_EMODW, I_EMODB, I_ENORMS, I_EWIN, I_ECONV, I_EALOG, I_EDTB, I_EGDNN, I_ESINK, I_EWOUT, I_EFG, I_EFU, I_EFD,
       I_OMODW, I_OMODB, I_ONORMS, I_OWIN, I_OQN, I_OKVN, I_OWUQ, I_OWUKV, I_OLAM, I_OSUBLN, I_OWOUT, I_OROUTER, I_OXG, I_OXU, I_OXD };

__device__ __forceinline__ void tr_load(float (&v)[32], const float* W, int N, int k0, int n0, const float* kscale, int lane) {
#pragma unroll
    for (int i = 0; i < 32; ++i) { const int kk = 2 * i + (lane >> 5); v[i] = W[(size_t)(k0 + kk) * N + n0 + (lane & 31)]; if (kscale) v[i] *= kscale[k0 + kk]; }
}
__device__ __forceinline__ void tr_store(const float (&v)[32], bf16* WT, int ldk, int k0, int drow0, LAS float* scr, int lane) {
#pragma unroll
    for (int i = 0; i < 32; ++i) scr[(2 * i + (lane >> 5)) * 33 + (lane & 31)] = v[i];
    LDS_WAIT(); asm volatile("" ::: "memory");
    const int c = lane & 7;
#pragma unroll
    for (int j = 0; j < 4; ++j) { const int n = (lane >> 3) + 8 * j; const LAS float* s = scr + (8 * c) * 33 + n;
        v4u o; o.x = pk2(s[0 * 33], s[1 * 33]); o.y = pk2(s[2 * 33], s[3 * 33]); o.z = pk2(s[4 * 33], s[5 * 33]); o.w = pk2(s[6 * 33], s[7 * 33]);
        *(GAS v4u*)(WT + (size_t)(drow0 + n) * ldk + k0 + 8 * c) = o; }
    LDS_WAIT(); asm volatile("" ::: "memory");
}
template <int MAP> __device__ __forceinline__ void transpose_job(Frame& F, const float* W, int K, int N, bf16* WT, const float* kscale, int first, int stride, LAS unsigned char* scrb) {
    LAS float* scr = (LAS float*)scrb;
    const int nblk = N / 32, items = (K / 64) * nblk;
    float vn[32];
    if (first < items) tr_load(vn, W, N, 64 * (first / nblk), 32 * (first % nblk), kscale, F.lane);
    for (int it = first; it < items; it += stride) { const int kb = it / nblk, nb = it % nblk, n0 = 32 * nb;
        const int drow0 = (MAP == 0) ? n0 : ((n0 >> 7) * 256 + (n0 & 127) + (MAP == 2 ? 128 : 0));
        float vc[32];
#pragma unroll
        for (int i = 0; i < 32; ++i) vc[i] = vn[i];
        const int nx = it + stride; if (nx < items) tr_load(vn, W, N, 64 * (nx / nblk), 32 * (nx % nblk), kscale, F.lane);
        tr_store(vc, WT, K, 64 * kb, drow0, scr, F.lane); }
}
__device__ __forceinline__ void zero_rows(Frame& F, bf16* WT, int row0, int nrows, int K) {
    const size_t n16 = (size_t)nrows * K / 8; GAS v4u* p = (GAS v4u*)(WT + (size_t)row0 * K);
    for (size_t i = (size_t)F.gw * 64 + F.lane; i < n16; i += (size_t)F.NGW * 64) p[i] = (v4u){0u, 0u, 0u, 0u};
}
__device__ __forceinline__ void modv_items(Frame& F) {
    LAS float* sc = (LAS float*)(F.lds + RING_OFF);
    LAS float* part = (LAS float*)(F.lds + RING_OFF + 20480);
    float* MODV = (float*)(F.ws + WS_MODV);
    const int nitems = 2 * 96;
    if ((int)blockIdx.x >= nitems) return;
    for (int i = F.tid; i < 5 * 1024; i += 512) { const int r = i >> 10, k = i & 1023; const float v = (r < 4) ? F.in[I_C][r * 1024 + k] : F.in[I_CCTX][k]; sc[i] = siluf(v); }
    __syncthreads();
    for (int it = blockIdx.x; it < nitems; it += F.G) {
        const int l = it / 96, n0 = (it % 96) * 64, col = F.tid & 63, ks = F.tid >> 6;
        const float* W = F.in[l ? I_OMODW : I_EMODW] + (size_t)(ks * 128) * 6144 + n0 + col;
        float a0 = 0, a1 = 0, a2 = 0, a3 = 0, a4 = 0;
#pragma unroll 8
        for (int k = 0; k < 128; ++k) { const float w = W[(size_t)k * 6144]; const int kk = ks * 128 + k;
            a0 += sc[kk] * w; a1 += sc[1024 + kk] * w; a2 += sc[2048 + kk] * w; a3 += sc[3072 + kk] * w; a4 += sc[4096 + kk] * w; }
        part[(ks * 5 + 0) * 64 + col] = a0; part[(ks * 5 + 1) * 64 + col] = a1; part[(ks * 5 + 2) * 64 + col] = a2; part[(ks * 5 + 3) * 64 + col] = a3; part[(ks * 5 + 4) * 64 + col] = a4;
        __syncthreads();
        if (F.tid < 320) { const int r = F.tid >> 6, c2 = F.tid & 63; float s = F.in[l ? I_OMODB : I_EMODB][n0 + c2];
#pragma unroll
            for (int q = 0; q < 8; ++q) s += part[(q * 5 + r) * 64 + c2];
            MODV[(size_t)(l * 5 + r) * 6144 + n0 + c2] = s; }
        __syncthreads();
    }
}
__device__ __forceinline__ const float* modvec(Frame& F, int l, int mr, int k) { return (const float*)(F.ws + WS_MODV) + (size_t)((l * 5 + mr) * 6 + k) * 1024; }

struct Row4 { f32x4 v[4]; };
__device__ __forceinline__ Row4 ld_row_f32(const float* p, int lane) { Row4 r; const GAS f32x4* q = (const GAS f32x4*)p + lane;
#pragma unroll
    for (int j = 0; j < 4; ++j) r.v[j] = q[64 * j]; return r; }
__device__ __forceinline__ Row4 ld_row_bf16(const bf16* p, int lane) { Row4 r; const GAS v2u* q = (const GAS v2u*)p + lane;
#pragma unroll
    for (int j = 0; j < 4; ++j) { const v2u w = q[64 * j]; r.v[j] = (f32x4){bflo(w.x), bfhi(w.x), bflo(w.y), bfhi(w.y)}; } return r; }
__device__ __forceinline__ void st_row_f32(float* p, int lane, const Row4& r) { GAS f32x4* q = (GAS f32x4*)p + lane;
#pragma unroll
    for (int j = 0; j < 4; ++j) q[64 * j] = r.v[j]; }
__device__ __forceinline__ void st_row_bf16(bf16* p, int lane, const Row4& r) { GAS v2u* q = (GAS v2u*)p + lane;
#pragma unroll
    for (int j = 0; j < 4; ++j) q[64 * j] = (v2u){pk2(r.v[j].x, r.v[j].y), pk2(r.v[j].z, r.v[j].w)}; }
__device__ __forceinline__ float row_rstd(const Row4& r) { float s = 0.f;
#pragma unroll
    for (int j = 0; j < 4; ++j) s += (r.v[j].x * r.v[j].x + r.v[j].y * r.v[j].y) + (r.v[j].z * r.v[j].z + r.v[j].w * r.v[j].w);
    return __builtin_amdgcn_rsqf(wave_sum(s) * (1.f / 1024.f) + EPS); }
__device__ __forceinline__ float* xres_ptr(Frame& F, int r, int& mr) { const int b = r / SROW, s = r - b * SROW;
    if (s < TC) { mr = 4; return (float*)(F.ws + WS_HCTX) + (size_t)(b * TC + s) * D; }
    mr = b; return F.out + (size_t)(b * T + s - TC) * D; }
__device__ __forceinline__ Row4 norm_mod(const Row4& x, const float* w, const float* shift, const float* scale, int lane) {
    const float rs = row_rstd(x); const Row4 W = ld_row_f32(w, lane), SH = ld_row_f32(shift, lane), SC = ld_row_f32(scale, lane); Row4 a;
#pragma unroll
    for (int j = 0; j < 4; ++j) a.v[j] = (x.v[j] * rs * W.v[j]) * (SC.v[j] + 1.f) + SH.v[j];
    return a; }
__device__ __forceinline__ Row4 norm_mod_r(const Row4& x, const Row4& W, const Row4& SH, const Row4& SC) {
    const float rs = row_rstd(x); Row4 a;
#pragma unroll
    for (int j = 0; j < 4; ++j) a.v[j] = (x.v[j] * rs * W.v[j]) * (SC.v[j] + 1.f) + SH.v[j];
    return a; }
__device__ __forceinline__ void add_gated_norm_r(Row4& x, const Row4& y, const Row4& W, const Row4& G) {
    const float rs = row_rstd(y);
#pragma unroll
    for (int j = 0; j < 4; ++j) x.v[j] = x.v[j] + G.v[j] * (y.v[j] * rs * W.v[j]); }
__device__ __forceinline__ int tok_vcu(const Frame& F, int b, int t) { const int wpb = F.NGW >> 2; return (b * wpb + t % wpb) >> 3; }
__device__ __forceinline__ void add_gated_norm(Row4& x, const Row4& y, const float* w, const float* gate, int lane) {
    const float rs = row_rstd(y); const Row4 W = ld_row_f32(w, lane), G = ld_row_f32(gate, lane);
#pragma unroll
    for (int j = 0; j < 4; ++j) x.v[j] = x.v[j] + G.v[j] * (y.v[j] * rs * W.v[j]); }
__device__ __forceinline__ void p0_prologue(Frame& F) {
    modv_items(F);
    __syncthreads();
    transpose_job<0>(F, F.in[I_EWIN], 1024, EIN, (bf16*)(F.ws + WS_WEIN), nullptr, F.gw, F.NGW, F.lds + RING_OFF + F.wave * 16384);
    zero_rows(F, (bf16*)(F.ws + WS_WEIN), EIN, EINP - EIN, 1024);
}
__device__ __forceinline__ void p0_deferred(Frame& F, int w4, LAS unsigned char* scr) {
    const float* const* in = F.in; unsigned char* ws = F.ws; const int gw = F.vcu * 4 + w4, N = F.G * 4;
    transpose_job<0>(F, in[I_EWOUT], 1024, 1024, (bf16*)(ws + WS_WEOUT), nullptr, gw, N, scr);
    transpose_job<1>(F, in[I_EFG], 1024, DFF, (bf16*)(ws + WS_WEGU), nullptr, (gw + 512) % N, N, scr);
    transpose_job<2>(F, in[I_EFU], 1024, DFF, (bf16*)(ws + WS_WEGU), nullptr, (gw + 896) % N, N, scr);
    transpose_job<0>(F, in[I_EFD], DFF, 1024, (bf16*)(ws + WS_WEDN), nullptr, (gw + 256) % N, N, scr);
    transpose_job<0>(F, in[I_OWIN], 1024, OIN, (bf16*)(ws + WS_WOIN), nullptr, (gw + 640) % N, N, scr);
    transpose_job<0>(F, in[I_OWUQ], 384, 768, (bf16*)(ws + WS_WUQ), in[I_OQN], (gw + 720) % N, N, scr);
    transpose_job<0>(F, in[I_OWUKV], 256, 1024, (bf16*)(ws + WS_WUKV), in[I_OKVN], (gw + 864) % N, N, scr);
    transpose_job<0>(F, in[I_OWOUT], 1024, 1024, (bf16*)(ws + WS_WOOUT), nullptr, (gw + 992) % N, N, scr);
    { const size_t n16 = (size_t)(OINP - OIN) * 1024 / 8; GAS v4u* p = (GAS v4u*)((bf16*)(ws + WS_WOIN) + (size_t)OIN * 1024);
      for (size_t i = (size_t)gw * 64 + F.lane; i < n16; i += (size_t)N * 64) p[i] = (v4u){0u, 0u, 0u, 0u}; }
}
__device__ __forceinline__ void px_expert_weights(Frame& F) {
    for (int e = 0; e < NEXP; ++e) {
        transpose_job<1>(F, F.in[I_OXG] + (size_t)e * 1024 * DFX, 1024, DFX, (bf16*)(F.ws + WS_WXGU) + (size_t)e * 7168 * 1024, nullptr, (F.gw + e * 448) % F.NGW, F.NGW, F.lds + RING_OFF + F.wave * 8448);
        transpose_job<2>(F, F.in[I_OXU] + (size_t)e * 1024 * DFX, 1024, DFX, (bf16*)(F.ws + WS_WXGU) + (size_t)e * 7168 * 1024, nullptr, (F.gw + e * 448 + 224) % F.NGW, F.NGW, F.lds + RING_OFF + F.wave * 8448);
    }
}
__device__ __forceinline__ void px_expert_down(Frame& F, int wk, int nwk, int e0, int e1) {
    for (int e = e0; e < e1; ++e)
        transpose_job<0>(F, F.in[I_OXD] + (size_t)e * DFX * 1024, DFX, 1024, (bf16*)(F.ws + WS_WXDN) + (size_t)e * 1024 * DFX, nullptr, (wk + e * 448 + 112) % nwk, nwk, F.lds + RING_OFF + F.wave * 8448);
}
__device__ __forceinline__ void p1_first_rows(Frame& F) {
    bf16* A = (bf16*)(F.ws + WS_ABUF); const float* w0 = F.in[I_ENORMS]; const int wpb = F.NGW >> 2, b = F.gw / wpb, wl = F.gw - b * wpb;
    { const Row4 W = ld_row_f32(w0, F.lane), SH = ld_row_f32(modvec(F, 0, b, 0), F.lane), SC = ld_row_f32(modvec(F, 0, b, 1), F.lane);
      for (int t = wl; t < T; t += wpb) { const size_t tk = (size_t)b * T + t; const Row4 x = ld_row_f32(F.in[I_X] + tk * D, F.lane); st_row_bf16((bf16*)(F.ws + WS_XB) + tk * D, F.lane, x);
          const Row4 a = norm_mod_r(x, W, SH, SC); st_row_bf16(A + ((size_t)b * SROW + TC + t) * D, F.lane, a); } }
    for (int c = F.gw; c < NB * TC; c += F.NGW) { const int cb = c / TC, s = c - cb * TC;
        const Row4 x = ld_row_f32(F.in[I_CTX] + (size_t)c * D, F.lane); st_row_f32((float*)(F.ws + WS_HCTX) + (size_t)c * D, F.lane, x);
        const Row4 a = norm_mod(x, w0, modvec(F, 0, 4, 0), modvec(F, 0, 4, 1), F.lane); st_row_bf16(A + ((size_t)cb * SROW + s) * D, F.lane, a); }
}
constexpr int ROUTER_TAB_OFF = 69632;
__device__ __forceinline__ void router_table(Frame& F) {
    LAS f32x4* tab = (LAS f32x4*)(F.lds + RING_OFF + ROUTER_TAB_OFF); const float* Rw = F.in[I_OROUTER];
    for (int i = F.tid; i < 2048; i += 512) { const int ln = i & 63, h = (i >> 6) & 1, q = (i >> 7) & 3, j = i >> 9; tab[i] = *(const GAS f32x4*)(Rw + (size_t)(4 * ln + 256 * j + q) * 8 + 4 * h); }
    __syncthreads();
}
template <bool ROUTER> __device__ __forceinline__ void rows_mid(Frame& F, const bf16* Y, const float* wy, int lg, int kg, const float* w2, int l2, int ks2, bf16* Aout, bool lat_only, int nsl = 0) {
    const int wpb = F.NGW >> 2, b = F.gw / wpb, wl = F.gw - b * wpb;
    { const Row4 Wy = ld_row_f32(wy, F.lane), Gt = ld_row_f32(modvec(F, lg, b, kg), F.lane), W2 = ld_row_f32(w2, F.lane), SH = ld_row_f32(modvec(F, l2, b, ks2), F.lane), SC = ld_row_f32(modvec(F, l2, b, ks2 + 1), F.lane);
      for (int t = wl; t < T; t += wpb) { const size_t tk = (size_t)b * T + t, r = (size_t)b * SROW + TC + t; bf16* xr = (bf16*)(F.ws + WS_XB) + tk * D;
        Row4 x = ld_row_bf16(xr, F.lane); const Row4 y = ld_row_bf16(Y + r * D, F.lane);
        add_gated_norm_r(x, y, Wy, Gt); st_row_bf16(xr, F.lane, x);
        const Row4 a = norm_mod_r(x, W2, SH, SC);
        st_row_bf16(Aout + r * D, F.lane, a);
        if constexpr (ROUTER) {
            LAS const f32x4* Rt = (LAS const f32x4*)(F.lds + RING_OFF + ROUTER_TAB_OFF) + F.lane; float lg8[8];
#pragma unroll
            for (int e = 0; e < 8; ++e) lg8[e] = 0.f;
#pragma unroll
            for (int j = 0; j < 4; ++j)
#pragma unroll
                for (int q = 0; q < 4; ++q) { const f32x4 r0 = Rt[((j * 4 + q) * 2 + 0) * 64], r1 = Rt[((j * 4 + q) * 2 + 1) * 64]; const float av = a.v[j][q];
                    lg8[0] += av * r0.x; lg8[1] += av * r0.y; lg8[2] += av * r0.z; lg8[3] += av * r0.w; lg8[4] += av * r1.x; lg8[5] += av * r1.y; lg8[6] += av * r1.z; lg8[7] += av * r1.w; }
#pragma unroll
            for (int e = 0; e < 8; ++e) lg8[e] = wave_sum(lg8[e]);
            int i0 = 0; float v0 = lg8[0];
#pragma unroll
            for (int e = 1; e < 8; ++e) if (lg8[e] > v0) { v0 = lg8[e]; i0 = e; }
            int i1 = -1; float v1 = -3.0e38f;
#pragma unroll
            for (int e = 0; e < 8; ++e) if (e != i0 && lg8[e] > v1) { v1 = lg8[e]; i1 = e; }
            const float e1 = __expf(v1 - v0), w0 = 1.f / (1.f + e1), w1 = e1 * w0;
            if (F.lane == 0) {
                int* TOPI = (int*)(F.ws + WS_META + META_TOPI); float* TOPW = (float*)(F.ws + WS_META + META_TOPW); int* RANK = (int*)(F.ws + WS_META + META_RANK);
                TOPI[tk * 2] = i0; TOPI[tk * 2 + 1] = i1; TOPW[tk * 2] = w0; TOPW[tk * 2 + 1] = w1;
                RANK[tk * 2] = (int)__hip_atomic_fetch_add((LAS unsigned*)(F.MISC + 24 + i0), 1u, __ATOMIC_RELAXED, __HIP_MEMORY_SCOPE_WORKGROUP);
                RANK[tk * 2 + 1] = (int)__hip_atomic_fetch_add((LAS unsigned*)(F.MISC + 24 + i1), 1u, __ATOMIC_RELAXED, __HIP_MEMORY_SCOPE_WORKGROUP); }
        } } }
    if (!lat_only) for (int c = F.gw; c < NB * TC; c += F.NGW) { const int cb = c / TC, s = c - cb * TC; const size_t r = (size_t)cb * SROW + s; float* xr = (float*)(F.ws + WS_HCTX) + (size_t)c * D;
        Row4 x = ld_row_f32(xr, F.lane); Row4 y;
        if (nsl > 0) {
            const float* pp = (const float*)(F.ws + WS_PART) + (size_t)c * 1024; y = ld_row_f32(pp, F.lane);
            for (int q = 1; q < nsl; ++q) { const Row4 t = ld_row_f32(pp + (size_t)q * 1024 * 1024, F.lane);
#pragma unroll
                for (int j = 0; j < 4; ++j) y.v[j] = y.v[j] + t.v[j]; } }
        else y = ld_row_bf16(Y + r * D, F.lane);
        add_gated_norm(x, y, wy, modvec(F, lg, 4, kg), F.lane); st_row_f32(xr, F.lane, x);
        const Row4 a = norm_mod(x, w2, modvec(F, l2, 4, ks2), modvec(F, l2, 4, ks2 + 1), F.lane);
        st_row_bf16(Aout + r * D, F.lane, a); }
}
__device__ __forceinline__ void router_tail(Frame& F) {
    {
        __syncthreads();
        if (F.tid < 8) { ((int*)(F.ws + WS_META + META_BLKB))[F.vcu * 8 + F.tid] = (int)__hip_atomic_fetch_add((unsigned*)(F.ctl + CW_MOECNT + 64 * F.tid), F.MISC[24 + F.tid], RLX_AGENT); F.MISC[24 + F.tid] = 0u; }
    }
}
__device__ __forceinline__ void g0_prep(Frame& F) {
    const bf16* P = (const bf16*)(F.ws + WS_PROJ); bf16* PW = (bf16*)(F.ws + WS_PROJ); bf16* QK = (bf16*)(F.ws + WS_QKVN); float* GB = (float*)(F.ws + WS_GB);
    const float* cw = F.in[I_ECONV]; const int lane = F.lane;
#pragma unroll 1
    for (int part = 0; part < 3; ++part) { const int ch = part * 512 + 8 * lane; float w[5][8];
#pragma unroll
        for (int j = 0; j < 5; ++j) { const f32x4 w0 = *(const GAS f32x4*)(cw + j * 1536 + ch), w1 = *(const GAS f32x4*)(cw + j * 1536 + ch + 4); w[j][0] = w0.x; w[j][1] = w0.y; w[j][2] = w0.z; w[j][3] = w0.w; w[j][4] = w1.x; w[j][5] = w1.y; w[j][6] = w1.z; w[j][7] = w1.w; }
        v4u tn[5];
#define G0_TAPS(dst, r_) do { const int b_ = (r_) / SROW, s_ = (r_) - b_ * SROW; const bool c_ = s_ < TC; const int p_ = c_ ? s_ : s_ - TC, len_ = c_ ? TC : T; \
            _Pragma("unroll") for (int j = 0; j < 5; ++j) { const int pp = p_ + j - 2; dst[j] = (pp >= 0 && pp < len_) ? *(const GAS v4u*)(P + (size_t)((r_) + j - 2) * EINP + ch) : (v4u){0u, 0u, 0u, 0u}; } } while (0)
        if (F.gw < NR) G0_TAPS(tn, F.gw);
        for (int r = F.gw; r < NR; r += F.NGW) { v4u tc[5];
#pragma unroll
            for (int j = 0; j < 5; ++j) tc[j] = tn[j];
            if (r + F.NGW < NR) G0_TAPS(tn, r + F.NGW);
            float acc[8];
#pragma unroll
            for (int e = 0; e < 8; ++e) acc[e] = 0.f;
#pragma unroll
            for (int j = 0; j < 5; ++j) { const v4u xv = tc[j];
                acc[0] += bflo(xv.x) * w[j][0]; acc[1] += bfhi(xv.x) * w[j][1]; acc[2] += bflo(xv.y) * w[j][2]; acc[3] += bfhi(xv.y) * w[j][3];
                acc[4] += bflo(xv.z) * w[j][4]; acc[5] += bfhi(xv.z) * w[j][5]; acc[6] += bflo(xv.w) * w[j][6]; acc[7] += bfhi(xv.w) * w[j][7]; }
            float ss = 0.f;
#pragma unroll
            for (int e = 0; e < 8; ++e) { acc[e] = siluf(acc[e]); ss += acc[e] * acc[e]; }
            if (part < 2) { ss += __shfl_xor(ss, 1); ss += __shfl_xor(ss, 2); ss += __shfl_xor(ss, 4); const float sc = (part == 0 ? 0.125f : 1.f) * __builtin_amdgcn_rsqf(ss + EPS);
#pragma unroll
                for (int e = 0; e < 8; ++e) acc[e] *= sc; }
            *(GAS v4u*)(QK + (size_t)r * 1536 + ch) = (v4u){pk2(acc[0], acc[1]), pk2(acc[2], acc[3]), pk2(acc[4], acc[5]), pk2(acc[6], acc[7])}; }
#undef G0_TAPS
    }
    for (int r = F.gw; r < NR; r += F.NGW) { const int b = r / SROW, s = r - b * SROW; const bool isc = s < TC; const int p = isc ? s : s - TC;
        if (lane < 16) { const float ga = bf2f(P[(size_t)r * EINP + E_GA + lane]), gb = bf2f(P[(size_t)r * EINP + E_GB + lane]);
            const float xx = ga + F.in[I_EDTB][lane], sp = fmaxf(xx, 0.f) + log1pf(__expf(-fabsf(xx)));
            GB[(size_t)r * 32 + lane] = -__expf(F.in[I_EALOG][lane]) * sp; GB[(size_t)r * 32 + 16 + lane] = 1.f / (1.f + __expf(-gb)); }
        if (!isc) {
            const int pi = lane & 31, seg = pi >> 4, i = pi & 15, d0 = seg * 32 + i; const float pos = (float)(seg ? (p & 63) : (p >> 6));
            const float ang = pos * __powf(10000.f, -(float)i * (1.f / 16.f)); float sn, cs; sincosf(ang, &sn, &cs);
#pragma unroll
            for (int q = 0; q < 5; ++q) { const int hh = (lane >> 5) + 2 * q; bf16* base = PW + (size_t)r * EINP + (hh < 8 ? E_SQ + hh * 64 : E_SK + (hh - 8) * 64) + d0;
                const float x0 = bf2f(base[0]), x1 = bf2f(base[16]); base[0] = (bf16)f2bf(x0 * cs - x1 * sn); base[16] = (bf16)f2bf(x1 * cs + x0 * sn); }
        }
    }
}
constexpr int GP = 65, GLP = 68;
template <int I> struct SolveRow {
    static __device__ __forceinline__ void run(float (&x)[64], const LAS float* Ls) {
        SolveRow<I - 1>::run(x, Ls);
        float a = x[I];
#pragma unroll
        for (int j = 0; j < I; ++j) a -= Ls[I * GLP + j] * x[j];
        x[I] = a;
    }
};
template <> struct SolveRow<0> { static __device__ __forceinline__ void run(float (&)[64], const LAS float*) {} };

__device__ __forceinline__ void gdn_chain(Frame& F, int chain) {
    const int b = chain >> 4, h = (chain >> 1) & 7, dir = chain & 1;
    LAS float* Ss = (LAS float*)(F.lds + RING_OFF);
    LAS float* Qs = Ss + 64 * GP, *Ks = Qs + 64 * GP, *Vs = Ks + 64 * GP  , *ATs = Vs + 64 * GP, *Ws = ATs + 64 * GP, *VNs = Ws + 64 * GP;
    LAS float* Ls = VNs + 64 * GP;
    LAS float* gcs = Ls + 64 * GLP, *bts = gcs + 64;
    const bf16* QK = (const bf16*)(F.ws + WS_QKVN); const float* GB = (const float*)(F.ws + WS_GB); bf16* OG = (bf16*)(F.ws + WS_OG);
    const int tid = F.tid, lane = F.lane, w = F.wave;
    for (int i = tid; i < 64 * GP; i += 512) Ss[i] = 0.f;
    for (int ci = 0; ci < 68; ++ci) {
        const bool isc = ci < 4; const int n0 = (isc ? ci : ci - 4) * 64; const int rbase = b * SROW + (isc ? 0 : TC), len = isc ? TC : T;
        __syncthreads();
        for (int e = tid; e < 64 * 24; e += 512) { const int i = e / 24, c8 = e % 24, part = c8 >> 3, cc = (c8 & 7) * 8; const int n = n0 + i, row = rbase + (dir ? len - 1 - n : n);
            const v4u xv = *(const GAS v4u*)(QK + (size_t)row * 1536 + part * 512 + h * 64 + cc); LAS float* dst = (part == 0 ? Qs : part == 1 ? Ks : Vs) + i * GP + cc;
            dst[0] = bflo(xv.x); dst[1] = bfhi(xv.x); dst[2] = bflo(xv.y); dst[3] = bfhi(xv.y); dst[4] = bflo(xv.z); dst[5] = bfhi(xv.z); dst[6] = bflo(xv.w); dst[7] = bfhi(xv.w); }
        if (tid < 64) { const int n = n0 + tid, row = rbase + (dir ? len - 1 - n : n); float g = GB[(size_t)row * 32 + dir * 8 + h]; bts[tid] = GB[(size_t)row * 32 + 16 + dir * 8 + h];
#pragma unroll
            for (int o = 1; o < 64; o <<= 1) { const float t = __shfl_up(g, o); if (lane >= o) g += t; }
            gcs[tid] = g; }
        __syncthreads();
#pragma unroll 1
        for (int k = 0; k < 8; ++k) { const int i = w + 8 * k, j = lane; float kk = 0.f, qk = 0.f;
#pragma unroll 16
            for (int d = 0; d < 64; ++d) { const float kj = Ks[j * GP + d]; kk += Ks[i * GP + d] * kj; qk += Qs[i * GP + d] * kj; }
            const float dec = (j <= i) ? __expf(gcs[i] - gcs[j]) : 0.f;
            Ls[i * GLP + j] = (j < i) ? bts[i] * kk * dec : 0.f; ATs[i * GP + j] = qk * dec; }
        __syncthreads();
        if (tid < 128) { float x[64]; const int c = tid & 63; const bool isw = tid >= 64; int zz = 0; asm volatile("" : "+v"(zz));
            const LAS float* src = (isw ? Ks : Vs) + c; const LAS float* btz = bts + zz; const LAS float* gcz = gcs + zz;
#pragma unroll
            for (int i = 0; i < 64; ++i) { const float e = isw ? __expf(gcz[i]) : 1.f; x[i] = src[i * GP] * btz[i] * e; }
            SolveRow<63>::run(x, Ls + zz);
            LAS float* dst = isw ? Ws : Vs;
#pragma unroll
            for (int i = 0; i < 64; ++i) dst[i * GP + c] = x[i]; }
        __syncthreads();
#pragma unroll 1
        for (int k = 0; k < 8; ++k) { const int i = w + 8 * k, d = lane; float a = Vs[i * GP + d];
#pragma unroll 16
            for (int q = 0; q < 64; ++q) a -= Ws[i * GP + q] * Ss[q * GP + d];
            VNs[i * GP + d] = a; }
        __syncthreads();
#pragma unroll 1
        for (int k = 0; k < 8; ++k) { const int i = w + 8 * k, d = lane; float a = 0.f, c2 = 0.f;
#pragma unroll 16
            for (int q = 0; q < 64; ++q) { a += Qs[i * GP + q] * Ss[q * GP + d]; c2 += ATs[i * GP + q] * VNs[q * GP + d]; }
            const int n = n0 + i, row = rbase + (dir ? len - 1 - n : n);
            OG[(size_t)row * 1024 + dir * 512 + h * 64 + d] = (bf16)f2bf(a * __expf(gcs[i]) + c2); }
        __syncthreads();
        const float gl = gcs[63];
#pragma unroll 1
        for (int k = 0; k < 8; ++k) { const int a = w + 8 * k, d = lane; float acc = Ss[a * GP + d] * __expf(gl);
#pragma unroll 16
            for (int i = 0; i < 64; ++i) acc += Ks[i * GP + a] * __expf(gl - gcs[i]) * VNs[i * GP + d];
            Ss[a * GP + d] = acc; }
    }
    __syncthreads();
}
__device__ __forceinline__ void g4_gdn_out(Frame& F) {
    const bf16* OG = (const bf16*)(F.ws + WS_OG); const bf16* P = (const bf16*)(F.ws + WS_PROJ); bf16* MIX = (bf16*)(F.ws + WS_MIX); const float* gn = F.in[I_EGDNN]; const int lane = F.lane;
    const f32x4 g0 = *(const GAS f32x4*)(gn + (lane & 7) * 8), g1 = *(const GAS f32x4*)(gn + (lane & 7) * 8 + 4);
    v4u an, cn, zn;
    if (F.gw < NR) { an = *(const GAS v4u*)(OG + (size_t)F.gw * 1024 + 8 * lane); cn = *(const GAS v4u*)(OG + (size_t)F.gw * 1024 + 512 + 8 * lane); zn = *(const GAS v4u*)(P + (size_t)F.gw * EINP + E_Z + 8 * lane); }
    for (int r = F.gw; r < NR; r += F.NGW) {
        const v4u a = an, c = cn, z = zn;
        if (r + F.NGW < NR) { const size_t rn = (size_t)(r + F.NGW); an = *(const GAS v4u*)(OG + rn * 1024 + 8 * lane); cn = *(const GAS v4u*)(OG + rn * 1024 + 512 + 8 * lane); zn = *(const GAS v4u*)(P + rn * EINP + E_Z + 8 * lane); }
        float o[8] = {bflo(a.x) + bflo(c.x), bfhi(a.x) + bfhi(c.x), bflo(a.y) + bflo(c.y), bfhi(a.y) + bfhi(c.y), bflo(a.z) + bflo(c.z), bfhi(a.z) + bfhi(c.z), bflo(a.w) + bflo(c.w), bfhi(a.w) + bfhi(c.w)};
        float ss = 0.f;
#pragma unroll
        for (int e = 0; e < 8; ++e) ss += o[e] * o[e];
        ss += __shfl_xor(ss, 1); ss += __shfl_xor(ss, 2); ss += __shfl_xor(ss, 4);
        const float rs = __builtin_amdgcn_rsqf(ss * (1.f / 64.f) + EPS);
        const float zz[8] = {bflo(z.x), bfhi(z.x), bflo(z.y), bfhi(z.y), bflo(z.z), bfhi(z.z), bflo(z.w), bfhi(z.w)};
        const float gg[8] = {g0.x, g0.y, g0.z, g0.w, g1.x, g1.y, g1.z, g1.w};
#pragma unroll
        for (int e = 0; e < 8; ++e) o[e] = o[e] * rs * gg[e] * siluf(zz[e]);
        *(GAS v4u*)(MIX + (size_t)r * 1024 + 8 * lane) = (v4u){pk2(o[0], o[1]), pk2(o[2], o[3]), pk2(o[4], o[5]), pk2(o[6], o[7])}; }
}
__device__ __forceinline__ void swa_unit(Frame& F, int u) {
    const bf16* P = (const bf16*)(F.ws + WS_PROJ); bf16* MIX = (bf16*)(F.ws + WS_MIX);
    constexpr float SC = 0.125f, C = SC * 1.4426950408889634f, THRS = att::THR / SC;
    if (u < 512) { const int b = u >> 7, qb = (u >> 3) & 15, hq = u & 7, kvh = hq >> 2; const size_t rq = (size_t)b * SROW + TC + qb * 256, r0 = (size_t)b * SROW;
        const int lat0 = qb * 256 - 128 < 0 ? 0 : qb * 256 - 128, lend = qb * 256 + 384 > T ? T : qb * 256 + 384, NT = 4 + (lend - lat0) / 64;
        att::attn_unit<64, 64, 1>(P + rq * EINP + E_SQ + hq * 64, EINP, P + r0 * EINP + E_SK + kvh * 64, EINP, P + r0 * EINP + E_SV + kvh * 64, EINP,
                                  MIX + rq * 1024 + 512 + hq * 64, 1024, NT, lat0, qb * 256, C, THRS, F.in[I_ESINK][hq] * 1.4426950408889634f, F.ldsg + RING_OFF);
    } else { const int v = u - 512, b = v >> 3, hq = v & 7, kvh = hq >> 2; const size_t r0 = (size_t)b * SROW;
        att::attn_unit<64, 64, 2>(P + r0 * EINP + E_SQ + hq * 64, EINP, P + r0 * EINP + E_SK + kvh * 64, EINP, P + r0 * EINP + E_SV + kvh * 64, EINP,
                                  MIX + r0 * 1024 + 512 + hq * 64, 1024, 4, 0, 0, C, THRS, F.in[I_ESINK][hq] * 1.4426950408889634f, F.ldsg + RING_OFF); }
}
namespace gdn {
using bf16x8 = __attribute__((ext_vector_type(8))) short;
using f32x16 = __attribute__((ext_vector_type(16))) float;
using u32x4  = __attribute__((ext_vector_type(4))) unsigned;
__device__ __forceinline__ int crow(int r, int hi) { return (r & 3) + 8 * (r >> 2) + 4 * hi; }
typedef float f32x2_t __attribute__((ext_vector_type(2))); typedef __bf16 bf16x2_t __attribute__((ext_vector_type(2)));
__device__ __forceinline__ unsigned cvtpk(float lo, float hi) { f32x2_t v = {lo, hi}; bf16x2_t b = __builtin_convertvector(v, bf16x2_t); return __builtin_bit_cast(unsigned, b); }
__device__ __forceinline__ int swap23(int p) { return (p & ~0xC) | ((p & 4) << 1) | ((p & 8) >> 1); }
typedef float f32x4g __attribute__((ext_vector_type(4)));
template <int I> struct LRow {
    static constexpr int NQ = (I + 3) / 4, O = I * 128;
    static __device__ __forceinline__ void load(f32x4g (&b)[8], unsigned la) {
        if constexpr (NQ == 1) asm volatile("ds_read_b128 %0, %1 offset:%2\n\ts_waitcnt lgkmcnt(0)" : "=&v"(b[0]) : "v"(la), "i"(O));
        else if constexpr (NQ == 2) asm volatile("ds_read_b128 %0, %2 offset:%3\n\tds_read_b128 %1, %2 offset:%4\n\ts_waitcnt lgkmcnt(0)" : "=&v"(b[0]), "=&v"(b[1]) : "v"(la), "i"(O), "i"(O + 16));
        else if constexpr (NQ == 3) asm volatile("ds_read_b128 %0, %3 offset:%4\n\tds_read_b128 %1, %3 offset:%5\n\tds_read_b128 %2, %3 offset:%6\n\ts_waitcnt lgkmcnt(0)" : "=&v"(b[0]), "=&v"(b[1]), "=&v"(b[2]) : "v"(la), "i"(O), "i"(O + 16), "i"(O + 32));
        else if constexpr (NQ == 4) asm volatile("ds_read_b128 %0, %4 offset:%5\n\tds_read_b128 %1, %4 offset:%6\n\tds_read_b128 %2, %4 offset:%7\n\tds_read_b128 %3, %4 offset:%8\n\ts_waitcnt lgkmcnt(0)" : "=&v"(b[0]), "=&v"(b[1]), "=&v"(b[2]), "=&v"(b[3]) : "v"(la), "i"(O), "i"(O + 16), "i"(O + 32), "i"(O + 48));
        else if constexpr (NQ == 5) asm volatile("ds_read_b128 %0, %5 offset:%6\n\tds_read_b128 %1, %5 offset:%7\n\tds_read_b128 %2, %5 offset:%8\n\tds_read_b128 %3, %5 offset:%9\n\tds_read_b128 %4, %5 offset:%10\n\ts_waitcnt lgkmcnt(0)" : "=&v"(b[0]), "=&v"(b[1]), "=&v"(b[2]), "=&v"(b[3]), "=&v"(b[4]) : "v"(la), "i"(O), "i"(O + 16), "i"(O + 32), "i"(O + 48), "i"(O + 64));
        else if constexpr (NQ == 6) asm volatile("ds_read_b128 %0, %6 offset:%7\n\tds_read_b128 %1, %6 offset:%8\n\tds_read_b128 %2, %6 offset:%9\n\tds_read_b128 %3, %6 offset:%10\n\tds_read_b128 %4, %6 offset:%11\n\tds_read_b128 %5, %6 offset:%12\n\ts_waitcnt lgkmcnt(0)" : "=&v"(b[0]), "=&v"(b[1]), "=&v"(b[2]), "=&v"(b[3]), "=&v"(b[4]), "=&v"(b[5]) : "v"(la), "i"(O), "i"(O + 16), "i"(O + 32), "i"(O + 48), "i"(O + 64), "i"(O + 80));
        else if constexpr (NQ == 7) asm volatile("ds_read_b128 %0, %7 offset:%8\n\tds_read_b128 %1, %7 offset:%9\n\tds_read_b128 %2, %7 offset:%10\n\tds_read_b128 %3, %7 offset:%11\n\tds_read_b128 %4, %7 offset:%12\n\tds_read_b128 %5, %7 offset:%13\n\tds_read_b128 %6, %7 offset:%14\n\ts_waitcnt lgkmcnt(0)" : "=&v"(b[0]), "=&v"(b[1]), "=&v"(b[2]), "=&v"(b[3]), "=&v"(b[4]), "=&v"(b[5]), "=&v"(b[6]) : "v"(la), "i"(O), "i"(O + 16), "i"(O + 32), "i"(O + 48), "i"(O + 64), "i"(O + 80), "i"(O + 96));
        else asm volatile("ds_read_b128 %0, %8 offset:%9\n\tds_read_b128 %1, %8 offset:%10\n\tds_read_b128 %2, %8 offset:%11\n\tds_read_b128 %3, %8 offset:%12\n\tds_read_b128 %4, %8 offset:%13\n\tds_read_b128 %5, %8 offset:%14\n\tds_read_b128 %6, %8 offset:%15\n\tds_read_b128 %7, %8 offset:%16\n\ts_waitcnt lgkmcnt(0)" : "=&v"(b[0]), "=&v"(b[1]), "=&v"(b[2]), "=&v"(b[3]), "=&v"(b[4]), "=&v"(b[5]), "=&v"(b[6]), "=&v"(b[7]) : "v"(la), "i"(O), "i"(O + 16), "i"(O + 32), "i"(O + 48), "i"(O + 64), "i"(O + 80), "i"(O + 96), "i"(O + 112));
    }
};
template <int I> struct Solve32 {
    static __device__ __forceinline__ void run(float (&x)[32], unsigned la) {
#ifdef SOLVE_C_LOAD
        f32x4g b[8]; { const LAS f32x4g* Lp = (const LAS f32x4g*)(uintptr_t)(la + I * 128);
#pragma unroll
          for (int q = 0; q < (I + 3) / 4; ++q) b[q] = Lp[q]; }
#else
        f32x4g b[8]; LRow<I>::load(b, la);
#endif
        float a = x[I];
#pragma unroll
#ifdef SOLVE_C_FMA
        for (int j = 0; j < I; ++j) a = __builtin_fmaf(-b[j >> 2][j & 3], x[j], a);
#else
        for (int j = 0; j < I; ++j) asm volatile("v_fma_f32 %0, -%1, %2, %0" : "+v"(a) : "v"(b[j >> 2][j & 3]), "v"(x[j]));
#endif
        x[I] = a;
        if constexpr (I < 31) Solve32<I + 1>::run(x, la);
    }
};
__device__ __forceinline__ void solve32(float (&x)[32], unsigned la) { Solve32<1>::run(x, la); }
__device__ __forceinline__ void col_frags32(const float (&x)[32], bf16x8 (&F)[4][2], int s0) {
#pragma unroll
    for (int s = 0; s < 2; ++s) {
        const unsigned p0[4] = {cvtpk(x[16 * s + 0], x[16 * s + 1]), cvtpk(x[16 * s + 2], x[16 * s + 3]), cvtpk(x[16 * s + 8], x[16 * s + 9]), cvtpk(x[16 * s + 10], x[16 * s + 11])};
        const unsigned p1[4] = {cvtpk(x[16 * s + 4], x[16 * s + 5]), cvtpk(x[16 * s + 6], x[16 * s + 7]), cvtpk(x[16 * s + 12], x[16 * s + 13]), cvtpk(x[16 * s + 14], x[16 * s + 15])};
        u32x4 f0, f1;
#pragma unroll
        for (int q = 0; q < 4; ++q) { auto r = __builtin_amdgcn_permlane32_swap(p0[q], p1[q], false, false); f0[q] = r[0]; f1[q] = r[1]; }
        F[s0 + s][0] = __builtin_bit_cast(bf16x8, f0); F[s0 + s][1] = __builtin_bit_cast(bf16x8, f1); }
}
__device__ __forceinline__ void solve_blocked(float (&x1)[32], float (&x2)[32], unsigned la, const bf16x8 (&L21A)[2], bf16x8 (&F)[4][2]) {
    solve32(x1, la);
    col_frags32(x1, F, 0);
    f32x16 t0 = f32x16{}, t1 = f32x16{};
    t0 = __builtin_amdgcn_mfma_f32_32x32x16_bf16(L21A[0], F[0][0], t0, 0, 0, 0); t0 = __builtin_amdgcn_mfma_f32_32x32x16_bf16(L21A[1], F[1][0], t0, 0, 0, 0);
    t1 = __builtin_amdgcn_mfma_f32_32x32x16_bf16(L21A[0], F[0][1], t1, 0, 0, 0); t1 = __builtin_amdgcn_mfma_f32_32x32x16_bf16(L21A[1], F[1][1], t1, 0, 0, 0);
#pragma unroll
    for (int r = 0; r < 16; ++r) { const float e0 = t0[r], e1 = t1[r]; auto sw = __builtin_amdgcn_permlane32_swap(__float_as_uint(e0), __float_as_uint(e1), false, false);
        x2[(r & 3) + 8 * (r >> 2)] -= __uint_as_float(sw[0]); x2[(r & 3) + 8 * (r >> 2) + 4] -= __uint_as_float(sw[1]); }
    __builtin_amdgcn_sched_barrier(0);
    solve32(x2, la + 4096u);
    col_frags32(x2, F, 2);
}
__device__ __forceinline__ bf16x8 acc_frag(const f32x16& t, int sp) {
    u32x4 w;
    if (sp == 0) { w[0] = cvtpk(t[0], t[1]); w[1] = cvtpk(t[2], t[3]); w[2] = cvtpk(t[4], t[5]); w[3] = cvtpk(t[6], t[7]); }
    else { w[0] = cvtpk(t[8], t[9]); w[1] = cvtpk(t[10], t[11]); w[2] = cvtpk(t[12], t[13]); w[3] = cvtpk(t[14], t[15]); }
    return __builtin_bit_cast(bf16x8, w);
}
__device__ __forceinline__ void store_accfrag(__amdgpu_buffer_rsrc_t ro, int soff, int lane, const f32x16& t) {
    __builtin_amdgcn_raw_buffer_store_b128((u32x4){cvtpk(t[0], t[1]), cvtpk(t[2], t[3]), cvtpk(t[4], t[5]), cvtpk(t[6], t[7])}, ro, lane * 32, soff, 0);
    __builtin_amdgcn_raw_buffer_store_b128((u32x4){cvtpk(t[8], t[9]), cvtpk(t[10], t[11]), cvtpk(t[12], t[13]), cvtpk(t[14], t[15])}, ro, lane * 32 + 16, soff, 0);
}
struct ItemGeom { int b, h, dir, rbase, len, n0; };
__device__ __forceinline__ ItemGeom item_geom(int chain, int ci) { ItemGeom g; g.b = chain >> 4; g.h = (chain >> 1) & 7; g.dir = chain & 1; const bool isc = ci < 4;
    g.n0 = (isc ? ci : ci - 4) * 64; g.rbase = g.b * SROW + (isc ? 0 : TC); g.len = isc ? TC : T; return g; }
__device__ __forceinline__ int item_row(const ItemGeom& g, int i) { const int n = g.n0 + i; return g.rbase + (g.dir ? g.len - 1 - n : n); }

#define G1_LANES() int zs_ = 0; asm volatile("" : "+v"(zs_)); const int lane = (int)__builtin_amdgcn_mbcnt_hi(~0u, __builtin_amdgcn_mbcnt_lo(~0u, (unsigned)zs_)), r32 = lane & 31, hi = lane >> 5; (void)r32; (void)hi
__device__ __forceinline__ void pair_lock(volatile LAS unsigned* w) {
    for (;;) { unsigned got = 0u; if (__builtin_amdgcn_mbcnt_hi(~0u, __builtin_amdgcn_mbcnt_lo(~0u, 0u)) == 0u) got = (__hip_atomic_exchange((LAS unsigned*)w, 1u, __ATOMIC_RELAXED, __HIP_MEMORY_SCOPE_WORKGROUP) == 0u) ? 1u : 0u;
        got = (unsigned)__builtin_amdgcn_readfirstlane((int)got); if (got) break; __builtin_amdgcn_s_sleep(2); }
    asm volatile("s_waitcnt lgkmcnt(0)" ::: "memory"); }
__device__ __forceinline__ void pair_unlock(volatile LAS unsigned* w) { asm volatile("s_waitcnt vmcnt(0) lgkmcnt(0)" ::: "memory"); if (__builtin_amdgcn_mbcnt_hi(~0u, __builtin_amdgcn_mbcnt_lo(~0u, 0u)) == 0u) __hip_atomic_store((LAS unsigned*)w, 0u, __ATOMIC_RELAXED, __HIP_MEMORY_SCOPE_WORKGROUP); asm volatile("s_waitcnt lgkmcnt(0)" ::: "memory"); }
#ifndef G1_LOCK
#define G1_LOCK 0
#endif
#define LOCK_IF(m) do { if (G1_LOCK & (m)) pair_lock(lockw); } while (0)
#define UNLOCK_IF(m) do { if (G1_LOCK & (m)) pair_unlock(lockw); } while (0)
constexpr int G1_L = 0, G1_ARR = 8192, G1_TK = 9216, G1_TV = 17408, G1_TQ = 17408  , G1_WAVE_LDS = 26624;
__device__ __forceinline__ void g1_item(Frame& F, int item, LAS unsigned char* wl, volatile LAS unsigned* lockw) {
    int zz = 0; asm volatile("" : "+v"(zz)); __builtin_assume((unsigned)zz < 2u);
    const int chain = item / 68, ci = item - chain * 68; const ItemGeom G = item_geom(chain, ci); const int h = G.h;
    LAS float* Ls = (LAS float*)(wl + G1_L); LAS float* gcA = (LAS float*)(wl + G1_ARR), *btA = gcA + 64, *egA = gcA + 128, *etA = gcA + 192;
    const LAS bf16* TK = (const LAS bf16*)(wl + G1_TK); const LAS bf16* TV = (const LAS bf16*)(wl + G1_TV); const LAS bf16* TQ = (const LAS bf16*)(wl + G1_TQ);
    const bf16* QK = (const bf16*)(F.ws + WS_QKVN); const float* GB = (const float*)(F.ws + WS_GB);
    bf16* out = (bf16*)(F.ws + WS_GDNI) + (size_t)item * 16384;
    LOCK_IF(1);
    u32x4 tq[8];
    { G1_LANES(); u32x4 t[2][8];
#pragma unroll
      for (int j = 0; j < 8; ++j) { const int i = (lane >> 3) + 8 * j; const bf16* rp = QK + (size_t)item_row(G, i) * 1536 + h * 64 + (lane & 7) * 8;
          t[0][j] = *(const GAS u32x4*)(rp + 512); t[1][j] = *(const GAS u32x4*)(rp + 1024); tq[j] = *(const GAS u32x4*)rp; }
#pragma unroll
      for (int j = 0; j < 8; ++j) { const int o = ((lane >> 3) + 8 * j) * 128 + (lane & 7) * 16;
          *(LAS u32x4*)(wl + G1_TK + o) = t[0][j]; *(LAS u32x4*)(wl + G1_TV + o) = t[1][j]; } }
    float gl;
    { G1_LANES(); const int row = item_row(G, lane); float g = GB[(size_t)row * 32 + G.dir * 8 + h]; const float bt = GB[(size_t)row * 32 + 16 + G.dir * 8 + h];
#pragma unroll
      for (int o = 1; o < 64; o <<= 1) { const float t = __builtin_bit_cast(float, __builtin_amdgcn_ds_bpermute((lane - o) << 2, __builtin_bit_cast(int, g))); if (lane >= o) g += t; }
      gl = __builtin_bit_cast(float, __builtin_amdgcn_readlane(__builtin_bit_cast(int, g), 63)); gcA[lane] = g; btA[lane] = bt; egA[lane] = __expf(g); etA[lane] = __expf(gl - g); }
    asm volatile("s_waitcnt lgkmcnt(0)" ::: "memory");
    const LAS float* gcz = gcA + zz; const LAS float* btz = btA + zz; const LAS float* egz = egA + zz; const LAS float* etz = etA + zz;
    UNLOCK_IF(1); LOCK_IF(2);
    bf16x8 L21A[2];
    { G1_LANES(); bf16x8 Kf[2][4];
#pragma unroll
      for (int t = 0; t < 2; ++t)
#pragma unroll
          for (int s = 0; s < 4; ++s) Kf[t][s] = *(const LAS bf16x8*)(TK + (32 * t + r32) * 64 + 16 * s + 8 * hi);
#pragma unroll
      for (int t = 0; t < 2; ++t) { f32x16 acc = f32x16{};
#pragma unroll
          for (int s = 0; s < 4; ++s) acc = __builtin_amdgcn_mfma_f32_32x32x16_bf16(Kf[t][s], Kf[t][s], acc, 0, 0, 0);
          const float gcj = gcz[32 * t + r32];
#pragma unroll
          for (int r = 0; r < 16; ++r) { const int il = crow(r, hi), i = 32 * t + il; const float e = __expf(fminf(gcz[i] - gcj, 0.f)); const float v0 = btz[i] * acc[r] * e; Ls[t * 1024 + il * 32 + r32] = (r32 < il) ? v0 : 0.f; } }
      { f32x16 acc = f32x16{};
#pragma unroll
          for (int s = 0; s < 4; ++s) acc = __builtin_amdgcn_mfma_f32_32x32x16_bf16(Kf[0][s], Kf[1][s], acc, 0, 0, 0);
          const int i = 32 + r32; const float gci = gcz[i], bti = btz[i];
#pragma unroll
          for (int r = 0; r < 16; ++r) { const int j = crow(r, hi); acc[r] = bti * acc[r] * __expf(fminf(gci - gcz[j], 0.f)); }
          L21A[0] = acc_frag(acc, 0); L21A[1] = acc_frag(acc, 1); } }
    asm volatile("s_waitcnt lgkmcnt(0)" ::: "memory"); __builtin_amdgcn_sched_barrier(0);
    UNLOCK_IF(2); LOCK_IF(4);
    bf16x8 UF[4][2];
    const unsigned la = (unsigned)(uintptr_t)Ls + ((unsigned)zz << 4);
    { G1_LANES(); float x1[32], x2[32];
#pragma unroll
      for (int i = 0; i < 64; ++i) { const float v = bf2f(TV[i * 64 + lane]) * btz[i]; if (i < 32) x1[i & 31] = v; else x2[i & 31] = v; }
      asm volatile("s_waitcnt lgkmcnt(0)" ::: "memory");
#pragma unroll
      for (int j = 0; j < 8; ++j) *(LAS u32x4*)(wl + G1_TQ + ((lane >> 3) + 8 * j) * 128 + (lane & 7) * 16) = tq[j];
      solve_blocked(x1, x2, la, L21A, UF); }
    __builtin_amdgcn_sched_barrier(0);
    bf16x8 WF[4][2];
    { G1_LANES(); float x1[32], x2[32];
#pragma unroll
      for (int i = 0; i < 64; ++i) { const float v = bf2f(TK[i * 64 + lane]) * btz[i] * egz[i]; if (i < 32) x1[i & 31] = v; else x2[i & 31] = v; }
      solve_blocked(x1, x2, la, L21A, WF); }
    __builtin_amdgcn_sched_barrier(0);
    UNLOCK_IF(4); LOCK_IF(8);
    bf16x8 KTA[4][2];
    { G1_LANES(); float k1[32], k2[32];
#pragma unroll
      for (int i = 0; i < 32; ++i) { k1[i] = bf2f(TK[i * 64 + lane]) * etz[i]; k2[i] = bf2f(TK[(32 + i) * 64 + lane]) * etz[32 + i]; }
      col_frags32(k1, KTA, 0); col_frags32(k2, KTA, 2); }
    __builtin_amdgcn_sched_barrier(0);
    const __amdgpu_buffer_rsrc_t ro = __builtin_amdgcn_make_buffer_rsrc((void*)out, 0, 32768, 0x00020000);
    {
    G1_LANES();
    const float egl = __expf(gl);
#pragma unroll
    for (int at = 0; at < 2; ++at)
#pragma unroll
        for (int ct = 0; ct < 2; ++ct) { f32x16 a0 = f32x16{}, a1 = f32x16{};
#pragma unroll
            for (int s = 0; s < 4; ++s) { a0 = __builtin_amdgcn_mfma_f32_32x32x16_bf16(KTA[s][at], UF[s][ct], a0, 0, 0, 0); a1 = __builtin_amdgcn_mfma_f32_32x32x16_bf16(KTA[s][at], WF[s][ct], a1, 0, 0, 0); }
            store_accfrag(ro, 16384 + (at * 2 + ct) * 2048, lane, a0);
            const int vo = 4 * hi * 128 + (32 * ct + swap23(r32)) * 2;
#pragma unroll
            for (int r = 0; r < 16; ++r) { const float v = ((at == ct && crow(r, hi) == r32) ? egl : 0.f) - a1[r];
                __builtin_amdgcn_raw_buffer_store_b16((short)f2bf(v), ro, vo + (r & 3) * 128 + (r >> 2) * 1024, 32 * at * 128, 0); }
            __builtin_amdgcn_sched_barrier(0); }
    }
    UNLOCK_IF(8); LOCK_IF(16);
    bf16x8 XA[3][2];
    { G1_LANES(); bf16x8 Kf[4], Qf[2][4]; const LAS bf16* TK2 = TK + zz;
#pragma unroll
      for (int t = 0; t < 2; ++t)
#pragma unroll
          for (int s = 0; s < 4; ++s) Qf[t][s] = *(const LAS bf16x8*)(TQ + (32 * t + r32) * 64 + 16 * s + 8 * hi);
#pragma unroll
      for (int tl = 0; tl < 3; ++tl) { const int jt = tl == 2 ? 1 : 0, it = tl == 0 ? 0 : 1;
          if (tl != 1) {
#pragma unroll
              for (int s = 0; s < 4; ++s) Kf[s] = *(const LAS bf16x8*)(TK2 + (32 * jt + r32) * 64 + 16 * s + 8 * hi); }
          f32x16 acc = f32x16{};
#pragma unroll
          for (int s = 0; s < 4; ++s) acc = __builtin_amdgcn_mfma_f32_32x32x16_bf16(Kf[s], Qf[it][s], acc, 0, 0, 0);
          const int i = 32 * it + r32; const float gci = gcz[i];
#pragma unroll
          for (int r = 0; r < 16; ++r) { const int j = 32 * jt + crow(r, hi); const float e = __expf(fminf(gci - gcz[j], 0.f)); const float v0 = acc[r] * e; acc[r] = (j <= i) ? v0 : 0.f; }
          XA[tl][0] = acc_frag(acc, 0); XA[tl][1] = acc_frag(acc, 1); __builtin_amdgcn_sched_barrier(0); } }
    __builtin_amdgcn_sched_barrier(0);
    {
    G1_LANES();
#pragma unroll
    for (int it = 0; it < 2; ++it)
#pragma unroll
        for (int ct = 0; ct < 2; ++ct) { f32x16 a0 = f32x16{}, a1 = f32x16{};
#pragma unroll
            for (int jt = 0; jt <= it; ++jt) { const int tl = (it == 0) ? 0 : (jt == 0 ? 1 : 2);
#pragma unroll
                for (int sp = 0; sp < 2; ++sp) { a0 = __builtin_amdgcn_mfma_f32_32x32x16_bf16(XA[tl][sp], UF[2 * jt + sp][ct], a0, 0, 0, 0); a1 = __builtin_amdgcn_mfma_f32_32x32x16_bf16(XA[tl][sp], WF[2 * jt + sp][ct], a1, 0, 0, 0); } }
            store_accfrag(ro, 24576 + (it * 2 + ct) * 2048, lane, a0);
            const int vo = 4 * hi * 128 + (32 * ct + swap23(r32)) * 2; const int a = 32 * ct + r32;
#pragma unroll
            for (int r = 0; r < 16; ++r) { const int i = 32 * it + crow(r, hi); const float qv = bf2f(TQ[i * 64 + a]);
                __builtin_amdgcn_raw_buffer_store_b16((short)f2bf(qv * egz[i] - a1[r]), ro, vo + (r & 3) * 128 + (r >> 2) * 1024, 8192 + 32 * it * 128, 0); }
            __builtin_amdgcn_sched_barrier(0); }
    }
    asm volatile("s_waitcnt lgkmcnt(0)" ::: "memory");
    UNLOCK_IF(16);
}
__device__ __forceinline__ void scan_chain(Frame& F, int chain, int dc) {
    const int w = F.wave, lane = F.lane, r32 = lane & 31, hi = lane >> 5, role = (w >> 1) & 1, rt = w & 1;
    LAS u32x4* SF = (LAS u32x4*)(F.lds + RING_OFF);
    const bf16* base = (const bf16*)(F.ws + WS_GDNI) + (size_t)chain * 68 * 16384; bf16* OG = (bf16*)(F.ws + WS_OG);
    for (int i = F.tid; i < 2 * 4 * 64; i += 512) SF[i] = (u32x4){0u, 0u, 0u, 0u};
    const bf16* Ab = base + (role ? 4096 : 0) + (32 * rt + r32) * 64 + 8 * hi; const bf16* Cb = base + (role ? 12288 : 8192) + ((rt * 2 + dc) * 64 + lane) * 16;
    struct Ops { bf16x8 a[4]; u32x4 c[2]; };
#define SC_LOAD(o, ci_) do { const bf16* A_ = Ab + (size_t)(ci_) * 16384; const bf16* C_ = Cb + (size_t)(ci_) * 16384; \
        _Pragma("unroll") for (int s_ = 0; s_ < 4; ++s_) (o).a[s_] = *(const GAS bf16x8*)(A_ + 16 * s_); (o).c[0] = *(const GAS u32x4*)C_; (o).c[1] = *(const GAS u32x4*)(C_ + 8); } while (0)
#define SC_STEP(o, ci_) do { f32x16 acc; \
        _Pragma("unroll") for (int q = 0; q < 4; ++q) { acc[2 * q] = bflo((o).c[0][q]); acc[2 * q + 1] = bfhi((o).c[0][q]); acc[8 + 2 * q] = bflo((o).c[1][q]); acc[8 + 2 * q + 1] = bfhi((o).c[1][q]); } \
        const LAS u32x4* Sb = SF + (((ci_) & 1) * 256) + lane; \
        _Pragma("unroll") for (int s_ = 0; s_ < 4; ++s_) { const u32x4 bw = Sb[s_ * 64]; acc = __builtin_amdgcn_mfma_f32_32x32x16_bf16((o).a[s_], __builtin_bit_cast(bf16x8, bw), acc, 0, 0, 0); } \
        SC_LOAD(o, ((ci_) + SCAN_PF < 68) ? (ci_) + SCAN_PF : 67);     \
        if (role == 0) { LAS u32x4* Sn = SF + ((((((ci_) + 1) & 1)) * 4 + 2 * rt) * 64) + lane; Sn[0] = __builtin_bit_cast(u32x4, acc_frag(acc, 0)); Sn[64] = __builtin_bit_cast(u32x4, acc_frag(acc, 1)); } \
        else { const ItemGeom G = item_geom(chain, (ci_)); LAS bf16* stg = (LAS bf16*)(F.lds + RING_OFF + 16384 + rt * 2048);     \
            _Pragma("unroll") for (int r = 0; r < 16; ++r) stg[crow(r, hi) * 32 + r32] = (bf16)f2bf(acc[r]); \
            asm volatile("s_waitcnt lgkmcnt(0)" ::: "memory"); \
            const u32x4 v0 = *(const LAS u32x4*)(stg + (lane >> 1) * 32 + (lane & 1) * 16), v1 = *(const LAS u32x4*)(stg + (lane >> 1) * 32 + (lane & 1) * 16 + 8); \
            GAS u32x4* po = (GAS u32x4*)(OG + (size_t)item_row(G, 32 * rt + (lane >> 1)) * 1024 + G.dir * 512 + G.h * 64 + 32 * dc + (lane & 1) * 16); po[0] = v0; po[1] = v1; } \
        asm volatile("s_waitcnt lgkmcnt(0)" ::: "memory"); __builtin_amdgcn_s_barrier(); asm volatile("" ::: "memory"); } while (0)
    if (w < 4) {
        Ops o[SCAN_PF];
#pragma unroll
        for (int k = 0; k < SCAN_PF; ++k) SC_LOAD(o[k], k);
        __syncthreads();
#pragma unroll
        for (int ci = 0; ci < 68; ++ci) SC_STEP(o[ci % SCAN_PF], ci);
        asm volatile("s_waitcnt vmcnt(0)" ::: "memory");
    } else {
        __syncthreads();
#pragma unroll 1
        for (int ci = 0; ci < 68; ++ci) { __builtin_amdgcn_s_barrier(); asm volatile("" ::: "memory"); }
    }
#undef SC_LOAD
#undef SC_STEP
}
}
__device__ __forceinline__ void l1_prep(Frame& F) {
    bf16* P = (bf16*)(F.ws + WS_PROJ2); bf16* KM = (bf16*)(F.ws + WS_KMLA); const int lane = F.lane;
    const int kseg = (lane >> 3) & 1, ki = lane & 7, kd0 = kseg * 16 + ki;
    const int pi = lane & 31, seg = pi >> 4, ri = pi & 15, d0 = seg * 32 + ri;
    const float kfreq = __powf(10000.f, -(float)ki * (1.f / 8.f)), freq = __powf(10000.f, -(float)ri * (1.f / 16.f));
    struct L1Row { v2u a, c, k; bf16 kr0, kr1, x0[8], x1[8]; };
#define L1_OFF(q) ((((lane >> 5) + 2 * (q)) < 8 ? O_DQ + ((lane >> 5) + 2 * (q)) * 64 : O_DK + ((lane >> 5) + 2 * (q) - 8) * 64) + d0)
#define L1_LOAD(d, r_) do { const bf16* row_ = P + (size_t)(r_) * OINP; d.a = *(const GAS v2u*)(row_ + O_CQ + 4 * lane); d.c = (lane < 32) ? *(const GAS v2u*)(row_ + O_CQ + 256 + 4 * lane) : (v2u){0u, 0u}; \
        d.k = *(const GAS v2u*)(row_ + O_CKV + 4 * lane); if (lane < 16) { d.kr0 = row_[O_KR + kd0]; d.kr1 = row_[O_KR + kd0 + 8]; } \
        if ((r_) % SROW >= TC) { _Pragma("unroll") for (int q = 0; q < 8; ++q) { d.x0[q] = row_[L1_OFF(q)]; d.x1[q] = row_[L1_OFF(q) + 16]; } } } while (0)
    L1Row nx; if (F.gw < NR) L1_LOAD(nx, F.gw);
    for (int r = F.gw; r < NR; r += F.NGW) { const int b = r / SROW, s = r - b * SROW; const bool isc = s < TC; const int p = s - TC; bf16* row = P + (size_t)r * OINP;
        const L1Row cu = nx; if (r + F.NGW < NR) L1_LOAD(nx, r + F.NGW);
        { bf16* CQ = (bf16*)(F.ws + WS_CQN) + (size_t)r * 640; const v2u a = cu.a, c = cu.c, k = cu.k;
          const float a0 = bflo(a.x), a1 = bfhi(a.x), a2 = bflo(a.y), a3 = bfhi(a.y), c0 = bflo(c.x), c1 = bfhi(c.x), c2 = bflo(c.y), c3 = bfhi(c.y), k0 = bflo(k.x), k1 = bfhi(k.x), k2 = bflo(k.y), k3 = bfhi(k.y);
          const float sq = wave_sum(a0 * a0 + a1 * a1 + a2 * a2 + a3 * a3 + c0 * c0 + c1 * c1 + c2 * c2 + c3 * c3), skv = wave_sum(k0 * k0 + k1 * k1 + k2 * k2 + k3 * k3);
          const float rq = __builtin_amdgcn_rsqf(sq * (1.f / 384.f) + EPS), rk = __builtin_amdgcn_rsqf(skv * (1.f / 256.f) + EPS);
          *(GAS v2u*)(CQ + 4 * lane) = (v2u){pk2(a0 * rq, a1 * rq), pk2(a2 * rq, a3 * rq)};
          if (lane < 32) *(GAS v2u*)(CQ + 256 + 4 * lane) = (v2u){pk2(c0 * rq, c1 * rq), pk2(c2 * rq, c3 * rq)};
          *(GAS v2u*)(CQ + 384 + 4 * lane) = (v2u){pk2(k0 * rk, k1 * rk), pk2(k2 * rk, k3 * rk)}; }
        if (lane < 16) { float x0 = bf2f(cu.kr0), x1 = bf2f(cu.kr1);
            if (!isc) { const float pos = (float)(kseg ? (p & 63) : (p >> 6)); float sn, cs; sincosf(pos * kfreq, &sn, &cs);
                const float y0 = x0 * cs - x1 * sn, y1 = x1 * cs + x0 * sn; x0 = y0; x1 = y1; }
            const bf16 b0 = (bf16)f2bf(x0), b1 = (bf16)f2bf(x1);
#pragma unroll
            for (int h = 0; h < 8; ++h) { KM[(size_t)r * 768 + h * 96 + 64 + kd0] = b0; KM[(size_t)r * 768 + h * 96 + 64 + kd0 + 8] = b1; } }
        if (!isc) { const float pos = (float)(seg ? (p & 63) : (p >> 6)); float sn, cs; sincosf(pos * freq, &sn, &cs);
#pragma unroll
            for (int q = 0; q < 8; ++q) { bf16* base = row + L1_OFF(q);
                const float x0 = bf2f(cu.x0[q]), x1 = bf2f(cu.x1[q]); base[0] = (bf16)f2bf(x0 * cs - x1 * sn); base[16] = (bf16)f2bf(x1 * cs + x0 * sn); } }
    }
#undef L1_LOAD
#undef L1_OFF
}
__device__ __forceinline__ void l1_qrope(Frame& F) {
    bf16* QM = (bf16*)(F.ws + WS_QM); const int lane = F.lane;
    for (int r = F.gw; r < NR; r += F.NGW) { const int b = r / SROW, s = r - b * SROW; if (s < TC) continue; const int p = s - TC;
        const int pi = lane & 15, seg = pi >> 3, i = pi & 7, d0 = seg * 16 + i; const float pos = (float)(seg ? (p & 63) : (p >> 6));
        const float ang = pos * __powf(10000.f, -(float)i * (1.f / 8.f)); float sn, cs; sincosf(ang, &sn, &cs);
#pragma unroll
        for (int q = 0; q < 2; ++q) { const int h = (lane >> 4) + 4 * q; bf16* base = QM + (size_t)r * 768 + h * 96 + 64 + d0;
            const float x0 = bf2f(base[0]), x1 = bf2f(base[8]); base[0] = (bf16)f2bf(x0 * cs - x1 * sn); base[8] = (bf16)f2bf(x1 * cs + x0 * sn); } }
}
__device__ __forceinline__ void l1_attn_unit(Frame& F, int u) {
    if (u < 512) { const int b = u >> 7, qb = (u >> 3) & 15, h = u & 7; const size_t rq = (size_t)b * SROW + TC + qb * 256, r0 = (size_t)b * SROW;
        constexpr float SC = 0.10206207261596575f  , C = SC * 1.4426950408889634f, THRS = att::THR / SC;
        const bf16* QM = (const bf16*)(F.ws + WS_QM); const bf16* KM = (const bf16*)(F.ws + WS_KMLA); const bf16* VM = (const bf16*)(F.ws + WS_VMLA); bf16* MIX = (bf16*)(F.ws + WS_MIX);
        att::attn_unit<96, 64, 0, true>(QM + rq * 768 + h * 96, 768, KM + r0 * 768 + h * 96, 768, VM + r0 * 512 + h * 64, 512, MIX + rq * 1024 + h * 64, 1024, SROW / 64, 0, qb * 256, C, THRS, -3.0e38f, F.ldsg + RING_OFF);
    } else { const int v = u - 512, b = v >> 6, qb = (v >> 2) & 15, head = v & 3; const size_t rq = (size_t)b * SROW + TC + qb * 256, r0 = (size_t)b * SROW;
        constexpr float SC = 0.125f, C = SC * 1.4426950408889634f, THRS = att::THR / SC; constexpr float LAM_INIT = 0.35550906759096556f;
        const float* lp = F.in[I_OLAM]; const float lam = __expf(wave_sum(lp[F.lane] * lp[64 + F.lane])) - __expf(wave_sum(lp[128 + F.lane] * lp[192 + F.lane])) + LAM_INIT;
        const bf16* P = (const bf16*)(F.ws + WS_PROJ2); bf16* MIX = (bf16*)(F.ws + WS_MIX); const int hh = 2 * head;
        att::attn_unit<64, 128, 0, false, 1>(P + rq * OINP + O_DQ + hh * 64, OINP, P + r0 * OINP + O_DK + hh * 64, OINP, P + r0 * OINP + O_DV + head * 128, OINP, MIX, 1024, SROW / 64, 0, 0, C, THRS, -3.0e38f, F.ldsg + RING_OFF);
        att::attn_unit<64, 128, 0, false, 2>(P + rq * OINP + O_DQ + (hh + 1) * 64, OINP, P + r0 * OINP + O_DK + (hh + 1) * 64, OINP, P + r0 * OINP + O_DV + head * 128, OINP, MIX + rq * 1024 + 512 + head * 128, 1024, SROW / 64, 0, 0, C, THRS, -3.0e38f, F.ldsg + RING_OFF,
                                             lam, F.in[I_OSUBLN], 1.f - LAM_INIT); }
}
__device__ __forceinline__ void l1_diff_post(Frame& F) {
    const bf16* OD = (const bf16*)(F.ws + WS_ODIFF); bf16* MIX = (bf16*)(F.ws + WS_MIX); const int lane = F.lane; const float* lp = F.in[I_OLAM];
    constexpr float LAM_INIT = 0.35550906759096556f;
    const float s01 = wave_sum(lp[lane] * lp[64 + lane]), s23 = wave_sum(lp[128 + lane] * lp[192 + lane]); const float lam = __expf(s01) - __expf(s23) + LAM_INIT;
    const int head = lane >> 4, d = (lane & 15) * 8; const f32x4 w0 = *(const GAS f32x4*)(F.in[I_OSUBLN] + d), w1 = *(const GAS f32x4*)(F.in[I_OSUBLN] + d + 4);
    const float ww[8] = {w0.x, w0.y, w0.z, w0.w, w1.x, w1.y, w1.z, w1.w};
    for (int r = F.gw; r < NR; r += F.NGW) { const int b = r / SROW, s = r - b * SROW; if (s < TC) continue;
        const v4u a = *(const GAS v4u*)(OD + (size_t)r * 1024 + (2 * head) * 128 + d), c = *(const GAS v4u*)(OD + (size_t)r * 1024 + (2 * head + 1) * 128 + d);
        float o[8] = {bflo(a.x) - lam * bflo(c.x), bfhi(a.x) - lam * bfhi(c.x), bflo(a.y) - lam * bflo(c.y), bfhi(a.y) - lam * bfhi(c.y), bflo(a.z) - lam * bflo(c.z), bfhi(a.z) - lam * bfhi(c.z), bflo(a.w) - lam * bflo(c.w), bfhi(a.w) - lam * bfhi(c.w)};
        float ss = 0.f;
#pragma unroll
        for (int e = 0; e < 8; ++e) ss += o[e] * o[e];
        ss += __shfl_xor(ss, 1); ss += __shfl_xor(ss, 2); ss += __shfl_xor(ss, 4); ss += __shfl_xor(ss, 8);
        const float rs = (1.f - LAM_INIT) / sqrtf(ss * (1.f / 128.f) + EPS);
#pragma unroll
        for (int e = 0; e < 8; ++e) o[e] = o[e] * rs * ww[e];
        *(GAS v4u*)(MIX + (size_t)r * 1024 + 512 + head * 128 + d) = (v4u){pk2(o[0], o[1]), pk2(o[2], o[3]), pk2(o[4], o[5]), pk2(o[6], o[7])}; }
}
__device__ __forceinline__ void moe_bases(Frame& F, int (&base)[8], int& ntiles) { int acc = 0;
#pragma unroll
    for (int e = 0; e < 8; ++e) { base[e] = acc; const int c = (int)__hip_atomic_load((unsigned*)(F.ctl + CW_MOECNT + 64 * e), RLX_AGENT); acc += (c + 255) & ~255; }
    ntiles = acc >> 8; }
constexpr size_t META_TEXP = 640 * 1024, META_POS = 768 * 1024;
__device__ __forceinline__ int row_vcu(const Frame& F, int r) { return (r % F.NGW) >> 3; }
__device__ __forceinline__ void moe_gather(Frame& F) {
    int base[8], ntiles; moe_bases(F, base, ntiles);
    int* TEXP = (int*)(F.ws + WS_META + META_TEXP); int* POS = (int*)(F.ws + WS_META + META_POS);
    const int* TOPI = (const int*)(F.ws + WS_META + META_TOPI); const int* RANK = (const int*)(F.ws + WS_META + META_RANK);
    if (blockIdx.x == 0 && F.tid < 144) { const int t = F.tid; int e = 0;
#pragma unroll
        for (int q = 1; q < 8; ++q) if (t * 256 >= base[q]) e = q;
        TEXP[t] = e; if (t == 143) TEXP[144] = ntiles; }
    const bf16* FIN = (const bf16*)(F.ws + WS_FIN2); bf16* AS = (bf16*)(F.ws + WS_ASORT);
    for (int tk0 = F.gw; tk0 < NB * T; tk0 += 8 * F.NGW) { int posl = 0;
        { const int i = F.lane >> 1, sl = F.lane & 1, tk = tk0 + i * F.NGW;
          if (F.lane < 16 && tk < NB * T) { const int b = tk / T, t = tk - b * T; const int e = TOPI[tk * 2 + sl]; int bs = 0;
#pragma unroll
              for (int q = 0; q < 8; ++q) if (q == e) bs = base[q];
              posl = bs + ((const int*)(F.ws + WS_META + META_BLKB))[tok_vcu(F, b, t) * 8 + e] + RANK[tk * 2 + sl]; POS[tk * 2 + sl] = posl; } }
#pragma unroll
        for (int i = 0; i < 8; ++i) { const int tk = tk0 + i * F.NGW; if (tk < NB * T) { const int b = tk / T, t = tk - b * T; const size_t r = (size_t)b * SROW + TC + t;
            const GAS v4u* src = (const GAS v4u*)(FIN + r * D) + F.lane; const v4u x0 = src[0], x1 = src[64];
            const int p0 = __builtin_amdgcn_readlane(posl, 2 * i), p1 = __builtin_amdgcn_readlane(posl, 2 * i + 1);
            GAS v4u* d0 = (GAS v4u*)(AS + (size_t)p0 * D) + F.lane; d0[0] = x0; d0[64] = x1;
            GAS v4u* d1 = (GAS v4u*)(AS + (size_t)p1 * D) + F.lane; d1[0] = x0; d1[64] = x1; } } }
}
__device__ __forceinline__ Row4 moe_out_row(Frame& F, const bf16* OR, int pos_) {
    const int pos = __builtin_amdgcn_readfirstlane(pos_), tile = pos >> 8, part = tile >= 68 ? 1 : 0, local = tile - 68 * part;
    if (local < 64) return ld_row_bf16(OR + (size_t)pos * D, F.lane);
    const float* P = (const float*)(F.ws + (part ? WS_WXGU : WS_FIN2)) + ((size_t)(local - 64) * 256 + (pos & 255)) * 1024; Row4 y = ld_row_f32(P, F.lane);
    for (int s = 1; s < DFX / MOE_KSL; ++s) { const Row4 p = ld_row_f32(P + (size_t)s * 4 * 256 * 1024, F.lane);
#pragma unroll
        for (int j = 0; j < 4; ++j) y.v[j] += p.v[j]; }
    return y; }
__device__ __forceinline__ void rows_final(Frame& F) {
    const bf16* OR = (const bf16*)(F.ws + WS_ASORT); const int* POS = (const int*)(F.ws + WS_META + META_POS); const float* TOPW = (const float*)(F.ws + WS_META + META_TOPW);
    const int wpb = F.NGW >> 2, b = F.gw / wpb, wl = F.gw - b * wpb; const Row4 W = ld_row_f32(F.in[I_ONORMS] + 3 * 1024, F.lane), Gt = ld_row_f32(modvec(F, 1, b, 5), F.lane);
    for (int t0 = wl; t0 < T; t0 += 8 * wpb) { int posl = 0; float wgl = 0.f;
        { const int i = F.lane >> 1, sl = F.lane & 1, t = t0 + i * wpb; if (F.lane < 16 && t < T) { posl = POS[(b * T + t) * 2 + sl]; wgl = TOPW[(b * T + t) * 2 + sl]; } }
#pragma unroll
        for (int i = 0; i < 8; ++i) { const int t = t0 + i * wpb; if (t < T) { const int tk = b * T + t; float* xr = F.out + (size_t)tk * D;
            Row4 x = ld_row_bf16((const bf16*)(F.ws + WS_XB) + (size_t)tk * D, F.lane);
            const Row4 y0 = moe_out_row(F, OR, __builtin_amdgcn_readlane(posl, 2 * i)), y1 = moe_out_row(F, OR, __builtin_amdgcn_readlane(posl, 2 * i + 1));
            const float w0 = __uint_as_float((unsigned)__builtin_amdgcn_readlane((int)__float_as_uint(wgl), 2 * i)), w1 = __uint_as_float((unsigned)__builtin_amdgcn_readlane((int)__float_as_uint(wgl), 2 * i + 1)); Row4 y;
#pragma unroll
            for (int j = 0; j < 4; ++j) y.v[j] = y0.v[j] * w0 + y1.v[j] * w1;
            add_gated_norm_r(x, y, W, Gt); st_row_f32(xr, F.lane, x); } } }
}
constexpr int N_PHASES = 26;
__global__ void __launch_bounds__(NWAVES * 64, 2) trunk_fwd(Args args) {
    extern __shared__ __attribute__((aligned(16))) unsigned char lds[];
    Frame F;
    F.lds = (LAS unsigned char*)lds; F.ldsg = (char*)lds;
    F.MISC = (volatile LAS unsigned*)(F.lds + MISC_OFF);
    F.wave = __builtin_amdgcn_readfirstlane((int)threadIdx.x >> 6);
#define REFRESH() do { int z_ = 0; asm volatile("" : "+v"(z_)); F.lane = (int)__builtin_amdgcn_mbcnt_hi(~0u, __builtin_amdgcn_mbcnt_lo(~0u, (unsigned)z_)); F.tid = F.wave * 64 + F.lane; } while (0)
    REFRESH();
    F.G = gridDim.x; { const int bx = blockIdx.x; F.vcu = (F.G % 8 == 0) ? (bx % 8) * (F.G / 8) + bx / 8 : bx; }
    F.gw = F.vcu * NWAVES + F.wave; F.NGW = F.G * NWAVES;
    F.in = args.in; F.out = args.out; F.ws = args.ws; F.ctl = (gu32*)(args.ws + WS_CTL);
    unsigned char* ws = args.ws;
    for (int u = F.tid; u < (LDS_BYTES - MISC_OFF) / 4; u += NWAVES * 64) ((LAS unsigned*)(F.lds + MISC_OFF))[u] = 0u;
    __syncthreads();
    XcdBarrier bar; bar.bar = (unsigned*)(F.ctl + CW_BAR); bar.x = 0; bar.st = nullptr;
    const int lo = args.ph_lo, hi = args.ph_hi;
    const bool use_bar = (hi - lo) > 1;
    if (use_bar) bar = xcd_barrier_post((unsigned*)(F.ctl + CW_BAR), F.MISC + 8);
#ifndef MK_ONLY
#define MK_ONLY_OK(k) true
#else
#define MK_ONLY_OK(k) ((k) == MK_ONLY)
#endif
#define IN(k) (MK_ONLY_OK(k) && lo <= (k) && (k) < hi && (k) <= MK_LAST_PHASE)
#ifndef PROBE_MULT
#define PROBE_MULT 4
#endif
#ifndef PROBE_SPAN
#define PROBE_SPAN 1
#endif
#ifndef SCAN_REP
#define SCAN_REP 1
#endif
#ifndef SWA_REP
#define SWA_REP 1
#endif
#ifndef CHK_MASK
#define CHK_MASK 0xffu
#endif
#ifndef MK_REP_MASK
#define MK_REP_MASK 0u
#endif
#define REPS(k) ((((unsigned)MK_REP_MASK >> (k)) & 1u) ? 2 : 1)
#ifdef PROBE_PHASE
#define STAMP(k) do { if (blockIdx.x == 0 && F.tid == 0) { const unsigned long long t_ = __builtin_amdgcn_s_memrealtime(); F.MISC[64 + 2 * (k)] = (unsigned)t_; F.MISC[65 + 2 * (k)] = (unsigned)(t_ >> 32); } } while (0)
#else
#define STAMP(k) do { } while (0)
#endif
#define SEAM(k) do { if (IN(k) && IN((k) + 1)) xcd_barrier(bar); STAMP((k) + 1); } while (0)
    typedef pg8::bf16_t pb;
    const int bid = blockIdx.x;

    STAMP(0);
    if (IN(0)) for (int rep_ = 0; rep_ < REPS(0); ++rep_) { REFRESH(); p0_prologue(F); } SEAM(0);
    if (IN(1)) for (int rep_ = 0; rep_ < REPS(1); ++rep_) { REFRESH(); p1_first_rows(F); } SEAM(1);
    if (IN(2)) for (int rep_ = 0; rep_ < REPS(2); ++rep_) { REFRESH();
        pg8::Gemm g{(const pb*)(ws + WS_ABUF), (const pb*)(ws + WS_WEIN), NR, EINP, 1024, 1024, 1024}; pg8::StaticOrder S; S.init(NR, EINP, F.G, bid);
        pg8::EpiStore E{(pb*)(ws + WS_PROJ), EINP, EINP / 256};
        pg8::gemm_phase<pg8::EpiStore, pg8::StaticOrder, PG8_ALIGN, PG8_SP2>(F.lds + RING_OFF, g, S, E); } SEAM(2);
    if (IN(3)) for (int rep_ = 0; rep_ < REPS(3); ++rep_) { REFRESH(); g0_prep(F); } SEAM(3);
#ifdef GDN_SLOW
    if (IN(5)) for (int rep_ = 0; rep_ < REPS(5); ++rep_) { REFRESH();
        if (F.G > 64) { if (bid < 64) gdn_chain(F, bid); else for (int u = bid - 64; u < 544; u += F.G - 64) swa_unit(F, u); }
        else { for (int c = bid; c < 64; c += F.G) gdn_chain(F, c); for (int u = bid; u < 544; u += F.G) swa_unit(F, u); } } SEAM(5);
#else
    if (IN(4)) for (int rep_ = 0; rep_ < REPS(4); ++rep_) { REFRESH();
#if G1_LOCK
        if ((F.wave & 3) == 0) for (int item = F.vcu * 2 + (F.wave >> 2); item < 64 * 68; item += F.G * 2) gdn::g1_item(F, item, F.lds + RING_OFF + (F.wave >> 2) * gdn::G1_WAVE_LDS, F.MISC + 16);
#else
        const int n_main = ((64 * 68) / (F.G * 4)) * (F.G * 4), n_late = (64 * 68 - n_main + 3) / 4;
        if (F.wave < 4) { const int R = n_main / (F.G * 4);
            _Pragma("unroll 1") for (int r = 0; r <= R; ++r) { int item;
                if (r < R) item = F.vcu * 4 + F.wave + r * F.G * 4; else { if (F.vcu >= n_late) break; item = n_main + F.vcu * 4 + F.wave; if (item >= 64 * 68) break; }
                gdn::g1_item(F, item, F.lds + RING_OFF + F.wave * gdn::G1_WAVE_LDS, F.MISC + 16); } }
        else p0_deferred(F, F.wave - 4, F.lds + RING_OFF + 4 * gdn::G1_WAVE_LDS + (F.wave - 4) * 8448);
        if (F.vcu >= n_late) { __syncthreads(); REFRESH();
            if (F.tid == 0) F.MISC[20] = __hip_atomic_fetch_add((unsigned*)(F.ctl + CW_SWAQ), 1u, RLX_AGENT);
            __syncthreads(); const int u = (int)F.MISC[20]; __syncthreads();
            if (u < 544) swa_unit(F, u); }
#endif
    } SEAM(4);
    if (IN(5)) for (int rep_ = 0; rep_ < REPS(5); ++rep_) { REFRESH();
        STAMP(30); if (bid < 128) for (int c = bid; c < 128; c += F.G) { gdn::scan_chain(F, c >> 1, c & 1); __syncthreads(); } STAMP(31);
        REFRESH();
        for (;;) { if (F.tid == 0) F.MISC[20] = __hip_atomic_fetch_add((unsigned*)(F.ctl + CW_SWAQ), 1u, RLX_AGENT);
            __syncthreads(); const int u = (int)F.MISC[20]; __syncthreads();
            if (u >= 544 * REPS(5) * SWA_REP) break;
            swa_unit(F, u % 544); } } SEAM(5);
#endif
    if (IN(6)) for (int rep_ = 0; rep_ < REPS(6); ++rep_) { REFRESH(); g4_gdn_out(F); } SEAM(6);
    if (IN(7)) for (int rep_ = 0; rep_ < REPS(7); ++rep_) { REFRESH();
        { pg8::Gemm g{(const pb*)(ws + WS_MIX), (const pb*)(ws + WS_WEOUT), NR, 1024, 1024, 1024, 1024}; pg8::LatOrder S; S.init(1024, F.G, bid);
          pg8::EpiStore E{(pb*)(ws + WS_YBUF), 1024, 4};
          pg8::gemm_phase<pg8::EpiStore, pg8::LatOrder, PG8_ALIGN, PG8_SP2>(F.lds + RING_OFF, g, S, E); }
        __syncthreads();
        { pg8::Gemm g{(const pb*)(ws + WS_MIX), (const pb*)(ws + WS_WEOUT), NR, 1024, 256, 1024, 1024}; pg8::CtxSplitOrder S; S.init(4, 256, F.G, bid);
          pg8::EpiPartF32 E{(float*)(ws + WS_PART), 256};
          pg8::gemm_phase<pg8::EpiPartF32, pg8::CtxSplitOrder, PG8_ALIGN, PG8_SP2>(F.lds + RING_OFF, g, S, E); } } SEAM(7);
    if (IN(8)) for (int rep_ = 0; rep_ < REPS(8); ++rep_) { REFRESH(); rows_mid<false>(F, (const bf16*)(ws + WS_YBUF), F.in[I_ENORMS] + 1024, 0, 2, F.in[I_ENORMS] + 2048, 0, 3, (bf16*)(ws + WS_ABUF), false, 4); } SEAM(8);
    if (IN(9)) for (int rep_ = 0; rep_ < REPS(9); ++rep_) { REFRESH();
        pg8::Gemm g{(const pb*)(ws + WS_ABUF), (const pb*)(ws + WS_WEGU), NR, 2 * DFF, 1024, 1024, 1024}; pg8::StaticOrder S; S.init(NR, 2 * DFF, F.G, bid);
        pg8::EpiSwiGLU E{(pb*)(ws + WS_HID), DFF, DFF / 128};
        pg8::gemm_phase<pg8::EpiSwiGLU, pg8::StaticOrder, PG8_ALIGN, PG8_SP2>(F.lds + RING_OFF, g, S, E); } SEAM(9);
    if (IN(10)) for (int rep_ = 0; rep_ < REPS(10); ++rep_) { REFRESH();
        { pg8::Gemm g{(const pb*)(ws + WS_HID), (const pb*)(ws + WS_WEDN), NR, 1024, DFF, DFF, DFF}; pg8::LatOrder S; S.init(1024, F.G, bid);
          pg8::EpiStore E{(pb*)(ws + WS_YBUF), 1024, 4};
          pg8::gemm_phase<pg8::EpiStore, pg8::LatOrder, PG8_ALIGN, PG8_SP2>(F.lds + RING_OFF, g, S, E); }
        __syncthreads();
        { pg8::Gemm g{(const pb*)(ws + WS_HID), (const pb*)(ws + WS_WEDN), NR, 1024, 256, DFF, DFF}; pg8::CtxSplitOrder S; S.init(11, 256, F.G, bid);
          pg8::EpiPartF32 E{(float*)(ws + WS_PART), 256};
          pg8::gemm_phase<pg8::EpiPartF32, pg8::CtxSplitOrder, PG8_ALIGN, PG8_SP2>(F.lds + RING_OFF, g, S, E); } } SEAM(10);
    if (IN(11)) for (int rep_ = 0; rep_ < REPS(11); ++rep_) { REFRESH(); rows_mid<false>(F, (const bf16*)(ws + WS_YBUF), F.in[I_ENORMS] + 3072, 0, 5, F.in[I_ONORMS], 1, 0, (bf16*)(ws + WS_ABUF), false, 11); } SEAM(11);
    if (IN(12)) for (int rep_ = 0; rep_ < REPS(12); ++rep_) { REFRESH();
        pg8::Gemm g{(const pb*)(ws + WS_ABUF), (const pb*)(ws + WS_WOIN), NR, OINP, 1024, 1024, 1024}; pg8::StaticOrder S; S.init(NR, OINP, F.G, bid);
        pg8::EpiStore E{(pb*)(ws + WS_PROJ2), OINP, OINP / 256};
        pg8::gemm_phase<pg8::EpiStore, pg8::StaticOrder, PG8_ALIGN, PG8_SP2>(F.lds + RING_OFF, g, S, E); } SEAM(12);
    if (IN(13)) for (int rep_ = 0; rep_ < REPS(13); ++rep_) { REFRESH(); l1_prep(F); } SEAM(13);
    if (IN(14)) for (int rep_ = 0; rep_ < REPS(14); ++rep_) { REFRESH();
#if !defined(T13) || T13 == 1
        { pg8::Gemm g{(const pb*)(ws + WS_CQN), (const pb*)(ws + WS_WUQ), NR, 768, 384, 640, 384}; pg8::LatOrder S; S.init(768, F.G, bid);
          pg8::EpiStore E{(pb*)(ws + WS_QM), 768, 3};
          pg8::gemm_phase<pg8::EpiStore, pg8::LatOrder, PG8_ALIGN, PG8_SP2>(F.lds + RING_OFF, g, S, E); }
#endif
        __syncthreads();
#if !defined(T13) || T13 == 2
        { pg8::Gemm g{(const pb*)(ws + WS_CQN) + 384, (const pb*)(ws + WS_WUKV), NR, 1024, 256, 640, 256}; pg8::StaticOrder S; S.init(NR, 1024, F.G, bid);
          pg8::EpiKV E{(pb*)(ws + WS_KMLA), (pb*)(ws + WS_VMLA)};
          pg8::gemm_phase<pg8::EpiKV, pg8::StaticOrder, PG8_ALIGN, PG8_SP2>(F.lds + RING_OFF, g, S, E); }
#endif
    } SEAM(14);
    STAMP(16);
    if (IN(16)) for (int rep_ = 0; rep_ < REPS(16); ++rep_) { REFRESH(); for (int u = F.vcu; u < 768; u += F.G) l1_attn_unit(F, u); } SEAM(16);
    STAMP(18);
    if (IN(18)) for (int rep_ = 0; rep_ < REPS(18); ++rep_) { REFRESH();
        pg8::Gemm g{(const pb*)(ws + WS_MIX), (const pb*)(ws + WS_WOOUT), NR, 1024, 1024, 1024, 1024}; pg8::LatOrder S; S.init(1024, F.G, bid);
        pg8::EpiStore E{(pb*)(ws + WS_Y2), 1024, 4};
        pg8::gemm_phase<pg8::EpiStore, pg8::LatOrder, PG8_ALIGN, PG8_SP2>(F.lds + RING_OFF, g, S, E); } SEAM(18);
    if (IN(19)) for (int rep_ = 0; rep_ < REPS(19); ++rep_) { REFRESH();
        router_table(F);
        if (F.wave >= 4) px_expert_weights(F);
        rows_mid<true>(F, (const bf16*)(ws + WS_Y2), F.in[I_ONORMS] + 1024, 1, 2, F.in[I_ONORMS] + 2048, 1, 3, (bf16*)(ws + WS_FIN2), true);
        if (F.wave < 4) px_expert_weights(F);
        router_tail(F); } SEAM(19);
    if (IN(20)) for (int rep_ = 0; rep_ < REPS(20); ++rep_) { REFRESH(); moe_gather(F); } SEAM(20);
#define MOE_PART(kgu, kdn, t0_, cap_) \
    if (IN(kgu)) for (int rep_ = 0; rep_ < REPS(kgu); ++rep_) { REFRESH(); int base[8], ntiles; moe_bases(F, base, ntiles); const int t0 = (t0_), ntl = (ntiles - t0 < 0) ? 0 : ((ntiles - t0 < (cap_)) ? ntiles - t0 : (cap_)); \
        pg8::Gemm g{(const pb*)(ws + WS_ASORT) + (size_t)t0 * 256 * 1024, (const pb*)(ws + WS_WXGU), 0, 0, 1024, 1024, 1024}; pg8::MoeOrder S; S.init(ntl, 28, F.G, bid, (const int*)(ws + WS_META + META_TEXP), t0); \
        pg8::EpiSwiGLU E{(pb*)(ws + WS_HIDX), DFX, 28}; \
        pg8::gemm_phase<pg8::EpiSwiGLU, pg8::MoeOrder, PG8_ALIGN, PG8_SP2>(F.lds + RING_OFF, g, S, E); \
        if ((t0_) == 0 && ntl > 0) { const int nu = ntl * 28, remu = nu % F.G, first = remu ? remu : 0, ns = F.G - first;     \
            const int esp = ((const int*)(ws + WS_META + META_TEXP))[ntl - 1]; \
            if (bid >= first) { __syncthreads(); px_expert_down(F, (bid - first) * NWAVES + F.wave, ns * NWAVES, 0, esp + 1); } } } SEAM(kgu); \
    if (IN(kdn)) for (int rep_ = 0; rep_ < REPS(kdn); ++rep_) { REFRESH(); int base[8], ntiles; moe_bases(F, base, ntiles); const int t0 = (t0_), ntl = (ntiles - t0 < 0) ? 0 : ((ntiles - t0 < (cap_)) ? ntiles - t0 : (cap_)); \
        const int full = ntl < 64 ? ntl : 64, ex = ntl - full; \
        { pg8::Gemm g{(const pb*)(ws + WS_HIDX), (const pb*)(ws + WS_WXDN), 0, 0, DFX, DFX, DFX}; pg8::MoeOrder S; S.init(full, 4, F.G, bid, (const int*)(ws + WS_META + META_TEXP), t0); \
          pg8::EpiStore E{(pb*)(ws + WS_ASORT) + (size_t)t0 * 256 * 1024, 1024, 4}; \
          pg8::gemm_phase<pg8::EpiStore, pg8::MoeOrder, PG8_ALIGN, PG8_SP2>(F.lds + RING_OFF, g, S, E); } \
        if (ex > 0) { __syncthreads(); \
          pg8::Gemm g{(const pb*)(ws + WS_HIDX), (const pb*)(ws + WS_WXDN), 0, 0, MOE_KSL, DFX, DFX}; pg8::MoeSplitOrder S; S.init(ex, DFX / MOE_KSL, MOE_KSL, F.G, bid, (const int*)(ws + WS_META + META_TEXP), t0); \
          pg8::EpiMoePart E{(float*)(ws + ((t0_) ? WS_WXGU : WS_FIN2)), MOE_KSL}; \
          pg8::gemm_phase<pg8::EpiMoePart, pg8::MoeSplitOrder, PG8_ALIGN, PG8_SP2>(F.lds + RING_OFF, g, S, E); } \
        if ((t0_) == 0 && ntl > 0) { const int nsu = ex * 4 * (DFX / MOE_KSL), first = nsu < F.G ? nsu : 0, ns = F.G - first;     \
            const int esp = ((const int*)(ws + WS_META + META_TEXP))[ntl - 1]; \
            if (bid >= first && esp + 1 < NEXP) { __syncthreads(); px_expert_down(F, (bid - first) * NWAVES + F.wave, ns * NWAVES, esp + 1, NEXP); } } } SEAM(kdn);
    MOE_PART(21, 22, 0, 68)
    MOE_PART(23, 24, 68, 68)
    if (IN(25)) for (int rep_ = 0; rep_ < REPS(25); ++rep_) { REFRESH(); rows_final(F);
#if defined(CHK_G1) || defined(CHK_SCAN)
        { const unsigned fb = __hip_atomic_load((unsigned*)(F.ctl + CW_CHK), RLX_AGENT) & CHK_MASK; if (fb != 0u) { VM_WAIT(); __syncthreads(); for (int i = F.gw * 64 + F.lane; i < NB * T * D; i += F.NGW * 64) F.out[i] = 0.f; } }
#endif
    }
#ifdef PROBE_PHASE
    STAMP(26);
    if (blockIdx.x == 0 && F.tid == 0) {
        const unsigned long long t0 = ((unsigned long long)F.MISC[65 + 2 * PROBE_PHASE] << 32) | F.MISC[64 + 2 * PROBE_PHASE], t1 = ((unsigned long long)F.MISC[65 + 2 * (PROBE_PHASE + PROBE_SPAN)] << 32) | F.MISC[64 + 2 * (PROBE_PHASE + PROBE_SPAN)];
        unsigned long long dly = (t1 - t0) * PROBE_MULT; if (dly > 2000000ull) dly = 2000000ull; const unsigned long long s0 = __builtin_amdgcn_s_memrealtime();
        while (__builtin_amdgcn_s_memrealtime() - s0 < dly) __builtin_amdgcn_s_sleep(8); }
#endif
#undef IN
#undef SEAM
}

extern "C" void kernel_launch(void* const* d_in, const int* in_sizes, int n_in, void* d_out, int out_size, void* d_ws, size_t ws_size, hipStream_t stream) {
    static int grid = 0;
    if (grid == 0) {
        if (n_in != 32 || in_sizes[0] != NB * T * D || out_size != NB * T * D || ws_size < WS_END) { fprintf(stderr, "kernel_launch: unexpected shapes: n_in %d in0 %d out %d ws %zu (need %zu)\n", n_in, n_in > 0 ? in_sizes[0] : -1, out_size, ws_size, (size_t)WS_END); grid = -1; return; }
        int dev = 0, cus = 0, per_cu = 0;
        if (hipGetDevice(&dev) != hipSuccess || hipDeviceGetAttribute(&cus, hipDeviceAttributeMultiprocessorCount, dev) != hipSuccess) { grid = -1; return; }
        if (hipFuncSetAttribute((const void*)trunk_fwd, hipFuncAttributeMaxDynamicSharedMemorySize, LDS_BYTES) != hipSuccess) { fprintf(stderr, "kernel_launch: hipFuncSetAttribute failed\n"); grid = -1; return; }
        if (hipOccupancyMaxActiveBlocksPerMultiprocessor(&per_cu, (const void*)trunk_fwd, NWAVES * 64, LDS_BYTES) != hipSuccess || per_cu < 1) fprintf(stderr, "kernel_launch: occupancy query reports %d\n", per_cu);
        (void)hipGetLastError();
        grid = cus;
    }
    if (grid < 0) return;
    if (hipMemsetAsync((char*)d_ws + WS_CTL, 0, CTL_ZERO_BYTES, stream) != hipSuccess) return;
#ifdef DIAG_POISON
    (void)hipMemsetAsync((char*)d_ws + WS_GDNI, 0xFF, (size_t)64 * 68 * 32768, stream);
    (void)hipMemsetAsync((char*)d_ws + WS_OG, 0xFF, (size_t)NR * 1024 * 2, stream);
    (void)hipMemsetAsync((char*)d_ws + WS_QKVN, 0xFF, (size_t)NR * 1536 * 2, stream);
    (void)hipMemsetAsync((char*)d_ws + WS_GB, 0xFF, (size_t)NR * 32 * 4, stream);
#endif
    Args a{};
    for (int i = 0; i < 32; ++i) a.in[i] = (const float*)d_in[i];
    a.out = (float*)d_out; a.ws = (unsigned char*)d_ws;
#if MK_N_LAUNCHES == 1
    a.ph_lo = 0; a.ph_hi = N_PHASES;
    hipLaunchKernelGGL(trunk_fwd, dim3(grid), dim3(NWAVES * 64), LDS_BYTES, stream, a);
#else
    for (int p = 0; p < N_PHASES && p <= MK_LAST_PHASE; ++p) { a.ph_lo = p; a.ph_hi = p + 1; hipLaunchKernelGGL(trunk_fwd, dim3(grid), dim3(NWAVES * 64), LDS_BYTES, stream, a); }
#endif
    const hipError_t le = hipPeekAtLastError();
    if (le != hipSuccess) fprintf(stderr, "kernel_launch: launch failed: %s\n", hipGetErrorName(le));
}
```
